# Optimizing an MI355X kernel written in HIP

```python
import math
import jax, jax.numpy as jnp
from jax import lax
import numpy as np

D_MODEL = 1024
BATCH = 8
SEQ = 4096
DEPTH = 2
DEC_BATCH = 8
DEC_SEQ = 2048
PAST_LEN = 128

GRID_W = 64
HEAD_DIM = 64
MIX_WIDTH = D_MODEL
Q_BLOCK = 128
NORM_EPS = 1e-6
A_HEADS = 4
A_KV_HEADS = 2
A_THETA = 10000.0
B_HEADS = 4
B_SUB = HEAD_DIM // 2
B_ROT = B_SUB // 4
PARTIAL_THETA = 500000.0
C_HEADS = 4
RET_THETA = 10000.0
RET_CHUNK = 128
D_HEADS = 4
W_LORA = 64
A_LORA = 64
G_LORA = 128
WKV_GN_EPS = 64e-5
D_FF = ((-(-8 * D_MODEL // 3) + 255) // 256) * 256

A_W = A_HEADS * HEAD_DIM
A_KV_W = A_KV_HEADS * HEAD_DIM
B_W = B_HEADS * HEAD_DIM
C_W = C_HEADS * HEAD_DIM
D_W = D_HEADS * HEAD_DIM
A_COLS = A_W + 2 * A_KV_W
B_COLS = 3 * B_W
C_COLS = 4 * C_W
D_SPLITS = (D_W, D_W, D_W, W_LORA, W_LORA, A_LORA, G_LORA)
D_COLS = 3 * D_W + 2 * W_LORA + A_LORA + G_LORA
IN_COLS = A_COLS + B_COLS + C_COLS + D_COLS
GROUP_OFFS = (A_COLS, A_COLS + B_COLS, A_COLS + B_COLS + C_COLS)

kernel_name = 'hybrid_bidir_parallel_heads_encoder'


def _rms(x, gain, eps=NORM_EPS):
    xf = x.astype(jnp.float32)
    y = xf * lax.rsqrt(jnp.mean(xf * xf, axis=-1, keepdims=True) + eps)
    return (y * gain.astype(jnp.float32)).astype(x.dtype)


def _split(z, sizes):
    offs = [int(o) for o in np.cumsum(sizes)[:-1]]
    return jnp.split(z, offs, axis=-1)


def _angles(pos, rot_dim, theta):
    inv = theta ** (-jnp.arange(0, rot_dim, 2, dtype=jnp.float32) / rot_dim)
    return pos.astype(jnp.float32)[:, None] * inv[None, :]


def _rotate(x, ang):
    half = x.shape[-1] // 2
    x1, x2 = x[..., :half], x[..., half:]
    c = jnp.cos(ang)[None, :, None, :].astype(x.dtype)
    s = jnp.sin(ang)[None, :, None, :].astype(x.dtype)
    return jnp.concatenate([x1 * c - x2 * s, x2 * c + x1 * s], axis=-1)


def _mixer_gqa(z, q_gain, k_gain, row_idx, col_idx):
    bn, t, _ = z.shape
    q, k, v = _split(z, (A_W, A_KV_W, A_KV_W))
    q = _rms(q.reshape(bn, t, A_HEADS, HEAD_DIM), q_gain)
    k = _rms(k.reshape(bn, t, A_KV_HEADS, HEAD_DIM), k_gain)
    v = v.reshape(bn, t, A_KV_HEADS, HEAD_DIM)
    half = HEAD_DIM // 2
    ang_r = _angles(row_idx, half, A_THETA)
    ang_c = _angles(col_idx, half, A_THETA)

    def axial(x):
        return jnp.concatenate([_rotate(x[..., :half], ang_r), _rotate(x[..., half:], ang_c)], axis=-1)

    q, k = axial(q), axial(k)
    g = A_HEADS // A_KV_HEADS
    nb = t // Q_BLOCK
    qb = q.reshape(bn, nb, Q_BLOCK, A_KV_HEADS, g, HEAD_DIM).transpose(1, 0, 3, 4, 2, 5)
    kt = k.transpose(0, 2, 1, 3)
    vt = v.transpose(0, 2, 1, 3)
    scale = HEAD_DIM ** -0.5

    def block(qblk):
        s = jnp.einsum('bhgqd,bhkd->bhgqk', qblk, kt).astype(jnp.float32) * scale
        p = jax.nn.softmax(s, axis=-1).astype(vt.dtype)
        return jnp.einsum('bhgqk,bhkd->bhgqd', p, vt)

    o = lax.map(block, qb)
    return o.transpose(1, 0, 4, 2, 3, 5).reshape(bn, t, A_W)


def _mixer_diff(z, lam_params, subln_gain, pos, lam_init):
    bn, t, _ = z.shape
    q, k, v = _split(z, (B_W, B_W, B_W))
    q = q.reshape(bn, t, 2 * B_HEADS, B_SUB)
    k = k.reshape(bn, t, 2 * B_HEADS, B_SUB)
    v = v.reshape(bn, t, B_HEADS, HEAD_DIM)
    ang = _angles(pos, B_ROT, PARTIAL_THETA)

    def partial_rope(x):
        return jnp.concatenate([_rotate(x[..., :B_ROT], ang), x[..., B_ROT:]], axis=-1)

    q, k = partial_rope(q), partial_rope(k)
    lp = lam_params.astype(jnp.float32)
    lam = jnp.exp(jnp.sum(lp[0] * lp[1])) - jnp.exp(jnp.sum(lp[2] * lp[3])) + lam_init
    nb = t // Q_BLOCK
    qb = q.reshape(bn, nb, Q_BLOCK, 2 * B_HEADS, B_SUB).transpose(1, 0, 3, 2, 4)
    kt = k.transpose(0, 2, 1, 3)
    vt = v.transpose(0, 2, 1, 3)
    scale = B_SUB ** -0.5

    def block(qblk):
        s = jnp.einsum('bhqd,bhkd->bhqk', qblk, kt).astype(jnp.float32) * scale
        p = jax.nn.softmax(s, axis=-1)
        p = p.reshape(p.shape[0], B_HEADS, 2, p.shape[2], p.shape[3])
        a = p[:, :, 0] - lam * p[:, :, 1]
        return jnp.einsum('bhqk,bhkd->bhqd', a.astype(vt.dtype), vt)

    o = lax.map(block, qb)
    o = o.transpose(1, 0, 3, 2, 4).reshape(bn, t, B_HEADS, HEAD_DIM)
    o = _rms(o, subln_gain) * (1.0 - lam_init)
    return o.reshape(bn, t, B_W)


def _retention_dir(q, k, v, log_gamma):
    bn, h, t, d = q.shape
    c = RET_CHUNK
    n = t // c
    qc = q.reshape(bn, h, n, c, d)
    kc = k.reshape(bn, h, n, c, d)
    vc = v.reshape(bn, h, n, c, d)
    i = jnp.arange(c, dtype=jnp.float32)
    lg = log_gamma.astype(jnp.float32)[:, None]
    diff = i[:, None] - i[None, :]
    dmask = jnp.where(diff >= 0, jnp.exp(lg[:, :, None] * jnp.maximum(diff, 0.0)), 0.0)
    inner = jnp.einsum('bhnid,bhnjd->bhnij', qc, kc) * dmask[None, :, None].astype(q.dtype)
    o_inner = jnp.einsum('bhnij,bhnje->bhnie', inner, vc)
    k_dec = jnp.exp(lg * (c - 1 - i))
    kv = jnp.einsum('bhnjd,bhnje->bhnde', kc * k_dec[None, :, None, :, None].astype(q.dtype), vc)
    g_chunk = jnp.exp(log_gamma.astype(jnp.float32) * c)[None, :, None, None]

    def step(state, kv_c):
        return g_chunk * state + kv_c, state

    s0 = jnp.zeros((bn, h, d, d), jnp.float32)
    _, states = lax.scan(step, s0, kv.transpose(2, 0, 1, 3, 4).astype(jnp.float32))
    states = states.transpose(1, 2, 0, 3, 4).astype(q.dtype)
    q_dec = jnp.exp(lg * (i + 1.0))
    cross = jnp.einsum('bhnid,bhnde->bhnie', qc * q_dec[None, :, None, :, None].astype(q.dtype), states)
    return (o_inner + cross).reshape(bn, h, t, d)


def _mixer_retention(z, gn_gain, pos, lg_fwd, lg_bwd):
    bn, t, _ = z.shape
    q, k, v, g = _split(z, (C_W, C_W, C_W, C_W))
    ang = _angles(pos, HEAD_DIM, RET_THETA)
    q = _rotate(q.reshape(bn, t, C_HEADS, HEAD_DIM), ang).transpose(0, 2, 1, 3)
    k = (_rotate(k.reshape(bn, t, C_HEADS, HEAD_DIM), ang) * (HEAD_DIM ** -0.5)).transpose(0, 2, 1, 3)
    v = v.reshape(bn, t, C_HEADS, HEAD_DIM).transpose(0, 2, 1, 3)
    fwd = _retention_dir(q, k, v, lg_fwd)
    bwd = jnp.flip(_retention_dir(jnp.flip(q, 2), jnp.flip(k, 2), jnp.flip(v, 2), lg_bwd), 2)
    o = (fwd + bwd).transpose(0, 2, 1, 3)
    o = _rms(o, gn_gain.reshape(C_HEADS, HEAD_DIM))
    return o.reshape(bn, t, C_W) * jax.nn.silu(g)


def _wkv7(r, w, k, v, kk, b, reverse):
    bn, t, h, n = r.shape
    xs = (r.transpose(1, 0, 2, 3), w.transpose(1, 0, 2, 3), k.transpose(1, 0, 2, 3),
          v.transpose(1, 0, 2, 3), kk.transpose(1, 0, 2, 3), b.transpose(1, 0, 2, 3))

    def step(state, xs_t):
        r_t, w_t, k_t, v_t, kk_t, b_t = xs_t
        sa = jnp.einsum('bhvk,bhk->bhv', state, -kk_t)
        state = state * w_t[:, :, None, :] + sa[..., None] * b_t[:, :, None, :] + v_t[..., None] * k_t[:, :, None, :]
        return state, jnp.einsum('bhvk,bhk->bhv', state, r_t)

    _, y = lax.scan(step, jnp.zeros((bn, h, n, n), jnp.float32), xs, reverse=reverse)
    return y.transpose(1, 0, 2, 3)


def _mixer_rwkv7(z, mu_prev, mu_next, w0, w_up, a0, a_up, g_up, k_k, k_a, r_k, gn_w, gn_b):
    bn, t, _ = z.shape
    z_prev = jnp.pad(z[:, :-1], ((0, 0), (1, 0), (0, 0)))
    z_next = jnp.pad(z[:, 1:], ((0, 0), (0, 1), (0, 0)))
    u = z + mu_prev * (z_prev - z) + mu_next * (z_next - z)
    r, k, v, wdf, wdb, ad, gd = _split(u, D_SPLITS)
    f32 = jnp.float32

    def decay(wd, w0_d, w_up_d):
        w = -jax.nn.softplus(-(w0_d + jnp.tanh(wd) @ w_up_d).astype(f32)) - 0.5
        return jnp.exp(-jnp.exp(w)).reshape(bn, t, D_HEADS, HEAD_DIM)

    dec_f = decay(wdf, w0[0], w_up[0])
    dec_b = decay(wdb, w0[1], w_up[1])
    a = jax.nn.sigmoid((a0 + ad @ a_up).astype(f32)).reshape(bn, t, D_HEADS, HEAD_DIM)
    g = (jax.nn.sigmoid(gd) @ g_up).astype(f32)
    rh = r.astype(f32).reshape(bn, t, D_HEADS, HEAD_DIM)
    kh = k.astype(f32).reshape(bn, t, D_HEADS, HEAD_DIM)
    vh = v.astype(f32).reshape(bn, t, D_HEADS, HEAD_DIM)
    kk = kh * k_k.astype(f32).reshape(D_HEADS, HEAD_DIM)
    kk = kk / jnp.maximum(jnp.sqrt(jnp.sum(kk * kk, axis=-1, keepdims=True)), 1e-12)
    kh = kh * (1.0 + (a - 1.0) * k_a.astype(f32).reshape(D_HEADS, HEAD_DIM))
    b = kk * a
    y = _wkv7(rh, dec_f, kh, vh, kk, b, False) + _wkv7(rh, dec_b, kh, vh, kk, b, True)
    mean = jnp.mean(y, axis=-1, keepdims=True)
    var = jnp.mean((y - mean) ** 2, axis=-1, keepdims=True)
    yn = (y - mean) * lax.rsqrt(var + WKV_GN_EPS) * gn_w.astype(f32).reshape(D_HEADS, HEAD_DIM) \
        + gn_b.astype(f32).reshape(D_HEADS, HEAD_DIM)
    yn = yn + jnp.sum(rh * kh * r_k.astype(f32), axis=-1, keepdims=True) * vh
    return (yn.reshape(bn, t, D_W) * g).astype(z.dtype)


def _trunk(x, p):
    bn, t, _ = x.shape
    rows = t // GRID_W
    row_idx = jnp.repeat(jnp.arange(rows), GRID_W)
    col_idx = jnp.tile(jnp.arange(GRID_W), rows)
    pos = jnp.arange(t)
    lg_fwd = jnp.log1p(-jnp.exp2(-5.0 - jnp.arange(C_HEADS, dtype=jnp.float32)))
    lg_bwd = lg_fwd[::-1]
    for l in range(DEPTH):
        h = _rms(x, p['norm_mix_pre'][l])
        z = h @ p['w_in'][l]
        z_a, z_b, z_c, z_d = jnp.split(z, list(GROUP_OFFS), axis=-1)
        lam_init = 0.8 - 0.6 * math.exp(-0.3 * l)
        o_a = _mixer_gqa(z_a, p['a_q_gain'][l], p['a_k_gain'][l], row_idx, col_idx)
        o_b = _mixer_diff(z_b, p['b_lambda'][l], p['b_subln_gain'][l], pos, lam_init)
        o_c = _mixer_retention(z_c, p['c_gn_gain'][l], pos, lg_fwd, lg_bwd)
        o_d = _mixer_rwkv7(z_d, p['d_mu_prev'][l], p['d_mu_next'][l], p['d_w0'][l], p['d_w_up'][l],
                           p['d_a0'][l], p['d_a_up'][l], p['d_g_up'][l], p['d_k_k'][l], p['d_k_a'][l],
                           p['d_r_k'][l], p['d_gn_w'][l], p['d_gn_b'][l])
        mix = jnp.concatenate([o_a, o_b, o_c, o_d], axis=-1) @ p['w_out'][l]
        x = x + _rms(mix, p['norm_mix_post'][l])
        h = _rms(x, p['norm_ffn_pre'][l])
        f = (jax.nn.silu(h @ p['ffn_w_gate'][l]) * (h @ p['ffn_w_up'][l])) @ p['ffn_w_down'][l]
        x = x + _rms(f, p['norm_ffn_post'][l])
    return x


def setup_inputs(seed: int = 0) -> dict:
    key = jax.random.key(seed)
    ks = iter(jax.random.split(key, 40))
    L = DEPTH

    def nrm(shape, scale):
        return jax.random.normal(next(ks), shape, jnp.float32) * scale

    return {
        'x_prompt': nrm((BATCH, SEQ, D_MODEL), 1.0),
        'x_sample': nrm((DEC_BATCH, DEC_SEQ, D_MODEL), 1.0),
        'norm_mix_pre': 1.0 + nrm((L, D_MODEL), 0.02),
        'norm_mix_post': 1.0 + nrm((L, D_MODEL), 0.02),
        'norm_ffn_pre': 1.0 + nrm((L, D_MODEL), 0.02),
        'norm_ffn_post': 1.0 + nrm((L, D_MODEL), 0.02),
        'w_in': nrm((L, D_MODEL, IN_COLS), D_MODEL ** -0.5),
        'w_out': nrm((L, MIX_WIDTH, D_MODEL), MIX_WIDTH ** -0.5),
        'a_q_gain': 1.0 + nrm((L, HEAD_DIM), 0.02),
        'a_k_gain': 1.0 + nrm((L, HEAD_DIM), 0.02),
        'b_lambda': nrm((L, 4, B_SUB), 0.1),
        'b_subln_gain': 1.0 + nrm((L, HEAD_DIM), 0.02),
        'c_gn_gain': 1.0 + nrm((L, C_W), 0.02),
        'd_mu_prev': 0.3 + nrm((L, D_COLS), 0.1),
        'd_mu_next': 0.3 + nrm((L, D_COLS), 0.1),
        'd_w0': -1.0 + nrm((L, 2, D_W), 0.5),
        'd_w_up': nrm((L, 2, W_LORA, D_W), 0.1 * W_LORA ** -0.5),
        'd_a0': nrm((L, D_W), 0.1),
        'd_a_up': nrm((L, A_LORA, D_W), 0.5 * A_LORA ** -0.5),
        'd_g_up': nrm((L, G_LORA, D_W), G_LORA ** -0.5),
        'd_k_k': 0.85 + nrm((L, D_W), 0.05),
        'd_k_a': 1.0 + nrm((L, D_W), 0.05),
        'd_r_k': nrm((L, D_HEADS, HEAD_DIM), 0.1),
        'd_gn_w': 1.0 + nrm((L, D_W), 0.02),
        'd_gn_b': nrm((L, D_W), 0.02),
        'ffn_w_gate': nrm((L, D_MODEL, D_FF), D_MODEL ** -0.5),
        'ffn_w_up': nrm((L, D_MODEL, D_FF), D_MODEL ** -0.5),
        'ffn_w_down': nrm((L, D_FF, D_MODEL), D_FF ** -0.5),
    }


def reference(x_prompt, x_sample, norm_mix_pre, norm_mix_post, norm_ffn_pre, norm_ffn_post,
              w_in, w_out, a_q_gain, a_k_gain, b_lambda, b_subln_gain, c_gn_gain,
              d_mu_prev, d_mu_next, d_w0, d_w_up, d_a0, d_a_up, d_g_up, d_k_k, d_k_a, d_r_k,
              d_gn_w, d_gn_b, ffn_w_gate, ffn_w_up, ffn_w_down):
    params = {
        'norm_mix_pre': norm_mix_pre, 'norm_mix_post': norm_mix_post,
        'norm_ffn_pre': norm_ffn_pre, 'norm_ffn_post': norm_ffn_post,
        'w_in': w_in, 'w_out': w_out,
        'a_q_gain': a_q_gain, 'a_k_gain': a_k_gain,
        'b_lambda': b_lambda, 'b_subln_gain': b_subln_gain,
        'c_gn_gain': c_gn_gain,
        'd_mu_prev': d_mu_prev, 'd_mu_next': d_mu_next, 'd_w0': d_w0, 'd_w_up': d_w_up,
        'd_a0': d_a0, 'd_a_up': d_a_up, 'd_g_up': d_g_up, 'd_k_k': d_k_k, 'd_k_a': d_k_a,
        'd_r_k': d_r_k, 'd_gn_w': d_gn_w, 'd_gn_b': d_gn_b,
        'ffn_w_gate': ffn_w_gate, 'ffn_w_up': ffn_w_up, 'ffn_w_down': ffn_w_down,
    }
    y_prompt = _trunk(x_prompt, params)
    y_sample = _trunk(x_sample, params)
    return (y_prompt, y_sample)
```

```cpp
#include <hip/hip_runtime.h>
#include <hip/hip_cooperative_groups.h>
#include <cstdio>
#include <cstdint>
namespace cg = cooperative_groups;

#define DI __device__ __forceinline__
typedef unsigned short bf16_t;
typedef short bf16x8 __attribute__((ext_vector_type(8)));
typedef float f32x2 __attribute__((ext_vector_type(2)));
typedef float f32x4 __attribute__((ext_vector_type(4)));
typedef float f32x16 __attribute__((ext_vector_type(16)));
typedef unsigned u32x2 __attribute__((ext_vector_type(2)));
typedef unsigned u32x4 __attribute__((ext_vector_type(4)));
typedef __bf16 bf16x2_t __attribute__((ext_vector_type(2)));

constexpr int M0 = 32768, MT = 49152, DM = 1024, NIN = 3392, NINP = 3456, DFF = 2816;
constexpr int A_Q = 0, A_K = 256, A_V = 384, B_Q = 512, B_K = 768, B_V = 1024, C_Q = 1280, C_K = 1536, C_V = 1792, C_G = 2048, D_0 = 2304;
constexpr int PITCH = 144;
constexpr size_t PLANE = (size_t)MT * 256;
constexpr int LDS_BYTES = 73728;
constexpr float LOG2E = 1.4426950408889634f;
constexpr float EPS = 1e-6f;

enum { I_XP = 0, I_XS, I_NMPRE, I_NMPOST, I_NFPRE, I_NFPOST, I_WIN, I_WOUT, I_AQG, I_AKG, I_BLAM, I_BSUB, I_CGN, I_DMUP, I_DMUN, I_DW0, I_DWUP,
       I_DA0, I_DAUP, I_DGUP, I_DKK, I_DKA, I_DRK, I_DGNW, I_DGNB, I_FG, I_FU, I_FD };

struct Params {
  const float* in[28];
  float* out;
  bf16_t* z;
  bf16_t* pl;
  bf16_t* wtin;
  bf16_t* wtout;
  f32x2* tabC;
  f32x2* tabB;
  f32x2* tabA;
  int* ctr;
};

DI int opaque(int x) { asm volatile("" : "+v"(x)); return x; }
DI float bf2f(bf16_t v) { return __uint_as_float(((unsigned)v) << 16); }
DI float bflo(unsigned w) { return __uint_as_float(w << 16); }
DI float bfhi(unsigned w) { return __uint_as_float(w & 0xffff0000u); }
DI unsigned pk(float lo, float hi) { f32x2 v = {lo, hi}; bf16x2_t b = __builtin_convertvector(v, bf16x2_t); return __builtin_bit_cast(unsigned, b); }
DI bf16_t f2bf(float x) { return (bf16_t)(pk(x, 0.f) & 0xffffu); }
DI float wave_sum(float v) {
#pragma unroll
  for (int o = 32; o; o >>= 1) v += __shfl_xor(v, o);
  return v;
}
DI float fexp2(float x) { return __builtin_amdgcn_exp2f(x); }
DI void seq_info(int s, int& row0, int& T) { if (s < 8) { row0 = s * 4096; T = 4096; } else { row0 = M0 + (s - 8) * 2048; T = 2048; } }
DI void row_info(int r, int& t, int& T) { if (r < M0) { t = r & 4095; T = 4096; } else { t = (r - M0) & 2047; T = 2048; } }
#define MFMA32(a, b, c) __builtin_amdgcn_mfma_f32_32x32x16_bf16((a), (b), (c), 0, 0, 0)

DI void conv_T(char* lds, const float* __restrict__ W, int K, int N, bf16_t* __restrict__ Wt, int mode, int tile) {
  float* t = (float*)lds;
  const int tid0 = opaque(threadIdx.x);
  const int ntn = N >> 6, kt = tile / ntn, nt = tile - kt * ntn, k0 = kt << 6, n0 = nt << 6;
#pragma unroll 4
  for (int i = 0; i < 16; ++i) { const int idx = tid0 + 256 * i, k = idx >> 6, n = idx & 63; t[k * 65 + n] = W[(size_t)(k0 + k) * N + n0 + n]; }
  __syncthreads();
#pragma unroll 4
  for (int i = 0; i < 16; ++i) {
    const int idx = tid0 + 256 * i, n = idx >> 6, k = idx & 63, j = n0 + n;
    const int rho = (mode == 0) ? j : ((j >> 6) * 128 + ((j >> 5) & 1) * 64 + (mode - 1) * 32 + (j & 31));
    Wt[(size_t)rho * K + k0 + k] = f2bf(t[k * 65 + n]);
  }
  __syncthreads();
}

DI void row_phase(const float* __restrict__ xin, float* __restrict__ xout, const bf16_t* addsrc, const float* __restrict__ gpost,
                  const float* __restrict__ gpre, bf16_t* hout, int lane_in) {
  const int lane = opaque(lane_in);
  f32x4 x[4];
#pragma unroll
  for (int i = 0; i < 4; ++i) x[i] = *(const f32x4*)(xin + i * 256 + lane * 4);
  if (addsrc) {
    f32x4 m[4]; float ss = 0.f;
#pragma unroll
    for (int i = 0; i < 4; ++i) { const u32x2 w = *(const u32x2*)(addsrc + i * 256 + lane * 4); m[i] = (f32x4){bflo(w.x), bfhi(w.x), bflo(w.y), bfhi(w.y)};
      ss += m[i][0] * m[i][0] + m[i][1] * m[i][1] + m[i][2] * m[i][2] + m[i][3] * m[i][3]; }
    ss = wave_sum(ss); const float rs = rsqrtf(ss * (1.0f / 1024.0f) + EPS);
#pragma unroll
    for (int i = 0; i < 4; ++i) { const f32x4 g = *(const f32x4*)(gpost + i * 256 + lane * 4); x[i] += m[i] * rs * g; }
  }
#pragma unroll
  for (int i = 0; i < 4; ++i) *(f32x4*)(xout + i * 256 + lane * 4) = x[i];
  if (gpre) {
    float ss = 0.f;
#pragma unroll
    for (int i = 0; i < 4; ++i) ss += x[i][0] * x[i][0] + x[i][1] * x[i][1] + x[i][2] * x[i][2] + x[i][3] * x[i][3];
    ss = wave_sum(ss); const float rs = rsqrtf(ss * (1.0f / 1024.0f) + EPS);
#pragma unroll
    for (int i = 0; i < 4; ++i) { const f32x4 g = *(const f32x4*)(gpre + i * 256 + lane * 4); const f32x4 hv = x[i] * rs * g;
      u32x2 w; w.x = pk(hv[0], hv[1]); w.y = pk(hv[2], hv[3]); *(u32x2*)(hout + i * 256 + lane * 4) = w; }
  }
}

struct ASrc { const bf16_t* b0; const bf16_t* b1; const bf16_t* b2; const bf16_t* b3; int s0, s1, s2, s3; int shift; };

struct EpiStore { bf16_t* out; int ldc; int nmax;
  DI void operator()(const f32x16 (&acc)[2][2], int mb, int nb, int n0, int wc, int l31, int h) const {
#pragma unroll
    for (int mf = 0; mf < 2; ++mf) { bf16_t* rp = out + (size_t)(mb + mf * 32 + l31) * ldc;
#pragma unroll
      for (int nf = 0; nf < 2; ++nf) { if (nb + nf * 32 < nmax) {
#pragma unroll
        for (int g = 0; g < 4; ++g) { u32x2 v; v.x = pk(acc[mf][nf][4 * g], acc[mf][nf][4 * g + 1]); v.y = pk(acc[mf][nf][4 * g + 2], acc[mf][nf][4 * g + 3]);
          *(u32x2*)(rp + nb + nf * 32 + 8 * g + 4 * h) = v; } } } }
  } };
struct EpiSwiGLU { bf16_t* out;
  DI void operator()(const f32x16 (&acc)[2][2], int mb, int nb, int n0, int wc, int l31, int h) const {
    const int hc = (n0 >> 7) * 64 + wc * 32;
#pragma unroll
    for (int mf = 0; mf < 2; ++mf) { bf16_t* rp = out + (size_t)(mb + mf * 32 + l31) * DFF + hc;
#pragma unroll
      for (int g = 0; g < 4; ++g) { float r[4];
#pragma unroll
        for (int e = 0; e < 4; ++e) { const float gt = acc[mf][0][4 * g + e], up = acc[mf][1][4 * g + e]; r[e] = gt / (1.0f + __expf(-gt)) * up; }
        u32x2 v; v.x = pk(r[0], r[1]); v.y = pk(r[2], r[3]); *(u32x2*)(rp + 8 * g + 4 * h) = v; } }
  } };

template <class Epi>
DI void gemm_tile(char* lds, const ASrc& A, const bf16_t* __restrict__ Bt, int K, int m0, int n0, const Epi& epi) {
  const int tid = opaque(threadIdx.x), lane = tid & 63, w = tid >> 6, wr = w >> 1, wc = w & 1, l31 = lane & 31, h = lane >> 5;
  const int nk = K >> 6, srow = tid >> 3, sc8 = tid & 7, smask = (1 << A.shift) - 1;
  u32x4 ra[4], rb[4];
  f32x16 acc[2][2];
#pragma unroll
  for (int a = 0; a < 2; ++a)
#pragma unroll
    for (int b = 0; b < 2; ++b)
#pragma unroll
      for (int i = 0; i < 16; ++i) acc[a][b][i] = 0.f;
#define GEMM_GLOAD(kt) do { const int k0_ = (kt) << 6, seg_ = k0_ >> A.shift, kk_ = k0_ & smask; \
    const bf16_t* bp_ = seg_ == 0 ? A.b0 : seg_ == 1 ? A.b1 : seg_ == 2 ? A.b2 : A.b3; const int st_ = seg_ == 0 ? A.s0 : seg_ == 1 ? A.s1 : seg_ == 2 ? A.s2 : A.s3; \
    const bf16_t* ab_ = bp_ + (size_t)(m0 + srow) * st_ + kk_ + sc8 * 8; const bf16_t* bb_ = Bt + (size_t)(n0 + srow) * K + k0_ + sc8 * 8; \
    _Pragma("unroll") for (int i_ = 0; i_ < 4; ++i_) { ra[i_] = *(const u32x4*)(ab_ + (size_t)(32 * i_) * st_); rb[i_] = *(const u32x4*)(bb_ + (size_t)(32 * i_) * K); } } while (0)
#define GEMM_LSTORE(buf) do { char* as_ = lds + (buf) * 36864; char* bs_ = as_ + 18432; \
    _Pragma("unroll") for (int i_ = 0; i_ < 4; ++i_) { *(u32x4*)(as_ + (srow + 32 * i_) * PITCH + sc8 * 16) = ra[i_]; *(u32x4*)(bs_ + (srow + 32 * i_) * PITCH + sc8 * 16) = rb[i_]; } } while (0)
  GEMM_GLOAD(0); GEMM_LSTORE(0); __syncthreads();
  for (int kt = 0; kt < nk; ++kt) {
    if (kt + 1 < nk) GEMM_GLOAD(kt + 1);
    const char* as = lds + (kt & 1) * 36864; const char* bs = as + 18432;
#pragma unroll
    for (int s = 0; s < 4; ++s) {
      bf16x8 af[2], wf[2];
#pragma unroll
      for (int mf = 0; mf < 2; ++mf) af[mf] = *(const bf16x8*)(as + (wr * 64 + mf * 32 + l31) * PITCH + s * 32 + h * 16);
#pragma unroll
      for (int nf = 0; nf < 2; ++nf) wf[nf] = *(const bf16x8*)(bs + (wc * 64 + nf * 32 + l31) * PITCH + s * 32 + h * 16);
#pragma unroll
      for (int mf = 0; mf < 2; ++mf)
#pragma unroll
        for (int nf = 0; nf < 2; ++nf) acc[mf][nf] = MFMA32(wf[nf], af[mf], acc[mf][nf]);
    }
    if (kt + 1 < nk) GEMM_LSTORE((kt + 1) & 1);
    __syncthreads();
  }
  epi(acc, m0 + wr * 64, n0 + wc * 64, n0, wc, l31, h);
#undef GEMM_GLOAD
#undef GEMM_LSTORE
}

template <class Epi>
DI void gemm_phase(char* lds, const ASrc& A, const bf16_t* Bt, int K, int ntn, const Epi& epi) {
  const int total = (MT / 128) * ntn, grp = 8 * ntn;
  for (int id = blockIdx.x; id < total; id += gridDim.x) {
    const int g = id / grp, wi = id - g * grp, mt = g * 8 + (wi & 7), nt = wi >> 3;
    gemm_tile(lds, A, Bt, K, mt * 128, nt * 128, epi);
  }
}

DI void prep_item(char* lds, const Params& p, int layer, int item) {
  const int tid = opaque(threadIdx.x), lane = tid & 63, w = tid >> 6;
  const int rowb = item * 64; int tb, T; row_info(rowb, tb, T);
  const float* qg = p.in[I_AQG] + layer * 64; const float* kg = p.in[I_AKG] + layer * 64;
  const float qgl = qg[lane], kgl = kg[lane];
  for (int tt = 0; tt < 16; ++tt) {
    const int row = rowb + w * 16 + tt, t = tb + w * 16 + tt;
    bf16_t* zr = p.z + (size_t)row * NIN;
    {
      const int j = lane & 31, i = j & 15; const bool first = j < 16; const int pos = (lane < 32) ? (t >> 6) : (t & 63);
      const f32x2 cs = p.tabA[pos * 16 + i];
#pragma unroll
      for (int hd = 0; hd < 6; ++hd) {
        bf16_t* ptr = zr + (hd < 4 ? A_Q + hd * 64 : A_K + (hd - 4) * 64) + lane;
        float v = bf2f(*ptr);
        const float ss = wave_sum(v * v);
        v = v * rsqrtf(ss * (1.0f / 64.0f) + EPS) * (hd < 4 ? qgl : kgl);
        const float o = __shfl_xor(v, 16);
        float r = first ? (v * cs.x - o * cs.y) : (v * cs.x + o * cs.y);
        if (hd < 4) r *= 0.125f * LOG2E;
        *ptr = f2bf(r);
      }
    }
    {
      const int d = lane & 31; const f32x2 cs = p.tabB[t * 4 + (d & 3)];
#pragma unroll
      for (int c = 0; c < 8; ++c) {
        bf16_t* ptr = zr + (c < 4 ? B_Q + c * 64 : B_K + (c - 4) * 64) + lane;
        float v = bf2f(*ptr);
        const float o = __shfl_xor(v, 4);
        float r = v;
        if (d < 8) r = (d < 4) ? (v * cs.x - o * cs.y) : (v * cs.x + o * cs.y);
        if (c < 4) r *= 0.17677669529663687f * LOG2E;
        *ptr = f2bf(r);
      }
    }
    {
      const f32x2 cs = p.tabC[t * 32 + (lane & 31)];
#pragma unroll
      for (int c = 0; c < 8; ++c) {
        bf16_t* ptr = zr + (c < 4 ? C_Q + c * 64 : C_K + (c - 4) * 64) + lane;
        const float v = bf2f(*ptr);
        const float o = __shfl_xor(v, 32);
        float r = (lane < 32) ? (v * cs.x - o * cs.y) : (v * cs.x + o * cs.y);
        if (c >= 4) r *= 0.125f;
        *ptr = f2bf(r);
      }
    }
  }
  bf16_t* tl = (bf16_t*)lds;
  const int r = tid >> 2, c0 = (tid & 3) * 16;
  for (int sl = 0; sl < 10; ++sl) {
    const int col = sl < 2 ? A_V + sl * 64 : sl < 6 ? B_V + (sl - 2) * 64 : C_V + (sl - 6) * 64;
    bf16_t* gp = p.z + (size_t)(rowb + r) * NIN + col + c0;
    const u32x4 v0 = *(const u32x4*)gp, v1 = *(const u32x4*)(gp + 8);
    __syncthreads();
#pragma unroll
    for (int e = 0; e < 4; ++e) {
      tl[(c0 + 2 * e) * 72 + r] = (bf16_t)(v0[e] & 0xffffu); tl[(c0 + 2 * e + 1) * 72 + r] = (bf16_t)(v0[e] >> 16);
      tl[(c0 + 8 + 2 * e) * 72 + r] = (bf16_t)(v1[e] & 0xffffu); tl[(c0 + 8 + 2 * e + 1) * 72 + r] = (bf16_t)(v1[e] >> 16);
    }
    __syncthreads();
    const u32x4 o0 = *(const u32x4*)(tl + r * 72 + c0), o1 = *(const u32x4*)(tl + r * 72 + c0 + 8);
    *(u32x4*)gp = o0; *(u32x4*)(gp + 8) = o1;
  }
  __syncthreads();
}

DI float dshift(const Params& p, const float* mup, const float* mun, int row, int t, int T, int dc) {
  const bf16_t* zp = p.z + (size_t)row * NIN + D_0 + dc;
  const float z = bf2f(*zp);
  const float zprev = (t > 0) ? bf2f(*(zp - NIN)) : 0.f;
  const float znext = (t < T - 1) ? bf2f(*(zp + NIN)) : 0.f;
  return z + mup[dc] * (zprev - z) + mun[dc] * (znext - z);
}
DI float sigmoidf_(float x) { return 1.0f / (1.0f + __expf(-x)); }
DI float omdecay(float ww) {
  const float y = -ww; const float sp = fmaxf(y, 0.f) + log1pf(__expf(-fabsf(y)));
  return -expm1f(-__expf(-sp - 0.5f));
}
DI void dprep_item(char* lds, const Params& p, int layer, int item) {
  const int tid = opaque(threadIdx.x);
  const int rowb = item * 8; int tb, T; row_info(rowb, tb, T);
  const float* mup = p.in[I_DMUP] + layer * 1088; const float* mun = p.in[I_DMUN] + layer * 1088;
  float* su = (float*)lds;
#pragma unroll
  for (int i = 0; i < 6; ++i) {
    const int idx = tid + 256 * i, tok = idx / 192, c = idx - tok * 192;
    float u = dshift(p, mup, mun, rowb + tok, tb + tok, T, 768 + c);
    if (c < 128) u = tanhf(u);
    su[idx] = u;
  }
  __syncthreads();
  const int c = tid;
  float accf[8], accb[8], acca[8];
#pragma unroll
  for (int k = 0; k < 8; ++k) { accf[k] = 0.f; accb[k] = 0.f; acca[k] = 0.f; }
  const float* wupf = p.in[I_DWUP] + (size_t)(layer * 2 + 0) * 64 * 256 + c;
  const float* wupb = p.in[I_DWUP] + (size_t)(layer * 2 + 1) * 64 * 256 + c;
  const float* aup = p.in[I_DAUP] + (size_t)layer * 64 * 256 + c;
#pragma unroll 4
  for (int j = 0; j < 64; ++j) {
    const float wf = wupf[j * 256], wb = wupb[j * 256], wa = aup[j * 256];
#pragma unroll
    for (int k = 0; k < 8; ++k) { accf[k] += su[k * 192 + j] * wf; accb[k] += su[k * 192 + 64 + j] * wb; acca[k] += su[k * 192 + 128 + j] * wa; }
  }
  const float w0f = p.in[I_DW0][(layer * 2 + 0) * 256 + c], w0b = p.in[I_DW0][(layer * 2 + 1) * 256 + c];
  const float a0 = p.in[I_DA0][layer * 256 + c], kkw = p.in[I_DKK][layer * 256 + c], kaw = p.in[I_DKA][layer * 256 + c];
#pragma unroll
  for (int k = 0; k < 8; ++k) {
    const int row = rowb + k, t = tb + k;
    const float r = dshift(p, mup, mun, row, t, T, c), kx = dshift(p, mup, mun, row, t, T, 256 + c), v = dshift(p, mup, mun, row, t, T, 512 + c);
    const float omf = omdecay(w0f + accf[k]), omb = omdecay(w0b + accb[k]);
    const float a = sigmoidf_(a0 + acca[k]);
    float kk = kx * kkw; const float n2 = wave_sum(kk * kk);
    kk = kk / fmaxf(sqrtf(n2), 1e-12f);
    const float kmod = kx * (1.0f + (a - 1.0f) * kaw), b = kk * a;
    const size_t o = (size_t)row * 256 + c;
    p.pl[o] = f2bf(r); p.pl[PLANE + o] = f2bf(kmod); p.pl[2 * PLANE + o] = f2bf(v); p.pl[3 * PLANE + o] = f2bf(-kk);
    p.pl[4 * PLANE + o] = f2bf(b); p.pl[5 * PLANE + o] = f2bf(omf); p.pl[6 * PLANE + o] = f2bf(omb);
  }
  __syncthreads();
}

DI void dpost_item(char* lds, const Params& p, int layer, int item) {
  const int tid = opaque(threadIdx.x);
  const int rowb = item * 8; int tb, T; row_info(rowb, tb, T);
  const float* mup = p.in[I_DMUP] + layer * 1088; const float* mun = p.in[I_DMUN] + layer * 1088;
  float* sg = (float*)lds;
#pragma unroll
  for (int i = 0; i < 4; ++i) { const int idx = tid + 256 * i, tok = idx >> 7, c = idx & 127; sg[idx] = sigmoidf_(dshift(p, mup, mun, rowb + tok, tb + tok, T, 960 + c)); }
  __syncthreads();
  const int c = tid;
  float acc[8];
#pragma unroll
  for (int k = 0; k < 8; ++k) acc[k] = 0.f;
  const float* gup = p.in[I_DGUP] + (size_t)layer * 128 * 256 + c;
#pragma unroll 4
  for (int j = 0; j < 128; ++j) { const float gw = gup[j * 256];
#pragma unroll
    for (int k = 0; k < 8; ++k) acc[k] += sg[k * 128 + j] * gw; }
  const float gnw = p.in[I_DGNW][layer * 256 + c], gnb = p.in[I_DGNB][layer * 256 + c], rk = p.in[I_DRK][layer * 256 + c];
#pragma unroll
  for (int k = 0; k < 8; ++k) {
    const int row = rowb + k;
    const bf16_t* zd = p.z + (size_t)row * NIN + D_0;
    const float y = bf2f(zd[c]) + bf2f(zd[256 + c]);
    const float mean = wave_sum(y) * (1.0f / 64.0f); const float d = y - mean; const float var = wave_sum(d * d) * (1.0f / 64.0f);
    const float yn = d * rsqrtf(var + 64e-5f) * gnw + gnb;
    const size_t o = (size_t)row * 256 + c;
    const float r = bf2f(p.pl[o]), km = bf2f(p.pl[PLANE + o]), v = bf2f(p.pl[2 * PLANE + o]);
    const float bonus = wave_sum(r * km * rk);
    p.pl[4 * PLANE + o] = f2bf((yn + bonus * v) * acc[k]);
  }
  __syncthreads();
}

DI void rwkv_item(char* lds, const Params& p, int seq, int head, int dir) {
  int row0, T; seq_info(seq, row0, T);
  const int tid = opaque(threadIdx.x), kc = tid & 7, rp = tid >> 3;
  float* st = (float*)lds;
  float S0[8], S1[8];
#pragma unroll
  for (int j = 0; j < 8; ++j) { S0[j] = 0.f; S1[j] = 0.f; }
  const int nchunk = T >> 4;
  u32x4 rg[3];
  const int tsel = tid >> 7, srem = tid & 127, sstep = srem >> 3, sc8 = srem & 7;
#define RW_GLOAD(c) do { _Pragma("unroll") for (int i_ = 0; i_ < 3; ++i_) { const int tens_ = tsel + 2 * i_; \
      const int plane_ = tens_ == 0 ? (dir ? 6 : 5) : tens_ == 1 ? 3 : tens_ == 2 ? 4 : tens_ == 3 ? 1 : tens_ == 4 ? 0 : 2; \
      const int t_ = dir ? (T - 1 - ((c) * 16 + sstep)) : ((c) * 16 + sstep); \
      rg[i_] = *(const u32x4*)(p.pl + (size_t)plane_ * PLANE + (size_t)(row0 + t_) * 256 + head * 64 + sc8 * 8); } } while (0)
#define RW_LSTORE(buf) do { _Pragma("unroll") for (int i_ = 0; i_ < 3; ++i_) { const int tens_ = tsel + 2 * i_; \
      f32x4 a_ = {bflo(rg[i_].x), bfhi(rg[i_].x), bflo(rg[i_].y), bfhi(rg[i_].y)}, b_ = {bflo(rg[i_].z), bfhi(rg[i_].z), bflo(rg[i_].w), bfhi(rg[i_].w)}; \
      if (tens_ == 0) { a_ = 1.0f - a_; b_ = 1.0f - b_; } \
      float* d_ = st + (((buf) * 16 + sstep) * 6 + tens_) * 64 + sc8 * 8; *(f32x4*)d_ = a_; *(f32x4*)(d_ + 4) = b_; } } while (0)
  RW_GLOAD(0); RW_LSTORE(0); __syncthreads();
  bf16_t* ybase = p.z + (size_t)row0 * NIN + D_0 + dir * 256 + head * 64 + rp * 2;
  for (int c = 0; c < nchunk; ++c) {
    if (c + 1 < nchunk) RW_GLOAD(c + 1);
    const float* sb = st + (c & 1) * (16 * 384);
#pragma unroll 4
    for (int s = 0; s < 16; ++s) {
      const float* q = sb + s * 384 + kc * 8;
      const f32x4 w0 = *(const f32x4*)(q), w1 = *(const f32x4*)(q + 4);
      const f32x4 n0 = *(const f32x4*)(q + 64), n1 = *(const f32x4*)(q + 68);
      const f32x4 b0 = *(const f32x4*)(q + 128), b1 = *(const f32x4*)(q + 132);
      const f32x4 k0 = *(const f32x4*)(q + 192), k1 = *(const f32x4*)(q + 196);
      const f32x4 r0 = *(const f32x4*)(q + 256), r1 = *(const f32x4*)(q + 260);
      const f32x2 vv = *(const f32x2*)(sb + s * 384 + 320 + rp * 2);
      float sa0 = 0.f, sa1 = 0.f;
#pragma unroll
      for (int j = 0; j < 4; ++j) { sa0 += S0[j] * n0[j]; sa1 += S1[j] * n0[j]; }
#pragma unroll
      for (int j = 0; j < 4; ++j) { sa0 += S0[4 + j] * n1[j]; sa1 += S1[4 + j] * n1[j]; }
      sa0 += __shfl_xor(sa0, 1); sa1 += __shfl_xor(sa1, 1);
      sa0 += __shfl_xor(sa0, 2); sa1 += __shfl_xor(sa1, 2);
      sa0 += __shfl_xor(sa0, 4); sa1 += __shfl_xor(sa1, 4);
      float y0 = 0.f, y1 = 0.f;
#pragma unroll
      for (int j = 0; j < 4; ++j) {
        S0[j] = S0[j] * w0[j] + (sa0 * b0[j] + vv.x * k0[j]); S1[j] = S1[j] * w0[j] + (sa1 * b0[j] + vv.y * k0[j]);
        y0 += S0[j] * r0[j]; y1 += S1[j] * r0[j];
      }
#pragma unroll
      for (int j = 0; j < 4; ++j) {
        S0[4 + j] = S0[4 + j] * w1[j] + (sa0 * b1[j] + vv.x * k1[j]); S1[4 + j] = S1[4 + j] * w1[j] + (sa1 * b1[j] + vv.y * k1[j]);
        y0 += S0[4 + j] * r1[j]; y1 += S1[4 + j] * r1[j];
      }
      y0 += __shfl_xor(y0, 1); y1 += __shfl_xor(y1, 1);
      y0 += __shfl_xor(y0, 2); y1 += __shfl_xor(y1, 2);
      y0 += __shfl_xor(y0, 4); y1 += __shfl_xor(y1, 4);
      if (kc == 0) { const int t = dir ? (T - 1 - (c * 16 + s)) : (c * 16 + s); *(unsigned*)(ybase + (size_t)t * NIN) = pk(y0, y1); }
    }
    if (c + 1 < nchunk) RW_LSTORE((c + 1) & 1);
    __syncthreads();
  }
#undef RW_GLOAD
#undef RW_LSTORE
}

template <int MODE>
DI void attn_item(char* lds, const Params& p, int layer, int seq, int head, int qt) {
  const int tid = opaque(threadIdx.x), lane = tid & 63, w = tid >> 6, l31 = lane & 31, h = lane >> 5;
  int row0, T; seq_info(seq, row0, T);
  const int QC = (MODE == 0 ? A_Q : MODE == 1 ? B_Q : C_Q) + head * 64;
  const int KC = MODE == 0 ? A_K + (head >> 1) * 64 : MODE == 1 ? B_K + head * 64 : C_K + head * 64;
  const int VC = MODE == 0 ? A_V + (head >> 1) * 64 : MODE == 1 ? B_V + head * 64 : C_V + head * 64;
  const int qw0 = qt * 128 + w * 32, qi = qw0 + l31;
  bf16_t* zq = p.z + (size_t)(row0 + qi) * NIN + QC;
  bf16x8 qf[4];
#pragma unroll
  for (int s = 0; s < 4; ++s) qf[s] = *(const bf16x8*)(zq + s * 16 + h * 8);
  const int srow = tid >> 3, sc8 = tid & 7;
  const bf16_t* kbase = p.z + (size_t)(row0 + srow) * NIN + KC + sc8 * 8;
  const bf16_t* vbase = p.z + (size_t)(row0 + srow) * NIN + VC + sc8 * 8;
  u32x4 rk[2], rv[2];
  const int nt = T >> 6;
  const int prow = (l31 & 19) | ((l31 & 4) << 1) | ((l31 & 8) >> 1);
#define AT_GLOAD(t) do { _Pragma("unroll") for (int i_ = 0; i_ < 2; ++i_) { const size_t off_ = (size_t)((t) * 64 + 32 * i_) * NIN; rk[i_] = *(const u32x4*)(kbase + off_); rv[i_] = *(const u32x4*)(vbase + off_); } } while (0)
#define AT_LSTORE(buf) do { char* ks_ = lds + (buf) * 18432; char* vs_ = ks_ + 9216; \
    _Pragma("unroll") for (int i_ = 0; i_ < 2; ++i_) { *(u32x4*)(ks_ + (srow + 32 * i_) * PITCH + sc8 * 16) = rk[i_]; *(u32x4*)(vs_ + (srow + 32 * i_) * PITCH + sc8 * 16) = rv[i_]; } } while (0)
  constexpr int NMAP = (MODE == 1) ? 2 : 1;
  f32x16 o[NMAP][2];
  float m_run[NMAP], l_run[NMAP];
#pragma unroll
  for (int a = 0; a < NMAP; ++a) { m_run[a] = -INFINITY; l_run[a] = 0.f;
#pragma unroll
    for (int b = 0; b < 2; ++b)
#pragma unroll
      for (int i = 0; i < 16; ++i) o[a][b][i] = 0.f; }
  float lf = 0.f, lb = 0.f;
  if (MODE == 2) { lf = log2f(1.0f - exp2f(-5.0f - (float)head)); lb = log2f(1.0f - exp2f(-5.0f - (float)(3 - head))); }
  AT_GLOAD(0); AT_LSTORE(0); __syncthreads();
  for (int t = 0; t < nt; ++t) {
    if (t + 1 < nt) AT_GLOAD(t + 1);
    const char* ks = lds + (t & 1) * 18432; const char* vs = ks + 9216;
#pragma unroll
    for (int mp = 0; mp < NMAP; ++mp) {
      f32x16 st[2];
#pragma unroll
      for (int kf = 0; kf < 2; ++kf) {
#pragma unroll
        for (int i = 0; i < 16; ++i) st[kf][i] = 0.f;
        if (MODE == 1) {
#pragma unroll
          for (int s = 0; s < 2; ++s) { const bf16x8 kfr = *(const bf16x8*)(ks + (kf * 32 + prow) * PITCH + (mp * 2 + s) * 32 + h * 16); st[kf] = MFMA32(kfr, qf[mp * 2 + s], st[kf]); }
        } else {
#pragma unroll
          for (int s = 0; s < 4; ++s) { const bf16x8 kfr = *(const bf16x8*)(ks + (kf * 32 + prow) * PITCH + s * 32 + h * 16); st[kf] = MFMA32(kfr, qf[s], st[kf]); }
        }
      }
      if (MODE == 2) {
        const int k0 = t * 64;
        const float dbase = (float)(qi - k0 - 8 * h);
        if (k0 + 63 < qw0) {
#pragma unroll
          for (int kf = 0; kf < 2; ++kf)
#pragma unroll
            for (int i = 0; i < 16; ++i) { const float cc = (float)(32 * kf + (i & 3) + 4 * ((i >> 2) & 1) + 16 * ((i >> 3) & 1)); st[kf][i] *= fexp2(lf * (dbase - cc)); }
        } else if (k0 > qw0 + 31) {
#pragma unroll
          for (int kf = 0; kf < 2; ++kf)
#pragma unroll
            for (int i = 0; i < 16; ++i) { const float cc = (float)(32 * kf + (i & 3) + 4 * ((i >> 2) & 1) + 16 * ((i >> 3) & 1)); st[kf][i] *= fexp2(lb * (cc - dbase)); }
        } else {
#pragma unroll
          for (int kf = 0; kf < 2; ++kf)
#pragma unroll
            for (int i = 0; i < 16; ++i) { const float cc = (float)(32 * kf + (i & 3) + 4 * ((i >> 2) & 1) + 16 * ((i >> 3) & 1)); const float d = dbase - cc;
              float dd = fexp2(fminf(lf * d, -lb * d)); if (d == 0.f) dd = 2.0f; st[kf][i] *= dd; }
        }
      } else {
        float mx = st[0][0];
#pragma unroll
        for (int kf = 0; kf < 2; ++kf)
#pragma unroll
          for (int i = 0; i < 16; ++i) mx = fmaxf(mx, st[kf][i]);
        mx = fmaxf(mx, __shfl_xor(mx, 32));
        const float mn = fmaxf(m_run[mp], mx); const float alpha = fexp2(m_run[mp] - mn); m_run[mp] = mn;
        float ps = 0.f;
#pragma unroll
        for (int kf = 0; kf < 2; ++kf)
#pragma unroll
          for (int i = 0; i < 16; ++i) { st[kf][i] = fexp2(st[kf][i] - mn); ps += st[kf][i]; }
        l_run[mp] = l_run[mp] * alpha + ps;
#pragma unroll
        for (int df = 0; df < 2; ++df) o[mp][df] *= alpha;
      }
      bf16x8 pf[4];
#pragma unroll
      for (int kf = 0; kf < 2; ++kf)
#pragma unroll
        for (int s2 = 0; s2 < 2; ++s2) { u32x4 u; u.x = pk(st[kf][8 * s2], st[kf][8 * s2 + 1]); u.y = pk(st[kf][8 * s2 + 2], st[kf][8 * s2 + 3]);
          u.z = pk(st[kf][8 * s2 + 4], st[kf][8 * s2 + 5]); u.w = pk(st[kf][8 * s2 + 6], st[kf][8 * s2 + 7]); pf[kf * 2 + s2] = __builtin_bit_cast(bf16x8, u); }
#pragma unroll
      for (int df = 0; df < 2; ++df)
#pragma unroll
        for (int ksx = 0; ksx < 4; ++ksx) { const bf16x8 vfr = *(const bf16x8*)(vs + (df * 32 + l31) * PITCH + ksx * 32 + h * 16); o[mp][df] = MFMA32(vfr, pf[ksx], o[mp][df]); }
    }
    if (t + 1 < nt) AT_LSTORE((t + 1) & 1);
    __syncthreads();
  }
#undef AT_GLOAD
#undef AT_LSTORE
  f32x16 r[2];
  if (MODE == 0) {
    const float l = l_run[0] + __shfl_xor(l_run[0], 32); const float inv = 1.0f / l;
#pragma unroll
    for (int df = 0; df < 2; ++df) r[df] = o[0][df] * inv;
  } else if (MODE == 1) {
    const float* lp = p.in[I_BLAM] + layer * 128;
    float s01 = 0.f, s23 = 0.f;
    for (int i = 0; i < 32; ++i) { s01 += lp[i] * lp[32 + i]; s23 += lp[64 + i] * lp[96 + i]; }
    const float lam_init = 0.8f - 0.6f * expf(-0.3f * (float)layer);
    const float lam = expf(s01) - expf(s23) + lam_init;
    const float l0 = l_run[0] + __shfl_xor(l_run[0], 32), l1 = l_run[NMAP - 1] + __shfl_xor(l_run[NMAP - 1], 32);
    const float i0 = 1.0f / l0, i1 = lam / l1;
    float ss = 0.f;
#pragma unroll
    for (int df = 0; df < 2; ++df) { r[df] = o[0][df] * i0 - o[NMAP - 1][df] * i1;
#pragma unroll
      for (int i = 0; i < 16; ++i) ss += r[df][i] * r[df][i]; }
    ss += __shfl_xor(ss, 32);
    const float rs = rsqrtf(ss * (1.0f / 64.0f) + EPS) * (1.0f - lam_init);
    const float* sg = p.in[I_BSUB] + layer * 64;
#pragma unroll
    for (int df = 0; df < 2; ++df)
#pragma unroll
      for (int i = 0; i < 16; ++i) r[df][i] *= rs * sg[df * 32 + (i & 3) + 8 * (i >> 2) + 4 * h];
  } else {
    float ss = 0.f;
#pragma unroll
    for (int df = 0; df < 2; ++df)
#pragma unroll
      for (int i = 0; i < 16; ++i) ss += o[0][df][i] * o[0][df][i];
    ss += __shfl_xor(ss, 32);
    const float rs = rsqrtf(ss * (1.0f / 64.0f) + EPS);
    const float* gg = p.in[I_CGN] + layer * 256 + head * 64;
    const bf16_t* zg = p.z + (size_t)(row0 + qi) * NIN + C_G + head * 64;
#pragma unroll
    for (int df = 0; df < 2; ++df)
#pragma unroll
      for (int g = 0; g < 4; ++g) { const u32x2 gw = *(const u32x2*)(zg + df * 32 + 8 * g + 4 * h);
        const float gv[4] = {bflo(gw.x), bfhi(gw.x), bflo(gw.y), bfhi(gw.y)};
#pragma unroll
        for (int e = 0; e < 4; ++e) { const float x = gv[e]; r[df][4 * g + e] = o[0][df][4 * g + e] * rs * gg[df * 32 + 8 * g + 4 * h + e] * (x / (1.0f + __expf(-x))); } }
  }
#pragma unroll
  for (int df = 0; df < 2; ++df)
#pragma unroll
    for (int g = 0; g < 4; ++g) { u32x2 v; v.x = pk(r[df][4 * g], r[df][4 * g + 1]); v.y = pk(r[df][4 * g + 2], r[df][4 * g + 3]); *(u32x2*)(zq + df * 32 + 8 * g + 4 * h) = v; }
}

DI int next_item(int* ctr, int* sh) {
  __syncthreads();
  if (threadIdx.x == 0) *sh = atomicAdd(ctr, 1);
  __syncthreads();
  return *sh;
}

__global__ void __launch_bounds__(256, 2) fwd(Params p) {
  extern __shared__ __attribute__((aligned(16))) char lds[];
  __shared__ int s_item;
  cg::grid_group grid = cg::this_grid();
  const int bid = blockIdx.x, nb = gridDim.x, tid = threadIdx.x, lane = tid & 63, w = tid >> 6;
  if (bid == 0 && tid < 64) p.ctr[tid] = 0;
  for (int i = bid * 256 + tid; i < 4096 * 32; i += nb * 256) { const int t = i >> 5, j = i & 31; const float inv = powf(10000.0f, -(float)(2 * j) / 64.0f); float sn, cs; sincosf((float)t * inv, &sn, &cs); p.tabC[i] = (f32x2){cs, sn}; }
  for (int i = bid * 256 + tid; i < 4096 * 4; i += nb * 256) { const int t = i >> 2, j = i & 3; const float inv = powf(500000.0f, -(float)(2 * j) / 8.0f); float sn, cs; sincosf((float)t * inv, &sn, &cs); p.tabB[i] = (f32x2){cs, sn}; }
  for (int i = bid * 256 + tid; i < 64 * 16; i += nb * 256) { const int t = i >> 4, j = i & 15; const float inv = powf(10000.0f, -(float)(2 * j) / 32.0f); float sn, cs; sincosf((float)t * inv, &sn, &cs); p.tabA[i] = (f32x2){cs, sn}; }
  for (int l = 0; l < 2; ++l) {
    for (int i = bid * 256 + tid; i < 64 * 1024; i += nb * 256) p.wtin[(size_t)l * NINP * 1024 + (size_t)NIN * 1024 + i] = 0;
    for (int tl = bid; tl < 16 * 53; tl += nb) conv_T(lds, p.in[I_WIN] + (size_t)l * 1024 * NIN, 1024, NIN, p.wtin + (size_t)l * NINP * 1024, 0, tl);
    for (int tl = bid; tl < 16 * 16; tl += nb) conv_T(lds, p.in[I_WOUT] + (size_t)l * 1024 * 1024, 1024, 1024, p.wtout + (size_t)l * 1024 * 1024, 0, tl);
  }
  bf16_t* hb = p.pl;
  for (int row = bid * 4 + w; row < MT; row += nb * 4) {
    const float* xin = row < M0 ? p.in[I_XP] + (size_t)row * 1024 : p.in[I_XS] + (size_t)(row - M0) * 1024;
    row_phase(xin, p.out + (size_t)row * 1024, nullptr, nullptr, p.in[I_NMPRE], hb + (size_t)row * 1024, lane);
  }
  grid.sync();
  for (int l = 0; l < 2; ++l) {
    { ASrc A; A.b0 = hb; A.b1 = hb; A.b2 = hb; A.b3 = hb; A.s0 = A.s1 = A.s2 = A.s3 = 1024; A.shift = 12;
      EpiStore e; e.out = p.z; e.ldc = NIN; e.nmax = NIN;
      gemm_phase(lds, A, p.wtin + (size_t)l * NINP * 1024, 1024, 27, e); }
    grid.sync();
    for (int it = bid; it < MT / 64 + MT / 8; it += nb) { if (it < MT / 64) prep_item(lds, p, l, it); else dprep_item(lds, p, l, it - MT / 64); }
    grid.sync();
    for (;;) {
      const int it = next_item(p.ctr + l * 16, &s_item);
      if (it >= 128 + 4608) break;
      if (it < 128) { const int sq = it < 64 ? (it >> 3) : 8 + ((it - 64) >> 3); rwkv_item(lds, p, sq, (it >> 1) & 3, it & 1); }
      else {
        int j = it - 128, mode, sq, hd, qt;
        if (j < 3072) { mode = j >> 10; const int rem = j & 1023; sq = rem >> 7; hd = (rem >> 5) & 3; qt = rem & 31; }
        else { j -= 3072; mode = j >> 9; const int rem = j & 511; sq = 8 + (rem >> 6); hd = (rem >> 4) & 3; qt = rem & 15; }
        if (mode == 0) attn_item<1>(lds, p, l, sq, hd, qt); else if (mode == 1) attn_item<2>(lds, p, l, sq, hd, qt); else attn_item<0>(lds, p, l, sq, hd, qt);
      }
    }
    grid.sync();
    bf16_t* wtgu = p.pl + 5 * PLANE; bf16_t* wtd = wtgu + (size_t)2 * DFF * 1024;
    for (int it = bid; it < MT / 8 + 3 * 704; it += nb) {
      if (it < MT / 8) dpost_item(lds, p, l, it);
      else { const int j = it - MT / 8;
        if (j < 704) conv_T(lds, p.in[I_FG] + (size_t)l * 1024 * DFF, 1024, DFF, wtgu, 1, j);
        else if (j < 1408) conv_T(lds, p.in[I_FU] + (size_t)l * 1024 * DFF, 1024, DFF, wtgu, 2, j - 704);
        else conv_T(lds, p.in[I_FD] + (size_t)l * DFF * 1024, DFF, 1024, wtd, 0, j - 1408); }
    }
    grid.sync();
    { ASrc A; A.b0 = p.z + A_Q; A.b1 = p.z + B_Q; A.b2 = p.z + C_Q; A.b3 = p.pl + 4 * PLANE; A.s0 = A.s1 = A.s2 = NIN; A.s3 = 256; A.shift = 8;
      EpiStore e; e.out = hb; e.ldc = 1024; e.nmax = 1024;
      gemm_phase(lds, A, p.wtout + (size_t)l * 1024 * 1024, 1024, 8, e); }
    grid.sync();
    for (int row = bid * 4 + w; row < MT; row += nb * 4)
      row_phase(p.out + (size_t)row * 1024, p.out + (size_t)row * 1024, hb + (size_t)row * 1024, p.in[I_NMPOST] + l * 1024, p.in[I_NFPRE] + l * 1024, hb + (size_t)row * 1024, lane);
    grid.sync();
    { ASrc A; A.b0 = hb; A.b1 = hb; A.b2 = hb; A.b3 = hb; A.s0 = A.s1 = A.s2 = A.s3 = 1024; A.shift = 12;
      EpiSwiGLU e; e.out = p.z;
      gemm_phase(lds, A, wtgu, 1024, 44, e); }
    grid.sync();
    { ASrc A; A.b0 = p.z; A.b1 = p.z; A.b2 = p.z; A.b3 = p.z; A.s0 = A.s1 = A.s2 = A.s3 = DFF; A.shift = 12;
      EpiStore e; e.out = hb; e.ldc = 1024; e.nmax = 1024;
      gemm_phase(lds, A, wtd, DFF, 8, e); }
    grid.sync();
    for (int row = bid * 4 + w; row < MT; row += nb * 4)
      row_phase(p.out + (size_t)row * 1024, p.out + (size_t)row * 1024, hb + (size_t)row * 1024, p.in[I_NFPOST] + l * 1024, l == 0 ? p.in[I_NMPRE] + 1024 : nullptr, hb + (size_t)row * 1024, lane);
    if (l == 0) grid.sync();
  }
}

extern "C" void kernel_launch(void* const* d_in, const int* in_sizes, int n_in, void* d_out, int out_size,
                              void* d_ws, size_t ws_size, hipStream_t stream) {
  static int grid_blocks = 0;
  if (!grid_blocks) {
    int dev = 0, cus = 0, per_cu = 0;
    hipGetDevice(&dev);
    hipDeviceGetAttribute(&cus, hipDeviceAttributeMultiprocessorCount, dev);
    hipFuncSetAttribute((const void*)fwd, hipFuncAttributeMaxDynamicSharedMemorySize, LDS_BYTES);
    hipOccupancyMaxActiveBlocksPerMultiprocessor(&per_cu, fwd, 256, LDS_BYTES);
    if (per_cu > 2) per_cu = 2;
    if (per_cu < 1) per_cu = 1;
    grid_blocks = cus * per_cu;
  }
  Params p{};
  for (int i = 0; i < 28; ++i) p.in[i] = (const float*)d_in[i];
  p.out = (float*)d_out;
  char* ws = (char*)d_ws;
  size_t off = 0;
  p.z = (bf16_t*)(ws + off); off += (size_t)MT * NIN * 2;
  p.pl = (bf16_t*)(ws + off); off += 7 * PLANE * 2;
  p.wtin = (bf16_t*)(ws + off); off += (size_t)2 * NINP * 1024 * 2;
  p.wtout = (bf16_t*)(ws + off); off += (size_t)2 * 1024 * 1024 * 2;
  p.tabC = (f32x2*)(ws + off); off += (size_t)4096 * 32 * 8;
  p.tabB = (f32x2*)(ws + off); off += (size_t)4096 * 4 * 8;
  p.tabA = (f32x2*)(ws + off); off += (size_t)64 * 16 * 8;
  p.ctr = (int*)(ws + off); off += 256;
  if (off > ws_size) fprintf(stderr, "workspace too small: need %zu have %zu\n", off, ws_size);
  void* args[] = {&p};
  hipError_t e = hipLaunchCooperativeKernel((void*)fwd, dim3(grid_blocks), dim3(256), args, LDS_BYTES, stream);
  if (e != hipSuccess) fprintf(stderr, "coop launch failed: %s (grid %d)\n", hipGetErrorString(e), grid_blocks);
}
```

```cpp
#include <hip/hip_runtime.h>
#include <hip/hip_cooperative_groups.h>
#include <cstdio>
#include <cstdint>
namespace cg = cooperative_groups;

#define DI __device__ __forceinline__
typedef unsigned short bf16_t;
typedef short bf16x8 __attribute__((ext_vector_type(8)));
typedef float f32x2 __attribute__((ext_vector_type(2)));
typedef float f32x4 __attribute__((ext_vector_type(4)));
typedef float f32x16 __attribute__((ext_vector_type(16)));
typedef unsigned u32x2 __attribute__((ext_vector_type(2)));
typedef unsigned u32x4 __attribute__((ext_vector_type(4)));
typedef __bf16 bf16x2_t __attribute__((ext_vector_type(2)));

constexpr int M0 = 32768, MT = 49152, DM = 1024, NIN = 3392, NINP = 3456, DFF = 2816;
constexpr int A_Q = 0, A_K = 256, A_V = 384, B_Q = 512, B_K = 768, B_V = 1024, C_Q = 1280, C_K = 1536, C_V = 1792, C_G = 2048, D_0 = 2304;
constexpr int PITCH = 144;
constexpr size_t PLANE = (size_t)MT * 256;
constexpr int LDS_BYTES = 73728;
constexpr float LOG2E = 1.4426950408889634f;
constexpr float EPS = 1e-6f;

enum { I_XP = 0, I_XS, I_NMPRE, I_NMPOST, I_NFPRE, I_NFPOST, I_WIN, I_WOUT, I_AQG, I_AKG, I_BLAM, I_BSUB, I_CGN, I_DMUP, I_DMUN, I_DW0, I_DWUP,
       I_DA0, I_DAUP, I_DGUP, I_DKK, I_DKA, I_DRK, I_DGNW, I_DGNB, I_FG, I_FU, I_FD };

struct Params {
  const float* in[28];
  float* out;
  bf16_t* z;
  bf16_t* pl;
  bf16_t* wtin;
  bf16_t* wtout;
  f32x2* tabC;
  f32x2* tabB;
  f32x2* tabA;
  int* ctr;
};

DI int opaque(int x) { asm volatile("" : "+v"(x)); return x; }
DI int opaque_s(int x) { asm volatile("" : "+s"(x)); return x; }
DI float bf2f(bf16_t v) { return __uint_as_float(((unsigned)v) << 16); }
DI float bflo(unsigned w) { return __uint_as_float(w << 16); }
DI float bfhi(unsigned w) { return __uint_as_float(w & 0xffff0000u); }
DI unsigned pk(float lo, float hi) { f32x2 v = {lo, hi}; bf16x2_t b = __builtin_convertvector(v, bf16x2_t); return __builtin_bit_cast(unsigned, b); }
DI bf16_t f2bf(float x) { return (bf16_t)(pk(x, 0.f) & 0xffffu); }
DI float dppf(float x, const int ctrl) { return x; }
#define DPPF(x, ctrl) __int_as_float(__builtin_amdgcn_update_dpp(0, __float_as_int(x), (ctrl), 0xF, 0xF, true))
DI float wave_sum(float v) {
  v += DPPF(v, 0xB1);
  v += DPPF(v, 0x4E);
  v += DPPF(v, 0x141);
  v += DPPF(v, 0x140);
  const int vi = __float_as_int(v);
  return (__int_as_float(__builtin_amdgcn_readlane(vi, 0)) + __int_as_float(__builtin_amdgcn_readlane(vi, 16))) +
         (__int_as_float(__builtin_amdgcn_readlane(vi, 32)) + __int_as_float(__builtin_amdgcn_readlane(vi, 48)));
}
DI float dpp_xor1(float x) { return __int_as_float(__builtin_amdgcn_update_dpp(0, __float_as_int(x), 0xB1, 0xF, 0xF, true)); }
DI float dpp_xor2(float x) { return __int_as_float(__builtin_amdgcn_update_dpp(0, __float_as_int(x), 0x4E, 0xF, 0xF, true)); }
DI float dpp_hmir(float x) { return __int_as_float(__builtin_amdgcn_update_dpp(0, __float_as_int(x), 0x141, 0xF, 0xF, true)); }
DI float red8(float x) { x += dpp_xor1(x); x += dpp_xor2(x); x += dpp_hmir(x); return x; }
DI float fexp2(float x) { return __builtin_amdgcn_exp2f(x); }
DI void seq_info(int s, int& row0, int& T) { if (s < 8) { row0 = s * 4096; T = 4096; } else { row0 = M0 + (s - 8) * 2048; T = 2048; } }
DI void row_info(int r, int& t, int& T) { if (r < M0) { t = r & 4095; T = 4096; } else { t = (r - M0) & 2047; T = 2048; } }
#define MFMA32(a, b, c) __builtin_amdgcn_mfma_f32_32x32x16_bf16((a), (b), (c), 0, 0, 0)

DI void conv_T(char* lds, const float* __restrict__ W, int K, int N, bf16_t* __restrict__ Wt, int mode, int tile) {
  float* t = (float*)lds;
  const int tid0 = opaque(threadIdx.x);
  const int ntn = N >> 6, kt = tile / ntn, nt = tile - kt * ntn, k0 = kt << 6, n0 = nt << 6;
#pragma unroll 4
  for (int i = 0; i < 16; ++i) { const int idx = tid0 + 256 * i, k = idx >> 6, n = idx & 63; t[k * 65 + n] = W[(size_t)(k0 + k) * N + n0 + n]; }
  __syncthreads();
#pragma unroll 4
  for (int i = 0; i < 16; ++i) {
    const int idx = tid0 + 256 * i, n = idx >> 6, k = idx & 63, j = n0 + n;
    const int rho = (mode == 0) ? j : ((j >> 6) * 128 + ((j >> 5) & 1) * 64 + (mode - 1) * 32 + (j & 31));
    Wt[(size_t)rho * K + k0 + k] = f2bf(t[k * 65 + n]);
  }
  __syncthreads();
}

DI void row_phase(const float* __restrict__ xin, float* __restrict__ xout, const bf16_t* addsrc, const float* __restrict__ gpost,
                  const float* __restrict__ gpre, bf16_t* hout, int lane_in) {
  const int lane = opaque(lane_in);
  f32x4 x[4];
#pragma unroll
  for (int i = 0; i < 4; ++i) x[i] = *(const f32x4*)(xin + i * 256 + lane * 4);
  if (addsrc) {
    f32x4 m[4]; float ss = 0.f;
#pragma unroll
    for (int i = 0; i < 4; ++i) { const u32x2 w = *(const u32x2*)(addsrc + i * 256 + lane * 4); m[i] = (f32x4){bflo(w.x), bfhi(w.x), bflo(w.y), bfhi(w.y)};
      ss += m[i][0] * m[i][0] + m[i][1] * m[i][1] + m[i][2] * m[i][2] + m[i][3] * m[i][3]; }
    ss = wave_sum(ss); const float rs = rsqrtf(ss * (1.0f / 1024.0f) + EPS);
#pragma unroll
    for (int i = 0; i < 4; ++i) { const f32x4 g = *(const f32x4*)(gpost + i * 256 + lane * 4); x[i] += m[i] * rs * g; }
  }
#pragma unroll
  for (int i = 0; i < 4; ++i) *(f32x4*)(xout + i * 256 + lane * 4) = x[i];
  if (gpre) {
    float ss = 0.f;
#pragma unroll
    for (int i = 0; i < 4; ++i) ss += x[i][0] * x[i][0] + x[i][1] * x[i][1] + x[i][2] * x[i][2] + x[i][3] * x[i][3];
    ss = wave_sum(ss); const float rs = rsqrtf(ss * (1.0f / 1024.0f) + EPS);
#pragma unroll
    for (int i = 0; i < 4; ++i) { const f32x4 g = *(const f32x4*)(gpre + i * 256 + lane * 4); const f32x4 hv = x[i] * rs * g;
      u32x2 w; w.x = pk(hv[0], hv[1]); w.y = pk(hv[2], hv[3]); *(u32x2*)(hout + i * 256 + lane * 4) = w; }
  }
}

struct ASrc { const bf16_t* b0; const bf16_t* b1; const bf16_t* b2; const bf16_t* b3; int s0, s1, s2, s3; int shift; };

struct EpiStore { bf16_t* out; int ldc; int nmax;
  DI void operator()(const f32x16 (&acc)[2][2], int mb, int nb, int n0, int wc, int l31, int h) const {
#pragma unroll
    for (int mf = 0; mf < 2; ++mf) { bf16_t* rp = out + (size_t)(mb + mf * 32 + l31) * ldc;
#pragma unroll
      for (int nf = 0; nf < 2; ++nf) { if (nb + nf * 32 < nmax) {
#pragma unroll
        for (int g = 0; g < 4; ++g) { u32x2 v; v.x = pk(acc[mf][nf][4 * g], acc[mf][nf][4 * g + 1]); v.y = pk(acc[mf][nf][4 * g + 2], acc[mf][nf][4 * g + 3]);
          *(u32x2*)(rp + nb + nf * 32 + 8 * g + 4 * h) = v; } } } }
  } };
struct EpiSwiGLU { bf16_t* out;
  DI void operator()(const f32x16 (&acc)[2][2], int mb, int nb, int n0, int wc, int l31, int h) const {
    const int hc = (n0 >> 7) * 64 + wc * 32;
#pragma unroll
    for (int mf = 0; mf < 2; ++mf) { bf16_t* rp = out + (size_t)(mb + mf * 32 + l31) * DFF + hc;
#pragma unroll
      for (int g = 0; g < 4; ++g) { float r[4];
#pragma unroll
        for (int e = 0; e < 4; ++e) { const float gt = acc[mf][0][4 * g + e], up = acc[mf][1][4 * g + e]; r[e] = gt / (1.0f + __expf(-gt)) * up; }
        u32x2 v; v.x = pk(r[0], r[1]); v.y = pk(r[2], r[3]); *(u32x2*)(rp + 8 * g + 4 * h) = v; } }
  } };

struct EpiIn { bf16_t* z; const float* qg; const float* kg; const f32x2* tabA; const f32x2* tabB; const f32x2* tabC;
  DI void operator()(f32x16 (&acc)[2][2], int mb, int nb, int n0, int wc, int l31, int h) const {
    if (nb >= NIN) return;
    const bool isv = (nb >= A_V && nb < B_Q) || (nb >= B_V && nb < C_Q) || (nb >= C_V && nb < C_G);
    if (isv) {
#pragma unroll
      for (int mf = 0; mf < 2; ++mf)
#pragma unroll
        for (int nf = 0; nf < 2; ++nf)
#pragma unroll
          for (int i = 0; i < 16; ++i) { const int d = nf * 32 + (i & 3) + 8 * (i >> 2) + 4 * h; z[(size_t)(mb + d) * NIN + nb + mf * 32 + l31] = f2bf(acc[mf][nf][i]); }
      return;
    }
#pragma unroll
    for (int mf = 0; mf < 2; ++mf) {
      const int row = mb + mf * 32 + l31; int t, T; row_info(row, t, T);
      if (nb < A_V) {
        const bool isq = nb < A_K; const float* gn = isq ? qg : kg;
        float ss = 0.f;
#pragma unroll
        for (int nf = 0; nf < 2; ++nf)
#pragma unroll
          for (int i = 0; i < 16; ++i) ss += acc[mf][nf][i] * acc[mf][nf][i];
        ss += __shfl_xor(ss, 32);
        const float rs = rsqrtf(ss * (1.0f / 64.0f) + EPS) * (isq ? 0.125f * LOG2E : 1.0f);
#pragma unroll
        for (int nf = 0; nf < 2; ++nf) {
          const int pos = nf == 0 ? (t >> 6) : (t & 63);
#pragma unroll
          for (int g = 0; g < 4; ++g)
#pragma unroll
            for (int e = 0; e < 4; ++e) acc[mf][nf][4 * g + e] *= rs * gn[nf * 32 + 8 * g + 4 * h + e];
#pragma unroll
          for (int g = 0; g < 2; ++g)
#pragma unroll
            for (int e = 0; e < 4; ++e) { const f32x2 cs = tabA[pos * 16 + 8 * g + 4 * h + e];
              const float x1 = acc[mf][nf][4 * g + e], x2 = acc[mf][nf][4 * (g + 2) + e];
              acc[mf][nf][4 * g + e] = x1 * cs.x - x2 * cs.y; acc[mf][nf][4 * (g + 2) + e] = x2 * cs.x + x1 * cs.y; }
        }
      } else if (nb >= B_Q && nb < B_V) {
        const bool isq = nb < B_K;
#pragma unroll
        for (int nf = 0; nf < 2; ++nf) {
#pragma unroll
          for (int e = 0; e < 4; ++e) { const f32x2 cs = tabB[t * 4 + e]; const float v = acc[mf][nf][e]; const float o = __shfl_xor(v, 32);
            acc[mf][nf][e] = (h == 0) ? (v * cs.x - o * cs.y) : (v * cs.x + o * cs.y); }
          if (isq) {
#pragma unroll
            for (int i = 0; i < 16; ++i) acc[mf][nf][i] *= 0.17677669529663687f * LOG2E; }
        }
      } else if (nb >= C_Q && nb < C_V) {
        const float sc = nb < C_K ? 1.0f : 0.125f;
#pragma unroll
        for (int g = 0; g < 4; ++g)
#pragma unroll
          for (int e = 0; e < 4; ++e) { const f32x2 cs = tabC[t * 32 + 8 * g + 4 * h + e]; const float x1 = acc[mf][0][4 * g + e], x2 = acc[mf][1][4 * g + e];
            acc[mf][0][4 * g + e] = (x1 * cs.x - x2 * cs.y) * sc; acc[mf][1][4 * g + e] = (x2 * cs.x + x1 * cs.y) * sc; }
      }
      bf16_t* rp = z + (size_t)row * NIN + nb;
#pragma unroll
      for (int nf = 0; nf < 2; ++nf)
#pragma unroll
        for (int g = 0; g < 4; ++g) { u32x2 v; v.x = pk(acc[mf][nf][4 * g], acc[mf][nf][4 * g + 1]); v.y = pk(acc[mf][nf][4 * g + 2], acc[mf][nf][4 * g + 3]);
          *(u32x2*)(rp + nf * 32 + 8 * g + 4 * h) = v; }
    }
  } };

template <class Epi>
DI void gemm_tile(char* lds, const ASrc& A, const bf16_t* __restrict__ Bt, int K, int m0, int n0, const Epi& epi) {
  const int tid = opaque(threadIdx.x), lane = tid & 63, w = tid >> 6, wr = w >> 1, wc = w & 1, l31 = lane & 31, h = lane >> 5;
  const int nk = K >> 6, srow = tid >> 3, sc8 = tid & 7, smask = (1 << A.shift) - 1;
  u32x4 ra0[4], rb0[4];
  f32x16 acc[2][2];
#pragma unroll
  for (int a = 0; a < 2; ++a)
#pragma unroll
    for (int b = 0; b < 2; ++b)
#pragma unroll
      for (int i = 0; i < 16; ++i) acc[a][b][i] = 0.f;
#define GEMM_GLOAD(kt, RA, RB) do { const int k0_ = (kt) << 6, seg_ = k0_ >> A.shift, kk_ = k0_ & smask; \
    const bf16_t* bp_ = seg_ == 0 ? A.b0 : seg_ == 1 ? A.b1 : seg_ == 2 ? A.b2 : A.b3; const int st_ = seg_ == 0 ? A.s0 : seg_ == 1 ? A.s1 : seg_ == 2 ? A.s2 : A.s3; \
    const bf16_t* ab_ = bp_ + (size_t)(m0 + srow) * st_ + kk_ + sc8 * 8; const bf16_t* bb_ = Bt + (size_t)(n0 + srow) * K + k0_ + sc8 * 8; \
    _Pragma("unroll") for (int i_ = 0; i_ < 4; ++i_) { RA[i_] = *(const u32x4*)(ab_ + (size_t)(32 * i_) * st_); RB[i_] = *(const u32x4*)(bb_ + (size_t)(32 * i_) * K); } } while (0)
#define GEMM_LSTORE(buf, RA, RB) do { char* as_ = lds + (buf) * 36864; char* bs_ = as_ + 18432; \
    _Pragma("unroll") for (int i_ = 0; i_ < 4; ++i_) { *(u32x4*)(as_ + (srow + 32 * i_) * PITCH + sc8 * 16) = RA[i_]; *(u32x4*)(bs_ + (srow + 32 * i_) * PITCH + sc8 * 16) = RB[i_]; } } while (0)
#define GEMM_COMPUTE(buf) do { const char* as = lds + (buf) * 36864; const char* bs = as + 18432; \
    _Pragma("unroll") for (int s = 0; s < 4; ++s) { bf16x8 af[2], wf[2]; \
      _Pragma("unroll") for (int mf = 0; mf < 2; ++mf) af[mf] = *(const bf16x8*)(as + (wr * 64 + mf * 32 + l31) * PITCH + s * 32 + h * 16); \
      _Pragma("unroll") for (int nf = 0; nf < 2; ++nf) wf[nf] = *(const bf16x8*)(bs + (wc * 64 + nf * 32 + l31) * PITCH + s * 32 + h * 16); \
      _Pragma("unroll") for (int mf = 0; mf < 2; ++mf) _Pragma("unroll") for (int nf = 0; nf < 2; ++nf) acc[mf][nf] = MFMA32(wf[nf], af[mf], acc[mf][nf]); } } while (0)
  GEMM_GLOAD(0, ra0, rb0); GEMM_LSTORE(0, ra0, rb0); __syncthreads();
  for (int kt = 0; kt < nk; kt += 2) {
    GEMM_GLOAD(kt + 1, ra0, rb0);
    GEMM_COMPUTE(0);
    GEMM_LSTORE(1, ra0, rb0);
    __syncthreads();
    if (kt + 2 < nk) GEMM_GLOAD(kt + 2, ra0, rb0);
    GEMM_COMPUTE(1);
    if (kt + 2 < nk) GEMM_LSTORE(0, ra0, rb0);
    __syncthreads();
  }
  epi(acc, m0 + wr * 64, n0 + wc * 64, n0, wc, l31, h);
#undef GEMM_GLOAD
#undef GEMM_LSTORE
#undef GEMM_COMPUTE
}

template <class Epi>
DI void gemm_phase(char* lds, const ASrc& A, const bf16_t* Bt, int K, int ntn, const Epi& epi) {
  const int xcd = blockIdx.x & 7, j = blockIdx.x >> 3, nloc = gridDim.x >> 3, per = 48 * ntn, grp = 8 * ntn;
  for (int li = j; li < per; li += nloc) {
    const int sg = li / grp, wi = li - sg * grp, nt = wi >> 3, mt = xcd * 48 + sg * 8 + (wi & 7);
    gemm_tile(lds, A, Bt, K, mt * 128, nt * 128, epi);
  }
}

DI void prep_item(char* lds, const Params& p, int layer, int item) {
  const int tid = opaque(threadIdx.x), lane = tid & 63, w = tid >> 6;
  const int rowb = item * 64; int tb, T; row_info(rowb, tb, T);
  const float* qg = p.in[I_AQG] + layer * 64; const float* kg = p.in[I_AKG] + layer * 64;
  const float qgl = qg[lane], kgl = kg[lane];
  for (int tt = 0; tt < 16; ++tt) {
    const int row = rowb + w * 16 + tt, t = tb + w * 16 + tt;
    bf16_t* zr = p.z + (size_t)row * NIN;
    {
      const int j = lane & 31, i = j & 15; const bool first = j < 16; const int pos = (lane < 32) ? (t >> 6) : (t & 63);
      const f32x2 cs = p.tabA[pos * 16 + i];
#pragma unroll
      for (int hd = 0; hd < 6; ++hd) {
        bf16_t* ptr = zr + (hd < 4 ? A_Q + hd * 64 : A_K + (hd - 4) * 64) + lane;
        float v = bf2f(*ptr);
        const float ss = wave_sum(v * v);
        v = v * rsqrtf(ss * (1.0f / 64.0f) + EPS) * (hd < 4 ? qgl : kgl);
        const float o = __shfl_xor(v, 16);
        float r = first ? (v * cs.x - o * cs.y) : (v * cs.x + o * cs.y);
        if (hd < 4) r *= 0.125f * LOG2E;
        *ptr = f2bf(r);
      }
    }
    {
      const int d = lane & 31; const f32x2 cs = p.tabB[t * 4 + (d & 3)];
#pragma unroll
      for (int c = 0; c < 8; ++c) {
        bf16_t* ptr = zr + (c < 4 ? B_Q + c * 64 : B_K + (c - 4) * 64) + lane;
        float v = bf2f(*ptr);
        const float o = __shfl_xor(v, 4);
        float r = v;
        if (d < 8) r = (d < 4) ? (v * cs.x - o * cs.y) : (v * cs.x + o * cs.y);
        if (c < 4) r *= 0.17677669529663687f * LOG2E;
        *ptr = f2bf(r);
      }
    }
    {
      const f32x2 cs = p.tabC[t * 32 + (lane & 31)];
#pragma unroll
      for (int c = 0; c < 8; ++c) {
        bf16_t* ptr = zr + (c < 4 ? C_Q + c * 64 : C_K + (c - 4) * 64) + lane;
        const float v = bf2f(*ptr);
        const float o = __shfl_xor(v, 32);
        float r = (lane < 32) ? (v * cs.x - o * cs.y) : (v * cs.x + o * cs.y);
        if (c >= 4) r *= 0.125f;
        *ptr = f2bf(r);
      }
    }
  }
  bf16_t* tl = (bf16_t*)lds;
  const int r = tid >> 2, c0 = (tid & 3) * 16;
  for (int sl = 0; sl < 10; ++sl) {
    const int col = sl < 2 ? A_V + sl * 64 : sl < 6 ? B_V + (sl - 2) * 64 : C_V + (sl - 6) * 64;
    bf16_t* gp = p.z + (size_t)(rowb + r) * NIN + col + c0;
    const u32x4 v0 = *(const u32x4*)gp, v1 = *(const u32x4*)(gp + 8);
    __syncthreads();
#pragma unroll
    for (int e = 0; e < 4; ++e) {
      tl[(c0 + 2 * e) * 72 + r] = (bf16_t)(v0[e] & 0xffffu); tl[(c0 + 2 * e + 1) * 72 + r] = (bf16_t)(v0[e] >> 16);
      tl[(c0 + 8 + 2 * e) * 72 + r] = (bf16_t)(v1[e] & 0xffffu); tl[(c0 + 8 + 2 * e + 1) * 72 + r] = (bf16_t)(v1[e] >> 16);
    }
    __syncthreads();
    const u32x4 o0 = *(const u32x4*)(tl + r * 72 + c0), o1 = *(const u32x4*)(tl + r * 72 + c0 + 8);
    *(u32x4*)gp = o0; *(u32x4*)(gp + 8) = o1;
  }
  __syncthreads();
}

DI float dshift(const Params& p, const float* mup, const float* mun, int row, int t, int T, int dc) {
  const bf16_t* zp = p.z + (size_t)row * NIN + D_0 + dc;
  const float z = bf2f(*zp);
  const float zprev = (t > 0) ? bf2f(*(zp - NIN)) : 0.f;
  const float znext = (t < T - 1) ? bf2f(*(zp + NIN)) : 0.f;
  return z + mup[dc] * (zprev - z) + mun[dc] * (znext - z);
}
DI float sigmoidf_(float x) { return 1.0f / (1.0f + __expf(-x)); }
DI float omdecay(float ww) {
  const float y = -ww; const float sp = fmaxf(y, 0.f) + log1pf(__expf(-fabsf(y)));
  return -expm1f(-__expf(-sp - 0.5f));
}
DI void dprep_item(char* lds, const Params& p, int layer, int item) {
  const int tid = opaque(threadIdx.x);
  const int rowb = item * 8; int tb, T; row_info(rowb, tb, T);
  const float* mup = p.in[I_DMUP] + layer * 1088; const float* mun = p.in[I_DMUN] + layer * 1088;
  float* su = (float*)lds;
#pragma unroll
  for (int i = 0; i < 6; ++i) {
    const int idx = tid + 256 * i, tok = idx / 192, c = idx - tok * 192;
    float u = dshift(p, mup, mun, rowb + tok, tb + tok, T, 768 + c);
    if (c < 128) u = tanhf(u);
    su[c * 8 + tok] = u;
  }
  __syncthreads();
  const int c = tid;
  float accf[8], accb[8], acca[8];
#pragma unroll
  for (int k = 0; k < 8; ++k) { accf[k] = 0.f; accb[k] = 0.f; acca[k] = 0.f; }
  const float* wupf = p.in[I_DWUP] + (size_t)(layer * 2 + 0) * 64 * 256 + c;
  const float* wupb = p.in[I_DWUP] + (size_t)(layer * 2 + 1) * 64 * 256 + c;
  const float* aup = p.in[I_DAUP] + (size_t)layer * 64 * 256 + c;
#pragma unroll 4
  for (int j = 0; j < 64; ++j) {
    const float wf = wupf[j * 256], wb = wupb[j * 256], wa = aup[j * 256];
    const f32x4 f0 = *(const f32x4*)(su + j * 8), f1 = *(const f32x4*)(su + j * 8 + 4);
    const f32x4 b0 = *(const f32x4*)(su + (64 + j) * 8), b1 = *(const f32x4*)(su + (64 + j) * 8 + 4);
    const f32x4 a0v = *(const f32x4*)(su + (128 + j) * 8), a1v = *(const f32x4*)(su + (128 + j) * 8 + 4);
#pragma unroll
    for (int k = 0; k < 4; ++k) { accf[k] += f0[k] * wf; accf[4 + k] += f1[k] * wf; accb[k] += b0[k] * wb; accb[4 + k] += b1[k] * wb; acca[k] += a0v[k] * wa; acca[4 + k] += a1v[k] * wa; }
  }
  const float w0f = p.in[I_DW0][(layer * 2 + 0) * 256 + c], w0b = p.in[I_DW0][(layer * 2 + 1) * 256 + c];
  const float a0 = p.in[I_DA0][layer * 256 + c], kkw = p.in[I_DKK][layer * 256 + c], kaw = p.in[I_DKA][layer * 256 + c];
#pragma unroll
  for (int k = 0; k < 8; ++k) {
    const int row = rowb + k, t = tb + k;
    const float r = dshift(p, mup, mun, row, t, T, c), kx = dshift(p, mup, mun, row, t, T, 256 + c), v = dshift(p, mup, mun, row, t, T, 512 + c);
    const float omf = omdecay(w0f + accf[k]), omb = omdecay(w0b + accb[k]);
    const float a = sigmoidf_(a0 + acca[k]);
    float kk = kx * kkw; const float n2 = wave_sum(kk * kk);
    kk = kk / fmaxf(sqrtf(n2), 1e-12f);
    const float kmod = kx * (1.0f + (a - 1.0f) * kaw), b = kk * a;
    const size_t o = (size_t)row * 256 + c;
    p.pl[o] = f2bf(r); p.pl[PLANE + o] = f2bf(kmod); p.pl[2 * PLANE + o] = f2bf(v); p.pl[3 * PLANE + o] = f2bf(-kk);
    p.pl[4 * PLANE + o] = f2bf(b); p.pl[5 * PLANE + o] = f2bf(omf); p.pl[6 * PLANE + o] = f2bf(omb);
  }
  __syncthreads();
}

DI void dpost_item(char* lds, const Params& p, int layer, int item) {
  const int tid = opaque(threadIdx.x);
  const int rowb = item * 8; int tb, T; row_info(rowb, tb, T);
  const float* mup = p.in[I_DMUP] + layer * 1088; const float* mun = p.in[I_DMUN] + layer * 1088;
  float* sg = (float*)lds;
#pragma unroll
  for (int i = 0; i < 4; ++i) { const int idx = tid + 256 * i, tok = idx >> 7, c = idx & 127; sg[c * 8 + tok] = sigmoidf_(dshift(p, mup, mun, rowb + tok, tb + tok, T, 960 + c)); }
  __syncthreads();
  const int c = tid;
  float acc[8];
#pragma unroll
  for (int k = 0; k < 8; ++k) acc[k] = 0.f;
  const float* gup = p.in[I_DGUP] + (size_t)layer * 128 * 256 + c;
#pragma unroll 4
  for (int j = 0; j < 128; ++j) { const float gw = gup[j * 256];
    const f32x4 s0 = *(const f32x4*)(sg + j * 8), s1 = *(const f32x4*)(sg + j * 8 + 4);
#pragma unroll
    for (int k = 0; k < 4; ++k) { acc[k] += s0[k] * gw; acc[4 + k] += s1[k] * gw; } }
  const float gnw = p.in[I_DGNW][layer * 256 + c], gnb = p.in[I_DGNB][layer * 256 + c], rk = p.in[I_DRK][layer * 256 + c];
#pragma unroll
  for (int k = 0; k < 8; ++k) {
    const int row = rowb + k;
    const bf16_t* zd = p.z + (size_t)row * NIN + D_0;
    const float y = bf2f(zd[c]) + bf2f(zd[256 + c]);
    const float mean = wave_sum(y) * (1.0f / 64.0f); const float d = y - mean; const float var = wave_sum(d * d) * (1.0f / 64.0f);
    const float yn = d * rsqrtf(var + 64e-5f) * gnw + gnb;
    const size_t o = (size_t)row * 256 + c;
    const float r = bf2f(p.pl[o]), km = bf2f(p.pl[PLANE + o]), v = bf2f(p.pl[2 * PLANE + o]);
    const float bonus = wave_sum(r * km * rk);
    p.pl[4 * PLANE + o] = f2bf((yn + bonus * v) * acc[k]);
  }
  __syncthreads();
}

DI void rwkv_item(char* lds, const Params& p, int seq, int head, int dir) {
  int row0, T; seq_info(seq, row0, T);
  const int tid = opaque(threadIdx.x), kc = tid & 7, rp = tid >> 3;
  float* st = (float*)lds;
  float S0[8], S1[8];
#pragma unroll
  for (int j = 0; j < 8; ++j) { S0[j] = 0.f; S1[j] = 0.f; }
  const int nchunk = T >> 4;
  u32x4 rg[3];
  const int tsel = tid >> 7, srem = tid & 127, sstep = srem >> 3, sc8 = srem & 7;
#define RW_GLOAD(c) do { _Pragma("unroll") for (int i_ = 0; i_ < 3; ++i_) { const int tens_ = tsel + 2 * i_; \
      const int plane_ = tens_ == 0 ? (dir ? 6 : 5) : tens_ == 1 ? 3 : tens_ == 2 ? 4 : tens_ == 3 ? 1 : tens_ == 4 ? 0 : 2; \
      const int t_ = dir ? (T - 1 - ((c) * 16 + sstep)) : ((c) * 16 + sstep); \
      rg[i_] = *(const u32x4*)(p.pl + (size_t)plane_ * PLANE + (size_t)(row0 + t_) * 256 + head * 64 + sc8 * 8); } } while (0)
#define RW_LSTORE(buf) do { _Pragma("unroll") for (int i_ = 0; i_ < 3; ++i_) { const int tens_ = tsel + 2 * i_; \
      f32x4 a_ = {bflo(rg[i_].x), bfhi(rg[i_].x), bflo(rg[i_].y), bfhi(rg[i_].y)}, b_ = {bflo(rg[i_].z), bfhi(rg[i_].z), bflo(rg[i_].w), bfhi(rg[i_].w)}; \
      if (tens_ == 0) { a_ = 1.0f - a_; b_ = 1.0f - b_; } \
      float* d_ = st + (((buf) * 16 + sstep) * 6 + tens_) * 64 + sc8 * 8; *(f32x4*)d_ = a_; *(f32x4*)(d_ + 4) = b_; } } while (0)
  RW_GLOAD(0); RW_LSTORE(0); __syncthreads();
  bf16_t* ybase = p.z + (size_t)row0 * NIN + D_0 + dir * 256 + head * 64 + rp * 2;
  for (int c = 0; c < nchunk; ++c) {
    if (c + 1 < nchunk) RW_GLOAD(c + 1);
    const float* sb = st + (c & 1) * (16 * 384);
#pragma unroll 4
    for (int s = 0; s < 16; ++s) {
      const float* q = sb + s * 384 + kc * 8;
      const f32x4 w0 = *(const f32x4*)(q), w1 = *(const f32x4*)(q + 4);
      const f32x4 n0 = *(const f32x4*)(q + 64), n1 = *(const f32x4*)(q + 68);
      const f32x4 b0 = *(const f32x4*)(q + 128), b1 = *(const f32x4*)(q + 132);
      const f32x4 k0 = *(const f32x4*)(q + 192), k1 = *(const f32x4*)(q + 196);
      const f32x4 r0 = *(const f32x4*)(q + 256), r1 = *(const f32x4*)(q + 260);
      const f32x2 vv = *(const f32x2*)(sb + s * 384 + 320 + rp * 2);
      float sa0 = 0.f, sa1 = 0.f;
#pragma unroll
      for (int j = 0; j < 4; ++j) { sa0 += S0[j] * n0[j]; sa1 += S1[j] * n0[j]; }
#pragma unroll
      for (int j = 0; j < 4; ++j) { sa0 += S0[4 + j] * n1[j]; sa1 += S1[4 + j] * n1[j]; }
      sa0 = red8(sa0); sa1 = red8(sa1);
      float y0 = 0.f, y1 = 0.f;
#pragma unroll
      for (int j = 0; j < 4; ++j) {
        S0[j] = S0[j] * w0[j] + (sa0 * b0[j] + vv.x * k0[j]); S1[j] = S1[j] * w0[j] + (sa1 * b0[j] + vv.y * k0[j]);
        y0 += S0[j] * r0[j]; y1 += S1[j] * r0[j];
      }
#pragma unroll
      for (int j = 0; j < 4; ++j) {
        S0[4 + j] = S0[4 + j] * w1[j] + (sa0 * b1[j] + vv.x * k1[j]); S1[4 + j] = S1[4 + j] * w1[j] + (sa1 * b1[j] + vv.y * k1[j]);
        y0 += S0[4 + j] * r1[j]; y1 += S1[4 + j] * r1[j];
      }
      y0 = red8(y0); y1 = red8(y1);
      if (kc == 0) { const int t = dir ? (T - 1 - (c * 16 + s)) : (c * 16 + s); *(unsigned*)(ybase + (size_t)t * NIN) = pk(y0, y1); }
    }
    if (c + 1 < nchunk) RW_LSTORE((c + 1) & 1);
    __syncthreads();
  }
#undef RW_GLOAD
#undef RW_LSTORE
}

template <int MODE>
DI void attn_item(char* lds, const Params& p, int layer, int seq, int head, int qt) {
  const int tid = opaque(threadIdx.x), lane = tid & 63, w = tid >> 6, l31 = lane & 31, h = lane >> 5;
  layer = opaque_s(layer); seq = opaque_s(seq); head = opaque_s(head); qt = opaque_s(qt);
  int row0, T; seq_info(seq, row0, T);
  const int QC = (MODE == 0 ? A_Q : MODE == 1 ? B_Q : C_Q) + head * 64;
  const int KC = MODE == 0 ? A_K + (head >> 1) * 64 : MODE == 1 ? B_K + head * 64 : C_K + head * 64;
  const int VC = MODE == 0 ? A_V + (head >> 1) * 64 : MODE == 1 ? B_V + head * 64 : C_V + head * 64;
  const int qw0 = qt * 128 + w * 32, qi = qw0 + l31;
  bf16_t* zq = p.z + (size_t)(row0 + qi) * NIN + QC;
  bf16x8 qf[4];
#pragma unroll
  for (int s = 0; s < 4; ++s) qf[s] = *(const bf16x8*)(zq + s * 16 + h * 8);
  const int srow = tid >> 3, sc8 = tid & 7;
  const bf16_t* kbase = p.z + (size_t)(row0 + srow) * NIN + KC + sc8 * 8;
  const bf16_t* vbase = p.z + (size_t)(row0 + srow) * NIN + VC + sc8 * 8;
  u32x4 rk[2][2], rv[2][2];
  const int nt = T >> 6;
  const int prow = (l31 & 19) | ((l31 & 4) << 1) | ((l31 & 8) >> 1);
#define AT_GLOAD(t, S) do { _Pragma("unroll") for (int i_ = 0; i_ < 2; ++i_) { const size_t off_ = (size_t)((t) * 64 + 32 * i_) * NIN; rk[S][i_] = *(const u32x4*)(kbase + off_); rv[S][i_] = *(const u32x4*)(vbase + off_); } } while (0)
#define AT_LSTORE(buf, S) do { char* ks_ = lds + (buf) * 18432; char* vs_ = ks_ + 9216; \
    _Pragma("unroll") for (int i_ = 0; i_ < 2; ++i_) { *(u32x4*)(ks_ + (srow + 32 * i_) * PITCH + sc8 * 16) = rk[S][i_]; *(u32x4*)(vs_ + (srow + 32 * i_) * PITCH + sc8 * 16) = rv[S][i_]; } } while (0)
  constexpr int NMAP = (MODE == 1) ? 2 : 1;
  f32x16 o[NMAP][2];
  float m_run[NMAP], l_run[NMAP];
#pragma unroll
  for (int a = 0; a < NMAP; ++a) { m_run[a] = -INFINITY; l_run[a] = 0.f;
#pragma unroll
    for (int b = 0; b < 2; ++b)
#pragma unroll
      for (int i = 0; i < 16; ++i) o[a][b][i] = 0.f; }
  float lf = 0.f, lb = 0.f;
  if (MODE == 2) { lf = log2f(1.0f - exp2f(-5.0f - (float)head)); lb = log2f(1.0f - exp2f(-5.0f - (float)(3 - head))); }
  auto body = [&](const char* ks, const char* vs, const int t) __attribute__((always_inline)) {
#pragma unroll
    for (int mp = 0; mp < NMAP; ++mp) {
      f32x16 st[2];
#pragma unroll
      for (int kf = 0; kf < 2; ++kf) {
#pragma unroll
        for (int i = 0; i < 16; ++i) st[kf][i] = 0.f;
        if (MODE == 1) {
#pragma unroll
          for (int s = 0; s < 2; ++s) { const bf16x8 kfr = *(const bf16x8*)(ks + (kf * 32 + prow) * PITCH + (mp * 2 + s) * 32 + h * 16); st[kf] = MFMA32(kfr, qf[mp * 2 + s], st[kf]); }
        } else {
#pragma unroll
          for (int s = 0; s < 4; ++s) { const bf16x8 kfr = *(const bf16x8*)(ks + (kf * 32 + prow) * PITCH + s * 32 + h * 16); st[kf] = MFMA32(kfr, qf[s], st[kf]); }
        }
      }
      if (MODE == 2) {
        const int k0 = t * 64;
        const float dbase = (float)(qi - k0 - 8 * h);
        if (k0 + 63 < qw0) {
#pragma unroll
          for (int kf = 0; kf < 2; ++kf)
#pragma unroll
            for (int i = 0; i < 16; ++i) { const float cc = (float)(32 * kf + (i & 3) + 4 * ((i >> 2) & 1) + 16 * ((i >> 3) & 1)); st[kf][i] *= fexp2(lf * (dbase - cc)); }
        } else if (k0 > qw0 + 31) {
#pragma unroll
          for (int kf = 0; kf < 2; ++kf)
#pragma unroll
            for (int i = 0; i < 16; ++i) { const float cc = (float)(32 * kf + (i & 3) + 4 * ((i >> 2) & 1) + 16 * ((i >> 3) & 1)); st[kf][i] *= fexp2(lb * (cc - dbase)); }
        } else {
#pragma unroll
          for (int kf = 0; kf < 2; ++kf)
#pragma unroll
            for (int i = 0; i < 16; ++i) { const float cc = (float)(32 * kf + (i & 3) + 4 * ((i >> 2) & 1) + 16 * ((i >> 3) & 1)); const float d = dbase - cc;
              float dd = fexp2(fminf(lf * d, -lb * d)); if (d == 0.f) dd = 2.0f; st[kf][i] *= dd; }
        }
      } else {
        float mx = st[0][0];
#pragma unroll
        for (int kf = 0; kf < 2; ++kf)
#pragma unroll
          for (int i = 0; i < 16; ++i) mx = fmaxf(mx, st[kf][i]);
        mx = fmaxf(mx, __shfl_xor(mx, 32));
        const float mn = fmaxf(m_run[mp], mx); const float alpha = fexp2(m_run[mp] - mn); m_run[mp] = mn;
        float ps = 0.f;
#pragma unroll
        for (int kf = 0; kf < 2; ++kf)
#pragma unroll
          for (int i = 0; i < 16; ++i) { st[kf][i] = fexp2(st[kf][i] - mn); ps += st[kf][i]; }
        l_run[mp] = l_run[mp] * alpha + ps;
#pragma unroll
        for (int df = 0; df < 2; ++df) o[mp][df] *= alpha;
      }
      bf16x8 pf[4];
#pragma unroll
      for (int kf = 0; kf < 2; ++kf)
#pragma unroll
        for (int s2 = 0; s2 < 2; ++s2) { u32x4 u; u.x = pk(st[kf][8 * s2], st[kf][8 * s2 + 1]); u.y = pk(st[kf][8 * s2 + 2], st[kf][8 * s2 + 3]);
          u.z = pk(st[kf][8 * s2 + 4], st[kf][8 * s2 + 5]); u.w = pk(st[kf][8 * s2 + 6], st[kf][8 * s2 + 7]); pf[kf * 2 + s2] = __builtin_bit_cast(bf16x8, u); }
#pragma unroll
      for (int df = 0; df < 2; ++df)
#pragma unroll
        for (int ksx = 0; ksx < 4; ++ksx) { const bf16x8 vfr = *(const bf16x8*)(vs + (df * 32 + l31) * PITCH + ksx * 32 + h * 16); o[mp][df] = MFMA32(vfr, pf[ksx], o[mp][df]); }
    }
  };
  if constexpr (MODE == 1) {
    AT_GLOAD(0, 0); AT_LSTORE(0, 0); __syncthreads();
#pragma unroll 1
    for (int t = 0; t < nt; ++t) {
      if (t + 1 < nt) AT_GLOAD(t + 1, 0);
      const char* ks = lds + (t & 1) * 18432;
      body(ks, ks + 9216, t);
      if (t + 1 < nt) AT_LSTORE((t + 1) & 1, 0);
      __syncthreads();
    }
  } else {
    AT_GLOAD(0, 0); AT_GLOAD(1, 1); AT_LSTORE(0, 0); __syncthreads();
#pragma unroll 1
    for (int t2 = 0; t2 < nt; t2 += 2) {
      if (t2 + 2 < nt) AT_GLOAD(t2 + 2, 0);
      body(lds, lds + 9216, t2);
      AT_LSTORE(1, 1);
      __syncthreads();
      if (t2 + 3 < nt) AT_GLOAD(t2 + 3, 1);
      body(lds + 18432, lds + 18432 + 9216, t2 + 1);
      if (t2 + 2 < nt) AT_LSTORE(0, 0);
      __syncthreads();
    }
  }
#undef AT_GLOAD
#undef AT_LSTORE
  f32x16 r[2];
  if (MODE == 0) {
    const float l = l_run[0] + __shfl_xor(l_run[0], 32); const float inv = 1.0f / l;
#pragma unroll
    for (int df = 0; df < 2; ++df) r[df] = o[0][df] * inv;
  } else if (MODE == 1) {
    const float* lp = p.in[I_BLAM] + layer * 128;
    float s01 = 0.f, s23 = 0.f;
    for (int i = 0; i < 32; ++i) { s01 += lp[i] * lp[32 + i]; s23 += lp[64 + i] * lp[96 + i]; }
    const float lam_init = 0.8f - 0.6f * expf(-0.3f * (float)layer);
    const float lam = expf(s01) - expf(s23) + lam_init;
    const float l0 = l_run[0] + __shfl_xor(l_run[0], 32), l1 = l_run[NMAP - 1] + __shfl_xor(l_run[NMAP - 1], 32);
    const float i0 = 1.0f / l0, i1 = lam / l1;
    float ss = 0.f;
#pragma unroll
    for (int df = 0; df < 2; ++df) { r[df] = o[0][df] * i0 - o[NMAP - 1][df] * i1;
#pragma unroll
      for (int i = 0; i < 16; ++i) ss += r[df][i] * r[df][i]; }
    ss += __shfl_xor(ss, 32);
    const float rs = rsqrtf(ss * (1.0f / 64.0f) + EPS) * (1.0f - lam_init);
    const float* sg = p.in[I_BSUB] + layer * 64;
#pragma unroll
    for (int df = 0; df < 2; ++df)
#pragma unroll
      for (int i = 0; i < 16; ++i) r[df][i] *= rs * sg[df * 32 + (i & 3) + 8 * (i >> 2) + 4 * h];
  } else {
    float ss = 0.f;
#pragma unroll
    for (int df = 0; df < 2; ++df)
#pragma unroll
      for (int i = 0; i < 16; ++i) ss += o[0][df][i] * o[0][df][i];
    ss += __shfl_xor(ss, 32);
    const float rs = rsqrtf(ss * (1.0f / 64.0f) + EPS);
    const float* gg = p.in[I_CGN] + layer * 256 + head * 64;
    const bf16_t* zg = p.z + (size_t)(row0 + qi) * NIN + C_G + head * 64;
#pragma unroll
    for (int df = 0; df < 2; ++df)
#pragma unroll
      for (int g = 0; g < 4; ++g) { const u32x2 gw = *(const u32x2*)(zg + df * 32 + 8 * g + 4 * h);
        const float gv[4] = {bflo(gw.x), bfhi(gw.x), bflo(gw.y), bfhi(gw.y)};
#pragma unroll
        for (int e = 0; e < 4; ++e) { const float x = gv[e]; r[df][4 * g + e] = o[0][df][4 * g + e] * rs * gg[df * 32 + 8 * g + 4 * h + e] * (x / (1.0f + __expf(-x))); } }
  }
#pragma unroll
  for (int df = 0; df < 2; ++df)
#pragma unroll
    for (int g = 0; g < 4; ++g) { u32x2 v; v.x = pk(r[df][4 * g], r[df][4 * g + 1]); v.y = pk(r[df][4 * g + 2], r[df][4 * g + 3]); *(u32x2*)(zq + df * 32 + 8 * g + 4 * h) = v; }
}

DI int next_item(int* ctr, int* sh) {
  __syncthreads();
  if (threadIdx.x == 0) *sh = atomicAdd(ctr, 1);
  __syncthreads();
  return *sh;
}

__global__ void __launch_bounds__(256, 2) fwd(Params p) {
  extern __shared__ __attribute__((aligned(16))) char lds[];
  __shared__ int s_item;
  cg::grid_group grid = cg::this_grid();
  const int bid = blockIdx.x, nb = gridDim.x, tid = threadIdx.x, lane = tid & 63, w = tid >> 6;
  if (bid == 0 && tid < 64) p.ctr[tid] = 0;
  for (int i = bid * 256 + tid; i < 4096 * 32; i += nb * 256) { const int t = i >> 5, j = i & 31; const float inv = powf(10000.0f, -(float)(2 * j) / 64.0f); float sn, cs; sincosf((float)t * inv, &sn, &cs); p.tabC[i] = (f32x2){cs, sn}; }
  for (int i = bid * 256 + tid; i < 4096 * 4; i += nb * 256) { const int t = i >> 2, j = i & 3; const float inv = powf(500000.0f, -(float)(2 * j) / 8.0f); float sn, cs; sincosf((float)t * inv, &sn, &cs); p.tabB[i] = (f32x2){cs, sn}; }
  for (int i = bid * 256 + tid; i < 64 * 16; i += nb * 256) { const int t = i >> 4, j = i & 15; const float inv = powf(10000.0f, -(float)(2 * j) / 32.0f); float sn, cs; sincosf((float)t * inv, &sn, &cs); p.tabA[i] = (f32x2){cs, sn}; }
  for (int l = 0; l < 2; ++l) {
    for (int i = bid * 256 + tid; i < 64 * 1024; i += nb * 256) p.wtin[(size_t)l * NINP * 1024 + (size_t)NIN * 1024 + i] = 0;
    for (int tl = bid; tl < 16 * 53; tl += nb) conv_T(lds, p.in[I_WIN] + (size_t)l * 1024 * NIN, 1024, NIN, p.wtin + (size_t)l * NINP * 1024, 0, tl);
    for (int tl = bid; tl < 16 * 16; tl += nb) conv_T(lds, p.in[I_WOUT] + (size_t)l * 1024 * 1024, 1024, 1024, p.wtout + (size_t)l * 1024 * 1024, 0, tl);
  }
  bf16_t* hb = p.pl;
  for (int row = bid * 4 + w; row < MT; row += nb * 4) {
    const float* xin = row < M0 ? p.in[I_XP] + (size_t)row * 1024 : p.in[I_XS] + (size_t)(row - M0) * 1024;
    row_phase(xin, p.out + (size_t)row * 1024, nullptr, nullptr, p.in[I_NMPRE], hb + (size_t)row * 1024, lane);
  }
  grid.sync();
  for (int l = 0; l < 2; ++l) {
    { ASrc A; A.b0 = hb; A.b1 = hb; A.b2 = hb; A.b3 = hb; A.s0 = A.s1 = A.s2 = A.s3 = 1024; A.shift = 12;
      EpiIn e; e.z = p.z; e.qg = p.in[I_AQG] + l * 64; e.kg = p.in[I_AKG] + l * 64; e.tabA = p.tabA; e.tabB = p.tabB; e.tabC = p.tabC;
      gemm_phase(lds, A, p.wtin + (size_t)l * NINP * 1024, 1024, 27, e); }
    grid.sync();
    for (int it = bid; it < MT / 8; it += nb) dprep_item(lds, p, l, it);
    grid.sync();
    for (;;) {
      const int it = next_item(p.ctr + l * 16, &s_item);
      if (it >= 128 + 4608) break;
      if (it < 128) { const int sq = it < 64 ? (it >> 3) : 8 + ((it - 64) >> 3); rwkv_item(lds, p, sq, (it >> 1) & 3, it & 1); }
      else {
        int j = it - 128, mode, sq, hd, qt;
        if (j < 3072) { mode = j >> 10; const int rem = j & 1023; sq = rem >> 7; hd = (rem >> 5) & 3; qt = rem & 31; }
        else { j -= 3072; mode = j >> 9; const int rem = j & 511; sq = 8 + (rem >> 6); hd = (rem >> 4) & 3; qt = rem & 15; }
        if (mode == 0) attn_item<1>(lds, p, l, sq, hd, qt); else if (mode == 1) attn_item<2>(lds, p, l, sq, hd, qt); else attn_item<0>(lds, p, l, sq, hd, qt);
      }
    }
    grid.sync();
    bf16_t* wtgu = p.pl + 5 * PLANE; bf16_t* wtd = wtgu + (size_t)2 * DFF * 1024;
    for (int it = bid; it < MT / 8 + 3 * 704; it += nb) {
      if (it < MT / 8) dpost_item(lds, p, l, it);
      else { const int j = it - MT / 8;
        if (j < 704) conv_T(lds, p.in[I_FG] + (size_t)l * 1024 * DFF, 1024, DFF, wtgu, 1, j);
        else if (j < 1408) conv_T(lds, p.in[I_FU] + (size_t)l * 1024 * DFF, 1024, DFF, wtgu, 2, j - 704);
        else conv_T(lds, p.in[I_FD] + (size_t)l * DFF * 1024, DFF, 1024, wtd, 0, j - 1408); }
    }
    grid.sync();
    { ASrc A; A.b0 = p.z + A_Q; A.b1 = p.z + B_Q; A.b2 = p.z + C_Q; A.b3 = p.pl + 4 * PLANE; A.s0 = A.s1 = A.s2 = NIN; A.s3 = 256; A.shift = 8;
      EpiStore e; e.out = hb; e.ldc = 1024; e.nmax = 1024;
      gemm_phase(lds, A, p.wtout + (size_t)l * 1024 * 1024, 1024, 8, e); }
    grid.sync();
    for (int row = bid * 4 + w; row < MT; row += nb * 4)
      row_phase(p.out + (size_t)row * 1024, p.out + (size_t)row * 1024, hb + (size_t)row * 1024, p.in[I_NMPOST] + l * 1024, p.in[I_NFPRE] + l * 1024, hb + (size_t)row * 1024, lane);
    grid.sync();
    { ASrc A; A.b0 = hb; A.b1 = hb; A.b2 = hb; A.b3 = hb; A.s0 = A.s1 = A.s2 = A.s3 = 1024; A.shift = 12;
      EpiSwiGLU e; e.out = p.z;
      gemm_phase(lds, A, wtgu, 1024, 44, e); }
    grid.sync();
    { ASrc A; A.b0 = p.z; A.b1 = p.z; A.b2 = p.z; A.b3 = p.z; A.s0 = A.s1 = A.s2 = A.s3 = DFF; A.shift = 12;
      EpiStore e; e.out = hb; e.ldc = 1024; e.nmax = 1024;
      gemm_phase(lds, A, wtd, DFF, 8, e); }
    grid.sync();
    for (int row = bid * 4 + w; row < MT; row += nb * 4)
      row_phase(p.out + (size_t)row * 1024, p.out + (size_t)row * 1024, hb + (size_t)row * 1024, p.in[I_NFPOST] + l * 1024, l == 0 ? p.in[I_NMPRE] + 1024 : nullptr, hb + (size_t)row * 1024, lane);
    if (l == 0) grid.sync();
  }
}

extern "C" void kernel_launch(void* const* d_in, const int* in_sizes, int n_in, void* d_out, int out_size,
                              void* d_ws, size_t ws_size, hipStream_t stream) {
  static int grid_blocks = 0;
  if (!grid_blocks) {
    int dev = 0, cus = 0, per_cu = 0;
    hipGetDevice(&dev);
    hipDeviceGetAttribute(&cus, hipDeviceAttributeMultiprocessorCount, dev);
    hipFuncSetAttribute((const void*)fwd, hipFuncAttributeMaxDynamicSharedMemorySize, LDS_BYTES);
    hipOccupancyMaxActiveBlocksPerMultiprocessor(&per_cu, fwd, 256, LDS_BYTES);
    if (per_cu > 2) per_cu = 2;
    if (per_cu < 1) per_cu = 1;
    grid_blocks = cus * per_cu;
  }
  Params p{};
  for (int i = 0; i < 28; ++i) p.in[i] = (const float*)d_in[i];
  p.out = (float*)d_out;
  char* ws = (char*)d_ws;
  size_t off = 0;
  p.z = (bf16_t*)(ws + off); off += (size_t)MT * NIN * 2;
  p.pl = (bf16_t*)(ws + off); off += 7 * PLANE * 2;
  p.wtin = (bf16_t*)(ws + off); off += (size_t)2 * NINP * 1024 * 2;
  p.wtout = (bf16_t*)(ws + off); off += (size_t)2 * 1024 * 1024 * 2;
  p.tabC = (f32x2*)(ws + off); off += (size_t)4096 * 32 * 8;
  p.tabB = (f32x2*)(ws + off); off += (size_t)4096 * 4 * 8;
  p.tabA = (f32x2*)(ws + off); off += (size_t)64 * 16 * 8;
  p.ctr = (int*)(ws + off); off += 256;
  if (off > ws_size) fprintf(stderr, "workspace too small: need %zu have %zu\n", off, ws_size);
  void* args[] = {&p};
  hipError_t e = hipLaunchCooperativeKernel((void*)fwd, dim3(grid_blocks), dim3(256), args, LDS_BYTES, stream);
  if (e != hipSuccess) fprintf(stderr, "coop launch failed: %s (grid %d)\n", hipGetErrorString(e), grid_blocks);
}
```

```cpp
#include <hip/hip_runtime.h>
#include <hip/hip_cooperative_groups.h>
#include <cstdio>
#include <cstdint>
namespace cg = cooperative_groups;

#define DI __device__ __forceinline__
typedef unsigned short bf16_t;
typedef short bf16x8 __attribute__((ext_vector_type(8)));
typedef float f32x2 __attribute__((ext_vector_type(2)));
typedef float f32x4 __attribute__((ext_vector_type(4)));
typedef float f32x16 __attribute__((ext_vector_type(16)));
typedef unsigned u32x2 __attribute__((ext_vector_type(2)));
typedef unsigned u32x4 __attribute__((ext_vector_type(4)));
typedef __bf16 bf16x2_t __attribute__((ext_vector_type(2)));

constexpr int M0 = 32768, MT = 49152, DM = 1024, NIN = 3392, NINP = 3456, DFF = 2816;
constexpr int A_Q = 0, A_K = 256, A_V = 384, B_Q = 512, B_K = 768, B_V = 1024, C_Q = 1280, C_K = 1536, C_V = 1792, C_G = 2048, D_0 = 2304;
constexpr int PITCH = 144;
constexpr size_t PLANE = (size_t)MT * 256;
constexpr int LDS_BYTES = 73728;
constexpr float LOG2E = 1.4426950408889634f;
constexpr float EPS = 1e-6f;

enum { I_XP = 0, I_XS, I_NMPRE, I_NMPOST, I_NFPRE, I_NFPOST, I_WIN, I_WOUT, I_AQG, I_AKG, I_BLAM, I_BSUB, I_CGN, I_DMUP, I_DMUN, I_DW0, I_DWUP,
       I_DA0, I_DAUP, I_DGUP, I_DKK, I_DKA, I_DRK, I_DGNW, I_DGNB, I_FG, I_FU, I_FD };

struct Params {
  const float* in[28];
  float* out;
  bf16_t* z;
  bf16_t* pl;
  bf16_t* wtin;
  bf16_t* wtout;
  f32x2* tabC;
  f32x2* tabB;
  f32x2* tabA;
  int* ctr;
};

DI int opaque(int x) { asm volatile("" : "+v"(x)); return x; }
DI int opaque_s(int x) { asm volatile("" : "+s"(x)); return x; }
DI float bf2f(bf16_t v) { return __uint_as_float(((unsigned)v) << 16); }
DI float bflo(unsigned w) { return __uint_as_float(w << 16); }
DI float bfhi(unsigned w) { return __uint_as_float(w & 0xffff0000u); }
DI unsigned pk(float lo, float hi) { f32x2 v = {lo, hi}; bf16x2_t b = __builtin_convertvector(v, bf16x2_t); return __builtin_bit_cast(unsigned, b); }
DI bf16_t f2bf(float x) { return (bf16_t)(pk(x, 0.f) & 0xffffu); }
DI float dppf(float x, const int ctrl) { return x; }
#define DPPF(x, ctrl) __int_as_float(__builtin_amdgcn_update_dpp(0, __float_as_int(x), (ctrl), 0xF, 0xF, true))
DI float wave_sum(float v) {
  v += DPPF(v, 0xB1);
  v += DPPF(v, 0x4E);
  v += DPPF(v, 0x141);
  v += DPPF(v, 0x140);
  const int vi = __float_as_int(v);
  return (__int_as_float(__builtin_amdgcn_readlane(vi, 0)) + __int_as_float(__builtin_amdgcn_readlane(vi, 16))) +
         (__int_as_float(__builtin_amdgcn_readlane(vi, 32)) + __int_as_float(__builtin_amdgcn_readlane(vi, 48)));
}
DI float dpp_xor1(float x) { return __int_as_float(__builtin_amdgcn_update_dpp(0, __float_as_int(x), 0xB1, 0xF, 0xF, true)); }
DI float dpp_xor2(float x) { return __int_as_float(__builtin_amdgcn_update_dpp(0, __float_as_int(x), 0x4E, 0xF, 0xF, true)); }
DI float dpp_hmir(float x) { return __int_as_float(__builtin_amdgcn_update_dpp(0, __float_as_int(x), 0x141, 0xF, 0xF, true)); }
DI float red8(float x) { x += dpp_xor1(x); x += dpp_xor2(x); x += dpp_hmir(x); return x; }
DI float fexp2(float x) { return __builtin_amdgcn_exp2f(x); }
DI void seq_info(int s, int& row0, int& T) { if (s < 8) { row0 = s * 4096; T = 4096; } else { row0 = M0 + (s - 8) * 2048; T = 2048; } }
DI void row_info(int r, int& t, int& T) { if (r < M0) { t = r & 4095; T = 4096; } else { t = (r - M0) & 2047; T = 2048; } }
#define MFMA32(a, b, c) __builtin_amdgcn_mfma_f32_32x32x16_bf16((a), (b), (c), 0, 0, 0)

DI void conv_T(char* lds, const float* __restrict__ W, int K, int N, bf16_t* __restrict__ Wt, int mode, int tile) {
  float* t = (float*)lds;
  const int tid0 = opaque(threadIdx.x);
  const int ntn = N >> 6, kt = tile / ntn, nt = tile - kt * ntn, k0 = kt << 6, n0 = nt << 6;
#pragma unroll 4
  for (int i = 0; i < 16; ++i) { const int idx = tid0 + 256 * i, k = idx >> 6, n = idx & 63; t[k * 65 + n] = W[(size_t)(k0 + k) * N + n0 + n]; }
  __syncthreads();
#pragma unroll 4
  for (int i = 0; i < 8; ++i) {
    const int idx = tid0 + 256 * i, n = idx >> 5, k = (idx & 31) * 2, j = n0 + n;
    const int rho = (mode == 0) ? j : ((j >> 6) * 128 + ((j >> 5) & 1) * 64 + (mode - 1) * 32 + (j & 31));
    *(unsigned*)(Wt + (size_t)rho * K + k0 + k) = pk(t[k * 65 + n], t[(k + 1) * 65 + n]);
  }
  __syncthreads();
}

DI void row_phase(const float* __restrict__ xin, float* __restrict__ xout, const bf16_t* addsrc, const float* __restrict__ gpost,
                  const float* __restrict__ gpre, bf16_t* hout, int lane_in) {
  const int lane = opaque(lane_in);
  f32x4 x[4];
#pragma unroll
  for (int i = 0; i < 4; ++i) x[i] = *(const f32x4*)(xin + i * 256 + lane * 4);
  if (addsrc) {
    f32x4 m[4]; float ss = 0.f;
#pragma unroll
    for (int i = 0; i < 4; ++i) { const u32x2 w = *(const u32x2*)(addsrc + i * 256 + lane * 4); m[i] = (f32x4){bflo(w.x), bfhi(w.x), bflo(w.y), bfhi(w.y)};
      ss += m[i][0] * m[i][0] + m[i][1] * m[i][1] + m[i][2] * m[i][2] + m[i][3] * m[i][3]; }
    ss = wave_sum(ss); const float rs = rsqrtf(ss * (1.0f / 1024.0f) + EPS);
#pragma unroll
    for (int i = 0; i < 4; ++i) { const f32x4 g = *(const f32x4*)(gpost + i * 256 + lane * 4); x[i] += m[i] * rs * g; }
  }
#pragma unroll
  for (int i = 0; i < 4; ++i) *(f32x4*)(xout + i * 256 + lane * 4) = x[i];
  if (gpre) {
    float ss = 0.f;
#pragma unroll
    for (int i = 0; i < 4; ++i) ss += x[i][0] * x[i][0] + x[i][1] * x[i][1] + x[i][2] * x[i][2] + x[i][3] * x[i][3];
    ss = wave_sum(ss); const float rs = rsqrtf(ss * (1.0f / 1024.0f) + EPS);
#pragma unroll
    for (int i = 0; i < 4; ++i) { const f32x4 g = *(const f32x4*)(gpre + i * 256 + lane * 4); const f32x4 hv = x[i] * rs * g;
      u32x2 w; w.x = pk(hv[0], hv[1]); w.y = pk(hv[2], hv[3]); *(u32x2*)(hout + i * 256 + lane * 4) = w; }
  }
}

struct ASrc { const bf16_t* b0; const bf16_t* b1; const bf16_t* b2; const bf16_t* b3; int s0, s1, s2, s3; int shift; };

struct EpiStore { bf16_t* out; int ldc; int nmax;
  DI void operator()(const f32x16 (&acc)[2][2], int mb, int nb, int n0, int wc, int l31, int h) const {
#pragma unroll
    for (int mf = 0; mf < 2; ++mf) { bf16_t* rp = out + (size_t)(mb + mf * 32 + l31) * ldc;
#pragma unroll
      for (int nf = 0; nf < 2; ++nf) { if (nb + nf * 32 < nmax) {
#pragma unroll
        for (int g = 0; g < 4; ++g) { u32x2 v; v.x = pk(acc[mf][nf][4 * g], acc[mf][nf][4 * g + 1]); v.y = pk(acc[mf][nf][4 * g + 2], acc[mf][nf][4 * g + 3]);
          *(u32x2*)(rp + nb + nf * 32 + 8 * g + 4 * h) = v; } } } }
  } };
struct EpiSwiGLU { bf16_t* out;
  DI void operator()(const f32x16 (&acc)[2][2], int mb, int nb, int n0, int wc, int l31, int h) const {
    const int hc = (n0 >> 7) * 64 + wc * 32;
#pragma unroll
    for (int mf = 0; mf < 2; ++mf) { bf16_t* rp = out + (size_t)(mb + mf * 32 + l31) * DFF + hc;
#pragma unroll
      for (int g = 0; g < 4; ++g) { float r[4];
#pragma unroll
        for (int e = 0; e < 4; ++e) { const float gt = acc[mf][0][4 * g + e], up = acc[mf][1][4 * g + e]; r[e] = gt / (1.0f + __expf(-gt)) * up; }
        u32x2 v; v.x = pk(r[0], r[1]); v.y = pk(r[2], r[3]); *(u32x2*)(rp + 8 * g + 4 * h) = v; } }
  } };

struct EpiIn { bf16_t* z; char* lds; const float* qg; const float* kg; const f32x2* tabA; const f32x2* tabB; const f32x2* tabC;
  DI void operator()(f32x16 (&acc)[2][2], int mb, int nb, int n0, int wc, int l31, int h) const {
    if (nb >= NIN) return;
    const bool isv = (nb >= A_V && nb < B_Q) || (nb >= B_V && nb < C_Q) || (nb >= C_V && nb < C_G);
    if (isv) {
      const int wv = (threadIdx.x >> 6);
      bf16_t* img = (bf16_t*)(lds + wv * 9216);
#pragma unroll
      for (int mf = 0; mf < 2; ++mf)
#pragma unroll
        for (int nf = 0; nf < 2; ++nf)
#pragma unroll
          for (int i = 0; i < 16; ++i) { const int d = nf * 32 + (i & 3) + 8 * (i >> 2) + 4 * h; img[d * 72 + mf * 32 + l31] = f2bf(acc[mf][nf][i]); }
      __builtin_amdgcn_s_waitcnt(0xc07f);
      const int ln = l31 + 32 * h;
#pragma unroll
      for (int i = 0; i < 8; ++i) { const int q = ln + 64 * i, d = q >> 3, c8 = q & 7;
        const u32x4 v = *(const u32x4*)(img + d * 72 + c8 * 8); *(u32x4*)(z + (size_t)(mb + d) * NIN + nb + c8 * 8) = v; }
      return;
    }
#pragma unroll
    for (int mf = 0; mf < 2; ++mf) {
      const int row = mb + mf * 32 + l31; int t, T; row_info(row, t, T);
      if (nb < A_V) {
        const bool isq = nb < A_K; const float* gn = isq ? qg : kg;
        float ss = 0.f;
#pragma unroll
        for (int nf = 0; nf < 2; ++nf)
#pragma unroll
          for (int i = 0; i < 16; ++i) ss += acc[mf][nf][i] * acc[mf][nf][i];
        ss += __shfl_xor(ss, 32);
        const float rs = rsqrtf(ss * (1.0f / 64.0f) + EPS) * (isq ? 0.125f * LOG2E : 1.0f);
#pragma unroll
        for (int nf = 0; nf < 2; ++nf) {
          const int pos = nf == 0 ? (t >> 6) : (t & 63);
#pragma unroll
          for (int g = 0; g < 4; ++g)
#pragma unroll
            for (int e = 0; e < 4; ++e) acc[mf][nf][4 * g + e] *= rs * gn[nf * 32 + 8 * g + 4 * h + e];
#pragma unroll
          for (int g = 0; g < 2; ++g)
#pragma unroll
            for (int e = 0; e < 4; ++e) { const f32x2 cs = tabA[pos * 16 + 8 * g + 4 * h + e];
              const float x1 = acc[mf][nf][4 * g + e], x2 = acc[mf][nf][4 * (g + 2) + e];
              acc[mf][nf][4 * g + e] = x1 * cs.x - x2 * cs.y; acc[mf][nf][4 * (g + 2) + e] = x2 * cs.x + x1 * cs.y; }
        }
      } else if (nb >= B_Q && nb < B_V) {
        const bool isq = nb < B_K;
#pragma unroll
        for (int nf = 0; nf < 2; ++nf) {
#pragma unroll
          for (int e = 0; e < 4; ++e) { const f32x2 cs = tabB[t * 4 + e]; const float v = acc[mf][nf][e]; const float o = __shfl_xor(v, 32);
            acc[mf][nf][e] = (h == 0) ? (v * cs.x - o * cs.y) : (v * cs.x + o * cs.y); }
          if (isq) {
#pragma unroll
            for (int i = 0; i < 16; ++i) acc[mf][nf][i] *= 0.17677669529663687f * LOG2E; }
        }
      } else if (nb >= C_Q && nb < C_V) {
        const float sc = nb < C_K ? 1.0f : 0.125f;
#pragma unroll
        for (int g = 0; g < 4; ++g)
#pragma unroll
          for (int e = 0; e < 4; ++e) { const f32x2 cs = tabC[t * 32 + 8 * g + 4 * h + e]; const float x1 = acc[mf][0][4 * g + e], x2 = acc[mf][1][4 * g + e];
            acc[mf][0][4 * g + e] = (x1 * cs.x - x2 * cs.y) * sc; acc[mf][1][4 * g + e] = (x2 * cs.x + x1 * cs.y) * sc; }
      }
      bf16_t* rp = z + (size_t)row * NIN + nb;
#pragma unroll
      for (int nf = 0; nf < 2; ++nf)
#pragma unroll
        for (int g = 0; g < 4; ++g) { u32x2 v; v.x = pk(acc[mf][nf][4 * g], acc[mf][nf][4 * g + 1]); v.y = pk(acc[mf][nf][4 * g + 2], acc[mf][nf][4 * g + 3]);
          *(u32x2*)(rp + nf * 32 + 8 * g + 4 * h) = v; }
    }
  } };

#define LASP __attribute__((address_space(3)))
template <class Epi>
DI void gemm_tile(char* lds, const ASrc& A, const bf16_t* __restrict__ Bt, int K, int m0, int n0, const Epi& epi) {
  const int tid = opaque(threadIdx.x), lane = tid & 63, w = __builtin_amdgcn_readfirstlane(tid >> 6), wr = w >> 1, wc = w & 1, l31 = lane & 31, h = lane >> 5;
  const int nk = K >> 6, smask = (1 << A.shift) - 1;
  LASP char* ldsl = (LASP char*)lds;
  f32x16 acc[2][2];
#pragma unroll
  for (int a = 0; a < 2; ++a)
#pragma unroll
    for (int b = 0; b < 2; ++b)
#pragma unroll
      for (int i = 0; i < 16; ++i) acc[a][b][i] = 0.f;
  const int lrow = lane >> 3, lslot = lane & 7;
  int goffA[4], goffB[4];
#pragma unroll
  for (int i = 0; i < 4; ++i) { const int r = w * 32 + i * 8 + lrow, c = lslot ^ ((r >> 1) & 7); goffA[i] = r; goffB[i] = (n0 + r) * K + c * 8; goffA[i] = (goffA[i] << 3) | c; }
#define GEMM_ISSUE(kt, st) do { const int k0_ = (kt) << 6, seg_ = k0_ >> A.shift, kk_ = k0_ & smask; \
    const bf16_t* bp_ = seg_ == 0 ? A.b0 : seg_ == 1 ? A.b1 : seg_ == 2 ? A.b2 : A.b3; const int st_ = seg_ == 0 ? A.s0 : seg_ == 1 ? A.s1 : seg_ == 2 ? A.s2 : A.s3; \
    _Pragma("unroll") for (int i_ = 0; i_ < 4; ++i_) { \
      const bf16_t* ga_ = bp_ + (size_t)(m0 + (goffA[i_] >> 3)) * st_ + kk_ + (goffA[i_] & 7) * 8; \
      __builtin_amdgcn_global_load_lds((const unsigned*)ga_, (LASP unsigned*)(ldsl + (st) * 32768 + (w * 4 + i_) * 1024), 16, 0, 0); \
      const bf16_t* gb_ = Bt + (size_t)goffB[i_] + k0_; \
      __builtin_amdgcn_global_load_lds((const unsigned*)gb_, (LASP unsigned*)(ldsl + (st) * 32768 + 16384 + (w * 4 + i_) * 1024), 16, 0, 0); } } while (0)
  const int xr = (l31 >> 1) & 7;
  int coff[4];
#pragma unroll
  for (int s = 0; s < 4; ++s) coff[s] = ((2 * s + h) ^ xr) * 16;
#define GEMM_COMPUTE(st) do { const char* as = lds + (st) * 32768; const char* bs = as + 16384; \
    bf16x8 af[4][2], wf[4][2]; \
    _Pragma("unroll") for (int s = 0; s < 4; ++s) { \
      _Pragma("unroll") for (int mf = 0; mf < 2; ++mf) af[s][mf] = *(const bf16x8*)(as + (wr * 64 + mf * 32 + l31) * 128 + coff[s]); \
      _Pragma("unroll") for (int nf = 0; nf < 2; ++nf) wf[s][nf] = *(const bf16x8*)(bs + (wc * 64 + nf * 32 + l31) * 128 + coff[s]); } \
    __builtin_amdgcn_sched_barrier(0); __builtin_amdgcn_s_setprio(1); \
    _Pragma("unroll") for (int s = 0; s < 4; ++s) \
      _Pragma("unroll") for (int mf = 0; mf < 2; ++mf) _Pragma("unroll") for (int nf = 0; nf < 2; ++nf) acc[mf][nf] = MFMA32(wf[s][nf], af[s][mf], acc[mf][nf]); \
    __builtin_amdgcn_s_setprio(0); __builtin_amdgcn_sched_barrier(0); } while (0)
  GEMM_ISSUE(0, 0);
  for (int kt = 0; kt < nk; kt += 2) {
    asm volatile("s_waitcnt vmcnt(0)" ::: "memory"); __syncthreads();
    GEMM_ISSUE(kt + 1, 1);
    GEMM_COMPUTE(0);
    asm volatile("s_waitcnt vmcnt(0)" ::: "memory"); __syncthreads();
    if (kt + 2 < nk) GEMM_ISSUE(kt + 2, 0);
    GEMM_COMPUTE(1);
  }
  __syncthreads();
  epi(acc, m0 + wr * 64, n0 + wc * 64, n0, wc, l31, h);
  __syncthreads();
#undef GEMM_ISSUE
#undef GEMM_COMPUTE
}

template <class Epi>
DI void gemm_phase(char* lds, const ASrc& A, const bf16_t* Bt, int K, int ntn, const Epi& epi) {
  const int xcd = blockIdx.x & 7, j = blockIdx.x >> 3, nloc = gridDim.x >> 3, per = 48 * ntn, grp = 8 * ntn;
  for (int li = j; li < per; li += nloc) {
    const int sg = li / grp, wi = li - sg * grp, nt = wi >> 3, mt = xcd * 48 + sg * 8 + (wi & 7);
    gemm_tile(lds, A, Bt, K, mt * 128, nt * 128, epi);
  }
}

DI void prep_item(char* lds, const Params& p, int layer, int item) {
  const int tid = opaque(threadIdx.x), lane = tid & 63, w = tid >> 6;
  const int rowb = item * 64; int tb, T; row_info(rowb, tb, T);
  const float* qg = p.in[I_AQG] + layer * 64; const float* kg = p.in[I_AKG] + layer * 64;
  const float qgl = qg[lane], kgl = kg[lane];
  for (int tt = 0; tt < 16; ++tt) {
    const int row = rowb + w * 16 + tt, t = tb + w * 16 + tt;
    bf16_t* zr = p.z + (size_t)row * NIN;
    {
      const int j = lane & 31, i = j & 15; const bool first = j < 16; const int pos = (lane < 32) ? (t >> 6) : (t & 63);
      const f32x2 cs = p.tabA[pos * 16 + i];
#pragma unroll
      for (int hd = 0; hd < 6; ++hd) {
        bf16_t* ptr = zr + (hd < 4 ? A_Q + hd * 64 : A_K + (hd - 4) * 64) + lane;
        float v = bf2f(*ptr);
        const float ss = wave_sum(v * v);
        v = v * rsqrtf(ss * (1.0f / 64.0f) + EPS) * (hd < 4 ? qgl : kgl);
        const float o = __shfl_xor(v, 16);
        float r = first ? (v * cs.x - o * cs.y) : (v * cs.x + o * cs.y);
        if (hd < 4) r *= 0.125f * LOG2E;
        *ptr = f2bf(r);
      }
    }
    {
      const int d = lane & 31; const f32x2 cs = p.tabB[t * 4 + (d & 3)];
#pragma unroll
      for (int c = 0; c < 8; ++c) {
        bf16_t* ptr = zr + (c < 4 ? B_Q + c * 64 : B_K + (c - 4) * 64) + lane;
        float v = bf2f(*ptr);
        const float o = __shfl_xor(v, 4);
        float r = v;
        if (d < 8) r = (d < 4) ? (v * cs.x - o * cs.y) : (v * cs.x + o * cs.y);
        if (c < 4) r *= 0.17677669529663687f * LOG2E;
        *ptr = f2bf(r);
      }
    }
    {
      const f32x2 cs = p.tabC[t * 32 + (lane & 31)];
#pragma unroll
      for (int c = 0; c < 8; ++c) {
        bf16_t* ptr = zr + (c < 4 ? C_Q + c * 64 : C_K + (c - 4) * 64) + lane;
        const float v = bf2f(*ptr);
        const float o = __shfl_xor(v, 32);
        float r = (lane < 32) ? (v * cs.x - o * cs.y) : (v * cs.x + o * cs.y);
        if (c >= 4) r *= 0.125f;
        *ptr = f2bf(r);
      }
    }
  }
  bf16_t* tl = (bf16_t*)lds;
  const int r = tid >> 2, c0 = (tid & 3) * 16;
  for (int sl = 0; sl < 10; ++sl) {
    const int col = sl < 2 ? A_V + sl * 64 : sl < 6 ? B_V + (sl - 2) * 64 : C_V + (sl - 6) * 64;
    bf16_t* gp = p.z + (size_t)(rowb + r) * NIN + col + c0;
    const u32x4 v0 = *(const u32x4*)gp, v1 = *(const u32x4*)(gp + 8);
    __syncthreads();
#pragma unroll
    for (int e = 0; e < 4; ++e) {
      tl[(c0 + 2 * e) * 72 + r] = (bf16_t)(v0[e] & 0xffffu); tl[(c0 + 2 * e + 1) * 72 + r] = (bf16_t)(v0[e] >> 16);
      tl[(c0 + 8 + 2 * e) * 72 + r] = (bf16_t)(v1[e] & 0xffffu); tl[(c0 + 8 + 2 * e + 1) * 72 + r] = (bf16_t)(v1[e] >> 16);
    }
    __syncthreads();
    const u32x4 o0 = *(const u32x4*)(tl + r * 72 + c0), o1 = *(const u32x4*)(tl + r * 72 + c0 + 8);
    *(u32x4*)gp = o0; *(u32x4*)(gp + 8) = o1;
  }
  __syncthreads();
}

DI float dshift(const Params& p, const float* mup, const float* mun, int row, int t, int T, int dc) {
  const bf16_t* zp = p.z + (size_t)row * NIN + D_0 + dc;
  const float z = bf2f(*zp);
  const float zprev = (t > 0) ? bf2f(*(zp - NIN)) : 0.f;
  const float znext = (t < T - 1) ? bf2f(*(zp + NIN)) : 0.f;
  return z + mup[dc] * (zprev - z) + mun[dc] * (znext - z);
}
DI float sigmoidf_(float x) { return 1.0f / (1.0f + __expf(-x)); }
DI float omdecay(float ww) {
  const float y = -ww; const float sp = fmaxf(y, 0.f) + log1pf(__expf(-fabsf(y)));
  return -expm1f(-__expf(-sp - 0.5f));
}
DI void dprep_item(char* lds, const Params& p, int layer, int item) {
  const int tid = opaque(threadIdx.x);
  const int rowb = item * 8; int tb, T; row_info(rowb, tb, T);
  const float* mup = p.in[I_DMUP] + layer * 1088; const float* mun = p.in[I_DMUN] + layer * 1088;
  float* su = (float*)lds;
#pragma unroll
  for (int i = 0; i < 6; ++i) {
    const int idx = tid + 256 * i, tok = idx / 192, c = idx - tok * 192;
    float u = dshift(p, mup, mun, rowb + tok, tb + tok, T, 768 + c);
    if (c < 128) u = tanhf(u);
    su[c * 8 + tok] = u;
  }
  __syncthreads();
  const int c = tid;
  float accf[8], accb[8], acca[8];
#pragma unroll
  for (int k = 0; k < 8; ++k) { accf[k] = 0.f; accb[k] = 0.f; acca[k] = 0.f; }
  const float* wupf = p.in[I_DWUP] + (size_t)(layer * 2 + 0) * 64 * 256 + c;
  const float* wupb = p.in[I_DWUP] + (size_t)(layer * 2 + 1) * 64 * 256 + c;
  const float* aup = p.in[I_DAUP] + (size_t)layer * 64 * 256 + c;
#pragma unroll 4
  for (int j = 0; j < 64; ++j) {
    const float wf = wupf[j * 256], wb = wupb[j * 256], wa = aup[j * 256];
    const f32x4 f0 = *(const f32x4*)(su + j * 8), f1 = *(const f32x4*)(su + j * 8 + 4);
    const f32x4 b0 = *(const f32x4*)(su + (64 + j) * 8), b1 = *(const f32x4*)(su + (64 + j) * 8 + 4);
    const f32x4 a0v = *(const f32x4*)(su + (128 + j) * 8), a1v = *(const f32x4*)(su + (128 + j) * 8 + 4);
#pragma unroll
    for (int k = 0; k < 4; ++k) { accf[k] += f0[k] * wf; accf[4 + k] += f1[k] * wf; accb[k] += b0[k] * wb; accb[4 + k] += b1[k] * wb; acca[k] += a0v[k] * wa; acca[4 + k] += a1v[k] * wa; }
  }
  const float w0f = p.in[I_DW0][(layer * 2 + 0) * 256 + c], w0b = p.in[I_DW0][(layer * 2 + 1) * 256 + c];
  const float a0 = p.in[I_DA0][layer * 256 + c], kkw = p.in[I_DKK][layer * 256 + c], kaw = p.in[I_DKA][layer * 256 + c];
#pragma unroll
  for (int k = 0; k < 8; ++k) {
    const int row = rowb + k, t = tb + k;
    const float r = dshift(p, mup, mun, row, t, T, c), kx = dshift(p, mup, mun, row, t, T, 256 + c), v = dshift(p, mup, mun, row, t, T, 512 + c);
    const float omf = omdecay(w0f + accf[k]), omb = omdecay(w0b + accb[k]);
    const float a = sigmoidf_(a0 + acca[k]);
    float kk = kx * kkw; const float n2 = wave_sum(kk * kk);
    kk = kk / fmaxf(sqrtf(n2), 1e-12f);
    const float kmod = kx * (1.0f + (a - 1.0f) * kaw), b = kk * a;
    bf16_t* so = (bf16_t*)(lds + 8192) + k * 256 + c;
    so[0] = f2bf(r); so[2048] = f2bf(kmod); so[2 * 2048] = f2bf(v); so[3 * 2048] = f2bf(-kk);
    so[4 * 2048] = f2bf(b); so[5 * 2048] = f2bf(omf); so[6 * 2048] = f2bf(omb);
  }
  __syncthreads();
#pragma unroll
  for (int i = 0; i < 7; ++i) {
    const int tok = tid >> 5, c16 = tid & 31;
    const u32x4 v = *(const u32x4*)((bf16_t*)(lds + 8192) + i * 2048 + tok * 256 + c16 * 8);
    *(u32x4*)(p.pl + (size_t)i * PLANE + (size_t)(rowb + tok) * 256 + c16 * 8) = v;
  }
  __syncthreads();
}

DI void dpost_item(char* lds, const Params& p, int layer, int item) {
  const int tid = opaque(threadIdx.x);
  const int rowb = item * 8; int tb, T; row_info(rowb, tb, T);
  const float* mup = p.in[I_DMUP] + layer * 1088; const float* mun = p.in[I_DMUN] + layer * 1088;
  float* sg = (float*)lds;
#pragma unroll
  for (int i = 0; i < 4; ++i) { const int idx = tid + 256 * i, tok = idx >> 7, c = idx & 127; sg[c * 8 + tok] = sigmoidf_(dshift(p, mup, mun, rowb + tok, tb + tok, T, 960 + c)); }
  __syncthreads();
  const int c = tid;
  float acc[8];
#pragma unroll
  for (int k = 0; k < 8; ++k) acc[k] = 0.f;
  const float* gup = p.in[I_DGUP] + (size_t)layer * 128 * 256 + c;
#pragma unroll 4
  for (int j = 0; j < 128; ++j) { const float gw = gup[j * 256];
    const f32x4 s0 = *(const f32x4*)(sg + j * 8), s1 = *(const f32x4*)(sg + j * 8 + 4);
#pragma unroll
    for (int k = 0; k < 4; ++k) { acc[k] += s0[k] * gw; acc[4 + k] += s1[k] * gw; } }
  const float gnw = p.in[I_DGNW][layer * 256 + c], gnb = p.in[I_DGNB][layer * 256 + c], rk = p.in[I_DRK][layer * 256 + c];
#pragma unroll
  for (int k = 0; k < 8; ++k) {
    const int row = rowb + k;
    const bf16_t* zd = p.z + (size_t)row * NIN + D_0;
    const float y = bf2f(zd[c]) + bf2f(zd[256 + c]);
    const float mean = wave_sum(y) * (1.0f / 64.0f); const float d = y - mean; const float var = wave_sum(d * d) * (1.0f / 64.0f);
    const float yn = d * rsqrtf(var + 64e-5f) * gnw + gnb;
    const size_t o = (size_t)row * 256 + c;
    const float r = bf2f(p.pl[o]), km = bf2f(p.pl[PLANE + o]), v = bf2f(p.pl[2 * PLANE + o]);
    const float bonus = wave_sum(r * km * rk);
    ((bf16_t*)(lds + 8192))[k * 256 + c] = f2bf((yn + bonus * v) * acc[k]);
  }
  __syncthreads();
  { const int tok = tid >> 5, c16 = tid & 31;
    const u32x4 v = *(const u32x4*)((bf16_t*)(lds + 8192) + tok * 256 + c16 * 8);
    *(u32x4*)(p.pl + 4 * PLANE + (size_t)(rowb + tok) * 256 + c16 * 8) = v; }
  __syncthreads();
}

DI void rwkv_item(char* lds, const Params& p, int seq, int head, int dir) {
  int row0, T; seq_info(seq, row0, T);
  const int tid = opaque(threadIdx.x), kc = tid & 7, rp = tid >> 3;
  float* st = (float*)lds;
  float S0[8], S1[8];
#pragma unroll
  for (int j = 0; j < 8; ++j) { S0[j] = 0.f; S1[j] = 0.f; }
  const int nchunk = T >> 4;
  u32x4 rg[3];
  const int tsel = tid >> 7, srem = tid & 127, sstep = srem >> 3, sc8 = srem & 7;
#define RW_GLOAD(c) do { _Pragma("unroll") for (int i_ = 0; i_ < 3; ++i_) { const int tens_ = tsel + 2 * i_; \
      const int plane_ = tens_ == 0 ? (dir ? 6 : 5) : tens_ == 1 ? 3 : tens_ == 2 ? 4 : tens_ == 3 ? 1 : tens_ == 4 ? 0 : 2; \
      const int t_ = dir ? (T - 1 - ((c) * 16 + sstep)) : ((c) * 16 + sstep); \
      rg[i_] = *(const u32x4*)(p.pl + (size_t)plane_ * PLANE + (size_t)(row0 + t_) * 256 + head * 64 + sc8 * 8); } } while (0)
#define RW_LSTORE(buf) do { _Pragma("unroll") for (int i_ = 0; i_ < 3; ++i_) { const int tens_ = tsel + 2 * i_; \
      f32x4 a_ = {bflo(rg[i_].x), bfhi(rg[i_].x), bflo(rg[i_].y), bfhi(rg[i_].y)}, b_ = {bflo(rg[i_].z), bfhi(rg[i_].z), bflo(rg[i_].w), bfhi(rg[i_].w)}; \
      if (tens_ == 0) { a_ = 1.0f - a_; b_ = 1.0f - b_; } \
      float* d_ = st + (((buf) * 16 + sstep) * 6 + tens_) * 64 + sc8 * 8; *(f32x4*)d_ = a_; *(f32x4*)(d_ + 4) = b_; } } while (0)
  __builtin_amdgcn_s_setprio(3);
  RW_GLOAD(0); RW_LSTORE(0); __syncthreads();
  bf16_t* ybase = p.z + (size_t)row0 * NIN + D_0 + dir * 256 + head * 64 + rp * 2;
  for (int c = 0; c < nchunk; ++c) {
    if (c + 1 < nchunk) RW_GLOAD(c + 1);
    const float* sb = st + (c & 1) * (16 * 384);
#define RW_FETCH(S, s_) do { const float* q_ = sb + (s_) * 384 + kc * 8; \
      S##w0 = *(const f32x4*)(q_); S##w1 = *(const f32x4*)(q_ + 4); S##n0 = *(const f32x4*)(q_ + 64); S##n1 = *(const f32x4*)(q_ + 68); \
      S##b0 = *(const f32x4*)(q_ + 128); S##b1 = *(const f32x4*)(q_ + 132); S##k0 = *(const f32x4*)(q_ + 192); S##k1 = *(const f32x4*)(q_ + 196); \
      S##r0 = *(const f32x4*)(q_ + 256); S##r1 = *(const f32x4*)(q_ + 260); S##vv = *(const f32x2*)(sb + (s_) * 384 + 320 + rp * 2); } while (0)
#define RW_STEP(S, s_) do { \
      float sa0 = 0.f, sa1 = 0.f; \
      _Pragma("unroll") for (int j = 0; j < 4; ++j) { sa0 += S0[j] * S##n0[j]; sa1 += S1[j] * S##n0[j]; } \
      _Pragma("unroll") for (int j = 0; j < 4; ++j) { sa0 += S0[4 + j] * S##n1[j]; sa1 += S1[4 + j] * S##n1[j]; } \
      sa0 = red8(sa0); sa1 = red8(sa1); \
      float y0 = 0.f, y1 = 0.f; \
      _Pragma("unroll") for (int j = 0; j < 4; ++j) { \
        S0[j] = S0[j] * S##w0[j] + (sa0 * S##b0[j] + S##vv.x * S##k0[j]); S1[j] = S1[j] * S##w0[j] + (sa1 * S##b0[j] + S##vv.y * S##k0[j]); \
        y0 += S0[j] * S##r0[j]; y1 += S1[j] * S##r0[j]; } \
      _Pragma("unroll") for (int j = 0; j < 4; ++j) { \
        S0[4 + j] = S0[4 + j] * S##w1[j] + (sa0 * S##b1[j] + S##vv.x * S##k1[j]); S1[4 + j] = S1[4 + j] * S##w1[j] + (sa1 * S##b1[j] + S##vv.y * S##k1[j]); \
        y0 += S0[4 + j] * S##r1[j]; y1 += S1[4 + j] * S##r1[j]; } \
      y0 = red8(y0); y1 = red8(y1); \
      if (kc == 0) { const int t_ = dir ? (T - 1 - (c * 16 + (s_))) : (c * 16 + (s_)); *(unsigned*)(ybase + (size_t)t_ * NIN) = pk(y0, y1); } } while (0)
    f32x4 Aw0, Aw1, An0, An1, Ab0, Ab1, Ak0, Ak1, Ar0, Ar1; f32x2 Avv;
    f32x4 Bw0, Bw1, Bn0, Bn1, Bb0, Bb1, Bk0, Bk1, Br0, Br1; f32x2 Bvv;
    RW_FETCH(A, 0);
#pragma unroll 2
    for (int s = 0; s < 16; s += 2) {
      RW_FETCH(B, s + 1);
      RW_STEP(A, s);
      if (s + 2 < 16) RW_FETCH(A, s + 2);
      RW_STEP(B, s + 1);
    }
#undef RW_FETCH
#undef RW_STEP
    if (c + 1 < nchunk) RW_LSTORE((c + 1) & 1);
    __syncthreads();
  }
#undef RW_GLOAD
#undef RW_LSTORE
  __builtin_amdgcn_s_setprio(0);
}

template <int MODE>
DI void attn_item(char* lds, const Params& p, int layer, int seq, int head, int qt) {
  const int tid = opaque(threadIdx.x), lane = tid & 63, w = tid >> 6, l31 = lane & 31, h = lane >> 5;
  layer = opaque_s(layer); seq = opaque_s(seq); head = opaque_s(head); qt = opaque_s(qt);
  int row0, T; seq_info(seq, row0, T);
  const int QC = (MODE == 0 ? A_Q : MODE == 1 ? B_Q : C_Q) + head * 64;
  const int KC = MODE == 0 ? A_K + (head >> 1) * 64 : MODE == 1 ? B_K + head * 64 : C_K + head * 64;
  const int VC = MODE == 0 ? A_V + (head >> 1) * 64 : MODE == 1 ? B_V + head * 64 : C_V + head * 64;
  const int qw0 = qt * 128 + w * 32, qi = qw0 + l31;
  bf16_t* zq = p.z + (size_t)(row0 + qi) * NIN + QC;
  bf16x8 qf[4];
#pragma unroll
  for (int s = 0; s < 4; ++s) qf[s] = *(const bf16x8*)(zq + s * 16 + h * 8);
  const int srow = tid >> 3, sc8 = tid & 7;
  const bf16_t* kbase = p.z + (size_t)(row0 + srow) * NIN + KC + sc8 * 8;
  const bf16_t* vbase = p.z + (size_t)(row0 + srow) * NIN + VC + sc8 * 8;
  u32x4 rk[2][2], rv[2][2];
  const int nt = T >> 6;
  const int prow = (l31 & 19) | ((l31 & 4) << 1) | ((l31 & 8) >> 1);
#define AT_GLOAD(t, S) do { _Pragma("unroll") for (int i_ = 0; i_ < 2; ++i_) { const size_t off_ = (size_t)((t) * 64 + 32 * i_) * NIN; rk[S][i_] = *(const u32x4*)(kbase + off_); rv[S][i_] = *(const u32x4*)(vbase + off_); } } while (0)
#define AT_LSTORE(buf, S) do { char* ks_ = lds + (buf) * 18432; char* vs_ = ks_ + 9216; \
    _Pragma("unroll") for (int i_ = 0; i_ < 2; ++i_) { *(u32x4*)(ks_ + (srow + 32 * i_) * PITCH + sc8 * 16) = rk[S][i_]; *(u32x4*)(vs_ + (srow + 32 * i_) * PITCH + sc8 * 16) = rv[S][i_]; } } while (0)
  constexpr int NMAP = (MODE == 1) ? 2 : 1;
  f32x16 o[NMAP][2];
  float m_run[NMAP], l_run[NMAP];
#pragma unroll
  for (int a = 0; a < NMAP; ++a) { m_run[a] = -INFINITY; l_run[a] = 0.f;
#pragma unroll
    for (int b = 0; b < 2; ++b)
#pragma unroll
      for (int i = 0; i < 16; ++i) o[a][b][i] = 0.f; }
  float lf = 0.f, lb = 0.f;
  if (MODE == 2) { lf = log2f(1.0f - exp2f(-5.0f - (float)head)); lb = log2f(1.0f - exp2f(-5.0f - (float)(3 - head))); }
  auto body = [&](const char* ks, const char* vs, const int t) __attribute__((always_inline)) {
#pragma unroll
    for (int mp = 0; mp < NMAP; ++mp) {
      f32x16 st[2];
#pragma unroll
      for (int kf = 0; kf < 2; ++kf) {
#pragma unroll
        for (int i = 0; i < 16; ++i) st[kf][i] = 0.f;
        if (MODE == 1) {
#pragma unroll
          for (int s = 0; s < 2; ++s) { const bf16x8 kfr = *(const bf16x8*)(ks + (kf * 32 + prow) * PITCH + (mp * 2 + s) * 32 + h * 16); st[kf] = MFMA32(kfr, qf[mp * 2 + s], st[kf]); }
        } else {
#pragma unroll
          for (int s = 0; s < 4; ++s) { const bf16x8 kfr = *(const bf16x8*)(ks + (kf * 32 + prow) * PITCH + s * 32 + h * 16); st[kf] = MFMA32(kfr, qf[s], st[kf]); }
        }
      }
      if (MODE == 2) {
        const int k0 = t * 64;
        const float dbase = (float)(qi - k0 - 8 * h);
        if (k0 + 63 < qw0) {
#pragma unroll
          for (int kf = 0; kf < 2; ++kf)
#pragma unroll
            for (int i = 0; i < 16; ++i) { const float cc = (float)(32 * kf + (i & 3) + 4 * ((i >> 2) & 1) + 16 * ((i >> 3) & 1)); st[kf][i] *= fexp2(lf * (dbase - cc)); }
        } else if (k0 > qw0 + 31) {
#pragma unroll
          for (int kf = 0; kf < 2; ++kf)
#pragma unroll
            for (int i = 0; i < 16; ++i) { const float cc = (float)(32 * kf + (i & 3) + 4 * ((i >> 2) & 1) + 16 * ((i >> 3) & 1)); st[kf][i] *= fexp2(lb * (cc - dbase)); }
        } else {
#pragma unroll
          for (int kf = 0; kf < 2; ++kf)
#pragma unroll
            for (int i = 0; i < 16; ++i) { const float cc = (float)(32 * kf + (i & 3) + 4 * ((i >> 2) & 1) + 16 * ((i >> 3) & 1)); const float d = dbase - cc;
              float dd = fexp2(fminf(lf * d, -lb * d)); if (d == 0.f) dd = 2.0f; st[kf][i] *= dd; }
        }
      } else {
        float mx = st[0][0];
#pragma unroll
        for (int kf = 0; kf < 2; ++kf)
#pragma unroll
          for (int i = 0; i < 16; ++i) mx = fmaxf(mx, st[kf][i]);
        mx = fmaxf(mx, __shfl_xor(mx, 32));
        const float mn = fmaxf(m_run[mp], mx); const float alpha = fexp2(m_run[mp] - mn); m_run[mp] = mn;
        float ps = 0.f;
#pragma unroll
        for (int kf = 0; kf < 2; ++kf)
#pragma unroll
          for (int i = 0; i < 16; ++i) { st[kf][i] = fexp2(st[kf][i] - mn); ps += st[kf][i]; }
        l_run[mp] = l_run[mp] * alpha + ps;
#pragma unroll
        for (int df = 0; df < 2; ++df) o[mp][df] *= alpha;
      }
      bf16x8 pf[4];
#pragma unroll
      for (int kf = 0; kf < 2; ++kf)
#pragma unroll
        for (int s2 = 0; s2 < 2; ++s2) { u32x4 u; u.x = pk(st[kf][8 * s2], st[kf][8 * s2 + 1]); u.y = pk(st[kf][8 * s2 + 2], st[kf][8 * s2 + 3]);
          u.z = pk(st[kf][8 * s2 + 4], st[kf][8 * s2 + 5]); u.w = pk(st[kf][8 * s2 + 6], st[kf][8 * s2 + 7]); pf[kf * 2 + s2] = __builtin_bit_cast(bf16x8, u); }
#pragma unroll
      for (int df = 0; df < 2; ++df)
#pragma unroll
        for (int ksx = 0; ksx < 4; ++ksx) { const bf16x8 vfr = *(const bf16x8*)(vs + (df * 32 + l31) * PITCH + ksx * 32 + h * 16); o[mp][df] = MFMA32(vfr, pf[ksx], o[mp][df]); }
    }
  };
  if constexpr (MODE == 1) {
    AT_GLOAD(0, 0); AT_LSTORE(0, 0); __syncthreads();
#pragma unroll 1
    for (int t = 0; t < nt; ++t) {
      if (t + 1 < nt) AT_GLOAD(t + 1, 0);
      const char* ks = lds + (t & 1) * 18432;
      body(ks, ks + 9216, t);
      if (t + 1 < nt) AT_LSTORE((t + 1) & 1, 0);
      __syncthreads();
    }
  } else {
    AT_GLOAD(0, 0); AT_GLOAD(1, 1); AT_LSTORE(0, 0); __syncthreads();
#pragma unroll 1
    for (int t2 = 0; t2 < nt; t2 += 2) {
      if (t2 + 2 < nt) AT_GLOAD(t2 + 2, 0);
      body(lds, lds + 9216, t2);
      AT_LSTORE(1, 1);
      __syncthreads();
      if (t2 + 3 < nt) AT_GLOAD(t2 + 3, 1);
      body(lds + 18432, lds + 18432 + 9216, t2 + 1);
      if (t2 + 2 < nt) AT_LSTORE(0, 0);
      __syncthreads();
    }
  }
#undef AT_GLOAD
#undef AT_LSTORE
  f32x16 r[2];
  if (MODE == 0) {
    const float l = l_run[0] + __shfl_xor(l_run[0], 32); const float inv = 1.0f / l;
#pragma unroll
    for (int df = 0; df < 2; ++df) r[df] = o[0][df] * inv;
  } else if (MODE == 1) {
    const float* lp = p.in[I_BLAM] + layer * 128;
    float s01 = 0.f, s23 = 0.f;
    for (int i = 0; i < 32; ++i) { s01 += lp[i] * lp[32 + i]; s23 += lp[64 + i] * lp[96 + i]; }
    const float lam_init = 0.8f - 0.6f * expf(-0.3f * (float)layer);
    const float lam = expf(s01) - expf(s23) + lam_init;
    const float l0 = l_run[0] + __shfl_xor(l_run[0], 32), l1 = l_run[NMAP - 1] + __shfl_xor(l_run[NMAP - 1], 32);
    const float i0 = 1.0f / l0, i1 = lam / l1;
    float ss = 0.f;
#pragma unroll
    for (int df = 0; df < 2; ++df) { r[df] = o[0][df] * i0 - o[NMAP - 1][df] * i1;
#pragma unroll
      for (int i = 0; i < 16; ++i) ss += r[df][i] * r[df][i]; }
    ss += __shfl_xor(ss, 32);
    const float rs = rsqrtf(ss * (1.0f / 64.0f) + EPS) * (1.0f - lam_init);
    const float* sg = p.in[I_BSUB] + layer * 64;
#pragma unroll
    for (int df = 0; df < 2; ++df)
#pragma unroll
      for (int i = 0; i < 16; ++i) r[df][i] *= rs * sg[df * 32 + (i & 3) + 8 * (i >> 2) + 4 * h];
  } else {
    float ss = 0.f;
#pragma unroll
    for (int df = 0; df < 2; ++df)
#pragma unroll
      for (int i = 0; i < 16; ++i) ss += o[0][df][i] * o[0][df][i];
    ss += __shfl_xor(ss, 32);
    const float rs = rsqrtf(ss * (1.0f / 64.0f) + EPS);
    const float* gg = p.in[I_CGN] + layer * 256 + head * 64;
    const bf16_t* zg = p.z + (size_t)(row0 + qi) * NIN + C_G + head * 64;
#pragma unroll
    for (int df = 0; df < 2; ++df)
#pragma unroll
      for (int g = 0; g < 4; ++g) { const u32x2 gw = *(const u32x2*)(zg + df * 32 + 8 * g + 4 * h);
        const float gv[4] = {bflo(gw.x), bfhi(gw.x), bflo(gw.y), bfhi(gw.y)};
#pragma unroll
        for (int e = 0; e < 4; ++e) { const float x = gv[e]; r[df][4 * g + e] = o[0][df][4 * g + e] * rs * gg[df * 32 + 8 * g + 4 * h + e] * (x / (1.0f + __expf(-x))); } }
  }
#pragma unroll
  for (int df = 0; df < 2; ++df)
#pragma unroll
    for (int g = 0; g < 4; ++g) { u32x2 v; v.x = pk(r[df][4 * g], r[df][4 * g + 1]); v.y = pk(r[df][4 * g + 2], r[df][4 * g + 3]); *(u32x2*)(zq + df * 32 + 8 * g + 4 * h) = v; }
}

DI int next_item(int* ctr, int* sh) {
  __syncthreads();
  if (threadIdx.x == 0) *sh = atomicAdd(ctr, 1);
  __syncthreads();
  return *sh;
}

__global__ void __launch_bounds__(256, 2) fwd(Params p) {
  extern __shared__ __attribute__((aligned(16))) char lds[];
  __shared__ int s_item;
  cg::grid_group grid = cg::this_grid();
  const int bid = blockIdx.x, nb = gridDim.x, tid = threadIdx.x, lane = tid & 63, w = tid >> 6;
  if (bid == 0 && tid < 64) p.ctr[tid] = 0;
  for (int i = bid * 256 + tid; i < 4096 * 32; i += nb * 256) { const int t = i >> 5, j = i & 31; const float inv = powf(10000.0f, -(float)(2 * j) / 64.0f); float sn, cs; sincosf((float)t * inv, &sn, &cs); p.tabC[i] = (f32x2){cs, sn}; }
  for (int i = bid * 256 + tid; i < 4096 * 4; i += nb * 256) { const int t = i >> 2, j = i & 3; const float inv = powf(500000.0f, -(float)(2 * j) / 8.0f); float sn, cs; sincosf((float)t * inv, &sn, &cs); p.tabB[i] = (f32x2){cs, sn}; }
  for (int i = bid * 256 + tid; i < 64 * 16; i += nb * 256) { const int t = i >> 4, j = i & 15; const float inv = powf(10000.0f, -(float)(2 * j) / 32.0f); float sn, cs; sincosf((float)t * inv, &sn, &cs); p.tabA[i] = (f32x2){cs, sn}; }
  for (int l = 0; l < 2; ++l) {
    for (int i = bid * 256 + tid; i < 64 * 1024; i += nb * 256) p.wtin[(size_t)l * NINP * 1024 + (size_t)NIN * 1024 + i] = 0;
    for (int tl = bid; tl < 16 * 53; tl += nb) conv_T(lds, p.in[I_WIN] + (size_t)l * 1024 * NIN, 1024, NIN, p.wtin + (size_t)l * NINP * 1024, 0, tl);
    for (int tl = bid; tl < 16 * 16; tl += nb) conv_T(lds, p.in[I_WOUT] + (size_t)l * 1024 * 1024, 1024, 1024, p.wtout + (size_t)l * 1024 * 1024, 0, tl);
  }
  bf16_t* hb = p.pl;
  for (int row = bid * 4 + w; row < MT; row += nb * 4) {
    const float* xin = row < M0 ? p.in[I_XP] + (size_t)row * 1024 : p.in[I_XS] + (size_t)(row - M0) * 1024;
    row_phase(xin, p.out + (size_t)row * 1024, nullptr, nullptr, p.in[I_NMPRE], hb + (size_t)row * 1024, lane);
  }
  grid.sync();
  for (int l = 0; l < 2; ++l) {
    { ASrc A; A.b0 = hb; A.b1 = hb; A.b2 = hb; A.b3 = hb; A.s0 = A.s1 = A.s2 = A.s3 = 1024; A.shift = 12;
      EpiIn e; e.z = p.z; e.lds = lds; e.qg = p.in[I_AQG] + l * 64; e.kg = p.in[I_AKG] + l * 64; e.tabA = p.tabA; e.tabB = p.tabB; e.tabC = p.tabC;
      gemm_phase(lds, A, p.wtin + (size_t)l * NINP * 1024, 1024, 27, e); }
    grid.sync();
    for (int it = bid; it < MT / 8; it += nb) dprep_item(lds, p, l, it);
    grid.sync();
    for (;;) {
      const int it = next_item(p.ctr + l * 16, &s_item);
      if (it >= 128 + 4608) break;
      if (it < 128) { const int sq = it < 64 ? (it >> 3) : 8 + ((it - 64) >> 3); rwkv_item(lds, p, sq, (it >> 1) & 3, it & 1); }
      else {
        int j = it - 128, mode, sq, hd, qt;
        if (j < 3072) { mode = j >> 10; const int rem = j & 1023; sq = rem >> 7; hd = (rem >> 5) & 3; qt = rem & 31; }
        else { j -= 3072; mode = j >> 9; const int rem = j & 511; sq = 8 + (rem >> 6); hd = (rem >> 4) & 3; qt = rem & 15; }
        if (mode == 0) attn_item<1>(lds, p, l, sq, hd, qt); else if (mode == 1) attn_item<2>(lds, p, l, sq, hd, qt); else attn_item<0>(lds, p, l, sq, hd, qt);
      }
    }
    grid.sync();
    bf16_t* wtgu = p.pl + 5 * PLANE; bf16_t* wtd = wtgu + (size_t)2 * DFF * 1024;
    for (int it = bid; it < MT / 8 + 3 * 704; it += nb) {
      if (it < MT / 8) dpost_item(lds, p, l, it);
      else { const int j = it - MT / 8;
        if (j < 704) conv_T(lds, p.in[I_FG] + (size_t)l * 1024 * DFF, 1024, DFF, wtgu, 1, j);
        else if (j < 1408) conv_T(lds, p.in[I_FU] + (size_t)l * 1024 * DFF, 1024, DFF, wtgu, 2, j - 704);
        else conv_T(lds, p.in[I_FD] + (size_t)l * DFF * 1024, DFF, 1024, wtd, 0, j - 1408); }
    }
    grid.sync();
    { ASrc A; A.b0 = p.z + A_Q; A.b1 = p.z + B_Q; A.b2 = p.z + C_Q; A.b3 = p.pl + 4 * PLANE; A.s0 = A.s1 = A.s2 = NIN; A.s3 = 256; A.shift = 8;
      EpiStore e; e.out = hb; e.ldc = 1024; e.nmax = 1024;
      gemm_phase(lds, A, p.wtout + (size_t)l * 1024 * 1024, 1024, 8, e); }
    grid.sync();
    for (int row = bid * 4 + w; row < MT; row += nb * 4)
      row_phase(p.out + (size_t)row * 1024, p.out + (size_t)row * 1024, hb + (size_t)row * 1024, p.in[I_NMPOST] + l * 1024, p.in[I_NFPRE] + l * 1024, hb + (size_t)row * 1024, lane);
    grid.sync();
    { ASrc A; A.b0 = hb; A.b1 = hb; A.b2 = hb; A.b3 = hb; A.s0 = A.s1 = A.s2 = A.s3 = 1024; A.shift = 12;
      EpiSwiGLU e; e.out = p.z;
      gemm_phase(lds, A, wtgu, 1024, 44, e); }
    grid.sync();
    { ASrc A; A.b0 = p.z; A.b1 = p.z; A.b2 = p.z; A.b3 = p.z; A.s0 = A.s1 = A.s2 = A.s3 = DFF; A.shift = 12;
      EpiStore e; e.out = hb; e.ldc = 1024; e.nmax = 1024;
      gemm_phase(lds, A, wtd, DFF, 8, e); }
    grid.sync();
    for (int row = bid * 4 + w; row < MT; row += nb * 4)
      row_phase(p.out + (size_t)row * 1024, p.out + (size_t)row * 1024, hb + (size_t)row * 1024, p.in[I_NFPOST] + l * 1024, l == 0 ? p.in[I_NMPRE] + 1024 : nullptr, hb + (size_t)row * 1024, lane);
    if (l == 0) grid.sync();
  }
}

extern "C" void kernel_launch(void* const* d_in, const int* in_sizes, int n_in, void* d_out, int out_size,
                              void* d_ws, size_t ws_size, hipStream_t stream) {
  static int grid_blocks = 0;
  if (!grid_blocks) {
    int dev = 0, cus = 0, per_cu = 0;
    hipGetDevice(&dev);
    hipDeviceGetAttribute(&cus, hipDeviceAttributeMultiprocessorCount, dev);
    hipFuncSetAttribute((const void*)fwd, hipFuncAttributeMaxDynamicSharedMemorySize, LDS_BYTES);
    hipOccupancyMaxActiveBlocksPerMultiprocessor(&per_cu, fwd, 256, LDS_BYTES);
    if (per_cu > 2) per_cu = 2;
    if (per_cu < 1) per_cu = 1;
    grid_blocks = cus * per_cu;
  }
  Params p{};
  for (int i = 0; i < 28; ++i) p.in[i] = (const float*)d_in[i];
  p.out = (float*)d_out;
  char* ws = (char*)d_ws;
  size_t off = 0;
  p.z = (bf16_t*)(ws + off); off += (size_t)MT * NIN * 2;
  p.pl = (bf16_t*)(ws + off); off += 7 * PLANE * 2;
  p.wtin = (bf16_t*)(ws + off); off += (size_t)2 * NINP * 1024 * 2;
  p.wtout = (bf16_t*)(ws + off); off += (size_t)2 * 1024 * 1024 * 2;
  p.tabC = (f32x2*)(ws + off); off += (size_t)4096 * 32 * 8;
  p.tabB = (f32x2*)(ws + off); off += (size_t)4096 * 4 * 8;
  p.tabA = (f32x2*)(ws + off); off += (size_t)64 * 16 * 8;
  p.ctr = (int*)(ws + off); off += 256;
  if (off > ws_size) fprintf(stderr, "workspace too small: need %zu have %zu\n", off, ws_size);
  void* args[] = {&p};
  hipError_t e = hipLaunchCooperativeKernel((void*)fwd, dim3(grid_blocks), dim3(256), args, LDS_BYTES, stream);
  if (e != hipSuccess) fprintf(stderr, "coop launch failed: %s (grid %d)\n", hipGetErrorString(e), grid_blocks);
}
```

```cpp
#include <hip/hip_runtime.h>
#include <hip/hip_cooperative_groups.h>
#include <cstdio>
#include <cstdint>
namespace cg = cooperative_groups;

#define DI __device__ __forceinline__
typedef unsigned short bf16_t;
typedef short bf16x8 __attribute__((ext_vector_type(8)));
typedef float f32x2 __attribute__((ext_vector_type(2)));
typedef float f32x4 __attribute__((ext_vector_type(4)));
typedef float f32x16 __attribute__((ext_vector_type(16)));
typedef unsigned u32x2 __attribute__((ext_vector_type(2)));
typedef unsigned u32x4 __attribute__((ext_vector_type(4)));
typedef __bf16 bf16x2_t __attribute__((ext_vector_type(2)));

constexpr int M0 = 32768, MT = 49152, DM = 1024, NIN = 3392, NINP = 3456, DFF = 2816;
constexpr int A_Q = 0, A_K = 256, A_V = 384, B_Q = 512, B_K = 768, B_V = 1024, C_Q = 1280, C_K = 1536, C_V = 1792, C_G = 2048, D_0 = 2304;
constexpr int PITCH = 144;
constexpr size_t PLANE = (size_t)MT * 256;
constexpr int LDS_BYTES = 73728;
constexpr float LOG2E = 1.4426950408889634f;
constexpr float EPS = 1e-6f;

enum { I_XP = 0, I_XS, I_NMPRE, I_NMPOST, I_NFPRE, I_NFPOST, I_WIN, I_WOUT, I_AQG, I_AKG, I_BLAM, I_BSUB, I_CGN, I_DMUP, I_DMUN, I_DW0, I_DWUP,
       I_DA0, I_DAUP, I_DGUP, I_DKK, I_DKA, I_DRK, I_DGNW, I_DGNB, I_FG, I_FU, I_FD };

struct Params {
  const float* in[28];
  float* out;
  bf16_t* z;
  bf16_t* pl;
  bf16_t* wtin;
  bf16_t* wtout;
  f32x2* tabC;
  f32x2* tabB;
  f32x2* tabA;
  int* ctr;
};

DI int opaque(int x) { asm volatile("" : "+v"(x)); return x; }
DI int opaque_s(int x) { asm volatile("" : "+s"(x)); return x; }
DI float bf2f(bf16_t v) { return __uint_as_float(((unsigned)v) << 16); }
DI float bflo(unsigned w) { return __uint_as_float(w << 16); }
DI float bfhi(unsigned w) { return __uint_as_float(w & 0xffff0000u); }
DI unsigned pk(float lo, float hi) { f32x2 v = {lo, hi}; bf16x2_t b = __builtin_convertvector(v, bf16x2_t); return __builtin_bit_cast(unsigned, b); }
DI bf16_t f2bf(float x) { return (bf16_t)(pk(x, 0.f) & 0xffffu); }
DI float dppf(float x, const int ctrl) { return x; }
#define DPPF(x, ctrl) __int_as_float(__builtin_amdgcn_update_dpp(0, __float_as_int(x), (ctrl), 0xF, 0xF, true))
DI float wave_sum(float v) {
  v += DPPF(v, 0xB1);
  v += DPPF(v, 0x4E);
  v += DPPF(v, 0x141);
  v += DPPF(v, 0x140);
  const int vi = __float_as_int(v);
  return (__int_as_float(__builtin_amdgcn_readlane(vi, 0)) + __int_as_float(__builtin_amdgcn_readlane(vi, 16))) +
         (__int_as_float(__builtin_amdgcn_readlane(vi, 32)) + __int_as_float(__builtin_amdgcn_readlane(vi, 48)));
}
DI float dpp_xor1(float x) { return __int_as_float(__builtin_amdgcn_update_dpp(0, __float_as_int(x), 0xB1, 0xF, 0xF, true)); }
DI float dpp_xor2(float x) { return __int_as_float(__builtin_amdgcn_update_dpp(0, __float_as_int(x), 0x4E, 0xF, 0xF, true)); }
DI float dpp_hmir(float x) { return __int_as_float(__builtin_amdgcn_update_dpp(0, __float_as_int(x), 0x141, 0xF, 0xF, true)); }
DI float red8(float x) { x += dpp_xor1(x); x += dpp_xor2(x); x += dpp_hmir(x); return x; }
DI float fexp2(float x) { return __builtin_amdgcn_exp2f(x); }
DI void seq_info(int s, int& row0, int& T) { if (s < 8) { row0 = s * 4096; T = 4096; } else { row0 = M0 + (s - 8) * 2048; T = 2048; } }
DI void row_info(int r, int& t, int& T) { if (r < M0) { t = r & 4095; T = 4096; } else { t = (r - M0) & 2047; T = 2048; } }
#define MFMA32(a, b, c) __builtin_amdgcn_mfma_f32_32x32x16_bf16((a), (b), (c), 0, 0, 0)

DI void conv_T(char* lds, const float* __restrict__ W, int K, int N, bf16_t* __restrict__ Wt, int mode, int tile) {
  float* t = (float*)lds;
  const int tid0 = opaque(threadIdx.x);
  const int ntn = N >> 6, kt = tile / ntn, nt = tile - kt * ntn, k0 = kt << 6, n0 = nt << 6;
#pragma unroll 4
  for (int i = 0; i < 16; ++i) { const int idx = tid0 + 256 * i, k = idx >> 6, n = idx & 63; t[k * 65 + n] = W[(size_t)(k0 + k) * N + n0 + n]; }
  __syncthreads();
#pragma unroll 4
  for (int i = 0; i < 8; ++i) {
    const int idx = tid0 + 256 * i, n = idx >> 5, k = (idx & 31) * 2, j = n0 + n;
    const int rho = (mode == 0) ? j : ((j >> 6) * 128 + ((j >> 5) & 1) * 64 + (mode - 1) * 32 + (j & 31));
    *(unsigned*)(Wt + (size_t)rho * K + k0 + k) = pk(t[k * 65 + n], t[(k + 1) * 65 + n]);
  }
  __syncthreads();
}

DI void row_phase(const float* __restrict__ xin, float* __restrict__ xout, const bf16_t* addsrc, const float* __restrict__ gpost,
                  const float* __restrict__ gpre, bf16_t* hout, int lane_in) {
  const int lane = opaque(lane_in);
  f32x4 x[4];
#pragma unroll
  for (int i = 0; i < 4; ++i) x[i] = *(const f32x4*)(xin + i * 256 + lane * 4);
  if (addsrc) {
    f32x4 m[4]; float ss = 0.f;
#pragma unroll
    for (int i = 0; i < 4; ++i) { const u32x2 w = *(const u32x2*)(addsrc + i * 256 + lane * 4); m[i] = (f32x4){bflo(w.x), bfhi(w.x), bflo(w.y), bfhi(w.y)};
      ss += m[i][0] * m[i][0] + m[i][1] * m[i][1] + m[i][2] * m[i][2] + m[i][3] * m[i][3]; }
    ss = wave_sum(ss); const float rs = rsqrtf(ss * (1.0f / 1024.0f) + EPS);
#pragma unroll
    for (int i = 0; i < 4; ++i) { const f32x4 g = *(const f32x4*)(gpost + i * 256 + lane * 4); x[i] += m[i] * rs * g; }
  }
#pragma unroll
  for (int i = 0; i < 4; ++i) *(f32x4*)(xout + i * 256 + lane * 4) = x[i];
  if (gpre) {
    float ss = 0.f;
#pragma unroll
    for (int i = 0; i < 4; ++i) ss += x[i][0] * x[i][0] + x[i][1] * x[i][1] + x[i][2] * x[i][2] + x[i][3] * x[i][3];
    ss = wave_sum(ss); const float rs = rsqrtf(ss * (1.0f / 1024.0f) + EPS);
#pragma unroll
    for (int i = 0; i < 4; ++i) { const f32x4 g = *(const f32x4*)(gpre + i * 256 + lane * 4); const f32x4 hv = x[i] * rs * g;
      u32x2 w; w.x = pk(hv[0], hv[1]); w.y = pk(hv[2], hv[3]); *(u32x2*)(hout + i * 256 + lane * 4) = w; }
  }
}

struct ASrc { const bf16_t* b0; const bf16_t* b1; const bf16_t* b2; const bf16_t* b3; int s0, s1, s2, s3; int shift; };

struct EpiStore { bf16_t* out; int ldc; int nmax;
  DI void operator()(const f32x16 (&acc)[2][2], int mb, int nb, int n0, int wc, int l31, int h) const {
#pragma unroll
    for (int mf = 0; mf < 2; ++mf) { bf16_t* rp = out + (size_t)(mb + mf * 32 + l31) * ldc;
#pragma unroll
      for (int nf = 0; nf < 2; ++nf) { if (nb + nf * 32 < nmax) {
#pragma unroll
        for (int g = 0; g < 4; ++g) { u32x2 v; v.x = pk(acc[mf][nf][4 * g], acc[mf][nf][4 * g + 1]); v.y = pk(acc[mf][nf][4 * g + 2], acc[mf][nf][4 * g + 3]);
          *(u32x2*)(rp + nb + nf * 32 + 8 * g + 4 * h) = v; } } } }
  } };
struct EpiSwiGLU { bf16_t* out;
  DI void operator()(const f32x16 (&acc)[2][2], int mb, int nb, int n0, int wc, int l31, int h) const {
    const int hc = (n0 >> 7) * 64 + wc * 32;
#pragma unroll
    for (int mf = 0; mf < 2; ++mf) { bf16_t* rp = out + (size_t)(mb + mf * 32 + l31) * DFF + hc;
#pragma unroll
      for (int g = 0; g < 4; ++g) { float r[4];
#pragma unroll
        for (int e = 0; e < 4; ++e) { const float gt = acc[mf][0][4 * g + e], up = acc[mf][1][4 * g + e]; r[e] = gt / (1.0f + __expf(-gt)) * up; }
        u32x2 v; v.x = pk(r[0], r[1]); v.y = pk(r[2], r[3]); *(u32x2*)(rp + 8 * g + 4 * h) = v; } }
  } };

struct EpiIn { bf16_t* z; char* lds; const float* qg; const float* kg; const f32x2* tabA; const f32x2* tabB; const f32x2* tabC;
  DI void operator()(f32x16 (&acc)[2][2], int mb, int nb, int n0, int wc, int l31, int h) const {
    if (nb >= NIN) return;
    const bool isv = (nb >= A_V && nb < B_Q) || (nb >= B_V && nb < C_Q) || (nb >= C_V && nb < C_G);
    if (isv) {
      const int wv = (threadIdx.x >> 6);
      bf16_t* img = (bf16_t*)(lds + wv * 9216);
#pragma unroll
      for (int mf = 0; mf < 2; ++mf)
#pragma unroll
        for (int nf = 0; nf < 2; ++nf)
#pragma unroll
          for (int i = 0; i < 16; ++i) { const int d = nf * 32 + (i & 3) + 8 * (i >> 2) + 4 * h; img[d * 72 + mf * 32 + l31] = f2bf(acc[mf][nf][i]); }
      __builtin_amdgcn_s_waitcnt(0xc07f);
      const int ln = l31 + 32 * h;
#pragma unroll
      for (int i = 0; i < 8; ++i) { const int q = ln + 64 * i, d = q >> 3, c8 = q & 7;
        const u32x4 v = *(const u32x4*)(img + d * 72 + c8 * 8); *(u32x4*)(z + (size_t)(mb + d) * NIN + nb + c8 * 8) = v; }
      return;
    }
#pragma unroll
    for (int mf = 0; mf < 2; ++mf) {
      const int row = mb + mf * 32 + l31; int t, T; row_info(row, t, T);
      if (nb < A_V) {
        const bool isq = nb < A_K; const float* gn = isq ? qg : kg;
        float ss = 0.f;
#pragma unroll
        for (int nf = 0; nf < 2; ++nf)
#pragma unroll
          for (int i = 0; i < 16; ++i) ss += acc[mf][nf][i] * acc[mf][nf][i];
        ss += __shfl_xor(ss, 32);
        const float rs = rsqrtf(ss * (1.0f / 64.0f) + EPS) * (isq ? 0.125f * LOG2E : 1.0f);
#pragma unroll
        for (int nf = 0; nf < 2; ++nf) {
          const int pos = nf == 0 ? (t >> 6) : (t & 63);
#pragma unroll
          for (int g = 0; g < 4; ++g)
#pragma unroll
            for (int e = 0; e < 4; ++e) acc[mf][nf][4 * g + e] *= rs * gn[nf * 32 + 8 * g + 4 * h + e];
#pragma unroll
          for (int g = 0; g < 2; ++g)
#pragma unroll
            for (int e = 0; e < 4; ++e) { const f32x2 cs = tabA[pos * 16 + 8 * g + 4 * h + e];
              const float x1 = acc[mf][nf][4 * g + e], x2 = acc[mf][nf][4 * (g + 2) + e];
              acc[mf][nf][4 * g + e] = x1 * cs.x - x2 * cs.y; acc[mf][nf][4 * (g + 2) + e] = x2 * cs.x + x1 * cs.y; }
        }
      } else if (nb >= B_Q && nb < B_V) {
        const bool isq = nb < B_K;
#pragma unroll
        for (int nf = 0; nf < 2; ++nf) {
#pragma unroll
          for (int e = 0; e < 4; ++e) { const f32x2 cs = tabB[t * 4 + e]; const float v = acc[mf][nf][e]; const float o = __shfl_xor(v, 32);
            acc[mf][nf][e] = (h == 0) ? (v * cs.x - o * cs.y) : (v * cs.x + o * cs.y); }
          if (isq) {
#pragma unroll
            for (int i = 0; i < 16; ++i) acc[mf][nf][i] *= 0.17677669529663687f * LOG2E; }
        }
      } else if (nb >= C_Q && nb < C_V) {
        const float sc = nb < C_K ? 1.0f : 0.125f;
#pragma unroll
        for (int g = 0; g < 4; ++g)
#pragma unroll
          for (int e = 0; e < 4; ++e) { const f32x2 cs = tabC[t * 32 + 8 * g + 4 * h + e]; const float x1 = acc[mf][0][4 * g + e], x2 = acc[mf][1][4 * g + e];
            acc[mf][0][4 * g + e] = (x1 * cs.x - x2 * cs.y) * sc; acc[mf][1][4 * g + e] = (x2 * cs.x + x1 * cs.y) * sc; }
      }
      bf16_t* rp = z + (size_t)row * NIN + nb;
#pragma unroll
      for (int nf = 0; nf < 2; ++nf)
#pragma unroll
        for (int g = 0; g < 4; ++g) { u32x2 v; v.x = pk(acc[mf][nf][4 * g], acc[mf][nf][4 * g + 1]); v.y = pk(acc[mf][nf][4 * g + 2], acc[mf][nf][4 * g + 3]);
          *(u32x2*)(rp + nf * 32 + 8 * g + 4 * h) = v; }
    }
  } };

#define LASP __attribute__((address_space(3)))
template <class Epi>
DI void gemm_tile(char* lds, const ASrc& A, const bf16_t* __restrict__ Bt, int K, int m0, int n0, const Epi& epi) {
  const int tid = opaque(threadIdx.x), lane = tid & 63, w = __builtin_amdgcn_readfirstlane(tid >> 6), wr = w >> 1, wc = w & 1, l31 = lane & 31, h = lane >> 5;
  const int nk = K >> 6, smask = (1 << A.shift) - 1;
  LASP char* ldsl = (LASP char*)lds;
  f32x16 acc[2][2];
#pragma unroll
  for (int a = 0; a < 2; ++a)
#pragma unroll
    for (int b = 0; b < 2; ++b)
#pragma unroll
      for (int i = 0; i < 16; ++i) acc[a][b][i] = 0.f;
  const int lrow = lane >> 3, lslot = lane & 7;
  int goffA[4], goffB[4];
#pragma unroll
  for (int i = 0; i < 4; ++i) { const int r = w * 32 + i * 8 + lrow, c = lslot ^ ((r >> 1) & 7); goffA[i] = r; goffB[i] = (n0 + r) * K + c * 8; goffA[i] = (goffA[i] << 3) | c; }
#define GEMM_ISSUE(kt, st) do { const int k0_ = (kt) << 6, seg_ = k0_ >> A.shift, kk_ = k0_ & smask; \
    const bf16_t* bp_ = seg_ == 0 ? A.b0 : seg_ == 1 ? A.b1 : seg_ == 2 ? A.b2 : A.b3; const int st_ = seg_ == 0 ? A.s0 : seg_ == 1 ? A.s1 : seg_ == 2 ? A.s2 : A.s3; \
    _Pragma("unroll") for (int i_ = 0; i_ < 4; ++i_) { \
      const bf16_t* ga_ = bp_ + (size_t)(m0 + (goffA[i_] >> 3)) * st_ + kk_ + (goffA[i_] & 7) * 8; \
      __builtin_amdgcn_global_load_lds((const unsigned*)ga_, (LASP unsigned*)(ldsl + (st) * 32768 + (w * 4 + i_) * 1024), 16, 0, 0); \
      const bf16_t* gb_ = Bt + (size_t)goffB[i_] + k0_; \
      __builtin_amdgcn_global_load_lds((const unsigned*)gb_, (LASP unsigned*)(ldsl + (st) * 32768 + 16384 + (w * 4 + i_) * 1024), 16, 0, 0); } } while (0)
  const int xr = (l31 >> 1) & 7;
  int coff[4];
#pragma unroll
  for (int s = 0; s < 4; ++s) coff[s] = ((2 * s + h) ^ xr) * 16;
#define GEMM_COMPUTE(st) do { const char* as = lds + (st) * 32768; const char* bs = as + 16384; \
    bf16x8 af[4][2], wf[4][2]; \
    _Pragma("unroll") for (int s = 0; s < 4; ++s) { \
      _Pragma("unroll") for (int mf = 0; mf < 2; ++mf) af[s][mf] = *(const bf16x8*)(as + (wr * 64 + mf * 32 + l31) * 128 + coff[s]); \
      _Pragma("unroll") for (int nf = 0; nf < 2; ++nf) wf[s][nf] = *(const bf16x8*)(bs + (wc * 64 + nf * 32 + l31) * 128 + coff[s]); } \
    __builtin_amdgcn_sched_barrier(0); __builtin_amdgcn_s_setprio(1); \
    _Pragma("unroll") for (int s = 0; s < 4; ++s) \
      _Pragma("unroll") for (int mf = 0; mf < 2; ++mf) _Pragma("unroll") for (int nf = 0; nf < 2; ++nf) acc[mf][nf] = MFMA32(wf[s][nf], af[s][mf], acc[mf][nf]); \
    __builtin_amdgcn_s_setprio(0); __builtin_amdgcn_sched_barrier(0); } while (0)
  GEMM_ISSUE(0, 0);
  for (int kt = 0; kt < nk; kt += 2) {
    asm volatile("s_waitcnt vmcnt(0)" ::: "memory"); __syncthreads();
    GEMM_ISSUE(kt + 1, 1);
    GEMM_COMPUTE(0);
    asm volatile("s_waitcnt vmcnt(0)" ::: "memory"); __syncthreads();
    if (kt + 2 < nk) GEMM_ISSUE(kt + 2, 0);
    GEMM_COMPUTE(1);
  }
  __syncthreads();
  epi(acc, m0 + wr * 64, n0 + wc * 64, n0, wc, l31, h);
  __syncthreads();
#undef GEMM_ISSUE
#undef GEMM_COMPUTE
}

template <class Epi>
DI void gemm_phase(char* lds, const ASrc& A, const bf16_t* Bt, int K, int ntn, const Epi& epi) {
  const int xcd = blockIdx.x & 7, j = blockIdx.x >> 3, nloc = gridDim.x >> 3, per = 48 * ntn, grp = 8 * ntn;
  for (int li = j; li < per; li += nloc) {
    const int sg = li / grp, wi = li - sg * grp, nt = wi >> 3, mt = xcd * 48 + sg * 8 + (wi & 7);
    gemm_tile(lds, A, Bt, K, mt * 128, nt * 128, epi);
  }
}

DI void prep_item(char* lds, const Params& p, int layer, int item) {
  const int tid = opaque(threadIdx.x), lane = tid & 63, w = tid >> 6;
  const int rowb = item * 64; int tb, T; row_info(rowb, tb, T);
  const float* qg = p.in[I_AQG] + layer * 64; const float* kg = p.in[I_AKG] + layer * 64;
  const float qgl = qg[lane], kgl = kg[lane];
  for (int tt = 0; tt < 16; ++tt) {
    const int row = rowb + w * 16 + tt, t = tb + w * 16 + tt;
    bf16_t* zr = p.z + (size_t)row * NIN;
    {
      const int j = lane & 31, i = j & 15; const bool first = j < 16; const int pos = (lane < 32) ? (t >> 6) : (t & 63);
      const f32x2 cs = p.tabA[pos * 16 + i];
#pragma unroll
      for (int hd = 0; hd < 6; ++hd) {
        bf16_t* ptr = zr + (hd < 4 ? A_Q + hd * 64 : A_K + (hd - 4) * 64) + lane;
        float v = bf2f(*ptr);
        const float ss = wave_sum(v * v);
        v = v * rsqrtf(ss * (1.0f / 64.0f) + EPS) * (hd < 4 ? qgl : kgl);
        const float o = __shfl_xor(v, 16);
        float r = first ? (v * cs.x - o * cs.y) : (v * cs.x + o * cs.y);
        if (hd < 4) r *= 0.125f * LOG2E;
        *ptr = f2bf(r);
      }
    }
    {
      const int d = lane & 31; const f32x2 cs = p.tabB[t * 4 + (d & 3)];
#pragma unroll
      for (int c = 0; c < 8; ++c) {
        bf16_t* ptr = zr + (c < 4 ? B_Q + c * 64 : B_K + (c - 4) * 64) + lane;
        float v = bf2f(*ptr);
        const float o = __shfl_xor(v, 4);
        float r = v;
        if (d < 8) r = (d < 4) ? (v * cs.x - o * cs.y) : (v * cs.x + o * cs.y);
        if (c < 4) r *= 0.17677669529663687f * LOG2E;
        *ptr = f2bf(r);
      }
    }
    {
      const f32x2 cs = p.tabC[t * 32 + (lane & 31)];
#pragma unroll
      for (int c = 0; c < 8; ++c) {
        bf16_t* ptr = zr + (c < 4 ? C_Q + c * 64 : C_K + (c - 4) * 64) + lane;
        const float v = bf2f(*ptr);
        const float o = __shfl_xor(v, 32);
        float r = (lane < 32) ? (v * cs.x - o * cs.y) : (v * cs.x + o * cs.y);
        if (c >= 4) r *= 0.125f;
        *ptr = f2bf(r);
      }
    }
  }
  bf16_t* tl = (bf16_t*)lds;
  const int r = tid >> 2, c0 = (tid & 3) * 16;
  for (int sl = 0; sl < 10; ++sl) {
    const int col = sl < 2 ? A_V + sl * 64 : sl < 6 ? B_V + (sl - 2) * 64 : C_V + (sl - 6) * 64;
    bf16_t* gp = p.z + (size_t)(rowb + r) * NIN + col + c0;
    const u32x4 v0 = *(const u32x4*)gp, v1 = *(const u32x4*)(gp + 8);
    __syncthreads();
#pragma unroll
    for (int e = 0; e < 4; ++e) {
      tl[(c0 + 2 * e) * 72 + r] = (bf16_t)(v0[e] & 0xffffu); tl[(c0 + 2 * e + 1) * 72 + r] = (bf16_t)(v0[e] >> 16);
      tl[(c0 + 8 + 2 * e) * 72 + r] = (bf16_t)(v1[e] & 0xffffu); tl[(c0 + 8 + 2 * e + 1) * 72 + r] = (bf16_t)(v1[e] >> 16);
    }
    __syncthreads();
    const u32x4 o0 = *(const u32x4*)(tl + r * 72 + c0), o1 = *(const u32x4*)(tl + r * 72 + c0 + 8);
    *(u32x4*)gp = o0; *(u32x4*)(gp + 8) = o1;
  }
  __syncthreads();
}

DI float dshift(const Params& p, const float* mup, const float* mun, int row, int t, int T, int dc) {
  const bf16_t* zp = p.z + (size_t)row * NIN + D_0 + dc;
  const float z = bf2f(*zp);
  const float zprev = (t > 0) ? bf2f(*(zp - NIN)) : 0.f;
  const float znext = (t < T - 1) ? bf2f(*(zp + NIN)) : 0.f;
  return z + mup[dc] * (zprev - z) + mun[dc] * (znext - z);
}
DI float sigmoidf_(float x) { return 1.0f / (1.0f + __expf(-x)); }
DI float omdecay(float ww) {
  const float y = -ww; const float sp = fmaxf(y, 0.f) + log1pf(__expf(-fabsf(y)));
  return -expm1f(-__expf(-sp - 0.5f));
}
DI void dprep_item(char* lds, const Params& p, int layer, int item) {
  const int tid = opaque(threadIdx.x);
  const int rowb = item * 8; int tb, T; row_info(rowb, tb, T);
  const float* mup = p.in[I_DMUP] + layer * 1088; const float* mun = p.in[I_DMUN] + layer * 1088;
  float* su = (float*)lds;
#pragma unroll
  for (int i = 0; i < 6; ++i) {
    const int idx = tid + 256 * i, tok = idx / 192, c = idx - tok * 192;
    float u = dshift(p, mup, mun, rowb + tok, tb + tok, T, 768 + c);
    if (c < 128) u = tanhf(u);
    su[c * 8 + tok] = u;
  }
  __syncthreads();
  const int c = tid;
  float accf[8], accb[8], acca[8];
#pragma unroll
  for (int k = 0; k < 8; ++k) { accf[k] = 0.f; accb[k] = 0.f; acca[k] = 0.f; }
  const float* wupf = p.in[I_DWUP] + (size_t)(layer * 2 + 0) * 64 * 256 + c;
  const float* wupb = p.in[I_DWUP] + (size_t)(layer * 2 + 1) * 64 * 256 + c;
  const float* aup = p.in[I_DAUP] + (size_t)layer * 64 * 256 + c;
#pragma unroll 4
  for (int j = 0; j < 64; ++j) {
    const float wf = wupf[j * 256], wb = wupb[j * 256], wa = aup[j * 256];
    const f32x4 f0 = *(const f32x4*)(su + j * 8), f1 = *(const f32x4*)(su + j * 8 + 4);
    const f32x4 b0 = *(const f32x4*)(su + (64 + j) * 8), b1 = *(const f32x4*)(su + (64 + j) * 8 + 4);
    const f32x4 a0v = *(const f32x4*)(su + (128 + j) * 8), a1v = *(const f32x4*)(su + (128 + j) * 8 + 4);
#pragma unroll
    for (int k = 0; k < 4; ++k) { accf[k] += f0[k] * wf; accf[4 + k] += f1[k] * wf; accb[k] += b0[k] * wb; accb[4 + k] += b1[k] * wb; acca[k] += a0v[k] * wa; acca[4 + k] += a1v[k] * wa; }
  }
  const float w0f = p.in[I_DW0][(layer * 2 + 0) * 256 + c], w0b = p.in[I_DW0][(layer * 2 + 1) * 256 + c];
  const float a0 = p.in[I_DA0][layer * 256 + c], kkw = p.in[I_DKK][layer * 256 + c], kaw = p.in[I_DKA][layer * 256 + c];
#pragma unroll
  for (int k = 0; k < 8; ++k) {
    const int row = rowb + k, t = tb + k;
    const float r = dshift(p, mup, mun, row, t, T, c), kx = dshift(p, mup, mun, row, t, T, 256 + c), v = dshift(p, mup, mun, row, t, T, 512 + c);
    const float omf = omdecay(w0f + accf[k]), omb = omdecay(w0b + accb[k]);
    const float a = sigmoidf_(a0 + acca[k]);
    float kk = kx * kkw; const float n2 = wave_sum(kk * kk);
    kk = kk / fmaxf(sqrtf(n2), 1e-12f);
    const float kmod = kx * (1.0f + (a - 1.0f) * kaw), b = kk * a;
    bf16_t* so = (bf16_t*)(lds + 8192) + k * 256 + c;
    so[0] = f2bf(r); so[2048] = f2bf(kmod); so[2 * 2048] = f2bf(v); so[3 * 2048] = f2bf(-kk);
    so[4 * 2048] = f2bf(b); so[5 * 2048] = f2bf(omf); so[6 * 2048] = f2bf(omb);
  }
  __syncthreads();
#pragma unroll
  for (int i = 0; i < 7; ++i) {
    const int tok = tid >> 5, c16 = tid & 31;
    const u32x4 v = *(const u32x4*)((bf16_t*)(lds + 8192) + i * 2048 + tok * 256 + c16 * 8);
    *(u32x4*)(p.pl + (size_t)i * PLANE + (size_t)(rowb + tok) * 256 + c16 * 8) = v;
  }
  __syncthreads();
}

DI void dpost_item(char* lds, const Params& p, int layer, int item) {
  const int tid = opaque(threadIdx.x);
  const int rowb = item * 8; int tb, T; row_info(rowb, tb, T);
  const float* mup = p.in[I_DMUP] + layer * 1088; const float* mun = p.in[I_DMUN] + layer * 1088;
  float* sg = (float*)lds;
#pragma unroll
  for (int i = 0; i < 4; ++i) { const int idx = tid + 256 * i, tok = idx >> 7, c = idx & 127; sg[c * 8 + tok] = sigmoidf_(dshift(p, mup, mun, rowb + tok, tb + tok, T, 960 + c)); }
  __syncthreads();
  const int c = tid;
  float acc[8];
#pragma unroll
  for (int k = 0; k < 8; ++k) acc[k] = 0.f;
  const float* gup = p.in[I_DGUP] + (size_t)layer * 128 * 256 + c;
#pragma unroll 4
  for (int j = 0; j < 128; ++j) { const float gw = gup[j * 256];
    const f32x4 s0 = *(const f32x4*)(sg + j * 8), s1 = *(const f32x4*)(sg + j * 8 + 4);
#pragma unroll
    for (int k = 0; k < 4; ++k) { acc[k] += s0[k] * gw; acc[4 + k] += s1[k] * gw; } }
  const float gnw = p.in[I_DGNW][layer * 256 + c], gnb = p.in[I_DGNB][layer * 256 + c], rk = p.in[I_DRK][layer * 256 + c];
#pragma unroll
  for (int k = 0; k < 8; ++k) {
    const int row = rowb + k;
    const bf16_t* zd = p.z + (size_t)row * NIN + D_0;
    const float y = bf2f(zd[c]) + bf2f(zd[256 + c]);
    const float mean = wave_sum(y) * (1.0f / 64.0f); const float d = y - mean; const float var = wave_sum(d * d) * (1.0f / 64.0f);
    const float yn = d * rsqrtf(var + 64e-5f) * gnw + gnb;
    const size_t o = (size_t)row * 256 + c;
    const float r = bf2f(p.pl[o]), km = bf2f(p.pl[PLANE + o]), v = bf2f(p.pl[2 * PLANE + o]);
    const float bonus = wave_sum(r * km * rk);
    ((bf16_t*)(lds + 8192))[k * 256 + c] = f2bf((yn + bonus * v) * acc[k]);
  }
  __syncthreads();
  { const int tok = tid >> 5, c16 = tid & 31;
    const u32x4 v = *(const u32x4*)((bf16_t*)(lds + 8192) + tok * 256 + c16 * 8);
    *(u32x4*)(p.pl + 4 * PLANE + (size_t)(rowb + tok) * 256 + c16 * 8) = v; }
  __syncthreads();
}

DI void rwkv_item(char* lds, const Params& p, int seq, int head, int dir, int half) {
  int row0, T; seq_info(seq, row0, T);
  const int tid = opaque(threadIdx.x), kc = tid & 7, vrow = half * 32 + (tid >> 3);
  float* st = (float*)lds;
  f32x2 S[4];
#pragma unroll
  for (int j = 0; j < 4; ++j) S[j] = (f32x2){0.f, 0.f};
  const int nchunk = T >> 4;
  u32x4 rg[3];
  const int tsel = tid >> 7, srem = tid & 127, sstep = srem >> 3, sc8 = srem & 7;
#define RW_GLOAD(c) do { _Pragma("unroll") for (int i_ = 0; i_ < 3; ++i_) { const int tens_ = tsel + 2 * i_; \
      const int plane_ = tens_ == 0 ? (dir ? 6 : 5) : tens_ == 1 ? 3 : tens_ == 2 ? 4 : tens_ == 3 ? 1 : tens_ == 4 ? 0 : 2; \
      const int t_ = dir ? (T - 1 - ((c) * 16 + sstep)) : ((c) * 16 + sstep); \
      rg[i_] = *(const u32x4*)(p.pl + (size_t)plane_ * PLANE + (size_t)(row0 + t_) * 256 + head * 64 + sc8 * 8); } } while (0)
#define RW_LSTORE(buf) do { _Pragma("unroll") for (int i_ = 0; i_ < 3; ++i_) { const int tens_ = tsel + 2 * i_; \
      f32x4 a_ = {bflo(rg[i_].x), bfhi(rg[i_].x), bflo(rg[i_].y), bfhi(rg[i_].y)}, b_ = {bflo(rg[i_].z), bfhi(rg[i_].z), bflo(rg[i_].w), bfhi(rg[i_].w)}; \
      if (tens_ == 0) { a_ = 1.0f - a_; b_ = 1.0f - b_; } \
      float* d_ = st + (((buf) * 16 + sstep) * 6 + tens_) * 64 + sc8 * 8; *(f32x4*)d_ = a_; *(f32x4*)(d_ + 4) = b_; } } while (0)
  __builtin_amdgcn_s_setprio(3);
  RW_GLOAD(0); RW_LSTORE(0); __syncthreads();
  bf16_t* ybase = p.z + (size_t)row0 * NIN + D_0 + dir * 256 + head * 64 + vrow;
  for (int c = 0; c < nchunk; ++c) {
    if (c + 1 < nchunk) RW_GLOAD(c + 1);
    const float* sb = st + (c & 1) * (16 * 384);
#define RW_FETCH(S_, s_) do { const float* q_ = sb + (s_) * 384 + kc * 8; \
      S_##w0 = *(const f32x4*)(q_); S_##w1 = *(const f32x4*)(q_ + 4); S_##n0 = *(const f32x4*)(q_ + 64); S_##n1 = *(const f32x4*)(q_ + 68); \
      S_##b0 = *(const f32x4*)(q_ + 128); S_##b1 = *(const f32x4*)(q_ + 132); S_##k0 = *(const f32x4*)(q_ + 192); S_##k1 = *(const f32x4*)(q_ + 196); \
      S_##r0 = *(const f32x4*)(q_ + 256); S_##r1 = *(const f32x4*)(q_ + 260); S_##vv = sb[(s_) * 384 + 320 + vrow]; } while (0)
#define LO2(x) ((f32x2){(x)[0], (x)[1]})
#define HI2(x) ((f32x2){(x)[2], (x)[3]})
#define RW_STEP(S_, s_) do { \
      f32x2 a2 = S[0] * LO2(S_##n0); a2 += S[1] * HI2(S_##n0); a2 += S[2] * LO2(S_##n1); a2 += S[3] * HI2(S_##n1); \
      const float sa = red8(a2.x + a2.y); const float vx = S_##vv; \
      S[0] = S[0] * LO2(S_##w0) + (LO2(S_##b0) * sa + LO2(S_##k0) * vx); S[1] = S[1] * HI2(S_##w0) + (HI2(S_##b0) * sa + HI2(S_##k0) * vx); \
      S[2] = S[2] * LO2(S_##w1) + (LO2(S_##b1) * sa + LO2(S_##k1) * vx); S[3] = S[3] * HI2(S_##w1) + (HI2(S_##b1) * sa + HI2(S_##k1) * vx); \
      f32x2 y2 = S[0] * LO2(S_##r0); y2 += S[1] * HI2(S_##r0); y2 += S[2] * LO2(S_##r1); y2 += S[3] * HI2(S_##r1); \
      const float y = red8(y2.x + y2.y); const float yn = DPPF(y, 0x128);     \
      if ((tid & 15) == 0) { const int t_ = dir ? (T - 1 - (c * 16 + (s_))) : (c * 16 + (s_)); *(unsigned*)(ybase + (size_t)t_ * NIN) = pk(y, yn); } } while (0)
    f32x4 Aw0, Aw1, An0, An1, Ab0, Ab1, Ak0, Ak1, Ar0, Ar1; float Avv;
    f32x4 Bw0, Bw1, Bn0, Bn1, Bb0, Bb1, Bk0, Bk1, Br0, Br1; float Bvv;
    RW_FETCH(A, 0);
#pragma unroll 2
    for (int s = 0; s < 16; s += 2) {
      RW_FETCH(B, s + 1);
      RW_STEP(A, s);
      if (s + 2 < 16) RW_FETCH(A, s + 2);
      RW_STEP(B, s + 1);
    }
#undef RW_FETCH
#undef RW_STEP
    if (c + 1 < nchunk) RW_LSTORE((c + 1) & 1);
    __syncthreads();
  }
#undef RW_GLOAD
#undef RW_LSTORE
  __builtin_amdgcn_s_setprio(0);
}

template <int MODE>
DI void attn_item(char* lds, const Params& p, int layer, int seq, int head, int qt) {
  const int tid = opaque(threadIdx.x), lane = tid & 63, w = tid >> 6, l31 = lane & 31, h = lane >> 5;
  layer = opaque_s(layer); seq = opaque_s(seq); head = opaque_s(head); qt = opaque_s(qt);
  int row0, T; seq_info(seq, row0, T);
  const int QC = (MODE == 0 ? A_Q : MODE == 1 ? B_Q : C_Q) + head * 64;
  const int KC = MODE == 0 ? A_K + (head >> 1) * 64 : MODE == 1 ? B_K + head * 64 : C_K + head * 64;
  const int VC = MODE == 0 ? A_V + (head >> 1) * 64 : MODE == 1 ? B_V + head * 64 : C_V + head * 64;
  const int qw0 = qt * 128 + w * 32, qi = qw0 + l31;
  bf16_t* zq = p.z + (size_t)(row0 + qi) * NIN + QC;
  bf16x8 qf[4];
#pragma unroll
  for (int s = 0; s < 4; ++s) qf[s] = *(const bf16x8*)(zq + s * 16 + h * 8);
  const int srow = tid >> 3, sc8 = tid & 7;
  const bf16_t* kbase = p.z + (size_t)(row0 + srow) * NIN + KC + sc8 * 8;
  const bf16_t* vbase = p.z + (size_t)(row0 + srow) * NIN + VC + sc8 * 8;
  u32x4 rk[2][2], rv[2][2];
  const int nt = T >> 6;
  const int prow = (l31 & 19) | ((l31 & 4) << 1) | ((l31 & 8) >> 1);
#define AT_GLOAD(t, S) do { _Pragma("unroll") for (int i_ = 0; i_ < 2; ++i_) { const size_t off_ = (size_t)((t) * 64 + 32 * i_) * NIN; rk[S][i_] = *(const u32x4*)(kbase + off_); rv[S][i_] = *(const u32x4*)(vbase + off_); } } while (0)
#define AT_LSTORE(buf, S) do { char* ks_ = lds + (buf) * 18432; char* vs_ = ks_ + 9216; \
    _Pragma("unroll") for (int i_ = 0; i_ < 2; ++i_) { *(u32x4*)(ks_ + (srow + 32 * i_) * PITCH + sc8 * 16) = rk[S][i_]; *(u32x4*)(vs_ + (srow + 32 * i_) * PITCH + sc8 * 16) = rv[S][i_]; } } while (0)
  constexpr int NMAP = (MODE == 1) ? 2 : 1;
  f32x16 o[NMAP][2];
  float m_run[NMAP], l_run[NMAP];
#pragma unroll
  for (int a = 0; a < NMAP; ++a) { m_run[a] = -INFINITY; l_run[a] = 0.f;
#pragma unroll
    for (int b = 0; b < 2; ++b)
#pragma unroll
      for (int i = 0; i < 16; ++i) o[a][b][i] = 0.f; }
  float lf = 0.f, lb = 0.f;
  if (MODE == 2) { lf = log2f(1.0f - exp2f(-5.0f - (float)head)); lb = log2f(1.0f - exp2f(-5.0f - (float)(3 - head))); }
  auto body = [&](const char* ks, const char* vs, const int t) __attribute__((always_inline)) {
#pragma unroll
    for (int mp = 0; mp < NMAP; ++mp) {
      f32x16 st[2];
#pragma unroll
      for (int kf = 0; kf < 2; ++kf) {
#pragma unroll
        for (int i = 0; i < 16; ++i) st[kf][i] = 0.f;
        if (MODE == 1) {
#pragma unroll
          for (int s = 0; s < 2; ++s) { const bf16x8 kfr = *(const bf16x8*)(ks + (kf * 32 + prow) * PITCH + (mp * 2 + s) * 32 + h * 16); st[kf] = MFMA32(kfr, qf[mp * 2 + s], st[kf]); }
        } else {
#pragma unroll
          for (int s = 0; s < 4; ++s) { const bf16x8 kfr = *(const bf16x8*)(ks + (kf * 32 + prow) * PITCH + s * 32 + h * 16); st[kf] = MFMA32(kfr, qf[s], st[kf]); }
        }
      }
      if (MODE == 2) {
        const int k0 = t * 64;
        const float dbase = (float)(qi - k0 - 8 * h);
        if (k0 + 63 < qw0) {
#pragma unroll
          for (int kf = 0; kf < 2; ++kf)
#pragma unroll
            for (int i = 0; i < 16; ++i) { const float cc = (float)(32 * kf + (i & 3) + 4 * ((i >> 2) & 1) + 16 * ((i >> 3) & 1)); st[kf][i] *= fexp2(lf * (dbase - cc)); }
        } else if (k0 > qw0 + 31) {
#pragma unroll
          for (int kf = 0; kf < 2; ++kf)
#pragma unroll
            for (int i = 0; i < 16; ++i) { const float cc = (float)(32 * kf + (i & 3) + 4 * ((i >> 2) & 1) + 16 * ((i >> 3) & 1)); st[kf][i] *= fexp2(lb * (cc - dbase)); }
        } else {
#pragma unroll
          for (int kf = 0; kf < 2; ++kf)
#pragma unroll
            for (int i = 0; i < 16; ++i) { const float cc = (float)(32 * kf + (i & 3) + 4 * ((i >> 2) & 1) + 16 * ((i >> 3) & 1)); const float d = dbase - cc;
              float dd = fexp2(fminf(lf * d, -lb * d)); if (d == 0.f) dd = 2.0f; st[kf][i] *= dd; }
        }
      } else {
        float mx = st[0][0];
#pragma unroll
        for (int kf = 0; kf < 2; ++kf)
#pragma unroll
          for (int i = 0; i < 16; ++i) mx = fmaxf(mx, st[kf][i]);
        mx = fmaxf(mx, __shfl_xor(mx, 32));
        const float mn = fmaxf(m_run[mp], mx); const float alpha = fexp2(m_run[mp] - mn); m_run[mp] = mn;
        float ps = 0.f;
#pragma unroll
        for (int kf = 0; kf < 2; ++kf)
#pragma unroll
          for (int i = 0; i < 16; ++i) { st[kf][i] = fexp2(st[kf][i] - mn); ps += st[kf][i]; }
        l_run[mp] = l_run[mp] * alpha + ps;
#pragma unroll
        for (int df = 0; df < 2; ++df) o[mp][df] *= alpha;
      }
      bf16x8 pf[4];
#pragma unroll
      for (int kf = 0; kf < 2; ++kf)
#pragma unroll
        for (int s2 = 0; s2 < 2; ++s2) { u32x4 u; u.x = pk(st[kf][8 * s2], st[kf][8 * s2 + 1]); u.y = pk(st[kf][8 * s2 + 2], st[kf][8 * s2 + 3]);
          u.z = pk(st[kf][8 * s2 + 4], st[kf][8 * s2 + 5]); u.w = pk(st[kf][8 * s2 + 6], st[kf][8 * s2 + 7]); pf[kf * 2 + s2] = __builtin_bit_cast(bf16x8, u); }
#pragma unroll
      for (int df = 0; df < 2; ++df)
#pragma unroll
        for (int ksx = 0; ksx < 4; ++ksx) { const bf16x8 vfr = *(const bf16x8*)(vs + (df * 32 + l31) * PITCH + ksx * 32 + h * 16); o[mp][df] = MFMA32(vfr, pf[ksx], o[mp][df]); }
    }
  };
  if constexpr (MODE == 1) {
    AT_GLOAD(0, 0); AT_LSTORE(0, 0); __syncthreads();
#pragma unroll 1
    for (int t = 0; t < nt; ++t) {
      if (t + 1 < nt) AT_GLOAD(t + 1, 0);
      const char* ks = lds + (t & 1) * 18432;
      body(ks, ks + 9216, t);
      if (t + 1 < nt) AT_LSTORE((t + 1) & 1, 0);
      __syncthreads();
    }
  } else {
    AT_GLOAD(0, 0); AT_GLOAD(1, 1); AT_LSTORE(0, 0); __syncthreads();
#pragma unroll 1
    for (int t2 = 0; t2 < nt; t2 += 2) {
      if (t2 + 2 < nt) AT_GLOAD(t2 + 2, 0);
      body(lds, lds + 9216, t2);
      AT_LSTORE(1, 1);
      __syncthreads();
      if (t2 + 3 < nt) AT_GLOAD(t2 + 3, 1);
      body(lds + 18432, lds + 18432 + 9216, t2 + 1);
      if (t2 + 2 < nt) AT_LSTORE(0, 0);
      __syncthreads();
    }
  }
#undef AT_GLOAD
#undef AT_LSTORE
  f32x16 r[2];
  if (MODE == 0) {
    const float l = l_run[0] + __shfl_xor(l_run[0], 32); const float inv = 1.0f / l;
#pragma unroll
    for (int df = 0; df < 2; ++df) r[df] = o[0][df] * inv;
  } else if (MODE == 1) {
    const float* lp = p.in[I_BLAM] + layer * 128;
    float s01 = 0.f, s23 = 0.f;
    for (int i = 0; i < 32; ++i) { s01 += lp[i] * lp[32 + i]; s23 += lp[64 + i] * lp[96 + i]; }
    const float lam_init = 0.8f - 0.6f * expf(-0.3f * (float)layer);
    const float lam = expf(s01) - expf(s23) + lam_init;
    const float l0 = l_run[0] + __shfl_xor(l_run[0], 32), l1 = l_run[NMAP - 1] + __shfl_xor(l_run[NMAP - 1], 32);
    const float i0 = 1.0f / l0, i1 = lam / l1;
    float ss = 0.f;
#pragma unroll
    for (int df = 0; df < 2; ++df) { r[df] = o[0][df] * i0 - o[NMAP - 1][df] * i1;
#pragma unroll
      for (int i = 0; i < 16; ++i) ss += r[df][i] * r[df][i]; }
    ss += __shfl_xor(ss, 32);
    const float rs = rsqrtf(ss * (1.0f / 64.0f) + EPS) * (1.0f - lam_init);
    const float* sg = p.in[I_BSUB] + layer * 64;
#pragma unroll
    for (int df = 0; df < 2; ++df)
#pragma unroll
      for (int i = 0; i < 16; ++i) r[df][i] *= rs * sg[df * 32 + (i & 3) + 8 * (i >> 2) + 4 * h];
  } else {
    float ss = 0.f;
#pragma unroll
    for (int df = 0; df < 2; ++df)
#pragma unroll
      for (int i = 0; i < 16; ++i) ss += o[0][df][i] * o[0][df][i];
    ss += __shfl_xor(ss, 32);
    const float rs = rsqrtf(ss * (1.0f / 64.0f) + EPS);
    const float* gg = p.in[I_CGN] + layer * 256 + head * 64;
    const bf16_t* zg = p.z + (size_t)(row0 + qi) * NIN + C_G + head * 64;
#pragma unroll
    for (int df = 0; df < 2; ++df)
#pragma unroll
      for (int g = 0; g < 4; ++g) { const u32x2 gw = *(const u32x2*)(zg + df * 32 + 8 * g + 4 * h);
        const float gv[4] = {bflo(gw.x), bfhi(gw.x), bflo(gw.y), bfhi(gw.y)};
#pragma unroll
        for (int e = 0; e < 4; ++e) { const float x = gv[e]; r[df][4 * g + e] = o[0][df][4 * g + e] * rs * gg[df * 32 + 8 * g + 4 * h + e] * (x / (1.0f + __expf(-x))); } }
  }
#pragma unroll
  for (int df = 0; df < 2; ++df)
#pragma unroll
    for (int g = 0; g < 4; ++g) { u32x2 v; v.x = pk(r[df][4 * g], r[df][4 * g + 1]); v.y = pk(r[df][4 * g + 2], r[df][4 * g + 3]); *(u32x2*)(zq + df * 32 + 8 * g + 4 * h) = v; }
}

DI int next_item(int* ctr, int* sh) {
  __syncthreads();
  if (threadIdx.x == 0) *sh = atomicAdd(ctr, 1);
  __syncthreads();
  return *sh;
}

__global__ void __launch_bounds__(256, 2) fwd(Params p) {
  extern __shared__ __attribute__((aligned(16))) char lds[];
  __shared__ int s_item;
  cg::grid_group grid = cg::this_grid();
  const int bid = blockIdx.x, nb = gridDim.x, tid = threadIdx.x, lane = tid & 63, w = tid >> 6;
  if (bid == 0 && tid < 64) p.ctr[tid] = 0;
  for (int i = bid * 256 + tid; i < 4096 * 32; i += nb * 256) { const int t = i >> 5, j = i & 31; const float inv = powf(10000.0f, -(float)(2 * j) / 64.0f); float sn, cs; sincosf((float)t * inv, &sn, &cs); p.tabC[i] = (f32x2){cs, sn}; }
  for (int i = bid * 256 + tid; i < 4096 * 4; i += nb * 256) { const int t = i >> 2, j = i & 3; const float inv = powf(500000.0f, -(float)(2 * j) / 8.0f); float sn, cs; sincosf((float)t * inv, &sn, &cs); p.tabB[i] = (f32x2){cs, sn}; }
  for (int i = bid * 256 + tid; i < 64 * 16; i += nb * 256) { const int t = i >> 4, j = i & 15; const float inv = powf(10000.0f, -(float)(2 * j) / 32.0f); float sn, cs; sincosf((float)t * inv, &sn, &cs); p.tabA[i] = (f32x2){cs, sn}; }
  for (int l = 0; l < 2; ++l) {
    for (int i = bid * 256 + tid; i < 64 * 1024; i += nb * 256) p.wtin[(size_t)l * NINP * 1024 + (size_t)NIN * 1024 + i] = 0;
    for (int tl = bid; tl < 16 * 53; tl += nb) conv_T(lds, p.in[I_WIN] + (size_t)l * 1024 * NIN, 1024, NIN, p.wtin + (size_t)l * NINP * 1024, 0, tl);
    for (int tl = bid; tl < 16 * 16; tl += nb) conv_T(lds, p.in[I_WOUT] + (size_t)l * 1024 * 1024, 1024, 1024, p.wtout + (size_t)l * 1024 * 1024, 0, tl);
  }
  bf16_t* hb = p.pl;
  for (int row = bid * 4 + w; row < MT; row += nb * 4) {
    const float* xin = row < M0 ? p.in[I_XP] + (size_t)row * 1024 : p.in[I_XS] + (size_t)(row - M0) * 1024;
    row_phase(xin, p.out + (size_t)row * 1024, nullptr, nullptr, p.in[I_NMPRE], hb + (size_t)row * 1024, lane);
  }
  grid.sync();
  for (int l = 0; l < 2; ++l) {
    { ASrc A; A.b0 = hb; A.b1 = hb; A.b2 = hb; A.b3 = hb; A.s0 = A.s1 = A.s2 = A.s3 = 1024; A.shift = 12;
      EpiIn e; e.z = p.z; e.lds = lds; e.qg = p.in[I_AQG] + l * 64; e.kg = p.in[I_AKG] + l * 64; e.tabA = p.tabA; e.tabB = p.tabB; e.tabC = p.tabC;
      gemm_phase(lds, A, p.wtin + (size_t)l * NINP * 1024, 1024, 27, e); }
    grid.sync();
    for (int it = bid; it < MT / 8; it += nb) dprep_item(lds, p, l, it);
    grid.sync();
    for (;;) {
      const int it = next_item(p.ctr + l * 16, &s_item);
      if (it >= 256 + 4608) break;
      if (it < 256) { const int i2 = it >> 1; const int sq = i2 < 64 ? (i2 >> 3) : 8 + ((i2 - 64) >> 3); rwkv_item(lds, p, sq, (i2 >> 1) & 3, i2 & 1, it & 1); }
      else {
        int j = it - 256, mode, sq, hd, qt;
        if (j < 3072) { mode = j >> 10; const int rem = j & 1023; sq = rem >> 7; hd = (rem >> 5) & 3; qt = rem & 31; }
        else { j -= 3072; mode = j >> 9; const int rem = j & 511; sq = 8 + (rem >> 6); hd = (rem >> 4) & 3; qt = rem & 15; }
        if (mode == 0) attn_item<1>(lds, p, l, sq, hd, qt); else if (mode == 1) attn_item<2>(lds, p, l, sq, hd, qt); else attn_item<0>(lds, p, l, sq, hd, qt);
      }
    }
    grid.sync();
    bf16_t* wtgu = p.pl + 5 * PLANE; bf16_t* wtd = wtgu + (size_t)2 * DFF * 1024;
    for (int it = bid; it < MT / 8 + 3 * 704; it += nb) {
      if (it < MT / 8) dpost_item(lds, p, l, it);
      else { const int j = it - MT / 8;
        if (j < 704) conv_T(lds, p.in[I_FG] + (size_t)l * 1024 * DFF, 1024, DFF, wtgu, 1, j);
        else if (j < 1408) conv_T(lds, p.in[I_FU] + (size_t)l * 1024 * DFF, 1024, DFF, wtgu, 2, j - 704);
        else conv_T(lds, p.in[I_FD] + (size_t)l * DFF * 1024, DFF, 1024, wtd, 0, j - 1408); }
    }
    grid.sync();
    { ASrc A; A.b0 = p.z + A_Q; A.b1 = p.z + B_Q; A.b2 = p.z + C_Q; A.b3 = p.pl + 4 * PLANE; A.s0 = A.s1 = A.s2 = NIN; A.s3 = 256; A.shift = 8;
      EpiStore e; e.out = hb; e.ldc = 1024; e.nmax = 1024;
      gemm_phase(lds, A, p.wtout + (size_t)l * 1024 * 1024, 1024, 8, e); }
    grid.sync();
    for (int row = bid * 4 + w; row < MT; row += nb * 4)
      row_phase(p.out + (size_t)row * 1024, p.out + (size_t)row * 1024, hb + (size_t)row * 1024, p.in[I_NMPOST] + l * 1024, p.in[I_NFPRE] + l * 1024, hb + (size_t)row * 1024, lane);
    grid.sync();
    { ASrc A; A.b0 = hb; A.b1 = hb; A.b2 = hb; A.b3 = hb; A.s0 = A.s1 = A.s2 = A.s3 = 1024; A.shift = 12;
      EpiSwiGLU e; e.out = p.z;
      gemm_phase(lds, A, wtgu, 1024, 44, e); }
    grid.sync();
    { ASrc A; A.b0 = p.z; A.b1 = p.z; A.b2 = p.z; A.b3 = p.z; A.s0 = A.s1 = A.s2 = A.s3 = DFF; A.shift = 12;
      EpiStore e; e.out = hb; e.ldc = 1024; e.nmax = 1024;
      gemm_phase(lds, A, wtd, DFF, 8, e); }
    grid.sync();
    for (int row = bid * 4 + w; row < MT; row += nb * 4)
      row_phase(p.out + (size_t)row * 1024, p.out + (size_t)row * 1024, hb + (size_t)row * 1024, p.in[I_NFPOST] + l * 1024, l == 0 ? p.in[I_NMPRE] + 1024 : nullptr, hb + (size_t)row * 1024, lane);
    if (l == 0) grid.sync();
  }
}

extern "C" void kernel_launch(void* const* d_in, const int* in_sizes, int n_in, void* d_out, int out_size,
                              void* d_ws, size_t ws_size, hipStream_t stream) {
  static int grid_blocks = 0;
  if (!grid_blocks) {
    int dev = 0, cus = 0, per_cu = 0;
    hipGetDevice(&dev);
    hipDeviceGetAttribute(&cus, hipDeviceAttributeMultiprocessorCount, dev);
    hipFuncSetAttribute((const void*)fwd, hipFuncAttributeMaxDynamicSharedMemorySize, LDS_BYTES);
    hipOccupancyMaxActiveBlocksPerMultiprocessor(&per_cu, fwd, 256, LDS_BYTES);
    if (per_cu > 2) per_cu = 2;
    if (per_cu < 1) per_cu = 1;
    grid_blocks = cus * per_cu;
  }
  Params p{};
  for (int i = 0; i < 28; ++i) p.in[i] = (const float*)d_in[i];
  p.out = (float*)d_out;
  char* ws = (char*)d_ws;
  size_t off = 0;
  p.z = (bf16_t*)(ws + off); off += (size_t)MT * NIN * 2;
  p.pl = (bf16_t*)(ws + off); off += 7 * PLANE * 2;
  p.wtin = (bf16_t*)(ws + off); off += (size_t)2 * NINP * 1024 * 2;
  p.wtout = (bf16_t*)(ws + off); off += (size_t)2 * 1024 * 1024 * 2;
  p.tabC = (f32x2*)(ws + off); off += (size_t)4096 * 32 * 8;
  p.tabB = (f32x2*)(ws + off); off += (size_t)4096 * 4 * 8;
  p.tabA = (f32x2*)(ws + off); off += (size_t)64 * 16 * 8;
  p.ctr = (int*)(ws + off); off += 256;
  if (off > ws_size) fprintf(stderr, "workspace too small: need %zu have %zu\n", off, ws_size);
  void* args[] = {&p};
  hipError_t e = hipLaunchCooperativeKernel((void*)fwd, dim3(grid_blocks), dim3(256), args, LDS_BYTES, stream);
  if (e != hipSuccess) fprintf(stderr, "coop launch failed: %s (grid %d)\n", hipGetErrorString(e), grid_blocks);
}
```

```cpp
#include <hip/hip_runtime.h>
#include <hip/hip_cooperative_groups.h>
#include <cstdio>
#include <cstdint>
namespace cg = cooperative_groups;

#define DI __device__ __forceinline__
typedef unsigned short bf16_t;
typedef short bf16x8 __attribute__((ext_vector_type(8)));
typedef float f32x2 __attribute__((ext_vector_type(2)));
typedef float f32x4 __attribute__((ext_vector_type(4)));
typedef float f32x16 __attribute__((ext_vector_type(16)));
typedef unsigned u32x2 __attribute__((ext_vector_type(2)));
typedef unsigned u32x4 __attribute__((ext_vector_type(4)));
typedef __bf16 bf16x2_t __attribute__((ext_vector_type(2)));

constexpr int M0 = 32768, MT = 49152, DM = 1024, NIN = 3392, NINP = 3456, DFF = 2816;
constexpr int A_Q = 0, A_K = 256, A_V = 384, B_Q = 512, B_K = 768, B_V = 1024, C_Q = 1280, C_K = 1536, C_V = 1792, C_G = 2048, D_0 = 2304;
constexpr int PITCH = 144;
constexpr size_t PLANE = (size_t)MT * 256;
constexpr int LDS_BYTES = 73728;
constexpr float LOG2E = 1.4426950408889634f;
constexpr float EPS = 1e-6f;

enum { I_XP = 0, I_XS, I_NMPRE, I_NMPOST, I_NFPRE, I_NFPOST, I_WIN, I_WOUT, I_AQG, I_AKG, I_BLAM, I_BSUB, I_CGN, I_DMUP, I_DMUN, I_DW0, I_DWUP,
       I_DA0, I_DAUP, I_DGUP, I_DKK, I_DKA, I_DRK, I_DGNW, I_DGNB, I_FG, I_FU, I_FD };

struct Params {
  const float* in[28];
  float* out;
  bf16_t* z;
  bf16_t* pl;
  bf16_t* wtin;
  bf16_t* wtout;
  f32x2* tabC;
  f32x2* tabB;
  f32x2* tabA;
  int* ctr;
};

DI int opaque(int x) { asm volatile("" : "+v"(x)); return x; }
DI int opaque_s(int x) { asm volatile("" : "+s"(x)); return x; }
DI float bf2f(bf16_t v) { return __uint_as_float(((unsigned)v) << 16); }
DI float bflo(unsigned w) { return __uint_as_float(w << 16); }
DI float bfhi(unsigned w) { return __uint_as_float(w & 0xffff0000u); }
DI unsigned pk(float lo, float hi) { f32x2 v = {lo, hi}; bf16x2_t b = __builtin_convertvector(v, bf16x2_t); return __builtin_bit_cast(unsigned, b); }
DI bf16_t f2bf(float x) { return (bf16_t)(pk(x, 0.f) & 0xffffu); }
DI float dppf(float x, const int ctrl) { return x; }
#define DPPF(x, ctrl) __int_as_float(__builtin_amdgcn_update_dpp(0, __float_as_int(x), (ctrl), 0xF, 0xF, true))
DI float wave_sum(float v) {
  v += DPPF(v, 0xB1);
  v += DPPF(v, 0x4E);
  v += DPPF(v, 0x141);
  v += DPPF(v, 0x140);
  const int vi = __float_as_int(v);
  return (__int_as_float(__builtin_amdgcn_readlane(vi, 0)) + __int_as_float(__builtin_amdgcn_readlane(vi, 16))) +
         (__int_as_float(__builtin_amdgcn_readlane(vi, 32)) + __int_as_float(__builtin_amdgcn_readlane(vi, 48)));
}
DI float dpp_xor1(float x) { return __int_as_float(__builtin_amdgcn_update_dpp(0, __float_as_int(x), 0xB1, 0xF, 0xF, true)); }
DI float dpp_xor2(float x) { return __int_as_float(__builtin_amdgcn_update_dpp(0, __float_as_int(x), 0x4E, 0xF, 0xF, true)); }
DI float dpp_hmir(float x) { return __int_as_float(__builtin_amdgcn_update_dpp(0, __float_as_int(x), 0x141, 0xF, 0xF, true)); }
DI float red8(float x) { x += dpp_xor1(x); x += dpp_xor2(x); x += dpp_hmir(x); return x; }
DI float fexp2(float x) { return __builtin_amdgcn_exp2f(x); }
DI void seq_info(int s, int& row0, int& T) { if (s < 8) { row0 = s * 4096; T = 4096; } else { row0 = M0 + (s - 8) * 2048; T = 2048; } }
DI void row_info(int r, int& t, int& T) { if (r < M0) { t = r & 4095; T = 4096; } else { t = (r - M0) & 2047; T = 2048; } }
#define MFMA32(a, b, c) __builtin_amdgcn_mfma_f32_32x32x16_bf16((a), (b), (c), 0, 0, 0)

DI void conv_T(char* lds, const float* __restrict__ W, int K, int N, bf16_t* __restrict__ Wt, int mode, int tile) {
  float* t = (float*)lds;
  const int tid0 = opaque(threadIdx.x);
  const int ntn = N >> 6, kt = tile / ntn, nt = tile - kt * ntn, k0 = kt << 6, n0 = nt << 6;
#pragma unroll 4
  for (int i = 0; i < 16; ++i) { const int idx = tid0 + 256 * i, k = idx >> 6, n = idx & 63; t[k * 65 + n] = W[(size_t)(k0 + k) * N + n0 + n]; }
  __syncthreads();
#pragma unroll 4
  for (int i = 0; i < 8; ++i) {
    const int idx = tid0 + 256 * i, n = idx >> 5, k = (idx & 31) * 2, j = n0 + n;
    const int rho = (mode == 0) ? j : ((j >> 6) * 128 + ((j >> 5) & 1) * 64 + (mode - 1) * 32 + (j & 31));
    *(unsigned*)(Wt + (size_t)rho * K + k0 + k) = pk(t[k * 65 + n], t[(k + 1) * 65 + n]);
  }
  __syncthreads();
}

DI void row_phase(const float* __restrict__ xin, float* __restrict__ xout, const bf16_t* addsrc, const float* __restrict__ gpost,
                  const float* __restrict__ gpre, bf16_t* hout, int lane_in) {
  const int lane = opaque(lane_in);
  f32x4 x[4];
#pragma unroll
  for (int i = 0; i < 4; ++i) x[i] = *(const f32x4*)(xin + i * 256 + lane * 4);
  if (addsrc) {
    f32x4 m[4]; float ss = 0.f;
#pragma unroll
    for (int i = 0; i < 4; ++i) { const u32x2 w = *(const u32x2*)(addsrc + i * 256 + lane * 4); m[i] = (f32x4){bflo(w.x), bfhi(w.x), bflo(w.y), bfhi(w.y)};
      ss += m[i][0] * m[i][0] + m[i][1] * m[i][1] + m[i][2] * m[i][2] + m[i][3] * m[i][3]; }
    ss = wave_sum(ss); const float rs = rsqrtf(ss * (1.0f / 1024.0f) + EPS);
#pragma unroll
    for (int i = 0; i < 4; ++i) { const f32x4 g = *(const f32x4*)(gpost + i * 256 + lane * 4); x[i] += m[i] * rs * g; }
  }
#pragma unroll
  for (int i = 0; i < 4; ++i) *(f32x4*)(xout + i * 256 + lane * 4) = x[i];
  if (gpre) {
    float ss = 0.f;
#pragma unroll
    for (int i = 0; i < 4; ++i) ss += x[i][0] * x[i][0] + x[i][1] * x[i][1] + x[i][2] * x[i][2] + x[i][3] * x[i][3];
    ss = wave_sum(ss); const float rs = rsqrtf(ss * (1.0f / 1024.0f) + EPS);
#pragma unroll
    for (int i = 0; i < 4; ++i) { const f32x4 g = *(const f32x4*)(gpre + i * 256 + lane * 4); const f32x4 hv = x[i] * rs * g;
      u32x2 w; w.x = pk(hv[0], hv[1]); w.y = pk(hv[2], hv[3]); *(u32x2*)(hout + i * 256 + lane * 4) = w; }
  }
}

DI void row_phase2(const float* __restrict__ xinA, const float* __restrict__ xinB, float* __restrict__ xoutA, float* __restrict__ xoutB, const bf16_t* addA, const bf16_t* addB,
                   const float* __restrict__ gpost, const float* __restrict__ gpre, bf16_t* houtA, bf16_t* houtB, int lane_in) {
  const int lane = opaque(lane_in);
  f32x4 x[2][4]; u32x2 aw[2][4];
#pragma unroll
  for (int i = 0; i < 4; ++i) { x[0][i] = *(const f32x4*)(xinA + i * 256 + lane * 4); x[1][i] = *(const f32x4*)(xinB + i * 256 + lane * 4); }
  if (addA) {
#pragma unroll
    for (int i = 0; i < 4; ++i) { aw[0][i] = *(const u32x2*)(addA + i * 256 + lane * 4); aw[1][i] = *(const u32x2*)(addB + i * 256 + lane * 4); }
#pragma unroll
    for (int r = 0; r < 2; ++r) {
      f32x4 m[4]; float ss = 0.f;
#pragma unroll
      for (int i = 0; i < 4; ++i) { const u32x2 w = aw[r][i]; m[i] = (f32x4){bflo(w.x), bfhi(w.x), bflo(w.y), bfhi(w.y)};
        ss += m[i][0] * m[i][0] + m[i][1] * m[i][1] + m[i][2] * m[i][2] + m[i][3] * m[i][3]; }
      ss = wave_sum(ss); const float rs = rsqrtf(ss * (1.0f / 1024.0f) + EPS);
#pragma unroll
      for (int i = 0; i < 4; ++i) { const f32x4 g = *(const f32x4*)(gpost + i * 256 + lane * 4); x[r][i] += m[i] * rs * g; }
    }
  }
#pragma unroll
  for (int i = 0; i < 4; ++i) { *(f32x4*)(xoutA + i * 256 + lane * 4) = x[0][i]; *(f32x4*)(xoutB + i * 256 + lane * 4) = x[1][i]; }
  if (gpre) {
#pragma unroll
    for (int r = 0; r < 2; ++r) {
      float ss = 0.f;
#pragma unroll
      for (int i = 0; i < 4; ++i) ss += x[r][i][0] * x[r][i][0] + x[r][i][1] * x[r][i][1] + x[r][i][2] * x[r][i][2] + x[r][i][3] * x[r][i][3];
      ss = wave_sum(ss); const float rs = rsqrtf(ss * (1.0f / 1024.0f) + EPS);
      bf16_t* ho = r == 0 ? houtA : houtB;
#pragma unroll
      for (int i = 0; i < 4; ++i) { const f32x4 g = *(const f32x4*)(gpre + i * 256 + lane * 4); const f32x4 hv = x[r][i] * rs * g;
        u32x2 w; w.x = pk(hv[0], hv[1]); w.y = pk(hv[2], hv[3]); *(u32x2*)(ho + i * 256 + lane * 4) = w; }
    }
  }
}

struct ASrc { const bf16_t* b0; const bf16_t* b1; const bf16_t* b2; const bf16_t* b3; int s0, s1, s2, s3; int shift; };

struct EpiStore { bf16_t* out; int ldc; int nmax;
  DI void operator()(const f32x16 (&acc)[2][2], int mb, int nb, int n0, int wc, int l31, int h) const {
#pragma unroll
    for (int mf = 0; mf < 2; ++mf) { bf16_t* rp = out + (size_t)(mb + mf * 32 + l31) * ldc;
#pragma unroll
      for (int nf = 0; nf < 2; ++nf) { if (nb + nf * 32 < nmax) {
#pragma unroll
        for (int g = 0; g < 4; ++g) { u32x2 v; v.x = pk(acc[mf][nf][4 * g], acc[mf][nf][4 * g + 1]); v.y = pk(acc[mf][nf][4 * g + 2], acc[mf][nf][4 * g + 3]);
          *(u32x2*)(rp + nb + nf * 32 + 8 * g + 4 * h) = v; } } } }
  } };
struct EpiSwiGLU { bf16_t* out;
  DI void operator()(const f32x16 (&acc)[2][2], int mb, int nb, int n0, int wc, int l31, int h) const {
    const int hc = (n0 >> 7) * 64 + wc * 32;
#pragma unroll
    for (int mf = 0; mf < 2; ++mf) { bf16_t* rp = out + (size_t)(mb + mf * 32 + l31) * DFF + hc;
#pragma unroll
      for (int g = 0; g < 4; ++g) { float r[4];
#pragma unroll
        for (int e = 0; e < 4; ++e) { const float gt = acc[mf][0][4 * g + e], up = acc[mf][1][4 * g + e]; r[e] = gt / (1.0f + __expf(-gt)) * up; }
        u32x2 v; v.x = pk(r[0], r[1]); v.y = pk(r[2], r[3]); *(u32x2*)(rp + 8 * g + 4 * h) = v; } }
  } };

struct EpiIn { bf16_t* z; char* lds; const float* qg; const float* kg; const f32x2* tabA; const f32x2* tabB; const f32x2* tabC;
  DI void operator()(f32x16 (&acc)[2][2], int mb, int nb, int n0, int wc, int l31, int h) const {
    if (nb >= NIN) return;
    const bool isv = (nb >= A_V && nb < B_Q) || (nb >= B_V && nb < C_Q) || (nb >= C_V && nb < C_G);
    if (isv) {
      const int wv = (threadIdx.x >> 6);
      bf16_t* img = (bf16_t*)(lds + 32768 + wv * 9216);
#pragma unroll
      for (int mf = 0; mf < 2; ++mf)
#pragma unroll
        for (int nf = 0; nf < 2; ++nf)
#pragma unroll
          for (int i = 0; i < 16; ++i) { const int d = nf * 32 + (i & 3) + 8 * (i >> 2) + 4 * h; img[d * 72 + mf * 32 + l31] = f2bf(acc[mf][nf][i]); }
      __builtin_amdgcn_s_waitcnt(0xc07f);
      const int ln = l31 + 32 * h;
#pragma unroll
      for (int i = 0; i < 8; ++i) { const int q = ln + 64 * i, d = q >> 3, c8 = q & 7;
        const u32x4 v = *(const u32x4*)(img + d * 72 + c8 * 8); *(u32x4*)(z + (size_t)(mb + d) * NIN + nb + c8 * 8) = v; }
      return;
    }
#pragma unroll
    for (int mf = 0; mf < 2; ++mf) {
      const int row = mb + mf * 32 + l31; int t, T; row_info(row, t, T);
      if (nb < A_V) {
        const bool isq = nb < A_K; const float* gn = isq ? qg : kg;
        float ss = 0.f;
#pragma unroll
        for (int nf = 0; nf < 2; ++nf)
#pragma unroll
          for (int i = 0; i < 16; ++i) ss += acc[mf][nf][i] * acc[mf][nf][i];
        ss += __shfl_xor(ss, 32);
        const float rs = rsqrtf(ss * (1.0f / 64.0f) + EPS) * (isq ? 0.125f * LOG2E : 1.0f);
#pragma unroll
        for (int nf = 0; nf < 2; ++nf) {
          const int pos = nf == 0 ? (t >> 6) : (t & 63);
#pragma unroll
          for (int g = 0; g < 4; ++g)
#pragma unroll
            for (int e = 0; e < 4; ++e) acc[mf][nf][4 * g + e] *= rs * gn[nf * 32 + 8 * g + 4 * h + e];
#pragma unroll
          for (int g = 0; g < 2; ++g)
#pragma unroll
            for (int e = 0; e < 4; ++e) { const f32x2 cs = tabA[pos * 16 + 8 * g + 4 * h + e];
              const float x1 = acc[mf][nf][4 * g + e], x2 = acc[mf][nf][4 * (g + 2) + e];
              acc[mf][nf][4 * g + e] = x1 * cs.x - x2 * cs.y; acc[mf][nf][4 * (g + 2) + e] = x2 * cs.x + x1 * cs.y; }
        }
      } else if (nb >= B_Q && nb < B_V) {
        const bool isq = nb < B_K;
#pragma unroll
        for (int nf = 0; nf < 2; ++nf) {
#pragma unroll
          for (int e = 0; e < 4; ++e) { const f32x2 cs = tabB[t * 4 + e]; const float v = acc[mf][nf][e]; const float o = __shfl_xor(v, 32);
            acc[mf][nf][e] = (h == 0) ? (v * cs.x - o * cs.y) : (v * cs.x + o * cs.y); }
          if (isq) {
#pragma unroll
            for (int i = 0; i < 16; ++i) acc[mf][nf][i] *= 0.17677669529663687f * LOG2E; }
        }
      } else if (nb >= C_Q && nb < C_V) {
        const float sc = nb < C_K ? 1.0f : 0.125f;
#pragma unroll
        for (int g = 0; g < 4; ++g)
#pragma unroll
          for (int e = 0; e < 4; ++e) { const f32x2 cs = tabC[t * 32 + 8 * g + 4 * h + e]; const float x1 = acc[mf][0][4 * g + e], x2 = acc[mf][1][4 * g + e];
            acc[mf][0][4 * g + e] = (x1 * cs.x - x2 * cs.y) * sc; acc[mf][1][4 * g + e] = (x2 * cs.x + x1 * cs.y) * sc; }
      }
      bf16_t* rp = z + (size_t)row * NIN + nb;
#pragma unroll
      for (int nf = 0; nf < 2; ++nf)
#pragma unroll
        for (int g = 0; g < 4; ++g) { u32x2 v; v.x = pk(acc[mf][nf][4 * g], acc[mf][nf][4 * g + 1]); v.y = pk(acc[mf][nf][4 * g + 2], acc[mf][nf][4 * g + 3]);
          *(u32x2*)(rp + nf * 32 + 8 * g + 4 * h) = v; }
    }
  } };

#define LASP __attribute__((address_space(3)))
template <class Epi>
DI void gemm_tile(char* lds, const ASrc& A, const bf16_t* __restrict__ Bt, int K, int m0, int n0, const Epi& epi, bool first, bool has_next, int m0n, int n0n) {
  const int tid = opaque(threadIdx.x), lane = tid & 63, w = __builtin_amdgcn_readfirstlane(tid >> 6), wr = w >> 1, wc = w & 1, l31 = lane & 31, h = lane >> 5;
  const int nk = K >> 6, smask = (1 << A.shift) - 1;
  LASP char* ldsl = (LASP char*)lds;
  f32x16 acc[2][2];
#pragma unroll
  for (int a = 0; a < 2; ++a)
#pragma unroll
    for (int b = 0; b < 2; ++b)
#pragma unroll
      for (int i = 0; i < 16; ++i) acc[a][b][i] = 0.f;
  const int lrow = lane >> 3, lslot = lane & 7;
  int goffA[4], goffB[4];
#pragma unroll
  for (int i = 0; i < 4; ++i) { const int r = w * 32 + i * 8 + lrow, c = lslot ^ ((r >> 1) & 7); goffA[i] = r; goffB[i] = r * K + c * 8; goffA[i] = (goffA[i] << 3) | c; }
#define GEMM_ISSUE(kt, st, M0_, N0_) do { const int k0_ = (kt) << 6, seg_ = k0_ >> A.shift, kk_ = k0_ & smask; \
    const bf16_t* bp_ = seg_ == 0 ? A.b0 : seg_ == 1 ? A.b1 : seg_ == 2 ? A.b2 : A.b3; const int st_ = seg_ == 0 ? A.s0 : seg_ == 1 ? A.s1 : seg_ == 2 ? A.s2 : A.s3; \
    _Pragma("unroll") for (int i_ = 0; i_ < 4; ++i_) { \
      const bf16_t* ga_ = bp_ + (size_t)((M0_) + (goffA[i_] >> 3)) * st_ + kk_ + (goffA[i_] & 7) * 8; \
      __builtin_amdgcn_global_load_lds((const unsigned*)ga_, (LASP unsigned*)(ldsl + (st) * 32768 + (w * 4 + i_) * 1024), 16, 0, 0); \
      const bf16_t* gb_ = Bt + (size_t)(N0_) * K + goffB[i_] + k0_; \
      __builtin_amdgcn_global_load_lds((const unsigned*)gb_, (LASP unsigned*)(ldsl + (st) * 32768 + 16384 + (w * 4 + i_) * 1024), 16, 0, 0); } } while (0)
  const int xr = (l31 >> 1) & 7;
  int coff[4];
#pragma unroll
  for (int s = 0; s < 4; ++s) coff[s] = ((2 * s + h) ^ xr) * 16;
#define GEMM_COMPUTE(st) do { const char* as = lds + (st) * 32768; const char* bs = as + 16384; \
    bf16x8 af[4][2], wf[4][2]; \
    _Pragma("unroll") for (int s = 0; s < 4; ++s) { \
      _Pragma("unroll") for (int mf = 0; mf < 2; ++mf) af[s][mf] = *(const bf16x8*)(as + (wr * 64 + mf * 32 + l31) * 128 + coff[s]); \
      _Pragma("unroll") for (int nf = 0; nf < 2; ++nf) wf[s][nf] = *(const bf16x8*)(bs + (wc * 64 + nf * 32 + l31) * 128 + coff[s]); } \
    __builtin_amdgcn_sched_barrier(0); __builtin_amdgcn_s_setprio(1); \
    _Pragma("unroll") for (int s = 0; s < 4; ++s) \
      _Pragma("unroll") for (int mf = 0; mf < 2; ++mf) _Pragma("unroll") for (int nf = 0; nf < 2; ++nf) acc[mf][nf] = MFMA32(wf[s][nf], af[s][mf], acc[mf][nf]); \
    __builtin_amdgcn_s_setprio(0); __builtin_amdgcn_sched_barrier(0); } while (0)
  if (first) GEMM_ISSUE(0, 0, m0, n0);
  for (int kt = 0; kt < nk; kt += 2) {
    asm volatile("s_waitcnt vmcnt(0)" ::: "memory"); __syncthreads();
    GEMM_ISSUE(kt + 1, 1, m0, n0);
    GEMM_COMPUTE(0);
    asm volatile("s_waitcnt vmcnt(0)" ::: "memory"); __syncthreads();
    if (kt + 2 < nk) GEMM_ISSUE(kt + 2, 0, m0, n0);
    GEMM_COMPUTE(1);
  }
  __syncthreads();
  if (has_next) GEMM_ISSUE(0, 0, m0n, n0n);
  epi(acc, m0 + wr * 64, n0 + wc * 64, n0, wc, l31, h);
  __syncthreads();
#undef GEMM_ISSUE
#undef GEMM_COMPUTE
}

template <class Epi>
DI void gemm_phase(char* lds, const ASrc& A, const bf16_t* Bt, int K, int ntn, const Epi& epi) {
  const int xcd = blockIdx.x & 7, j = blockIdx.x >> 3, nloc = gridDim.x >> 3, per = 48 * ntn, grp = 8 * ntn;
  bool first = true;
  for (int li = j; li < per; li += nloc) {
    const int sg = li / grp, wi = li - sg * grp, nt = wi >> 3, mt = xcd * 48 + sg * 8 + (wi & 7);
    const int ln = li + nloc; const bool has_next = ln < per;
    const int sgn = ln / grp, win = ln - sgn * grp, ntn2 = win >> 3, mtn = xcd * 48 + sgn * 8 + (win & 7);
    gemm_tile(lds, A, Bt, K, mt * 128, nt * 128, epi, first, has_next, mtn * 128, ntn2 * 128);
    first = false;
  }
}

DI void prep_item(char* lds, const Params& p, int layer, int item) {
  const int tid = opaque(threadIdx.x), lane = tid & 63, w = tid >> 6;
  const int rowb = item * 64; int tb, T; row_info(rowb, tb, T);
  const float* qg = p.in[I_AQG] + layer * 64; const float* kg = p.in[I_AKG] + layer * 64;
  const float qgl = qg[lane], kgl = kg[lane];
  for (int tt = 0; tt < 16; ++tt) {
    const int row = rowb + w * 16 + tt, t = tb + w * 16 + tt;
    bf16_t* zr = p.z + (size_t)row * NIN;
    {
      const int j = lane & 31, i = j & 15; const bool first = j < 16; const int pos = (lane < 32) ? (t >> 6) : (t & 63);
      const f32x2 cs = p.tabA[pos * 16 + i];
#pragma unroll
      for (int hd = 0; hd < 6; ++hd) {
        bf16_t* ptr = zr + (hd < 4 ? A_Q + hd * 64 : A_K + (hd - 4) * 64) + lane;
        float v = bf2f(*ptr);
        const float ss = wave_sum(v * v);
        v = v * rsqrtf(ss * (1.0f / 64.0f) + EPS) * (hd < 4 ? qgl : kgl);
        const float o = __shfl_xor(v, 16);
        float r = first ? (v * cs.x - o * cs.y) : (v * cs.x + o * cs.y);
        if (hd < 4) r *= 0.125f * LOG2E;
        *ptr = f2bf(r);
      }
    }
    {
      const int d = lane & 31; const f32x2 cs = p.tabB[t * 4 + (d & 3)];
#pragma unroll
      for (int c = 0; c < 8; ++c) {
        bf16_t* ptr = zr + (c < 4 ? B_Q + c * 64 : B_K + (c - 4) * 64) + lane;
        float v = bf2f(*ptr);
        const float o = __shfl_xor(v, 4);
        float r = v;
        if (d < 8) r = (d < 4) ? (v * cs.x - o * cs.y) : (v * cs.x + o * cs.y);
        if (c < 4) r *= 0.17677669529663687f * LOG2E;
        *ptr = f2bf(r);
      }
    }
    {
      const f32x2 cs = p.tabC[t * 32 + (lane & 31)];
#pragma unroll
      for (int c = 0; c < 8; ++c) {
        bf16_t* ptr = zr + (c < 4 ? C_Q + c * 64 : C_K + (c - 4) * 64) + lane;
        const float v = bf2f(*ptr);
        const float o = __shfl_xor(v, 32);
        float r = (lane < 32) ? (v * cs.x - o * cs.y) : (v * cs.x + o * cs.y);
        if (c >= 4) r *= 0.125f;
        *ptr = f2bf(r);
      }
    }
  }
  bf16_t* tl = (bf16_t*)lds;
  const int r = tid >> 2, c0 = (tid & 3) * 16;
  for (int sl = 0; sl < 10; ++sl) {
    const int col = sl < 2 ? A_V + sl * 64 : sl < 6 ? B_V + (sl - 2) * 64 : C_V + (sl - 6) * 64;
    bf16_t* gp = p.z + (size_t)(rowb + r) * NIN + col + c0;
    const u32x4 v0 = *(const u32x4*)gp, v1 = *(const u32x4*)(gp + 8);
    __syncthreads();
#pragma unroll
    for (int e = 0; e < 4; ++e) {
      tl[(c0 + 2 * e) * 72 + r] = (bf16_t)(v0[e] & 0xffffu); tl[(c0 + 2 * e + 1) * 72 + r] = (bf16_t)(v0[e] >> 16);
      tl[(c0 + 8 + 2 * e) * 72 + r] = (bf16_t)(v1[e] & 0xffffu); tl[(c0 + 8 + 2 * e + 1) * 72 + r] = (bf16_t)(v1[e] >> 16);
    }
    __syncthreads();
    const u32x4 o0 = *(const u32x4*)(tl + r * 72 + c0), o1 = *(const u32x4*)(tl + r * 72 + c0 + 8);
    *(u32x4*)gp = o0; *(u32x4*)(gp + 8) = o1;
  }
  __syncthreads();
}

DI float dshift(const Params& p, const float* mup, const float* mun, int row, int t, int T, int dc) {
  const bf16_t* zp = p.z + (size_t)row * NIN + D_0 + dc;
  const float z = bf2f(*zp);
  const float zprev = (t > 0) ? bf2f(*(zp - NIN)) : 0.f;
  const float znext = (t < T - 1) ? bf2f(*(zp + NIN)) : 0.f;
  return z + mup[dc] * (zprev - z) + mun[dc] * (znext - z);
}
DI float sigmoidf_(float x) { return 1.0f / (1.0f + __expf(-x)); }
DI float omdecay(float ww) {
  const float e = 0.6065306597126334f / (1.0f + __expf(-ww));
  return 1.0f - __expf(-e);
}
DI float fast_tanh(float x) { const float xc = fminf(fmaxf(x, -15.f), 15.f); return 1.0f - 2.0f / (1.0f + __expf(2.0f * xc)); }
DI void dprep_item(char* lds, const Params& p, int layer, int item) {
  const int tid = opaque(threadIdx.x);
  const int rowb = item * 8; int tb, T; row_info(rowb, tb, T);
  const float* mup = p.in[I_DMUP] + layer * 1088; const float* mun = p.in[I_DMUN] + layer * 1088;
  float* su = (float*)lds;
#pragma unroll
  for (int i = 0; i < 6; ++i) {
    const int idx = tid + 256 * i, tok = idx / 192, c = idx - tok * 192;
    float u = dshift(p, mup, mun, rowb + tok, tb + tok, T, 768 + c);
    if (c < 128) u = fast_tanh(u);
    su[c * 8 + tok] = u;
  }
  __syncthreads();
  const int c = tid;
  float accf[8], accb[8], acca[8];
#pragma unroll
  for (int k = 0; k < 8; ++k) { accf[k] = 0.f; accb[k] = 0.f; acca[k] = 0.f; }
  const float* wupf = p.in[I_DWUP] + (size_t)(layer * 2 + 0) * 64 * 256 + c;
  const float* wupb = p.in[I_DWUP] + (size_t)(layer * 2 + 1) * 64 * 256 + c;
  const float* aup = p.in[I_DAUP] + (size_t)layer * 64 * 256 + c;
#pragma unroll 4
  for (int j = 0; j < 64; ++j) {
    const float wf = wupf[j * 256], wb = wupb[j * 256], wa = aup[j * 256];
    const f32x4 f0 = *(const f32x4*)(su + j * 8), f1 = *(const f32x4*)(su + j * 8 + 4);
    const f32x4 b0 = *(const f32x4*)(su + (64 + j) * 8), b1 = *(const f32x4*)(su + (64 + j) * 8 + 4);
    const f32x4 a0v = *(const f32x4*)(su + (128 + j) * 8), a1v = *(const f32x4*)(su + (128 + j) * 8 + 4);
#pragma unroll
    for (int k = 0; k < 4; ++k) { accf[k] += f0[k] * wf; accf[4 + k] += f1[k] * wf; accb[k] += b0[k] * wb; accb[4 + k] += b1[k] * wb; acca[k] += a0v[k] * wa; acca[4 + k] += a1v[k] * wa; }
  }
  const float w0f = p.in[I_DW0][(layer * 2 + 0) * 256 + c], w0b = p.in[I_DW0][(layer * 2 + 1) * 256 + c];
  const float a0 = p.in[I_DA0][layer * 256 + c], kkw = p.in[I_DKK][layer * 256 + c], kaw = p.in[I_DKA][layer * 256 + c];
  float zr[10], zk[10], zv[10];
  { const bf16_t* zp = p.z + (size_t)rowb * NIN + D_0 + c;
#pragma unroll
    for (int i = 0; i < 10; ++i) { const int t = tb - 1 + i; const bool ok = (t >= 0) && (t < T); const bf16_t* q = zp + (ptrdiff_t)(i - 1) * NIN;
      zr[i] = ok ? bf2f(q[0]) : 0.f; zk[i] = ok ? bf2f(q[256]) : 0.f; zv[i] = ok ? bf2f(q[512]) : 0.f; } }
  const float mpr = mup[c], mnr = mun[c], mpk = mup[256 + c], mnk = mun[256 + c], mpv = mup[512 + c], mnv = mun[512 + c];
#pragma unroll
  for (int k = 0; k < 8; ++k) {
    const int row = rowb + k;
    const float r = zr[k + 1] + mpr * (zr[k] - zr[k + 1]) + mnr * (zr[k + 2] - zr[k + 1]);
    const float kx = zk[k + 1] + mpk * (zk[k] - zk[k + 1]) + mnk * (zk[k + 2] - zk[k + 1]);
    const float v = zv[k + 1] + mpv * (zv[k] - zv[k + 1]) + mnv * (zv[k + 2] - zv[k + 1]);
    const float omf = omdecay(w0f + accf[k]), omb = omdecay(w0b + accb[k]);
    const float a = sigmoidf_(a0 + acca[k]);
    float kk = kx * kkw; const float n2 = wave_sum(kk * kk);
    kk = kk * rsqrtf(fmaxf(n2, 1e-24f));
    const float kmod = kx * (1.0f + (a - 1.0f) * kaw), b = kk * a;
    bf16_t* so = (bf16_t*)(lds + 8192) + k * 256 + c;
    so[0] = f2bf(r); so[2048] = f2bf(kmod); so[2 * 2048] = f2bf(v); so[3 * 2048] = f2bf(-kk);
    so[4 * 2048] = f2bf(b); so[5 * 2048] = f2bf(omf); so[6 * 2048] = f2bf(omb);
  }
  __syncthreads();
#pragma unroll
  for (int i = 0; i < 7; ++i) {
    const int tok = tid >> 5, c16 = tid & 31;
    const u32x4 v = *(const u32x4*)((bf16_t*)(lds + 8192) + i * 2048 + tok * 256 + c16 * 8);
    *(u32x4*)(p.pl + (size_t)i * PLANE + (size_t)(rowb + tok) * 256 + c16 * 8) = v;
  }
  __syncthreads();
}

DI void dpost_item(char* lds, const Params& p, int layer, int item) {
  const int tid = opaque(threadIdx.x);
  const int rowb = item * 8; int tb, T; row_info(rowb, tb, T);
  const float* mup = p.in[I_DMUP] + layer * 1088; const float* mun = p.in[I_DMUN] + layer * 1088;
  float* sg = (float*)lds;
#pragma unroll
  for (int i = 0; i < 4; ++i) { const int idx = tid + 256 * i, tok = idx >> 7, c = idx & 127; sg[c * 8 + tok] = sigmoidf_(dshift(p, mup, mun, rowb + tok, tb + tok, T, 960 + c)); }
  __syncthreads();
  const int c = tid;
  float acc[8];
#pragma unroll
  for (int k = 0; k < 8; ++k) acc[k] = 0.f;
  const float* gup = p.in[I_DGUP] + (size_t)layer * 128 * 256 + c;
#pragma unroll 4
  for (int j = 0; j < 128; ++j) { const float gw = gup[j * 256];
    const f32x4 s0 = *(const f32x4*)(sg + j * 8), s1 = *(const f32x4*)(sg + j * 8 + 4);
#pragma unroll
    for (int k = 0; k < 4; ++k) { acc[k] += s0[k] * gw; acc[4 + k] += s1[k] * gw; } }
  const float gnw = p.in[I_DGNW][layer * 256 + c], gnb = p.in[I_DGNB][layer * 256 + c], rk = p.in[I_DRK][layer * 256 + c];
#pragma unroll
  for (int k = 0; k < 8; ++k) {
    const int row = rowb + k;
    const bf16_t* zd = p.z + (size_t)row * NIN + D_0;
    const float y = bf2f(zd[c]) + bf2f(zd[256 + c]);
    const float mean = wave_sum(y) * (1.0f / 64.0f); const float d = y - mean; const float var = wave_sum(d * d) * (1.0f / 64.0f);
    const float yn = d * rsqrtf(var + 64e-5f) * gnw + gnb;
    const size_t o = (size_t)row * 256 + c;
    const float r = bf2f(p.pl[o]), km = bf2f(p.pl[PLANE + o]), v = bf2f(p.pl[2 * PLANE + o]);
    const float bonus = wave_sum(r * km * rk);
    ((bf16_t*)(lds + 8192))[k * 256 + c] = f2bf((yn + bonus * v) * acc[k]);
  }
  __syncthreads();
  { const int tok = tid >> 5, c16 = tid & 31;
    const u32x4 v = *(const u32x4*)((bf16_t*)(lds + 8192) + tok * 256 + c16 * 8);
    *(u32x4*)(p.pl + 4 * PLANE + (size_t)(rowb + tok) * 256 + c16 * 8) = v; }
  __syncthreads();
}

DI void rwkv_item(char* lds, const Params& p, int seq, int head, int dir, int half) {
  int row0, T; seq_info(seq, row0, T);
  const int tid = opaque(threadIdx.x), kc = tid & 7, vrow = half * 32 + (tid >> 3);
  float* st = (float*)lds;
  f32x2 S[4];
#pragma unroll
  for (int j = 0; j < 4; ++j) S[j] = (f32x2){0.f, 0.f};
  const int nchunk = T >> 4;
  u32x4 rg[3];
  const int tsel = tid >> 7, srem = tid & 127, sstep = srem >> 3, sc8 = srem & 7;
#define RW_GLOAD(c) do { _Pragma("unroll") for (int i_ = 0; i_ < 3; ++i_) { const int tens_ = tsel + 2 * i_; \
      const int plane_ = tens_ == 0 ? (dir ? 6 : 5) : tens_ == 1 ? 3 : tens_ == 2 ? 4 : tens_ == 3 ? 1 : tens_ == 4 ? 0 : 2; \
      const int t_ = dir ? (T - 1 - ((c) * 16 + sstep)) : ((c) * 16 + sstep); \
      rg[i_] = *(const u32x4*)(p.pl + (size_t)plane_ * PLANE + (size_t)(row0 + t_) * 256 + head * 64 + sc8 * 8); } } while (0)
#define RW_LSTORE(buf) do { _Pragma("unroll") for (int i_ = 0; i_ < 3; ++i_) { const int tens_ = tsel + 2 * i_; \
      f32x4 a_ = {bflo(rg[i_].x), bfhi(rg[i_].x), bflo(rg[i_].y), bfhi(rg[i_].y)}, b_ = {bflo(rg[i_].z), bfhi(rg[i_].z), bflo(rg[i_].w), bfhi(rg[i_].w)}; \
      if (tens_ == 0) { a_ = 1.0f - a_; b_ = 1.0f - b_; } \
      float* d_ = st + (((buf) * 16 + sstep) * 6 + tens_) * 64 + sc8 * 8; *(f32x4*)d_ = a_; *(f32x4*)(d_ + 4) = b_; } } while (0)
  __builtin_amdgcn_s_setprio(3);
  RW_GLOAD(0); RW_LSTORE(0); __syncthreads();
  bf16_t* ybase = p.z + (size_t)row0 * NIN + D_0 + dir * 256 + head * 64 + vrow;
  for (int c = 0; c < nchunk; ++c) {
    if (c + 1 < nchunk) RW_GLOAD(c + 1);
    const float* sb = st + (c & 1) * (16 * 384);
#define RW_FETCH(S_, s_) do { const float* q_ = sb + (s_) * 384 + kc * 8; \
      S_##w0 = *(const f32x4*)(q_); S_##w1 = *(const f32x4*)(q_ + 4); S_##n0 = *(const f32x4*)(q_ + 64); S_##n1 = *(const f32x4*)(q_ + 68); \
      S_##b0 = *(const f32x4*)(q_ + 128); S_##b1 = *(const f32x4*)(q_ + 132); S_##k0 = *(const f32x4*)(q_ + 192); S_##k1 = *(const f32x4*)(q_ + 196); \
      S_##r0 = *(const f32x4*)(q_ + 256); S_##r1 = *(const f32x4*)(q_ + 260); S_##vv = sb[(s_) * 384 + 320 + vrow]; } while (0)
#define LO2(x) ((f32x2){(x)[0], (x)[1]})
#define HI2(x) ((f32x2){(x)[2], (x)[3]})
#define RW_STEP(S_, s_) do { \
      f32x2 a2 = S[0] * LO2(S_##n0); a2 += S[1] * HI2(S_##n0); a2 += S[2] * LO2(S_##n1); a2 += S[3] * HI2(S_##n1); \
      const float sa = red8(a2.x + a2.y); const float vx = S_##vv; \
      S[0] = S[0] * LO2(S_##w0) + (LO2(S_##b0) * sa + LO2(S_##k0) * vx); S[1] = S[1] * HI2(S_##w0) + (HI2(S_##b0) * sa + HI2(S_##k0) * vx); \
      S[2] = S[2] * LO2(S_##w1) + (LO2(S_##b1) * sa + LO2(S_##k1) * vx); S[3] = S[3] * HI2(S_##w1) + (HI2(S_##b1) * sa + HI2(S_##k1) * vx); \
      f32x2 y2 = S[0] * LO2(S_##r0); y2 += S[1] * HI2(S_##r0); y2 += S[2] * LO2(S_##r1); y2 += S[3] * HI2(S_##r1); \
      const float y = red8(y2.x + y2.y); const float yn = DPPF(y, 0x128);     \
      if ((tid & 15) == 0) { const int t_ = dir ? (T - 1 - (c * 16 + (s_))) : (c * 16 + (s_)); *(unsigned*)(ybase + (size_t)t_ * NIN) = pk(y, yn); } } while (0)
    f32x4 Aw0, Aw1, An0, An1, Ab0, Ab1, Ak0, Ak1, Ar0, Ar1; float Avv;
    f32x4 Bw0, Bw1, Bn0, Bn1, Bb0, Bb1, Bk0, Bk1, Br0, Br1; float Bvv;
    RW_FETCH(A, 0);
#pragma unroll 2
    for (int s = 0; s < 16; s += 2) {
      RW_FETCH(B, s + 1);
      RW_STEP(A, s);
      if (s + 2 < 16) RW_FETCH(A, s + 2);
      RW_STEP(B, s + 1);
    }
#undef RW_FETCH
#undef RW_STEP
    if (c + 1 < nchunk) RW_LSTORE((c + 1) & 1);
    __syncthreads();
  }
#undef RW_GLOAD
#undef RW_LSTORE
  __builtin_amdgcn_s_setprio(0);
}

template <int MODE>
DI void attn_item(char* lds, const Params& p, int layer, int seq, int head, int qt) {
  const int tid = opaque(threadIdx.x), lane = tid & 63, w = tid >> 6, l31 = lane & 31, h = lane >> 5;
  layer = opaque_s(layer); seq = opaque_s(seq); head = opaque_s(head); qt = opaque_s(qt);
  int row0, T; seq_info(seq, row0, T);
  const int QC = (MODE == 0 ? A_Q : MODE == 1 ? B_Q : C_Q) + head * 64;
  const int KC = MODE == 0 ? A_K + (head >> 1) * 64 : MODE == 1 ? B_K + head * 64 : C_K + head * 64;
  const int VC = MODE == 0 ? A_V + (head >> 1) * 64 : MODE == 1 ? B_V + head * 64 : C_V + head * 64;
  const int qw0 = qt * 128 + w * 32, qi = qw0 + l31;
  bf16_t* zq = p.z + (size_t)(row0 + qi) * NIN + QC;
  bf16x8 qf[4];
#pragma unroll
  for (int s = 0; s < 4; ++s) qf[s] = *(const bf16x8*)(zq + s * 16 + h * 8);
  const int srow = tid >> 3, sc8 = tid & 7;
  const bf16_t* kbase = p.z + (size_t)(row0 + srow) * NIN + KC + sc8 * 8;
  const bf16_t* vbase = p.z + (size_t)(row0 + srow) * NIN + VC + sc8 * 8;
  u32x4 rk[2][2], rv[2][2];
  const int nt = T >> 6;
  const int prow = (l31 & 19) | ((l31 & 4) << 1) | ((l31 & 8) >> 1);
#define AT_GLOAD(t, S) do { _Pragma("unroll") for (int i_ = 0; i_ < 2; ++i_) { const size_t off_ = (size_t)((t) * 64 + 32 * i_) * NIN; rk[S][i_] = *(const u32x4*)(kbase + off_); rv[S][i_] = *(const u32x4*)(vbase + off_); } } while (0)
#define AT_LSTORE(buf, S) do { char* ks_ = lds + (buf) * 18432; char* vs_ = ks_ + 9216; \
    _Pragma("unroll") for (int i_ = 0; i_ < 2; ++i_) { *(u32x4*)(ks_ + (srow + 32 * i_) * PITCH + sc8 * 16) = rk[S][i_]; *(u32x4*)(vs_ + (srow + 32 * i_) * PITCH + sc8 * 16) = rv[S][i_]; } } while (0)
  constexpr int NMAP = (MODE == 1) ? 2 : 1;
  f32x16 o[NMAP][2];
  float m_run[NMAP], l_run[NMAP];
#pragma unroll
  for (int a = 0; a < NMAP; ++a) { m_run[a] = -INFINITY; l_run[a] = 0.f;
#pragma unroll
    for (int b = 0; b < 2; ++b)
#pragma unroll
      for (int i = 0; i < 16; ++i) o[a][b][i] = 0.f; }
  float lf = 0.f, lb = 0.f;
  if (MODE == 2) { lf = log2f(1.0f - exp2f(-5.0f - (float)head)); lb = log2f(1.0f - exp2f(-5.0f - (float)(3 - head))); }
  auto body = [&](const char* ks, const char* vs, const int t) __attribute__((always_inline)) {
#pragma unroll
    for (int mp = 0; mp < NMAP; ++mp) {
      f32x16 st[2];
#pragma unroll
      for (int kf = 0; kf < 2; ++kf) {
#pragma unroll
        for (int i = 0; i < 16; ++i) st[kf][i] = 0.f;
        if (MODE == 1) {
#pragma unroll
          for (int s = 0; s < 2; ++s) { const bf16x8 kfr = *(const bf16x8*)(ks + (kf * 32 + prow) * PITCH + (mp * 2 + s) * 32 + h * 16); st[kf] = MFMA32(kfr, qf[mp * 2 + s], st[kf]); }
        } else {
#pragma unroll
          for (int s = 0; s < 4; ++s) { const bf16x8 kfr = *(const bf16x8*)(ks + (kf * 32 + prow) * PITCH + s * 32 + h * 16); st[kf] = MFMA32(kfr, qf[s], st[kf]); }
        }
      }
      if (MODE == 2) {
        const int k0 = t * 64;
        const float dbase = (float)(qi - k0 - 8 * h);
        if (k0 + 63 < qw0) {
#pragma unroll
          for (int kf = 0; kf < 2; ++kf)
#pragma unroll
            for (int i = 0; i < 16; ++i) { const float cc = (float)(32 * kf + (i & 3) + 4 * ((i >> 2) & 1) + 16 * ((i >> 3) & 1)); st[kf][i] *= fexp2(lf * (dbase - cc)); }
        } else if (k0 > qw0 + 31) {
#pragma unroll
          for (int kf = 0; kf < 2; ++kf)
#pragma unroll
            for (int i = 0; i < 16; ++i) { const float cc = (float)(32 * kf + (i & 3) + 4 * ((i >> 2) & 1) + 16 * ((i >> 3) & 1)); st[kf][i] *= fexp2(lb * (cc - dbase)); }
        } else {
#pragma unroll
          for (int kf = 0; kf < 2; ++kf)
#pragma unroll
            for (int i = 0; i < 16; ++i) { const float cc = (float)(32 * kf + (i & 3) + 4 * ((i >> 2) & 1) + 16 * ((i >> 3) & 1)); const float d = dbase - cc;
              float dd = fexp2(fminf(lf * d, -lb * d)); if (d == 0.f) dd = 2.0f; st[kf][i] *= dd; }
        }
      } else {
        float mx = st[0][0];
#pragma unroll
        for (int kf = 0; kf < 2; ++kf)
#pragma unroll
          for (int i = 0; i < 16; ++i) mx = fmaxf(mx, st[kf][i]);
        mx = fmaxf(mx, __shfl_xor(mx, 32));
        const float mn = fmaxf(m_run[mp], mx); const float alpha = fexp2(m_run[mp] - mn); m_run[mp] = mn;
        float ps = 0.f;
#pragma unroll
        for (int kf = 0; kf < 2; ++kf)
#pragma unroll
          for (int i = 0; i < 16; ++i) { st[kf][i] = fexp2(st[kf][i] - mn); ps += st[kf][i]; }
        l_run[mp] = l_run[mp] * alpha + ps;
#pragma unroll
        for (int df = 0; df < 2; ++df) o[mp][df] *= alpha;
      }
      bf16x8 pf[4];
#pragma unroll
      for (int kf = 0; kf < 2; ++kf)
#pragma unroll
        for (int s2 = 0; s2 < 2; ++s2) { u32x4 u; u.x = pk(st[kf][8 * s2], st[kf][8 * s2 + 1]); u.y = pk(st[kf][8 * s2 + 2], st[kf][8 * s2 + 3]);
          u.z = pk(st[kf][8 * s2 + 4], st[kf][8 * s2 + 5]); u.w = pk(st[kf][8 * s2 + 6], st[kf][8 * s2 + 7]); pf[kf * 2 + s2] = __builtin_bit_cast(bf16x8, u); }
#pragma unroll
      for (int df = 0; df < 2; ++df)
#pragma unroll
        for (int ksx = 0; ksx < 4; ++ksx) { const bf16x8 vfr = *(const bf16x8*)(vs + (df * 32 + l31) * PITCH + ksx * 32 + h * 16); o[mp][df] = MFMA32(vfr, pf[ksx], o[mp][df]); }
    }
  };
  if constexpr (MODE == 1) {
    AT_GLOAD(0, 0); AT_LSTORE(0, 0); __syncthreads();
#pragma unroll 1
    for (int t = 0; t < nt; ++t) {
      if (t + 1 < nt) AT_GLOAD(t + 1, 0);
      const char* ks = lds + (t & 1) * 18432;
      body(ks, ks + 9216, t);
      if (t + 1 < nt) AT_LSTORE((t + 1) & 1, 0);
      __syncthreads();
    }
  } else {
    AT_GLOAD(0, 0); AT_GLOAD(1, 1); AT_LSTORE(0, 0); __syncthreads();
#pragma unroll 1
    for (int t2 = 0; t2 < nt; t2 += 2) {
      if (t2 + 2 < nt) AT_GLOAD(t2 + 2, 0);
      body(lds, lds + 9216, t2);
      AT_LSTORE(1, 1);
      __syncthreads();
      if (t2 + 3 < nt) AT_GLOAD(t2 + 3, 1);
      body(lds + 18432, lds + 18432 + 9216, t2 + 1);
      if (t2 + 2 < nt) AT_LSTORE(0, 0);
      __syncthreads();
    }
  }
#undef AT_GLOAD
#undef AT_LSTORE
  f32x16 r[2];
  if (MODE == 0) {
    const float l = l_run[0] + __shfl_xor(l_run[0], 32); const float inv = 1.0f / l;
#pragma unroll
    for (int df = 0; df < 2; ++df) r[df] = o[0][df] * inv;
  } else if (MODE == 1) {
    const float* lp = p.in[I_BLAM] + layer * 128;
    float s01 = 0.f, s23 = 0.f;
    for (int i = 0; i < 32; ++i) { s01 += lp[i] * lp[32 + i]; s23 += lp[64 + i] * lp[96 + i]; }
    const float lam_init = 0.8f - 0.6f * expf(-0.3f * (float)layer);
    const float lam = expf(s01) - expf(s23) + lam_init;
    const float l0 = l_run[0] + __shfl_xor(l_run[0], 32), l1 = l_run[NMAP - 1] + __shfl_xor(l_run[NMAP - 1], 32);
    const float i0 = 1.0f / l0, i1 = lam / l1;
    float ss = 0.f;
#pragma unroll
    for (int df = 0; df < 2; ++df) { r[df] = o[0][df] * i0 - o[NMAP - 1][df] * i1;
#pragma unroll
      for (int i = 0; i < 16; ++i) ss += r[df][i] * r[df][i]; }
    ss += __shfl_xor(ss, 32);
    const float rs = rsqrtf(ss * (1.0f / 64.0f) + EPS) * (1.0f - lam_init);
    const float* sg = p.in[I_BSUB] + layer * 64;
#pragma unroll
    for (int df = 0; df < 2; ++df)
#pragma unroll
      for (int i = 0; i < 16; ++i) r[df][i] *= rs * sg[df * 32 + (i & 3) + 8 * (i >> 2) + 4 * h];
  } else {
    float ss = 0.f;
#pragma unroll
    for (int df = 0; df < 2; ++df)
#pragma unroll
      for (int i = 0; i < 16; ++i) ss += o[0][df][i] * o[0][df][i];
    ss += __shfl_xor(ss, 32);
    const float rs = rsqrtf(ss * (1.0f / 64.0f) + EPS);
    const float* gg = p.in[I_CGN] + layer * 256 + head * 64;
    const bf16_t* zg = p.z + (size_t)(row0 + qi) * NIN + C_G + head * 64;
#pragma unroll
    for (int df = 0; df < 2; ++df)
#pragma unroll
      for (int g = 0; g < 4; ++g) { const u32x2 gw = *(const u32x2*)(zg + df * 32 + 8 * g + 4 * h);
        const float gv[4] = {bflo(gw.x), bfhi(gw.x), bflo(gw.y), bfhi(gw.y)};
#pragma unroll
        for (int e = 0; e < 4; ++e) { const float x = gv[e]; r[df][4 * g + e] = o[0][df][4 * g + e] * rs * gg[df * 32 + 8 * g + 4 * h + e] * (x / (1.0f + __expf(-x))); } }
  }
#pragma unroll
  for (int df = 0; df < 2; ++df)
#pragma unroll
    for (int g = 0; g < 4; ++g) { u32x2 v; v.x = pk(r[df][4 * g], r[df][4 * g + 1]); v.y = pk(r[df][4 * g + 2], r[df][4 * g + 3]); *(u32x2*)(zq + df * 32 + 8 * g + 4 * h) = v; }
}

template <int MODE>
DI void attn3_item(char* lds, const Params& p, int layer, int seq, int head, int qt) {
  const int tid = opaque(threadIdx.x), lane = tid & 63, w = tid >> 6, l31 = lane & 31, h = lane >> 5;
  layer = opaque_s(layer); seq = opaque_s(seq); head = opaque_s(head); qt = opaque_s(qt);
  int row0, T; seq_info(seq, row0, T);
  const int QC = (MODE == 0 ? A_Q : C_Q) + head * 64;
  const int KC = MODE == 0 ? A_K + (head >> 1) * 64 : C_K + head * 64;
  const int VC = MODE == 0 ? A_V + (head >> 1) * 64 : C_V + head * 64;
  const int qw0 = qt * 256 + w * 64;
  bf16x8 qf[2][4];
#pragma unroll
  for (int qi = 0; qi < 2; ++qi)
#pragma unroll
    for (int s = 0; s < 4; ++s) qf[qi][s] = *(const bf16x8*)(p.z + (size_t)(row0 + qw0 + qi * 32 + l31) * NIN + QC + s * 16 + h * 8);
  const int srow = tid >> 3, sc8 = tid & 7;
  const bf16_t* kbase = p.z + (size_t)(row0 + srow) * NIN + KC + sc8 * 8;
  const bf16_t* vbase = p.z + (size_t)(row0 + srow) * NIN + VC + sc8 * 8;
  u32x4 rk[2], rv[2];
  const int nt = T >> 6;
  const int prow = (l31 & 19) | ((l31 & 4) << 1) | ((l31 & 8) >> 1);
#define A3_GLOAD(t) do { _Pragma("unroll") for (int i_ = 0; i_ < 2; ++i_) { const size_t off_ = (size_t)((t) * 64 + 32 * i_) * NIN; rk[i_] = *(const u32x4*)(kbase + off_); rv[i_] = *(const u32x4*)(vbase + off_); } } while (0)
#define A3_LSTORE(buf) do { char* ks_ = lds + (buf) * 18432; char* vs_ = ks_ + 9216; \
    _Pragma("unroll") for (int i_ = 0; i_ < 2; ++i_) { *(u32x4*)(ks_ + (srow + 32 * i_) * PITCH + sc8 * 16) = rk[i_]; *(u32x4*)(vs_ + (srow + 32 * i_) * PITCH + sc8 * 16) = rv[i_]; } } while (0)
  f32x16 o[2][2];
  float m_run[2], l_run[2];
#pragma unroll
  for (int a = 0; a < 2; ++a) { m_run[a] = -INFINITY; l_run[a] = 0.f;
#pragma unroll
    for (int b = 0; b < 2; ++b)
#pragma unroll
      for (int i = 0; i < 16; ++i) o[a][b][i] = 0.f; }
  float lf = 0.f, lb = 0.f;
  if (MODE == 2) { lf = log2f(1.0f - exp2f(-5.0f - (float)head)); lb = log2f(1.0f - exp2f(-5.0f - (float)(3 - head))); }
  A3_GLOAD(0); A3_LSTORE(0); __syncthreads();
#pragma unroll 1
  for (int t = 0; t < nt; ++t) {
    if (t + 1 < nt) A3_GLOAD(t + 1);
    const char* ks = lds + (t & 1) * 18432; const char* vs = ks + 9216;
    f32x16 st[2][2];
#pragma unroll
    for (int kf = 0; kf < 2; ++kf) {
#pragma unroll
      for (int qi = 0; qi < 2; ++qi)
#pragma unroll
        for (int i = 0; i < 16; ++i) st[qi][kf][i] = 0.f;
#pragma unroll
      for (int s = 0; s < 4; ++s) { const bf16x8 kfr = *(const bf16x8*)(ks + (kf * 32 + prow) * PITCH + s * 32 + h * 16);
#pragma unroll
        for (int qi = 0; qi < 2; ++qi) st[qi][kf] = MFMA32(kfr, qf[qi][s], st[qi][kf]); }
    }
    __builtin_amdgcn_sched_barrier(0);
#pragma unroll
    for (int qi = 0; qi < 2; ++qi) {
      bf16x8 pf[4];
      if (MODE == 2) {
        const int k0 = t * 64, qb = qw0 + qi * 32;
        const float dbase = (float)(qb + l31 - k0 - 8 * h);
        if (k0 + 63 < qb) {
#pragma unroll
          for (int kf = 0; kf < 2; ++kf)
#pragma unroll
            for (int i = 0; i < 16; ++i) { const float cc = (float)(32 * kf + (i & 3) + 4 * ((i >> 2) & 1) + 16 * ((i >> 3) & 1)); st[qi][kf][i] *= fexp2(lf * (dbase - cc)); }
        } else if (k0 > qb + 31) {
#pragma unroll
          for (int kf = 0; kf < 2; ++kf)
#pragma unroll
            for (int i = 0; i < 16; ++i) { const float cc = (float)(32 * kf + (i & 3) + 4 * ((i >> 2) & 1) + 16 * ((i >> 3) & 1)); st[qi][kf][i] *= fexp2(lb * (cc - dbase)); }
        } else {
#pragma unroll
          for (int kf = 0; kf < 2; ++kf)
#pragma unroll
            for (int i = 0; i < 16; ++i) { const float cc = (float)(32 * kf + (i & 3) + 4 * ((i >> 2) & 1) + 16 * ((i >> 3) & 1)); const float d = dbase - cc;
              float dd = fexp2(fminf(lf * d, -lb * d)); if (d == 0.f) dd = 2.0f; st[qi][kf][i] *= dd; }
        }
      } else {
        float mx = st[qi][0][0];
#pragma unroll
        for (int kf = 0; kf < 2; ++kf)
#pragma unroll
          for (int i = 0; i < 16; ++i) mx = fmaxf(mx, st[qi][kf][i]);
        mx = fmaxf(mx, __shfl_xor(mx, 32));
        const float mn = fmaxf(m_run[qi], mx); const float alpha = fexp2(m_run[qi] - mn); m_run[qi] = mn;
        float ps = 0.f;
#pragma unroll
        for (int kf = 0; kf < 2; ++kf)
#pragma unroll
          for (int i = 0; i < 16; ++i) { st[qi][kf][i] = fexp2(st[qi][kf][i] - mn); ps += st[qi][kf][i]; }
        l_run[qi] = l_run[qi] * alpha + ps;
#pragma unroll
        for (int df = 0; df < 2; ++df) o[qi][df] *= alpha;
      }
#pragma unroll
      for (int kf = 0; kf < 2; ++kf)
#pragma unroll
        for (int s2 = 0; s2 < 2; ++s2) { u32x4 u; u.x = pk(st[qi][kf][8 * s2], st[qi][kf][8 * s2 + 1]); u.y = pk(st[qi][kf][8 * s2 + 2], st[qi][kf][8 * s2 + 3]);
          u.z = pk(st[qi][kf][8 * s2 + 4], st[qi][kf][8 * s2 + 5]); u.w = pk(st[qi][kf][8 * s2 + 6], st[qi][kf][8 * s2 + 7]); pf[kf * 2 + s2] = __builtin_bit_cast(bf16x8, u); }
#pragma unroll
      for (int df = 0; df < 2; ++df)
#pragma unroll
        for (int ksx = 0; ksx < 4; ++ksx) { const bf16x8 vfr = *(const bf16x8*)(vs + (df * 32 + l31) * PITCH + ksx * 32 + h * 16); o[qi][df] = MFMA32(vfr, pf[ksx], o[qi][df]); }
      __builtin_amdgcn_sched_barrier(0);
    }
    __builtin_amdgcn_sched_barrier(0);
    if (t + 1 < nt) A3_LSTORE((t + 1) & 1);
    __syncthreads();
  }
#undef A3_GLOAD
#undef A3_LSTORE
#pragma unroll
  for (int qi = 0; qi < 2; ++qi) {
    const int qrow = row0 + qw0 + qi * 32 + l31;
    bf16_t* zq = p.z + (size_t)qrow * NIN + QC;
    f32x16 r[2];
    if (MODE == 0) {
      const float l = l_run[qi] + __shfl_xor(l_run[qi], 32); const float inv = 1.0f / l;
#pragma unroll
      for (int df = 0; df < 2; ++df) r[df] = o[qi][df] * inv;
    } else {
      float ss = 0.f;
#pragma unroll
      for (int df = 0; df < 2; ++df)
#pragma unroll
        for (int i = 0; i < 16; ++i) ss += o[qi][df][i] * o[qi][df][i];
      ss += __shfl_xor(ss, 32);
      const float rs = rsqrtf(ss * (1.0f / 64.0f) + EPS);
      const float* gg = p.in[I_CGN] + layer * 256 + head * 64;
      const bf16_t* zg = p.z + (size_t)qrow * NIN + C_G + head * 64;
#pragma unroll
      for (int df = 0; df < 2; ++df)
#pragma unroll
        for (int g = 0; g < 4; ++g) { const u32x2 gw = *(const u32x2*)(zg + df * 32 + 8 * g + 4 * h);
          const float gv[4] = {bflo(gw.x), bfhi(gw.x), bflo(gw.y), bfhi(gw.y)};
#pragma unroll
          for (int e = 0; e < 4; ++e) { const float x = gv[e]; r[df][4 * g + e] = o[qi][df][4 * g + e] * rs * gg[df * 32 + 8 * g + 4 * h + e] * (x / (1.0f + __expf(-x))); } }
    }
#pragma unroll
    for (int df = 0; df < 2; ++df)
#pragma unroll
      for (int g = 0; g < 4; ++g) { u32x2 v; v.x = pk(r[df][4 * g], r[df][4 * g + 1]); v.y = pk(r[df][4 * g + 2], r[df][4 * g + 3]); *(u32x2*)(zq + df * 32 + 8 * g + 4 * h) = v; }
  }
}

DI int next_item(int* ctr, int* sh) {
  __syncthreads();
  if (threadIdx.x == 0) *sh = atomicAdd(ctr, 1);
  __syncthreads();
  return *sh;
}

__global__ void __launch_bounds__(256, 2) fwd(Params p) {
  extern __shared__ __attribute__((aligned(16))) char lds[];
  __shared__ int s_item;
  cg::grid_group grid = cg::this_grid();
  const int bid = blockIdx.x, nb = gridDim.x, tid = threadIdx.x, lane = tid & 63, w = tid >> 6;
  if (bid == 0 && tid < 64) p.ctr[tid] = 0;
  for (int i = bid * 256 + tid; i < 4096 * 32; i += nb * 256) { const int t = i >> 5, j = i & 31; const float inv = powf(10000.0f, -(float)(2 * j) / 64.0f); float sn, cs; sincosf((float)t * inv, &sn, &cs); p.tabC[i] = (f32x2){cs, sn}; }
  for (int i = bid * 256 + tid; i < 4096 * 4; i += nb * 256) { const int t = i >> 2, j = i & 3; const float inv = powf(500000.0f, -(float)(2 * j) / 8.0f); float sn, cs; sincosf((float)t * inv, &sn, &cs); p.tabB[i] = (f32x2){cs, sn}; }
  for (int i = bid * 256 + tid; i < 64 * 16; i += nb * 256) { const int t = i >> 4, j = i & 15; const float inv = powf(10000.0f, -(float)(2 * j) / 32.0f); float sn, cs; sincosf((float)t * inv, &sn, &cs); p.tabA[i] = (f32x2){cs, sn}; }
  for (int l = 0; l < 2; ++l) {
    for (int i = bid * 256 + tid; i < 64 * 1024; i += nb * 256) p.wtin[(size_t)l * NINP * 1024 + (size_t)NIN * 1024 + i] = 0;
    for (int tl = bid; tl < 16 * 53; tl += nb) conv_T(lds, p.in[I_WIN] + (size_t)l * 1024 * NIN, 1024, NIN, p.wtin + (size_t)l * NINP * 1024, 0, tl);
    for (int tl = bid; tl < 16 * 16; tl += nb) conv_T(lds, p.in[I_WOUT] + (size_t)l * 1024 * 1024, 1024, 1024, p.wtout + (size_t)l * 1024 * 1024, 0, tl);
  }
  bf16_t* hb = p.pl;
  for (int row = bid * 4 + opaque(w); row < MT; row += nb * 4) {
    const float* xin = row < M0 ? p.in[I_XP] + (size_t)row * 1024 : p.in[I_XS] + (size_t)(row - M0) * 1024;
    row_phase(xin, p.out + (size_t)row * 1024, nullptr, nullptr, p.in[I_NMPRE], hb + (size_t)row * 1024, lane);
  }
  grid.sync();
  for (int l = 0; l < 2; ++l) {
    { ASrc A; A.b0 = hb; A.b1 = hb; A.b2 = hb; A.b3 = hb; A.s0 = A.s1 = A.s2 = A.s3 = 1024; A.shift = 12;
      EpiIn e; e.z = p.z; e.lds = lds; e.qg = p.in[I_AQG] + l * 64; e.kg = p.in[I_AKG] + l * 64; e.tabA = p.tabA; e.tabB = p.tabB; e.tabC = p.tabC;
      gemm_phase(lds, A, p.wtin + (size_t)l * NINP * 1024, 1024, 27, e); }
    grid.sync();
    for (int it = bid; it < MT / 8; it += nb) dprep_item(lds, p, l, it);
    grid.sync();
    for (;;) {
      const int it = next_item(p.ctr + l * 16, &s_item);
      if (it >= 256 + 2048 + 1024) break;
      if (it < 256) { const int i2 = it >> 1; const int sq = i2 < 64 ? (i2 >> 3) : 8 + ((i2 - 64) >> 3); rwkv_item(lds, p, sq, (i2 >> 1) & 3, i2 & 1, it & 1); }
      else {
        int j = it - 256;
        if (j < 2048) {
          if (j < 1024) attn_item<1>(lds, p, l, j >> 7, (j >> 5) & 3, j & 31);
          else { const int r = (j - 1024) & 511; if (j < 1536) attn3_item<2>(lds, p, l, r >> 6, (r >> 4) & 3, r & 15); else attn3_item<0>(lds, p, l, r >> 6, (r >> 4) & 3, r & 15); }
        } else { j -= 2048;
          if (j < 512) attn_item<1>(lds, p, l, 8 + (j >> 6), (j >> 4) & 3, j & 15);
          else { const int r = (j - 512) & 255; if (j < 768) attn3_item<2>(lds, p, l, 8 + (r >> 5), (r >> 3) & 3, r & 7); else attn3_item<0>(lds, p, l, 8 + (r >> 5), (r >> 3) & 3, r & 7); }
        }
      }
    }
    grid.sync();
    bf16_t* wtgu = p.pl + 5 * PLANE; bf16_t* wtd = wtgu + (size_t)2 * DFF * 1024;
    for (int it = bid; it < MT / 8 + 3 * 704; it += nb) {
      if (it < MT / 8) dpost_item(lds, p, l, it);
      else { const int j = it - MT / 8;
        if (j < 704) conv_T(lds, p.in[I_FG] + (size_t)l * 1024 * DFF, 1024, DFF, wtgu, 1, j);
        else if (j < 1408) conv_T(lds, p.in[I_FU] + (size_t)l * 1024 * DFF, 1024, DFF, wtgu, 2, j - 704);
        else conv_T(lds, p.in[I_FD] + (size_t)l * DFF * 1024, DFF, 1024, wtd, 0, j - 1408); }
    }
    grid.sync();
    { ASrc A; A.b0 = p.z + A_Q; A.b1 = p.z + B_Q; A.b2 = p.z + C_Q; A.b3 = p.pl + 4 * PLANE; A.s0 = A.s1 = A.s2 = NIN; A.s3 = 256; A.shift = 8;
      EpiStore e; e.out = hb; e.ldc = 1024; e.nmax = 1024;
      gemm_phase(lds, A, p.wtout + (size_t)l * 1024 * 1024, 1024, 8, e); }
    grid.sync();
    for (int row = bid * 4 + opaque(w); row < MT; row += nb * 8) { const int rb = row + nb * 4;
      if (rb < MT) row_phase2(p.out + (size_t)row * 1024, p.out + (size_t)rb * 1024, p.out + (size_t)row * 1024, p.out + (size_t)rb * 1024, hb + (size_t)row * 1024, hb + (size_t)rb * 1024,
                              p.in[I_NMPOST] + l * 1024, p.in[I_NFPRE] + l * 1024, hb + (size_t)row * 1024, hb + (size_t)rb * 1024, lane);
      else row_phase(p.out + (size_t)row * 1024, p.out + (size_t)row * 1024, hb + (size_t)row * 1024, p.in[I_NMPOST] + l * 1024, p.in[I_NFPRE] + l * 1024, hb + (size_t)row * 1024, lane); }
    grid.sync();
    { ASrc A; A.b0 = hb; A.b1 = hb; A.b2 = hb; A.b3 = hb; A.s0 = A.s1 = A.s2 = A.s3 = 1024; A.shift = 12;
      EpiSwiGLU e; e.out = p.z;
      gemm_phase(lds, A, wtgu, 1024, 44, e); }
    grid.sync();
    { ASrc A; A.b0 = p.z; A.b1 = p.z; A.b2 = p.z; A.b3 = p.z; A.s0 = A.s1 = A.s2 = A.s3 = DFF; A.shift = 12;
      EpiStore e; e.out = hb; e.ldc = 1024; e.nmax = 1024;
      gemm_phase(lds, A, wtd, DFF, 8, e); }
    grid.sync();
    for (int row = bid * 4 + opaque(w); row < MT; row += nb * 8) { const int rb = row + nb * 4; const float* gp2 = l == 0 ? p.in[I_NMPRE] + 1024 : nullptr;
      if (rb < MT) row_phase2(p.out + (size_t)row * 1024, p.out + (size_t)rb * 1024, p.out + (size_t)row * 1024, p.out + (size_t)rb * 1024, hb + (size_t)row * 1024, hb + (size_t)rb * 1024,
                              p.in[I_NFPOST] + l * 1024, gp2, hb + (size_t)row * 1024, hb + (size_t)rb * 1024, lane);
      else row_phase(p.out + (size_t)row * 1024, p.out + (size_t)row * 1024, hb + (size_t)row * 1024, p.in[I_NFPOST] + l * 1024, gp2, hb + (size_t)row * 1024, lane); }
    if (l == 0) grid.sync();
  }
}

extern "C" void kernel_launch(void* const* d_in, const int* in_sizes, int n_in, void* d_out, int out_size,
                              void* d_ws, size_t ws_size, hipStream_t stream) {
  static int grid_blocks = 0;
  if (!grid_blocks) {
    int dev = 0, cus = 0, per_cu = 0;
    hipGetDevice(&dev);
    hipDeviceGetAttribute(&cus, hipDeviceAttributeMultiprocessorCount, dev);
    hipFuncSetAttribute((const void*)fwd, hipFuncAttributeMaxDynamicSharedMemorySize, LDS_BYTES);
    hipOccupancyMaxActiveBlocksPerMultiprocessor(&per_cu, fwd, 256, LDS_BYTES);
    if (per_cu > 2) per_cu = 2;
    if (per_cu < 1) per_cu = 1;
    grid_blocks = cus * per_cu;
  }
  Params p{};
  for (int i = 0; i < 28; ++i) p.in[i] = (const float*)d_in[i];
  p.out = (float*)d_out;
  char* ws = (char*)d_ws;
  size_t off = 0;
  p.z = (bf16_t*)(ws + off); off += (size_t)MT * NIN * 2;
  p.pl = (bf16_t*)(ws + off); off += 7 * PLANE * 2;
  p.wtin = (bf16_t*)(ws + off); off += (size_t)2 * NINP * 1024 * 2;
  p.wtout = (bf16_t*)(ws + off); off += (size_t)2 * 1024 * 1024 * 2;
  p.tabC = (f32x2*)(ws + off); off += (size_t)4096 * 32 * 8;
  p.tabB = (f32x2*)(ws + off); off += (size_t)4096 * 4 * 8;
  p.tabA = (f32x2*)(ws + off); off += (size_t)64 * 16 * 8;
  p.ctr = (int*)(ws + off); off += 256;
  if (off > ws_size) fprintf(stderr, "workspace too small: need %zu have %zu\n", off, ws_size);
  void* args[] = {&p};
  hipError_t e = hipLaunchCooperativeKernel((void*)fwd, dim3(grid_blocks), dim3(256), args, LDS_BYTES, stream);
  if (e != hipSuccess) fprintf(stderr, "coop launch failed: %s (grid %d)\n", hipGetErrorString(e), grid_blocks);
}
```

```cpp
#include <hip/hip_runtime.h>
#include <hip/hip_cooperative_groups.h>
#include <cstdio>
#include <cstdint>
namespace cg = cooperative_groups;

#define DI __device__ __forceinline__
typedef unsigned short bf16_t;
typedef short bf16x8 __attribute__((ext_vector_type(8)));
typedef float f32x2 __attribute__((ext_vector_type(2)));
typedef float f32x4 __attribute__((ext_vector_type(4)));
typedef float f32x16 __attribute__((ext_vector_type(16)));
typedef unsigned u32x2 __attribute__((ext_vector_type(2)));
typedef unsigned u32x4 __attribute__((ext_vector_type(4)));
typedef __bf16 bf16x2_t __attribute__((ext_vector_type(2)));

constexpr int M0 = 32768, MT = 49152, DM = 1024, NIN = 3392, NINP = 3456, DFF = 2816;
constexpr int A_Q = 0, A_K = 256, A_V = 384, B_Q = 512, B_K = 768, B_V = 1024, C_Q = 1280, C_K = 1536, C_V = 1792, C_G = 2048, D_0 = 2304;
constexpr int PITCH = 144;
constexpr size_t PLANE = (size_t)MT * 256;
constexpr int LDS_BYTES = 73728;
constexpr float LOG2E = 1.4426950408889634f;
constexpr float EPS = 1e-6f;

enum { I_XP = 0, I_XS, I_NMPRE, I_NMPOST, I_NFPRE, I_NFPOST, I_WIN, I_WOUT, I_AQG, I_AKG, I_BLAM, I_BSUB, I_CGN, I_DMUP, I_DMUN, I_DW0, I_DWUP,
       I_DA0, I_DAUP, I_DGUP, I_DKK, I_DKA, I_DRK, I_DGNW, I_DGNB, I_FG, I_FU, I_FD };

struct Params {
  const float* in[28];
  float* out;
  bf16_t* z;
  bf16_t* pl;
  bf16_t* wtin;
  bf16_t* wtout;
  f32x2* tabC;
  f32x2* tabB;
  f32x2* tabA;
  int* ctr;
};

DI int opaque(int x) { asm volatile("" : "+v"(x)); return x; }
DI int opaque_s(int x) { asm volatile("" : "+s"(x)); return x; }
DI float bf2f(bf16_t v) { return __uint_as_float(((unsigned)v) << 16); }
DI float bflo(unsigned w) { return __uint_as_float(w << 16); }
DI float bfhi(unsigned w) { return __uint_as_float(w & 0xffff0000u); }
DI unsigned pk(float lo, float hi) { f32x2 v = {lo, hi}; bf16x2_t b = __builtin_convertvector(v, bf16x2_t); return __builtin_bit_cast(unsigned, b); }
DI bf16_t f2bf(float x) { return (bf16_t)(pk(x, 0.f) & 0xffffu); }
DI float dppf(float x, const int ctrl) { return x; }
#define DPPF(x, ctrl) __int_as_float(__builtin_amdgcn_update_dpp(0, __float_as_int(x), (ctrl), 0xF, 0xF, true))
DI float wave_sum(float v) {
  v += DPPF(v, 0xB1);
  v += DPPF(v, 0x4E);
  v += DPPF(v, 0x141);
  v += DPPF(v, 0x140);
  const int vi = __float_as_int(v);
  return (__int_as_float(__builtin_amdgcn_readlane(vi, 0)) + __int_as_float(__builtin_amdgcn_readlane(vi, 16))) +
         (__int_as_float(__builtin_amdgcn_readlane(vi, 32)) + __int_as_float(__builtin_amdgcn_readlane(vi, 48)));
}
DI float dpp_xor1(float x) { return __int_as_float(__builtin_amdgcn_update_dpp(0, __float_as_int(x), 0xB1, 0xF, 0xF, true)); }
DI float dpp_xor2(float x) { return __int_as_float(__builtin_amdgcn_update_dpp(0, __float_as_int(x), 0x4E, 0xF, 0xF, true)); }
DI float dpp_hmir(float x) { return __int_as_float(__builtin_amdgcn_update_dpp(0, __float_as_int(x), 0x141, 0xF, 0xF, true)); }
DI float red8(float x) { x += dpp_xor1(x); x += dpp_xor2(x); x += dpp_hmir(x); return x; }
DI float fexp2(float x) { return __builtin_amdgcn_exp2f(x); }
DI void seq_info(int s, int& row0, int& T) { if (s < 8) { row0 = s * 4096; T = 4096; } else { row0 = M0 + (s - 8) * 2048; T = 2048; } }
DI void row_info(int r, int& t, int& T) { if (r < M0) { t = r & 4095; T = 4096; } else { t = (r - M0) & 2047; T = 2048; } }
#define MFMA32(a, b, c) __builtin_amdgcn_mfma_f32_32x32x16_bf16((a), (b), (c), 0, 0, 0)

DI void conv_T(char* lds, const float* __restrict__ W, int K, int N, bf16_t* __restrict__ Wt, int mode, int tile) {
  float* t = (float*)lds;
  const int tid0 = opaque(threadIdx.x);
  const int ntn = N >> 6, kt = tile / ntn, nt = tile - kt * ntn, k0 = kt << 6, n0 = nt << 6;
#pragma unroll 4
  for (int i = 0; i < 16; ++i) { const int idx = tid0 + 256 * i, k = idx >> 6, n = idx & 63; t[k * 65 + n] = W[(size_t)(k0 + k) * N + n0 + n]; }
  __syncthreads();
#pragma unroll 4
  for (int i = 0; i < 8; ++i) {
    const int idx = tid0 + 256 * i, n = idx >> 5, k = (idx & 31) * 2, j = n0 + n;
    const int rho = (mode == 0) ? j : ((j >> 6) * 128 + ((j >> 5) & 1) * 64 + (mode - 1) * 32 + (j & 31));
    *(unsigned*)(Wt + (size_t)rho * K + k0 + k) = pk(t[k * 65 + n], t[(k + 1) * 65 + n]);
  }
  __syncthreads();
}

DI void row_phase(const float* __restrict__ xin, float* __restrict__ xout, const bf16_t* addsrc, const float* __restrict__ gpost,
                  const float* __restrict__ gpre, bf16_t* hout, int lane_in) {
  const int lane = opaque(lane_in);
  f32x4 x[4];
#pragma unroll
  for (int i = 0; i < 4; ++i) x[i] = *(const f32x4*)(xin + i * 256 + lane * 4);
  if (addsrc) {
    f32x4 m[4]; float ss = 0.f;
#pragma unroll
    for (int i = 0; i < 4; ++i) { const u32x2 w = *(const u32x2*)(addsrc + i * 256 + lane * 4); m[i] = (f32x4){bflo(w.x), bfhi(w.x), bflo(w.y), bfhi(w.y)};
      ss += m[i][0] * m[i][0] + m[i][1] * m[i][1] + m[i][2] * m[i][2] + m[i][3] * m[i][3]; }
    ss = wave_sum(ss); const float rs = rsqrtf(ss * (1.0f / 1024.0f) + EPS);
#pragma unroll
    for (int i = 0; i < 4; ++i) { const f32x4 g = *(const f32x4*)(gpost + i * 256 + lane * 4); x[i] += m[i] * rs * g; }
  }
#pragma unroll
  for (int i = 0; i < 4; ++i) *(f32x4*)(xout + i * 256 + lane * 4) = x[i];
  if (gpre) {
    float ss = 0.f;
#pragma unroll
    for (int i = 0; i < 4; ++i) ss += x[i][0] * x[i][0] + x[i][1] * x[i][1] + x[i][2] * x[i][2] + x[i][3] * x[i][3];
    ss = wave_sum(ss); const float rs = rsqrtf(ss * (1.0f / 1024.0f) + EPS);
#pragma unroll
    for (int i = 0; i < 4; ++i) { const f32x4 g = *(const f32x4*)(gpre + i * 256 + lane * 4); const f32x4 hv = x[i] * rs * g;
      u32x2 w; w.x = pk(hv[0], hv[1]); w.y = pk(hv[2], hv[3]); *(u32x2*)(hout + i * 256 + lane * 4) = w; }
  }
}

DI void row_phase2(const float* __restrict__ xinA, const float* __restrict__ xinB, float* __restrict__ xoutA, float* __restrict__ xoutB, const bf16_t* addA, const bf16_t* addB,
                   const float* __restrict__ gpost, const float* __restrict__ gpre, bf16_t* houtA, bf16_t* houtB, int lane_in) {
  const int lane = opaque(lane_in);
  f32x4 x[2][4]; u32x2 aw[2][4];
#pragma unroll
  for (int i = 0; i < 4; ++i) { x[0][i] = *(const f32x4*)(xinA + i * 256 + lane * 4); x[1][i] = *(const f32x4*)(xinB + i * 256 + lane * 4); }
  if (addA) {
#pragma unroll
    for (int i = 0; i < 4; ++i) { aw[0][i] = *(const u32x2*)(addA + i * 256 + lane * 4); aw[1][i] = *(const u32x2*)(addB + i * 256 + lane * 4); }
#pragma unroll
    for (int r = 0; r < 2; ++r) {
      f32x4 m[4]; float ss = 0.f;
#pragma unroll
      for (int i = 0; i < 4; ++i) { const u32x2 w = aw[r][i]; m[i] = (f32x4){bflo(w.x), bfhi(w.x), bflo(w.y), bfhi(w.y)};
        ss += m[i][0] * m[i][0] + m[i][1] * m[i][1] + m[i][2] * m[i][2] + m[i][3] * m[i][3]; }
      ss = wave_sum(ss); const float rs = rsqrtf(ss * (1.0f / 1024.0f) + EPS);
#pragma unroll
      for (int i = 0; i < 4; ++i) { const f32x4 g = *(const f32x4*)(gpost + i * 256 + lane * 4); x[r][i] += m[i] * rs * g; }
    }
  }
#pragma unroll
  for (int i = 0; i < 4; ++i) { *(f32x4*)(xoutA + i * 256 + lane * 4) = x[0][i]; *(f32x4*)(xoutB + i * 256 + lane * 4) = x[1][i]; }
  if (gpre) {
#pragma unroll
    for (int r = 0; r < 2; ++r) {
      float ss = 0.f;
#pragma unroll
      for (int i = 0; i < 4; ++i) ss += x[r][i][0] * x[r][i][0] + x[r][i][1] * x[r][i][1] + x[r][i][2] * x[r][i][2] + x[r][i][3] * x[r][i][3];
      ss = wave_sum(ss); const float rs = rsqrtf(ss * (1.0f / 1024.0f) + EPS);
      bf16_t* ho = r == 0 ? houtA : houtB;
#pragma unroll
      for (int i = 0; i < 4; ++i) { const f32x4 g = *(const f32x4*)(gpre + i * 256 + lane * 4); const f32x4 hv = x[r][i] * rs * g;
        u32x2 w; w.x = pk(hv[0], hv[1]); w.y = pk(hv[2], hv[3]); *(u32x2*)(ho + i * 256 + lane * 4) = w; }
    }
  }
}

struct ASrc { const bf16_t* b0; const bf16_t* b1; const bf16_t* b2; const bf16_t* b3; int s0, s1, s2, s3; int shift; };

struct EpiStore { bf16_t* out; int ldc; int nmax;
  DI void operator()(const f32x16 (&acc)[2][2], int mb, int nb, int n0, int wc, int l31, int h) const {
#pragma unroll
    for (int mf = 0; mf < 2; ++mf) { bf16_t* rp = out + (size_t)(mb + mf * 32 + l31) * ldc;
#pragma unroll
      for (int nf = 0; nf < 2; ++nf) { if (nb + nf * 32 < nmax) {
#pragma unroll
        for (int g = 0; g < 4; ++g) { u32x2 v; v.x = pk(acc[mf][nf][4 * g], acc[mf][nf][4 * g + 1]); v.y = pk(acc[mf][nf][4 * g + 2], acc[mf][nf][4 * g + 3]);
          *(u32x2*)(rp + nb + nf * 32 + 8 * g + 4 * h) = v; } } } }
  } };
struct EpiSwiGLU { bf16_t* out;
  DI void operator()(const f32x16 (&acc)[2][2], int mb, int nb, int n0, int wc, int l31, int h) const {
    const int hc = (n0 >> 7) * 64 + wc * 32;
#pragma unroll
    for (int mf = 0; mf < 2; ++mf) { bf16_t* rp = out + (size_t)(mb + mf * 32 + l31) * DFF + hc;
#pragma unroll
      for (int g = 0; g < 4; ++g) { float r[4];
#pragma unroll
        for (int e = 0; e < 4; ++e) { const float gt = acc[mf][0][4 * g + e], up = acc[mf][1][4 * g + e]; r[e] = gt / (1.0f + __expf(-gt)) * up; }
        u32x2 v; v.x = pk(r[0], r[1]); v.y = pk(r[2], r[3]); *(u32x2*)(rp + 8 * g + 4 * h) = v; } }
  } };

struct EpiIn { bf16_t* z; char* lds; const float* qg; const float* kg; const f32x2* tabA; const f32x2* tabB; const f32x2* tabC;
  DI void operator()(f32x16 (&acc)[2][2], int mb, int nb, int n0, int wc, int l31, int h) const {
    if (nb >= NIN) return;
    const bool isv = (nb >= A_V && nb < B_Q) || (nb >= B_V && nb < C_Q) || (nb >= C_V && nb < C_G);
    if (isv) {
      const int wv = (threadIdx.x >> 6);
      bf16_t* img = (bf16_t*)(lds + 32768 + wv * 9216);
#pragma unroll
      for (int mf = 0; mf < 2; ++mf)
#pragma unroll
        for (int nf = 0; nf < 2; ++nf)
#pragma unroll
          for (int i = 0; i < 16; ++i) { const int d = nf * 32 + (i & 3) + 8 * (i >> 2) + 4 * h; img[d * 72 + mf * 32 + l31] = f2bf(acc[mf][nf][i]); }
      __builtin_amdgcn_s_waitcnt(0xc07f);
      const int ln = l31 + 32 * h;
#pragma unroll
      for (int i = 0; i < 8; ++i) { const int q = ln + 64 * i, d = q >> 3, c8 = q & 7;
        const u32x4 v = *(const u32x4*)(img + d * 72 + c8 * 8); *(u32x4*)(z + (size_t)(mb + d) * NIN + nb + c8 * 8) = v; }
      return;
    }
#pragma unroll
    for (int mf = 0; mf < 2; ++mf) {
      const int row = mb + mf * 32 + l31; int t, T; row_info(row, t, T);
      if (nb < A_V) {
        const bool isq = nb < A_K; const float* gn = isq ? qg : kg;
        float ss = 0.f;
#pragma unroll
        for (int nf = 0; nf < 2; ++nf)
#pragma unroll
          for (int i = 0; i < 16; ++i) ss += acc[mf][nf][i] * acc[mf][nf][i];
        ss += __shfl_xor(ss, 32);
        const float rs = rsqrtf(ss * (1.0f / 64.0f) + EPS) * (isq ? 0.125f * LOG2E : 1.0f);
#pragma unroll
        for (int nf = 0; nf < 2; ++nf) {
          const int pos = nf == 0 ? (t >> 6) : (t & 63);
#pragma unroll
          for (int g = 0; g < 4; ++g)
#pragma unroll
            for (int e = 0; e < 4; ++e) acc[mf][nf][4 * g + e] *= rs * gn[nf * 32 + 8 * g + 4 * h + e];
#pragma unroll
          for (int g = 0; g < 2; ++g)
#pragma unroll
            for (int e = 0; e < 4; ++e) { const f32x2 cs = tabA[pos * 16 + 8 * g + 4 * h + e];
              const float x1 = acc[mf][nf][4 * g + e], x2 = acc[mf][nf][4 * (g + 2) + e];
              acc[mf][nf][4 * g + e] = x1 * cs.x - x2 * cs.y; acc[mf][nf][4 * (g + 2) + e] = x2 * cs.x + x1 * cs.y; }
        }
      } else if (nb >= B_Q && nb < B_V) {
        const bool isq = nb < B_K;
#pragma unroll
        for (int nf = 0; nf < 2; ++nf) {
#pragma unroll
          for (int e = 0; e < 4; ++e) { const f32x2 cs = tabB[t * 4 + e]; const float v = acc[mf][nf][e]; const float o = __shfl_xor(v, 32);
            acc[mf][nf][e] = (h == 0) ? (v * cs.x - o * cs.y) : (v * cs.x + o * cs.y); }
          if (isq) {
#pragma unroll
            for (int i = 0; i < 16; ++i) acc[mf][nf][i] *= 0.17677669529663687f * LOG2E; }
        }
      } else if (nb >= C_Q && nb < C_V) {
        const float sc = nb < C_K ? 1.0f : 0.125f;
#pragma unroll
        for (int g = 0; g < 4; ++g)
#pragma unroll
          for (int e = 0; e < 4; ++e) { const f32x2 cs = tabC[t * 32 + 8 * g + 4 * h + e]; const float x1 = acc[mf][0][4 * g + e], x2 = acc[mf][1][4 * g + e];
            acc[mf][0][4 * g + e] = (x1 * cs.x - x2 * cs.y) * sc; acc[mf][1][4 * g + e] = (x2 * cs.x + x1 * cs.y) * sc; }
      }
      bf16_t* rp = z + (size_t)row * NIN + nb;
#pragma unroll
      for (int nf = 0; nf < 2; ++nf)
#pragma unroll
        for (int g = 0; g < 4; ++g) { u32x2 v; v.x = pk(acc[mf][nf][4 * g], acc[mf][nf][4 * g + 1]); v.y = pk(acc[mf][nf][4 * g + 2], acc[mf][nf][4 * g + 3]);
          *(u32x2*)(rp + nf * 32 + 8 * g + 4 * h) = v; }
    }
  } };

#define LASP __attribute__((address_space(3)))
template <class Epi>
DI void gemm_tile(char* lds, const ASrc& A, const bf16_t* __restrict__ Bt, int K, int m0, int n0, const Epi& epi, bool first, bool has_next, int m0n, int n0n) {
  const int tid = opaque(threadIdx.x), lane = tid & 63, w = __builtin_amdgcn_readfirstlane(tid >> 6), wr = w >> 1, wc = w & 1, l31 = lane & 31, h = lane >> 5;
  const int nk = K >> 6, smask = (1 << A.shift) - 1;
  LASP char* ldsl = (LASP char*)lds;
  f32x16 acc[2][2];
#pragma unroll
  for (int a = 0; a < 2; ++a)
#pragma unroll
    for (int b = 0; b < 2; ++b)
#pragma unroll
      for (int i = 0; i < 16; ++i) acc[a][b][i] = 0.f;
  const int lrow = lane >> 3, lslot = lane & 7;
  int goffA[4], goffB[4];
#pragma unroll
  for (int i = 0; i < 4; ++i) { const int r = w * 32 + i * 8 + lrow, c = lslot ^ ((r >> 1) & 7); goffA[i] = r; goffB[i] = r * K + c * 8; goffA[i] = (goffA[i] << 3) | c; }
#define GEMM_ISSUE(kt, st, M0_, N0_) do { const int k0_ = (kt) << 6, seg_ = k0_ >> A.shift, kk_ = k0_ & smask; \
    const bf16_t* bp_ = seg_ == 0 ? A.b0 : seg_ == 1 ? A.b1 : seg_ == 2 ? A.b2 : A.b3; const int st_ = seg_ == 0 ? A.s0 : seg_ == 1 ? A.s1 : seg_ == 2 ? A.s2 : A.s3; \
    _Pragma("unroll") for (int i_ = 0; i_ < 4; ++i_) { \
      const bf16_t* ga_ = bp_ + (size_t)((M0_) + (goffA[i_] >> 3)) * st_ + kk_ + (goffA[i_] & 7) * 8; \
      __builtin_amdgcn_global_load_lds((const unsigned*)ga_, (LASP unsigned*)(ldsl + (st) * 32768 + (w * 4 + i_) * 1024), 16, 0, 0); \
      const bf16_t* gb_ = Bt + (size_t)(N0_) * K + goffB[i_] + k0_; \
      __builtin_amdgcn_global_load_lds((const unsigned*)gb_, (LASP unsigned*)(ldsl + (st) * 32768 + 16384 + (w * 4 + i_) * 1024), 16, 0, 0); } } while (0)
  const int xr = (l31 >> 1) & 7;
  int coff[4];
#pragma unroll
  for (int s = 0; s < 4; ++s) coff[s] = ((2 * s + h) ^ xr) * 16;
#define GEMM_COMPUTE(st) do { const char* as = lds + (st) * 32768; const char* bs = as + 16384; \
    bf16x8 af[4][2], wf[4][2]; \
    _Pragma("unroll") for (int s = 0; s < 4; ++s) { \
      _Pragma("unroll") for (int mf = 0; mf < 2; ++mf) af[s][mf] = *(const bf16x8*)(as + (wr * 64 + mf * 32 + l31) * 128 + coff[s]); \
      _Pragma("unroll") for (int nf = 0; nf < 2; ++nf) wf[s][nf] = *(const bf16x8*)(bs + (wc * 64 + nf * 32 + l31) * 128 + coff[s]); } \
    __builtin_amdgcn_sched_barrier(0); __builtin_amdgcn_s_setprio(1); \
    _Pragma("unroll") for (int s = 0; s < 4; ++s) \
      _Pragma("unroll") for (int mf = 0; mf < 2; ++mf) _Pragma("unroll") for (int nf = 0; nf < 2; ++nf) acc[mf][nf] = MFMA32(wf[s][nf], af[s][mf], acc[mf][nf]); \
    __builtin_amdgcn_s_setprio(0); __builtin_amdgcn_sched_barrier(0); } while (0)
  if (first) GEMM_ISSUE(0, 0, m0, n0);
  for (int kt = 0; kt < nk; kt += 2) {
    asm volatile("s_waitcnt vmcnt(0)" ::: "memory"); __syncthreads();
    GEMM_ISSUE(kt + 1, 1, m0, n0);
    GEMM_COMPUTE(0);
    asm volatile("s_waitcnt vmcnt(0)" ::: "memory"); __syncthreads();
    if (kt + 2 < nk) GEMM_ISSUE(kt + 2, 0, m0, n0);
    GEMM_COMPUTE(1);
  }
  __syncthreads();
  if (has_next) GEMM_ISSUE(0, 0, m0n, n0n);
  epi(acc, m0 + wr * 64, n0 + wc * 64, n0, wc, l31, h);
  __syncthreads();
#undef GEMM_ISSUE
#undef GEMM_COMPUTE
}

template <class Epi>
DI void gemm_phase(char* lds, const ASrc& A, const bf16_t* Bt, int K, int ntn, const Epi& epi) {
  const int xcd = blockIdx.x & 7, j = blockIdx.x >> 3, nloc = gridDim.x >> 3, per = 48 * ntn, grp = 8 * ntn;
  bool first = true;
  for (int li = j; li < per; li += nloc) {
    const int sg = li / grp, wi = li - sg * grp, nt = wi >> 3, mt = xcd * 48 + sg * 8 + (wi & 7);
    const int ln = li + nloc; const bool has_next = ln < per;
    const int sgn = ln / grp, win = ln - sgn * grp, ntn2 = win >> 3, mtn = xcd * 48 + sgn * 8 + (win & 7);
    gemm_tile(lds, A, Bt, K, mt * 128, nt * 128, epi, first, has_next, mtn * 128, ntn2 * 128);
    first = false;
  }
}

DI void prep_item(char* lds, const Params& p, int layer, int item) {
  const int tid = opaque(threadIdx.x), lane = tid & 63, w = tid >> 6;
  const int rowb = item * 64; int tb, T; row_info(rowb, tb, T);
  const float* qg = p.in[I_AQG] + layer * 64; const float* kg = p.in[I_AKG] + layer * 64;
  const float qgl = qg[lane], kgl = kg[lane];
  for (int tt = 0; tt < 16; ++tt) {
    const int row = rowb + w * 16 + tt, t = tb + w * 16 + tt;
    bf16_t* zr = p.z + (size_t)row * NIN;
    {
      const int j = lane & 31, i = j & 15; const bool first = j < 16; const int pos = (lane < 32) ? (t >> 6) : (t & 63);
      const f32x2 cs = p.tabA[pos * 16 + i];
#pragma unroll
      for (int hd = 0; hd < 6; ++hd) {
        bf16_t* ptr = zr + (hd < 4 ? A_Q + hd * 64 : A_K + (hd - 4) * 64) + lane;
        float v = bf2f(*ptr);
        const float ss = wave_sum(v * v);
        v = v * rsqrtf(ss * (1.0f / 64.0f) + EPS) * (hd < 4 ? qgl : kgl);
        const float o = __shfl_xor(v, 16);
        float r = first ? (v * cs.x - o * cs.y) : (v * cs.x + o * cs.y);
        if (hd < 4) r *= 0.125f * LOG2E;
        *ptr = f2bf(r);
      }
    }
    {
      const int d = lane & 31; const f32x2 cs = p.tabB[t * 4 + (d & 3)];
#pragma unroll
      for (int c = 0; c < 8; ++c) {
        bf16_t* ptr = zr + (c < 4 ? B_Q + c * 64 : B_K + (c - 4) * 64) + lane;
        float v = bf2f(*ptr);
        const float o = __shfl_xor(v, 4);
        float r = v;
        if (d < 8) r = (d < 4) ? (v * cs.x - o * cs.y) : (v * cs.x + o * cs.y);
        if (c < 4) r *= 0.17677669529663687f * LOG2E;
        *ptr = f2bf(r);
      }
    }
    {
      const f32x2 cs = p.tabC[t * 32 + (lane & 31)];
#pragma unroll
      for (int c = 0; c < 8; ++c) {
        bf16_t* ptr = zr + (c < 4 ? C_Q + c * 64 : C_K + (c - 4) * 64) + lane;
        const float v = bf2f(*ptr);
        const float o = __shfl_xor(v, 32);
        float r = (lane < 32) ? (v * cs.x - o * cs.y) : (v * cs.x + o * cs.y);
        if (c >= 4) r *= 0.125f;
        *ptr = f2bf(r);
      }
    }
  }
  bf16_t* tl = (bf16_t*)lds;
  const int r = tid >> 2, c0 = (tid & 3) * 16;
  for (int sl = 0; sl < 10; ++sl) {
    const int col = sl < 2 ? A_V + sl * 64 : sl < 6 ? B_V + (sl - 2) * 64 : C_V + (sl - 6) * 64;
    bf16_t* gp = p.z + (size_t)(rowb + r) * NIN + col + c0;
    const u32x4 v0 = *(const u32x4*)gp, v1 = *(const u32x4*)(gp + 8);
    __syncthreads();
#pragma unroll
    for (int e = 0; e < 4; ++e) {
      tl[(c0 + 2 * e) * 72 + r] = (bf16_t)(v0[e] & 0xffffu); tl[(c0 + 2 * e + 1) * 72 + r] = (bf16_t)(v0[e] >> 16);
      tl[(c0 + 8 + 2 * e) * 72 + r] = (bf16_t)(v1[e] & 0xffffu); tl[(c0 + 8 + 2 * e + 1) * 72 + r] = (bf16_t)(v1[e] >> 16);
    }
    __syncthreads();
    const u32x4 o0 = *(const u32x4*)(tl + r * 72 + c0), o1 = *(const u32x4*)(tl + r * 72 + c0 + 8);
    *(u32x4*)gp = o0; *(u32x4*)(gp + 8) = o1;
  }
  __syncthreads();
}

DI float dshift(const Params& p, const float* mup, const float* mun, int row, int t, int T, int dc) {
  const bf16_t* zp = p.z + (size_t)row * NIN + D_0 + dc;
  const float z = bf2f(*zp);
  const float zprev = (t > 0) ? bf2f(*(zp - NIN)) : 0.f;
  const float znext = (t < T - 1) ? bf2f(*(zp + NIN)) : 0.f;
  return z + mup[dc] * (zprev - z) + mun[dc] * (znext - z);
}
DI float sigmoidf_(float x) { return 1.0f / (1.0f + __expf(-x)); }
DI float omdecay(float ww) {
  const float e = 0.6065306597126334f / (1.0f + __expf(-ww));
  return 1.0f - __expf(-e);
}
DI float fast_tanh(float x) { const float xc = fminf(fmaxf(x, -15.f), 15.f); return 1.0f - 2.0f / (1.0f + __expf(2.0f * xc)); }
constexpr int DTOK = 16;
DI void dprep_item(char* lds, const Params& p, int layer, int item) {
  const int tid = opaque(threadIdx.x);
  const int rowb = item * DTOK; int tb, T; row_info(rowb, tb, T);
  const float* mup = p.in[I_DMUP] + layer * 1088; const float* mun = p.in[I_DMUN] + layer * 1088;
  float* su = (float*)lds;
  bf16_t* stg = (bf16_t*)(lds + 12288);
#pragma unroll
  for (int i = 0; i < 12; ++i) {
    const int idx = tid + 256 * i, tok = idx / 192, c = idx - tok * 192;
    float u = dshift(p, mup, mun, rowb + tok, tb + tok, T, 768 + c);
    if (c < 128) u = fast_tanh(u);
    su[c * DTOK + tok] = u;
  }
  __syncthreads();
  const int c = tid;
  float accf[DTOK], accb[DTOK], acca[DTOK];
#pragma unroll
  for (int k = 0; k < DTOK; ++k) { accf[k] = 0.f; accb[k] = 0.f; acca[k] = 0.f; }
  const float* wupf = p.in[I_DWUP] + (size_t)(layer * 2 + 0) * 64 * 256 + c;
  const float* wupb = p.in[I_DWUP] + (size_t)(layer * 2 + 1) * 64 * 256 + c;
  const float* aup = p.in[I_DAUP] + (size_t)layer * 64 * 256 + c;
#pragma unroll 2
  for (int j = 0; j < 64; ++j) {
    const float wf = wupf[j * 256], wb = wupb[j * 256], wa = aup[j * 256];
#pragma unroll
    for (int q = 0; q < 4; ++q) {
      const f32x4 f0 = *(const f32x4*)(su + j * DTOK + 4 * q), b0 = *(const f32x4*)(su + (64 + j) * DTOK + 4 * q), a0v = *(const f32x4*)(su + (128 + j) * DTOK + 4 * q);
#pragma unroll
      for (int k = 0; k < 4; ++k) { accf[4 * q + k] += f0[k] * wf; accb[4 * q + k] += b0[k] * wb; acca[4 * q + k] += a0v[k] * wa; }
    }
  }
  const float w0f = p.in[I_DW0][(layer * 2 + 0) * 256 + c], w0b = p.in[I_DW0][(layer * 2 + 1) * 256 + c];
  const float a0 = p.in[I_DA0][layer * 256 + c], kkw = p.in[I_DKK][layer * 256 + c], kaw = p.in[I_DKA][layer * 256 + c];
  float zr[DTOK + 2], zk[DTOK + 2], zv[DTOK + 2];
  { const bf16_t* zp = p.z + (size_t)rowb * NIN + D_0 + c;
#pragma unroll
    for (int i = 0; i < DTOK + 2; ++i) { const int t = tb - 1 + i; const bool ok = (t >= 0) && (t < T); const bf16_t* q = zp + (ptrdiff_t)(i - 1) * NIN;
      zr[i] = ok ? bf2f(q[0]) : 0.f; zk[i] = ok ? bf2f(q[256]) : 0.f; zv[i] = ok ? bf2f(q[512]) : 0.f; } }
  const float mpr = mup[c], mnr = mun[c], mpk = mup[256 + c], mnk = mun[256 + c], mpv = mup[512 + c], mnv = mun[512 + c];
#pragma unroll
  for (int k = 0; k < DTOK; ++k) {
    const float r = zr[k + 1] + mpr * (zr[k] - zr[k + 1]) + mnr * (zr[k + 2] - zr[k + 1]);
    const float kx = zk[k + 1] + mpk * (zk[k] - zk[k + 1]) + mnk * (zk[k + 2] - zk[k + 1]);
    const float v = zv[k + 1] + mpv * (zv[k] - zv[k + 1]) + mnv * (zv[k + 2] - zv[k + 1]);
    const float omf = omdecay(w0f + accf[k]), omb = omdecay(w0b + accb[k]);
    const float a = sigmoidf_(a0 + acca[k]);
    float kk = kx * kkw; const float n2 = wave_sum(kk * kk);
    kk = kk * rsqrtf(fmaxf(n2, 1e-24f));
    const float kmod = kx * (1.0f + (a - 1.0f) * kaw), b = kk * a;
    bf16_t* so = stg + k * 256 + c;
    so[0] = f2bf(r); so[DTOK * 256] = f2bf(kmod); so[2 * DTOK * 256] = f2bf(v); so[3 * DTOK * 256] = f2bf(-kk);
    so[4 * DTOK * 256] = f2bf(b); so[5 * DTOK * 256] = f2bf(omf); so[6 * DTOK * 256] = f2bf(omb);
  }
  __syncthreads();
#pragma unroll
  for (int i = 0; i < 14; ++i) {
    const int q = tid + 256 * i, pln = q >> 9, rem = q & 511, tok = rem >> 5, c16 = rem & 31;
    const u32x4 v = *(const u32x4*)(stg + pln * (DTOK * 256) + tok * 256 + c16 * 8);
    *(u32x4*)(p.pl + (size_t)pln * PLANE + (size_t)(rowb + tok) * 256 + c16 * 8) = v;
  }
  __syncthreads();
}

DI void dpost_item(char* lds, const Params& p, int layer, int item) {
  const int tid = opaque(threadIdx.x);
  const int rowb = item * DTOK; int tb, T; row_info(rowb, tb, T);
  const float* mup = p.in[I_DMUP] + layer * 1088; const float* mun = p.in[I_DMUN] + layer * 1088;
  float* sg = (float*)lds;
  bf16_t* stg = (bf16_t*)(lds + 8192);
#pragma unroll
  for (int i = 0; i < 8; ++i) { const int idx = tid + 256 * i, tok = idx >> 7, c = idx & 127; sg[c * DTOK + tok] = sigmoidf_(dshift(p, mup, mun, rowb + tok, tb + tok, T, 960 + c)); }
  __syncthreads();
  const int c = tid;
  float acc[DTOK];
#pragma unroll
  for (int k = 0; k < DTOK; ++k) acc[k] = 0.f;
  const float* gup = p.in[I_DGUP] + (size_t)layer * 128 * 256 + c;
#pragma unroll 4
  for (int j = 0; j < 128; ++j) { const float gw = gup[j * 256];
#pragma unroll
    for (int q = 0; q < 4; ++q) { const f32x4 s0 = *(const f32x4*)(sg + j * DTOK + 4 * q);
#pragma unroll
      for (int k = 0; k < 4; ++k) acc[4 * q + k] += s0[k] * gw; } }
  const float gnw = p.in[I_DGNW][layer * 256 + c], gnb = p.in[I_DGNB][layer * 256 + c], rk = p.in[I_DRK][layer * 256 + c];
#pragma unroll
  for (int k = 0; k < DTOK; ++k) {
    const int row = rowb + k;
    const bf16_t* zd = p.z + (size_t)row * NIN + D_0;
    const float y = bf2f(zd[c]) + bf2f(zd[256 + c]);
    const float mean = wave_sum(y) * (1.0f / 64.0f); const float d = y - mean; const float var = wave_sum(d * d) * (1.0f / 64.0f);
    const float yn = d * rsqrtf(var + 64e-5f) * gnw + gnb;
    const size_t o = (size_t)row * 256 + c;
    const float r = bf2f(p.pl[o]), km = bf2f(p.pl[PLANE + o]), v = bf2f(p.pl[2 * PLANE + o]);
    const float bonus = wave_sum(r * km * rk);
    stg[k * 256 + c] = f2bf((yn + bonus * v) * acc[k]);
  }
  __syncthreads();
#pragma unroll
  for (int i = 0; i < 2; ++i) { const int q = tid + 256 * i, tok = q >> 5, c16 = q & 31;
    const u32x4 v = *(const u32x4*)(stg + tok * 256 + c16 * 8);
    *(u32x4*)(p.pl + 4 * PLANE + (size_t)(rowb + tok) * 256 + c16 * 8) = v; }
  __syncthreads();
}

DI void rwkv_item(char* lds, const Params& p, int seq, int head, int dir, int half) {
  int row0, T; seq_info(seq, row0, T);
  const int tid = opaque(threadIdx.x), kc = tid & 7, vrow = half * 32 + (tid >> 3);
  float* st = (float*)lds;
  f32x2 S[4];
#pragma unroll
  for (int j = 0; j < 4; ++j) S[j] = (f32x2){0.f, 0.f};
  const int nchunk = T >> 4;
  u32x4 rg[3];
  const int tsel = tid >> 7, srem = tid & 127, sstep = srem >> 3, sc8 = srem & 7;
#define RW_GLOAD(c) do { _Pragma("unroll") for (int i_ = 0; i_ < 3; ++i_) { const int tens_ = tsel + 2 * i_; \
      const int plane_ = tens_ == 0 ? (dir ? 6 : 5) : tens_ == 1 ? 3 : tens_ == 2 ? 4 : tens_ == 3 ? 1 : tens_ == 4 ? 0 : 2; \
      const int t_ = dir ? (T - 1 - ((c) * 16 + sstep)) : ((c) * 16 + sstep); \
      rg[i_] = *(const u32x4*)(p.pl + (size_t)plane_ * PLANE + (size_t)(row0 + t_) * 256 + head * 64 + sc8 * 8); } } while (0)
#define RW_LSTORE(buf) do { _Pragma("unroll") for (int i_ = 0; i_ < 3; ++i_) { const int tens_ = tsel + 2 * i_; \
      f32x4 a_ = {bflo(rg[i_].x), bfhi(rg[i_].x), bflo(rg[i_].y), bfhi(rg[i_].y)}, b_ = {bflo(rg[i_].z), bfhi(rg[i_].z), bflo(rg[i_].w), bfhi(rg[i_].w)}; \
      if (tens_ == 0) { a_ = 1.0f - a_; b_ = 1.0f - b_; } \
      float* d_ = st + (((buf) * 16 + sstep) * 6 + tens_) * 64 + sc8 * 8; *(f32x4*)d_ = a_; *(f32x4*)(d_ + 4) = b_; } } while (0)
  __builtin_amdgcn_s_setprio(3);
  RW_GLOAD(0); RW_LSTORE(0); __syncthreads();
  bf16_t* ybase = p.z + (size_t)row0 * NIN + D_0 + dir * 256 + head * 64 + vrow;
  for (int c = 0; c < nchunk; ++c) {
    if (c + 1 < nchunk) RW_GLOAD(c + 1);
    const float* sb = st + (c & 1) * (16 * 384);
#define RW_FETCH(S_, s_) do { const float* q_ = sb + (s_) * 384 + kc * 8; \
      S_##w0 = *(const f32x4*)(q_); S_##w1 = *(const f32x4*)(q_ + 4); S_##n0 = *(const f32x4*)(q_ + 64); S_##n1 = *(const f32x4*)(q_ + 68); \
      S_##b0 = *(const f32x4*)(q_ + 128); S_##b1 = *(const f32x4*)(q_ + 132); S_##k0 = *(const f32x4*)(q_ + 192); S_##k1 = *(const f32x4*)(q_ + 196); \
      S_##r0 = *(const f32x4*)(q_ + 256); S_##r1 = *(const f32x4*)(q_ + 260); S_##vv = sb[(s_) * 384 + 320 + vrow]; } while (0)
#define LO2(x) ((f32x2){(x)[0], (x)[1]})
#define HI2(x) ((f32x2){(x)[2], (x)[3]})
#define RW_STEP(S_, s_) do { \
      f32x2 a2 = S[0] * LO2(S_##n0); a2 += S[1] * HI2(S_##n0); a2 += S[2] * LO2(S_##n1); a2 += S[3] * HI2(S_##n1); \
      const float sa = red8(a2.x + a2.y); const float vx = S_##vv; \
      S[0] = S[0] * LO2(S_##w0) + (LO2(S_##b0) * sa + LO2(S_##k0) * vx); S[1] = S[1] * HI2(S_##w0) + (HI2(S_##b0) * sa + HI2(S_##k0) * vx); \
      S[2] = S[2] * LO2(S_##w1) + (LO2(S_##b1) * sa + LO2(S_##k1) * vx); S[3] = S[3] * HI2(S_##w1) + (HI2(S_##b1) * sa + HI2(S_##k1) * vx); \
      f32x2 y2 = S[0] * LO2(S_##r0); y2 += S[1] * HI2(S_##r0); y2 += S[2] * LO2(S_##r1); y2 += S[3] * HI2(S_##r1); \
      const float y = red8(y2.x + y2.y); const float yn = DPPF(y, 0x128);     \
      if ((tid & 15) == 0) { const int t_ = dir ? (T - 1 - (c * 16 + (s_))) : (c * 16 + (s_)); *(unsigned*)(ybase + (size_t)t_ * NIN) = pk(y, yn); } } while (0)
    f32x4 Aw0, Aw1, An0, An1, Ab0, Ab1, Ak0, Ak1, Ar0, Ar1; float Avv;
    f32x4 Bw0, Bw1, Bn0, Bn1, Bb0, Bb1, Bk0, Bk1, Br0, Br1; float Bvv;
    RW_FETCH(A, 0);
#pragma unroll 2
    for (int s = 0; s < 16; s += 2) {
      RW_FETCH(B, s + 1);
      RW_STEP(A, s);
      if (s + 2 < 16) RW_FETCH(A, s + 2);
      RW_STEP(B, s + 1);
    }
#undef RW_FETCH
#undef RW_STEP
    if (c + 1 < nchunk) RW_LSTORE((c + 1) & 1);
    __syncthreads();
  }
#undef RW_GLOAD
#undef RW_LSTORE
  __builtin_amdgcn_s_setprio(0);
}

template <int MODE>
DI void attn_item(char* lds, const Params& p, int layer, int seq, int head, int qt) {
  const int tid = opaque(threadIdx.x), lane = tid & 63, w = tid >> 6, l31 = lane & 31, h = lane >> 5;
  layer = opaque_s(layer); seq = opaque_s(seq); head = opaque_s(head); qt = opaque_s(qt);
  int row0, T; seq_info(seq, row0, T);
  const int QC = (MODE == 0 ? A_Q : MODE == 1 ? B_Q : C_Q) + head * 64;
  const int KC = MODE == 0 ? A_K + (head >> 1) * 64 : MODE == 1 ? B_K + head * 64 : C_K + head * 64;
  const int VC = MODE == 0 ? A_V + (head >> 1) * 64 : MODE == 1 ? B_V + head * 64 : C_V + head * 64;
  const int qw0 = qt * 128 + w * 32, qi = qw0 + l31;
  bf16_t* zq = p.z + (size_t)(row0 + qi) * NIN + QC;
  bf16x8 qf[4];
#pragma unroll
  for (int s = 0; s < 4; ++s) qf[s] = *(const bf16x8*)(zq + s * 16 + h * 8);
  const int srow = tid >> 3, sc8 = tid & 7;
  const bf16_t* kbase = p.z + (size_t)(row0 + srow) * NIN + KC + sc8 * 8;
  const bf16_t* vbase = p.z + (size_t)(row0 + srow) * NIN + VC + sc8 * 8;
  u32x4 rk[2][2], rv[2][2];
  const int nt = T >> 6;
  const int prow = (l31 & 19) | ((l31 & 4) << 1) | ((l31 & 8) >> 1);
#define AT_GLOAD(t, S) do { _Pragma("unroll") for (int i_ = 0; i_ < 2; ++i_) { const size_t off_ = (size_t)((t) * 64 + 32 * i_) * NIN; rk[S][i_] = *(const u32x4*)(kbase + off_); rv[S][i_] = *(const u32x4*)(vbase + off_); } } while (0)
#define AT_LSTORE(buf, S) do { char* ks_ = lds + (buf) * 18432; char* vs_ = ks_ + 9216; \
    _Pragma("unroll") for (int i_ = 0; i_ < 2; ++i_) { *(u32x4*)(ks_ + (srow + 32 * i_) * PITCH + sc8 * 16) = rk[S][i_]; *(u32x4*)(vs_ + (srow + 32 * i_) * PITCH + sc8 * 16) = rv[S][i_]; } } while (0)
  constexpr int NMAP = (MODE == 1) ? 2 : 1;
  f32x16 o[NMAP][2];
  float m_run[NMAP], l_run[NMAP];
#pragma unroll
  for (int a = 0; a < NMAP; ++a) { m_run[a] = -INFINITY; l_run[a] = 0.f;
#pragma unroll
    for (int b = 0; b < 2; ++b)
#pragma unroll
      for (int i = 0; i < 16; ++i) o[a][b][i] = 0.f; }
  float lf = 0.f, lb = 0.f;
  if (MODE == 2) { lf = log2f(1.0f - exp2f(-5.0f - (float)head)); lb = log2f(1.0f - exp2f(-5.0f - (float)(3 - head))); }
  auto body = [&](const char* ks, const char* vs, const int t) __attribute__((always_inline)) {
#pragma unroll
    for (int mp = 0; mp < NMAP; ++mp) {
      f32x16 st[2];
#pragma unroll
      for (int kf = 0; kf < 2; ++kf) {
#pragma unroll
        for (int i = 0; i < 16; ++i) st[kf][i] = 0.f;
        if (MODE == 1) {
#pragma unroll
          for (int s = 0; s < 2; ++s) { const bf16x8 kfr = *(const bf16x8*)(ks + (kf * 32 + prow) * PITCH + (mp * 2 + s) * 32 + h * 16); st[kf] = MFMA32(kfr, qf[mp * 2 + s], st[kf]); }
        } else {
#pragma unroll
          for (int s = 0; s < 4; ++s) { const bf16x8 kfr = *(const bf16x8*)(ks + (kf * 32 + prow) * PITCH + s * 32 + h * 16); st[kf] = MFMA32(kfr, qf[s], st[kf]); }
        }
      }
      if (MODE == 2) {
        const int k0 = t * 64;
        const float dbase = (float)(qi - k0 - 8 * h);
        if (k0 + 63 < qw0) {
#pragma unroll
          for (int kf = 0; kf < 2; ++kf)
#pragma unroll
            for (int i = 0; i < 16; ++i) { const float cc = (float)(32 * kf + (i & 3) + 4 * ((i >> 2) & 1) + 16 * ((i >> 3) & 1)); st[kf][i] *= fexp2(lf * (dbase - cc)); }
        } else if (k0 > qw0 + 31) {
#pragma unroll
          for (int kf = 0; kf < 2; ++kf)
#pragma unroll
            for (int i = 0; i < 16; ++i) { const float cc = (float)(32 * kf + (i & 3) + 4 * ((i >> 2) & 1) + 16 * ((i >> 3) & 1)); st[kf][i] *= fexp2(lb * (cc - dbase)); }
        } else {
#pragma unroll
          for (int kf = 0; kf < 2; ++kf)
#pragma unroll
            for (int i = 0; i < 16; ++i) { const float cc = (float)(32 * kf + (i & 3) + 4 * ((i >> 2) & 1) + 16 * ((i >> 3) & 1)); const float d = dbase - cc;
              float dd = fexp2(fminf(lf * d, -lb * d)); if (d == 0.f) dd = 2.0f; st[kf][i] *= dd; }
        }
      } else {
        float mx = st[0][0];
#pragma unroll
        for (int kf = 0; kf < 2; ++kf)
#pragma unroll
          for (int i = 0; i < 16; ++i) mx = fmaxf(mx, st[kf][i]);
        mx = fmaxf(mx, __shfl_xor(mx, 32));
        const float mn = fmaxf(m_run[mp], mx); const float alpha = fexp2(m_run[mp] - mn); m_run[mp] = mn;
        float ps = 0.f;
#pragma unroll
        for (int kf = 0; kf < 2; ++kf)
#pragma unroll
          for (int i = 0; i < 16; ++i) { st[kf][i] = fexp2(st[kf][i] - mn); ps += st[kf][i]; }
        l_run[mp] = l_run[mp] * alpha + ps;
#pragma unroll
        for (int df = 0; df < 2; ++df) o[mp][df] *= alpha;
      }
      bf16x8 pf[4];
#pragma unroll
      for (int kf = 0; kf < 2; ++kf)
#pragma unroll
        for (int s2 = 0; s2 < 2; ++s2) { u32x4 u; u.x = pk(st[kf][8 * s2], st[kf][8 * s2 + 1]); u.y = pk(st[kf][8 * s2 + 2], st[kf][8 * s2 + 3]);
          u.z = pk(st[kf][8 * s2 + 4], st[kf][8 * s2 + 5]); u.w = pk(st[kf][8 * s2 + 6], st[kf][8 * s2 + 7]); pf[kf * 2 + s2] = __builtin_bit_cast(bf16x8, u); }
#pragma unroll
      for (int df = 0; df < 2; ++df)
#pragma unroll
        for (int ksx = 0; ksx < 4; ++ksx) { const bf16x8 vfr = *(const bf16x8*)(vs + (df * 32 + l31) * PITCH + ksx * 32 + h * 16); o[mp][df] = MFMA32(vfr, pf[ksx], o[mp][df]); }
    }
  };
  if constexpr (MODE == 1) {
    AT_GLOAD(0, 0); AT_LSTORE(0, 0); __syncthreads();
#pragma unroll 1
    for (int t = 0; t < nt; ++t) {
      if (t + 1 < nt) AT_GLOAD(t + 1, 0);
      const char* ks = lds + (t & 1) * 18432;
      body(ks, ks + 9216, t);
      if (t + 1 < nt) AT_LSTORE((t + 1) & 1, 0);
      __syncthreads();
    }
  } else {
    AT_GLOAD(0, 0); AT_GLOAD(1, 1); AT_LSTORE(0, 0); __syncthreads();
#pragma unroll 1
    for (int t2 = 0; t2 < nt; t2 += 2) {
      if (t2 + 2 < nt) AT_GLOAD(t2 + 2, 0);
      body(lds, lds + 9216, t2);
      AT_LSTORE(1, 1);
      __syncthreads();
      if (t2 + 3 < nt) AT_GLOAD(t2 + 3, 1);
      body(lds + 18432, lds + 18432 + 9216, t2 + 1);
      if (t2 + 2 < nt) AT_LSTORE(0, 0);
      __syncthreads();
    }
  }
#undef AT_GLOAD
#undef AT_LSTORE
  f32x16 r[2];
  if (MODE == 0) {
    const float l = l_run[0] + __shfl_xor(l_run[0], 32); const float inv = 1.0f / l;
#pragma unroll
    for (int df = 0; df < 2; ++df) r[df] = o[0][df] * inv;
  } else if (MODE == 1) {
    const float* lp = p.in[I_BLAM] + layer * 128;
    float s01 = 0.f, s23 = 0.f;
    for (int i = 0; i < 32; ++i) { s01 += lp[i] * lp[32 + i]; s23 += lp[64 + i] * lp[96 + i]; }
    const float lam_init = 0.8f - 0.6f * expf(-0.3f * (float)layer);
    const float lam = expf(s01) - expf(s23) + lam_init;
    const float l0 = l_run[0] + __shfl_xor(l_run[0], 32), l1 = l_run[NMAP - 1] + __shfl_xor(l_run[NMAP - 1], 32);
    const float i0 = 1.0f / l0, i1 = lam / l1;
    float ss = 0.f;
#pragma unroll
    for (int df = 0; df < 2; ++df) { r[df] = o[0][df] * i0 - o[NMAP - 1][df] * i1;
#pragma unroll
      for (int i = 0; i < 16; ++i) ss += r[df][i] * r[df][i]; }
    ss += __shfl_xor(ss, 32);
    const float rs = rsqrtf(ss * (1.0f / 64.0f) + EPS) * (1.0f - lam_init);
    const float* sg = p.in[I_BSUB] + layer * 64;
#pragma unroll
    for (int df = 0; df < 2; ++df)
#pragma unroll
      for (int i = 0; i < 16; ++i) r[df][i] *= rs * sg[df * 32 + (i & 3) + 8 * (i >> 2) + 4 * h];
  } else {
    float ss = 0.f;
#pragma unroll
    for (int df = 0; df < 2; ++df)
#pragma unroll
      for (int i = 0; i < 16; ++i) ss += o[0][df][i] * o[0][df][i];
    ss += __shfl_xor(ss, 32);
    const float rs = rsqrtf(ss * (1.0f / 64.0f) + EPS);
    const float* gg = p.in[I_CGN] + layer * 256 + head * 64;
    const bf16_t* zg = p.z + (size_t)(row0 + qi) * NIN + C_G + head * 64;
#pragma unroll
    for (int df = 0; df < 2; ++df)
#pragma unroll
      for (int g = 0; g < 4; ++g) { const u32x2 gw = *(const u32x2*)(zg + df * 32 + 8 * g + 4 * h);
        const float gv[4] = {bflo(gw.x), bfhi(gw.x), bflo(gw.y), bfhi(gw.y)};
#pragma unroll
        for (int e = 0; e < 4; ++e) { const float x = gv[e]; r[df][4 * g + e] = o[0][df][4 * g + e] * rs * gg[df * 32 + 8 * g + 4 * h + e] * (x / (1.0f + __expf(-x))); } }
  }
#pragma unroll
  for (int df = 0; df < 2; ++df)
#pragma unroll
    for (int g = 0; g < 4; ++g) { u32x2 v; v.x = pk(r[df][4 * g], r[df][4 * g + 1]); v.y = pk(r[df][4 * g + 2], r[df][4 * g + 3]); *(u32x2*)(zq + df * 32 + 8 * g + 4 * h) = v; }
}

template <int MODE>
DI void attn3_item(char* lds, const Params& p, int layer, int seq, int head, int qt) {
  const int tid = opaque(threadIdx.x), lane = tid & 63, w = tid >> 6, l31 = lane & 31, h = lane >> 5;
  layer = opaque_s(layer); seq = opaque_s(seq); head = opaque_s(head); qt = opaque_s(qt);
  int row0, T; seq_info(seq, row0, T);
  const int QC = (MODE == 0 ? A_Q : C_Q) + head * 64;
  const int KC = MODE == 0 ? A_K + (head >> 1) * 64 : C_K + head * 64;
  const int VC = MODE == 0 ? A_V + (head >> 1) * 64 : C_V + head * 64;
  const int qw0 = qt * 256 + w * 64;
  bf16x8 qf[2][4];
#pragma unroll
  for (int qi = 0; qi < 2; ++qi)
#pragma unroll
    for (int s = 0; s < 4; ++s) qf[qi][s] = *(const bf16x8*)(p.z + (size_t)(row0 + qw0 + qi * 32 + l31) * NIN + QC + s * 16 + h * 8);
  const int srow = tid >> 3, sc8 = tid & 7;
  const bf16_t* kbase = p.z + (size_t)(row0 + srow) * NIN + KC + sc8 * 8;
  const bf16_t* vbase = p.z + (size_t)(row0 + srow) * NIN + VC + sc8 * 8;
  u32x4 rk[2], rv[2];
  const int nt = T >> 6;
  const int prow = (l31 & 19) | ((l31 & 4) << 1) | ((l31 & 8) >> 1);
#define A3_GLOAD(t) do { _Pragma("unroll") for (int i_ = 0; i_ < 2; ++i_) { const size_t off_ = (size_t)((t) * 64 + 32 * i_) * NIN; rk[i_] = *(const u32x4*)(kbase + off_); rv[i_] = *(const u32x4*)(vbase + off_); } } while (0)
#define A3_LSTORE(buf) do { char* ks_ = lds + (buf) * 18432; char* vs_ = ks_ + 9216; \
    _Pragma("unroll") for (int i_ = 0; i_ < 2; ++i_) { *(u32x4*)(ks_ + (srow + 32 * i_) * PITCH + sc8 * 16) = rk[i_]; *(u32x4*)(vs_ + (srow + 32 * i_) * PITCH + sc8 * 16) = rv[i_]; } } while (0)
  f32x16 o[2][2];
  float m_run[2], l_run[2];
#pragma unroll
  for (int a = 0; a < 2; ++a) { m_run[a] = -INFINITY; l_run[a] = 0.f;
#pragma unroll
    for (int b = 0; b < 2; ++b)
#pragma unroll
      for (int i = 0; i < 16; ++i) o[a][b][i] = 0.f; }
  float lf = 0.f, lb = 0.f;
  if (MODE == 2) { lf = log2f(1.0f - exp2f(-5.0f - (float)head)); lb = log2f(1.0f - exp2f(-5.0f - (float)(3 - head))); }
  A3_GLOAD(0); A3_LSTORE(0); __syncthreads();
#pragma unroll 1
  for (int t = 0; t < nt; ++t) {
    if (t + 1 < nt) A3_GLOAD(t + 1);
    const char* ks = lds + (t & 1) * 18432; const char* vs = ks + 9216;
    f32x16 st[2][2];
#pragma unroll
    for (int kf = 0; kf < 2; ++kf) {
#pragma unroll
      for (int qi = 0; qi < 2; ++qi)
#pragma unroll
        for (int i = 0; i < 16; ++i) st[qi][kf][i] = 0.f;
#pragma unroll
      for (int s = 0; s < 4; ++s) { const bf16x8 kfr = *(const bf16x8*)(ks + (kf * 32 + prow) * PITCH + s * 32 + h * 16);
#pragma unroll
        for (int qi = 0; qi < 2; ++qi) st[qi][kf] = MFMA32(kfr, qf[qi][s], st[qi][kf]); }
    }
    __builtin_amdgcn_sched_barrier(0);
#pragma unroll
    for (int qi = 0; qi < 2; ++qi) {
      bf16x8 pf[4];
      if (MODE == 2) {
        const int k0 = t * 64, qb = qw0 + qi * 32;
        const float dbase = (float)(qb + l31 - k0 - 8 * h);
        if (k0 + 63 < qb) {
#pragma unroll
          for (int kf = 0; kf < 2; ++kf)
#pragma unroll
            for (int i = 0; i < 16; ++i) { const float cc = (float)(32 * kf + (i & 3) + 4 * ((i >> 2) & 1) + 16 * ((i >> 3) & 1)); st[qi][kf][i] *= fexp2(lf * (dbase - cc)); }
        } else if (k0 > qb + 31) {
#pragma unroll
          for (int kf = 0; kf < 2; ++kf)
#pragma unroll
            for (int i = 0; i < 16; ++i) { const float cc = (float)(32 * kf + (i & 3) + 4 * ((i >> 2) & 1) + 16 * ((i >> 3) & 1)); st[qi][kf][i] *= fexp2(lb * (cc - dbase)); }
        } else {
#pragma unroll
          for (int kf = 0; kf < 2; ++kf)
#pragma unroll
            for (int i = 0; i < 16; ++i) { const float cc = (float)(32 * kf + (i & 3) + 4 * ((i >> 2) & 1) + 16 * ((i >> 3) & 1)); const float d = dbase - cc;
              float dd = fexp2(fminf(lf * d, -lb * d)); if (d == 0.f) dd = 2.0f; st[qi][kf][i] *= dd; }
        }
      } else {
        float mx = st[qi][0][0];
#pragma unroll
        for (int kf = 0; kf < 2; ++kf)
#pragma unroll
          for (int i = 0; i < 16; ++i) mx = fmaxf(mx, st[qi][kf][i]);
        mx = fmaxf(mx, __shfl_xor(mx, 32));
        const float mn = fmaxf(m_run[qi], mx); const float alpha = fexp2(m_run[qi] - mn); m_run[qi] = mn;
        float ps = 0.f;
#pragma unroll
        for (int kf = 0; kf < 2; ++kf)
#pragma unroll
          for (int i = 0; i < 16; ++i) { st[qi][kf][i] = fexp2(st[qi][kf][i] - mn); ps += st[qi][kf][i]; }
        l_run[qi] = l_run[qi] * alpha + ps;
#pragma unroll
        for (int df = 0; df < 2; ++df) o[qi][df] *= alpha;
      }
#pragma unroll
      for (int kf = 0; kf < 2; ++kf)
#pragma unroll
        for (int s2 = 0; s2 < 2; ++s2) { u32x4 u; u.x = pk(st[qi][kf][8 * s2], st[qi][kf][8 * s2 + 1]); u.y = pk(st[qi][kf][8 * s2 + 2], st[qi][kf][8 * s2 + 3]);
          u.z = pk(st[qi][kf][8 * s2 + 4], st[qi][kf][8 * s2 + 5]); u.w = pk(st[qi][kf][8 * s2 + 6], st[qi][kf][8 * s2 + 7]); pf[kf * 2 + s2] = __builtin_bit_cast(bf16x8, u); }
#pragma unroll
      for (int df = 0; df < 2; ++df)
#pragma unroll
        for (int ksx = 0; ksx < 4; ++ksx) { const bf16x8 vfr = *(const bf16x8*)(vs + (df * 32 + l31) * PITCH + ksx * 32 + h * 16); o[qi][df] = MFMA32(vfr, pf[ksx], o[qi][df]); }
      __builtin_amdgcn_sched_barrier(0);
    }
    __builtin_amdgcn_sched_barrier(0);
    if (t + 1 < nt) A3_LSTORE((t + 1) & 1);
    __syncthreads();
  }
#undef A3_GLOAD
#undef A3_LSTORE
#pragma unroll
  for (int qi = 0; qi < 2; ++qi) {
    const int qrow = row0 + qw0 + qi * 32 + l31;
    bf16_t* zq = p.z + (size_t)qrow * NIN + QC;
    f32x16 r[2];
    if (MODE == 0) {
      const float l = l_run[qi] + __shfl_xor(l_run[qi], 32); const float inv = 1.0f / l;
#pragma unroll
      for (int df = 0; df < 2; ++df) r[df] = o[qi][df] * inv;
    } else {
      float ss = 0.f;
#pragma unroll
      for (int df = 0; df < 2; ++df)
#pragma unroll
        for (int i = 0; i < 16; ++i) ss += o[qi][df][i] * o[qi][df][i];
      ss += __shfl_xor(ss, 32);
      const float rs = rsqrtf(ss * (1.0f / 64.0f) + EPS);
      const float* gg = p.in[I_CGN] + layer * 256 + head * 64;
      const bf16_t* zg = p.z + (size_t)qrow * NIN + C_G + head * 64;
#pragma unroll
      for (int df = 0; df < 2; ++df)
#pragma unroll
        for (int g = 0; g < 4; ++g) { const u32x2 gw = *(const u32x2*)(zg + df * 32 + 8 * g + 4 * h);
          const float gv[4] = {bflo(gw.x), bfhi(gw.x), bflo(gw.y), bfhi(gw.y)};
#pragma unroll
          for (int e = 0; e < 4; ++e) { const float x = gv[e]; r[df][4 * g + e] = o[qi][df][4 * g + e] * rs * gg[df * 32 + 8 * g + 4 * h + e] * (x / (1.0f + __expf(-x))); } }
    }
#pragma unroll
    for (int df = 0; df < 2; ++df)
#pragma unroll
      for (int g = 0; g < 4; ++g) { u32x2 v; v.x = pk(r[df][4 * g], r[df][4 * g + 1]); v.y = pk(r[df][4 * g + 2], r[df][4 * g + 3]); *(u32x2*)(zq + df * 32 + 8 * g + 4 * h) = v; }
  }
}

DI int next_item(int* ctr, int* sh) {
  __syncthreads();
  if (threadIdx.x == 0) *sh = atomicAdd(ctr, 1);
  __syncthreads();
  return *sh;
}

__global__ void __launch_bounds__(256, 2) fwd(Params p) {
  extern __shared__ __attribute__((aligned(16))) char lds[];
  __shared__ int s_item;
  cg::grid_group grid = cg::this_grid();
  const int bid = blockIdx.x, nb = gridDim.x, tid = threadIdx.x, lane = tid & 63, w = tid >> 6;
  if (bid == 0 && tid < 64) p.ctr[tid] = 0;
  for (int i = bid * 256 + tid; i < 4096 * 32; i += nb * 256) { const int t = i >> 5, j = i & 31; const float inv = powf(10000.0f, -(float)(2 * j) / 64.0f); float sn, cs; sincosf((float)t * inv, &sn, &cs); p.tabC[i] = (f32x2){cs, sn}; }
  for (int i = bid * 256 + tid; i < 4096 * 4; i += nb * 256) { const int t = i >> 2, j = i & 3; const float inv = powf(500000.0f, -(float)(2 * j) / 8.0f); float sn, cs; sincosf((float)t * inv, &sn, &cs); p.tabB[i] = (f32x2){cs, sn}; }
  for (int i = bid * 256 + tid; i < 64 * 16; i += nb * 256) { const int t = i >> 4, j = i & 15; const float inv = powf(10000.0f, -(float)(2 * j) / 32.0f); float sn, cs; sincosf((float)t * inv, &sn, &cs); p.tabA[i] = (f32x2){cs, sn}; }
  for (int l = 0; l < 2; ++l) {
    for (int i = bid * 256 + tid; i < 64 * 1024; i += nb * 256) p.wtin[(size_t)l * NINP * 1024 + (size_t)NIN * 1024 + i] = 0;
    for (int tl = bid; tl < 16 * 53; tl += nb) conv_T(lds, p.in[I_WIN] + (size_t)l * 1024 * NIN, 1024, NIN, p.wtin + (size_t)l * NINP * 1024, 0, tl);
    for (int tl = bid; tl < 16 * 16; tl += nb) conv_T(lds, p.in[I_WOUT] + (size_t)l * 1024 * 1024, 1024, 1024, p.wtout + (size_t)l * 1024 * 1024, 0, tl);
  }
  bf16_t* hb = p.pl;
  for (int row = bid * 4 + opaque(w); row < MT; row += nb * 4) {
    const float* xin = row < M0 ? p.in[I_XP] + (size_t)row * 1024 : p.in[I_XS] + (size_t)(row - M0) * 1024;
    row_phase(xin, p.out + (size_t)row * 1024, nullptr, nullptr, p.in[I_NMPRE], hb + (size_t)row * 1024, lane);
  }
  grid.sync();
  for (int l = 0; l < 2; ++l) {
    { ASrc A; A.b0 = hb; A.b1 = hb; A.b2 = hb; A.b3 = hb; A.s0 = A.s1 = A.s2 = A.s3 = 1024; A.shift = 12;
      EpiIn e; e.z = p.z; e.lds = lds; e.qg = p.in[I_AQG] + l * 64; e.kg = p.in[I_AKG] + l * 64; e.tabA = p.tabA; e.tabB = p.tabB; e.tabC = p.tabC;
      gemm_phase(lds, A, p.wtin + (size_t)l * NINP * 1024, 1024, 27, e); }
    grid.sync();
    for (int it = bid; it < MT / DTOK; it += nb) dprep_item(lds, p, l, it);
    grid.sync();
    for (;;) {
      const int it = next_item(p.ctr + l * 16, &s_item);
      if (it >= 256 + 2048 + 1024) break;
      if (it < 256) { const int i2 = it >> 1; const int sq = i2 < 64 ? (i2 >> 3) : 8 + ((i2 - 64) >> 3); rwkv_item(lds, p, sq, (i2 >> 1) & 3, i2 & 1, it & 1); }
      else {
        int j = it - 256;
        if (j < 2048) {
          if (j < 1024) attn_item<1>(lds, p, l, j >> 7, (j >> 5) & 3, j & 31);
          else { const int r = (j - 1024) & 511; if (j < 1536) attn3_item<2>(lds, p, l, r >> 6, (r >> 4) & 3, r & 15); else attn3_item<0>(lds, p, l, r >> 6, (r >> 4) & 3, r & 15); }
        } else { j -= 2048;
          if (j < 512) attn_item<1>(lds, p, l, 8 + (j >> 6), (j >> 4) & 3, j & 15);
          else { const int r = (j - 512) & 255; if (j < 768) attn3_item<2>(lds, p, l, 8 + (r >> 5), (r >> 3) & 3, r & 7); else attn3_item<0>(lds, p, l, 8 + (r >> 5), (r >> 3) & 3, r & 7); }
        }
      }
    }
    grid.sync();
    bf16_t* wtgu = p.pl + 5 * PLANE; bf16_t* wtd = wtgu + (size_t)2 * DFF * 1024;
    for (int it = bid; it < MT / DTOK + 3 * 704; it += nb) {
      if (it < MT / DTOK) dpost_item(lds, p, l, it);
      else { const int j = it - MT / DTOK;
        if (j < 704) conv_T(lds, p.in[I_FG] + (size_t)l * 1024 * DFF, 1024, DFF, wtgu, 1, j);
        else if (j < 1408) conv_T(lds, p.in[I_FU] + (size_t)l * 1024 * DFF, 1024, DFF, wtgu, 2, j - 704);
        else conv_T(lds, p.in[I_FD] + (size_t)l * DFF * 1024, DFF, 1024, wtd, 0, j - 1408); }
    }
    grid.sync();
    { ASrc A; A.b0 = p.z + A_Q; A.b1 = p.z + B_Q; A.b2 = p.z + C_Q; A.b3 = p.pl + 4 * PLANE; A.s0 = A.s1 = A.s2 = NIN; A.s3 = 256; A.shift = 8;
      EpiStore e; e.out = hb; e.ldc = 1024; e.nmax = 1024;
      gemm_phase(lds, A, p.wtout + (size_t)l * 1024 * 1024, 1024, 8, e); }
    grid.sync();
    for (int row = bid * 4 + opaque(w); row < MT; row += nb * 8) { const int rb = row + nb * 4;
      if (rb < MT) row_phase2(p.out + (size_t)row * 1024, p.out + (size_t)rb * 1024, p.out + (size_t)row * 1024, p.out + (size_t)rb * 1024, hb + (size_t)row * 1024, hb + (size_t)rb * 1024,
                              p.in[I_NMPOST] + l * 1024, p.in[I_NFPRE] + l * 1024, hb + (size_t)row * 1024, hb + (size_t)rb * 1024, lane);
      else row_phase(p.out + (size_t)row * 1024, p.out + (size_t)row * 1024, hb + (size_t)row * 1024, p.in[I_NMPOST] + l * 1024, p.in[I_NFPRE] + l * 1024, hb + (size_t)row * 1024, lane); }
    grid.sync();
    { ASrc A; A.b0 = hb; A.b1 = hb; A.b2 = hb; A.b3 = hb; A.s0 = A.s1 = A.s2 = A.s3 = 1024; A.shift = 12;
      EpiSwiGLU e; e.out = p.z;
      gemm_phase(lds, A, wtgu, 1024, 44, e); }
    grid.sync();
    { ASrc A; A.b0 = p.z; A.b1 = p.z; A.b2 = p.z; A.b3 = p.z; A.s0 = A.s1 = A.s2 = A.s3 = DFF; A.shift = 12;
      EpiStore e; e.out = hb; e.ldc = 1024; e.nmax = 1024;
      gemm_phase(lds, A, wtd, DFF, 8, e); }
    grid.sync();
    for (int row = bid * 4 + opaque(w); row < MT; row += nb * 8) { const int rb = row + nb * 4; const float* gp2 = l == 0 ? p.in[I_NMPRE] + 1024 : nullptr;
      if (rb < MT) row_phase2(p.out + (size_t)row * 1024, p.out + (size_t)rb * 1024, p.out + (size_t)row * 1024, p.out + (size_t)rb * 1024, hb + (size_t)row * 1024, hb + (size_t)rb * 1024,
                              p.in[I_NFPOST] + l * 1024, gp2, hb + (size_t)row * 1024, hb + (size_t)rb * 1024, lane);
      else row_phase(p.out + (size_t)row * 1024, p.out + (size_t)row * 1024, hb + (size_t)row * 1024, p.in[I_NFPOST] + l * 1024, gp2, hb + (size_t)row * 1024, lane); }
    if (l == 0) grid.sync();
  }
}

extern "C" void kernel_launch(void* const* d_in, const int* in_sizes, int n_in, void* d_out, int out_size,
                              void* d_ws, size_t ws_size, hipStream_t stream) {
  static int grid_blocks = 0;
  if (!grid_blocks) {
    int dev = 0, cus = 0, per_cu = 0;
    hipGetDevice(&dev);
    hipDeviceGetAttribute(&cus, hipDeviceAttributeMultiprocessorCount, dev);
    hipFuncSetAttribute((const void*)fwd, hipFuncAttributeMaxDynamicSharedMemorySize, LDS_BYTES);
    hipOccupancyMaxActiveBlocksPerMultiprocessor(&per_cu, fwd, 256, LDS_BYTES);
    if (per_cu > 2) per_cu = 2;
    if (per_cu < 1) per_cu = 1;
    grid_blocks = cus * per_cu;
  }
  Params p{};
  for (int i = 0; i < 28; ++i) p.in[i] = (const float*)d_in[i];
  p.out = (float*)d_out;
  char* ws = (char*)d_ws;
  size_t off = 0;
  p.z = (bf16_t*)(ws + off); off += (size_t)MT * NIN * 2;
  p.pl = (bf16_t*)(ws + off); off += 7 * PLANE * 2;
  p.wtin = (bf16_t*)(ws + off); off += (size_t)2 * NINP * 1024 * 2;
  p.wtout = (bf16_t*)(ws + off); off += (size_t)2 * 1024 * 1024 * 2;
  p.tabC = (f32x2*)(ws + off); off += (size_t)4096 * 32 * 8;
  p.tabB = (f32x2*)(ws + off); off += (size_t)4096 * 4 * 8;
  p.tabA = (f32x2*)(ws + off); off += (size_t)64 * 16 * 8;
  p.ctr = (int*)(ws + off); off += 256;
  if (off > ws_size) fprintf(stderr, "workspace too small: need %zu have %zu\n", off, ws_size);
  void* args[] = {&p};
  hipError_t e = hipLaunchCooperativeKernel((void*)fwd, dim3(grid_blocks), dim3(256), args, LDS_BYTES, stream);
  if (e != hipSuccess) fprintf(stderr, "coop launch failed: %s (grid %d)\n", hipGetErrorString(e), grid_blocks);
}
```

```cpp
#include <hip/hip_runtime.h>
#include <hip/hip_cooperative_groups.h>
#include <cstdio>
#include <cstdint>
namespace cg = cooperative_groups;

#define DI __device__ __forceinline__
typedef unsigned short bf16_t;
typedef short bf16x8 __attribute__((ext_vector_type(8)));
typedef float f32x2 __attribute__((ext_vector_type(2)));
typedef float f32x4 __attribute__((ext_vector_type(4)));
typedef float f32x16 __attribute__((ext_vector_type(16)));
typedef unsigned u32x2 __attribute__((ext_vector_type(2)));
typedef unsigned u32x4 __attribute__((ext_vector_type(4)));
typedef __bf16 bf16x2_t __attribute__((ext_vector_type(2)));

constexpr int M0 = 32768, MT = 49152, DM = 1024, NIN = 3392, NINP = 3584, DFF = 2816;
constexpr int A_Q = 0, A_K = 256, A_V = 384, B_Q = 512, B_K = 768, B_V = 1024, C_Q = 1280, C_K = 1536, C_V = 1792, C_G = 2048, D_0 = 2304;
constexpr int PITCH = 144;
constexpr size_t PLANE = (size_t)MT * 256;
constexpr int LDS_BYTES = 73728;
constexpr float LOG2E = 1.4426950408889634f;
constexpr float EPS = 1e-6f;

enum { I_XP = 0, I_XS, I_NMPRE, I_NMPOST, I_NFPRE, I_NFPOST, I_WIN, I_WOUT, I_AQG, I_AKG, I_BLAM, I_BSUB, I_CGN, I_DMUP, I_DMUN, I_DW0, I_DWUP,
       I_DA0, I_DAUP, I_DGUP, I_DKK, I_DKA, I_DRK, I_DGNW, I_DGNB, I_FG, I_FU, I_FD };

struct Params {
  const float* in[28];
  float* out;
  bf16_t* z;
  bf16_t* pl;
  bf16_t* wtin;
  bf16_t* wtout;
  f32x2* tabC;
  f32x2* tabB;
  f32x2* tabA;
  int* ctr;
};

DI int opaque(int x) { asm volatile("" : "+v"(x)); return x; }
DI int opaque_s(int x) { asm volatile("" : "+s"(x)); return x; }
DI float bf2f(bf16_t v) { return __uint_as_float(((unsigned)v) << 16); }
DI float bflo(unsigned w) { return __uint_as_float(w << 16); }
DI float bfhi(unsigned w) { return __uint_as_float(w & 0xffff0000u); }
DI unsigned pk(float lo, float hi) { f32x2 v = {lo, hi}; bf16x2_t b = __builtin_convertvector(v, bf16x2_t); return __builtin_bit_cast(unsigned, b); }
DI bf16_t f2bf(float x) { return (bf16_t)(pk(x, 0.f) & 0xffffu); }
DI float dppf(float x, const int ctrl) { return x; }
#define DPPF(x, ctrl) __int_as_float(__builtin_amdgcn_update_dpp(0, __float_as_int(x), (ctrl), 0xF, 0xF, true))
DI float wave_sum(float v) {
  v += DPPF(v, 0xB1);
  v += DPPF(v, 0x4E);
  v += DPPF(v, 0x141);
  v += DPPF(v, 0x140);
  const int vi = __float_as_int(v);
  return (__int_as_float(__builtin_amdgcn_readlane(vi, 0)) + __int_as_float(__builtin_amdgcn_readlane(vi, 16))) +
         (__int_as_float(__builtin_amdgcn_readlane(vi, 32)) + __int_as_float(__builtin_amdgcn_readlane(vi, 48)));
}
DI float dpp_xor1(float x) { return __int_as_float(__builtin_amdgcn_update_dpp(0, __float_as_int(x), 0xB1, 0xF, 0xF, true)); }
DI float dpp_xor2(float x) { return __int_as_float(__builtin_amdgcn_update_dpp(0, __float_as_int(x), 0x4E, 0xF, 0xF, true)); }
DI float dpp_hmir(float x) { return __int_as_float(__builtin_amdgcn_update_dpp(0, __float_as_int(x), 0x141, 0xF, 0xF, true)); }
DI float red8(float x) { x += dpp_xor1(x); x += dpp_xor2(x); x += dpp_hmir(x); return x; }
DI float fexp2(float x) { return __builtin_amdgcn_exp2f(x); }
DI void seq_info(int s, int& row0, int& T) { if (s < 8) { row0 = s * 4096; T = 4096; } else { row0 = M0 + (s - 8) * 2048; T = 2048; } }
DI void row_info(int r, int& t, int& T) { if (r < M0) { t = r & 4095; T = 4096; } else { t = (r - M0) & 2047; T = 2048; } }
#define MFMA32(a, b, c) __builtin_amdgcn_mfma_f32_32x32x16_bf16((a), (b), (c), 0, 0, 0)

DI void conv_T(char* lds, const float* __restrict__ W, int K, int N, bf16_t* __restrict__ Wt, int mode, int tile) {
  float* t = (float*)lds;
  const int tid0 = opaque(threadIdx.x);
  const int ntn = N >> 6, kt = tile / ntn, nt = tile - kt * ntn, k0 = kt << 6, n0 = nt << 6;
#pragma unroll 4
  for (int i = 0; i < 16; ++i) { const int idx = tid0 + 256 * i, k = idx >> 6, n = idx & 63; t[k * 65 + n] = W[(size_t)(k0 + k) * N + n0 + n]; }
  __syncthreads();
#pragma unroll 4
  for (int i = 0; i < 8; ++i) {
    const int idx = tid0 + 256 * i, n = idx >> 5, k = (idx & 31) * 2, j = n0 + n;
    const int rho = (mode == 0) ? j : ((j >> 6) * 128 + ((j >> 5) & 1) * 64 + (mode - 1) * 32 + (j & 31));
    *(unsigned*)(Wt + (size_t)rho * K + k0 + k) = pk(t[k * 65 + n], t[(k + 1) * 65 + n]);
  }
  __syncthreads();
}

DI void row_phase(const float* __restrict__ xin, float* __restrict__ xout, const bf16_t* addsrc, const float* __restrict__ gpost,
                  const float* __restrict__ gpre, bf16_t* hout, int lane_in) {
  const int lane = opaque(lane_in);
  f32x4 x[4];
#pragma unroll
  for (int i = 0; i < 4; ++i) x[i] = *(const f32x4*)(xin + i * 256 + lane * 4);
  if (addsrc) {
    f32x4 m[4]; float ss = 0.f;
#pragma unroll
    for (int i = 0; i < 4; ++i) { const u32x2 w = *(const u32x2*)(addsrc + i * 256 + lane * 4); m[i] = (f32x4){bflo(w.x), bfhi(w.x), bflo(w.y), bfhi(w.y)};
      ss += m[i][0] * m[i][0] + m[i][1] * m[i][1] + m[i][2] * m[i][2] + m[i][3] * m[i][3]; }
    ss = wave_sum(ss); const float rs = rsqrtf(ss * (1.0f / 1024.0f) + EPS);
#pragma unroll
    for (int i = 0; i < 4; ++i) { const f32x4 g = *(const f32x4*)(gpost + i * 256 + lane * 4); x[i] += m[i] * rs * g; }
  }
#pragma unroll
  for (int i = 0; i < 4; ++i) *(f32x4*)(xout + i * 256 + lane * 4) = x[i];
  if (gpre) {
    float ss = 0.f;
#pragma unroll
    for (int i = 0; i < 4; ++i) ss += x[i][0] * x[i][0] + x[i][1] * x[i][1] + x[i][2] * x[i][2] + x[i][3] * x[i][3];
    ss = wave_sum(ss); const float rs = rsqrtf(ss * (1.0f / 1024.0f) + EPS);
#pragma unroll
    for (int i = 0; i < 4; ++i) { const f32x4 g = *(const f32x4*)(gpre + i * 256 + lane * 4); const f32x4 hv = x[i] * rs * g;
      u32x2 w; w.x = pk(hv[0], hv[1]); w.y = pk(hv[2], hv[3]); *(u32x2*)(hout + i * 256 + lane * 4) = w; }
  }
}

DI void row_phase2(const float* __restrict__ xinA, const float* __restrict__ xinB, float* __restrict__ xoutA, float* __restrict__ xoutB, const bf16_t* addA, const bf16_t* addB,
                   const float* __restrict__ gpost, const float* __restrict__ gpre, bf16_t* houtA, bf16_t* houtB, int lane_in) {
  const int lane = opaque(lane_in);
  f32x4 x[2][4]; u32x2 aw[2][4];
#pragma unroll
  for (int i = 0; i < 4; ++i) { x[0][i] = *(const f32x4*)(xinA + i * 256 + lane * 4); x[1][i] = *(const f32x4*)(xinB + i * 256 + lane * 4); }
  if (addA) {
#pragma unroll
    for (int i = 0; i < 4; ++i) { aw[0][i] = *(const u32x2*)(addA + i * 256 + lane * 4); aw[1][i] = *(const u32x2*)(addB + i * 256 + lane * 4); }
#pragma unroll
    for (int r = 0; r < 2; ++r) {
      f32x4 m[4]; float ss = 0.f;
#pragma unroll
      for (int i = 0; i < 4; ++i) { const u32x2 w = aw[r][i]; m[i] = (f32x4){bflo(w.x), bfhi(w.x), bflo(w.y), bfhi(w.y)};
        ss += m[i][0] * m[i][0] + m[i][1] * m[i][1] + m[i][2] * m[i][2] + m[i][3] * m[i][3]; }
      ss = wave_sum(ss); const float rs = rsqrtf(ss * (1.0f / 1024.0f) + EPS);
#pragma unroll
      for (int i = 0; i < 4; ++i) { const f32x4 g = *(const f32x4*)(gpost + i * 256 + lane * 4); x[r][i] += m[i] * rs * g; }
    }
  }
#pragma unroll
  for (int i = 0; i < 4; ++i) { *(f32x4*)(xoutA + i * 256 + lane * 4) = x[0][i]; *(f32x4*)(xoutB + i * 256 + lane * 4) = x[1][i]; }
  if (gpre) {
#pragma unroll
    for (int r = 0; r < 2; ++r) {
      float ss = 0.f;
#pragma unroll
      for (int i = 0; i < 4; ++i) ss += x[r][i][0] * x[r][i][0] + x[r][i][1] * x[r][i][1] + x[r][i][2] * x[r][i][2] + x[r][i][3] * x[r][i][3];
      ss = wave_sum(ss); const float rs = rsqrtf(ss * (1.0f / 1024.0f) + EPS);
      bf16_t* ho = r == 0 ? houtA : houtB;
#pragma unroll
      for (int i = 0; i < 4; ++i) { const f32x4 g = *(const f32x4*)(gpre + i * 256 + lane * 4); const f32x4 hv = x[r][i] * rs * g;
        u32x2 w; w.x = pk(hv[0], hv[1]); w.y = pk(hv[2], hv[3]); *(u32x2*)(ho + i * 256 + lane * 4) = w; }
    }
  }
}

struct ASrc { const bf16_t* b0; const bf16_t* b1; const bf16_t* b2; const bf16_t* b3; int s0, s1, s2, s3; int shift; };

struct EpiStore { bf16_t* out; int ldc; int nmax;
  DI void operator()(const f32x16 (&acc)[2][2], int mb, int nb, int n0, int wc, int l31, int h) const {
#pragma unroll
    for (int mf = 0; mf < 2; ++mf) { bf16_t* rp = out + (size_t)(mb + mf * 32 + l31) * ldc;
#pragma unroll
      for (int nf = 0; nf < 2; ++nf) { if (nb + nf * 32 < nmax) {
#pragma unroll
        for (int g = 0; g < 4; ++g) { u32x2 v; v.x = pk(acc[mf][nf][4 * g], acc[mf][nf][4 * g + 1]); v.y = pk(acc[mf][nf][4 * g + 2], acc[mf][nf][4 * g + 3]);
          *(u32x2*)(rp + nb + nf * 32 + 8 * g + 4 * h) = v; } } } }
  } };
struct EpiSwiGLU { bf16_t* out;
  DI void operator()(const f32x16 (&acc)[2][2], int mb, int nb, int n0, int wc, int l31, int h) const {
    const int hc = (nb >> 6) * 32;
#pragma unroll
    for (int mf = 0; mf < 2; ++mf) { bf16_t* rp = out + (size_t)(mb + mf * 32 + l31) * DFF + hc;
#pragma unroll
      for (int g = 0; g < 4; ++g) { float r[4];
#pragma unroll
        for (int e = 0; e < 4; ++e) { const float gt = acc[mf][0][4 * g + e], up = acc[mf][1][4 * g + e]; r[e] = gt / (1.0f + __expf(-gt)) * up; }
        u32x2 v; v.x = pk(r[0], r[1]); v.y = pk(r[2], r[3]); *(u32x2*)(rp + 8 * g + 4 * h) = v; } }
  } };

struct EpiIn { bf16_t* z; char* lds; const float* qg; const float* kg; const f32x2* tabA; const f32x2* tabB; const f32x2* tabC;
  DI void operator()(f32x16 (&acc)[2][2], int mb, int nb, int n0, int wc, int l31, int h) const {
    if (nb >= NIN) return;
    const bool isv = (nb >= A_V && nb < B_Q) || (nb >= B_V && nb < C_Q) || (nb >= C_V && nb < C_G);
    if (isv) {
      const int wv = (threadIdx.x >> 6);
      bf16_t* img = (bf16_t*)(lds + 32768 + wv * 9216);
#pragma unroll
      for (int mf = 0; mf < 2; ++mf)
#pragma unroll
        for (int nf = 0; nf < 2; ++nf)
#pragma unroll
          for (int i = 0; i < 16; ++i) { const int d = nf * 32 + (i & 3) + 8 * (i >> 2) + 4 * h; img[d * 72 + mf * 32 + l31] = f2bf(acc[mf][nf][i]); }
      __builtin_amdgcn_s_waitcnt(0xc07f);
      const int ln = l31 + 32 * h;
#pragma unroll
      for (int i = 0; i < 8; ++i) { const int q = ln + 64 * i, d = q >> 3, c8 = q & 7;
        const u32x4 v = *(const u32x4*)(img + d * 72 + c8 * 8); *(u32x4*)(z + (size_t)(mb + d) * NIN + nb + c8 * 8) = v; }
      return;
    }
#pragma unroll
    for (int mf = 0; mf < 2; ++mf) {
      const int row = mb + mf * 32 + l31; int t, T; row_info(row, t, T);
      if (nb < A_V) {
        const bool isq = nb < A_K; const float* gn = isq ? qg : kg;
        float ss = 0.f;
#pragma unroll
        for (int nf = 0; nf < 2; ++nf)
#pragma unroll
          for (int i = 0; i < 16; ++i) ss += acc[mf][nf][i] * acc[mf][nf][i];
        ss += __shfl_xor(ss, 32);
        const float rs = rsqrtf(ss * (1.0f / 64.0f) + EPS) * (isq ? 0.125f * LOG2E : 1.0f);
#pragma unroll
        for (int nf = 0; nf < 2; ++nf) {
          const int pos = nf == 0 ? (t >> 6) : (t & 63);
#pragma unroll
          for (int g = 0; g < 4; ++g)
#pragma unroll
            for (int e = 0; e < 4; ++e) acc[mf][nf][4 * g + e] *= rs * gn[nf * 32 + 8 * g + 4 * h + e];
#pragma unroll
          for (int g = 0; g < 2; ++g)
#pragma unroll
            for (int e = 0; e < 4; ++e) { const f32x2 cs = tabA[pos * 16 + 8 * g + 4 * h + e];
              const float x1 = acc[mf][nf][4 * g + e], x2 = acc[mf][nf][4 * (g + 2) + e];
              acc[mf][nf][4 * g + e] = x1 * cs.x - x2 * cs.y; acc[mf][nf][4 * (g + 2) + e] = x2 * cs.x + x1 * cs.y; }
        }
      } else if (nb >= B_Q && nb < B_V) {
        const bool isq = nb < B_K;
#pragma unroll
        for (int nf = 0; nf < 2; ++nf) {
#pragma unroll
          for (int e = 0; e < 4; ++e) { const f32x2 cs = tabB[t * 4 + e]; const float v = acc[mf][nf][e]; const float o = __shfl_xor(v, 32);
            acc[mf][nf][e] = (h == 0) ? (v * cs.x - o * cs.y) : (v * cs.x + o * cs.y); }
          if (isq) {
#pragma unroll
            for (int i = 0; i < 16; ++i) acc[mf][nf][i] *= 0.17677669529663687f * LOG2E; }
        }
      } else if (nb >= C_Q && nb < C_V) {
        const float sc = nb < C_K ? 1.0f : 0.125f;
#pragma unroll
        for (int g = 0; g < 4; ++g)
#pragma unroll
          for (int e = 0; e < 4; ++e) { const f32x2 cs = tabC[t * 32 + 8 * g + 4 * h + e]; const float x1 = acc[mf][0][4 * g + e], x2 = acc[mf][1][4 * g + e];
            acc[mf][0][4 * g + e] = (x1 * cs.x - x2 * cs.y) * sc; acc[mf][1][4 * g + e] = (x2 * cs.x + x1 * cs.y) * sc; }
      }
      bf16_t* rp = z + (size_t)row * NIN + nb;
#pragma unroll
      for (int nf = 0; nf < 2; ++nf)
#pragma unroll
        for (int g = 0; g < 4; ++g) { u32x2 v; v.x = pk(acc[mf][nf][4 * g], acc[mf][nf][4 * g + 1]); v.y = pk(acc[mf][nf][4 * g + 2], acc[mf][nf][4 * g + 3]);
          *(u32x2*)(rp + nf * 32 + 8 * g + 4 * h) = v; }
    }
  } };

#define LASP __attribute__((address_space(3)))
template <class Epi>
DI void gemm_tile(char* lds, const ASrc& A, const bf16_t* __restrict__ Bt, int K, int m0, int n0, const Epi& epi, bool first, bool has_next, int m0n, int n0n) {
  const int tid = opaque(threadIdx.x), lane = tid & 63, w = __builtin_amdgcn_readfirstlane(tid >> 6), wr = w >> 1, wc = w & 1, l31 = lane & 31, h = lane >> 5;
  const int nk = K >> 6, smask = (1 << A.shift) - 1;
  LASP char* ldsl = (LASP char*)lds;
  f32x16 acc[2][2];
#pragma unroll
  for (int a = 0; a < 2; ++a)
#pragma unroll
    for (int b = 0; b < 2; ++b)
#pragma unroll
      for (int i = 0; i < 16; ++i) acc[a][b][i] = 0.f;
  const int lrow = lane >> 3, lslot = lane & 7;
  int goffA[4], goffB[4];
#pragma unroll
  for (int i = 0; i < 4; ++i) { const int r = w * 32 + i * 8 + lrow, c = lslot ^ ((r >> 1) & 7); goffA[i] = r; goffB[i] = r * K + c * 8; goffA[i] = (goffA[i] << 3) | c; }
#define GEMM_ISSUE(kt, st, M0_, N0_) do { const int k0_ = (kt) << 6, seg_ = k0_ >> A.shift, kk_ = k0_ & smask; \
    const bf16_t* bp_ = seg_ == 0 ? A.b0 : seg_ == 1 ? A.b1 : seg_ == 2 ? A.b2 : A.b3; const int st_ = seg_ == 0 ? A.s0 : seg_ == 1 ? A.s1 : seg_ == 2 ? A.s2 : A.s3; \
    _Pragma("unroll") for (int i_ = 0; i_ < 4; ++i_) { \
      const bf16_t* ga_ = bp_ + (size_t)((M0_) + (goffA[i_] >> 3)) * st_ + kk_ + (goffA[i_] & 7) * 8; \
      __builtin_amdgcn_global_load_lds((const unsigned*)ga_, (LASP unsigned*)(ldsl + (st) * 32768 + (w * 4 + i_) * 1024), 16, 0, 0); \
      const bf16_t* gb_ = Bt + (size_t)(N0_) * K + goffB[i_] + k0_; \
      __builtin_amdgcn_global_load_lds((const unsigned*)gb_, (LASP unsigned*)(ldsl + (st) * 32768 + 16384 + (w * 4 + i_) * 1024), 16, 0, 0); } } while (0)
  const int xr = (l31 >> 1) & 7;
  int coff[4];
#pragma unroll
  for (int s = 0; s < 4; ++s) coff[s] = ((2 * s + h) ^ xr) * 16;
#define GEMM_COMPUTE(st) do { const char* as = lds + (st) * 32768; const char* bs = as + 16384; \
    bf16x8 af[4][2], wf[4][2]; \
    _Pragma("unroll") for (int s = 0; s < 4; ++s) { \
      _Pragma("unroll") for (int mf = 0; mf < 2; ++mf) af[s][mf] = *(const bf16x8*)(as + (wr * 64 + mf * 32 + l31) * 128 + coff[s]); \
      _Pragma("unroll") for (int nf = 0; nf < 2; ++nf) wf[s][nf] = *(const bf16x8*)(bs + (wc * 64 + nf * 32 + l31) * 128 + coff[s]); } \
    __builtin_amdgcn_sched_barrier(0); __builtin_amdgcn_s_setprio(1); \
    _Pragma("unroll") for (int s = 0; s < 4; ++s) \
      _Pragma("unroll") for (int mf = 0; mf < 2; ++mf) _Pragma("unroll") for (int nf = 0; nf < 2; ++nf) acc[mf][nf] = MFMA32(wf[s][nf], af[s][mf], acc[mf][nf]); \
    __builtin_amdgcn_s_setprio(0); __builtin_amdgcn_sched_barrier(0); } while (0)
  if (first) GEMM_ISSUE(0, 0, m0, n0);
  for (int kt = 0; kt < nk; kt += 2) {
    asm volatile("s_waitcnt vmcnt(0)" ::: "memory"); __syncthreads();
    GEMM_ISSUE(kt + 1, 1, m0, n0);
    GEMM_COMPUTE(0);
    asm volatile("s_waitcnt vmcnt(0)" ::: "memory"); __syncthreads();
    if (kt + 2 < nk) GEMM_ISSUE(kt + 2, 0, m0, n0);
    GEMM_COMPUTE(1);
  }
  __syncthreads();
  if (has_next) GEMM_ISSUE(0, 0, m0n, n0n);
  epi(acc, m0 + wr * 64, n0 + wc * 64, n0, wc, l31, h);
  __syncthreads();
#undef GEMM_ISSUE
#undef GEMM_COMPUTE
}

template <class Epi>
DI void gemm_phase(char* lds, const ASrc& A, const bf16_t* Bt, int K, int ntn, const Epi& epi) {
  const int xcd = blockIdx.x & 7, j = blockIdx.x >> 3, nloc = gridDim.x >> 3, per = 48 * ntn, grp = 8 * ntn;
  bool first = true;
  for (int li = j; li < per; li += nloc) {
    const int sg = li / grp, wi = li - sg * grp, nt = wi >> 3, mt = xcd * 48 + sg * 8 + (wi & 7);
    const int ln = li + nloc; const bool has_next = ln < per;
    const int sgn = ln / grp, win = ln - sgn * grp, ntn2 = win >> 3, mtn = xcd * 48 + sgn * 8 + (win & 7);
    gemm_tile(lds, A, Bt, K, mt * 128, nt * 128, epi, first, has_next, mtn * 128, ntn2 * 128);
    first = false;
  }
}

DI void prep_item(char* lds, const Params& p, int layer, int item) {
  const int tid = opaque(threadIdx.x), lane = tid & 63, w = tid >> 6;
  const int rowb = item * 64; int tb, T; row_info(rowb, tb, T);
  const float* qg = p.in[I_AQG] + layer * 64; const float* kg = p.in[I_AKG] + layer * 64;
  const float qgl = qg[lane], kgl = kg[lane];
  for (int tt = 0; tt < 16; ++tt) {
    const int row = rowb + w * 16 + tt, t = tb + w * 16 + tt;
    bf16_t* zr = p.z + (size_t)row * NIN;
    {
      const int j = lane & 31, i = j & 15; const bool first = j < 16; const int pos = (lane < 32) ? (t >> 6) : (t & 63);
      const f32x2 cs = p.tabA[pos * 16 + i];
#pragma unroll
      for (int hd = 0; hd < 6; ++hd) {
        bf16_t* ptr = zr + (hd < 4 ? A_Q + hd * 64 : A_K + (hd - 4) * 64) + lane;
        float v = bf2f(*ptr);
        const float ss = wave_sum(v * v);
        v = v * rsqrtf(ss * (1.0f / 64.0f) + EPS) * (hd < 4 ? qgl : kgl);
        const float o = __shfl_xor(v, 16);
        float r = first ? (v * cs.x - o * cs.y) : (v * cs.x + o * cs.y);
        if (hd < 4) r *= 0.125f * LOG2E;
        *ptr = f2bf(r);
      }
    }
    {
      const int d = lane & 31; const f32x2 cs = p.tabB[t * 4 + (d & 3)];
#pragma unroll
      for (int c = 0; c < 8; ++c) {
        bf16_t* ptr = zr + (c < 4 ? B_Q + c * 64 : B_K + (c - 4) * 64) + lane;
        float v = bf2f(*ptr);
        const float o = __shfl_xor(v, 4);
        float r = v;
        if (d < 8) r = (d < 4) ? (v * cs.x - o * cs.y) : (v * cs.x + o * cs.y);
        if (c < 4) r *= 0.17677669529663687f * LOG2E;
        *ptr = f2bf(r);
      }
    }
    {
      const f32x2 cs = p.tabC[t * 32 + (lane & 31)];
#pragma unroll
      for (int c = 0; c < 8; ++c) {
        bf16_t* ptr = zr + (c < 4 ? C_Q + c * 64 : C_K + (c - 4) * 64) + lane;
        const float v = bf2f(*ptr);
        const float o = __shfl_xor(v, 32);
        float r = (lane < 32) ? (v * cs.x - o * cs.y) : (v * cs.x + o * cs.y);
        if (c >= 4) r *= 0.125f;
        *ptr = f2bf(r);
      }
    }
  }
  bf16_t* tl = (bf16_t*)lds;
  const int r = tid >> 2, c0 = (tid & 3) * 16;
  for (int sl = 0; sl < 10; ++sl) {
    const int col = sl < 2 ? A_V + sl * 64 : sl < 6 ? B_V + (sl - 2) * 64 : C_V + (sl - 6) * 64;
    bf16_t* gp = p.z + (size_t)(rowb + r) * NIN + col + c0;
    const u32x4 v0 = *(const u32x4*)gp, v1 = *(const u32x4*)(gp + 8);
    __syncthreads();
#pragma unroll
    for (int e = 0; e < 4; ++e) {
      tl[(c0 + 2 * e) * 72 + r] = (bf16_t)(v0[e] & 0xffffu); tl[(c0 + 2 * e + 1) * 72 + r] = (bf16_t)(v0[e] >> 16);
      tl[(c0 + 8 + 2 * e) * 72 + r] = (bf16_t)(v1[e] & 0xffffu); tl[(c0 + 8 + 2 * e + 1) * 72 + r] = (bf16_t)(v1[e] >> 16);
    }
    __syncthreads();
    const u32x4 o0 = *(const u32x4*)(tl + r * 72 + c0), o1 = *(const u32x4*)(tl + r * 72 + c0 + 8);
    *(u32x4*)gp = o0; *(u32x4*)(gp + 8) = o1;
  }
  __syncthreads();
}

DI float dshift(const Params& p, const float* mup, const float* mun, int row, int t, int T, int dc) {
  const bf16_t* zp = p.z + (size_t)row * NIN + D_0 + dc;
  const float z = bf2f(*zp);
  const float zprev = (t > 0) ? bf2f(*(zp - NIN)) : 0.f;
  const float znext = (t < T - 1) ? bf2f(*(zp + NIN)) : 0.f;
  return z + mup[dc] * (zprev - z) + mun[dc] * (znext - z);
}
DI float sigmoidf_(float x) { return 1.0f / (1.0f + __expf(-x)); }
DI float omdecay(float ww) {
  const float e = 0.6065306597126334f / (1.0f + __expf(-ww));
  return 1.0f - __expf(-e);
}
DI float fast_tanh(float x) { const float xc = fminf(fmaxf(x, -15.f), 15.f); return 1.0f - 2.0f / (1.0f + __expf(2.0f * xc)); }
constexpr int DTOK = 16;
DI void dprep_item(char* lds, const Params& p, int layer, int item) {
  const int tid = opaque(threadIdx.x);
  const int rowb = item * DTOK; int tb, T; row_info(rowb, tb, T);
  const float* mup = p.in[I_DMUP] + layer * 1088; const float* mun = p.in[I_DMUN] + layer * 1088;
  float* su = (float*)lds;
  bf16_t* stg = (bf16_t*)(lds + 12288);
#pragma unroll
  for (int i = 0; i < 12; ++i) {
    const int idx = tid + 256 * i, tok = idx / 192, c = idx - tok * 192;
    float u = dshift(p, mup, mun, rowb + tok, tb + tok, T, 768 + c);
    if (c < 128) u = fast_tanh(u);
    su[c * DTOK + tok] = u;
  }
  __syncthreads();
  const int c = tid;
  float accf[DTOK], accb[DTOK], acca[DTOK];
#pragma unroll
  for (int k = 0; k < DTOK; ++k) { accf[k] = 0.f; accb[k] = 0.f; acca[k] = 0.f; }
  const float* wupf = p.in[I_DWUP] + (size_t)(layer * 2 + 0) * 64 * 256 + c;
  const float* wupb = p.in[I_DWUP] + (size_t)(layer * 2 + 1) * 64 * 256 + c;
  const float* aup = p.in[I_DAUP] + (size_t)layer * 64 * 256 + c;
#pragma unroll 2
  for (int j = 0; j < 64; ++j) {
    const float wf = wupf[j * 256], wb = wupb[j * 256], wa = aup[j * 256];
#pragma unroll
    for (int q = 0; q < 4; ++q) {
      const f32x4 f0 = *(const f32x4*)(su + j * DTOK + 4 * q), b0 = *(const f32x4*)(su + (64 + j) * DTOK + 4 * q), a0v = *(const f32x4*)(su + (128 + j) * DTOK + 4 * q);
#pragma unroll
      for (int k = 0; k < 4; ++k) { accf[4 * q + k] += f0[k] * wf; accb[4 * q + k] += b0[k] * wb; acca[4 * q + k] += a0v[k] * wa; }
    }
  }
  const float w0f = p.in[I_DW0][(layer * 2 + 0) * 256 + c], w0b = p.in[I_DW0][(layer * 2 + 1) * 256 + c];
  const float a0 = p.in[I_DA0][layer * 256 + c], kkw = p.in[I_DKK][layer * 256 + c], kaw = p.in[I_DKA][layer * 256 + c];
  float zr[DTOK + 2], zk[DTOK + 2], zv[DTOK + 2];
  { const bf16_t* zp = p.z + (size_t)rowb * NIN + D_0 + c;
#pragma unroll
    for (int i = 0; i < DTOK + 2; ++i) { const int t = tb - 1 + i; const bool ok = (t >= 0) && (t < T); const bf16_t* q = zp + (ptrdiff_t)(i - 1) * NIN;
      zr[i] = ok ? bf2f(q[0]) : 0.f; zk[i] = ok ? bf2f(q[256]) : 0.f; zv[i] = ok ? bf2f(q[512]) : 0.f; } }
  const float mpr = mup[c], mnr = mun[c], mpk = mup[256 + c], mnk = mun[256 + c], mpv = mup[512 + c], mnv = mun[512 + c];
#pragma unroll
  for (int k = 0; k < DTOK; ++k) {
    const float r = zr[k + 1] + mpr * (zr[k] - zr[k + 1]) + mnr * (zr[k + 2] - zr[k + 1]);
    const float kx = zk[k + 1] + mpk * (zk[k] - zk[k + 1]) + mnk * (zk[k + 2] - zk[k + 1]);
    const float v = zv[k + 1] + mpv * (zv[k] - zv[k + 1]) + mnv * (zv[k + 2] - zv[k + 1]);
    const float omf = omdecay(w0f + accf[k]), omb = omdecay(w0b + accb[k]);
    const float a = sigmoidf_(a0 + acca[k]);
    float kk = kx * kkw; const float n2 = wave_sum(kk * kk);
    kk = kk * rsqrtf(fmaxf(n2, 1e-24f));
    const float kmod = kx * (1.0f + (a - 1.0f) * kaw), b = kk * a;
    bf16_t* so = stg + k * 256 + c;
    so[0] = f2bf(r); so[DTOK * 256] = f2bf(kmod); so[2 * DTOK * 256] = f2bf(v); so[3 * DTOK * 256] = f2bf(-kk);
    so[4 * DTOK * 256] = f2bf(b); so[5 * DTOK * 256] = f2bf(omf); so[6 * DTOK * 256] = f2bf(omb);
  }
  __syncthreads();
#pragma unroll
  for (int i = 0; i < 14; ++i) {
    const int q = tid + 256 * i, pln = q >> 9, rem = q & 511, tok = rem >> 5, c16 = rem & 31;
    const u32x4 v = *(const u32x4*)(stg + pln * (DTOK * 256) + tok * 256 + c16 * 8);
    *(u32x4*)(p.pl + (size_t)pln * PLANE + (size_t)(rowb + tok) * 256 + c16 * 8) = v;
  }
  __syncthreads();
}

DI void dpost_item(char* lds, const Params& p, int layer, int item) {
  const int tid = opaque(threadIdx.x);
  const int rowb = item * DTOK; int tb, T; row_info(rowb, tb, T);
  const float* mup = p.in[I_DMUP] + layer * 1088; const float* mun = p.in[I_DMUN] + layer * 1088;
  float* sg = (float*)lds;
  bf16_t* stg = (bf16_t*)(lds + 8192);
#pragma unroll
  for (int i = 0; i < 8; ++i) { const int idx = tid + 256 * i, tok = idx >> 7, c = idx & 127; sg[c * DTOK + tok] = sigmoidf_(dshift(p, mup, mun, rowb + tok, tb + tok, T, 960 + c)); }
  __syncthreads();
  const int c = tid;
  float acc[DTOK];
#pragma unroll
  for (int k = 0; k < DTOK; ++k) acc[k] = 0.f;
  const float* gup = p.in[I_DGUP] + (size_t)layer * 128 * 256 + c;
#pragma unroll 4
  for (int j = 0; j < 128; ++j) { const float gw = gup[j * 256];
#pragma unroll
    for (int q = 0; q < 4; ++q) { const f32x4 s0 = *(const f32x4*)(sg + j * DTOK + 4 * q);
#pragma unroll
      for (int k = 0; k < 4; ++k) acc[4 * q + k] += s0[k] * gw; } }
  const float gnw = p.in[I_DGNW][layer * 256 + c], gnb = p.in[I_DGNB][layer * 256 + c], rk = p.in[I_DRK][layer * 256 + c];
#pragma unroll
  for (int k = 0; k < DTOK; ++k) {
    const int row = rowb + k;
    const bf16_t* zd = p.z + (size_t)row * NIN + D_0;
    const float y = bf2f(zd[c]) + bf2f(zd[256 + c]);
    const float mean = wave_sum(y) * (1.0f / 64.0f); const float d = y - mean; const float var = wave_sum(d * d) * (1.0f / 64.0f);
    const float yn = d * rsqrtf(var + 64e-5f) * gnw + gnb;
    const size_t o = (size_t)row * 256 + c;
    const float r = bf2f(p.pl[o]), km = bf2f(p.pl[PLANE + o]), v = bf2f(p.pl[2 * PLANE + o]);
    const float bonus = wave_sum(r * km * rk);
    stg[k * 256 + c] = f2bf((yn + bonus * v) * acc[k]);
  }
  __syncthreads();
#pragma unroll
  for (int i = 0; i < 2; ++i) { const int q = tid + 256 * i, tok = q >> 5, c16 = q & 31;
    const u32x4 v = *(const u32x4*)(stg + tok * 256 + c16 * 8);
    *(u32x4*)(p.pl + 4 * PLANE + (size_t)(rowb + tok) * 256 + c16 * 8) = v; }
  __syncthreads();
}

DI void rwkv_item(char* lds, const Params& p, int seq, int head, int dir, int half) {
  int row0, T; seq_info(seq, row0, T);
  const int tid = opaque(threadIdx.x), kc = tid & 7, vrow = half * 32 + (tid >> 3);
  float* st = (float*)lds;
  f32x2 S[4];
#pragma unroll
  for (int j = 0; j < 4; ++j) S[j] = (f32x2){0.f, 0.f};
  const int nchunk = T >> 4;
  u32x4 rg[3];
  const int tsel = tid >> 7, srem = tid & 127, sstep = srem >> 3, sc8 = srem & 7;
#define RW_GLOAD(c) do { _Pragma("unroll") for (int i_ = 0; i_ < 3; ++i_) { const int tens_ = tsel + 2 * i_; \
      const int plane_ = tens_ == 0 ? (dir ? 6 : 5) : tens_ == 1 ? 3 : tens_ == 2 ? 4 : tens_ == 3 ? 1 : tens_ == 4 ? 0 : 2; \
      const int t_ = dir ? (T - 1 - ((c) * 16 + sstep)) : ((c) * 16 + sstep); \
      rg[i_] = *(const u32x4*)(p.pl + (size_t)plane_ * PLANE + (size_t)(row0 + t_) * 256 + head * 64 + sc8 * 8); } } while (0)
#define RW_LSTORE(buf) do { _Pragma("unroll") for (int i_ = 0; i_ < 3; ++i_) { const int tens_ = tsel + 2 * i_; \
      f32x4 a_ = {bflo(rg[i_].x), bfhi(rg[i_].x), bflo(rg[i_].y), bfhi(rg[i_].y)}, b_ = {bflo(rg[i_].z), bfhi(rg[i_].z), bflo(rg[i_].w), bfhi(rg[i_].w)}; \
      if (tens_ == 0) { a_ = 1.0f - a_; b_ = 1.0f - b_; } \
      float* d_ = st + (((buf) * 16 + sstep) * 6 + tens_) * 64 + sc8 * 8; *(f32x4*)d_ = a_; *(f32x4*)(d_ + 4) = b_; } } while (0)
  __builtin_amdgcn_s_setprio(3);
  RW_GLOAD(0); RW_LSTORE(0); __syncthreads();
  bf16_t* ybase = p.z + (size_t)row0 * NIN + D_0 + dir * 256 + head * 64 + vrow;
  for (int c = 0; c < nchunk; ++c) {
    if (c + 1 < nchunk) RW_GLOAD(c + 1);
    const float* sb = st + (c & 1) * (16 * 384);
#define RW_FETCH(S_, s_) do { const float* q_ = sb + (s_) * 384 + kc * 8; \
      S_##w0 = *(const f32x4*)(q_); S_##w1 = *(const f32x4*)(q_ + 4); S_##n0 = *(const f32x4*)(q_ + 64); S_##n1 = *(const f32x4*)(q_ + 68); \
      S_##b0 = *(const f32x4*)(q_ + 128); S_##b1 = *(const f32x4*)(q_ + 132); S_##k0 = *(const f32x4*)(q_ + 192); S_##k1 = *(const f32x4*)(q_ + 196); \
      S_##r0 = *(const f32x4*)(q_ + 256); S_##r1 = *(const f32x4*)(q_ + 260); S_##vv = sb[(s_) * 384 + 320 + vrow]; } while (0)
#define LO2(x) ((f32x2){(x)[0], (x)[1]})
#define HI2(x) ((f32x2){(x)[2], (x)[3]})
#define RW_STEP(S_, s_) do { \
      f32x2 a2 = S[0] * LO2(S_##n0); a2 += S[1] * HI2(S_##n0); a2 += S[2] * LO2(S_##n1); a2 += S[3] * HI2(S_##n1); \
      const float sa = red8(a2.x + a2.y); const float vx = S_##vv; \
      S[0] = S[0] * LO2(S_##w0) + (LO2(S_##b0) * sa + LO2(S_##k0) * vx); S[1] = S[1] * HI2(S_##w0) + (HI2(S_##b0) * sa + HI2(S_##k0) * vx); \
      S[2] = S[2] * LO2(S_##w1) + (LO2(S_##b1) * sa + LO2(S_##k1) * vx); S[3] = S[3] * HI2(S_##w1) + (HI2(S_##b1) * sa + HI2(S_##k1) * vx); \
      f32x2 y2 = S[0] * LO2(S_##r0); y2 += S[1] * HI2(S_##r0); y2 += S[2] * LO2(S_##r1); y2 += S[3] * HI2(S_##r1); \
      const float y = red8(y2.x + y2.y); const float yn = DPPF(y, 0x128);     \
      if ((tid & 15) == 0) { const int t_ = dir ? (T - 1 - (c * 16 + (s_))) : (c * 16 + (s_)); *(unsigned*)(ybase + (size_t)t_ * NIN) = pk(y, yn); } } while (0)
    f32x4 Aw0, Aw1, An0, An1, Ab0, Ab1, Ak0, Ak1, Ar0, Ar1; float Avv;
    f32x4 Bw0, Bw1, Bn0, Bn1, Bb0, Bb1, Bk0, Bk1, Br0, Br1; float Bvv;
    RW_FETCH(A, 0);
#pragma unroll 2
    for (int s = 0; s < 16; s += 2) {
      RW_FETCH(B, s + 1);
      RW_STEP(A, s);
      if (s + 2 < 16) RW_FETCH(A, s + 2);
      RW_STEP(B, s + 1);
    }
#undef RW_FETCH
#undef RW_STEP
    if (c + 1 < nchunk) RW_LSTORE((c + 1) & 1);
    __syncthreads();
  }
#undef RW_GLOAD
#undef RW_LSTORE
  __builtin_amdgcn_s_setprio(0);
}

template <int MODE>
DI void attn_item(char* lds, const Params& p, int layer, int seq, int head, int qt) {
  const int tid = opaque(threadIdx.x), lane = tid & 63, w = tid >> 6, l31 = lane & 31, h = lane >> 5;
  layer = opaque_s(layer); seq = opaque_s(seq); head = opaque_s(head); qt = opaque_s(qt);
  int row0, T; seq_info(seq, row0, T);
  const int QC = (MODE == 0 ? A_Q : MODE == 1 ? B_Q : C_Q) + head * 64;
  const int KC = MODE == 0 ? A_K + (head >> 1) * 64 : MODE == 1 ? B_K + head * 64 : C_K + head * 64;
  const int VC = MODE == 0 ? A_V + (head >> 1) * 64 : MODE == 1 ? B_V + head * 64 : C_V + head * 64;
  const int qw0 = qt * 128 + w * 32, qi = qw0 + l31;
  bf16_t* zq = p.z + (size_t)(row0 + qi) * NIN + QC;
  bf16x8 qf[4];
#pragma unroll
  for (int s = 0; s < 4; ++s) qf[s] = *(const bf16x8*)(zq + s * 16 + h * 8);
  const int srow = tid >> 3, sc8 = tid & 7;
  const bf16_t* kbase = p.z + (size_t)(row0 + srow) * NIN + KC + sc8 * 8;
  const bf16_t* vbase = p.z + (size_t)(row0 + srow) * NIN + VC + sc8 * 8;
  u32x4 rk[2][2], rv[2][2];
  const int nt = T >> 6;
  const int prow = (l31 & 19) | ((l31 & 4) << 1) | ((l31 & 8) >> 1);
#define AT_GLOAD(t, S) do { _Pragma("unroll") for (int i_ = 0; i_ < 2; ++i_) { const size_t off_ = (size_t)((t) * 64 + 32 * i_) * NIN; rk[S][i_] = *(const u32x4*)(kbase + off_); rv[S][i_] = *(const u32x4*)(vbase + off_); } } while (0)
#define AT_LSTORE(buf, S) do { char* ks_ = lds + (buf) * 18432; char* vs_ = ks_ + 9216; \
    _Pragma("unroll") for (int i_ = 0; i_ < 2; ++i_) { *(u32x4*)(ks_ + (srow + 32 * i_) * PITCH + sc8 * 16) = rk[S][i_]; *(u32x4*)(vs_ + (srow + 32 * i_) * PITCH + sc8 * 16) = rv[S][i_]; } } while (0)
  constexpr int NMAP = (MODE == 1) ? 2 : 1;
  f32x16 o[NMAP][2];
  float m_run[NMAP], l_run[NMAP];
#pragma unroll
  for (int a = 0; a < NMAP; ++a) { m_run[a] = -INFINITY; l_run[a] = 0.f;
#pragma unroll
    for (int b = 0; b < 2; ++b)
#pragma unroll
      for (int i = 0; i < 16; ++i) o[a][b][i] = 0.f; }
  float lf = 0.f, lb = 0.f;
  if (MODE == 2) { lf = log2f(1.0f - exp2f(-5.0f - (float)head)); lb = log2f(1.0f - exp2f(-5.0f - (float)(3 - head))); }
  auto body = [&](const char* ks, const char* vs, const int t) __attribute__((always_inline)) {
#pragma unroll
    for (int mp = 0; mp < NMAP; ++mp) {
      f32x16 st[2];
#pragma unroll
      for (int kf = 0; kf < 2; ++kf) {
#pragma unroll
        for (int i = 0; i < 16; ++i) st[kf][i] = 0.f;
        if (MODE == 1) {
#pragma unroll
          for (int s = 0; s < 2; ++s) { const bf16x8 kfr = *(const bf16x8*)(ks + (kf * 32 + prow) * PITCH + (mp * 2 + s) * 32 + h * 16); st[kf] = MFMA32(kfr, qf[mp * 2 + s], st[kf]); }
        } else {
#pragma unroll
          for (int s = 0; s < 4; ++s) { const bf16x8 kfr = *(const bf16x8*)(ks + (kf * 32 + prow) * PITCH + s * 32 + h * 16); st[kf] = MFMA32(kfr, qf[s], st[kf]); }
        }
      }
      if (MODE == 2) {
        const int k0 = t * 64;
        const float dbase = (float)(qi - k0 - 8 * h);
        if (k0 + 63 < qw0) {
#pragma unroll
          for (int kf = 0; kf < 2; ++kf)
#pragma unroll
            for (int i = 0; i < 16; ++i) { const float cc = (float)(32 * kf + (i & 3) + 4 * ((i >> 2) & 1) + 16 * ((i >> 3) & 1)); st[kf][i] *= fexp2(lf * (dbase - cc)); }
        } else if (k0 > qw0 + 31) {
#pragma unroll
          for (int kf = 0; kf < 2; ++kf)
#pragma unroll
            for (int i = 0; i < 16; ++i) { const float cc = (float)(32 * kf + (i & 3) + 4 * ((i >> 2) & 1) + 16 * ((i >> 3) & 1)); st[kf][i] *= fexp2(lb * (cc - dbase)); }
        } else {
#pragma unroll
          for (int kf = 0; kf < 2; ++kf)
#pragma unroll
            for (int i = 0; i < 16; ++i) { const float cc = (float)(32 * kf + (i & 3) + 4 * ((i >> 2) & 1) + 16 * ((i >> 3) & 1)); const float d = dbase - cc;
              float dd = fexp2(fminf(lf * d, -lb * d)); if (d == 0.f) dd = 2.0f; st[kf][i] *= dd; }
        }
      } else {
        float mx = st[0][0];
#pragma unroll
        for (int kf = 0; kf < 2; ++kf)
#pragma unroll
          for (int i = 0; i < 16; ++i) mx = fmaxf(mx, st[kf][i]);
        mx = fmaxf(mx, __shfl_xor(mx, 32));
        const float mn = fmaxf(m_run[mp], mx); const float alpha = fexp2(m_run[mp] - mn); m_run[mp] = mn;
        float ps = 0.f;
#pragma unroll
        for (int kf = 0; kf < 2; ++kf)
#pragma unroll
          for (int i = 0; i < 16; ++i) { st[kf][i] = fexp2(st[kf][i] - mn); ps += st[kf][i]; }
        l_run[mp] = l_run[mp] * alpha + ps;
#pragma unroll
        for (int df = 0; df < 2; ++df) o[mp][df] *= alpha;
      }
      bf16x8 pf[4];
#pragma unroll
      for (int kf = 0; kf < 2; ++kf)
#pragma unroll
        for (int s2 = 0; s2 < 2; ++s2) { u32x4 u; u.x = pk(st[kf][8 * s2], st[kf][8 * s2 + 1]); u.y = pk(st[kf][8 * s2 + 2], st[kf][8 * s2 + 3]);
          u.z = pk(st[kf][8 * s2 + 4], st[kf][8 * s2 + 5]); u.w = pk(st[kf][8 * s2 + 6], st[kf][8 * s2 + 7]); pf[kf * 2 + s2] = __builtin_bit_cast(bf16x8, u); }
#pragma unroll
      for (int df = 0; df < 2; ++df)
#pragma unroll
        for (int ksx = 0; ksx < 4; ++ksx) { const bf16x8 vfr = *(const bf16x8*)(vs + (df * 32 + l31) * PITCH + ksx * 32 + h * 16); o[mp][df] = MFMA32(vfr, pf[ksx], o[mp][df]); }
    }
  };
  if constexpr (MODE == 1) {
    AT_GLOAD(0, 0); AT_LSTORE(0, 0); __syncthreads();
#pragma unroll 1
    for (int t = 0; t < nt; ++t) {
      if (t + 1 < nt) AT_GLOAD(t + 1, 0);
      const char* ks = lds + (t & 1) * 18432;
      body(ks, ks + 9216, t);
      if (t + 1 < nt) AT_LSTORE((t + 1) & 1, 0);
      __syncthreads();
    }
  } else {
    AT_GLOAD(0, 0); AT_GLOAD(1, 1); AT_LSTORE(0, 0); __syncthreads();
#pragma unroll 1
    for (int t2 = 0; t2 < nt; t2 += 2) {
      if (t2 + 2 < nt) AT_GLOAD(t2 + 2, 0);
      body(lds, lds + 9216, t2);
      AT_LSTORE(1, 1);
      __syncthreads();
      if (t2 + 3 < nt) AT_GLOAD(t2 + 3, 1);
      body(lds + 18432, lds + 18432 + 9216, t2 + 1);
      if (t2 + 2 < nt) AT_LSTORE(0, 0);
      __syncthreads();
    }
  }
#undef AT_GLOAD
#undef AT_LSTORE
  f32x16 r[2];
  if (MODE == 0) {
    const float l = l_run[0] + __shfl_xor(l_run[0], 32); const float inv = 1.0f / l;
#pragma unroll
    for (int df = 0; df < 2; ++df) r[df] = o[0][df] * inv;
  } else if (MODE == 1) {
    const float* lp = p.in[I_BLAM] + layer * 128;
    float s01 = 0.f, s23 = 0.f;
    for (int i = 0; i < 32; ++i) { s01 += lp[i] * lp[32 + i]; s23 += lp[64 + i] * lp[96 + i]; }
    const float lam_init = 0.8f - 0.6f * expf(-0.3f * (float)layer);
    const float lam = expf(s01) - expf(s23) + lam_init;
    const float l0 = l_run[0] + __shfl_xor(l_run[0], 32), l1 = l_run[NMAP - 1] + __shfl_xor(l_run[NMAP - 1], 32);
    const float i0 = 1.0f / l0, i1 = lam / l1;
    float ss = 0.f;
#pragma unroll
    for (int df = 0; df < 2; ++df) { r[df] = o[0][df] * i0 - o[NMAP - 1][df] * i1;
#pragma unroll
      for (int i = 0; i < 16; ++i) ss += r[df][i] * r[df][i]; }
    ss += __shfl_xor(ss, 32);
    const float rs = rsqrtf(ss * (1.0f / 64.0f) + EPS) * (1.0f - lam_init);
    const float* sg = p.in[I_BSUB] + layer * 64;
#pragma unroll
    for (int df = 0; df < 2; ++df)
#pragma unroll
      for (int i = 0; i < 16; ++i) r[df][i] *= rs * sg[df * 32 + (i & 3) + 8 * (i >> 2) + 4 * h];
  } else {
    float ss = 0.f;
#pragma unroll
    for (int df = 0; df < 2; ++df)
#pragma unroll
      for (int i = 0; i < 16; ++i) ss += o[0][df][i] * o[0][df][i];
    ss += __shfl_xor(ss, 32);
    const float rs = rsqrtf(ss * (1.0f / 64.0f) + EPS);
    const float* gg = p.in[I_CGN] + layer * 256 + head * 64;
    const bf16_t* zg = p.z + (size_t)(row0 + qi) * NIN + C_G + head * 64;
#pragma unroll
    for (int df = 0; df < 2; ++df)
#pragma unroll
      for (int g = 0; g < 4; ++g) { const u32x2 gw = *(const u32x2*)(zg + df * 32 + 8 * g + 4 * h);
        const float gv[4] = {bflo(gw.x), bfhi(gw.x), bflo(gw.y), bfhi(gw.y)};
#pragma unroll
        for (int e = 0; e < 4; ++e) { const float x = gv[e]; r[df][4 * g + e] = o[0][df][4 * g + e] * rs * gg[df * 32 + 8 * g + 4 * h + e] * (x / (1.0f + __expf(-x))); } }
  }
#pragma unroll
  for (int df = 0; df < 2; ++df)
#pragma unroll
    for (int g = 0; g < 4; ++g) { u32x2 v; v.x = pk(r[df][4 * g], r[df][4 * g + 1]); v.y = pk(r[df][4 * g + 2], r[df][4 * g + 3]); *(u32x2*)(zq + df * 32 + 8 * g + 4 * h) = v; }
}

template <class Epi>
DI void gemm_tile2(char* lds, const ASrc& A, const bf16_t* __restrict__ Bt, int K, int m0, int n0, const Epi& epi) {
  const int tid = opaque(threadIdx.x), lane = tid & 63, w = __builtin_amdgcn_readfirstlane(tid >> 6), wr = w >> 1, wc = w & 1, l31 = lane & 31, h = lane >> 5;
  const int nk = K >> 5, smask = (1 << A.shift) - 1;
  LASP char* ldsl = (LASP char*)lds;
  f32x16 acc[2][4];
#pragma unroll
  for (int a = 0; a < 2; ++a)
#pragma unroll
    for (int b = 0; b < 4; ++b)
#pragma unroll
      for (int i = 0; i < 16; ++i) acc[a][b][i] = 0.f;
  const int lrow = lane >> 2, lslot = lane & 3;
  int goffA[2], goffB[4];
#pragma unroll
  for (int i = 0; i < 2; ++i) { const int r = (2 * w + i) * 16 + lrow, c = lslot ^ ((r >> 2) & 3); goffA[i] = (r << 2) | c; }
#pragma unroll
  for (int i = 0; i < 4; ++i) { const int r = (4 * w + i) * 16 + lrow, c = lslot ^ ((r >> 2) & 3); goffB[i] = r * K + c * 8; }
#define G2_ISSUE(kt, st) do { const int k0_ = (kt) << 5, seg_ = k0_ >> A.shift, kk_ = k0_ & smask; \
    const bf16_t* bp_ = seg_ == 0 ? A.b0 : seg_ == 1 ? A.b1 : seg_ == 2 ? A.b2 : A.b3; const int st_ = seg_ == 0 ? A.s0 : seg_ == 1 ? A.s1 : seg_ == 2 ? A.s2 : A.s3; \
    _Pragma("unroll") for (int i_ = 0; i_ < 2; ++i_) { \
      const bf16_t* ga_ = bp_ + (size_t)(m0 + (goffA[i_] >> 2)) * st_ + kk_ + (goffA[i_] & 3) * 8; \
      __builtin_amdgcn_global_load_lds((const unsigned*)ga_, (LASP unsigned*)(ldsl + (st) * 24576 + (2 * w + i_) * 1024), 16, 0, 0); } \
    _Pragma("unroll") for (int i_ = 0; i_ < 4; ++i_) { \
      const bf16_t* gb_ = Bt + (size_t)n0 * K + goffB[i_] + k0_; \
      __builtin_amdgcn_global_load_lds((const unsigned*)gb_, (LASP unsigned*)(ldsl + (st) * 24576 + 8192 + (4 * w + i_) * 1024), 16, 0, 0); } } while (0)
  const int xr = (l31 >> 2) & 3;
  int coff[2];
#pragma unroll
  for (int s = 0; s < 2; ++s) coff[s] = ((2 * s + h) ^ xr) * 16;
#define G2_COMPUTE(st) do { const char* as = lds + (st) * 24576; const char* bs = as + 8192; \
    bf16x8 af[2][2], wf[2][4]; \
    _Pragma("unroll") for (int s = 0; s < 2; ++s) { \
      _Pragma("unroll") for (int mf = 0; mf < 2; ++mf) af[s][mf] = *(const bf16x8*)(as + (wr * 64 + mf * 32 + l31) * 64 + coff[s]); \
      _Pragma("unroll") for (int nf = 0; nf < 4; ++nf) wf[s][nf] = *(const bf16x8*)(bs + (wc * 128 + nf * 32 + l31) * 64 + coff[s]); } \
    __builtin_amdgcn_sched_barrier(0); __builtin_amdgcn_s_setprio(1); \
    _Pragma("unroll") for (int s = 0; s < 2; ++s) \
      _Pragma("unroll") for (int mf = 0; mf < 2; ++mf) _Pragma("unroll") for (int nf = 0; nf < 4; ++nf) acc[mf][nf] = MFMA32(wf[s][nf], af[s][mf], acc[mf][nf]); \
    __builtin_amdgcn_s_setprio(0); __builtin_amdgcn_sched_barrier(0); } while (0)
  G2_ISSUE(0, 0);
  for (int kt = 0; kt < nk; kt += 2) {
    asm volatile("s_waitcnt vmcnt(0)" ::: "memory"); __syncthreads();
    G2_ISSUE(kt + 1, 1);
    G2_COMPUTE(0);
    asm volatile("s_waitcnt vmcnt(0)" ::: "memory"); __syncthreads();
    if (kt + 2 < nk) G2_ISSUE(kt + 2, 0);
    G2_COMPUTE(1);
  }
  __syncthreads();
#pragma unroll
  for (int hf = 0; hf < 2; ++hf) {
    f32x16 t[2][2];
#pragma unroll
    for (int mf = 0; mf < 2; ++mf) { t[mf][0] = acc[mf][2 * hf]; t[mf][1] = acc[mf][2 * hf + 1]; }
    epi(t, m0 + wr * 64, n0 + wc * 128 + hf * 64, n0, wc, l31, h);
  }
  __syncthreads();
#undef G2_ISSUE
#undef G2_COMPUTE
}

template <class Epi>
DI void gemm_phase2(char* lds, const ASrc& A, const bf16_t* Bt, int K, int ntn, const Epi& epi) {
  const int xcd = blockIdx.x & 7, j = blockIdx.x >> 3, nloc = gridDim.x >> 3, per = 48 * ntn, grp = 8 * ntn;
  for (int li = j; li < per; li += nloc) {
    const int sg = li / grp, wi = li - sg * grp, nt = wi >> 3, mt = xcd * 48 + sg * 8 + (wi & 7);
    gemm_tile2(lds, A, Bt, K, mt * 128, nt * 256, epi);
  }
}

template <int MODE>
DI void attn3_item(char* lds, const Params& p, int layer, int seq, int head, int qt) {
  const int tid = opaque(threadIdx.x), lane = tid & 63, w = tid >> 6, l31 = lane & 31, h = lane >> 5;
  layer = opaque_s(layer); seq = opaque_s(seq); head = opaque_s(head); qt = opaque_s(qt);
  int row0, T; seq_info(seq, row0, T);
  const int QC = (MODE == 0 ? A_Q : C_Q) + head * 64;
  const int KC = MODE == 0 ? A_K + (head >> 1) * 64 : C_K + head * 64;
  const int VC = MODE == 0 ? A_V + (head >> 1) * 64 : C_V + head * 64;
  const int qw0 = qt * 256 + w * 64;
  bf16x8 qf[2][4];
#pragma unroll
  for (int qi = 0; qi < 2; ++qi)
#pragma unroll
    for (int s = 0; s < 4; ++s) qf[qi][s] = *(const bf16x8*)(p.z + (size_t)(row0 + qw0 + qi * 32 + l31) * NIN + QC + s * 16 + h * 8);
  const int srow = tid >> 3, sc8 = tid & 7;
  const bf16_t* kbase = p.z + (size_t)(row0 + srow) * NIN + KC + sc8 * 8;
  const bf16_t* vbase = p.z + (size_t)(row0 + srow) * NIN + VC + sc8 * 8;
  u32x4 rk[2], rv[2];
  const int nt = T >> 6;
  const int prow = (l31 & 19) | ((l31 & 4) << 1) | ((l31 & 8) >> 1);
#define A3_GLOAD(t) do { _Pragma("unroll") for (int i_ = 0; i_ < 2; ++i_) { const size_t off_ = (size_t)((t) * 64 + 32 * i_) * NIN; rk[i_] = *(const u32x4*)(kbase + off_); rv[i_] = *(const u32x4*)(vbase + off_); } } while (0)
#define A3_LSTORE(buf) do { char* ks_ = lds + (buf) * 18432; char* vs_ = ks_ + 9216; \
    _Pragma("unroll") for (int i_ = 0; i_ < 2; ++i_) { *(u32x4*)(ks_ + (srow + 32 * i_) * PITCH + sc8 * 16) = rk[i_]; *(u32x4*)(vs_ + (srow + 32 * i_) * PITCH + sc8 * 16) = rv[i_]; } } while (0)
  f32x16 o[2][2];
  float m_run[2], l_run[2];
#pragma unroll
  for (int a = 0; a < 2; ++a) { m_run[a] = -INFINITY; l_run[a] = 0.f;
#pragma unroll
    for (int b = 0; b < 2; ++b)
#pragma unroll
      for (int i = 0; i < 16; ++i) o[a][b][i] = 0.f; }
  float lf = 0.f, lb = 0.f;
  if (MODE == 2) { lf = log2f(1.0f - exp2f(-5.0f - (float)head)); lb = log2f(1.0f - exp2f(-5.0f - (float)(3 - head))); }
  A3_GLOAD(0); A3_LSTORE(0); __syncthreads();
#pragma unroll 1
  for (int t = 0; t < nt; ++t) {
    if (t + 1 < nt) A3_GLOAD(t + 1);
    const char* ks = lds + (t & 1) * 18432; const char* vs = ks + 9216;
    f32x16 st[2][2];
#pragma unroll
    for (int kf = 0; kf < 2; ++kf) {
#pragma unroll
      for (int qi = 0; qi < 2; ++qi)
#pragma unroll
        for (int i = 0; i < 16; ++i) st[qi][kf][i] = 0.f;
#pragma unroll
      for (int s = 0; s < 4; ++s) { const bf16x8 kfr = *(const bf16x8*)(ks + (kf * 32 + prow) * PITCH + s * 32 + h * 16);
#pragma unroll
        for (int qi = 0; qi < 2; ++qi) st[qi][kf] = MFMA32(kfr, qf[qi][s], st[qi][kf]); }
    }
    __builtin_amdgcn_sched_barrier(0);
#pragma unroll
    for (int qi = 0; qi < 2; ++qi) {
      bf16x8 pf[4];
      if (MODE == 2) {
        const int k0 = t * 64, qb = qw0 + qi * 32;
        const float dbase = (float)(qb + l31 - k0 - 8 * h);
        if (k0 + 63 < qb) {
#pragma unroll
          for (int kf = 0; kf < 2; ++kf)
#pragma unroll
            for (int i = 0; i < 16; ++i) { const float cc = (float)(32 * kf + (i & 3) + 4 * ((i >> 2) & 1) + 16 * ((i >> 3) & 1)); st[qi][kf][i] *= fexp2(lf * (dbase - cc)); }
        } else if (k0 > qb + 31) {
#pragma unroll
          for (int kf = 0; kf < 2; ++kf)
#pragma unroll
            for (int i = 0; i < 16; ++i) { const float cc = (float)(32 * kf + (i & 3) + 4 * ((i >> 2) & 1) + 16 * ((i >> 3) & 1)); st[qi][kf][i] *= fexp2(lb * (cc - dbase)); }
        } else {
#pragma unroll
          for (int kf = 0; kf < 2; ++kf)
#pragma unroll
            for (int i = 0; i < 16; ++i) { const float cc = (float)(32 * kf + (i & 3) + 4 * ((i >> 2) & 1) + 16 * ((i >> 3) & 1)); const float d = dbase - cc;
              float dd = fexp2(fminf(lf * d, -lb * d)); if (d == 0.f) dd = 2.0f; st[qi][kf][i] *= dd; }
        }
      } else {
        float mx = st[qi][0][0];
#pragma unroll
        for (int kf = 0; kf < 2; ++kf)
#pragma unroll
          for (int i = 0; i < 16; ++i) mx = fmaxf(mx, st[qi][kf][i]);
        mx = fmaxf(mx, __shfl_xor(mx, 32));
        const float mn = fmaxf(m_run[qi], mx); const float alpha = fexp2(m_run[qi] - mn); m_run[qi] = mn;
        float ps = 0.f;
#pragma unroll
        for (int kf = 0; kf < 2; ++kf)
#pragma unroll
          for (int i = 0; i < 16; ++i) { st[qi][kf][i] = fexp2(st[qi][kf][i] - mn); ps += st[qi][kf][i]; }
        l_run[qi] = l_run[qi] * alpha + ps;
#pragma unroll
        for (int df = 0; df < 2; ++df) o[qi][df] *= alpha;
      }
#pragma unroll
      for (int kf = 0; kf < 2; ++kf)
#pragma unroll
        for (int s2 = 0; s2 < 2; ++s2) { u32x4 u; u.x = pk(st[qi][kf][8 * s2], st[qi][kf][8 * s2 + 1]); u.y = pk(st[qi][kf][8 * s2 + 2], st[qi][kf][8 * s2 + 3]);
          u.z = pk(st[qi][kf][8 * s2 + 4], st[qi][kf][8 * s2 + 5]); u.w = pk(st[qi][kf][8 * s2 + 6], st[qi][kf][8 * s2 + 7]); pf[kf * 2 + s2] = __builtin_bit_cast(bf16x8, u); }
#pragma unroll
      for (int df = 0; df < 2; ++df)
#pragma unroll
        for (int ksx = 0; ksx < 4; ++ksx) { const bf16x8 vfr = *(const bf16x8*)(vs + (df * 32 + l31) * PITCH + ksx * 32 + h * 16); o[qi][df] = MFMA32(vfr, pf[ksx], o[qi][df]); }
      __builtin_amdgcn_sched_barrier(0);
    }
    __builtin_amdgcn_sched_barrier(0);
    if (t + 1 < nt) A3_LSTORE((t + 1) & 1);
    __syncthreads();
  }
#undef A3_GLOAD
#undef A3_LSTORE
#pragma unroll
  for (int qi = 0; qi < 2; ++qi) {
    const int qrow = row0 + qw0 + qi * 32 + l31;
    bf16_t* zq = p.z + (size_t)qrow * NIN + QC;
    f32x16 r[2];
    if (MODE == 0) {
      const float l = l_run[qi] + __shfl_xor(l_run[qi], 32); const float inv = 1.0f / l;
#pragma unroll
      for (int df = 0; df < 2; ++df) r[df] = o[qi][df] * inv;
    } else {
      float ss = 0.f;
#pragma unroll
      for (int df = 0; df < 2; ++df)
#pragma unroll
        for (int i = 0; i < 16; ++i) ss += o[qi][df][i] * o[qi][df][i];
      ss += __shfl_xor(ss, 32);
      const float rs = rsqrtf(ss * (1.0f / 64.0f) + EPS);
      const float* gg = p.in[I_CGN] + layer * 256 + head * 64;
      const bf16_t* zg = p.z + (size_t)qrow * NIN + C_G + head * 64;
#pragma unroll
      for (int df = 0; df < 2; ++df)
#pragma unroll
        for (int g = 0; g < 4; ++g) { const u32x2 gw = *(const u32x2*)(zg + df * 32 + 8 * g + 4 * h);
          const float gv[4] = {bflo(gw.x), bfhi(gw.x), bflo(gw.y), bfhi(gw.y)};
#pragma unroll
          for (int e = 0; e < 4; ++e) { const float x = gv[e]; r[df][4 * g + e] = o[qi][df][4 * g + e] * rs * gg[df * 32 + 8 * g + 4 * h + e] * (x / (1.0f + __expf(-x))); } }
    }
#pragma unroll
    for (int df = 0; df < 2; ++df)
#pragma unroll
      for (int g = 0; g < 4; ++g) { u32x2 v; v.x = pk(r[df][4 * g], r[df][4 * g + 1]); v.y = pk(r[df][4 * g + 2], r[df][4 * g + 3]); *(u32x2*)(zq + df * 32 + 8 * g + 4 * h) = v; }
  }
}

DI int next_item(int* ctr, int* sh) {
  __syncthreads();
  if (threadIdx.x == 0) *sh = atomicAdd(ctr, 1);
  __syncthreads();
  return *sh;
}

__global__ void __launch_bounds__(256, 2) fwd(Params p) {
  extern __shared__ __attribute__((aligned(16))) char lds[];
  __shared__ int s_item;
  cg::grid_group grid = cg::this_grid();
  const int bid = blockIdx.x, nb = gridDim.x, tid = threadIdx.x, lane = tid & 63, w = tid >> 6;
  if (bid == 0 && tid < 64) p.ctr[tid] = 0;
  for (int i = bid * 256 + tid; i < 4096 * 32; i += nb * 256) { const int t = i >> 5, j = i & 31; const float inv = powf(10000.0f, -(float)(2 * j) / 64.0f); float sn, cs; sincosf((float)t * inv, &sn, &cs); p.tabC[i] = (f32x2){cs, sn}; }
  for (int i = bid * 256 + tid; i < 4096 * 4; i += nb * 256) { const int t = i >> 2, j = i & 3; const float inv = powf(500000.0f, -(float)(2 * j) / 8.0f); float sn, cs; sincosf((float)t * inv, &sn, &cs); p.tabB[i] = (f32x2){cs, sn}; }
  for (int i = bid * 256 + tid; i < 64 * 16; i += nb * 256) { const int t = i >> 4, j = i & 15; const float inv = powf(10000.0f, -(float)(2 * j) / 32.0f); float sn, cs; sincosf((float)t * inv, &sn, &cs); p.tabA[i] = (f32x2){cs, sn}; }
  for (int l = 0; l < 2; ++l) {
    for (int i = bid * 256 + tid; i < (NINP - NIN) * 1024; i += nb * 256) p.wtin[(size_t)l * NINP * 1024 + (size_t)NIN * 1024 + i] = 0;
    for (int tl = bid; tl < 16 * 53; tl += nb) conv_T(lds, p.in[I_WIN] + (size_t)l * 1024 * NIN, 1024, NIN, p.wtin + (size_t)l * NINP * 1024, 0, tl);
    for (int tl = bid; tl < 16 * 16; tl += nb) conv_T(lds, p.in[I_WOUT] + (size_t)l * 1024 * 1024, 1024, 1024, p.wtout + (size_t)l * 1024 * 1024, 0, tl);
  }
  bf16_t* hb = p.pl;
  for (int row = bid * 4 + opaque(w); row < MT; row += nb * 4) {
    const float* xin = row < M0 ? p.in[I_XP] + (size_t)row * 1024 : p.in[I_XS] + (size_t)(row - M0) * 1024;
    row_phase(xin, p.out + (size_t)row * 1024, nullptr, nullptr, p.in[I_NMPRE], hb + (size_t)row * 1024, lane);
  }
  grid.sync();
  for (int l = 0; l < 2; ++l) {
    { ASrc A; A.b0 = hb; A.b1 = hb; A.b2 = hb; A.b3 = hb; A.s0 = A.s1 = A.s2 = A.s3 = 1024; A.shift = 12;
      EpiIn e; e.z = p.z; e.lds = lds; e.qg = p.in[I_AQG] + l * 64; e.kg = p.in[I_AKG] + l * 64; e.tabA = p.tabA; e.tabB = p.tabB; e.tabC = p.tabC;
      gemm_phase2(lds, A, p.wtin + (size_t)l * NINP * 1024, 1024, 14, e); }
    grid.sync();
    for (int it = bid; it < MT / DTOK; it += nb) dprep_item(lds, p, l, it);
    grid.sync();
    for (;;) {
      const int it = next_item(p.ctr + l * 16, &s_item);
      if (it >= 256 + 2048 + 1024) break;
      if (it < 256) { const int i2 = it >> 1; const int sq = i2 < 64 ? (i2 >> 3) : 8 + ((i2 - 64) >> 3); rwkv_item(lds, p, sq, (i2 >> 1) & 3, i2 & 1, it & 1); }
      else {
        int j = it - 256;
        if (j < 2048) {
          if (j < 1024) attn_item<1>(lds, p, l, j >> 7, (j >> 5) & 3, j & 31);
          else { const int r = (j - 1024) & 511; if (j < 1536) attn3_item<2>(lds, p, l, r >> 6, (r >> 4) & 3, r & 15); else attn3_item<0>(lds, p, l, r >> 6, (r >> 4) & 3, r & 15); }
        } else { j -= 2048;
          if (j < 512) attn_item<1>(lds, p, l, 8 + (j >> 6), (j >> 4) & 3, j & 15);
          else { const int r = (j - 512) & 255; if (j < 768) attn3_item<2>(lds, p, l, 8 + (r >> 5), (r >> 3) & 3, r & 7); else attn3_item<0>(lds, p, l, 8 + (r >> 5), (r >> 3) & 3, r & 7); }
        }
      }
    }
    grid.sync();
    bf16_t* wtgu = p.pl + 5 * PLANE; bf16_t* wtd = wtgu + (size_t)2 * DFF * 1024;
    for (int it = bid; it < MT / DTOK + 3 * 704; it += nb) {
      if (it < MT / DTOK) dpost_item(lds, p, l, it);
      else { const int j = it - MT / DTOK;
        if (j < 704) conv_T(lds, p.in[I_FG] + (size_t)l * 1024 * DFF, 1024, DFF, wtgu, 1, j);
        else if (j < 1408) conv_T(lds, p.in[I_FU] + (size_t)l * 1024 * DFF, 1024, DFF, wtgu, 2, j - 704);
        else conv_T(lds, p.in[I_FD] + (size_t)l * DFF * 1024, DFF, 1024, wtd, 0, j - 1408); }
    }
    grid.sync();
    { ASrc A; A.b0 = p.z + A_Q; A.b1 = p.z + B_Q; A.b2 = p.z + C_Q; A.b3 = p.pl + 4 * PLANE; A.s0 = A.s1 = A.s2 = NIN; A.s3 = 256; A.shift = 8;
      EpiStore e; e.out = hb; e.ldc = 1024; e.nmax = 1024;
      gemm_phase2(lds, A, p.wtout + (size_t)l * 1024 * 1024, 1024, 4, e); }
    grid.sync();
    for (int row = bid * 4 + opaque(w); row < MT; row += nb * 8) { const int rb = row + nb * 4;
      if (rb < MT) row_phase2(p.out + (size_t)row * 1024, p.out + (size_t)rb * 1024, p.out + (size_t)row * 1024, p.out + (size_t)rb * 1024, hb + (size_t)row * 1024, hb + (size_t)rb * 1024,
                              p.in[I_NMPOST] + l * 1024, p.in[I_NFPRE] + l * 1024, hb + (size_t)row * 1024, hb + (size_t)rb * 1024, lane);
      else row_phase(p.out + (size_t)row * 1024, p.out + (size_t)row * 1024, hb + (size_t)row * 1024, p.in[I_NMPOST] + l * 1024, p.in[I_NFPRE] + l * 1024, hb + (size_t)row * 1024, lane); }
    grid.sync();
    { ASrc A; A.b0 = hb; A.b1 = hb; A.b2 = hb; A.b3 = hb; A.s0 = A.s1 = A.s2 = A.s3 = 1024; A.shift = 12;
      EpiSwiGLU e; e.out = p.z;
      gemm_phase2(lds, A, wtgu, 1024, 22, e); }
    grid.sync();
    { ASrc A; A.b0 = p.z; A.b1 = p.z; A.b2 = p.z; A.b3 = p.z; A.s0 = A.s1 = A.s2 = A.s3 = DFF; A.shift = 12;
      EpiStore e; e.out = hb; e.ldc = 1024; e.nmax = 1024;
      gemm_phase2(lds, A, wtd, DFF, 4, e); }
    grid.sync();
    for (int row = bid * 4 + opaque(w); row < MT; row += nb * 8) { const int rb = row + nb * 4; const float* gp2 = l == 0 ? p.in[I_NMPRE] + 1024 : nullptr;
      if (rb < MT) row_phase2(p.out + (size_t)row * 1024, p.out + (size_t)rb * 1024, p.out + (size_t)row * 1024, p.out + (size_t)rb * 1024, hb + (size_t)row * 1024, hb + (size_t)rb * 1024,
                              p.in[I_NFPOST] + l * 1024, gp2, hb + (size_t)row * 1024, hb + (size_t)rb * 1024, lane);
      else row_phase(p.out + (size_t)row * 1024, p.out + (size_t)row * 1024, hb + (size_t)row * 1024, p.in[I_NFPOST] + l * 1024, gp2, hb + (size_t)row * 1024, lane); }
    if (l == 0) grid.sync();
  }
}

extern "C" void kernel_launch(void* const* d_in, const int* in_sizes, int n_in, void* d_out, int out_size,
                              void* d_ws, size_t ws_size, hipStream_t stream) {
  static int grid_blocks = 0;
  if (!grid_blocks) {
    int dev = 0, cus = 0, per_cu = 0;
    hipGetDevice(&dev);
    hipDeviceGetAttribute(&cus, hipDeviceAttributeMultiprocessorCount, dev);
    hipFuncSetAttribute((const void*)fwd, hipFuncAttributeMaxDynamicSharedMemorySize, LDS_BYTES);
    hipOccupancyMaxActiveBlocksPerMultiprocessor(&per_cu, fwd, 256, LDS_BYTES);
    if (per_cu > 2) per_cu = 2;
    if (per_cu < 1) per_cu = 1;
    grid_blocks = cus * per_cu;
  }
  Params p{};
  for (int i = 0; i < 28; ++i) p.in[i] = (const float*)d_in[i];
  p.out = (float*)d_out;
  char* ws = (char*)d_ws;
  size_t off = 0;
  p.z = (bf16_t*)(ws + off); off += (size_t)MT * NIN * 2;
  p.pl = (bf16_t*)(ws + off); off += 7 * PLANE * 2;
  p.wtin = (bf16_t*)(ws + off); off += (size_t)2 * NINP * 1024 * 2;
  p.wtout = (bf16_t*)(ws + off); off += (size_t)2 * 1024 * 1024 * 2;
  p.tabC = (f32x2*)(ws + off); off += (size_t)4096 * 32 * 8;
  p.tabB = (f32x2*)(ws + off); off += (size_t)4096 * 4 * 8;
  p.tabA = (f32x2*)(ws + off); off += (size_t)64 * 16 * 8;
  p.ctr = (int*)(ws + off); off += 256;
  if (off > ws_size) fprintf(stderr, "workspace too small: need %zu have %zu\n", off, ws_size);
  void* args[] = {&p};
  hipError_t e = hipLaunchCooperativeKernel((void*)fwd, dim3(grid_blocks), dim3(256), args, LDS_BYTES, stream);
  if (e != hipSuccess) fprintf(stderr, "coop launch failed: %s (grid %d)\n", hipGetErrorString(e), grid_blocks);
}
```

```cpp
#include <hip/hip_runtime.h>
#include <hip/hip_cooperative_groups.h>
#include <cstdio>
#include <cstdint>
namespace cg = cooperative_groups;

#define DI __device__ __forceinline__
typedef unsigned short bf16_t;
typedef short bf16x8 __attribute__((ext_vector_type(8)));
typedef float f32x2 __attribute__((ext_vector_type(2)));
typedef float f32x4 __attribute__((ext_vector_type(4)));
typedef float f32x16 __attribute__((ext_vector_type(16)));
typedef unsigned u32x2 __attribute__((ext_vector_type(2)));
typedef unsigned u32x4 __attribute__((ext_vector_type(4)));
typedef __bf16 bf16x2_t __attribute__((ext_vector_type(2)));

constexpr int M0 = 32768, MT = 49152, DM = 1024, NIN = 3392, NINP = 3584, DFF = 2816;
constexpr int A_Q = 0, A_K = 256, A_V = 384, B_Q = 512, B_K = 768, B_V = 1024, C_Q = 1280, C_K = 1536, C_V = 1792, C_G = 2048, D_0 = 2304;
constexpr int PITCH = 144;
constexpr size_t PLANE = (size_t)MT * 256;
constexpr int LDS_BYTES = 73728;
constexpr float LOG2E = 1.4426950408889634f;
constexpr float EPS = 1e-6f;

enum { I_XP = 0, I_XS, I_NMPRE, I_NMPOST, I_NFPRE, I_NFPOST, I_WIN, I_WOUT, I_AQG, I_AKG, I_BLAM, I_BSUB, I_CGN, I_DMUP, I_DMUN, I_DW0, I_DWUP,
       I_DA0, I_DAUP, I_DGUP, I_DKK, I_DKA, I_DRK, I_DGNW, I_DGNB, I_FG, I_FU, I_FD };

struct Params {
  const float* in[28];
  float* out;
  bf16_t* z;
  bf16_t* pl;
  bf16_t* wtin;
  bf16_t* wtout;
  f32x2* tabC;
  f32x2* tabB;
  f32x2* tabA;
  int* ctr;
};

DI int opaque(int x) { asm volatile("" : "+v"(x)); return x; }
DI int opaque_s(int x) { asm volatile("" : "+s"(x)); return x; }
DI float bf2f(bf16_t v) { return __uint_as_float(((unsigned)v) << 16); }
DI float bflo(unsigned w) { return __uint_as_float(w << 16); }
DI float bfhi(unsigned w) { return __uint_as_float(w & 0xffff0000u); }
DI unsigned pk(float lo, float hi) { f32x2 v = {lo, hi}; bf16x2_t b = __builtin_convertvector(v, bf16x2_t); return __builtin_bit_cast(unsigned, b); }
DI bf16_t f2bf(float x) { return (bf16_t)(pk(x, 0.f) & 0xffffu); }
DI float dppf(float x, const int ctrl) { return x; }
#define DPPF(x, ctrl) __int_as_float(__builtin_amdgcn_update_dpp(0, __float_as_int(x), (ctrl), 0xF, 0xF, true))
DI float wave_sum(float v) {
  v += DPPF(v, 0xB1);
  v += DPPF(v, 0x4E);
  v += DPPF(v, 0x141);
  v += DPPF(v, 0x140);
  const int vi = __float_as_int(v);
  return (__int_as_float(__builtin_amdgcn_readlane(vi, 0)) + __int_as_float(__builtin_amdgcn_readlane(vi, 16))) +
         (__int_as_float(__builtin_amdgcn_readlane(vi, 32)) + __int_as_float(__builtin_amdgcn_readlane(vi, 48)));
}
DI float dpp_xor1(float x) { return __int_as_float(__builtin_amdgcn_update_dpp(0, __float_as_int(x), 0xB1, 0xF, 0xF, true)); }
DI float dpp_xor2(float x) { return __int_as_float(__builtin_amdgcn_update_dpp(0, __float_as_int(x), 0x4E, 0xF, 0xF, true)); }
DI float dpp_hmir(float x) { return __int_as_float(__builtin_amdgcn_update_dpp(0, __float_as_int(x), 0x141, 0xF, 0xF, true)); }
DI float red8(float x) { x += dpp_xor1(x); x += dpp_xor2(x); x += dpp_hmir(x); return x; }
DI float fexp2(float x) { return __builtin_amdgcn_exp2f(x); }
DI void seq_info(int s, int& row0, int& T) { if (s < 8) { row0 = s * 4096; T = 4096; } else { row0 = M0 + (s - 8) * 2048; T = 2048; } }
DI void row_info(int r, int& t, int& T) { if (r < M0) { t = r & 4095; T = 4096; } else { t = (r - M0) & 2047; T = 2048; } }
#define MFMA32(a, b, c) __builtin_amdgcn_mfma_f32_32x32x16_bf16((a), (b), (c), 0, 0, 0)

DI void conv_T(char* lds, const float* __restrict__ W, int K, int N, bf16_t* __restrict__ Wt, int mode, int tile) {
  float* t = (float*)lds;
  const int tid0 = opaque(threadIdx.x);
  const int ntn = N >> 6, kt = tile / ntn, nt = tile - kt * ntn, k0 = kt << 6, n0 = nt << 6;
#pragma unroll 4
  for (int i = 0; i < 16; ++i) { const int idx = tid0 + 256 * i, k = idx >> 6, n = idx & 63; t[k * 65 + n] = W[(size_t)(k0 + k) * N + n0 + n]; }
  __syncthreads();
#pragma unroll 4
  for (int i = 0; i < 8; ++i) {
    const int idx = tid0 + 256 * i, n = idx >> 5, k = (idx & 31) * 2, j = n0 + n;
    const int rho = (mode == 0) ? j : ((j >> 6) * 128 + ((j >> 5) & 1) * 64 + (mode - 1) * 32 + (j & 31));
    *(unsigned*)(Wt + (size_t)rho * K + k0 + k) = pk(t[k * 65 + n], t[(k + 1) * 65 + n]);
  }
  __syncthreads();
}

DI void row_phase(const float* __restrict__ xin, float* __restrict__ xout, const bf16_t* addsrc, const float* __restrict__ gpost,
                  const float* __restrict__ gpre, bf16_t* hout, int lane_in) {
  const int lane = opaque(lane_in);
  f32x4 x[4];
#pragma unroll
  for (int i = 0; i < 4; ++i) x[i] = *(const f32x4*)(xin + i * 256 + lane * 4);
  if (addsrc) {
    f32x4 m[4]; float ss = 0.f;
#pragma unroll
    for (int i = 0; i < 4; ++i) { const u32x2 w = *(const u32x2*)(addsrc + i * 256 + lane * 4); m[i] = (f32x4){bflo(w.x), bfhi(w.x), bflo(w.y), bfhi(w.y)};
      ss += m[i][0] * m[i][0] + m[i][1] * m[i][1] + m[i][2] * m[i][2] + m[i][3] * m[i][3]; }
    ss = wave_sum(ss); const float rs = rsqrtf(ss * (1.0f / 1024.0f) + EPS);
#pragma unroll
    for (int i = 0; i < 4; ++i) { const f32x4 g = *(const f32x4*)(gpost + i * 256 + lane * 4); x[i] += m[i] * rs * g; }
  }
#pragma unroll
  for (int i = 0; i < 4; ++i) *(f32x4*)(xout + i * 256 + lane * 4) = x[i];
  if (gpre) {
    float ss = 0.f;
#pragma unroll
    for (int i = 0; i < 4; ++i) ss += x[i][0] * x[i][0] + x[i][1] * x[i][1] + x[i][2] * x[i][2] + x[i][3] * x[i][3];
    ss = wave_sum(ss); const float rs = rsqrtf(ss * (1.0f / 1024.0f) + EPS);
#pragma unroll
    for (int i = 0; i < 4; ++i) { const f32x4 g = *(const f32x4*)(gpre + i * 256 + lane * 4); const f32x4 hv = x[i] * rs * g;
      u32x2 w; w.x = pk(hv[0], hv[1]); w.y = pk(hv[2], hv[3]); *(u32x2*)(hout + i * 256 + lane * 4) = w; }
  }
}

DI void row_phase2(const float* __restrict__ xinA, const float* __restrict__ xinB, float* __restrict__ xoutA, float* __restrict__ xoutB, const bf16_t* addA, const bf16_t* addB,
                   const float* __restrict__ gpost, const float* __restrict__ gpre, bf16_t* houtA, bf16_t* houtB, int lane_in) {
  const int lane = opaque(lane_in);
  f32x4 x[2][4]; u32x2 aw[2][4];
#pragma unroll
  for (int i = 0; i < 4; ++i) { x[0][i] = *(const f32x4*)(xinA + i * 256 + lane * 4); x[1][i] = *(const f32x4*)(xinB + i * 256 + lane * 4); }
  if (addA) {
#pragma unroll
    for (int i = 0; i < 4; ++i) { aw[0][i] = *(const u32x2*)(addA + i * 256 + lane * 4); aw[1][i] = *(const u32x2*)(addB + i * 256 + lane * 4); }
#pragma unroll
    for (int r = 0; r < 2; ++r) {
      f32x4 m[4]; float ss = 0.f;
#pragma unroll
      for (int i = 0; i < 4; ++i) { const u32x2 w = aw[r][i]; m[i] = (f32x4){bflo(w.x), bfhi(w.x), bflo(w.y), bfhi(w.y)};
        ss += m[i][0] * m[i][0] + m[i][1] * m[i][1] + m[i][2] * m[i][2] + m[i][3] * m[i][3]; }
      ss = wave_sum(ss); const float rs = rsqrtf(ss * (1.0f / 1024.0f) + EPS);
#pragma unroll
      for (int i = 0; i < 4; ++i) { const f32x4 g = *(const f32x4*)(gpost + i * 256 + lane * 4); x[r][i] += m[i] * rs * g; }
    }
  }
#pragma unroll
  for (int i = 0; i < 4; ++i) { *(f32x4*)(xoutA + i * 256 + lane * 4) = x[0][i]; *(f32x4*)(xoutB + i * 256 + lane * 4) = x[1][i]; }
  if (gpre) {
#pragma unroll
    for (int r = 0; r < 2; ++r) {
      float ss = 0.f;
#pragma unroll
      for (int i = 0; i < 4; ++i) ss += x[r][i][0] * x[r][i][0] + x[r][i][1] * x[r][i][1] + x[r][i][2] * x[r][i][2] + x[r][i][3] * x[r][i][3];
      ss = wave_sum(ss); const float rs = rsqrtf(ss * (1.0f / 1024.0f) + EPS);
      bf16_t* ho = r == 0 ? houtA : houtB;
#pragma unroll
      for (int i = 0; i < 4; ++i) { const f32x4 g = *(const f32x4*)(gpre + i * 256 + lane * 4); const f32x4 hv = x[r][i] * rs * g;
        u32x2 w; w.x = pk(hv[0], hv[1]); w.y = pk(hv[2], hv[3]); *(u32x2*)(ho + i * 256 + lane * 4) = w; }
    }
  }
}

struct ASrc { const bf16_t* b0; const bf16_t* b1; const bf16_t* b2; const bf16_t* b3; int s0, s1, s2, s3; int shift; };

struct EpiStore { bf16_t* out; int ldc; int nmax;
  DI void operator()(const f32x16 (&acc)[2][2], int mb, int nb, int n0, int wc, int l31, int h) const {
#pragma unroll
    for (int mf = 0; mf < 2; ++mf) { bf16_t* rp = out + (size_t)(mb + mf * 32 + l31) * ldc;
#pragma unroll
      for (int nf = 0; nf < 2; ++nf) { if (nb + nf * 32 < nmax) {
#pragma unroll
        for (int g = 0; g < 4; ++g) { u32x2 v; v.x = pk(acc[mf][nf][4 * g], acc[mf][nf][4 * g + 1]); v.y = pk(acc[mf][nf][4 * g + 2], acc[mf][nf][4 * g + 3]);
          *(u32x2*)(rp + nb + nf * 32 + 8 * g + 4 * h) = v; } } } }
  } };
struct EpiSwiGLU { bf16_t* out;
  DI void operator()(const f32x16 (&acc)[2][2], int mb, int nb, int n0, int wc, int l31, int h) const {
    const int hc = (nb >> 6) * 32;
#pragma unroll
    for (int mf = 0; mf < 2; ++mf) { bf16_t* rp = out + (size_t)(mb + mf * 32 + l31) * DFF + hc;
#pragma unroll
      for (int g = 0; g < 4; ++g) { float r[4];
#pragma unroll
        for (int e = 0; e < 4; ++e) { const float gt = acc[mf][0][4 * g + e], up = acc[mf][1][4 * g + e]; r[e] = gt / (1.0f + __expf(-gt)) * up; }
        u32x2 v; v.x = pk(r[0], r[1]); v.y = pk(r[2], r[3]); *(u32x2*)(rp + 8 * g + 4 * h) = v; } }
  } };

struct EpiIn { bf16_t* z; char* lds; const float* qg; const float* kg; const f32x2* tabA; const f32x2* tabB; const f32x2* tabC;
  DI void operator()(f32x16 (&acc)[2][2], int mb, int nb, int n0, int wc, int l31, int h) const {
    if (nb >= NIN) return;
    const bool isv = (nb >= A_V && nb < B_Q) || (nb >= B_V && nb < C_Q) || (nb >= C_V && nb < C_G);
    if (isv) {
      const int wv = (threadIdx.x >> 6);
      bf16_t* img = (bf16_t*)(lds + 32768 + wv * 9216);
#pragma unroll
      for (int mf = 0; mf < 2; ++mf)
#pragma unroll
        for (int nf = 0; nf < 2; ++nf)
#pragma unroll
          for (int i = 0; i < 16; ++i) { const int d = nf * 32 + (i & 3) + 8 * (i >> 2) + 4 * h; img[d * 72 + mf * 32 + l31] = f2bf(acc[mf][nf][i]); }
      __builtin_amdgcn_s_waitcnt(0xc07f);
      const int ln = l31 + 32 * h;
#pragma unroll
      for (int i = 0; i < 8; ++i) { const int q = ln + 64 * i, d = q >> 3, c8 = q & 7;
        const u32x4 v = *(const u32x4*)(img + d * 72 + c8 * 8); *(u32x4*)(z + (size_t)(mb + d) * NIN + nb + c8 * 8) = v; }
      return;
    }
#pragma unroll
    for (int mf = 0; mf < 2; ++mf) {
      const int row = mb + mf * 32 + l31; int t, T; row_info(row, t, T);
      if (nb < A_V) {
        const bool isq = nb < A_K; const float* gn = isq ? qg : kg;
        float ss = 0.f;
#pragma unroll
        for (int nf = 0; nf < 2; ++nf)
#pragma unroll
          for (int i = 0; i < 16; ++i) ss += acc[mf][nf][i] * acc[mf][nf][i];
        ss += __shfl_xor(ss, 32);
        const float rs = rsqrtf(ss * (1.0f / 64.0f) + EPS) * (isq ? 0.125f * LOG2E : 1.0f);
#pragma unroll
        for (int nf = 0; nf < 2; ++nf) {
          const int pos = nf == 0 ? (t >> 6) : (t & 63);
#pragma unroll
          for (int g = 0; g < 4; ++g)
#pragma unroll
            for (int e = 0; e < 4; ++e) acc[mf][nf][4 * g + e] *= rs * gn[nf * 32 + 8 * g + 4 * h + e];
#pragma unroll
          for (int g = 0; g < 2; ++g)
#pragma unroll
            for (int e = 0; e < 4; ++e) { const f32x2 cs = tabA[pos * 16 + 8 * g + 4 * h + e];
              const float x1 = acc[mf][nf][4 * g + e], x2 = acc[mf][nf][4 * (g + 2) + e];
              acc[mf][nf][4 * g + e] = x1 * cs.x - x2 * cs.y; acc[mf][nf][4 * (g + 2) + e] = x2 * cs.x + x1 * cs.y; }
        }
      } else if (nb >= B_Q && nb < B_V) {
        const bool isq = nb < B_K;
#pragma unroll
        for (int nf = 0; nf < 2; ++nf) {
#pragma unroll
          for (int e = 0; e < 4; ++e) { const f32x2 cs = tabB[t * 4 + e]; const float v = acc[mf][nf][e]; const float o = __shfl_xor(v, 32);
            acc[mf][nf][e] = (h == 0) ? (v * cs.x - o * cs.y) : (v * cs.x + o * cs.y); }
          if (isq) {
#pragma unroll
            for (int i = 0; i < 16; ++i) acc[mf][nf][i] *= 0.17677669529663687f * LOG2E; }
        }
      } else if (nb >= C_Q && nb < C_V) {
        const float sc = nb < C_K ? 1.0f : 0.125f;
#pragma unroll
        for (int g = 0; g < 4; ++g)
#pragma unroll
          for (int e = 0; e < 4; ++e) { const f32x2 cs = tabC[t * 32 + 8 * g + 4 * h + e]; const float x1 = acc[mf][0][4 * g + e], x2 = acc[mf][1][4 * g + e];
            acc[mf][0][4 * g + e] = (x1 * cs.x - x2 * cs.y) * sc; acc[mf][1][4 * g + e] = (x2 * cs.x + x1 * cs.y) * sc; }
      }
      bf16_t* rp = z + (size_t)row * NIN + nb;
#pragma unroll
      for (int nf = 0; nf < 2; ++nf)
#pragma unroll
        for (int g = 0; g < 4; ++g) { u32x2 v; v.x = pk(acc[mf][nf][4 * g], acc[mf][nf][4 * g + 1]); v.y = pk(acc[mf][nf][4 * g + 2], acc[mf][nf][4 * g + 3]);
          *(u32x2*)(rp + nf * 32 + 8 * g + 4 * h) = v; }
    }
  } };

#define LASP __attribute__((address_space(3)))
template <class Epi>
DI void gemm_tile(char* lds, const ASrc& A, const bf16_t* __restrict__ Bt, int K, int m0, int n0, const Epi& epi, bool first, bool has_next, int m0n, int n0n) {
  const int tid = opaque(threadIdx.x), lane = tid & 63, w = __builtin_amdgcn_readfirstlane(tid >> 6), wr = w >> 1, wc = w & 1, l31 = lane & 31, h = lane >> 5;
  const int nk = K >> 6, smask = (1 << A.shift) - 1;
  LASP char* ldsl = (LASP char*)lds;
  f32x16 acc[2][2];
#pragma unroll
  for (int a = 0; a < 2; ++a)
#pragma unroll
    for (int b = 0; b < 2; ++b)
#pragma unroll
      for (int i = 0; i < 16; ++i) acc[a][b][i] = 0.f;
  const int lrow = lane >> 3, lslot = lane & 7;
  int goffA[4], goffB[4];
#pragma unroll
  for (int i = 0; i < 4; ++i) { const int r = w * 32 + i * 8 + lrow, c = lslot ^ ((r >> 1) & 7); goffA[i] = r; goffB[i] = r * K + c * 8; goffA[i] = (goffA[i] << 3) | c; }
#define GEMM_ISSUE(kt, st, M0_, N0_) do { const int k0_ = (kt) << 6, seg_ = k0_ >> A.shift, kk_ = k0_ & smask; \
    const bf16_t* bp_ = seg_ == 0 ? A.b0 : seg_ == 1 ? A.b1 : seg_ == 2 ? A.b2 : A.b3; const int st_ = seg_ == 0 ? A.s0 : seg_ == 1 ? A.s1 : seg_ == 2 ? A.s2 : A.s3; \
    _Pragma("unroll") for (int i_ = 0; i_ < 4; ++i_) { \
      const bf16_t* ga_ = bp_ + (size_t)((M0_) + (goffA[i_] >> 3)) * st_ + kk_ + (goffA[i_] & 7) * 8; \
      __builtin_amdgcn_global_load_lds((const unsigned*)ga_, (LASP unsigned*)(ldsl + (st) * 32768 + (w * 4 + i_) * 1024), 16, 0, 0); \
      const bf16_t* gb_ = Bt + (size_t)(N0_) * K + goffB[i_] + k0_; \
      __builtin_amdgcn_global_load_lds((const unsigned*)gb_, (LASP unsigned*)(ldsl + (st) * 32768 + 16384 + (w * 4 + i_) * 1024), 16, 0, 0); } } while (0)
  const int xr = (l31 >> 1) & 7;
  int coff[4];
#pragma unroll
  for (int s = 0; s < 4; ++s) coff[s] = ((2 * s + h) ^ xr) * 16;
#define GEMM_COMPUTE(st) do { const char* as = lds + (st) * 32768; const char* bs = as + 16384; \
    bf16x8 af[4][2], wf[4][2]; \
    _Pragma("unroll") for (int s = 0; s < 4; ++s) { \
      _Pragma("unroll") for (int mf = 0; mf < 2; ++mf) af[s][mf] = *(const bf16x8*)(as + (wr * 64 + mf * 32 + l31) * 128 + coff[s]); \
      _Pragma("unroll") for (int nf = 0; nf < 2; ++nf) wf[s][nf] = *(const bf16x8*)(bs + (wc * 64 + nf * 32 + l31) * 128 + coff[s]); } \
    __builtin_amdgcn_sched_barrier(0); __builtin_amdgcn_s_setprio(1); \
    _Pragma("unroll") for (int s = 0; s < 4; ++s) \
      _Pragma("unroll") for (int mf = 0; mf < 2; ++mf) _Pragma("unroll") for (int nf = 0; nf < 2; ++nf) acc[mf][nf] = MFMA32(wf[s][nf], af[s][mf], acc[mf][nf]); \
    __builtin_amdgcn_s_setprio(0); __builtin_amdgcn_sched_barrier(0); } while (0)
  if (first) GEMM_ISSUE(0, 0, m0, n0);
  for (int kt = 0; kt < nk; kt += 2) {
    asm volatile("s_waitcnt vmcnt(0)" ::: "memory"); __syncthreads();
    GEMM_ISSUE(kt + 1, 1, m0, n0);
    GEMM_COMPUTE(0);
    asm volatile("s_waitcnt vmcnt(0)" ::: "memory"); __syncthreads();
    if (kt + 2 < nk) GEMM_ISSUE(kt + 2, 0, m0, n0);
    GEMM_COMPUTE(1);
  }
  __syncthreads();
  if (has_next) GEMM_ISSUE(0, 0, m0n, n0n);
  epi(acc, m0 + wr * 64, n0 + wc * 64, n0, wc, l31, h);
  __syncthreads();
#undef GEMM_ISSUE
#undef GEMM_COMPUTE
}

template <class Epi>
DI void gemm_phase(char* lds, const ASrc& A, const bf16_t* Bt, int K, int ntn, const Epi& epi) {
  const int xcd = blockIdx.x & 7, j = blockIdx.x >> 3, nloc = gridDim.x >> 3, per = 48 * ntn, grp = 8 * ntn;
  bool first = true;
  for (int li = j; li < per; li += nloc) {
    const int sg = li / grp, wi = li - sg * grp, nt = wi >> 3, mt = xcd * 48 + sg * 8 + (wi & 7);
    const int ln = li + nloc; const bool has_next = ln < per;
    const int sgn = ln / grp, win = ln - sgn * grp, ntn2 = win >> 3, mtn = xcd * 48 + sgn * 8 + (win & 7);
    gemm_tile(lds, A, Bt, K, mt * 128, nt * 128, epi, first, has_next, mtn * 128, ntn2 * 128);
    first = false;
  }
}

DI void prep_item(char* lds, const Params& p, int layer, int item) {
  const int tid = opaque(threadIdx.x), lane = tid & 63, w = tid >> 6;
  const int rowb = item * 64; int tb, T; row_info(rowb, tb, T);
  const float* qg = p.in[I_AQG] + layer * 64; const float* kg = p.in[I_AKG] + layer * 64;
  const float qgl = qg[lane], kgl = kg[lane];
  for (int tt = 0; tt < 16; ++tt) {
    const int row = rowb + w * 16 + tt, t = tb + w * 16 + tt;
    bf16_t* zr = p.z + (size_t)row * NIN;
    {
      const int j = lane & 31, i = j & 15; const bool first = j < 16; const int pos = (lane < 32) ? (t >> 6) : (t & 63);
      const f32x2 cs = p.tabA[pos * 16 + i];
#pragma unroll
      for (int hd = 0; hd < 6; ++hd) {
        bf16_t* ptr = zr + (hd < 4 ? A_Q + hd * 64 : A_K + (hd - 4) * 64) + lane;
        float v = bf2f(*ptr);
        const float ss = wave_sum(v * v);
        v = v * rsqrtf(ss * (1.0f / 64.0f) + EPS) * (hd < 4 ? qgl : kgl);
        const float o = __shfl_xor(v, 16);
        float r = first ? (v * cs.x - o * cs.y) : (v * cs.x + o * cs.y);
        if (hd < 4) r *= 0.125f * LOG2E;
        *ptr = f2bf(r);
      }
    }
    {
      const int d = lane & 31; const f32x2 cs = p.tabB[t * 4 + (d & 3)];
#pragma unroll
      for (int c = 0; c < 8; ++c) {
        bf16_t* ptr = zr + (c < 4 ? B_Q + c * 64 : B_K + (c - 4) * 64) + lane;
        float v = bf2f(*ptr);
        const float o = __shfl_xor(v, 4);
        float r = v;
        if (d < 8) r = (d < 4) ? (v * cs.x - o * cs.y) : (v * cs.x + o * cs.y);
        if (c < 4) r *= 0.17677669529663687f * LOG2E;
        *ptr = f2bf(r);
      }
    }
    {
      const f32x2 cs = p.tabC[t * 32 + (lane & 31)];
#pragma unroll
      for (int c = 0; c < 8; ++c) {
        bf16_t* ptr = zr + (c < 4 ? C_Q + c * 64 : C_K + (c - 4) * 64) + lane;
        const float v = bf2f(*ptr);
        const float o = __shfl_xor(v, 32);
        float r = (lane < 32) ? (v * cs.x - o * cs.y) : (v * cs.x + o * cs.y);
        if (c >= 4) r *= 0.125f;
        *ptr = f2bf(r);
      }
    }
  }
  bf16_t* tl = (bf16_t*)lds;
  const int r = tid >> 2, c0 = (tid & 3) * 16;
  for (int sl = 0; sl < 10; ++sl) {
    const int col = sl < 2 ? A_V + sl * 64 : sl < 6 ? B_V + (sl - 2) * 64 : C_V + (sl - 6) * 64;
    bf16_t* gp = p.z + (size_t)(rowb + r) * NIN + col + c0;
    const u32x4 v0 = *(const u32x4*)gp, v1 = *(const u32x4*)(gp + 8);
    __syncthreads();
#pragma unroll
    for (int e = 0; e < 4; ++e) {
      tl[(c0 + 2 * e) * 72 + r] = (bf16_t)(v0[e] & 0xffffu); tl[(c0 + 2 * e + 1) * 72 + r] = (bf16_t)(v0[e] >> 16);
      tl[(c0 + 8 + 2 * e) * 72 + r] = (bf16_t)(v1[e] & 0xffffu); tl[(c0 + 8 + 2 * e + 1) * 72 + r] = (bf16_t)(v1[e] >> 16);
    }
    __syncthreads();
    const u32x4 o0 = *(const u32x4*)(tl + r * 72 + c0), o1 = *(const u32x4*)(tl + r * 72 + c0 + 8);
    *(u32x4*)gp = o0; *(u32x4*)(gp + 8) = o1;
  }
  __syncthreads();
}

DI float dshift(const Params& p, const float* mup, const float* mun, int row, int t, int T, int dc) {
  const bf16_t* zp = p.z + (size_t)row * NIN + D_0 + dc;
  const float z = bf2f(*zp);
  const float zprev = (t > 0) ? bf2f(*(zp - NIN)) : 0.f;
  const float znext = (t < T - 1) ? bf2f(*(zp + NIN)) : 0.f;
  return z + mup[dc] * (zprev - z) + mun[dc] * (znext - z);
}
DI float sigmoidf_(float x) { return 1.0f / (1.0f + __expf(-x)); }
DI float omdecay(float ww) {
  const float e = 0.6065306597126334f / (1.0f + __expf(-ww));
  return 1.0f - __expf(-e);
}
DI float fast_tanh(float x) { const float xc = fminf(fmaxf(x, -15.f), 15.f); return 1.0f - 2.0f / (1.0f + __expf(2.0f * xc)); }
constexpr int DTOK = 16;
DI void dprep_item(char* lds, const Params& p, int layer, int item) {
  const int tid = opaque(threadIdx.x);
  const int rowb = item * DTOK; int tb, T; row_info(rowb, tb, T);
  const float* mup = p.in[I_DMUP] + layer * 1088; const float* mun = p.in[I_DMUN] + layer * 1088;
  float* su = (float*)lds;
  bf16_t* stg = (bf16_t*)(lds + 12288);
#pragma unroll
  for (int i = 0; i < 12; ++i) {
    const int idx = tid + 256 * i, tok = idx / 192, c = idx - tok * 192;
    float u = dshift(p, mup, mun, rowb + tok, tb + tok, T, 768 + c);
    if (c < 128) u = fast_tanh(u);
    su[c * DTOK + tok] = u;
  }
  __syncthreads();
  const int c = tid;
  float accf[DTOK], accb[DTOK], acca[DTOK];
#pragma unroll
  for (int k = 0; k < DTOK; ++k) { accf[k] = 0.f; accb[k] = 0.f; acca[k] = 0.f; }
  const float* wupf = p.in[I_DWUP] + (size_t)(layer * 2 + 0) * 64 * 256 + c;
  const float* wupb = p.in[I_DWUP] + (size_t)(layer * 2 + 1) * 64 * 256 + c;
  const float* aup = p.in[I_DAUP] + (size_t)layer * 64 * 256 + c;
#pragma unroll 2
  for (int j = 0; j < 64; ++j) {
    const float wf = wupf[j * 256], wb = wupb[j * 256], wa = aup[j * 256];
#pragma unroll
    for (int q = 0; q < 4; ++q) {
      const f32x4 f0 = *(const f32x4*)(su + j * DTOK + 4 * q), b0 = *(const f32x4*)(su + (64 + j) * DTOK + 4 * q), a0v = *(const f32x4*)(su + (128 + j) * DTOK + 4 * q);
#pragma unroll
      for (int k = 0; k < 4; ++k) { accf[4 * q + k] += f0[k] * wf; accb[4 * q + k] += b0[k] * wb; acca[4 * q + k] += a0v[k] * wa; }
    }
  }
  const float w0f = p.in[I_DW0][(layer * 2 + 0) * 256 + c], w0b = p.in[I_DW0][(layer * 2 + 1) * 256 + c];
  const float a0 = p.in[I_DA0][layer * 256 + c], kkw = p.in[I_DKK][layer * 256 + c], kaw = p.in[I_DKA][layer * 256 + c];
  float zr[DTOK + 2], zk[DTOK + 2], zv[DTOK + 2];
  { const bf16_t* zp = p.z + (size_t)rowb * NIN + D_0 + c;
#pragma unroll
    for (int i = 0; i < DTOK + 2; ++i) { const int t = tb - 1 + i; const bool ok = (t >= 0) && (t < T); const bf16_t* q = zp + (ptrdiff_t)(i - 1) * NIN;
      zr[i] = ok ? bf2f(q[0]) : 0.f; zk[i] = ok ? bf2f(q[256]) : 0.f; zv[i] = ok ? bf2f(q[512]) : 0.f; } }
  const float mpr = mup[c], mnr = mun[c], mpk = mup[256 + c], mnk = mun[256 + c], mpv = mup[512 + c], mnv = mun[512 + c];
#pragma unroll
  for (int k = 0; k < DTOK; ++k) {
    const float r = zr[k + 1] + mpr * (zr[k] - zr[k + 1]) + mnr * (zr[k + 2] - zr[k + 1]);
    const float kx = zk[k + 1] + mpk * (zk[k] - zk[k + 1]) + mnk * (zk[k + 2] - zk[k + 1]);
    const float v = zv[k + 1] + mpv * (zv[k] - zv[k + 1]) + mnv * (zv[k + 2] - zv[k + 1]);
    const float omf = omdecay(w0f + accf[k]), omb = omdecay(w0b + accb[k]);
    const float a = sigmoidf_(a0 + acca[k]);
    float kk = kx * kkw; const float n2 = wave_sum(kk * kk);
    kk = kk * rsqrtf(fmaxf(n2, 1e-24f));
    const float kmod = kx * (1.0f + (a - 1.0f) * kaw), b = kk * a;
    bf16_t* so = stg + k * 256 + c;
    so[0] = f2bf(r); so[DTOK * 256] = f2bf(kmod); so[2 * DTOK * 256] = f2bf(v); so[3 * DTOK * 256] = f2bf(-kk);
    so[4 * DTOK * 256] = f2bf(b); so[5 * DTOK * 256] = f2bf(omf); so[6 * DTOK * 256] = f2bf(omb);
  }
  __syncthreads();
#pragma unroll
  for (int i = 0; i < 14; ++i) {
    const int q = tid + 256 * i, pln = q >> 9, rem = q & 511, tok = rem >> 5, c16 = rem & 31;
    const u32x4 v = *(const u32x4*)(stg + pln * (DTOK * 256) + tok * 256 + c16 * 8);
    *(u32x4*)(p.pl + (size_t)pln * PLANE + (size_t)(rowb + tok) * 256 + c16 * 8) = v;
  }
  __syncthreads();
}

DI void dpost_item(char* lds, const Params& p, int layer, int item) {
  const int tid = opaque(threadIdx.x);
  const int rowb = item * DTOK; int tb, T; row_info(rowb, tb, T);
  const float* mup = p.in[I_DMUP] + layer * 1088; const float* mun = p.in[I_DMUN] + layer * 1088;
  float* sg = (float*)lds;
  bf16_t* stg = (bf16_t*)(lds + 8192);
#pragma unroll
  for (int i = 0; i < 8; ++i) { const int idx = tid + 256 * i, tok = idx >> 7, c = idx & 127; sg[c * DTOK + tok] = sigmoidf_(dshift(p, mup, mun, rowb + tok, tb + tok, T, 960 + c)); }
  __syncthreads();
  const int c = tid;
  float acc[DTOK];
#pragma unroll
  for (int k = 0; k < DTOK; ++k) acc[k] = 0.f;
  const float* gup = p.in[I_DGUP] + (size_t)layer * 128 * 256 + c;
#pragma unroll 4
  for (int j = 0; j < 128; ++j) { const float gw = gup[j * 256];
#pragma unroll
    for (int q = 0; q < 4; ++q) { const f32x4 s0 = *(const f32x4*)(sg + j * DTOK + 4 * q);
#pragma unroll
      for (int k = 0; k < 4; ++k) acc[4 * q + k] += s0[k] * gw; } }
  const float gnw = p.in[I_DGNW][layer * 256 + c], gnb = p.in[I_DGNB][layer * 256 + c], rk = p.in[I_DRK][layer * 256 + c];
#pragma unroll
  for (int k = 0; k < DTOK; ++k) {
    const int row = rowb + k;
    const bf16_t* zd = p.z + (size_t)row * NIN + D_0;
    const float y = bf2f(zd[c]) + bf2f(zd[256 + c]);
    const float mean = wave_sum(y) * (1.0f / 64.0f); const float d = y - mean; const float var = wave_sum(d * d) * (1.0f / 64.0f);
    const float yn = d * rsqrtf(var + 64e-5f) * gnw + gnb;
    const size_t o = (size_t)row * 256 + c;
    const float r = bf2f(p.pl[o]), km = bf2f(p.pl[PLANE + o]), v = bf2f(p.pl[2 * PLANE + o]);
    const float bonus = wave_sum(r * km * rk);
    stg[k * 256 + c] = f2bf((yn + bonus * v) * acc[k]);
  }
  __syncthreads();
#pragma unroll
  for (int i = 0; i < 2; ++i) { const int q = tid + 256 * i, tok = q >> 5, c16 = q & 31;
    const u32x4 v = *(const u32x4*)(stg + tok * 256 + c16 * 8);
    *(u32x4*)(p.pl + 4 * PLANE + (size_t)(rowb + tok) * 256 + c16 * 8) = v; }
  __syncthreads();
}

DI void rwkv_item(char* lds, const Params& p, int seq, int head, int dir, int half) {
  int row0, T; seq_info(seq, row0, T);
  const int tid = opaque(threadIdx.x), kc = tid & 7, vrow = half * 32 + (tid >> 3);
  float* st = (float*)lds;
  f32x2 S[4];
#pragma unroll
  for (int j = 0; j < 4; ++j) S[j] = (f32x2){0.f, 0.f};
  const int nchunk = T >> 4;
  u32x4 rg[3];
  const int tsel = tid >> 7, srem = tid & 127, sstep = srem >> 3, sc8 = srem & 7;
#define RW_GLOAD(c) do { _Pragma("unroll") for (int i_ = 0; i_ < 3; ++i_) { const int tens_ = tsel + 2 * i_; \
      const int plane_ = tens_ == 0 ? (dir ? 6 : 5) : tens_ == 1 ? 3 : tens_ == 2 ? 4 : tens_ == 3 ? 1 : tens_ == 4 ? 0 : 2; \
      const int t_ = dir ? (T - 1 - ((c) * 16 + sstep)) : ((c) * 16 + sstep); \
      rg[i_] = *(const u32x4*)(p.pl + (size_t)plane_ * PLANE + (size_t)(row0 + t_) * 256 + head * 64 + sc8 * 8); } } while (0)
#define RW_LSTORE(buf) do { _Pragma("unroll") for (int i_ = 0; i_ < 3; ++i_) { const int tens_ = tsel + 2 * i_; \
      f32x4 a_ = {bflo(rg[i_].x), bfhi(rg[i_].x), bflo(rg[i_].y), bfhi(rg[i_].y)}, b_ = {bflo(rg[i_].z), bfhi(rg[i_].z), bflo(rg[i_].w), bfhi(rg[i_].w)}; \
      if (tens_ == 0) { a_ = 1.0f - a_; b_ = 1.0f - b_; } \
      float* d_ = st + (((buf) * 16 + sstep) * 6 + tens_) * 64 + sc8 * 8; *(f32x4*)d_ = a_; *(f32x4*)(d_ + 4) = b_; } } while (0)
  __builtin_amdgcn_s_setprio(3);
  RW_GLOAD(0); RW_LSTORE(0); __syncthreads();
  bf16_t* ybase = p.z + (size_t)row0 * NIN + D_0 + dir * 256 + head * 64 + vrow;
  for (int c = 0; c < nchunk; ++c) {
    if (c + 1 < nchunk) RW_GLOAD(c + 1);
    const float* sb = st + (c & 1) * (16 * 384);
#define RW_FETCH(S_, s_) do { const float* q_ = sb + (s_) * 384 + kc * 8; \
      S_##w0 = *(const f32x4*)(q_); S_##w1 = *(const f32x4*)(q_ + 4); S_##n0 = *(const f32x4*)(q_ + 64); S_##n1 = *(const f32x4*)(q_ + 68); \
      S_##b0 = *(const f32x4*)(q_ + 128); S_##b1 = *(const f32x4*)(q_ + 132); S_##k0 = *(const f32x4*)(q_ + 192); S_##k1 = *(const f32x4*)(q_ + 196); \
      S_##r0 = *(const f32x4*)(q_ + 256); S_##r1 = *(const f32x4*)(q_ + 260); S_##vv = sb[(s_) * 384 + 320 + vrow]; } while (0)
#define LO2(x) ((f32x2){(x)[0], (x)[1]})
#define HI2(x) ((f32x2){(x)[2], (x)[3]})
#define RW_STEP(S_, s_) do { \
      f32x2 a2 = S[0] * LO2(S_##n0); a2 += S[1] * HI2(S_##n0); a2 += S[2] * LO2(S_##n1); a2 += S[3] * HI2(S_##n1); \
      const float sa = red8(a2.x + a2.y); const float vx = S_##vv; \
      S[0] = S[0] * LO2(S_##w0) + (LO2(S_##b0) * sa + LO2(S_##k0) * vx); S[1] = S[1] * HI2(S_##w0) + (HI2(S_##b0) * sa + HI2(S_##k0) * vx); \
      S[2] = S[2] * LO2(S_##w1) + (LO2(S_##b1) * sa + LO2(S_##k1) * vx); S[3] = S[3] * HI2(S_##w1) + (HI2(S_##b1) * sa + HI2(S_##k1) * vx); \
      f32x2 y2 = S[0] * LO2(S_##r0); y2 += S[1] * HI2(S_##r0); y2 += S[2] * LO2(S_##r1); y2 += S[3] * HI2(S_##r1); \
      const float y = red8(y2.x + y2.y); const float yn = DPPF(y, 0x128);     \
      if ((tid & 15) == 0) { const int t_ = dir ? (T - 1 - (c * 16 + (s_))) : (c * 16 + (s_)); *(unsigned*)(ybase + (size_t)t_ * NIN) = pk(y, yn); } } while (0)
    f32x4 Aw0, Aw1, An0, An1, Ab0, Ab1, Ak0, Ak1, Ar0, Ar1; float Avv;
    f32x4 Bw0, Bw1, Bn0, Bn1, Bb0, Bb1, Bk0, Bk1, Br0, Br1; float Bvv;
    RW_FETCH(A, 0);
#pragma unroll 2
    for (int s = 0; s < 16; s += 2) {
      RW_FETCH(B, s + 1);
      RW_STEP(A, s);
      if (s + 2 < 16) RW_FETCH(A, s + 2);
      RW_STEP(B, s + 1);
    }
#undef RW_FETCH
#undef RW_STEP
    if (c + 1 < nchunk) RW_LSTORE((c + 1) & 1);
    __syncthreads();
  }
#undef RW_GLOAD
#undef RW_LSTORE
  __builtin_amdgcn_s_setprio(0);
}

template <int MODE>
DI void attn_item(char* lds, const Params& p, int layer, int seq, int head, int qt) {
  const int tid = opaque(threadIdx.x), lane = tid & 63, w = tid >> 6, l31 = lane & 31, h = lane >> 5;
  layer = opaque_s(layer); seq = opaque_s(seq); head = opaque_s(head); qt = opaque_s(qt);
  int row0, T; seq_info(seq, row0, T);
  const int QC = (MODE == 0 ? A_Q : MODE == 1 ? B_Q : C_Q) + head * 64;
  const int KC = MODE == 0 ? A_K + (head >> 1) * 64 : MODE == 1 ? B_K + head * 64 : C_K + head * 64;
  const int VC = MODE == 0 ? A_V + (head >> 1) * 64 : MODE == 1 ? B_V + head * 64 : C_V + head * 64;
  const int qw0 = qt * 128 + w * 32, qi = qw0 + l31;
  bf16_t* zq = p.z + (size_t)(row0 + qi) * NIN + QC;
  bf16x8 qf[4];
#pragma unroll
  for (int s = 0; s < 4; ++s) qf[s] = *(const bf16x8*)(zq + s * 16 + h * 8);
  const int srow = tid >> 3, sc8 = tid & 7;
  const bf16_t* kbase = p.z + (size_t)(row0 + srow) * NIN + KC + sc8 * 8;
  const bf16_t* vbase = p.z + (size_t)(row0 + srow) * NIN + VC + sc8 * 8;
  u32x4 rk[2][2], rv[2][2];
  const int nt = T >> 6;
  const int prow = (l31 & 19) | ((l31 & 4) << 1) | ((l31 & 8) >> 1);
#define AT_GLOAD(t, S) do { _Pragma("unroll") for (int i_ = 0; i_ < 2; ++i_) { const size_t off_ = (size_t)((t) * 64 + 32 * i_) * NIN; rk[S][i_] = *(const u32x4*)(kbase + off_); rv[S][i_] = *(const u32x4*)(vbase + off_); } } while (0)
#define AT_LSTORE(buf, S) do { char* ks_ = lds + (buf) * 18432; char* vs_ = ks_ + 9216; \
    _Pragma("unroll") for (int i_ = 0; i_ < 2; ++i_) { *(u32x4*)(ks_ + (srow + 32 * i_) * PITCH + sc8 * 16) = rk[S][i_]; *(u32x4*)(vs_ + (srow + 32 * i_) * PITCH + sc8 * 16) = rv[S][i_]; } } while (0)
  constexpr int NMAP = (MODE == 1) ? 2 : 1;
  f32x16 o[NMAP][2];
  float m_run[NMAP], l_run[NMAP];
#pragma unroll
  for (int a = 0; a < NMAP; ++a) { m_run[a] = -INFINITY; l_run[a] = 0.f;
#pragma unroll
    for (int b = 0; b < 2; ++b)
#pragma unroll
      for (int i = 0; i < 16; ++i) o[a][b][i] = 0.f; }
  float lf = 0.f, lb = 0.f;
  if (MODE == 2) { lf = log2f(1.0f - exp2f(-5.0f - (float)head)); lb = log2f(1.0f - exp2f(-5.0f - (float)(3 - head))); }
  auto body = [&](const char* ks, const char* vs, const int t) __attribute__((always_inline)) {
#pragma unroll
    for (int mp = 0; mp < NMAP; ++mp) {
      f32x16 st[2];
#pragma unroll
      for (int kf = 0; kf < 2; ++kf) {
#pragma unroll
        for (int i = 0; i < 16; ++i) st[kf][i] = 0.f;
        if (MODE == 1) {
#pragma unroll
          for (int s = 0; s < 2; ++s) { const bf16x8 kfr = *(const bf16x8*)(ks + (kf * 32 + prow) * PITCH + (mp * 2 + s) * 32 + h * 16); st[kf] = MFMA32(kfr, qf[mp * 2 + s], st[kf]); }
        } else {
#pragma unroll
          for (int s = 0; s < 4; ++s) { const bf16x8 kfr = *(const bf16x8*)(ks + (kf * 32 + prow) * PITCH + s * 32 + h * 16); st[kf] = MFMA32(kfr, qf[s], st[kf]); }
        }
      }
      if (MODE == 2) {
        const int k0 = t * 64;
        const float dbase = (float)(qi - k0 - 8 * h);
        if (k0 + 63 < qw0) {
#pragma unroll
          for (int kf = 0; kf < 2; ++kf)
#pragma unroll
            for (int i = 0; i < 16; ++i) { const float cc = (float)(32 * kf + (i & 3) + 4 * ((i >> 2) & 1) + 16 * ((i >> 3) & 1)); st[kf][i] *= fexp2(lf * (dbase - cc)); }
        } else if (k0 > qw0 + 31) {
#pragma unroll
          for (int kf = 0; kf < 2; ++kf)
#pragma unroll
            for (int i = 0; i < 16; ++i) { const float cc = (float)(32 * kf + (i & 3) + 4 * ((i >> 2) & 1) + 16 * ((i >> 3) & 1)); st[kf][i] *= fexp2(lb * (cc - dbase)); }
        } else {
#pragma unroll
          for (int kf = 0; kf < 2; ++kf)
#pragma unroll
            for (int i = 0; i < 16; ++i) { const float cc = (float)(32 * kf + (i & 3) + 4 * ((i >> 2) & 1) + 16 * ((i >> 3) & 1)); const float d = dbase - cc;
              float dd = fexp2(fminf(lf * d, -lb * d)); if (d == 0.f) dd = 2.0f; st[kf][i] *= dd; }
        }
      } else {
        float mx = st[0][0];
#pragma unroll
        for (int kf = 0; kf < 2; ++kf)
#pragma unroll
          for (int i = 0; i < 16; ++i) mx = fmaxf(mx, st[kf][i]);
        mx = fmaxf(mx, __shfl_xor(mx, 32));
        const float mn = fmaxf(m_run[mp], mx); const float alpha = fexp2(m_run[mp] - mn); m_run[mp] = mn;
        float ps = 0.f;
#pragma unroll
        for (int kf = 0; kf < 2; ++kf)
#pragma unroll
          for (int i = 0; i < 16; ++i) { st[kf][i] = fexp2(st[kf][i] - mn); ps += st[kf][i]; }
        l_run[mp] = l_run[mp] * alpha + ps;
#pragma unroll
        for (int df = 0; df < 2; ++df) o[mp][df] *= alpha;
      }
      bf16x8 pf[4];
#pragma unroll
      for (int kf = 0; kf < 2; ++kf)
#pragma unroll
        for (int s2 = 0; s2 < 2; ++s2) { u32x4 u; u.x = pk(st[kf][8 * s2], st[kf][8 * s2 + 1]); u.y = pk(st[kf][8 * s2 + 2], st[kf][8 * s2 + 3]);
          u.z = pk(st[kf][8 * s2 + 4], st[kf][8 * s2 + 5]); u.w = pk(st[kf][8 * s2 + 6], st[kf][8 * s2 + 7]); pf[kf * 2 + s2] = __builtin_bit_cast(bf16x8, u); }
#pragma unroll
      for (int df = 0; df < 2; ++df)
#pragma unroll
        for (int ksx = 0; ksx < 4; ++ksx) { const bf16x8 vfr = *(const bf16x8*)(vs + (df * 32 + l31) * PITCH + ksx * 32 + h * 16); o[mp][df] = MFMA32(vfr, pf[ksx], o[mp][df]); }
    }
  };
  if constexpr (MODE == 1) {
    AT_GLOAD(0, 0); AT_LSTORE(0, 0); __syncthreads();
#pragma unroll 1
    for (int t = 0; t < nt; ++t) {
      if (t + 1 < nt) AT_GLOAD(t + 1, 0);
      const char* ks = lds + (t & 1) * 18432;
      body(ks, ks + 9216, t);
      if (t + 1 < nt) AT_LSTORE((t + 1) & 1, 0);
      __syncthreads();
    }
  } else {
    AT_GLOAD(0, 0); AT_GLOAD(1, 1); AT_LSTORE(0, 0); __syncthreads();
#pragma unroll 1
    for (int t2 = 0; t2 < nt; t2 += 2) {
      if (t2 + 2 < nt) AT_GLOAD(t2 + 2, 0);
      body(lds, lds + 9216, t2);
      AT_LSTORE(1, 1);
      __syncthreads();
      if (t2 + 3 < nt) AT_GLOAD(t2 + 3, 1);
      body(lds + 18432, lds + 18432 + 9216, t2 + 1);
      if (t2 + 2 < nt) AT_LSTORE(0, 0);
      __syncthreads();
    }
  }
#undef AT_GLOAD
#undef AT_LSTORE
  f32x16 r[2];
  if (MODE == 0) {
    const float l = l_run[0] + __shfl_xor(l_run[0], 32); const float inv = 1.0f / l;
#pragma unroll
    for (int df = 0; df < 2; ++df) r[df] = o[0][df] * inv;
  } else if (MODE == 1) {
    const float* lp = p.in[I_BLAM] + layer * 128;
    float s01 = 0.f, s23 = 0.f;
    for (int i = 0; i < 32; ++i) { s01 += lp[i] * lp[32 + i]; s23 += lp[64 + i] * lp[96 + i]; }
    const float lam_init = 0.8f - 0.6f * expf(-0.3f * (float)layer);
    const float lam = expf(s01) - expf(s23) + lam_init;
    const float l0 = l_run[0] + __shfl_xor(l_run[0], 32), l1 = l_run[NMAP - 1] + __shfl_xor(l_run[NMAP - 1], 32);
    const float i0 = 1.0f / l0, i1 = lam / l1;
    float ss = 0.f;
#pragma unroll
    for (int df = 0; df < 2; ++df) { r[df] = o[0][df] * i0 - o[NMAP - 1][df] * i1;
#pragma unroll
      for (int i = 0; i < 16; ++i) ss += r[df][i] * r[df][i]; }
    ss += __shfl_xor(ss, 32);
    const float rs = rsqrtf(ss * (1.0f / 64.0f) + EPS) * (1.0f - lam_init);
    const float* sg = p.in[I_BSUB] + layer * 64;
#pragma unroll
    for (int df = 0; df < 2; ++df)
#pragma unroll
      for (int i = 0; i < 16; ++i) r[df][i] *= rs * sg[df * 32 + (i & 3) + 8 * (i >> 2) + 4 * h];
  } else {
    float ss = 0.f;
#pragma unroll
    for (int df = 0; df < 2; ++df)
#pragma unroll
      for (int i = 0; i < 16; ++i) ss += o[0][df][i] * o[0][df][i];
    ss += __shfl_xor(ss, 32);
    const float rs = rsqrtf(ss * (1.0f / 64.0f) + EPS);
    const float* gg = p.in[I_CGN] + layer * 256 + head * 64;
    const bf16_t* zg = p.z + (size_t)(row0 + qi) * NIN + C_G + head * 64;
#pragma unroll
    for (int df = 0; df < 2; ++df)
#pragma unroll
      for (int g = 0; g < 4; ++g) { const u32x2 gw = *(const u32x2*)(zg + df * 32 + 8 * g + 4 * h);
        const float gv[4] = {bflo(gw.x), bfhi(gw.x), bflo(gw.y), bfhi(gw.y)};
#pragma unroll
        for (int e = 0; e < 4; ++e) { const float x = gv[e]; r[df][4 * g + e] = o[0][df][4 * g + e] * rs * gg[df * 32 + 8 * g + 4 * h + e] * (x / (1.0f + __expf(-x))); } }
  }
#pragma unroll
  for (int df = 0; df < 2; ++df)
#pragma unroll
    for (int g = 0; g < 4; ++g) { u32x2 v; v.x = pk(r[df][4 * g], r[df][4 * g + 1]); v.y = pk(r[df][4 * g + 2], r[df][4 * g + 3]); *(u32x2*)(zq + df * 32 + 8 * g + 4 * h) = v; }
}

template <class Epi>
DI void gemm_tile2(char* lds, const ASrc& A, const bf16_t* __restrict__ Bt, int K, int m0, int n0, const Epi& epi) {
  const int tid = opaque(threadIdx.x), lane = tid & 63, w = __builtin_amdgcn_readfirstlane(tid >> 6), wr = w >> 1, wc = w & 1, l31 = lane & 31, h = lane >> 5;
  const int nk = K >> 5, smask = (1 << A.shift) - 1;
  LASP char* ldsl = (LASP char*)lds;
  f32x16 acc[2][4];
#pragma unroll
  for (int a = 0; a < 2; ++a)
#pragma unroll
    for (int b = 0; b < 4; ++b)
#pragma unroll
      for (int i = 0; i < 16; ++i) acc[a][b][i] = 0.f;
  const int lrow = lane >> 2, lslot = lane & 3;
  int goffA[2], goffB[4];
#pragma unroll
  for (int i = 0; i < 2; ++i) { const int r = (2 * w + i) * 16 + lrow, c = lslot ^ ((r >> 2) & 3); goffA[i] = (r << 2) | c; }
#pragma unroll
  for (int i = 0; i < 4; ++i) { const int r = (4 * w + i) * 16 + lrow, c = lslot ^ ((r >> 2) & 3); goffB[i] = r * K + c * 8; }
#define G2_ISSUE(kt, st) do { const int k0_ = (kt) << 5, seg_ = k0_ >> A.shift, kk_ = k0_ & smask; \
    const bf16_t* bp_ = seg_ == 0 ? A.b0 : seg_ == 1 ? A.b1 : seg_ == 2 ? A.b2 : A.b3; const int st_ = seg_ == 0 ? A.s0 : seg_ == 1 ? A.s1 : seg_ == 2 ? A.s2 : A.s3; \
    _Pragma("unroll") for (int i_ = 0; i_ < 2; ++i_) { \
      const bf16_t* ga_ = bp_ + (size_t)(m0 + (goffA[i_] >> 2)) * st_ + kk_ + (goffA[i_] & 3) * 8; \
      __builtin_amdgcn_global_load_lds((const unsigned*)ga_, (LASP unsigned*)(ldsl + (st) * 24576 + (2 * w + i_) * 1024), 16, 0, 0); } \
    _Pragma("unroll") for (int i_ = 0; i_ < 4; ++i_) { \
      const bf16_t* gb_ = Bt + (size_t)n0 * K + goffB[i_] + k0_; \
      __builtin_amdgcn_global_load_lds((const unsigned*)gb_, (LASP unsigned*)(ldsl + (st) * 24576 + 8192 + (4 * w + i_) * 1024), 16, 0, 0); } } while (0)
  const int xr = (l31 >> 2) & 3;
  int coff[2];
#pragma unroll
  for (int s = 0; s < 2; ++s) coff[s] = ((2 * s + h) ^ xr) * 16;
#define G2_COMPUTE(st) do { const char* as = lds + (st) * 24576; const char* bs = as + 8192; \
    bf16x8 af[2][2], wf[2][4]; \
    _Pragma("unroll") for (int s = 0; s < 2; ++s) { \
      _Pragma("unroll") for (int mf = 0; mf < 2; ++mf) af[s][mf] = *(const bf16x8*)(as + (wr * 64 + mf * 32 + l31) * 64 + coff[s]); \
      _Pragma("unroll") for (int nf = 0; nf < 4; ++nf) wf[s][nf] = *(const bf16x8*)(bs + (wc * 128 + nf * 32 + l31) * 64 + coff[s]); } \
    __builtin_amdgcn_sched_barrier(0); __builtin_amdgcn_s_setprio(1); \
    _Pragma("unroll") for (int s = 0; s < 2; ++s) \
      _Pragma("unroll") for (int mf = 0; mf < 2; ++mf) _Pragma("unroll") for (int nf = 0; nf < 4; ++nf) acc[mf][nf] = MFMA32(wf[s][nf], af[s][mf], acc[mf][nf]); \
    __builtin_amdgcn_s_setprio(0); __builtin_amdgcn_sched_barrier(0); } while (0)
  G2_ISSUE(0, 0);
  for (int kt = 0; kt < nk; kt += 2) {
    asm volatile("s_waitcnt vmcnt(0)" ::: "memory"); __syncthreads();
    G2_ISSUE(kt + 1, 1);
    G2_COMPUTE(0);
    asm volatile("s_waitcnt vmcnt(0)" ::: "memory"); __syncthreads();
    if (kt + 2 < nk) G2_ISSUE(kt + 2, 0);
    G2_COMPUTE(1);
  }
  __syncthreads();
#pragma unroll
  for (int hf = 0; hf < 2; ++hf) {
    f32x16 t[2][2];
#pragma unroll
    for (int mf = 0; mf < 2; ++mf) { t[mf][0] = acc[mf][2 * hf]; t[mf][1] = acc[mf][2 * hf + 1]; }
    epi(t, m0 + wr * 64, n0 + wc * 128 + hf * 64, n0, wc, l31, h);
  }
  __syncthreads();
#undef G2_ISSUE
#undef G2_COMPUTE
}

template <class Epi>
DI void gemm_phase2(char* lds, const ASrc& A, const bf16_t* Bt, int K, int ntn, const Epi& epi) {
  const int xcd = blockIdx.x & 7, j = blockIdx.x >> 3, nloc = gridDim.x >> 3, per = 48 * ntn, grp = 8 * ntn;
  for (int li = j; li < per; li += nloc) {
    const int sg = li / grp, wi = li - sg * grp, nt = wi >> 3, mt = xcd * 48 + sg * 8 + (wi & 7);
    gemm_tile2(lds, A, Bt, K, mt * 128, nt * 256, epi);
  }
}

template <int MODE>
DI void attn3_item(char* lds, const Params& p, int layer, int seq, int head, int qt) {
  const int tid = opaque(threadIdx.x), lane = tid & 63, w = tid >> 6, l31 = lane & 31, h = lane >> 5;
  layer = opaque_s(layer); seq = opaque_s(seq); head = opaque_s(head); qt = opaque_s(qt);
  int row0, T; seq_info(seq, row0, T);
  const int QC = (MODE == 0 ? A_Q : C_Q) + head * 64;
  const int KC = MODE == 0 ? A_K + (head >> 1) * 64 : C_K + head * 64;
  const int VC = MODE == 0 ? A_V + (head >> 1) * 64 : C_V + head * 64;
  const int qw0 = qt * 256 + w * 64;
  bf16x8 qf[2][4];
#pragma unroll
  for (int qi = 0; qi < 2; ++qi)
#pragma unroll
    for (int s = 0; s < 4; ++s) qf[qi][s] = *(const bf16x8*)(p.z + (size_t)(row0 + qw0 + qi * 32 + l31) * NIN + QC + s * 16 + h * 8);
  const int srow = tid >> 3, sc8 = tid & 7;
  const bf16_t* kbase = p.z + (size_t)(row0 + srow) * NIN + KC + sc8 * 8;
  const bf16_t* vbase = p.z + (size_t)(row0 + srow) * NIN + VC + sc8 * 8;
  u32x4 rk[2], rv[2];
  const int nt = T >> 6;
  const int prow = (l31 & 19) | ((l31 & 4) << 1) | ((l31 & 8) >> 1);
#define A3_GLOAD(t) do { _Pragma("unroll") for (int i_ = 0; i_ < 2; ++i_) { const size_t off_ = (size_t)((t) * 64 + 32 * i_) * NIN; rk[i_] = *(const u32x4*)(kbase + off_); rv[i_] = *(const u32x4*)(vbase + off_); } } while (0)
#define A3_LSTORE(buf) do { char* ks_ = lds + (buf) * 18432; char* vs_ = ks_ + 9216; \
    _Pragma("unroll") for (int i_ = 0; i_ < 2; ++i_) { *(u32x4*)(ks_ + (srow + 32 * i_) * PITCH + sc8 * 16) = rk[i_]; *(u32x4*)(vs_ + (srow + 32 * i_) * PITCH + sc8 * 16) = rv[i_]; } } while (0)
  f32x16 o[2][2];
  float m_run[2], l_run[2];
#pragma unroll
  for (int a = 0; a < 2; ++a) { m_run[a] = -INFINITY; l_run[a] = 0.f;
#pragma unroll
    for (int b = 0; b < 2; ++b)
#pragma unroll
      for (int i = 0; i < 16; ++i) o[a][b][i] = 0.f; }
  float lf = 0.f, lb = 0.f;
  if (MODE == 2) { lf = log2f(1.0f - exp2f(-5.0f - (float)head)); lb = log2f(1.0f - exp2f(-5.0f - (float)(3 - head))); }
  A3_GLOAD(0); A3_LSTORE(0); __syncthreads();
#pragma unroll 1
  for (int t = 0; t < nt; ++t) {
    if (t + 1 < nt) A3_GLOAD(t + 1);
    const char* ks = lds + (t & 1) * 18432; const char* vs = ks + 9216;
    f32x16 st[2][2];
#pragma unroll
    for (int kf = 0; kf < 2; ++kf) {
#pragma unroll
      for (int qi = 0; qi < 2; ++qi)
#pragma unroll
        for (int i = 0; i < 16; ++i) st[qi][kf][i] = 0.f;
#pragma unroll
      for (int s = 0; s < 4; ++s) { const bf16x8 kfr = *(const bf16x8*)(ks + (kf * 32 + prow) * PITCH + s * 32 + h * 16);
#pragma unroll
        for (int qi = 0; qi < 2; ++qi) st[qi][kf] = MFMA32(kfr, qf[qi][s], st[qi][kf]); }
    }
    __builtin_amdgcn_sched_barrier(0);
#pragma unroll
    for (int qi = 0; qi < 2; ++qi) {
      bf16x8 pf[4];
      if (MODE == 2) {
        const int k0 = t * 64, qb = qw0 + qi * 32;
        const float dbase = (float)(qb + l31 - k0 - 8 * h);
        if (k0 + 63 < qb) {
#pragma unroll
          for (int kf = 0; kf < 2; ++kf)
#pragma unroll
            for (int i = 0; i < 16; ++i) { const float cc = (float)(32 * kf + (i & 3) + 4 * ((i >> 2) & 1) + 16 * ((i >> 3) & 1)); st[qi][kf][i] *= fexp2(lf * (dbase - cc)); }
        } else if (k0 > qb + 31) {
#pragma unroll
          for (int kf = 0; kf < 2; ++kf)
#pragma unroll
            for (int i = 0; i < 16; ++i) { const float cc = (float)(32 * kf + (i & 3) + 4 * ((i >> 2) & 1) + 16 * ((i >> 3) & 1)); st[qi][kf][i] *= fexp2(lb * (cc - dbase)); }
        } else {
#pragma unroll
          for (int kf = 0; kf < 2; ++kf)
#pragma unroll
            for (int i = 0; i < 16; ++i) { const float cc = (float)(32 * kf + (i & 3) + 4 * ((i >> 2) & 1) + 16 * ((i >> 3) & 1)); const float d = dbase - cc;
              float dd = fexp2(fminf(lf * d, -lb * d)); if (d == 0.f) dd = 2.0f; st[qi][kf][i] *= dd; }
        }
      } else {
        float mx = st[qi][0][0];
#pragma unroll
        for (int kf = 0; kf < 2; ++kf)
#pragma unroll
          for (int i = 0; i < 16; ++i) mx = fmaxf(mx, st[qi][kf][i]);
        mx = fmaxf(mx, __shfl_xor(mx, 32));
        const float mn = fmaxf(m_run[qi], mx); const float alpha = fexp2(m_run[qi] - mn); m_run[qi] = mn;
        float ps = 0.f;
#pragma unroll
        for (int kf = 0; kf < 2; ++kf)
#pragma unroll
          for (int i = 0; i < 16; ++i) { st[qi][kf][i] = fexp2(st[qi][kf][i] - mn); ps += st[qi][kf][i]; }
        l_run[qi] = l_run[qi] * alpha + ps;
#pragma unroll
        for (int df = 0; df < 2; ++df) o[qi][df] *= alpha;
      }
#pragma unroll
      for (int kf = 0; kf < 2; ++kf)
#pragma unroll
        for (int s2 = 0; s2 < 2; ++s2) { u32x4 u; u.x = pk(st[qi][kf][8 * s2], st[qi][kf][8 * s2 + 1]); u.y = pk(st[qi][kf][8 * s2 + 2], st[qi][kf][8 * s2 + 3]);
          u.z = pk(st[qi][kf][8 * s2 + 4], st[qi][kf][8 * s2 + 5]); u.w = pk(st[qi][kf][8 * s2 + 6], st[qi][kf][8 * s2 + 7]); pf[kf * 2 + s2] = __builtin_bit_cast(bf16x8, u); }
#pragma unroll
      for (int df = 0; df < 2; ++df)
#pragma unroll
        for (int ksx = 0; ksx < 4; ++ksx) { const bf16x8 vfr = *(const bf16x8*)(vs + (df * 32 + l31) * PITCH + ksx * 32 + h * 16); o[qi][df] = MFMA32(vfr, pf[ksx], o[qi][df]); }
      __builtin_amdgcn_sched_barrier(0);
    }
    __builtin_amdgcn_sched_barrier(0);
    if (t + 1 < nt) A3_LSTORE((t + 1) & 1);
    __syncthreads();
  }
#undef A3_GLOAD
#undef A3_LSTORE
#pragma unroll
  for (int qi = 0; qi < 2; ++qi) {
    const int qrow = row0 + qw0 + qi * 32 + l31;
    bf16_t* zq = p.z + (size_t)qrow * NIN + QC;
    f32x16 r[2];
    if (MODE == 0) {
      const float l = l_run[qi] + __shfl_xor(l_run[qi], 32); const float inv = 1.0f / l;
#pragma unroll
      for (int df = 0; df < 2; ++df) r[df] = o[qi][df] * inv;
    } else {
      float ss = 0.f;
#pragma unroll
      for (int df = 0; df < 2; ++df)
#pragma unroll
        for (int i = 0; i < 16; ++i) ss += o[qi][df][i] * o[qi][df][i];
      ss += __shfl_xor(ss, 32);
      const float rs = rsqrtf(ss * (1.0f / 64.0f) + EPS);
      const float* gg = p.in[I_CGN] + layer * 256 + head * 64;
      const bf16_t* zg = p.z + (size_t)qrow * NIN + C_G + head * 64;
#pragma unroll
      for (int df = 0; df < 2; ++df)
#pragma unroll
        for (int g = 0; g < 4; ++g) { const u32x2 gw = *(const u32x2*)(zg + df * 32 + 8 * g + 4 * h);
          const float gv[4] = {bflo(gw.x), bfhi(gw.x), bflo(gw.y), bfhi(gw.y)};
#pragma unroll
          for (int e = 0; e < 4; ++e) { const float x = gv[e]; r[df][4 * g + e] = o[qi][df][4 * g + e] * rs * gg[df * 32 + 8 * g + 4 * h + e] * (x / (1.0f + __expf(-x))); } }
    }
#pragma unroll
    for (int df = 0; df < 2; ++df)
#pragma unroll
      for (int g = 0; g < 4; ++g) { u32x2 v; v.x = pk(r[df][4 * g], r[df][4 * g + 1]); v.y = pk(r[df][4 * g + 2], r[df][4 * g + 3]); *(u32x2*)(zq + df * 32 + 8 * g + 4 * h) = v; }
  }
}

DI void ctr_barrier(unsigned* cnt) {
  asm volatile("s_waitcnt vmcnt(0) lgkmcnt(0)" ::: "memory");
  __syncthreads();
  if (threadIdx.x == 0) {
    __builtin_amdgcn_fence(__ATOMIC_RELEASE, "agent");
    asm volatile("s_waitcnt vmcnt(0)" ::: "memory");
    const unsigned G = gridDim.x;
    const unsigned old = __hip_atomic_fetch_add(cnt, 1u, __ATOMIC_RELAXED, __HIP_MEMORY_SCOPE_AGENT);
    const unsigned gen = old / G + 1u;
    if (old + 1u == gen * G) __hip_atomic_store(cnt + 64, gen, __ATOMIC_RELAXED, __HIP_MEMORY_SCOPE_AGENT);
    else while (__hip_atomic_load(cnt + 64, __ATOMIC_RELAXED, __HIP_MEMORY_SCOPE_AGENT) < gen) __builtin_amdgcn_s_sleep(1);
    __builtin_amdgcn_fence(__ATOMIC_ACQUIRE, "agent");
    asm volatile("s_waitcnt vmcnt(0)" ::: "memory");
  }
  __syncthreads();
}

DI int next_item(int* ctr, int* sh) {
  __syncthreads();
  if (threadIdx.x == 0) *sh = atomicAdd(ctr, 1);
  __syncthreads();
  return *sh;
}

__global__ void __launch_bounds__(256, 2) fwd(Params p) {
  extern __shared__ __attribute__((aligned(16))) char lds[];
  __shared__ int s_item;
  cg::grid_group grid = cg::this_grid();
  const int bid = blockIdx.x, nb = gridDim.x, tid = threadIdx.x, lane = tid & 63, w = tid >> 6;
  if (bid == 0) p.ctr[tid] = 0;
  for (int i = bid * 256 + tid; i < 4096 * 32; i += nb * 256) { const int t = i >> 5, j = i & 31; const float inv = powf(10000.0f, -(float)(2 * j) / 64.0f); float sn, cs; sincosf((float)t * inv, &sn, &cs); p.tabC[i] = (f32x2){cs, sn}; }
  for (int i = bid * 256 + tid; i < 4096 * 4; i += nb * 256) { const int t = i >> 2, j = i & 3; const float inv = powf(500000.0f, -(float)(2 * j) / 8.0f); float sn, cs; sincosf((float)t * inv, &sn, &cs); p.tabB[i] = (f32x2){cs, sn}; }
  for (int i = bid * 256 + tid; i < 64 * 16; i += nb * 256) { const int t = i >> 4, j = i & 15; const float inv = powf(10000.0f, -(float)(2 * j) / 32.0f); float sn, cs; sincosf((float)t * inv, &sn, &cs); p.tabA[i] = (f32x2){cs, sn}; }
  for (int l = 0; l < 2; ++l) {
    for (int i = bid * 256 + tid; i < (NINP - NIN) * 1024; i += nb * 256) p.wtin[(size_t)l * NINP * 1024 + (size_t)NIN * 1024 + i] = 0;
    for (int tl = bid; tl < 16 * 53; tl += nb) conv_T(lds, p.in[I_WIN] + (size_t)l * 1024 * NIN, 1024, NIN, p.wtin + (size_t)l * NINP * 1024, 0, tl);
    for (int tl = bid; tl < 16 * 16; tl += nb) conv_T(lds, p.in[I_WOUT] + (size_t)l * 1024 * 1024, 1024, 1024, p.wtout + (size_t)l * 1024 * 1024, 0, tl);
  }
  bf16_t* hb = p.pl;
  for (int row = bid * 4 + opaque(w); row < MT; row += nb * 4) {
    const float* xin = row < M0 ? p.in[I_XP] + (size_t)row * 1024 : p.in[I_XS] + (size_t)(row - M0) * 1024;
    row_phase(xin, p.out + (size_t)row * 1024, nullptr, nullptr, p.in[I_NMPRE], hb + (size_t)row * 1024, lane);
  }
  grid.sync();
  for (int l = 0; l < 2; ++l) {
    { ASrc A; A.b0 = hb; A.b1 = hb; A.b2 = hb; A.b3 = hb; A.s0 = A.s1 = A.s2 = A.s3 = 1024; A.shift = 12;
      EpiIn e; e.z = p.z; e.lds = lds; e.qg = p.in[I_AQG] + l * 64; e.kg = p.in[I_AKG] + l * 64; e.tabA = p.tabA; e.tabB = p.tabB; e.tabC = p.tabC;
      gemm_phase2(lds, A, p.wtin + (size_t)l * NINP * 1024, 1024, 14, e); }
    ctr_barrier((unsigned*)p.ctr + 96);
    for (int it = bid; it < MT / DTOK; it += nb) dprep_item(lds, p, l, it);
    ctr_barrier((unsigned*)p.ctr + 96);
    for (;;) {
      const int it = next_item(p.ctr + l * 16, &s_item);
      if (it >= 256 + 2048 + 1024) break;
      if (it < 256) { const int i2 = it >> 1; const int sq = i2 < 64 ? (i2 >> 3) : 8 + ((i2 - 64) >> 3); rwkv_item(lds, p, sq, (i2 >> 1) & 3, i2 & 1, it & 1); }
      else {
        int j = it - 256;
        if (j < 2048) {
          if (j < 1024) attn_item<1>(lds, p, l, j >> 7, (j >> 5) & 3, j & 31);
          else { const int r = (j - 1024) & 511; if (j < 1536) attn3_item<2>(lds, p, l, r >> 6, (r >> 4) & 3, r & 15); else attn3_item<0>(lds, p, l, r >> 6, (r >> 4) & 3, r & 15); }
        } else { j -= 2048;
          if (j < 512) attn_item<1>(lds, p, l, 8 + (j >> 6), (j >> 4) & 3, j & 15);
          else { const int r = (j - 512) & 255; if (j < 768) attn3_item<2>(lds, p, l, 8 + (r >> 5), (r >> 3) & 3, r & 7); else attn3_item<0>(lds, p, l, 8 + (r >> 5), (r >> 3) & 3, r & 7); }
        }
      }
    }
    ctr_barrier((unsigned*)p.ctr + 96);
    bf16_t* wtgu = p.pl + 5 * PLANE; bf16_t* wtd = wtgu + (size_t)2 * DFF * 1024;
    for (int it = bid; it < MT / DTOK + 3 * 704; it += nb) {
      if (it < MT / DTOK) dpost_item(lds, p, l, it);
      else { const int j = it - MT / DTOK;
        if (j < 704) conv_T(lds, p.in[I_FG] + (size_t)l * 1024 * DFF, 1024, DFF, wtgu, 1, j);
        else if (j < 1408) conv_T(lds, p.in[I_FU] + (size_t)l * 1024 * DFF, 1024, DFF, wtgu, 2, j - 704);
        else conv_T(lds, p.in[I_FD] + (size_t)l * DFF * 1024, DFF, 1024, wtd, 0, j - 1408); }
    }
    ctr_barrier((unsigned*)p.ctr + 96);
    { ASrc A; A.b0 = p.z + A_Q; A.b1 = p.z + B_Q; A.b2 = p.z + C_Q; A.b3 = p.pl + 4 * PLANE; A.s0 = A.s1 = A.s2 = NIN; A.s3 = 256; A.shift = 8;
      EpiStore e; e.out = hb; e.ldc = 1024; e.nmax = 1024;
      gemm_phase2(lds, A, p.wtout + (size_t)l * 1024 * 1024, 1024, 4, e); }
    ctr_barrier((unsigned*)p.ctr + 96);
    for (int row = bid * 4 + opaque(w); row < MT; row += nb * 8) { const int rb = row + nb * 4;
      if (rb < MT) row_phase2(p.out + (size_t)row * 1024, p.out + (size_t)rb * 1024, p.out + (size_t)row * 1024, p.out + (size_t)rb * 1024, hb + (size_t)row * 1024, hb + (size_t)rb * 1024,
                              p.in[I_NMPOST] + l * 1024, p.in[I_NFPRE] + l * 1024, hb + (size_t)row * 1024, hb + (size_t)rb * 1024, lane);
      else row_phase(p.out + (size_t)row * 1024, p.out + (size_t)row * 1024, hb + (size_t)row * 1024, p.in[I_NMPOST] + l * 1024, p.in[I_NFPRE] + l * 1024, hb + (size_t)row * 1024, lane); }
    ctr_barrier((unsigned*)p.ctr + 96);
    { ASrc A; A.b0 = hb; A.b1 = hb; A.b2 = hb; A.b3 = hb; A.s0 = A.s1 = A.s2 = A.s3 = 1024; A.shift = 12;
      EpiSwiGLU e; e.out = p.z;
      gemm_phase2(lds, A, wtgu, 1024, 22, e); }
    ctr_barrier((unsigned*)p.ctr + 96);
    { ASrc A; A.b0 = p.z; A.b1 = p.z; A.b2 = p.z; A.b3 = p.z; A.s0 = A.s1 = A.s2 = A.s3 = DFF; A.shift = 12;
      EpiStore e; e.out = hb; e.ldc = 1024; e.nmax = 1024;
      gemm_phase2(lds, A, wtd, DFF, 4, e); }
    ctr_barrier((unsigned*)p.ctr + 96);
    for (int row = bid * 4 + opaque(w); row < MT; row += nb * 8) { const int rb = row + nb * 4; const float* gp2 = l == 0 ? p.in[I_NMPRE] + 1024 : nullptr;
      if (rb < MT) row_phase2(p.out + (size_t)row * 1024, p.out + (size_t)rb * 1024, p.out + (size_t)row * 1024, p.out + (size_t)rb * 1024, hb + (size_t)row * 1024, hb + (size_t)rb * 1024,
                              p.in[I_NFPOST] + l * 1024, gp2, hb + (size_t)row * 1024, hb + (size_t)rb * 1024, lane);
      else row_phase(p.out + (size_t)row * 1024, p.out + (size_t)row * 1024, hb + (size_t)row * 1024, p.in[I_NFPOST] + l * 1024, gp2, hb + (size_t)row * 1024, lane); }
    if (l == 0) ctr_barrier((unsigned*)p.ctr + 96);
  }
}

extern "C" void kernel_launch(void* const* d_in, const int* in_sizes, int n_in, void* d_out, int out_size,
                              void* d_ws, size_t ws_size, hipStream_t stream) {
  static int grid_blocks = 0;
  if (!grid_blocks) {
    int dev = 0, cus = 0, per_cu = 0;
    hipGetDevice(&dev);
    hipDeviceGetAttribute(&cus, hipDeviceAttributeMultiprocessorCount, dev);
    hipFuncSetAttribute((const void*)fwd, hipFuncAttributeMaxDynamicSharedMemorySize, LDS_BYTES);
    hipOccupancyMaxActiveBlocksPerMultiprocessor(&per_cu, fwd, 256, LDS_BYTES);
    if (per_cu > 2) per_cu = 2;
    if (per_cu < 1) per_cu = 1;
    grid_blocks = cus * per_cu;
  }
  Params p{};
  for (int i = 0; i < 28; ++i) p.in[i] = (const float*)d_in[i];
  p.out = (float*)d_out;
  char* ws = (char*)d_ws;
  size_t off = 0;
  p.z = (bf16_t*)(ws + off); off += (size_t)MT * NIN * 2;
  p.pl = (bf16_t*)(ws + off); off += 7 * PLANE * 2;
  p.wtin = (bf16_t*)(ws + off); off += (size_t)2 * NINP * 1024 * 2;
  p.wtout = (bf16_t*)(ws + off); off += (size_t)2 * 1024 * 1024 * 2;
  p.tabC = (f32x2*)(ws + off); off += (size_t)4096 * 32 * 8;
  p.tabB = (f32x2*)(ws + off); off += (size_t)4096 * 4 * 8;
  p.tabA = (f32x2*)(ws + off); off += (size_t)64 * 16 * 8;
  p.ctr = (int*)(ws + off); off += 1024;
  if (off > ws_size) fprintf(stderr, "workspace too small: need %zu have %zu\n", off, ws_size);
  void* args[] = {&p};
  hipError_t e = hipLaunchCooperativeKernel((void*)fwd, dim3(grid_blocks), dim3(256), args, LDS_BYTES, stream);
  if (e != hipSuccess) fprintf(stderr, "coop launch failed: %s (grid %d)\n", hipGetErrorString(e), grid_blocks);
}
```

```cpp
#include <hip/hip_runtime.h>
#include <hip/hip_cooperative_groups.h>
#include <cstdio>
#include <cstdint>
namespace cg = cooperative_groups;

#define DI __device__ __forceinline__
typedef unsigned short bf16_t;
typedef short bf16x8 __attribute__((ext_vector_type(8)));
typedef float f32x2 __attribute__((ext_vector_type(2)));
typedef float f32x4 __attribute__((ext_vector_type(4)));
typedef float f32x16 __attribute__((ext_vector_type(16)));
typedef unsigned u32x2 __attribute__((ext_vector_type(2)));
typedef unsigned u32x4 __attribute__((ext_vector_type(4)));
typedef __bf16 bf16x2_t __attribute__((ext_vector_type(2)));

constexpr int M0 = 32768, MT = 49152, DM = 1024, NIN = 3392, NINP = 3584, DFF = 2816;
constexpr int A_Q = 0, A_K = 256, A_V = 384, B_Q = 512, B_K = 768, B_V = 1024, C_Q = 1280, C_K = 1536, C_V = 1792, C_G = 2048, D_0 = 2304;
constexpr int PITCH = 144;
constexpr size_t PLANE = (size_t)MT * 256;
constexpr int LDS_BYTES = 73728;
constexpr float LOG2E = 1.4426950408889634f;
constexpr float EPS = 1e-6f;

enum { I_XP = 0, I_XS, I_NMPRE, I_NMPOST, I_NFPRE, I_NFPOST, I_WIN, I_WOUT, I_AQG, I_AKG, I_BLAM, I_BSUB, I_CGN, I_DMUP, I_DMUN, I_DW0, I_DWUP,
       I_DA0, I_DAUP, I_DGUP, I_DKK, I_DKA, I_DRK, I_DGNW, I_DGNB, I_FG, I_FU, I_FD };

struct Params {
  const float* in[28];
  float* out;
  bf16_t* z;
  bf16_t* pl;
  bf16_t* wtin;
  bf16_t* wtout;
  f32x2* tabC;
  f32x2* tabB;
  f32x2* tabA;
  int* ctr;
};

DI int opaque(int x) { asm volatile("" : "+v"(x)); return x; }
DI int opaque_s(int x) { asm volatile("" : "+s"(x)); return x; }
DI float bf2f(bf16_t v) { return __uint_as_float(((unsigned)v) << 16); }
DI float bflo(unsigned w) { return __uint_as_float(w << 16); }
DI float bfhi(unsigned w) { return __uint_as_float(w & 0xffff0000u); }
DI unsigned pk(float lo, float hi) { f32x2 v = {lo, hi}; bf16x2_t b = __builtin_convertvector(v, bf16x2_t); return __builtin_bit_cast(unsigned, b); }
DI bf16_t f2bf(float x) { return (bf16_t)(pk(x, 0.f) & 0xffffu); }
DI float dppf(float x, const int ctrl) { return x; }
#define DPPF(x, ctrl) __int_as_float(__builtin_amdgcn_update_dpp(0, __float_as_int(x), (ctrl), 0xF, 0xF, true))
DI float wave_sum(float v) {
  v += DPPF(v, 0xB1);
  v += DPPF(v, 0x4E);
  v += DPPF(v, 0x141);
  v += DPPF(v, 0x140);
  const int vi = __float_as_int(v);
  return (__int_as_float(__builtin_amdgcn_readlane(vi, 0)) + __int_as_float(__builtin_amdgcn_readlane(vi, 16))) +
         (__int_as_float(__builtin_amdgcn_readlane(vi, 32)) + __int_as_float(__builtin_amdgcn_readlane(vi, 48)));
}
DI float dpp_xor1(float x) { return __int_as_float(__builtin_amdgcn_update_dpp(0, __float_as_int(x), 0xB1, 0xF, 0xF, true)); }
DI float dpp_xor2(float x) { return __int_as_float(__builtin_amdgcn_update_dpp(0, __float_as_int(x), 0x4E, 0xF, 0xF, true)); }
DI float dpp_hmir(float x) { return __int_as_float(__builtin_amdgcn_update_dpp(0, __float_as_int(x), 0x141, 0xF, 0xF, true)); }
DI float red8(float x) { x += dpp_xor1(x); x += dpp_xor2(x); x += dpp_hmir(x); return x; }
DI float fexp2(float x) { return __builtin_amdgcn_exp2f(x); }
DI void seq_info(int s, int& row0, int& T) { if (s < 8) { row0 = s * 4096; T = 4096; } else { row0 = M0 + (s - 8) * 2048; T = 2048; } }
DI void row_info(int r, int& t, int& T) { if (r < M0) { t = r & 4095; T = 4096; } else { t = (r - M0) & 2047; T = 2048; } }
#define MFMA32(a, b, c) __builtin_amdgcn_mfma_f32_32x32x16_bf16((a), (b), (c), 0, 0, 0)

DI void conv_T(char* lds, const float* __restrict__ W, int K, int N, bf16_t* __restrict__ Wt, int mode, int tile) {
  float* t = (float*)lds;
  const int tid0 = opaque(threadIdx.x);
  const int ntn = N >> 6, kt = tile / ntn, nt = tile - kt * ntn, k0 = kt << 6, n0 = nt << 6;
  float wv[16];
#pragma unroll
  for (int i = 0; i < 16; ++i) { const int idx = tid0 + 256 * i, k = idx >> 6, n = idx & 63; wv[i] = W[(size_t)(k0 + k) * N + n0 + n]; }
#pragma unroll
  for (int i = 0; i < 16; ++i) { const int idx = tid0 + 256 * i, k = idx >> 6, n = idx & 63; t[k * 65 + n] = wv[i]; }
  __syncthreads();
#pragma unroll 4
  for (int i = 0; i < 8; ++i) {
    const int idx = tid0 + 256 * i, n = idx >> 5, k = (idx & 31) * 2, j = n0 + n;
    const int rho = (mode == 0) ? j : ((j >> 6) * 128 + ((j >> 5) & 1) * 64 + (mode - 1) * 32 + (j & 31));
    *(unsigned*)(Wt + (size_t)rho * K + k0 + k) = pk(t[k * 65 + n], t[(k + 1) * 65 + n]);
  }
  __syncthreads();
}

DI void row_phase(const float* __restrict__ xin, float* __restrict__ xout, const bf16_t* addsrc, const float* __restrict__ gpost,
                  const float* __restrict__ gpre, bf16_t* hout, int lane_in) {
  const int lane = opaque(lane_in);
  f32x4 x[4];
#pragma unroll
  for (int i = 0; i < 4; ++i) x[i] = *(const f32x4*)(xin + i * 256 + lane * 4);
  if (addsrc) {
    f32x4 m[4]; float ss = 0.f;
#pragma unroll
    for (int i = 0; i < 4; ++i) { const u32x2 w = *(const u32x2*)(addsrc + i * 256 + lane * 4); m[i] = (f32x4){bflo(w.x), bfhi(w.x), bflo(w.y), bfhi(w.y)};
      ss += m[i][0] * m[i][0] + m[i][1] * m[i][1] + m[i][2] * m[i][2] + m[i][3] * m[i][3]; }
    ss = wave_sum(ss); const float rs = rsqrtf(ss * (1.0f / 1024.0f) + EPS);
#pragma unroll
    for (int i = 0; i < 4; ++i) { const f32x4 g = *(const f32x4*)(gpost + i * 256 + lane * 4); x[i] += m[i] * rs * g; }
  }
#pragma unroll
  for (int i = 0; i < 4; ++i) *(f32x4*)(xout + i * 256 + lane * 4) = x[i];
  if (gpre) {
    float ss = 0.f;
#pragma unroll
    for (int i = 0; i < 4; ++i) ss += x[i][0] * x[i][0] + x[i][1] * x[i][1] + x[i][2] * x[i][2] + x[i][3] * x[i][3];
    ss = wave_sum(ss); const float rs = rsqrtf(ss * (1.0f / 1024.0f) + EPS);
#pragma unroll
    for (int i = 0; i < 4; ++i) { const f32x4 g = *(const f32x4*)(gpre + i * 256 + lane * 4); const f32x4 hv = x[i] * rs * g;
      u32x2 w; w.x = pk(hv[0], hv[1]); w.y = pk(hv[2], hv[3]); *(u32x2*)(hout + i * 256 + lane * 4) = w; }
  }
}

DI void row_phase2(const float* __restrict__ xinA, const float* __restrict__ xinB, float* __restrict__ xoutA, float* __restrict__ xoutB, const bf16_t* addA, const bf16_t* addB,
                   const float* __restrict__ gpost, const float* __restrict__ gpre, bf16_t* houtA, bf16_t* houtB, int lane_in) {
  const int lane = opaque(lane_in);
  f32x4 x[2][4]; u32x2 aw[2][4];
#pragma unroll
  for (int i = 0; i < 4; ++i) { x[0][i] = *(const f32x4*)(xinA + i * 256 + lane * 4); x[1][i] = *(const f32x4*)(xinB + i * 256 + lane * 4); }
  if (addA) {
#pragma unroll
    for (int i = 0; i < 4; ++i) { aw[0][i] = *(const u32x2*)(addA + i * 256 + lane * 4); aw[1][i] = *(const u32x2*)(addB + i * 256 + lane * 4); }
#pragma unroll
    for (int r = 0; r < 2; ++r) {
      f32x4 m[4]; float ss = 0.f;
#pragma unroll
      for (int i = 0; i < 4; ++i) { const u32x2 w = aw[r][i]; m[i] = (f32x4){bflo(w.x), bfhi(w.x), bflo(w.y), bfhi(w.y)};
        ss += m[i][0] * m[i][0] + m[i][1] * m[i][1] + m[i][2] * m[i][2] + m[i][3] * m[i][3]; }
      ss = wave_sum(ss); const float rs = rsqrtf(ss * (1.0f / 1024.0f) + EPS);
#pragma unroll
      for (int i = 0; i < 4; ++i) { const f32x4 g = *(const f32x4*)(gpost + i * 256 + lane * 4); x[r][i] += m[i] * rs * g; }
    }
  }
#pragma unroll
  for (int i = 0; i < 4; ++i) { *(f32x4*)(xoutA + i * 256 + lane * 4) = x[0][i]; *(f32x4*)(xoutB + i * 256 + lane * 4) = x[1][i]; }
  if (gpre) {
#pragma unroll
    for (int r = 0; r < 2; ++r) {
      float ss = 0.f;
#pragma unroll
      for (int i = 0; i < 4; ++i) ss += x[r][i][0] * x[r][i][0] + x[r][i][1] * x[r][i][1] + x[r][i][2] * x[r][i][2] + x[r][i][3] * x[r][i][3];
      ss = wave_sum(ss); const float rs = rsqrtf(ss * (1.0f / 1024.0f) + EPS);
      bf16_t* ho = r == 0 ? houtA : houtB;
#pragma unroll
      for (int i = 0; i < 4; ++i) { const f32x4 g = *(const f32x4*)(gpre + i * 256 + lane * 4); const f32x4 hv = x[r][i] * rs * g;
        u32x2 w; w.x = pk(hv[0], hv[1]); w.y = pk(hv[2], hv[3]); *(u32x2*)(ho + i * 256 + lane * 4) = w; }
    }
  }
}

struct ASrc { const bf16_t* b0; const bf16_t* b1; const bf16_t* b2; const bf16_t* b3; int s0, s1, s2, s3; int shift; };

struct EpiStore { bf16_t* out; int ldc; int nmax;
  DI void operator()(const f32x16 (&acc)[2][2], int mb, int nb, int n0, int wc, int l31, int h) const {
#pragma unroll
    for (int mf = 0; mf < 2; ++mf) { bf16_t* rp = out + (size_t)(mb + mf * 32 + l31) * ldc;
#pragma unroll
      for (int nf = 0; nf < 2; ++nf) { if (nb + nf * 32 < nmax) {
#pragma unroll
        for (int g = 0; g < 4; ++g) { u32x2 v; v.x = pk(acc[mf][nf][4 * g], acc[mf][nf][4 * g + 1]); v.y = pk(acc[mf][nf][4 * g + 2], acc[mf][nf][4 * g + 3]);
          *(u32x2*)(rp + nb + nf * 32 + 8 * g + 4 * h) = v; } } } }
  } };
struct EpiSwiGLU { bf16_t* out;
  DI void operator()(const f32x16 (&acc)[2][2], int mb, int nb, int n0, int wc, int l31, int h) const {
    const int hc = (nb >> 6) * 32;
#pragma unroll
    for (int mf = 0; mf < 2; ++mf) { bf16_t* rp = out + (size_t)(mb + mf * 32 + l31) * DFF + hc;
#pragma unroll
      for (int g = 0; g < 4; ++g) { float r[4];
#pragma unroll
        for (int e = 0; e < 4; ++e) { const float gt = acc[mf][0][4 * g + e], up = acc[mf][1][4 * g + e]; r[e] = gt / (1.0f + __expf(-gt)) * up; }
        u32x2 v; v.x = pk(r[0], r[1]); v.y = pk(r[2], r[3]); *(u32x2*)(rp + 8 * g + 4 * h) = v; } }
  } };

struct EpiIn { bf16_t* z; char* lds; const float* qg; const float* kg; const f32x2* tabA; const f32x2* tabB; const f32x2* tabC;
  DI void operator()(f32x16 (&acc)[2][2], int mb, int nb, int n0, int wc, int l31, int h) const {
    if (nb >= NIN) return;
    const bool isv = (nb >= A_V && nb < B_Q) || (nb >= B_V && nb < C_Q) || (nb >= C_V && nb < C_G);
    if (isv) {
      const int wv = (threadIdx.x >> 6);
      bf16_t* img = (bf16_t*)(lds + 32768 + wv * 9216);
#pragma unroll
      for (int mf = 0; mf < 2; ++mf)
#pragma unroll
        for (int nf = 0; nf < 2; ++nf)
#pragma unroll
          for (int i = 0; i < 16; ++i) { const int d = nf * 32 + (i & 3) + 8 * (i >> 2) + 4 * h; img[d * 72 + mf * 32 + l31] = f2bf(acc[mf][nf][i]); }
      __builtin_amdgcn_s_waitcnt(0xc07f);
      const int ln = l31 + 32 * h;
#pragma unroll
      for (int i = 0; i < 8; ++i) { const int q = ln + 64 * i, d = q >> 3, c8 = q & 7;
        const u32x4 v = *(const u32x4*)(img + d * 72 + c8 * 8); *(u32x4*)(z + (size_t)(mb + d) * NIN + nb + c8 * 8) = v; }
      return;
    }
#pragma unroll
    for (int mf = 0; mf < 2; ++mf) {
      const int row = mb + mf * 32 + l31; int t, T; row_info(row, t, T);
      if (nb < A_V) {
        const bool isq = nb < A_K; const float* gn = isq ? qg : kg;
        float ss = 0.f;
#pragma unroll
        for (int nf = 0; nf < 2; ++nf)
#pragma unroll
          for (int i = 0; i < 16; ++i) ss += acc[mf][nf][i] * acc[mf][nf][i];
        ss += __shfl_xor(ss, 32);
        const float rs = rsqrtf(ss * (1.0f / 64.0f) + EPS) * (isq ? 0.125f * LOG2E : 1.0f);
#pragma unroll
        for (int nf = 0; nf < 2; ++nf) {
          const int pos = nf == 0 ? (t >> 6) : (t & 63);
#pragma unroll
          for (int g = 0; g < 4; ++g)
#pragma unroll
            for (int e = 0; e < 4; ++e) acc[mf][nf][4 * g + e] *= rs * gn[nf * 32 + 8 * g + 4 * h + e];
#pragma unroll
          for (int g = 0; g < 2; ++g)
#pragma unroll
            for (int e = 0; e < 4; ++e) { const f32x2 cs = tabA[pos * 16 + 8 * g + 4 * h + e];
              const float x1 = acc[mf][nf][4 * g + e], x2 = acc[mf][nf][4 * (g + 2) + e];
              acc[mf][nf][4 * g + e] = x1 * cs.x - x2 * cs.y; acc[mf][nf][4 * (g + 2) + e] = x2 * cs.x + x1 * cs.y; }
        }
      } else if (nb >= B_Q && nb < B_V) {
        const bool isq = nb < B_K;
#pragma unroll
        for (int nf = 0; nf < 2; ++nf) {
#pragma unroll
          for (int e = 0; e < 4; ++e) { const f32x2 cs = tabB[t * 4 + e]; const float v = acc[mf][nf][e]; const float o = __shfl_xor(v, 32);
            acc[mf][nf][e] = (h == 0) ? (v * cs.x - o * cs.y) : (v * cs.x + o * cs.y); }
          if (isq) {
#pragma unroll
            for (int i = 0; i < 16; ++i) acc[mf][nf][i] *= 0.17677669529663687f * LOG2E; }
        }
      } else if (nb >= C_Q && nb < C_V) {
        const float sc = nb < C_K ? 1.0f : 0.125f;
#pragma unroll
        for (int g = 0; g < 4; ++g)
#pragma unroll
          for (int e = 0; e < 4; ++e) { const f32x2 cs = tabC[t * 32 + 8 * g + 4 * h + e]; const float x1 = acc[mf][0][4 * g + e], x2 = acc[mf][1][4 * g + e];
            acc[mf][0][4 * g + e] = (x1 * cs.x - x2 * cs.y) * sc; acc[mf][1][4 * g + e] = (x2 * cs.x + x1 * cs.y) * sc; }
      }
      bf16_t* rp = z + (size_t)row * NIN + nb;
#pragma unroll
      for (int nf = 0; nf < 2; ++nf)
#pragma unroll
        for (int g = 0; g < 4; ++g) { u32x2 v; v.x = pk(acc[mf][nf][4 * g], acc[mf][nf][4 * g + 1]); v.y = pk(acc[mf][nf][4 * g + 2], acc[mf][nf][4 * g + 3]);
          *(u32x2*)(rp + nf * 32 + 8 * g + 4 * h) = v; }
    }
  } };

#define LASP __attribute__((address_space(3)))
template <class Epi>
DI void gemm_tile(char* lds, const ASrc& A, const bf16_t* __restrict__ Bt, int K, int m0, int n0, const Epi& epi, bool first, bool has_next, int m0n, int n0n) {
  const int tid = opaque(threadIdx.x), lane = tid & 63, w = __builtin_amdgcn_readfirstlane(tid >> 6), wr = w >> 1, wc = w & 1, l31 = lane & 31, h = lane >> 5;
  const int nk = K >> 6, smask = (1 << A.shift) - 1;
  LASP char* ldsl = (LASP char*)lds;
  f32x16 acc[2][2];
#pragma unroll
  for (int a = 0; a < 2; ++a)
#pragma unroll
    for (int b = 0; b < 2; ++b)
#pragma unroll
      for (int i = 0; i < 16; ++i) acc[a][b][i] = 0.f;
  const int lrow = lane >> 3, lslot = lane & 7;
  int goffA[4], goffB[4];
#pragma unroll
  for (int i = 0; i < 4; ++i) { const int r = w * 32 + i * 8 + lrow, c = lslot ^ ((r >> 1) & 7); goffA[i] = r; goffB[i] = r * K + c * 8; goffA[i] = (goffA[i] << 3) | c; }
#define GEMM_ISSUE(kt, st, M0_, N0_) do { const int k0_ = (kt) << 6, seg_ = k0_ >> A.shift, kk_ = k0_ & smask; \
    const bf16_t* bp_ = seg_ == 0 ? A.b0 : seg_ == 1 ? A.b1 : seg_ == 2 ? A.b2 : A.b3; const int st_ = seg_ == 0 ? A.s0 : seg_ == 1 ? A.s1 : seg_ == 2 ? A.s2 : A.s3; \
    _Pragma("unroll") for (int i_ = 0; i_ < 4; ++i_) { \
      const bf16_t* ga_ = bp_ + (size_t)((M0_) + (goffA[i_] >> 3)) * st_ + kk_ + (goffA[i_] & 7) * 8; \
      __builtin_amdgcn_global_load_lds((const unsigned*)ga_, (LASP unsigned*)(ldsl + (st) * 32768 + (w * 4 + i_) * 1024), 16, 0, 0); \
      const bf16_t* gb_ = Bt + (size_t)(N0_) * K + goffB[i_] + k0_; \
      __builtin_amdgcn_global_load_lds((const unsigned*)gb_, (LASP unsigned*)(ldsl + (st) * 32768 + 16384 + (w * 4 + i_) * 1024), 16, 0, 0); } } while (0)
  const int xr = (l31 >> 1) & 7;
  int coff[4];
#pragma unroll
  for (int s = 0; s < 4; ++s) coff[s] = ((2 * s + h) ^ xr) * 16;
#define GEMM_COMPUTE(st) do { const char* as = lds + (st) * 32768; const char* bs = as + 16384; \
    bf16x8 af[4][2], wf[4][2]; \
    _Pragma("unroll") for (int s = 0; s < 4; ++s) { \
      _Pragma("unroll") for (int mf = 0; mf < 2; ++mf) af[s][mf] = *(const bf16x8*)(as + (wr * 64 + mf * 32 + l31) * 128 + coff[s]); \
      _Pragma("unroll") for (int nf = 0; nf < 2; ++nf) wf[s][nf] = *(const bf16x8*)(bs + (wc * 64 + nf * 32 + l31) * 128 + coff[s]); } \
    __builtin_amdgcn_sched_barrier(0); __builtin_amdgcn_s_setprio(1); \
    _Pragma("unroll") for (int s = 0; s < 4; ++s) \
      _Pragma("unroll") for (int mf = 0; mf < 2; ++mf) _Pragma("unroll") for (int nf = 0; nf < 2; ++nf) acc[mf][nf] = MFMA32(wf[s][nf], af[s][mf], acc[mf][nf]); \
    __builtin_amdgcn_s_setprio(0); __builtin_amdgcn_sched_barrier(0); } while (0)
  if (first) GEMM_ISSUE(0, 0, m0, n0);
  for (int kt = 0; kt < nk; kt += 2) {
    asm volatile("s_waitcnt vmcnt(0)" ::: "memory"); __syncthreads();
    GEMM_ISSUE(kt + 1, 1, m0, n0);
    GEMM_COMPUTE(0);
    asm volatile("s_waitcnt vmcnt(0)" ::: "memory"); __syncthreads();
    if (kt + 2 < nk) GEMM_ISSUE(kt + 2, 0, m0, n0);
    GEMM_COMPUTE(1);
  }
  __syncthreads();
  if (has_next) GEMM_ISSUE(0, 0, m0n, n0n);
  epi(acc, m0 + wr * 64, n0 + wc * 64, n0, wc, l31, h);
  __syncthreads();
#undef GEMM_ISSUE
#undef GEMM_COMPUTE
}

template <class Epi>
DI void gemm_phase(char* lds, const ASrc& A, const bf16_t* Bt, int K, int ntn, const Epi& epi) {
  const int xcd = blockIdx.x & 7, j = blockIdx.x >> 3, nloc = gridDim.x >> 3, per = 48 * ntn, grp = 8 * ntn;
  bool first = true;
  for (int li = j; li < per; li += nloc) {
    const int sg = li / grp, wi = li - sg * grp, nt = wi >> 3, mt = xcd * 48 + sg * 8 + (wi & 7);
    const int ln = li + nloc; const bool has_next = ln < per;
    const int sgn = ln / grp, win = ln - sgn * grp, ntn2 = win >> 3, mtn = xcd * 48 + sgn * 8 + (win & 7);
    gemm_tile(lds, A, Bt, K, mt * 128, nt * 128, epi, first, has_next, mtn * 128, ntn2 * 128);
    first = false;
  }
}

DI void prep_item(char* lds, const Params& p, int layer, int item) {
  const int tid = opaque(threadIdx.x), lane = tid & 63, w = tid >> 6;
  const int rowb = item * 64; int tb, T; row_info(rowb, tb, T);
  const float* qg = p.in[I_AQG] + layer * 64; const float* kg = p.in[I_AKG] + layer * 64;
  const float qgl = qg[lane], kgl = kg[lane];
  for (int tt = 0; tt < 16; ++tt) {
    const int row = rowb + w * 16 + tt, t = tb + w * 16 + tt;
    bf16_t* zr = p.z + (size_t)row * NIN;
    {
      const int j = lane & 31, i = j & 15; const bool first = j < 16; const int pos = (lane < 32) ? (t >> 6) : (t & 63);
      const f32x2 cs = p.tabA[pos * 16 + i];
#pragma unroll
      for (int hd = 0; hd < 6; ++hd) {
        bf16_t* ptr = zr + (hd < 4 ? A_Q + hd * 64 : A_K + (hd - 4) * 64) + lane;
        float v = bf2f(*ptr);
        const float ss = wave_sum(v * v);
        v = v * rsqrtf(ss * (1.0f / 64.0f) + EPS) * (hd < 4 ? qgl : kgl);
        const float o = __shfl_xor(v, 16);
        float r = first ? (v * cs.x - o * cs.y) : (v * cs.x + o * cs.y);
        if (hd < 4) r *= 0.125f * LOG2E;
        *ptr = f2bf(r);
      }
    }
    {
      const int d = lane & 31; const f32x2 cs = p.tabB[t * 4 + (d & 3)];
#pragma unroll
      for (int c = 0; c < 8; ++c) {
        bf16_t* ptr = zr + (c < 4 ? B_Q + c * 64 : B_K + (c - 4) * 64) + lane;
        float v = bf2f(*ptr);
        const float o = __shfl_xor(v, 4);
        float r = v;
        if (d < 8) r = (d < 4) ? (v * cs.x - o * cs.y) : (v * cs.x + o * cs.y);
        if (c < 4) r *= 0.17677669529663687f * LOG2E;
        *ptr = f2bf(r);
      }
    }
    {
      const f32x2 cs = p.tabC[t * 32 + (lane & 31)];
#pragma unroll
      for (int c = 0; c < 8; ++c) {
        bf16_t* ptr = zr + (c < 4 ? C_Q + c * 64 : C_K + (c - 4) * 64) + lane;
        const float v = bf2f(*ptr);
        const float o = __shfl_xor(v, 32);
        float r = (lane < 32) ? (v * cs.x - o * cs.y) : (v * cs.x + o * cs.y);
        if (c >= 4) r *= 0.125f;
        *ptr = f2bf(r);
      }
    }
  }
  bf16_t* tl = (bf16_t*)lds;
  const int r = tid >> 2, c0 = (tid & 3) * 16;
  for (int sl = 0; sl < 10; ++sl) {
    const int col = sl < 2 ? A_V + sl * 64 : sl < 6 ? B_V + (sl - 2) * 64 : C_V + (sl - 6) * 64;
    bf16_t* gp = p.z + (size_t)(rowb + r) * NIN + col + c0;
    const u32x4 v0 = *(const u32x4*)gp, v1 = *(const u32x4*)(gp + 8);
    __syncthreads();
#pragma unroll
    for (int e = 0; e < 4; ++e) {
      tl[(c0 + 2 * e) * 72 + r] = (bf16_t)(v0[e] & 0xffffu); tl[(c0 + 2 * e + 1) * 72 + r] = (bf16_t)(v0[e] >> 16);
      tl[(c0 + 8 + 2 * e) * 72 + r] = (bf16_t)(v1[e] & 0xffffu); tl[(c0 + 8 + 2 * e + 1) * 72 + r] = (bf16_t)(v1[e] >> 16);
    }
    __syncthreads();
    const u32x4 o0 = *(const u32x4*)(tl + r * 72 + c0), o1 = *(const u32x4*)(tl + r * 72 + c0 + 8);
    *(u32x4*)gp = o0; *(u32x4*)(gp + 8) = o1;
  }
  __syncthreads();
}

DI float dshift(const Params& p, const float* mup, const float* mun, int row, int t, int T, int dc) {
  const bf16_t* zp = p.z + (size_t)row * NIN + D_0 + dc;
  const float z = bf2f(*zp);
  const float zprev = (t > 0) ? bf2f(*(zp - NIN)) : 0.f;
  const float znext = (t < T - 1) ? bf2f(*(zp + NIN)) : 0.f;
  return z + mup[dc] * (zprev - z) + mun[dc] * (znext - z);
}
DI float sigmoidf_(float x) { return 1.0f / (1.0f + __expf(-x)); }
DI float omdecay(float ww) {
  const float e = 0.6065306597126334f / (1.0f + __expf(-ww));
  return 1.0f - __expf(-e);
}
DI float fast_tanh(float x) { const float xc = fminf(fmaxf(x, -15.f), 15.f); return 1.0f - 2.0f / (1.0f + __expf(2.0f * xc)); }
constexpr int DTOK = 16;
DI void dprep_item(char* lds, const Params& p, int layer, int item) {
  const int tid = opaque(threadIdx.x);
  const int rowb = item * DTOK; int tb, T; row_info(rowb, tb, T);
  const float* mup = p.in[I_DMUP] + layer * 1088; const float* mun = p.in[I_DMUN] + layer * 1088;
  float* su = (float*)lds;
  bf16_t* stg = (bf16_t*)(lds + 12288);
#pragma unroll
  for (int i = 0; i < 12; ++i) {
    const int idx = tid + 256 * i, tok = idx / 192, c = idx - tok * 192;
    float u = dshift(p, mup, mun, rowb + tok, tb + tok, T, 768 + c);
    if (c < 128) u = fast_tanh(u);
    su[c * DTOK + tok] = u;
  }
  __syncthreads();
  const int c = tid;
  const float w0f = p.in[I_DW0][(layer * 2 + 0) * 256 + c], w0b = p.in[I_DW0][(layer * 2 + 1) * 256 + c];
  const float a0 = p.in[I_DA0][layer * 256 + c], kkw = p.in[I_DKK][layer * 256 + c], kaw = p.in[I_DKA][layer * 256 + c];
  float zr[DTOK + 2], zk[DTOK + 2], zv[DTOK + 2];
  { const bf16_t* zp = p.z + (size_t)rowb * NIN + D_0 + c;
#pragma unroll
    for (int i = 0; i < DTOK + 2; ++i) { const int t = tb - 1 + i; const bool ok = (t >= 0) && (t < T); const bf16_t* q = zp + (ptrdiff_t)(i - 1) * NIN;
      zr[i] = ok ? bf2f(q[0]) : 0.f; zk[i] = ok ? bf2f(q[256]) : 0.f; zv[i] = ok ? bf2f(q[512]) : 0.f; } }
  const float mpr = mup[c], mnr = mun[c], mpk = mup[256 + c], mnk = mun[256 + c], mpv = mup[512 + c], mnv = mun[512 + c];
  float accf[DTOK], accb[DTOK], acca[DTOK];
#pragma unroll
  for (int k = 0; k < DTOK; ++k) { accf[k] = 0.f; accb[k] = 0.f; acca[k] = 0.f; }
  const float* wupf = p.in[I_DWUP] + (size_t)(layer * 2 + 0) * 64 * 256 + c;
  const float* wupb = p.in[I_DWUP] + (size_t)(layer * 2 + 1) * 64 * 256 + c;
  const float* aup = p.in[I_DAUP] + (size_t)layer * 64 * 256 + c;
#pragma unroll 2
  for (int j = 0; j < 64; ++j) {
    const float wf = wupf[j * 256], wb = wupb[j * 256], wa = aup[j * 256];
#pragma unroll
    for (int q = 0; q < 4; ++q) {
      const f32x4 f0 = *(const f32x4*)(su + j * DTOK + 4 * q), b0 = *(const f32x4*)(su + (64 + j) * DTOK + 4 * q), a0v = *(const f32x4*)(su + (128 + j) * DTOK + 4 * q);
#pragma unroll
      for (int k = 0; k < 4; ++k) { accf[4 * q + k] += f0[k] * wf; accb[4 * q + k] += b0[k] * wb; acca[4 * q + k] += a0v[k] * wa; }
    }
  }
#pragma unroll
  for (int k = 0; k < DTOK; ++k) {
    const float r = zr[k + 1] + mpr * (zr[k] - zr[k + 1]) + mnr * (zr[k + 2] - zr[k + 1]);
    const float kx = zk[k + 1] + mpk * (zk[k] - zk[k + 1]) + mnk * (zk[k + 2] - zk[k + 1]);
    const float v = zv[k + 1] + mpv * (zv[k] - zv[k + 1]) + mnv * (zv[k + 2] - zv[k + 1]);
    const float omf = omdecay(w0f + accf[k]), omb = omdecay(w0b + accb[k]);
    const float a = sigmoidf_(a0 + acca[k]);
    float kk = kx * kkw; const float n2 = wave_sum(kk * kk);
    kk = kk * rsqrtf(fmaxf(n2, 1e-24f));
    const float kmod = kx * (1.0f + (a - 1.0f) * kaw), b = kk * a;
    bf16_t* so = stg + k * 256 + c;
    so[0] = f2bf(r); so[DTOK * 256] = f2bf(kmod); so[2 * DTOK * 256] = f2bf(v); so[3 * DTOK * 256] = f2bf(-kk);
    so[4 * DTOK * 256] = f2bf(b); so[5 * DTOK * 256] = f2bf(omf); so[6 * DTOK * 256] = f2bf(omb);
  }
  __syncthreads();
#pragma unroll
  for (int i = 0; i < 14; ++i) {
    const int q = tid + 256 * i, pln = q >> 9, rem = q & 511, tok = rem >> 5, c16 = rem & 31;
    const u32x4 v = *(const u32x4*)(stg + pln * (DTOK * 256) + tok * 256 + c16 * 8);
    *(u32x4*)(p.pl + (size_t)pln * PLANE + (size_t)(rowb + tok) * 256 + c16 * 8) = v;
  }
  __syncthreads();
}

DI void dpost_item(char* lds, const Params& p, int layer, int item) {
  const int tid = opaque(threadIdx.x);
  const int rowb = item * DTOK; int tb, T; row_info(rowb, tb, T);
  const float* mup = p.in[I_DMUP] + layer * 1088; const float* mun = p.in[I_DMUN] + layer * 1088;
  float* sg = (float*)lds;
  bf16_t* stg = (bf16_t*)(lds + 8192);
#pragma unroll
  for (int i = 0; i < 8; ++i) { const int idx = tid + 256 * i, tok = idx >> 7, c = idx & 127; sg[c * DTOK + tok] = sigmoidf_(dshift(p, mup, mun, rowb + tok, tb + tok, T, 960 + c)); }
  __syncthreads();
  const int c = tid;
  float acc[DTOK];
#pragma unroll
  for (int k = 0; k < DTOK; ++k) acc[k] = 0.f;
  float yv[DTOK], rv_[DTOK], kmv[DTOK], vv_[DTOK];
#pragma unroll
  for (int k = 0; k < DTOK; ++k) { const int row = rowb + k; const bf16_t* zd = p.z + (size_t)row * NIN + D_0; const size_t o = (size_t)row * 256 + c;
    yv[k] = bf2f(zd[c]) + bf2f(zd[256 + c]); rv_[k] = bf2f(p.pl[o]); kmv[k] = bf2f(p.pl[PLANE + o]); vv_[k] = bf2f(p.pl[2 * PLANE + o]); }
  const float* gup = p.in[I_DGUP] + (size_t)layer * 128 * 256 + c;
#pragma unroll 4
  for (int j = 0; j < 128; ++j) { const float gw = gup[j * 256];
#pragma unroll
    for (int q = 0; q < 4; ++q) { const f32x4 s0 = *(const f32x4*)(sg + j * DTOK + 4 * q);
#pragma unroll
      for (int k = 0; k < 4; ++k) acc[4 * q + k] += s0[k] * gw; } }
  const float gnw = p.in[I_DGNW][layer * 256 + c], gnb = p.in[I_DGNB][layer * 256 + c], rk = p.in[I_DRK][layer * 256 + c];
#pragma unroll
  for (int k = 0; k < DTOK; ++k) {
    const float y = yv[k];
    const float mean = wave_sum(y) * (1.0f / 64.0f); const float d = y - mean; const float var = wave_sum(d * d) * (1.0f / 64.0f);
    const float yn = d * rsqrtf(var + 64e-5f) * gnw + gnb;
    const float r = rv_[k], km = kmv[k], v = vv_[k];
    const float bonus = wave_sum(r * km * rk);
    stg[k * 256 + c] = f2bf((yn + bonus * v) * acc[k]);
  }
  __syncthreads();
#pragma unroll
  for (int i = 0; i < 2; ++i) { const int q = tid + 256 * i, tok = q >> 5, c16 = q & 31;
    const u32x4 v = *(const u32x4*)(stg + tok * 256 + c16 * 8);
    *(u32x4*)(p.pl + 4 * PLANE + (size_t)(rowb + tok) * 256 + c16 * 8) = v; }
  __syncthreads();
}

DI void rwkv_item(char* lds, const Params& p, int seq, int head, int dir, int half) {
  int row0, T; seq_info(seq, row0, T);
  const int tid = opaque(threadIdx.x), kc = tid & 7, vrow = half * 32 + (tid >> 3);
  float* st = (float*)lds;
  f32x2 S[4];
#pragma unroll
  for (int j = 0; j < 4; ++j) S[j] = (f32x2){0.f, 0.f};
  const int nchunk = T >> 4;
  u32x4 rg[3];
  const int tsel = tid >> 7, srem = tid & 127, sstep = srem >> 3, sc8 = srem & 7;
#define RW_GLOAD(c) do { _Pragma("unroll") for (int i_ = 0; i_ < 3; ++i_) { const int tens_ = tsel + 2 * i_; \
      const int plane_ = tens_ == 0 ? (dir ? 6 : 5) : tens_ == 1 ? 3 : tens_ == 2 ? 4 : tens_ == 3 ? 1 : tens_ == 4 ? 0 : 2; \
      const int t_ = dir ? (T - 1 - ((c) * 16 + sstep)) : ((c) * 16 + sstep); \
      rg[i_] = *(const u32x4*)(p.pl + (size_t)plane_ * PLANE + (size_t)(row0 + t_) * 256 + head * 64 + sc8 * 8); } } while (0)
#define RW_LSTORE(buf) do { _Pragma("unroll") for (int i_ = 0; i_ < 3; ++i_) { const int tens_ = tsel + 2 * i_; \
      f32x4 a_ = {bflo(rg[i_].x), bfhi(rg[i_].x), bflo(rg[i_].y), bfhi(rg[i_].y)}, b_ = {bflo(rg[i_].z), bfhi(rg[i_].z), bflo(rg[i_].w), bfhi(rg[i_].w)}; \
      if (tens_ == 0) { a_ = 1.0f - a_; b_ = 1.0f - b_; } \
      float* d_ = st + (((buf) * 16 + sstep) * 6 + tens_) * 64 + sc8 * 8; *(f32x4*)d_ = a_; *(f32x4*)(d_ + 4) = b_; } } while (0)
  __builtin_amdgcn_s_setprio(3);
  RW_GLOAD(0); RW_LSTORE(0); __syncthreads();
  bf16_t* ybase = p.z + (size_t)row0 * NIN + D_0 + dir * 256 + head * 64 + vrow;
  for (int c = 0; c < nchunk; ++c) {
    if (c + 1 < nchunk) RW_GLOAD(c + 1);
    const float* sb = st + (c & 1) * (16 * 384);
#define RW_FETCH(S_, s_) do { const float* q_ = sb + (s_) * 384 + kc * 8; \
      S_##w0 = *(const f32x4*)(q_); S_##w1 = *(const f32x4*)(q_ + 4); S_##n0 = *(const f32x4*)(q_ + 64); S_##n1 = *(const f32x4*)(q_ + 68); \
      S_##b0 = *(const f32x4*)(q_ + 128); S_##b1 = *(const f32x4*)(q_ + 132); S_##k0 = *(const f32x4*)(q_ + 192); S_##k1 = *(const f32x4*)(q_ + 196); \
      S_##r0 = *(const f32x4*)(q_ + 256); S_##r1 = *(const f32x4*)(q_ + 260); S_##vv = sb[(s_) * 384 + 320 + vrow]; } while (0)
#define LO2(x) ((f32x2){(x)[0], (x)[1]})
#define HI2(x) ((f32x2){(x)[2], (x)[3]})
#define RW_STEP(S_, s_) do { \
      f32x2 a2 = S[0] * LO2(S_##n0); a2 += S[1] * HI2(S_##n0); a2 += S[2] * LO2(S_##n1); a2 += S[3] * HI2(S_##n1); \
      const float sa = red8(a2.x + a2.y); const float vx = S_##vv; \
      S[0] = S[0] * LO2(S_##w0) + (LO2(S_##b0) * sa + LO2(S_##k0) * vx); S[1] = S[1] * HI2(S_##w0) + (HI2(S_##b0) * sa + HI2(S_##k0) * vx); \
      S[2] = S[2] * LO2(S_##w1) + (LO2(S_##b1) * sa + LO2(S_##k1) * vx); S[3] = S[3] * HI2(S_##w1) + (HI2(S_##b1) * sa + HI2(S_##k1) * vx); \
      f32x2 y2 = S[0] * LO2(S_##r0); y2 += S[1] * HI2(S_##r0); y2 += S[2] * LO2(S_##r1); y2 += S[3] * HI2(S_##r1); \
      const float y = red8(y2.x + y2.y); const float yn = DPPF(y, 0x128);     \
      if ((tid & 15) == 0) { const int t_ = dir ? (T - 1 - (c * 16 + (s_))) : (c * 16 + (s_)); *(unsigned*)(ybase + (size_t)t_ * NIN) = pk(y, yn); } } while (0)
    f32x4 Aw0, Aw1, An0, An1, Ab0, Ab1, Ak0, Ak1, Ar0, Ar1; float Avv;
    f32x4 Bw0, Bw1, Bn0, Bn1, Bb0, Bb1, Bk0, Bk1, Br0, Br1; float Bvv;
    RW_FETCH(A, 0);
#pragma unroll 2
    for (int s = 0; s < 16; s += 2) {
      RW_FETCH(B, s + 1);
      RW_STEP(A, s);
      if (s + 2 < 16) RW_FETCH(A, s + 2);
      RW_STEP(B, s + 1);
    }
#undef RW_FETCH
#undef RW_STEP
    if (c + 1 < nchunk) RW_LSTORE((c + 1) & 1);
    __syncthreads();
  }
#undef RW_GLOAD
#undef RW_LSTORE
  __builtin_amdgcn_s_setprio(0);
}

template <int MODE>
DI void attn_item(char* lds, const Params& p, int layer, int seq, int head, int qt) {
  const int tid = opaque(threadIdx.x), lane = tid & 63, w = tid >> 6, l31 = lane & 31, h = lane >> 5;
  layer = opaque_s(layer); seq = opaque_s(seq); head = opaque_s(head); qt = opaque_s(qt);
  int row0, T; seq_info(seq, row0, T);
  const int QC = (MODE == 0 ? A_Q : MODE == 1 ? B_Q : C_Q) + head * 64;
  const int KC = MODE == 0 ? A_K + (head >> 1) * 64 : MODE == 1 ? B_K + head * 64 : C_K + head * 64;
  const int VC = MODE == 0 ? A_V + (head >> 1) * 64 : MODE == 1 ? B_V + head * 64 : C_V + head * 64;
  const int qw0 = qt * 128 + w * 32, qi = qw0 + l31;
  bf16_t* zq = p.z + (size_t)(row0 + qi) * NIN + QC;
  bf16x8 qf[4];
#pragma unroll
  for (int s = 0; s < 4; ++s) qf[s] = *(const bf16x8*)(zq + s * 16 + h * 8);
  const int srow = tid >> 3, sc8 = tid & 7;
  const bf16_t* kbase = p.z + (size_t)(row0 + srow) * NIN + KC + sc8 * 8;
  const bf16_t* vbase = p.z + (size_t)(row0 + srow) * NIN + VC + sc8 * 8;
  u32x4 rk[2][2], rv[2][2];
  const int nt = T >> 6;
  const int prow = (l31 & 19) | ((l31 & 4) << 1) | ((l31 & 8) >> 1);
#define AT_GLOAD(t, S) do { _Pragma("unroll") for (int i_ = 0; i_ < 2; ++i_) { const size_t off_ = (size_t)((t) * 64 + 32 * i_) * NIN; rk[S][i_] = *(const u32x4*)(kbase + off_); rv[S][i_] = *(const u32x4*)(vbase + off_); } } while (0)
#define AT_LSTORE(buf, S) do { char* ks_ = lds + (buf) * 18432; char* vs_ = ks_ + 9216; \
    _Pragma("unroll") for (int i_ = 0; i_ < 2; ++i_) { *(u32x4*)(ks_ + (srow + 32 * i_) * PITCH + sc8 * 16) = rk[S][i_]; *(u32x4*)(vs_ + (srow + 32 * i_) * PITCH + sc8 * 16) = rv[S][i_]; } } while (0)
  constexpr int NMAP = (MODE == 1) ? 2 : 1;
  f32x16 o[NMAP][2];
  float m_run[NMAP], l_run[NMAP];
#pragma unroll
  for (int a = 0; a < NMAP; ++a) { m_run[a] = -INFINITY; l_run[a] = 0.f;
#pragma unroll
    for (int b = 0; b < 2; ++b)
#pragma unroll
      for (int i = 0; i < 16; ++i) o[a][b][i] = 0.f; }
  float lf = 0.f, lb = 0.f;
  if (MODE == 2) { lf = log2f(1.0f - exp2f(-5.0f - (float)head)); lb = log2f(1.0f - exp2f(-5.0f - (float)(3 - head))); }
  auto body = [&](const char* ks, const char* vs, const int t) __attribute__((always_inline)) {
#pragma unroll
    for (int mp = 0; mp < NMAP; ++mp) {
      f32x16 st[2];
#pragma unroll
      for (int kf = 0; kf < 2; ++kf) {
#pragma unroll
        for (int i = 0; i < 16; ++i) st[kf][i] = 0.f;
        if (MODE == 1) {
#pragma unroll
          for (int s = 0; s < 2; ++s) { const bf16x8 kfr = *(const bf16x8*)(ks + (kf * 32 + prow) * PITCH + (mp * 2 + s) * 32 + h * 16); st[kf] = MFMA32(kfr, qf[mp * 2 + s], st[kf]); }
        } else {
#pragma unroll
          for (int s = 0; s < 4; ++s) { const bf16x8 kfr = *(const bf16x8*)(ks + (kf * 32 + prow) * PITCH + s * 32 + h * 16); st[kf] = MFMA32(kfr, qf[s], st[kf]); }
        }
      }
      if (MODE == 2) {
        const int k0 = t * 64;
        const float dbase = (float)(qi - k0 - 8 * h);
        if (k0 + 63 < qw0) {
#pragma unroll
          for (int kf = 0; kf < 2; ++kf)
#pragma unroll
            for (int i = 0; i < 16; ++i) { const float cc = (float)(32 * kf + (i & 3) + 4 * ((i >> 2) & 1) + 16 * ((i >> 3) & 1)); st[kf][i] *= fexp2(lf * (dbase - cc)); }
        } else if (k0 > qw0 + 31) {
#pragma unroll
          for (int kf = 0; kf < 2; ++kf)
#pragma unroll
            for (int i = 0; i < 16; ++i) { const float cc = (float)(32 * kf + (i & 3) + 4 * ((i >> 2) & 1) + 16 * ((i >> 3) & 1)); st[kf][i] *= fexp2(lb * (cc - dbase)); }
        } else {
#pragma unroll
          for (int kf = 0; kf < 2; ++kf)
#pragma unroll
            for (int i = 0; i < 16; ++i) { const float cc = (float)(32 * kf + (i & 3) + 4 * ((i >> 2) & 1) + 16 * ((i >> 3) & 1)); const float d = dbase - cc;
              float dd = fexp2(fminf(lf * d, -lb * d)); if (d == 0.f) dd = 2.0f; st[kf][i] *= dd; }
        }
      } else {
        float mx = st[0][0];
#pragma unroll
        for (int kf = 0; kf < 2; ++kf)
#pragma unroll
          for (int i = 0; i < 16; ++i) mx = fmaxf(mx, st[kf][i]);
        mx = fmaxf(mx, __shfl_xor(mx, 32));
        const float mn = fmaxf(m_run[mp], mx); const float alpha = fexp2(m_run[mp] - mn); m_run[mp] = mn;
        float ps = 0.f;
#pragma unroll
        for (int kf = 0; kf < 2; ++kf)
#pragma unroll
          for (int i = 0; i < 16; ++i) { st[kf][i] = fexp2(st[kf][i] - mn); ps += st[kf][i]; }
        l_run[mp] = l_run[mp] * alpha + ps;
#pragma unroll
        for (int df = 0; df < 2; ++df) o[mp][df] *= alpha;
      }
      bf16x8 pf[4];
#pragma unroll
      for (int kf = 0; kf < 2; ++kf)
#pragma unroll
        for (int s2 = 0; s2 < 2; ++s2) { u32x4 u; u.x = pk(st[kf][8 * s2], st[kf][8 * s2 + 1]); u.y = pk(st[kf][8 * s2 + 2], st[kf][8 * s2 + 3]);
          u.z = pk(st[kf][8 * s2 + 4], st[kf][8 * s2 + 5]); u.w = pk(st[kf][8 * s2 + 6], st[kf][8 * s2 + 7]); pf[kf * 2 + s2] = __builtin_bit_cast(bf16x8, u); }
#pragma unroll
      for (int df = 0; df < 2; ++df)
#pragma unroll
        for (int ksx = 0; ksx < 4; ++ksx) { const bf16x8 vfr = *(const bf16x8*)(vs + (df * 32 + l31) * PITCH + ksx * 32 + h * 16); o[mp][df] = MFMA32(vfr, pf[ksx], o[mp][df]); }
    }
  };
  if constexpr (MODE == 1) {
    AT_GLOAD(0, 0); AT_LSTORE(0, 0); __syncthreads();
#pragma unroll 1
    for (int t = 0; t < nt; ++t) {
      if (t + 1 < nt) AT_GLOAD(t + 1, 0);
      const char* ks = lds + (t & 1) * 18432;
      body(ks, ks + 9216, t);
      if (t + 1 < nt) AT_LSTORE((t + 1) & 1, 0);
      __syncthreads();
    }
  } else {
    AT_GLOAD(0, 0); AT_GLOAD(1, 1); AT_LSTORE(0, 0); __syncthreads();
#pragma unroll 1
    for (int t2 = 0; t2 < nt; t2 += 2) {
      if (t2 + 2 < nt) AT_GLOAD(t2 + 2, 0);
      body(lds, lds + 9216, t2);
      AT_LSTORE(1, 1);
      __syncthreads();
      if (t2 + 3 < nt) AT_GLOAD(t2 + 3, 1);
      body(lds + 18432, lds + 18432 + 9216, t2 + 1);
      if (t2 + 2 < nt) AT_LSTORE(0, 0);
      __syncthreads();
    }
  }
#undef AT_GLOAD
#undef AT_LSTORE
  f32x16 r[2];
  if (MODE == 0) {
    const float l = l_run[0] + __shfl_xor(l_run[0], 32); const float inv = 1.0f / l;
#pragma unroll
    for (int df = 0; df < 2; ++df) r[df] = o[0][df] * inv;
  } else if (MODE == 1) {
    const float* lp = p.in[I_BLAM] + layer * 128;
    float s01 = 0.f, s23 = 0.f;
    for (int i = 0; i < 32; ++i) { s01 += lp[i] * lp[32 + i]; s23 += lp[64 + i] * lp[96 + i]; }
    const float lam_init = 0.8f - 0.6f * expf(-0.3f * (float)layer);
    const float lam = expf(s01) - expf(s23) + lam_init;
    const float l0 = l_run[0] + __shfl_xor(l_run[0], 32), l1 = l_run[NMAP - 1] + __shfl_xor(l_run[NMAP - 1], 32);
    const float i0 = 1.0f / l0, i1 = lam / l1;
    float ss = 0.f;
#pragma unroll
    for (int df = 0; df < 2; ++df) { r[df] = o[0][df] * i0 - o[NMAP - 1][df] * i1;
#pragma unroll
      for (int i = 0; i < 16; ++i) ss += r[df][i] * r[df][i]; }
    ss += __shfl_xor(ss, 32);
    const float rs = rsqrtf(ss * (1.0f / 64.0f) + EPS) * (1.0f - lam_init);
    const float* sg = p.in[I_BSUB] + layer * 64;
#pragma unroll
    for (int df = 0; df < 2; ++df)
#pragma unroll
      for (int i = 0; i < 16; ++i) r[df][i] *= rs * sg[df * 32 + (i & 3) + 8 * (i >> 2) + 4 * h];
  } else {
    float ss = 0.f;
#pragma unroll
    for (int df = 0; df < 2; ++df)
#pragma unroll
      for (int i = 0; i < 16; ++i) ss += o[0][df][i] * o[0][df][i];
    ss += __shfl_xor(ss, 32);
    const float rs = rsqrtf(ss * (1.0f / 64.0f) + EPS);
    const float* gg = p.in[I_CGN] + layer * 256 + head * 64;
    const bf16_t* zg = p.z + (size_t)(row0 + qi) * NIN + C_G + head * 64;
#pragma unroll
    for (int df = 0; df < 2; ++df)
#pragma unroll
      for (int g = 0; g < 4; ++g) { const u32x2 gw = *(const u32x2*)(zg + df * 32 + 8 * g + 4 * h);
        const float gv[4] = {bflo(gw.x), bfhi(gw.x), bflo(gw.y), bfhi(gw.y)};
#pragma unroll
        for (int e = 0; e < 4; ++e) { const float x = gv[e]; r[df][4 * g + e] = o[0][df][4 * g + e] * rs * gg[df * 32 + 8 * g + 4 * h + e] * (x / (1.0f + __expf(-x))); } }
  }
#pragma unroll
  for (int df = 0; df < 2; ++df)
#pragma unroll
    for (int g = 0; g < 4; ++g) { u32x2 v; v.x = pk(r[df][4 * g], r[df][4 * g + 1]); v.y = pk(r[df][4 * g + 2], r[df][4 * g + 3]); *(u32x2*)(zq + df * 32 + 8 * g + 4 * h) = v; }
}

template <class Epi>
DI void gemm_tile2(char* lds, const ASrc& A, const bf16_t* __restrict__ Bt, int K, int m0, int n0, const Epi& epi) {
  const int tid = opaque(threadIdx.x), lane = tid & 63, w = __builtin_amdgcn_readfirstlane(tid >> 6), wr = w >> 1, wc = w & 1, l31 = lane & 31, h = lane >> 5;
  const int nk = K >> 5, smask = (1 << A.shift) - 1;
  LASP char* ldsl = (LASP char*)lds;
  f32x16 acc[2][4];
#pragma unroll
  for (int a = 0; a < 2; ++a)
#pragma unroll
    for (int b = 0; b < 4; ++b)
#pragma unroll
      for (int i = 0; i < 16; ++i) acc[a][b][i] = 0.f;
  const int lrow = lane >> 2, lslot = lane & 3;
  int goffA[2], goffB[4];
#pragma unroll
  for (int i = 0; i < 2; ++i) { const int r = (2 * w + i) * 16 + lrow, c = lslot ^ ((r >> 2) & 3); goffA[i] = (r << 2) | c; }
#pragma unroll
  for (int i = 0; i < 4; ++i) { const int r = (4 * w + i) * 16 + lrow, c = lslot ^ ((r >> 2) & 3); goffB[i] = r * K + c * 8; }
#define G2_ISSUE(kt, st) do { const int k0_ = (kt) << 5, seg_ = k0_ >> A.shift, kk_ = k0_ & smask; \
    const bf16_t* bp_ = seg_ == 0 ? A.b0 : seg_ == 1 ? A.b1 : seg_ == 2 ? A.b2 : A.b3; const int st_ = seg_ == 0 ? A.s0 : seg_ == 1 ? A.s1 : seg_ == 2 ? A.s2 : A.s3; \
    _Pragma("unroll") for (int i_ = 0; i_ < 2; ++i_) { \
      const bf16_t* ga_ = bp_ + (size_t)(m0 + (goffA[i_] >> 2)) * st_ + kk_ + (goffA[i_] & 3) * 8; \
      __builtin_amdgcn_global_load_lds((const unsigned*)ga_, (LASP unsigned*)(ldsl + (st) * 24576 + (2 * w + i_) * 1024), 16, 0, 0); } \
    _Pragma("unroll") for (int i_ = 0; i_ < 4; ++i_) { \
      const bf16_t* gb_ = Bt + (size_t)n0 * K + goffB[i_] + k0_; \
      __builtin_amdgcn_global_load_lds((const unsigned*)gb_, (LASP unsigned*)(ldsl + (st) * 24576 + 8192 + (4 * w + i_) * 1024), 16, 0, 0); } } while (0)
  const int xr = (l31 >> 2) & 3;
  int coff[2];
#pragma unroll
  for (int s = 0; s < 2; ++s) coff[s] = ((2 * s + h) ^ xr) * 16;
#define G2_COMPUTE(st) do { const char* as = lds + (st) * 24576; const char* bs = as + 8192; \
    bf16x8 af[2][2], wf[2][4]; \
    _Pragma("unroll") for (int s = 0; s < 2; ++s) { \
      _Pragma("unroll") for (int mf = 0; mf < 2; ++mf) af[s][mf] = *(const bf16x8*)(as + (wr * 64 + mf * 32 + l31) * 64 + coff[s]); \
      _Pragma("unroll") for (int nf = 0; nf < 4; ++nf) wf[s][nf] = *(const bf16x8*)(bs + (wc * 128 + nf * 32 + l31) * 64 + coff[s]); } \
    __builtin_amdgcn_sched_barrier(0); __builtin_amdgcn_s_setprio(1); \
    _Pragma("unroll") for (int s = 0; s < 2; ++s) \
      _Pragma("unroll") for (int mf = 0; mf < 2; ++mf) _Pragma("unroll") for (int nf = 0; nf < 4; ++nf) acc[mf][nf] = MFMA32(wf[s][nf], af[s][mf], acc[mf][nf]); \
    __builtin_amdgcn_s_setprio(0); __builtin_amdgcn_sched_barrier(0); } while (0)
  G2_ISSUE(0, 0);
  for (int kt = 0; kt < nk; kt += 2) {
    asm volatile("s_waitcnt vmcnt(0)" ::: "memory"); __syncthreads();
    G2_ISSUE(kt + 1, 1);
    G2_COMPUTE(0);
    asm volatile("s_waitcnt vmcnt(0)" ::: "memory"); __syncthreads();
    if (kt + 2 < nk) G2_ISSUE(kt + 2, 0);
    G2_COMPUTE(1);
  }
  __syncthreads();
#pragma unroll
  for (int hf = 0; hf < 2; ++hf) {
    f32x16 t[2][2];
#pragma unroll
    for (int mf = 0; mf < 2; ++mf) { t[mf][0] = acc[mf][2 * hf]; t[mf][1] = acc[mf][2 * hf + 1]; }
    epi(t, m0 + wr * 64, n0 + wc * 128 + hf * 64, n0, wc, l31, h);
  }
  __syncthreads();
#undef G2_ISSUE
#undef G2_COMPUTE
}

template <class Epi>
DI void gemm_phase2(char* lds, const ASrc& A, const bf16_t* Bt, int K, int ntn, const Epi& epi) {
  const int xcd = blockIdx.x & 7, j = blockIdx.x >> 3, nloc = gridDim.x >> 3, per = 48 * ntn, grp = 8 * ntn;
  for (int li = j; li < per; li += nloc) {
    const int sg = li / grp, wi = li - sg * grp, nt = wi >> 3, mt = xcd * 48 + sg * 8 + (wi & 7);
    gemm_tile2(lds, A, Bt, K, mt * 128, nt * 256, epi);
  }
}

template <int MODE>
DI void attn3_item(char* lds, const Params& p, int layer, int seq, int head, int qt) {
  const int tid = opaque(threadIdx.x), lane = tid & 63, w = tid >> 6, l31 = lane & 31, h = lane >> 5;
  layer = opaque_s(layer); seq = opaque_s(seq); head = opaque_s(head); qt = opaque_s(qt);
  int row0, T; seq_info(seq, row0, T);
  const int QC = (MODE == 0 ? A_Q : C_Q) + head * 64;
  const int KC = MODE == 0 ? A_K + (head >> 1) * 64 : C_K + head * 64;
  const int VC = MODE == 0 ? A_V + (head >> 1) * 64 : C_V + head * 64;
  const int qw0 = qt * 256 + w * 64;
  bf16x8 qf[2][4];
#pragma unroll
  for (int qi = 0; qi < 2; ++qi)
#pragma unroll
    for (int s = 0; s < 4; ++s) qf[qi][s] = *(const bf16x8*)(p.z + (size_t)(row0 + qw0 + qi * 32 + l31) * NIN + QC + s * 16 + h * 8);
  const int srow = tid >> 3, sc8 = tid & 7;
  const bf16_t* kbase = p.z + (size_t)(row0 + srow) * NIN + KC + sc8 * 8;
  const bf16_t* vbase = p.z + (size_t)(row0 + srow) * NIN + VC + sc8 * 8;
  u32x4 rk[2], rv[2];
  const int nt = T >> 6;
  const int prow = (l31 & 19) | ((l31 & 4) << 1) | ((l31 & 8) >> 1);
#define A3_GLOAD(t) do { _Pragma("unroll") for (int i_ = 0; i_ < 2; ++i_) { const size_t off_ = (size_t)((t) * 64 + 32 * i_) * NIN; rk[i_] = *(const u32x4*)(kbase + off_); rv[i_] = *(const u32x4*)(vbase + off_); } } while (0)
#define A3_LSTORE(buf) do { char* ks_ = lds + (buf) * 18432; char* vs_ = ks_ + 9216; \
    _Pragma("unroll") for (int i_ = 0; i_ < 2; ++i_) { *(u32x4*)(ks_ + (srow + 32 * i_) * PITCH + sc8 * 16) = rk[i_]; *(u32x4*)(vs_ + (srow + 32 * i_) * PITCH + sc8 * 16) = rv[i_]; } } while (0)
  f32x16 o[2][2];
  float m_run[2], l_run[2];
#pragma unroll
  for (int a = 0; a < 2; ++a) { m_run[a] = -INFINITY; l_run[a] = 0.f;
#pragma unroll
    for (int b = 0; b < 2; ++b)
#pragma unroll
      for (int i = 0; i < 16; ++i) o[a][b][i] = 0.f; }
  float lf = 0.f, lb = 0.f;
  if (MODE == 2) { lf = log2f(1.0f - exp2f(-5.0f - (float)head)); lb = log2f(1.0f - exp2f(-5.0f - (float)(3 - head))); }
  A3_GLOAD(0); A3_LSTORE(0); __syncthreads();
#pragma unroll 1
  for (int t = 0; t < nt; ++t) {
    if (t + 1 < nt) A3_GLOAD(t + 1);
    const char* ks = lds + (t & 1) * 18432; const char* vs = ks + 9216;
    f32x16 st[2][2];
#pragma unroll
    for (int kf = 0; kf < 2; ++kf) {
#pragma unroll
      for (int qi = 0; qi < 2; ++qi)
#pragma unroll
        for (int i = 0; i < 16; ++i) st[qi][kf][i] = 0.f;
#pragma unroll
      for (int s = 0; s < 4; ++s) { const bf16x8 kfr = *(const bf16x8*)(ks + (kf * 32 + prow) * PITCH + s * 32 + h * 16);
#pragma unroll
        for (int qi = 0; qi < 2; ++qi) st[qi][kf] = MFMA32(kfr, qf[qi][s], st[qi][kf]); }
    }
    __builtin_amdgcn_sched_barrier(0);
#pragma unroll
    for (int qi = 0; qi < 2; ++qi) {
      bf16x8 pf[4];
      if (MODE == 2) {
        const int k0 = t * 64, qb = qw0 + qi * 32;
        const float dbase = (float)(qb + l31 - k0 - 8 * h);
        if (k0 + 63 < qb) {
#pragma unroll
          for (int kf = 0; kf < 2; ++kf)
#pragma unroll
            for (int i = 0; i < 16; ++i) { const float cc = (float)(32 * kf + (i & 3) + 4 * ((i >> 2) & 1) + 16 * ((i >> 3) & 1)); st[qi][kf][i] *= fexp2(lf * (dbase - cc)); }
        } else if (k0 > qb + 31) {
#pragma unroll
          for (int kf = 0; kf < 2; ++kf)
#pragma unroll
            for (int i = 0; i < 16; ++i) { const float cc = (float)(32 * kf + (i & 3) + 4 * ((i >> 2) & 1) + 16 * ((i >> 3) & 1)); st[qi][kf][i] *= fexp2(lb * (cc - dbase)); }
        } else {
#pragma unroll
          for (int kf = 0; kf < 2; ++kf)
#pragma unroll
            for (int i = 0; i < 16; ++i) { const float cc = (float)(32 * kf + (i & 3) + 4 * ((i >> 2) & 1) + 16 * ((i >> 3) & 1)); const float d = dbase - cc;
              float dd = fexp2(fminf(lf * d, -lb * d)); if (d == 0.f) dd = 2.0f; st[qi][kf][i] *= dd; }
        }
      } else {
        float mx = st[qi][0][0];
#pragma unroll
        for (int kf = 0; kf < 2; ++kf)
#pragma unroll
          for (int i = 0; i < 16; ++i) mx = fmaxf(mx, st[qi][kf][i]);
        mx = fmaxf(mx, __shfl_xor(mx, 32));
        const float mn = fmaxf(m_run[qi], mx); const float alpha = fexp2(m_run[qi] - mn); m_run[qi] = mn;
        float ps = 0.f;
#pragma unroll
        for (int kf = 0; kf < 2; ++kf)
#pragma unroll
          for (int i = 0; i < 16; ++i) { st[qi][kf][i] = fexp2(st[qi][kf][i] - mn); ps += st[qi][kf][i]; }
        l_run[qi] = l_run[qi] * alpha + ps;
#pragma unroll
        for (int df = 0; df < 2; ++df) o[qi][df] *= alpha;
      }
#pragma unroll
      for (int kf = 0; kf < 2; ++kf)
#pragma unroll
        for (int s2 = 0; s2 < 2; ++s2) { u32x4 u; u.x = pk(st[qi][kf][8 * s2], st[qi][kf][8 * s2 + 1]); u.y = pk(st[qi][kf][8 * s2 + 2], st[qi][kf][8 * s2 + 3]);
          u.z = pk(st[qi][kf][8 * s2 + 4], st[qi][kf][8 * s2 + 5]); u.w = pk(st[qi][kf][8 * s2 + 6], st[qi][kf][8 * s2 + 7]); pf[kf * 2 + s2] = __builtin_bit_cast(bf16x8, u); }
#pragma unroll
      for (int df = 0; df < 2; ++df)
#pragma unroll
        for (int ksx = 0; ksx < 4; ++ksx) { const bf16x8 vfr = *(const bf16x8*)(vs + (df * 32 + l31) * PITCH + ksx * 32 + h * 16); o[qi][df] = MFMA32(vfr, pf[ksx], o[qi][df]); }
      __builtin_amdgcn_sched_barrier(0);
    }
    __builtin_amdgcn_sched_barrier(0);
    if (t + 1 < nt) A3_LSTORE((t + 1) & 1);
    __syncthreads();
  }
#undef A3_GLOAD
#undef A3_LSTORE
#pragma unroll
  for (int qi = 0; qi < 2; ++qi) {
    const int qrow = row0 + qw0 + qi * 32 + l31;
    bf16_t* zq = p.z + (size_t)qrow * NIN + QC;
    f32x16 r[2];
    if (MODE == 0) {
      const float l = l_run[qi] + __shfl_xor(l_run[qi], 32); const float inv = 1.0f / l;
#pragma unroll
      for (int df = 0; df < 2; ++df) r[df] = o[qi][df] * inv;
    } else {
      float ss = 0.f;
#pragma unroll
      for (int df = 0; df < 2; ++df)
#pragma unroll
        for (int i = 0; i < 16; ++i) ss += o[qi][df][i] * o[qi][df][i];
      ss += __shfl_xor(ss, 32);
      const float rs = rsqrtf(ss * (1.0f / 64.0f) + EPS);
      const float* gg = p.in[I_CGN] + layer * 256 + head * 64;
      const bf16_t* zg = p.z + (size_t)qrow * NIN + C_G + head * 64;
#pragma unroll
      for (int df = 0; df < 2; ++df)
#pragma unroll
        for (int g = 0; g < 4; ++g) { const u32x2 gw = *(const u32x2*)(zg + df * 32 + 8 * g + 4 * h);
          const float gv[4] = {bflo(gw.x), bfhi(gw.x), bflo(gw.y), bfhi(gw.y)};
#pragma unroll
          for (int e = 0; e < 4; ++e) { const float x = gv[e]; r[df][4 * g + e] = o[qi][df][4 * g + e] * rs * gg[df * 32 + 8 * g + 4 * h + e] * (x / (1.0f + __expf(-x))); } }
    }
#pragma unroll
    for (int df = 0; df < 2; ++df)
#pragma unroll
      for (int g = 0; g < 4; ++g) { u32x2 v; v.x = pk(r[df][4 * g], r[df][4 * g + 1]); v.y = pk(r[df][4 * g + 2], r[df][4 * g + 3]); *(u32x2*)(zq + df * 32 + 8 * g + 4 * h) = v; }
  }
}

DI void ctr_barrier(unsigned* cnt) {
  asm volatile("s_waitcnt vmcnt(0) lgkmcnt(0)" ::: "memory");
  __syncthreads();
  if (threadIdx.x == 0) {
    __builtin_amdgcn_fence(__ATOMIC_RELEASE, "agent");
    asm volatile("s_waitcnt vmcnt(0)" ::: "memory");
    const unsigned G = gridDim.x;
    const unsigned old = __hip_atomic_fetch_add(cnt, 1u, __ATOMIC_RELAXED, __HIP_MEMORY_SCOPE_AGENT);
    const unsigned gen = old / G + 1u;
    if (old + 1u == gen * G) __hip_atomic_store(cnt + 64, gen, __ATOMIC_RELAXED, __HIP_MEMORY_SCOPE_AGENT);
    else while (__hip_atomic_load(cnt + 64, __ATOMIC_RELAXED, __HIP_MEMORY_SCOPE_AGENT) < gen) __builtin_amdgcn_s_sleep(1);
    __builtin_amdgcn_fence(__ATOMIC_ACQUIRE, "agent");
    asm volatile("s_waitcnt vmcnt(0)" ::: "memory");
  }
  __syncthreads();
}

DI int next_item(int* ctr, int* sh) {
  __syncthreads();
  if (threadIdx.x == 0) *sh = atomicAdd(ctr, 1);
  __syncthreads();
  return *sh;
}

__global__ void __launch_bounds__(256, 2) fwd(Params p) {
  extern __shared__ __attribute__((aligned(16))) char lds[];
  __shared__ int s_item;
  cg::grid_group grid = cg::this_grid();
  const int bid = blockIdx.x, nb = gridDim.x, tid = threadIdx.x, lane = tid & 63, w = tid >> 6;
  if (bid == 0) p.ctr[tid] = 0;
  for (int i = bid * 256 + tid; i < 4096 * 32; i += nb * 256) { const int t = i >> 5, j = i & 31; const float inv = powf(10000.0f, -(float)(2 * j) / 64.0f); float sn, cs; sincosf((float)t * inv, &sn, &cs); p.tabC[i] = (f32x2){cs, sn}; }
  for (int i = bid * 256 + tid; i < 4096 * 4; i += nb * 256) { const int t = i >> 2, j = i & 3; const float inv = powf(500000.0f, -(float)(2 * j) / 8.0f); float sn, cs; sincosf((float)t * inv, &sn, &cs); p.tabB[i] = (f32x2){cs, sn}; }
  for (int i = bid * 256 + tid; i < 64 * 16; i += nb * 256) { const int t = i >> 4, j = i & 15; const float inv = powf(10000.0f, -(float)(2 * j) / 32.0f); float sn, cs; sincosf((float)t * inv, &sn, &cs); p.tabA[i] = (f32x2){cs, sn}; }
  for (int l = 0; l < 2; ++l) {
    for (int i = bid * 256 + tid; i < (NINP - NIN) * 1024; i += nb * 256) p.wtin[(size_t)l * NINP * 1024 + (size_t)NIN * 1024 + i] = 0;
    for (int tl = bid; tl < 16 * 53; tl += nb) conv_T(lds, p.in[I_WIN] + (size_t)l * 1024 * NIN, 1024, NIN, p.wtin + (size_t)l * NINP * 1024, 0, tl);
    for (int tl = bid; tl < 16 * 16; tl += nb) conv_T(lds, p.in[I_WOUT] + (size_t)l * 1024 * 1024, 1024, 1024, p.wtout + (size_t)l * 1024 * 1024, 0, tl);
  }
  bf16_t* hb = p.pl;
  for (int row = bid * 4 + opaque(w); row < MT; row += nb * 4) {
    const float* xin = row < M0 ? p.in[I_XP] + (size_t)row * 1024 : p.in[I_XS] + (size_t)(row - M0) * 1024;
    row_phase(xin, p.out + (size_t)row * 1024, nullptr, nullptr, p.in[I_NMPRE], hb + (size_t)row * 1024, lane);
  }
  grid.sync();
  for (int l = 0; l < 2; ++l) {
    { ASrc A; A.b0 = hb; A.b1 = hb; A.b2 = hb; A.b3 = hb; A.s0 = A.s1 = A.s2 = A.s3 = 1024; A.shift = 12;
      EpiIn e; e.z = p.z; e.lds = lds; e.qg = p.in[I_AQG] + l * 64; e.kg = p.in[I_AKG] + l * 64; e.tabA = p.tabA; e.tabB = p.tabB; e.tabC = p.tabC;
      gemm_phase2(lds, A, p.wtin + (size_t)l * NINP * 1024, 1024, 14, e); }
    ctr_barrier((unsigned*)p.ctr + 96);
    for (int it = bid; it < MT / DTOK; it += nb) dprep_item(lds, p, l, it);
    ctr_barrier((unsigned*)p.ctr + 96);
    for (;;) {
      const int it = next_item(p.ctr + l * 16, &s_item);
      if (it >= 256 + 2048 + 1024) break;
      if (it < 256) { const int i2 = it >> 1; const int sq = i2 < 64 ? (i2 >> 3) : 8 + ((i2 - 64) >> 3); rwkv_item(lds, p, sq, (i2 >> 1) & 3, i2 & 1, it & 1); }
      else {
        int j = it - 256;
        if (j < 2048) {
          if (j < 1024) attn_item<1>(lds, p, l, j >> 7, (j >> 5) & 3, j & 31);
          else { const int r = (j - 1024) & 511; if (j < 1536) attn3_item<2>(lds, p, l, r >> 6, (r >> 4) & 3, r & 15); else attn3_item<0>(lds, p, l, r >> 6, (r >> 4) & 3, r & 15); }
        } else { j -= 2048;
          if (j < 512) attn_item<1>(lds, p, l, 8 + (j >> 6), (j >> 4) & 3, j & 15);
          else { const int r = (j - 512) & 255; if (j < 768) attn3_item<2>(lds, p, l, 8 + (r >> 5), (r >> 3) & 3, r & 7); else attn3_item<0>(lds, p, l, 8 + (r >> 5), (r >> 3) & 3, r & 7); }
        }
      }
    }
    ctr_barrier((unsigned*)p.ctr + 96);
    bf16_t* wtgu = p.pl + 5 * PLANE; bf16_t* wtd = wtgu + (size_t)2 * DFF * 1024;
    for (int it = bid; it < MT / DTOK + 3 * 704; it += nb) {
      if (it < MT / DTOK) dpost_item(lds, p, l, it);
      else { const int j = it - MT / DTOK;
        if (j < 704) conv_T(lds, p.in[I_FG] + (size_t)l * 1024 * DFF, 1024, DFF, wtgu, 1, j);
        else if (j < 1408) conv_T(lds, p.in[I_FU] + (size_t)l * 1024 * DFF, 1024, DFF, wtgu, 2, j - 704);
        else conv_T(lds, p.in[I_FD] + (size_t)l * DFF * 1024, DFF, 1024, wtd, 0, j - 1408); }
    }
    ctr_barrier((unsigned*)p.ctr + 96);
    { ASrc A; A.b0 = p.z + A_Q; A.b1 = p.z + B_Q; A.b2 = p.z + C_Q; A.b3 = p.pl + 4 * PLANE; A.s0 = A.s1 = A.s2 = NIN; A.s3 = 256; A.shift = 8;
      EpiStore e; e.out = hb; e.ldc = 1024; e.nmax = 1024;
      gemm_phase2(lds, A, p.wtout + (size_t)l * 1024 * 1024, 1024, 4, e); }
    ctr_barrier((unsigned*)p.ctr + 96);
    for (int row = bid * 4 + opaque(w); row < MT; row += nb * 8) { const int rb = row + nb * 4;
      if (rb < MT) row_phase2(p.out + (size_t)row * 1024, p.out + (size_t)rb * 1024, p.out + (size_t)row * 1024, p.out + (size_t)rb * 1024, hb + (size_t)row * 1024, hb + (size_t)rb * 1024,
                              p.in[I_NMPOST] + l * 1024, p.in[I_NFPRE] + l * 1024, hb + (size_t)row * 1024, hb + (size_t)rb * 1024, lane);
      else row_phase(p.out + (size_t)row * 1024, p.out + (size_t)row * 1024, hb + (size_t)row * 1024, p.in[I_NMPOST] + l * 1024, p.in[I_NFPRE] + l * 1024, hb + (size_t)row * 1024, lane); }
    ctr_barrier((unsigned*)p.ctr + 96);
    { ASrc A; A.b0 = hb; A.b1 = hb; A.b2 = hb; A.b3 = hb; A.s0 = A.s1 = A.s2 = A.s3 = 1024; A.shift = 12;
      EpiSwiGLU e; e.out = p.z;
      gemm_phase2(lds, A, wtgu, 1024, 22, e); }
    ctr_barrier((unsigned*)p.ctr + 96);
    { ASrc A; A.b0 = p.z; A.b1 = p.z; A.b2 = p.z; A.b3 = p.z; A.s0 = A.s1 = A.s2 = A.s3 = DFF; A.shift = 12;
      EpiStore e; e.out = hb; e.ldc = 1024; e.nmax = 1024;
      gemm_phase2(lds, A, wtd, DFF, 4, e); }
    ctr_barrier((unsigned*)p.ctr + 96);
    for (int row = bid * 4 + opaque(w); row < MT; row += nb * 8) { const int rb = row + nb * 4; const float* gp2 = l == 0 ? p.in[I_NMPRE] + 1024 : nullptr;
      if (rb < MT) row_phase2(p.out + (size_t)row * 1024, p.out + (size_t)rb * 1024, p.out + (size_t)row * 1024, p.out + (size_t)rb * 1024, hb + (size_t)row * 1024, hb + (size_t)rb * 1024,
                              p.in[I_NFPOST] + l * 1024, gp2, hb + (size_t)row * 1024, hb + (size_t)rb * 1024, lane);
      else row_phase(p.out + (size_t)row * 1024, p.out + (size_t)row * 1024, hb + (size_t)row * 1024, p.in[I_NFPOST] + l * 1024, gp2, hb + (size_t)row * 1024, lane); }
    if (l == 0) ctr_barrier((unsigned*)p.ctr + 96);
  }
}

extern "C" void kernel_launch(void* const* d_in, const int* in_sizes, int n_in, void* d_out, int out_size,
                              void* d_ws, size_t ws_size, hipStream_t stream) {
  static int grid_blocks = 0;
  if (!grid_blocks) {
    int dev = 0, cus = 0, per_cu = 0;
    hipGetDevice(&dev);
    hipDeviceGetAttribute(&cus, hipDeviceAttributeMultiprocessorCount, dev);
    hipFuncSetAttribute((const void*)fwd, hipFuncAttributeMaxDynamicSharedMemorySize, LDS_BYTES);
    hipOccupancyMaxActiveBlocksPerMultiprocessor(&per_cu, fwd, 256, LDS_BYTES);
    if (per_cu > 2) per_cu = 2;
    if (per_cu < 1) per_cu = 1;
    grid_blocks = cus * per_cu;
  }
  Params p{};
  for (int i = 0; i < 28; ++i) p.in[i] = (const float*)d_in[i];
  p.out = (float*)d_out;
  char* ws = (char*)d_ws;
  size_t off = 0;
  p.z = (bf16_t*)(ws + off); off += (size_t)MT * NIN * 2;
  p.pl = (bf16_t*)(ws + off); off += 7 * PLANE * 2;
  p.wtin = (bf16_t*)(ws + off); off += (size_t)2 * NINP * 1024 * 2;
  p.wtout = (bf16_t*)(ws + off); off += (size_t)2 * 1024 * 1024 * 2;
  p.tabC = (f32x2*)(ws + off); off += (size_t)4096 * 32 * 8;
  p.tabB = (f32x2*)(ws + off); off += (size_t)4096 * 4 * 8;
  p.tabA = (f32x2*)(ws + off); off += (size_t)64 * 16 * 8;
  p.ctr = (int*)(ws + off); off += 1024;
  if (off > ws_size) fprintf(stderr, "workspace too small: need %zu have %zu\n", off, ws_size);
  void* args[] = {&p};
  hipError_t e = hipLaunchCooperativeKernel((void*)fwd, dim3(grid_blocks), dim3(256), args, LDS_BYTES, stream);
  if (e != hipSuccess) fprintf(stderr, "coop launch failed: %s (grid %d)\n", hipGetErrorString(e), grid_blocks);
}
```

```cpp
#include <hip/hip_runtime.h>
#include <hip/hip_cooperative_groups.h>
#include <cstdio>
#include <cstdint>
namespace cg = cooperative_groups;

#define DI __device__ __forceinline__
typedef unsigned short bf16_t;
typedef short bf16x8 __attribute__((ext_vector_type(8)));
typedef float f32x2 __attribute__((ext_vector_type(2)));
typedef float f32x4 __attribute__((ext_vector_type(4)));
typedef float f32x16 __attribute__((ext_vector_type(16)));
typedef unsigned u32x2 __attribute__((ext_vector_type(2)));
typedef unsigned u32x4 __attribute__((ext_vector_type(4)));
typedef __bf16 bf16x2_t __attribute__((ext_vector_type(2)));

constexpr int M0 = 32768, MT = 49152, DM = 1024, NIN = 3392, NINP = 3584, DFF = 2816;
constexpr int A_Q = 0, A_K = 256, A_V = 384, B_Q = 512, B_K = 768, B_V = 1024, C_Q = 1280, C_K = 1536, C_V = 1792, C_G = 2048, D_0 = 2304;
constexpr int PITCH = 144;
constexpr size_t PLANE = (size_t)MT * 256;
constexpr int LDS_BYTES = 73728;
constexpr float LOG2E = 1.4426950408889634f;
constexpr float EPS = 1e-6f;

enum { I_XP = 0, I_XS, I_NMPRE, I_NMPOST, I_NFPRE, I_NFPOST, I_WIN, I_WOUT, I_AQG, I_AKG, I_BLAM, I_BSUB, I_CGN, I_DMUP, I_DMUN, I_DW0, I_DWUP,
       I_DA0, I_DAUP, I_DGUP, I_DKK, I_DKA, I_DRK, I_DGNW, I_DGNB, I_FG, I_FU, I_FD };

struct Params {
  const float* in[28];
  float* out;
  bf16_t* z;
  bf16_t* pl;
  bf16_t* wtin;
  bf16_t* wtout;
  f32x2* tabC;
  f32x2* tabB;
  f32x2* tabA;
  int* ctr;
};

DI int opaque(int x) { asm volatile("" : "+v"(x)); return x; }
DI int opaque_s(int x) { asm volatile("" : "+s"(x)); return x; }
DI float bf2f(bf16_t v) { return __uint_as_float(((unsigned)v) << 16); }
DI float bflo(unsigned w) { return __uint_as_float(w << 16); }
DI float bfhi(unsigned w) { return __uint_as_float(w & 0xffff0000u); }
DI unsigned pk(float lo, float hi) { f32x2 v = {lo, hi}; bf16x2_t b = __builtin_convertvector(v, bf16x2_t); return __builtin_bit_cast(unsigned, b); }
DI bf16_t f2bf(float x) { return (bf16_t)(pk(x, 0.f) & 0xffffu); }
DI float dppf(float x, const int ctrl) { return x; }
#define DPPF(x, ctrl) __int_as_float(__builtin_amdgcn_update_dpp(0, __float_as_int(x), (ctrl), 0xF, 0xF, true))
DI float wave_sum(float v) {
  v += DPPF(v, 0xB1);
  v += DPPF(v, 0x4E);
  v += DPPF(v, 0x141);
  v += DPPF(v, 0x140);
  const int vi = __float_as_int(v);
  return (__int_as_float(__builtin_amdgcn_readlane(vi, 0)) + __int_as_float(__builtin_amdgcn_readlane(vi, 16))) +
         (__int_as_float(__builtin_amdgcn_readlane(vi, 32)) + __int_as_float(__builtin_amdgcn_readlane(vi, 48)));
}
DI float dpp_xor1(float x) { return __int_as_float(__builtin_amdgcn_update_dpp(0, __float_as_int(x), 0xB1, 0xF, 0xF, true)); }
DI float dpp_xor2(float x) { return __int_as_float(__builtin_amdgcn_update_dpp(0, __float_as_int(x), 0x4E, 0xF, 0xF, true)); }
DI float dpp_hmir(float x) { return __int_as_float(__builtin_amdgcn_update_dpp(0, __float_as_int(x), 0x141, 0xF, 0xF, true)); }
DI float red8(float x) { x += dpp_xor1(x); x += dpp_xor2(x); x += dpp_hmir(x); return x; }
DI float fexp2(float x) { return __builtin_amdgcn_exp2f(x); }
DI void seq_info(int s, int& row0, int& T) { if (s < 8) { row0 = s * 4096; T = 4096; } else { row0 = M0 + (s - 8) * 2048; T = 2048; } }
DI void row_info(int r, int& t, int& T) { if (r < M0) { t = r & 4095; T = 4096; } else { t = (r - M0) & 2047; T = 2048; } }
#define MFMA32(a, b, c) __builtin_amdgcn_mfma_f32_32x32x16_bf16((a), (b), (c), 0, 0, 0)

DI void conv_T(char* lds, const float* __restrict__ W, int K, int N, bf16_t* __restrict__ Wt, int mode, int tile) {
  float* t = (float*)lds;
  const int tid0 = opaque(threadIdx.x);
  const int ntn = N >> 6, kt = tile / ntn, nt = tile - kt * ntn, k0 = kt << 6, n0 = nt << 6;
  float wv[16];
#pragma unroll
  for (int i = 0; i < 16; ++i) { const int idx = tid0 + 256 * i, k = idx >> 6, n = idx & 63; wv[i] = W[(size_t)(k0 + k) * N + n0 + n]; }
#pragma unroll
  for (int i = 0; i < 16; ++i) { const int idx = tid0 + 256 * i, k = idx >> 6, n = idx & 63; t[k * 65 + n] = wv[i]; }
  __syncthreads();
#pragma unroll 4
  for (int i = 0; i < 8; ++i) {
    const int idx = tid0 + 256 * i, n = idx >> 5, k = (idx & 31) * 2, j = n0 + n;
    const int rho = (mode == 0) ? j : ((j >> 6) * 128 + ((j >> 5) & 1) * 64 + (mode - 1) * 32 + (j & 31));
    *(unsigned*)(Wt + (size_t)rho * K + k0 + k) = pk(t[k * 65 + n], t[(k + 1) * 65 + n]);
  }
  __syncthreads();
}

DI void row_phase(const float* __restrict__ xin, float* __restrict__ xout, const bf16_t* addsrc, const float* __restrict__ gpost,
                  const float* __restrict__ gpre, bf16_t* hout, int lane_in) {
  const int lane = opaque(lane_in);
  f32x4 x[4];
#pragma unroll
  for (int i = 0; i < 4; ++i) x[i] = *(const f32x4*)(xin + i * 256 + lane * 4);
  if (addsrc) {
    f32x4 m[4]; float ss = 0.f;
#pragma unroll
    for (int i = 0; i < 4; ++i) { const u32x2 w = *(const u32x2*)(addsrc + i * 256 + lane * 4); m[i] = (f32x4){bflo(w.x), bfhi(w.x), bflo(w.y), bfhi(w.y)};
      ss += m[i][0] * m[i][0] + m[i][1] * m[i][1] + m[i][2] * m[i][2] + m[i][3] * m[i][3]; }
    ss = wave_sum(ss); const float rs = rsqrtf(ss * (1.0f / 1024.0f) + EPS);
#pragma unroll
    for (int i = 0; i < 4; ++i) { const f32x4 g = *(const f32x4*)(gpost + i * 256 + lane * 4); x[i] += m[i] * rs * g; }
  }
#pragma unroll
  for (int i = 0; i < 4; ++i) *(f32x4*)(xout + i * 256 + lane * 4) = x[i];
  if (gpre) {
    float ss = 0.f;
#pragma unroll
    for (int i = 0; i < 4; ++i) ss += x[i][0] * x[i][0] + x[i][1] * x[i][1] + x[i][2] * x[i][2] + x[i][3] * x[i][3];
    ss = wave_sum(ss); const float rs = rsqrtf(ss * (1.0f / 1024.0f) + EPS);
#pragma unroll
    for (int i = 0; i < 4; ++i) { const f32x4 g = *(const f32x4*)(gpre + i * 256 + lane * 4); const f32x4 hv = x[i] * rs * g;
      u32x2 w; w.x = pk(hv[0], hv[1]); w.y = pk(hv[2], hv[3]); *(u32x2*)(hout + i * 256 + lane * 4) = w; }
  }
}

DI void row_phase2(const float* __restrict__ xinA, const float* __restrict__ xinB, float* __restrict__ xoutA, float* __restrict__ xoutB, const bf16_t* addA, const bf16_t* addB,
                   const float* __restrict__ gpost, const float* __restrict__ gpre, bf16_t* houtA, bf16_t* houtB, int lane_in) {
  const int lane = opaque(lane_in);
  f32x4 x[2][4]; u32x2 aw[2][4];
#pragma unroll
  for (int i = 0; i < 4; ++i) { x[0][i] = *(const f32x4*)(xinA + i * 256 + lane * 4); x[1][i] = *(const f32x4*)(xinB + i * 256 + lane * 4); }
  if (addA) {
#pragma unroll
    for (int i = 0; i < 4; ++i) { aw[0][i] = *(const u32x2*)(addA + i * 256 + lane * 4); aw[1][i] = *(const u32x2*)(addB + i * 256 + lane * 4); }
#pragma unroll
    for (int r = 0; r < 2; ++r) {
      f32x4 m[4]; float ss = 0.f;
#pragma unroll
      for (int i = 0; i < 4; ++i) { const u32x2 w = aw[r][i]; m[i] = (f32x4){bflo(w.x), bfhi(w.x), bflo(w.y), bfhi(w.y)};
        ss += m[i][0] * m[i][0] + m[i][1] * m[i][1] + m[i][2] * m[i][2] + m[i][3] * m[i][3]; }
      ss = wave_sum(ss); const float rs = rsqrtf(ss * (1.0f / 1024.0f) + EPS);
#pragma unroll
      for (int i = 0; i < 4; ++i) { const f32x4 g = *(const f32x4*)(gpost + i * 256 + lane * 4); x[r][i] += m[i] * rs * g; }
    }
  }
#pragma unroll
  for (int i = 0; i < 4; ++i) { *(f32x4*)(xoutA + i * 256 + lane * 4) = x[0][i]; *(f32x4*)(xoutB + i * 256 + lane * 4) = x[1][i]; }
  if (gpre) {
#pragma unroll
    for (int r = 0; r < 2; ++r) {
      float ss = 0.f;
#pragma unroll
      for (int i = 0; i < 4; ++i) ss += x[r][i][0] * x[r][i][0] + x[r][i][1] * x[r][i][1] + x[r][i][2] * x[r][i][2] + x[r][i][3] * x[r][i][3];
      ss = wave_sum(ss); const float rs = rsqrtf(ss * (1.0f / 1024.0f) + EPS);
      bf16_t* ho = r == 0 ? houtA : houtB;
#pragma unroll
      for (int i = 0; i < 4; ++i) { const f32x4 g = *(const f32x4*)(gpre + i * 256 + lane * 4); const f32x4 hv = x[r][i] * rs * g;
        u32x2 w; w.x = pk(hv[0], hv[1]); w.y = pk(hv[2], hv[3]); *(u32x2*)(ho + i * 256 + lane * 4) = w; }
    }
  }
}

struct ASrc { const bf16_t* b0; const bf16_t* b1; const bf16_t* b2; const bf16_t* b3; int s0, s1, s2, s3; int shift; };

struct EpiStore { bf16_t* out; int ldc; int nmax;
  DI void operator()(const f32x16 (&acc)[2][2], int mb, int nb, int n0, int wc, int l31, int h) const {
#pragma unroll
    for (int mf = 0; mf < 2; ++mf) { bf16_t* rp = out + (size_t)(mb + mf * 32 + l31) * ldc;
#pragma unroll
      for (int nf = 0; nf < 2; ++nf) { if (nb + nf * 32 < nmax) {
#pragma unroll
        for (int g = 0; g < 4; ++g) { u32x2 v; v.x = pk(acc[mf][nf][4 * g], acc[mf][nf][4 * g + 1]); v.y = pk(acc[mf][nf][4 * g + 2], acc[mf][nf][4 * g + 3]);
          *(u32x2*)(rp + nb + nf * 32 + 8 * g + 4 * h) = v; } } } }
  } };
struct EpiSwiGLU { bf16_t* out;
  DI void operator()(const f32x16 (&acc)[2][2], int mb, int nb, int n0, int wc, int l31, int h) const {
    const int hc = (nb >> 6) * 32;
#pragma unroll
    for (int mf = 0; mf < 2; ++mf) { bf16_t* rp = out + (size_t)(mb + mf * 32 + l31) * DFF + hc;
#pragma unroll
      for (int g = 0; g < 4; ++g) { float r[4];
#pragma unroll
        for (int e = 0; e < 4; ++e) { const float gt = acc[mf][0][4 * g + e], up = acc[mf][1][4 * g + e]; r[e] = gt / (1.0f + __expf(-gt)) * up; }
        u32x2 v; v.x = pk(r[0], r[1]); v.y = pk(r[2], r[3]); *(u32x2*)(rp + 8 * g + 4 * h) = v; } }
  } };

struct EpiIn { bf16_t* z; char* lds; const float* qg; const float* kg; const f32x2* tabA; const f32x2* tabB; const f32x2* tabC;
  DI void operator()(f32x16 (&acc)[2][2], int mb, int nb, int n0, int wc, int l31, int h) const {
    if (nb >= NIN) return;
    const bool isv = (nb >= A_V && nb < B_Q) || (nb >= B_V && nb < C_Q) || (nb >= C_V && nb < C_G);
    if (isv) {
      const int wv = (threadIdx.x >> 6);
      bf16_t* img = (bf16_t*)(lds + 32768 + wv * 9216);
#pragma unroll
      for (int mf = 0; mf < 2; ++mf)
#pragma unroll
        for (int nf = 0; nf < 2; ++nf)
#pragma unroll
          for (int i = 0; i < 16; ++i) { const int d = nf * 32 + (i & 3) + 8 * (i >> 2) + 4 * h; img[d * 72 + mf * 32 + l31] = f2bf(acc[mf][nf][i]); }
      __builtin_amdgcn_s_waitcnt(0xc07f);
      const int ln = l31 + 32 * h;
#pragma unroll
      for (int i = 0; i < 8; ++i) { const int q = ln + 64 * i, d = q >> 3, c8 = q & 7;
        const u32x4 v = *(const u32x4*)(img + d * 72 + c8 * 8); *(u32x4*)(z + (size_t)(mb + d) * NIN + nb + c8 * 8) = v; }
      return;
    }
#pragma unroll
    for (int mf = 0; mf < 2; ++mf) {
      const int row = mb + mf * 32 + l31; int t, T; row_info(row, t, T);
      if (nb < A_V) {
        const bool isq = nb < A_K; const float* gn = isq ? qg : kg;
        float ss = 0.f;
#pragma unroll
        for (int nf = 0; nf < 2; ++nf)
#pragma unroll
          for (int i = 0; i < 16; ++i) ss += acc[mf][nf][i] * acc[mf][nf][i];
        ss += __shfl_xor(ss, 32);
        const float rs = rsqrtf(ss * (1.0f / 64.0f) + EPS) * (isq ? 0.125f * LOG2E : 1.0f);
#pragma unroll
        for (int nf = 0; nf < 2; ++nf) {
          const int pos = nf == 0 ? (t >> 6) : (t & 63);
#pragma unroll
          for (int g = 0; g < 4; ++g)
#pragma unroll
            for (int e = 0; e < 4; ++e) acc[mf][nf][4 * g + e] *= rs * gn[nf * 32 + 8 * g + 4 * h + e];
#pragma unroll
          for (int g = 0; g < 2; ++g)
#pragma unroll
            for (int e = 0; e < 4; ++e) { const f32x2 cs = tabA[pos * 16 + 8 * g + 4 * h + e];
              const float x1 = acc[mf][nf][4 * g + e], x2 = acc[mf][nf][4 * (g + 2) + e];
              acc[mf][nf][4 * g + e] = x1 * cs.x - x2 * cs.y; acc[mf][nf][4 * (g + 2) + e] = x2 * cs.x + x1 * cs.y; }
        }
      } else if (nb >= B_Q && nb < B_V) {
        const bool isq = nb < B_K;
#pragma unroll
        for (int nf = 0; nf < 2; ++nf) {
#pragma unroll
          for (int e = 0; e < 4; ++e) { const f32x2 cs = tabB[t * 4 + e]; const float v = acc[mf][nf][e]; const float o = __shfl_xor(v, 32);
            acc[mf][nf][e] = (h == 0) ? (v * cs.x - o * cs.y) : (v * cs.x + o * cs.y); }
          if (isq) {
#pragma unroll
            for (int i = 0; i < 16; ++i) acc[mf][nf][i] *= 0.17677669529663687f * LOG2E; }
        }
      } else if (nb >= C_Q && nb < C_V) {
        const float sc = nb < C_K ? 1.0f : 0.125f;
#pragma unroll
        for (int g = 0; g < 4; ++g)
#pragma unroll
          for (int e = 0; e < 4; ++e) { const f32x2 cs = tabC[t * 32 + 8 * g + 4 * h + e]; const float x1 = acc[mf][0][4 * g + e], x2 = acc[mf][1][4 * g + e];
            acc[mf][0][4 * g + e] = (x1 * cs.x - x2 * cs.y) * sc; acc[mf][1][4 * g + e] = (x2 * cs.x + x1 * cs.y) * sc; }
      }
      bf16_t* rp = z + (size_t)row * NIN + nb;
#pragma unroll
      for (int nf = 0; nf < 2; ++nf)
#pragma unroll
        for (int g = 0; g < 4; ++g) { u32x2 v; v.x = pk(acc[mf][nf][4 * g], acc[mf][nf][4 * g + 1]); v.y = pk(acc[mf][nf][4 * g + 2], acc[mf][nf][4 * g + 3]);
          *(u32x2*)(rp + nf * 32 + 8 * g + 4 * h) = v; }
    }
  } };

#define LASP __attribute__((address_space(3)))
template <class Epi>
DI void gemm_tile(char* lds, const ASrc& A, const bf16_t* __restrict__ Bt, int K, int m0, int n0, const Epi& epi, bool first, bool has_next, int m0n, int n0n) {
  const int tid = opaque(threadIdx.x), lane = tid & 63, w = __builtin_amdgcn_readfirstlane(tid >> 6), wr = w >> 1, wc = w & 1, l31 = lane & 31, h = lane >> 5;
  const int nk = K >> 6, smask = (1 << A.shift) - 1;
  LASP char* ldsl = (LASP char*)lds;
  f32x16 acc[2][2];
#pragma unroll
  for (int a = 0; a < 2; ++a)
#pragma unroll
    for (int b = 0; b < 2; ++b)
#pragma unroll
      for (int i = 0; i < 16; ++i) acc[a][b][i] = 0.f;
  const int lrow = lane >> 3, lslot = lane & 7;
  int goffA[4], goffB[4];
#pragma unroll
  for (int i = 0; i < 4; ++i) { const int r = w * 32 + i * 8 + lrow, c = lslot ^ ((r >> 1) & 7); goffA[i] = r; goffB[i] = r * K + c * 8; goffA[i] = (goffA[i] << 3) | c; }
#define GEMM_ISSUE(kt, st, M0_, N0_) do { const int k0_ = (kt) << 6, seg_ = k0_ >> A.shift, kk_ = k0_ & smask; \
    const bf16_t* bp_ = seg_ == 0 ? A.b0 : seg_ == 1 ? A.b1 : seg_ == 2 ? A.b2 : A.b3; const int st_ = seg_ == 0 ? A.s0 : seg_ == 1 ? A.s1 : seg_ == 2 ? A.s2 : A.s3; \
    _Pragma("unroll") for (int i_ = 0; i_ < 4; ++i_) { \
      const bf16_t* ga_ = bp_ + (size_t)((M0_) + (goffA[i_] >> 3)) * st_ + kk_ + (goffA[i_] & 7) * 8; \
      __builtin_amdgcn_global_load_lds((const unsigned*)ga_, (LASP unsigned*)(ldsl + (st) * 32768 + (w * 4 + i_) * 1024), 16, 0, 0); \
      const bf16_t* gb_ = Bt + (size_t)(N0_) * K + goffB[i_] + k0_; \
      __builtin_amdgcn_global_load_lds((const unsigned*)gb_, (LASP unsigned*)(ldsl + (st) * 32768 + 16384 + (w * 4 + i_) * 1024), 16, 0, 0); } } while (0)
  const int xr = (l31 >> 1) & 7;
  int coff[4];
#pragma unroll
  for (int s = 0; s < 4; ++s) coff[s] = ((2 * s + h) ^ xr) * 16;
#define GEMM_COMPUTE(st) do { const char* as = lds + (st) * 32768; const char* bs = as + 16384; \
    bf16x8 af[4][2], wf[4][2]; \
    _Pragma("unroll") for (int s = 0; s < 4; ++s) { \
      _Pragma("unroll") for (int mf = 0; mf < 2; ++mf) af[s][mf] = *(const bf16x8*)(as + (wr * 64 + mf * 32 + l31) * 128 + coff[s]); \
      _Pragma("unroll") for (int nf = 0; nf < 2; ++nf) wf[s][nf] = *(const bf16x8*)(bs + (wc * 64 + nf * 32 + l31) * 128 + coff[s]); } \
    __builtin_amdgcn_sched_barrier(0); __builtin_amdgcn_s_setprio(1); \
    _Pragma("unroll") for (int s = 0; s < 4; ++s) \
      _Pragma("unroll") for (int mf = 0; mf < 2; ++mf) _Pragma("unroll") for (int nf = 0; nf < 2; ++nf) acc[mf][nf] = MFMA32(wf[s][nf], af[s][mf], acc[mf][nf]); \
    __builtin_amdgcn_s_setprio(0); __builtin_amdgcn_sched_barrier(0); } while (0)
  if (first) GEMM_ISSUE(0, 0, m0, n0);
  for (int kt = 0; kt < nk; kt += 2) {
    asm volatile("s_waitcnt vmcnt(0)" ::: "memory"); __syncthreads();
    GEMM_ISSUE(kt + 1, 1, m0, n0);
    GEMM_COMPUTE(0);
    asm volatile("s_waitcnt vmcnt(0)" ::: "memory"); __syncthreads();
    if (kt + 2 < nk) GEMM_ISSUE(kt + 2, 0, m0, n0);
    GEMM_COMPUTE(1);
  }
  __syncthreads();
  if (has_next) GEMM_ISSUE(0, 0, m0n, n0n);
  epi(acc, m0 + wr * 64, n0 + wc * 64, n0, wc, l31, h);
  __syncthreads();
#undef GEMM_ISSUE
#undef GEMM_COMPUTE
}

template <class Epi>
DI void gemm_phase(char* lds, const ASrc& A, const bf16_t* Bt, int K, int ntn, const Epi& epi) {
  const int xcd = blockIdx.x & 7, j = blockIdx.x >> 3, nloc = gridDim.x >> 3, per = 48 * ntn, grp = 8 * ntn;
  bool first = true;
  for (int li = j; li < per; li += nloc) {
    const int sg = li / grp, wi = li - sg * grp, nt = wi >> 3, mt = xcd * 48 + sg * 8 + (wi & 7);
    const int ln = li + nloc; const bool has_next = ln < per;
    const int sgn = ln / grp, win = ln - sgn * grp, ntn2 = win >> 3, mtn = xcd * 48 + sgn * 8 + (win & 7);
    gemm_tile(lds, A, Bt, K, mt * 128, nt * 128, epi, first, has_next, mtn * 128, ntn2 * 128);
    first = false;
  }
}

DI void prep_item(char* lds, const Params& p, int layer, int item) {
  const int tid = opaque(threadIdx.x), lane = tid & 63, w = tid >> 6;
  const int rowb = item * 64; int tb, T; row_info(rowb, tb, T);
  const float* qg = p.in[I_AQG] + layer * 64; const float* kg = p.in[I_AKG] + layer * 64;
  const float qgl = qg[lane], kgl = kg[lane];
  for (int tt = 0; tt < 16; ++tt) {
    const int row = rowb + w * 16 + tt, t = tb + w * 16 + tt;
    bf16_t* zr = p.z + (size_t)row * NIN;
    {
      const int j = lane & 31, i = j & 15; const bool first = j < 16; const int pos = (lane < 32) ? (t >> 6) : (t & 63);
      const f32x2 cs = p.tabA[pos * 16 + i];
#pragma unroll
      for (int hd = 0; hd < 6; ++hd) {
        bf16_t* ptr = zr + (hd < 4 ? A_Q + hd * 64 : A_K + (hd - 4) * 64) + lane;
        float v = bf2f(*ptr);
        const float ss = wave_sum(v * v);
        v = v * rsqrtf(ss * (1.0f / 64.0f) + EPS) * (hd < 4 ? qgl : kgl);
        const float o = __shfl_xor(v, 16);
        float r = first ? (v * cs.x - o * cs.y) : (v * cs.x + o * cs.y);
        if (hd < 4) r *= 0.125f * LOG2E;
        *ptr = f2bf(r);
      }
    }
    {
      const int d = lane & 31; const f32x2 cs = p.tabB[t * 4 + (d & 3)];
#pragma unroll
      for (int c = 0; c < 8; ++c) {
        bf16_t* ptr = zr + (c < 4 ? B_Q + c * 64 : B_K + (c - 4) * 64) + lane;
        float v = bf2f(*ptr);
        const float o = __shfl_xor(v, 4);
        float r = v;
        if (d < 8) r = (d < 4) ? (v * cs.x - o * cs.y) : (v * cs.x + o * cs.y);
        if (c < 4) r *= 0.17677669529663687f * LOG2E;
        *ptr = f2bf(r);
      }
    }
    {
      const f32x2 cs = p.tabC[t * 32 + (lane & 31)];
#pragma unroll
      for (int c = 0; c < 8; ++c) {
        bf16_t* ptr = zr + (c < 4 ? C_Q + c * 64 : C_K + (c - 4) * 64) + lane;
        const float v = bf2f(*ptr);
        const float o = __shfl_xor(v, 32);
        float r = (lane < 32) ? (v * cs.x - o * cs.y) : (v * cs.x + o * cs.y);
        if (c >= 4) r *= 0.125f;
        *ptr = f2bf(r);
      }
    }
  }
  bf16_t* tl = (bf16_t*)lds;
  const int r = tid >> 2, c0 = (tid & 3) * 16;
  for (int sl = 0; sl < 10; ++sl) {
    const int col = sl < 2 ? A_V + sl * 64 : sl < 6 ? B_V + (sl - 2) * 64 : C_V + (sl - 6) * 64;
    bf16_t* gp = p.z + (size_t)(rowb + r) * NIN + col + c0;
    const u32x4 v0 = *(const u32x4*)gp, v1 = *(const u32x4*)(gp + 8);
    __syncthreads();
#pragma unroll
    for (int e = 0; e < 4; ++e) {
      tl[(c0 + 2 * e) * 72 + r] = (bf16_t)(v0[e] & 0xffffu); tl[(c0 + 2 * e + 1) * 72 + r] = (bf16_t)(v0[e] >> 16);
      tl[(c0 + 8 + 2 * e) * 72 + r] = (bf16_t)(v1[e] & 0xffffu); tl[(c0 + 8 + 2 * e + 1) * 72 + r] = (bf16_t)(v1[e] >> 16);
    }
    __syncthreads();
    const u32x4 o0 = *(const u32x4*)(tl + r * 72 + c0), o1 = *(const u32x4*)(tl + r * 72 + c0 + 8);
    *(u32x4*)gp = o0; *(u32x4*)(gp + 8) = o1;
  }
  __syncthreads();
}

DI float dshift(const Params& p, const float* mup, const float* mun, int row, int t, int T, int dc) {
  const bf16_t* zp = p.z + (size_t)row * NIN + D_0 + dc;
  const float z = bf2f(*zp);
  const float zprev = (t > 0) ? bf2f(*(zp - NIN)) : 0.f;
  const float znext = (t < T - 1) ? bf2f(*(zp + NIN)) : 0.f;
  return z + mup[dc] * (zprev - z) + mun[dc] * (znext - z);
}
DI float sigmoidf_(float x) { return 1.0f / (1.0f + __expf(-x)); }
DI float omdecay(float ww) {
  const float e = 0.6065306597126334f / (1.0f + __expf(-ww));
  return 1.0f - __expf(-e);
}
DI float fast_tanh(float x) { const float xc = fminf(fmaxf(x, -15.f), 15.f); return 1.0f - 2.0f / (1.0f + __expf(2.0f * xc)); }
constexpr int DTOK = 16;
DI void dprep_item(char* lds, const Params& p, int layer, int item) {
  const int tid = opaque(threadIdx.x);
  const int rowb = item * DTOK; int tb, T; row_info(rowb, tb, T);
  const float* mup = p.in[I_DMUP] + layer * 1088; const float* mun = p.in[I_DMUN] + layer * 1088;
  float* su = (float*)lds;
  bf16_t* stg = (bf16_t*)(lds + 12288);
#pragma unroll
  for (int i = 0; i < 12; ++i) {
    const int idx = tid + 256 * i, tok = idx / 192, c = idx - tok * 192;
    float u = dshift(p, mup, mun, rowb + tok, tb + tok, T, 768 + c);
    if (c < 128) u = fast_tanh(u);
    su[c * DTOK + tok] = u;
  }
  __syncthreads();
  const int c = tid;
  const float w0f = p.in[I_DW0][(layer * 2 + 0) * 256 + c], w0b = p.in[I_DW0][(layer * 2 + 1) * 256 + c];
  const float a0 = p.in[I_DA0][layer * 256 + c], kkw = p.in[I_DKK][layer * 256 + c], kaw = p.in[I_DKA][layer * 256 + c];
  float zr[DTOK + 2], zk[DTOK + 2], zv[DTOK + 2];
  { const bf16_t* zp = p.z + (size_t)rowb * NIN + D_0 + c;
#pragma unroll
    for (int i = 0; i < DTOK + 2; ++i) { const int t = tb - 1 + i; const bool ok = (t >= 0) && (t < T); const bf16_t* q = zp + (ptrdiff_t)(i - 1) * NIN;
      zr[i] = ok ? bf2f(q[0]) : 0.f; zk[i] = ok ? bf2f(q[256]) : 0.f; zv[i] = ok ? bf2f(q[512]) : 0.f; } }
  const float mpr = mup[c], mnr = mun[c], mpk = mup[256 + c], mnk = mun[256 + c], mpv = mup[512 + c], mnv = mun[512 + c];
  float accf[DTOK], accb[DTOK], acca[DTOK];
#pragma unroll
  for (int k = 0; k < DTOK; ++k) { accf[k] = 0.f; accb[k] = 0.f; acca[k] = 0.f; }
  const float* wupf = p.in[I_DWUP] + (size_t)(layer * 2 + 0) * 64 * 256 + c;
  const float* wupb = p.in[I_DWUP] + (size_t)(layer * 2 + 1) * 64 * 256 + c;
  const float* aup = p.in[I_DAUP] + (size_t)layer * 64 * 256 + c;
#pragma unroll 2
  for (int j = 0; j < 64; ++j) {
    const float wf = wupf[j * 256], wb = wupb[j * 256], wa = aup[j * 256];
#pragma unroll
    for (int q = 0; q < 4; ++q) {
      const f32x4 f0 = *(const f32x4*)(su + j * DTOK + 4 * q), b0 = *(const f32x4*)(su + (64 + j) * DTOK + 4 * q), a0v = *(const f32x4*)(su + (128 + j) * DTOK + 4 * q);
#pragma unroll
      for (int k = 0; k < 4; ++k) { accf[4 * q + k] += f0[k] * wf; accb[4 * q + k] += b0[k] * wb; acca[4 * q + k] += a0v[k] * wa; }
    }
  }
#pragma unroll
  for (int k = 0; k < DTOK; ++k) {
    const float r = zr[k + 1] + mpr * (zr[k] - zr[k + 1]) + mnr * (zr[k + 2] - zr[k + 1]);
    const float kx = zk[k + 1] + mpk * (zk[k] - zk[k + 1]) + mnk * (zk[k + 2] - zk[k + 1]);
    const float v = zv[k + 1] + mpv * (zv[k] - zv[k + 1]) + mnv * (zv[k + 2] - zv[k + 1]);
    const float omf = omdecay(w0f + accf[k]), omb = omdecay(w0b + accb[k]);
    const float a = sigmoidf_(a0 + acca[k]);
    float kk = kx * kkw; const float n2 = wave_sum(kk * kk);
    kk = kk * rsqrtf(fmaxf(n2, 1e-24f));
    const float kmod = kx * (1.0f + (a - 1.0f) * kaw), b = kk * a;
    bf16_t* so = stg + k * 256 + c;
    so[0] = f2bf(r); so[DTOK * 256] = f2bf(kmod); so[2 * DTOK * 256] = f2bf(v); so[3 * DTOK * 256] = f2bf(-kk);
    so[4 * DTOK * 256] = f2bf(b); so[5 * DTOK * 256] = f2bf(omf); so[6 * DTOK * 256] = f2bf(omb);
  }
  __syncthreads();
#pragma unroll
  for (int i = 0; i < 14; ++i) {
    const int q = tid + 256 * i, pln = q >> 9, rem = q & 511, tok = rem >> 5, c16 = rem & 31;
    const u32x4 v = *(const u32x4*)(stg + pln * (DTOK * 256) + tok * 256 + c16 * 8);
    *(u32x4*)(p.pl + (size_t)pln * PLANE + (size_t)(rowb + tok) * 256 + c16 * 8) = v;
  }
  __syncthreads();
}

DI void dpost_item(char* lds, const Params& p, int layer, int item) {
  const int tid = opaque(threadIdx.x);
  const int rowb = item * DTOK; int tb, T; row_info(rowb, tb, T);
  const float* mup = p.in[I_DMUP] + layer * 1088; const float* mun = p.in[I_DMUN] + layer * 1088;
  float* sg = (float*)lds;
  bf16_t* stg = (bf16_t*)(lds + 8192);
#pragma unroll
  for (int i = 0; i < 8; ++i) { const int idx = tid + 256 * i, tok = idx >> 7, c = idx & 127; sg[c * DTOK + tok] = sigmoidf_(dshift(p, mup, mun, rowb + tok, tb + tok, T, 960 + c)); }
  __syncthreads();
  const int c = tid;
  float acc[DTOK];
#pragma unroll
  for (int k = 0; k < DTOK; ++k) acc[k] = 0.f;
  float yv[DTOK], rv_[DTOK], kmv[DTOK], vv_[DTOK];
#pragma unroll
  for (int k = 0; k < DTOK; ++k) { const int row = rowb + k; const bf16_t* zd = p.z + (size_t)row * NIN + D_0; const size_t o = (size_t)row * 256 + c;
    yv[k] = bf2f(zd[c]) + bf2f(zd[256 + c]); rv_[k] = bf2f(p.pl[o]); kmv[k] = bf2f(p.pl[PLANE + o]); vv_[k] = bf2f(p.pl[2 * PLANE + o]); }
  const float* gup = p.in[I_DGUP] + (size_t)layer * 128 * 256 + c;
#pragma unroll 4
  for (int j = 0; j < 128; ++j) { const float gw = gup[j * 256];
#pragma unroll
    for (int q = 0; q < 4; ++q) { const f32x4 s0 = *(const f32x4*)(sg + j * DTOK + 4 * q);
#pragma unroll
      for (int k = 0; k < 4; ++k) acc[4 * q + k] += s0[k] * gw; } }
  const float gnw = p.in[I_DGNW][layer * 256 + c], gnb = p.in[I_DGNB][layer * 256 + c], rk = p.in[I_DRK][layer * 256 + c];
#pragma unroll
  for (int k = 0; k < DTOK; ++k) {
    const float y = yv[k];
    const float mean = wave_sum(y) * (1.0f / 64.0f); const float d = y - mean; const float var = wave_sum(d * d) * (1.0f / 64.0f);
    const float yn = d * rsqrtf(var + 64e-5f) * gnw + gnb;
    const float r = rv_[k], km = kmv[k], v = vv_[k];
    const float bonus = wave_sum(r * km * rk);
    stg[k * 256 + c] = f2bf((yn + bonus * v) * acc[k]);
  }
  __syncthreads();
#pragma unroll
  for (int i = 0; i < 2; ++i) { const int q = tid + 256 * i, tok = q >> 5, c16 = q & 31;
    const u32x4 v = *(const u32x4*)(stg + tok * 256 + c16 * 8);
    *(u32x4*)(p.pl + 4 * PLANE + (size_t)(rowb + tok) * 256 + c16 * 8) = v; }
  __syncthreads();
}

DI void rwkv_item(char* lds, const Params& p, int seq, int head, int dir, int half) {
  int row0, T; seq_info(seq, row0, T);
  const int tid = opaque(threadIdx.x), kc = tid & 7, vrow = half * 32 + (tid >> 3);
  float* st = (float*)lds;
  f32x2 S[4];
#pragma unroll
  for (int j = 0; j < 4; ++j) S[j] = (f32x2){0.f, 0.f};
  const int nchunk = T >> 4;
  u32x4 rg[3];
  const int tsel = tid >> 7, srem = tid & 127, sstep = srem >> 3, sc8 = srem & 7;
#define RW_GLOAD(c) do { _Pragma("unroll") for (int i_ = 0; i_ < 3; ++i_) { const int tens_ = tsel + 2 * i_; \
      const int plane_ = tens_ == 0 ? (dir ? 6 : 5) : tens_ == 1 ? 3 : tens_ == 2 ? 4 : tens_ == 3 ? 1 : tens_ == 4 ? 0 : 2; \
      const int t_ = dir ? (T - 1 - ((c) * 16 + sstep)) : ((c) * 16 + sstep); \
      rg[i_] = *(const u32x4*)(p.pl + (size_t)plane_ * PLANE + (size_t)(row0 + t_) * 256 + head * 64 + sc8 * 8); } } while (0)
#define RW_LSTORE(buf) do { _Pragma("unroll") for (int i_ = 0; i_ < 3; ++i_) { const int tens_ = tsel + 2 * i_; \
      f32x4 a_ = {bflo(rg[i_].x), bfhi(rg[i_].x), bflo(rg[i_].y), bfhi(rg[i_].y)}, b_ = {bflo(rg[i_].z), bfhi(rg[i_].z), bflo(rg[i_].w), bfhi(rg[i_].w)}; \
      if (tens_ == 0) { a_ = 1.0f - a_; b_ = 1.0f - b_; } \
      float* d_ = st + (((buf) * 16 + sstep) * 6 + tens_) * 64 + sc8 * 8; *(f32x4*)d_ = a_; *(f32x4*)(d_ + 4) = b_; } } while (0)
  __builtin_amdgcn_s_setprio(3);
  RW_GLOAD(0); RW_LSTORE(0); __syncthreads();
  bf16_t* ybase = p.z + (size_t)row0 * NIN + D_0 + dir * 256 + head * 64 + vrow;
  for (int c = 0; c < nchunk; ++c) {
    if (c + 1 < nchunk) RW_GLOAD(c + 1);
    const float* sb = st + (c & 1) * (16 * 384);
#define RW_FETCH(S_, s_) do { const float* q_ = sb + (s_) * 384 + kc * 8; \
      S_##w0 = *(const f32x4*)(q_); S_##w1 = *(const f32x4*)(q_ + 4); S_##n0 = *(const f32x4*)(q_ + 64); S_##n1 = *(const f32x4*)(q_ + 68); \
      S_##b0 = *(const f32x4*)(q_ + 128); S_##b1 = *(const f32x4*)(q_ + 132); S_##k0 = *(const f32x4*)(q_ + 192); S_##k1 = *(const f32x4*)(q_ + 196); \
      S_##r0 = *(const f32x4*)(q_ + 256); S_##r1 = *(const f32x4*)(q_ + 260); S_##vv = sb[(s_) * 384 + 320 + vrow]; } while (0)
#define LO2(x) ((f32x2){(x)[0], (x)[1]})
#define HI2(x) ((f32x2){(x)[2], (x)[3]})
#define RW_STEP(S_, s_) do { \
      f32x2 a2 = S[0] * LO2(S_##n0); a2 += S[1] * HI2(S_##n0); a2 += S[2] * LO2(S_##n1); a2 += S[3] * HI2(S_##n1); \
      const float sa = red8(a2.x + a2.y); const float vx = S_##vv; \
      S[0] = S[0] * LO2(S_##w0) + (LO2(S_##b0) * sa + LO2(S_##k0) * vx); S[1] = S[1] * HI2(S_##w0) + (HI2(S_##b0) * sa + HI2(S_##k0) * vx); \
      S[2] = S[2] * LO2(S_##w1) + (LO2(S_##b1) * sa + LO2(S_##k1) * vx); S[3] = S[3] * HI2(S_##w1) + (HI2(S_##b1) * sa + HI2(S_##k1) * vx); \
      f32x2 y2 = S[0] * LO2(S_##r0); y2 += S[1] * HI2(S_##r0); y2 += S[2] * LO2(S_##r1); y2 += S[3] * HI2(S_##r1); \
      const float y = red8(y2.x + y2.y); const float yn = DPPF(y, 0x128);     \
      if ((tid & 15) == 0) { const int t_ = dir ? (T - 1 - (c * 16 + (s_))) : (c * 16 + (s_)); *(unsigned*)(ybase + (size_t)t_ * NIN) = pk(y, yn); } } while (0)
    f32x4 Aw0, Aw1, An0, An1, Ab0, Ab1, Ak0, Ak1, Ar0, Ar1; float Avv;
    f32x4 Bw0, Bw1, Bn0, Bn1, Bb0, Bb1, Bk0, Bk1, Br0, Br1; float Bvv;
    RW_FETCH(A, 0);
#pragma unroll 2
    for (int s = 0; s < 16; s += 2) {
      RW_FETCH(B, s + 1);
      RW_STEP(A, s);
      if (s + 2 < 16) RW_FETCH(A, s + 2);
      RW_STEP(B, s + 1);
    }
#undef RW_FETCH
#undef RW_STEP
    if (c + 1 < nchunk) RW_LSTORE((c + 1) & 1);
    __syncthreads();
  }
#undef RW_GLOAD
#undef RW_LSTORE
  __builtin_amdgcn_s_setprio(0);
}

template <int MODE>
DI void attn_item(char* lds, const Params& p, int layer, int seq, int head, int qt) {
  const int tid = opaque(threadIdx.x), lane = tid & 63, w = tid >> 6, l31 = lane & 31, h = lane >> 5;
  layer = opaque_s(layer); seq = opaque_s(seq); head = opaque_s(head); qt = opaque_s(qt);
  int row0, T; seq_info(seq, row0, T);
  const int QC = (MODE == 0 ? A_Q : MODE == 1 ? B_Q : C_Q) + head * 64;
  const int KC = MODE == 0 ? A_K + (head >> 1) * 64 : MODE == 1 ? B_K + head * 64 : C_K + head * 64;
  const int VC = MODE == 0 ? A_V + (head >> 1) * 64 : MODE == 1 ? B_V + head * 64 : C_V + head * 64;
  const int qw0 = qt * 128 + w * 32, qi = qw0 + l31;
  bf16_t* zq = p.z + (size_t)(row0 + qi) * NIN + QC;
  bf16x8 qf[4];
#pragma unroll
  for (int s = 0; s < 4; ++s) qf[s] = *(const bf16x8*)(zq + s * 16 + h * 8);
  const int srow = tid >> 3, sc8 = tid & 7;
  const bf16_t* kbase = p.z + (size_t)(row0 + srow) * NIN + KC + sc8 * 8;
  const bf16_t* vbase = p.z + (size_t)(row0 + srow) * NIN + VC + sc8 * 8;
  u32x4 rk[2][2], rv[2][2];
  const int nt = T >> 6;
  const int prow = (l31 & 19) | ((l31 & 4) << 1) | ((l31 & 8) >> 1);
#define AT_GLOAD(t, S) do { _Pragma("unroll") for (int i_ = 0; i_ < 2; ++i_) { const size_t off_ = (size_t)((t) * 64 + 32 * i_) * NIN; rk[S][i_] = *(const u32x4*)(kbase + off_); rv[S][i_] = *(const u32x4*)(vbase + off_); } } while (0)
#define AT_LSTORE(buf, S) do { char* ks_ = lds + (buf) * 18432; char* vs_ = ks_ + 9216; \
    _Pragma("unroll") for (int i_ = 0; i_ < 2; ++i_) { *(u32x4*)(ks_ + (srow + 32 * i_) * PITCH + sc8 * 16) = rk[S][i_]; *(u32x4*)(vs_ + (srow + 32 * i_) * PITCH + sc8 * 16) = rv[S][i_]; } } while (0)
  constexpr int NMAP = (MODE == 1) ? 2 : 1;
  f32x16 o[NMAP][2];
  float m_run[NMAP], l_run[NMAP];
#pragma unroll
  for (int a = 0; a < NMAP; ++a) { m_run[a] = -INFINITY; l_run[a] = 0.f;
#pragma unroll
    for (int b = 0; b < 2; ++b)
#pragma unroll
      for (int i = 0; i < 16; ++i) o[a][b][i] = 0.f; }
  float lf = 0.f, lb = 0.f;
  if (MODE == 2) { lf = log2f(1.0f - exp2f(-5.0f - (float)head)); lb = log2f(1.0f - exp2f(-5.0f - (float)(3 - head))); }
  auto body = [&](const char* ks, const char* vs, const int t) __attribute__((always_inline)) {
#pragma unroll
    for (int mp = 0; mp < NMAP; ++mp) {
      f32x16 st[2];
#pragma unroll
      for (int kf = 0; kf < 2; ++kf) {
#pragma unroll
        for (int i = 0; i < 16; ++i) st[kf][i] = 0.f;
        if (MODE == 1) {
#pragma unroll
          for (int s = 0; s < 2; ++s) { const bf16x8 kfr = *(const bf16x8*)(ks + (kf * 32 + prow) * PITCH + (mp * 2 + s) * 32 + h * 16); st[kf] = MFMA32(kfr, qf[mp * 2 + s], st[kf]); }
        } else {
#pragma unroll
          for (int s = 0; s < 4; ++s) { const bf16x8 kfr = *(const bf16x8*)(ks + (kf * 32 + prow) * PITCH + s * 32 + h * 16); st[kf] = MFMA32(kfr, qf[s], st[kf]); }
        }
      }
      if (MODE == 2) {
        const int k0 = t * 64;
        const float dbase = (float)(qi - k0 - 8 * h);
        if (k0 + 63 < qw0) {
#pragma unroll
          for (int kf = 0; kf < 2; ++kf)
#pragma unroll
            for (int i = 0; i < 16; ++i) { const float cc = (float)(32 * kf + (i & 3) + 4 * ((i >> 2) & 1) + 16 * ((i >> 3) & 1)); st[kf][i] *= fexp2(lf * (dbase - cc)); }
        } else if (k0 > qw0 + 31) {
#pragma unroll
          for (int kf = 0; kf < 2; ++kf)
#pragma unroll
            for (int i = 0; i < 16; ++i) { const float cc = (float)(32 * kf + (i & 3) + 4 * ((i >> 2) & 1) + 16 * ((i >> 3) & 1)); st[kf][i] *= fexp2(lb * (cc - dbase)); }
        } else {
#pragma unroll
          for (int kf = 0; kf < 2; ++kf)
#pragma unroll
            for (int i = 0; i < 16; ++i) { const float cc = (float)(32 * kf + (i & 3) + 4 * ((i >> 2) & 1) + 16 * ((i >> 3) & 1)); const float d = dbase - cc;
              float dd = fexp2(fminf(lf * d, -lb * d)); if (d == 0.f) dd = 2.0f; st[kf][i] *= dd; }
        }
      } else {
        float mx = st[0][0];
#pragma unroll
        for (int kf = 0; kf < 2; ++kf)
#pragma unroll
          for (int i = 0; i < 16; ++i) mx = fmaxf(mx, st[kf][i]);
        mx = fmaxf(mx, __shfl_xor(mx, 32));
        const float mn = fmaxf(m_run[mp], mx); const float alpha = fexp2(m_run[mp] - mn); m_run[mp] = mn;
        float ps = 0.f;
#pragma unroll
        for (int kf = 0; kf < 2; ++kf)
#pragma unroll
          for (int i = 0; i < 16; ++i) { st[kf][i] = fexp2(st[kf][i] - mn); ps += st[kf][i]; }
        l_run[mp] = l_run[mp] * alpha + ps;
#pragma unroll
        for (int df = 0; df < 2; ++df) o[mp][df] *= alpha;
      }
      bf16x8 pf[4];
#pragma unroll
      for (int kf = 0; kf < 2; ++kf)
#pragma unroll
        for (int s2 = 0; s2 < 2; ++s2) { u32x4 u; u.x = pk(st[kf][8 * s2], st[kf][8 * s2 + 1]); u.y = pk(st[kf][8 * s2 + 2], st[kf][8 * s2 + 3]);
          u.z = pk(st[kf][8 * s2 + 4], st[kf][8 * s2 + 5]); u.w = pk(st[kf][8 * s2 + 6], st[kf][8 * s2 + 7]); pf[kf * 2 + s2] = __builtin_bit_cast(bf16x8, u); }
#pragma unroll
      for (int df = 0; df < 2; ++df)
#pragma unroll
        for (int ksx = 0; ksx < 4; ++ksx) { const bf16x8 vfr = *(const bf16x8*)(vs + (df * 32 + l31) * PITCH + ksx * 32 + h * 16); o[mp][df] = MFMA32(vfr, pf[ksx], o[mp][df]); }
    }
  };
  if constexpr (MODE == 1) {
    AT_GLOAD(0, 0); AT_LSTORE(0, 0); __syncthreads();
#pragma unroll 1
    for (int t = 0; t < nt; ++t) {
      if (t + 1 < nt) AT_GLOAD(t + 1, 0);
      const char* ks = lds + (t & 1) * 18432;
      body(ks, ks + 9216, t);
      if (t + 1 < nt) AT_LSTORE((t + 1) & 1, 0);
      __syncthreads();
    }
  } else {
    AT_GLOAD(0, 0); AT_GLOAD(1, 1); AT_LSTORE(0, 0); __syncthreads();
#pragma unroll 1
    for (int t2 = 0; t2 < nt; t2 += 2) {
      if (t2 + 2 < nt) AT_GLOAD(t2 + 2, 0);
      body(lds, lds + 9216, t2);
      AT_LSTORE(1, 1);
      __syncthreads();
      if (t2 + 3 < nt) AT_GLOAD(t2 + 3, 1);
      body(lds + 18432, lds + 18432 + 9216, t2 + 1);
      if (t2 + 2 < nt) AT_LSTORE(0, 0);
      __syncthreads();
    }
  }
#undef AT_GLOAD
#undef AT_LSTORE
  f32x16 r[2];
  if (MODE == 0) {
    const float l = l_run[0] + __shfl_xor(l_run[0], 32); const float inv = 1.0f / l;
#pragma unroll
    for (int df = 0; df < 2; ++df) r[df] = o[0][df] * inv;
  } else if (MODE == 1) {
    const float* lp = p.in[I_BLAM] + layer * 128;
    float s01 = 0.f, s23 = 0.f;
    for (int i = 0; i < 32; ++i) { s01 += lp[i] * lp[32 + i]; s23 += lp[64 + i] * lp[96 + i]; }
    const float lam_init = 0.8f - 0.6f * expf(-0.3f * (float)layer);
    const float lam = expf(s01) - expf(s23) + lam_init;
    const float l0 = l_run[0] + __shfl_xor(l_run[0], 32), l1 = l_run[NMAP - 1] + __shfl_xor(l_run[NMAP - 1], 32);
    const float i0 = 1.0f / l0, i1 = lam / l1;
    float ss = 0.f;
#pragma unroll
    for (int df = 0; df < 2; ++df) { r[df] = o[0][df] * i0 - o[NMAP - 1][df] * i1;
#pragma unroll
      for (int i = 0; i < 16; ++i) ss += r[df][i] * r[df][i]; }
    ss += __shfl_xor(ss, 32);
    const float rs = rsqrtf(ss * (1.0f / 64.0f) + EPS) * (1.0f - lam_init);
    const float* sg = p.in[I_BSUB] + layer * 64;
#pragma unroll
    for (int df = 0; df < 2; ++df)
#pragma unroll
      for (int i = 0; i < 16; ++i) r[df][i] *= rs * sg[df * 32 + (i & 3) + 8 * (i >> 2) + 4 * h];
  } else {
    float ss = 0.f;
#pragma unroll
    for (int df = 0; df < 2; ++df)
#pragma unroll
      for (int i = 0; i < 16; ++i) ss += o[0][df][i] * o[0][df][i];
    ss += __shfl_xor(ss, 32);
    const float rs = rsqrtf(ss * (1.0f / 64.0f) + EPS);
    const float* gg = p.in[I_CGN] + layer * 256 + head * 64;
    const bf16_t* zg = p.z + (size_t)(row0 + qi) * NIN + C_G + head * 64;
#pragma unroll
    for (int df = 0; df < 2; ++df)
#pragma unroll
      for (int g = 0; g < 4; ++g) { const u32x2 gw = *(const u32x2*)(zg + df * 32 + 8 * g + 4 * h);
        const float gv[4] = {bflo(gw.x), bfhi(gw.x), bflo(gw.y), bfhi(gw.y)};
#pragma unroll
        for (int e = 0; e < 4; ++e) { const float x = gv[e]; r[df][4 * g + e] = o[0][df][4 * g + e] * rs * gg[df * 32 + 8 * g + 4 * h + e] * (x / (1.0f + __expf(-x))); } }
  }
#pragma unroll
  for (int df = 0; df < 2; ++df)
#pragma unroll
    for (int g = 0; g < 4; ++g) { u32x2 v; v.x = pk(r[df][4 * g], r[df][4 * g + 1]); v.y = pk(r[df][4 * g + 2], r[df][4 * g + 3]); *(u32x2*)(zq + df * 32 + 8 * g + 4 * h) = v; }
}

template <class Epi>
DI void gemm_tile2(char* lds, const ASrc& A, const bf16_t* __restrict__ Bt, int K, int m0, int n0, const Epi& epi) {
  const int tid = opaque(threadIdx.x), lane = tid & 63, w = __builtin_amdgcn_readfirstlane(tid >> 6), wr = w >> 1, wc = w & 1, l31 = lane & 31, h = lane >> 5;
  const int nk = K >> 5, smask = (1 << A.shift) - 1;
  LASP char* ldsl = (LASP char*)lds;
  f32x16 acc[2][4];
#pragma unroll
  for (int a = 0; a < 2; ++a)
#pragma unroll
    for (int b = 0; b < 4; ++b)
#pragma unroll
      for (int i = 0; i < 16; ++i) acc[a][b][i] = 0.f;
  const int lrow = lane >> 2, lslot = lane & 3;
  int goffA[2], goffB[4];
#pragma unroll
  for (int i = 0; i < 2; ++i) { const int r = (2 * w + i) * 16 + lrow, c = lslot ^ ((r >> 2) & 3); goffA[i] = (r << 2) | c; }
#pragma unroll
  for (int i = 0; i < 4; ++i) { const int r = (4 * w + i) * 16 + lrow, c = lslot ^ ((r >> 2) & 3); goffB[i] = r * K + c * 8; }
#define G2_ISSUE(kt, st) do { const int k0_ = (kt) << 5, seg_ = k0_ >> A.shift, kk_ = k0_ & smask; \
    const bf16_t* bp_ = seg_ == 0 ? A.b0 : seg_ == 1 ? A.b1 : seg_ == 2 ? A.b2 : A.b3; const int st_ = seg_ == 0 ? A.s0 : seg_ == 1 ? A.s1 : seg_ == 2 ? A.s2 : A.s3; \
    _Pragma("unroll") for (int i_ = 0; i_ < 2; ++i_) { \
      const bf16_t* ga_ = bp_ + (size_t)(m0 + (goffA[i_] >> 2)) * st_ + kk_ + (goffA[i_] & 3) * 8; \
      __builtin_amdgcn_global_load_lds((const unsigned*)ga_, (LASP unsigned*)(ldsl + (st) * 24576 + (2 * w + i_) * 1024), 16, 0, 0); } \
    _Pragma("unroll") for (int i_ = 0; i_ < 4; ++i_) { \
      const bf16_t* gb_ = Bt + (size_t)n0 * K + goffB[i_] + k0_; \
      __builtin_amdgcn_global_load_lds((const unsigned*)gb_, (LASP unsigned*)(ldsl + (st) * 24576 + 8192 + (4 * w + i_) * 1024), 16, 0, 0); } } while (0)
  const int xr = (l31 >> 2) & 3;
  int coff[2];
#pragma unroll
  for (int s = 0; s < 2; ++s) coff[s] = ((2 * s + h) ^ xr) * 16;
#define G2_COMPUTE(st) do { const char* as = lds + (st) * 24576; const char* bs = as + 8192; \
    bf16x8 af[2][2], wf[2][4]; \
    _Pragma("unroll") for (int s = 0; s < 2; ++s) { \
      _Pragma("unroll") for (int mf = 0; mf < 2; ++mf) af[s][mf] = *(const bf16x8*)(as + (wr * 64 + mf * 32 + l31) * 64 + coff[s]); \
      _Pragma("unroll") for (int nf = 0; nf < 4; ++nf) wf[s][nf] = *(const bf16x8*)(bs + (wc * 128 + nf * 32 + l31) * 64 + coff[s]); } \
    __builtin_amdgcn_sched_barrier(0); __builtin_amdgcn_s_setprio(1); \
    _Pragma("unroll") for (int s = 0; s < 2; ++s) \
      _Pragma("unroll") for (int mf = 0; mf < 2; ++mf) _Pragma("unroll") for (int nf = 0; nf < 4; ++nf) acc[mf][nf] = MFMA32(wf[s][nf], af[s][mf], acc[mf][nf]); \
    __builtin_amdgcn_s_setprio(0); __builtin_amdgcn_sched_barrier(0); } while (0)
  G2_ISSUE(0, 0);
  for (int kt = 0; kt < nk; kt += 2) {
    asm volatile("s_waitcnt vmcnt(0)" ::: "memory"); __syncthreads();
    G2_ISSUE(kt + 1, 1);
    G2_COMPUTE(0);
    asm volatile("s_waitcnt vmcnt(0)" ::: "memory"); __syncthreads();
    if (kt + 2 < nk) G2_ISSUE(kt + 2, 0);
    G2_COMPUTE(1);
  }
  __syncthreads();
#pragma unroll
  for (int hf = 0; hf < 2; ++hf) {
    f32x16 t[2][2];
#pragma unroll
    for (int mf = 0; mf < 2; ++mf) { t[mf][0] = acc[mf][2 * hf]; t[mf][1] = acc[mf][2 * hf + 1]; }
    epi(t, m0 + wr * 64, n0 + wc * 128 + hf * 64, n0, wc, l31, h);
  }
  __syncthreads();
#undef G2_ISSUE
#undef G2_COMPUTE
}

template <class Epi>
DI void gemm_phase2(char* lds, const ASrc& A, const bf16_t* Bt, int K, int ntn, const Epi& epi) {
  const int xcd = blockIdx.x & 7, j = blockIdx.x >> 3, nloc = gridDim.x >> 3, per = 48 * ntn, grp = 8 * ntn;
  for (int li = j; li < per; li += nloc) {
    const int sg = li / grp, wi = li - sg * grp, nt = wi >> 3, mt = xcd * 48 + sg * 8 + (wi & 7);
    gemm_tile2(lds, A, Bt, K, mt * 128, nt * 256, epi);
  }
}

template <int MODE>
DI void attn3_item(char* lds, const Params& p, int layer, int seq, int head, int qt) {
  const int tid = opaque(threadIdx.x), lane = tid & 63, w = tid >> 6, l31 = lane & 31, h = lane >> 5;
  layer = opaque_s(layer); seq = opaque_s(seq); head = opaque_s(head); qt = opaque_s(qt);
  int row0, T; seq_info(seq, row0, T);
  const int QC = (MODE == 0 ? A_Q : C_Q) + head * 64;
  const int KC = MODE == 0 ? A_K + (head >> 1) * 64 : C_K + head * 64;
  const int VC = MODE == 0 ? A_V + (head >> 1) * 64 : C_V + head * 64;
  const int qw0 = qt * 256 + w * 64;
  bf16x8 qf[2][4];
#pragma unroll
  for (int qi = 0; qi < 2; ++qi)
#pragma unroll
    for (int s = 0; s < 4; ++s) qf[qi][s] = *(const bf16x8*)(p.z + (size_t)(row0 + qw0 + qi * 32 + l31) * NIN + QC + s * 16 + h * 8);
  const int srow = tid >> 3, sc8 = tid & 7;
  const bf16_t* kbase = p.z + (size_t)(row0 + srow) * NIN + KC + sc8 * 8;
  const bf16_t* vbase = p.z + (size_t)(row0 + srow) * NIN + VC + sc8 * 8;
  u32x4 rk[2], rv[2];
  const int nt = T >> 6;
  const int prow = (l31 & 19) | ((l31 & 4) << 1) | ((l31 & 8) >> 1);
#define A3_GLOAD(t) do { _Pragma("unroll") for (int i_ = 0; i_ < 2; ++i_) { const size_t off_ = (size_t)((t) * 64 + 32 * i_) * NIN; rk[i_] = *(const u32x4*)(kbase + off_); rv[i_] = *(const u32x4*)(vbase + off_); } } while (0)
#define A3_LSTORE(buf) do { char* ks_ = lds + (buf) * 18432; char* vs_ = ks_ + 9216; \
    _Pragma("unroll") for (int i_ = 0; i_ < 2; ++i_) { *(u32x4*)(ks_ + (srow + 32 * i_) * PITCH + sc8 * 16) = rk[i_]; *(u32x4*)(vs_ + (srow + 32 * i_) * PITCH + sc8 * 16) = rv[i_]; } } while (0)
  f32x16 o[2][2];
  float m_run[2], l_run[2];
#pragma unroll
  for (int a = 0; a < 2; ++a) { m_run[a] = -INFINITY; l_run[a] = 0.f;
#pragma unroll
    for (int b = 0; b < 2; ++b)
#pragma unroll
      for (int i = 0; i < 16; ++i) o[a][b][i] = 0.f; }
  float lf = 0.f, lb = 0.f;
  if (MODE == 2) { lf = log2f(1.0f - exp2f(-5.0f - (float)head)); lb = log2f(1.0f - exp2f(-5.0f - (float)(3 - head))); }
  A3_GLOAD(0); A3_LSTORE(0); __syncthreads();
#pragma unroll 1
  for (int t = 0; t < nt; ++t) {
    if (t + 1 < nt) A3_GLOAD(t + 1);
    const char* ks = lds + (t & 1) * 18432; const char* vs = ks + 9216;
    f32x16 st[2][2];
#pragma unroll
    for (int kf = 0; kf < 2; ++kf) {
#pragma unroll
      for (int qi = 0; qi < 2; ++qi)
#pragma unroll
        for (int i = 0; i < 16; ++i) st[qi][kf][i] = 0.f;
#pragma unroll
      for (int s = 0; s < 4; ++s) { const bf16x8 kfr = *(const bf16x8*)(ks + (kf * 32 + prow) * PITCH + s * 32 + h * 16);
#pragma unroll
        for (int qi = 0; qi < 2; ++qi) st[qi][kf] = MFMA32(kfr, qf[qi][s], st[qi][kf]); }
    }
    __builtin_amdgcn_sched_barrier(0);
#pragma unroll
    for (int qi = 0; qi < 2; ++qi) {
      bf16x8 pf[4];
      if (MODE == 2) {
        const int k0 = t * 64, qb = qw0 + qi * 32;
        const float dbase = (float)(qb + l31 - k0 - 8 * h);
        if (k0 + 63 < qb) {
#pragma unroll
          for (int kf = 0; kf < 2; ++kf)
#pragma unroll
            for (int i = 0; i < 16; ++i) { const float cc = (float)(32 * kf + (i & 3) + 4 * ((i >> 2) & 1) + 16 * ((i >> 3) & 1)); st[qi][kf][i] *= fexp2(lf * (dbase - cc)); }
        } else if (k0 > qb + 31) {
#pragma unroll
          for (int kf = 0; kf < 2; ++kf)
#pragma unroll
            for (int i = 0; i < 16; ++i) { const float cc = (float)(32 * kf + (i & 3) + 4 * ((i >> 2) & 1) + 16 * ((i >> 3) & 1)); st[qi][kf][i] *= fexp2(lb * (cc - dbase)); }
        } else {
#pragma unroll
          for (int kf = 0; kf < 2; ++kf)
#pragma unroll
            for (int i = 0; i < 16; ++i) { const float cc = (float)(32 * kf + (i & 3) + 4 * ((i >> 2) & 1) + 16 * ((i >> 3) & 1)); const float d = dbase - cc;
              float dd = fexp2(fminf(lf * d, -lb * d)); if (d == 0.f) dd = 2.0f; st[qi][kf][i] *= dd; }
        }
      } else {
        float mx = st[qi][0][0];
#pragma unroll
        for (int kf = 0; kf < 2; ++kf)
#pragma unroll
          for (int i = 0; i < 16; ++i) mx = fmaxf(mx, st[qi][kf][i]);
        mx = fmaxf(mx, __shfl_xor(mx, 32));
        const float mn = fmaxf(m_run[qi], mx); const float alpha = fexp2(m_run[qi] - mn); m_run[qi] = mn;
        float ps = 0.f;
#pragma unroll
        for (int kf = 0; kf < 2; ++kf)
#pragma unroll
          for (int i = 0; i < 16; ++i) { st[qi][kf][i] = fexp2(st[qi][kf][i] - mn); ps += st[qi][kf][i]; }
        l_run[qi] = l_run[qi] * alpha + ps;
#pragma unroll
        for (int df = 0; df < 2; ++df) o[qi][df] *= alpha;
      }
#pragma unroll
      for (int kf = 0; kf < 2; ++kf)
#pragma unroll
        for (int s2 = 0; s2 < 2; ++s2) { u32x4 u; u.x = pk(st[qi][kf][8 * s2], st[qi][kf][8 * s2 + 1]); u.y = pk(st[qi][kf][8 * s2 + 2], st[qi][kf][8 * s2 + 3]);
          u.z = pk(st[qi][kf][8 * s2 + 4], st[qi][kf][8 * s2 + 5]); u.w = pk(st[qi][kf][8 * s2 + 6], st[qi][kf][8 * s2 + 7]); pf[kf * 2 + s2] = __builtin_bit_cast(bf16x8, u); }
#pragma unroll
      for (int df = 0; df < 2; ++df)
#pragma unroll
        for (int ksx = 0; ksx < 4; ++ksx) { const bf16x8 vfr = *(const bf16x8*)(vs + (df * 32 + l31) * PITCH + ksx * 32 + h * 16); o[qi][df] = MFMA32(vfr, pf[ksx], o[qi][df]); }
      __builtin_amdgcn_sched_barrier(0);
    }
    __builtin_amdgcn_sched_barrier(0);
    if (t + 1 < nt) A3_LSTORE((t + 1) & 1);
    __syncthreads();
  }
#undef A3_GLOAD
#undef A3_LSTORE
#pragma unroll
  for (int qi = 0; qi < 2; ++qi) {
    const int qrow = row0 + qw0 + qi * 32 + l31;
    bf16_t* zq = p.z + (size_t)qrow * NIN + QC;
    f32x16 r[2];
    if (MODE == 0) {
      const float l = l_run[qi] + __shfl_xor(l_run[qi], 32); const float inv = 1.0f / l;
#pragma unroll
      for (int df = 0; df < 2; ++df) r[df] = o[qi][df] * inv;
    } else {
      float ss = 0.f;
#pragma unroll
      for (int df = 0; df < 2; ++df)
#pragma unroll
        for (int i = 0; i < 16; ++i) ss += o[qi][df][i] * o[qi][df][i];
      ss += __shfl_xor(ss, 32);
      const float rs = rsqrtf(ss * (1.0f / 64.0f) + EPS);
      const float* gg = p.in[I_CGN] + layer * 256 + head * 64;
      const bf16_t* zg = p.z + (size_t)qrow * NIN + C_G + head * 64;
#pragma unroll
      for (int df = 0; df < 2; ++df)
#pragma unroll
        for (int g = 0; g < 4; ++g) { const u32x2 gw = *(const u32x2*)(zg + df * 32 + 8 * g + 4 * h);
          const float gv[4] = {bflo(gw.x), bfhi(gw.x), bflo(gw.y), bfhi(gw.y)};
#pragma unroll
          for (int e = 0; e < 4; ++e) { const float x = gv[e]; r[df][4 * g + e] = o[qi][df][4 * g + e] * rs * gg[df * 32 + 8 * g + 4 * h + e] * (x / (1.0f + __expf(-x))); } }
    }
#pragma unroll
    for (int df = 0; df < 2; ++df)
#pragma unroll
      for (int g = 0; g < 4; ++g) { u32x2 v; v.x = pk(r[df][4 * g], r[df][4 * g + 1]); v.y = pk(r[df][4 * g + 2], r[df][4 * g + 3]); *(u32x2*)(zq + df * 32 + 8 * g + 4 * h) = v; }
  }
}

DI void ctr_barrier(unsigned* cnt) {
  asm volatile("s_waitcnt vmcnt(0) lgkmcnt(0)" ::: "memory");
  __syncthreads();
  if (threadIdx.x == 0) {
    __builtin_amdgcn_fence(__ATOMIC_RELEASE, "agent");
    asm volatile("s_waitcnt vmcnt(0)" ::: "memory");
    const unsigned G = gridDim.x;
    const unsigned old = __hip_atomic_fetch_add(cnt, 1u, __ATOMIC_RELAXED, __HIP_MEMORY_SCOPE_AGENT);
    const unsigned gen = old / G + 1u;
    if (old + 1u == gen * G) __hip_atomic_store(cnt + 64, gen, __ATOMIC_RELAXED, __HIP_MEMORY_SCOPE_AGENT);
    else while (__hip_atomic_load(cnt + 64, __ATOMIC_RELAXED, __HIP_MEMORY_SCOPE_AGENT) < gen) __builtin_amdgcn_s_sleep(1);
    __builtin_amdgcn_fence(__ATOMIC_ACQUIRE, "agent");
    asm volatile("s_waitcnt vmcnt(0)" ::: "memory");
  }
  __syncthreads();
}

DI int next_item(int* ctr, int* sh) {
  __syncthreads();
  if (threadIdx.x == 0) *sh = atomicAdd(ctr, 1);
  __syncthreads();
  return *sh;
}

__global__ void __launch_bounds__(256, 2) fwd(Params p) {
  extern __shared__ __attribute__((aligned(16))) char lds[];
  __shared__ int s_item;
  cg::grid_group grid = cg::this_grid();
  const int bid = blockIdx.x, nb = gridDim.x, tid = threadIdx.x, lane = tid & 63, w = tid >> 6;
  if (bid == 0) p.ctr[tid] = 0;
  for (int i = bid * 256 + tid; i < 4096 * 32; i += nb * 256) { const int t = i >> 5, j = i & 31; const float inv = powf(10000.0f, -(float)(2 * j) / 64.0f); float sn, cs; sincosf((float)t * inv, &sn, &cs); p.tabC[i] = (f32x2){cs, sn}; }
  for (int i = bid * 256 + tid; i < 4096 * 4; i += nb * 256) { const int t = i >> 2, j = i & 3; const float inv = powf(500000.0f, -(float)(2 * j) / 8.0f); float sn, cs; sincosf((float)t * inv, &sn, &cs); p.tabB[i] = (f32x2){cs, sn}; }
  for (int i = bid * 256 + tid; i < 64 * 16; i += nb * 256) { const int t = i >> 4, j = i & 15; const float inv = powf(10000.0f, -(float)(2 * j) / 32.0f); float sn, cs; sincosf((float)t * inv, &sn, &cs); p.tabA[i] = (f32x2){cs, sn}; }
  for (int l = 0; l < 2; ++l) {
    for (int i = bid * 256 + tid; i < (NINP - NIN) * 1024; i += nb * 256) p.wtin[(size_t)l * NINP * 1024 + (size_t)NIN * 1024 + i] = 0;
    for (int tl = bid; tl < 16 * 53; tl += nb) conv_T(lds, p.in[I_WIN] + (size_t)l * 1024 * NIN, 1024, NIN, p.wtin + (size_t)l * NINP * 1024, 0, tl);
    for (int tl = bid; tl < 16 * 16; tl += nb) conv_T(lds, p.in[I_WOUT] + (size_t)l * 1024 * 1024, 1024, 1024, p.wtout + (size_t)l * 1024 * 1024, 0, tl);
  }
  bf16_t* hb = p.pl;
  for (int row = bid * 4 + opaque(w); row < MT; row += nb * 8) {
    const int rb = row + nb * 4;
    const float* xin = row < M0 ? p.in[I_XP] + (size_t)row * 1024 : p.in[I_XS] + (size_t)(row - M0) * 1024;
    if (rb < MT) { const float* xinb = rb < M0 ? p.in[I_XP] + (size_t)rb * 1024 : p.in[I_XS] + (size_t)(rb - M0) * 1024;
      row_phase2(xin, xinb, p.out + (size_t)row * 1024, p.out + (size_t)rb * 1024, nullptr, nullptr, nullptr, p.in[I_NMPRE], hb + (size_t)row * 1024, hb + (size_t)rb * 1024, lane); }
    else row_phase(xin, p.out + (size_t)row * 1024, nullptr, nullptr, p.in[I_NMPRE], hb + (size_t)row * 1024, lane);
  }
  grid.sync();
  for (int l = 0; l < 2; ++l) {
    { ASrc A; A.b0 = hb; A.b1 = hb; A.b2 = hb; A.b3 = hb; A.s0 = A.s1 = A.s2 = A.s3 = 1024; A.shift = 12;
      EpiIn e; e.z = p.z; e.lds = lds; e.qg = p.in[I_AQG] + l * 64; e.kg = p.in[I_AKG] + l * 64; e.tabA = p.tabA; e.tabB = p.tabB; e.tabC = p.tabC;
      gemm_phase2(lds, A, p.wtin + (size_t)l * NINP * 1024, 1024, 14, e); }
    ctr_barrier((unsigned*)p.ctr + 96);
    for (int it = bid; it < MT / DTOK; it += nb) dprep_item(lds, p, l, it);
    ctr_barrier((unsigned*)p.ctr + 96);
    for (;;) {
      const int it = next_item(p.ctr + l * 16, &s_item);
      if (it >= 256 + 2048 + 1024) break;
      if (it < 256) { const int i2 = it >> 1; const int sq = i2 < 64 ? (i2 >> 3) : 8 + ((i2 - 64) >> 3); rwkv_item(lds, p, sq, (i2 >> 1) & 3, i2 & 1, it & 1); }
      else {
        int j = it - 256;
        if (j < 2048) {
          if (j < 1024) attn_item<1>(lds, p, l, j >> 7, (j >> 5) & 3, j & 31);
          else { const int r = (j - 1024) & 511; if (j < 1536) attn3_item<2>(lds, p, l, r >> 6, (r >> 4) & 3, r & 15); else attn3_item<0>(lds, p, l, r >> 6, (r >> 4) & 3, r & 15); }
        } else { j -= 2048;
          if (j < 512) attn_item<1>(lds, p, l, 8 + (j >> 6), (j >> 4) & 3, j & 15);
          else { const int r = (j - 512) & 255; if (j < 768) attn3_item<2>(lds, p, l, 8 + (r >> 5), (r >> 3) & 3, r & 7); else attn3_item<0>(lds, p, l, 8 + (r >> 5), (r >> 3) & 3, r & 7); }
        }
      }
    }
    ctr_barrier((unsigned*)p.ctr + 96);
    bf16_t* wtgu = p.pl + 5 * PLANE; bf16_t* wtd = wtgu + (size_t)2 * DFF * 1024;
    for (int it = bid; it < MT / DTOK + 3 * 704; it += nb) {
      if (it < MT / DTOK) dpost_item(lds, p, l, it);
      else { const int j = it - MT / DTOK;
        if (j < 704) conv_T(lds, p.in[I_FG] + (size_t)l * 1024 * DFF, 1024, DFF, wtgu, 1, j);
        else if (j < 1408) conv_T(lds, p.in[I_FU] + (size_t)l * 1024 * DFF, 1024, DFF, wtgu, 2, j - 704);
        else conv_T(lds, p.in[I_FD] + (size_t)l * DFF * 1024, DFF, 1024, wtd, 0, j - 1408); }
    }
    ctr_barrier((unsigned*)p.ctr + 96);
    { ASrc A; A.b0 = p.z + A_Q; A.b1 = p.z + B_Q; A.b2 = p.z + C_Q; A.b3 = p.pl + 4 * PLANE; A.s0 = A.s1 = A.s2 = NIN; A.s3 = 256; A.shift = 8;
      EpiStore e; e.out = hb; e.ldc = 1024; e.nmax = 1024;
      gemm_phase2(lds, A, p.wtout + (size_t)l * 1024 * 1024, 1024, 4, e); }
    ctr_barrier((unsigned*)p.ctr + 96);
    for (int row = bid * 4 + opaque(w); row < MT; row += nb * 8) { const int rb = row + nb * 4;
      if (rb < MT) row_phase2(p.out + (size_t)row * 1024, p.out + (size_t)rb * 1024, p.out + (size_t)row * 1024, p.out + (size_t)rb * 1024, hb + (size_t)row * 1024, hb + (size_t)rb * 1024,
                              p.in[I_NMPOST] + l * 1024, p.in[I_NFPRE] + l * 1024, hb + (size_t)row * 1024, hb + (size_t)rb * 1024, lane);
      else row_phase(p.out + (size_t)row * 1024, p.out + (size_t)row * 1024, hb + (size_t)row * 1024, p.in[I_NMPOST] + l * 1024, p.in[I_NFPRE] + l * 1024, hb + (size_t)row * 1024, lane); }
    ctr_barrier((unsigned*)p.ctr + 96);
    { ASrc A; A.b0 = hb; A.b1 = hb; A.b2 = hb; A.b3 = hb; A.s0 = A.s1 = A.s2 = A.s3 = 1024; A.shift = 12;
      EpiSwiGLU e; e.out = p.z;
      gemm_phase2(lds, A, wtgu, 1024, 22, e); }
    ctr_barrier((unsigned*)p.ctr + 96);
    { ASrc A; A.b0 = p.z; A.b1 = p.z; A.b2 = p.z; A.b3 = p.z; A.s0 = A.s1 = A.s2 = A.s3 = DFF; A.shift = 12;
      EpiStore e; e.out = hb; e.ldc = 1024; e.nmax = 1024;
      gemm_phase2(lds, A, wtd, DFF, 4, e); }
    ctr_barrier((unsigned*)p.ctr + 96);
    for (int row = bid * 4 + opaque(w); row < MT; row += nb * 8) { const int rb = row + nb * 4; const float* gp2 = l == 0 ? p.in[I_NMPRE] + 1024 : nullptr;
      if (rb < MT) row_phase2(p.out + (size_t)row * 1024, p.out + (size_t)rb * 1024, p.out + (size_t)row * 1024, p.out + (size_t)rb * 1024, hb + (size_t)row * 1024, hb + (size_t)rb * 1024,
                              p.in[I_NFPOST] + l * 1024, gp2, hb + (size_t)row * 1024, hb + (size_t)rb * 1024, lane);
      else row_phase(p.out + (size_t)row * 1024, p.out + (size_t)row * 1024, hb + (size_t)row * 1024, p.in[I_NFPOST] + l * 1024, gp2, hb + (size_t)row * 1024, lane); }
    if (l == 0) ctr_barrier((unsigned*)p.ctr + 96);
  }
}

extern "C" void kernel_launch(void* const* d_in, const int* in_sizes, int n_in, void* d_out, int out_size,
                              void* d_ws, size_t ws_size, hipStream_t stream) {
  static int grid_blocks = 0;
  if (!grid_blocks) {
    int dev = 0, cus = 0, per_cu = 0;
    hipGetDevice(&dev);
    hipDeviceGetAttribute(&cus, hipDeviceAttributeMultiprocessorCount, dev);
    hipFuncSetAttribute((const void*)fwd, hipFuncAttributeMaxDynamicSharedMemorySize, LDS_BYTES);
    hipOccupancyMaxActiveBlocksPerMultiprocessor(&per_cu, fwd, 256, LDS_BYTES);
    if (per_cu > 2) per_cu = 2;
    if (per_cu < 1) per_cu = 1;
    grid_blocks = cus * per_cu;
  }
  Params p{};
  for (int i = 0; i < 28; ++i) p.in[i] = (const float*)d_in[i];
  p.out = (float*)d_out;
  char* ws = (char*)d_ws;
  size_t off = 0;
  p.z = (bf16_t*)(ws + off); off += (size_t)MT * NIN * 2;
  p.pl = (bf16_t*)(ws + off); off += 7 * PLANE * 2;
  p.wtin = (bf16_t*)(ws + off); off += (size_t)2 * NINP * 1024 * 2;
  p.wtout = (bf16_t*)(ws + off); off += (size_t)2 * 1024 * 1024 * 2;
  p.tabC = (f32x2*)(ws + off); off += (size_t)4096 * 32 * 8;
  p.tabB = (f32x2*)(ws + off); off += (size_t)4096 * 4 * 8;
  p.tabA = (f32x2*)(ws + off); off += (size_t)64 * 16 * 8;
  p.ctr = (int*)(ws + off); off += 1024;
  if (off > ws_size) fprintf(stderr, "workspace too small: need %zu have %zu\n", off, ws_size);
  void* args[] = {&p};
  hipError_t e = hipLaunchCooperativeKernel((void*)fwd, dim3(grid_blocks), dim3(256), args, LDS_BYTES, stream);
  if (e != hipSuccess) fprintf(stderr, "coop launch failed: %s (grid %d)\n", hipGetErrorString(e), grid_blocks);
}
```

```cpp
#include <hip/hip_runtime.h>
#include <hip/hip_cooperative_groups.h>
#include <cstdio>
#include <cstdint>
namespace cg = cooperative_groups;

#define DI __device__ __forceinline__
typedef unsigned short bf16_t;
typedef short bf16x8 __attribute__((ext_vector_type(8)));
typedef float f32x2 __attribute__((ext_vector_type(2)));
typedef float f32x4 __attribute__((ext_vector_type(4)));
typedef float f32x16 __attribute__((ext_vector_type(16)));
typedef unsigned u32x2 __attribute__((ext_vector_type(2)));
typedef unsigned u32x4 __attribute__((ext_vector_type(4)));
typedef __bf16 bf16x2_t __attribute__((ext_vector_type(2)));

constexpr int M0 = 32768, MT = 49152, DM = 1024, NIN = 3392, NINP = 3584, DFF = 2816;
constexpr int A_Q = 0, A_K = 256, A_V = 384, B_Q = 512, B_K = 768, B_V = 1024, C_Q = 1280, C_K = 1536, C_V = 1792, C_G = 2048, D_0 = 2304;
constexpr int PITCH = 144;
constexpr size_t PLANE = (size_t)MT * 256;
constexpr int LDS_BYTES = 73728;
constexpr float LOG2E = 1.4426950408889634f;
constexpr float EPS = 1e-6f;

enum { I_XP = 0, I_XS, I_NMPRE, I_NMPOST, I_NFPRE, I_NFPOST, I_WIN, I_WOUT, I_AQG, I_AKG, I_BLAM, I_BSUB, I_CGN, I_DMUP, I_DMUN, I_DW0, I_DWUP,
       I_DA0, I_DAUP, I_DGUP, I_DKK, I_DKA, I_DRK, I_DGNW, I_DGNB, I_FG, I_FU, I_FD };

struct Params {
  const float* in[28];
  float* out;
  bf16_t* z;
  bf16_t* pl;
  bf16_t* wtin;
  bf16_t* wtout;
  f32x2* tabC;
  f32x2* tabB;
  f32x2* tabA;
  int* ctr;
};

DI int opaque(int x) { asm volatile("" : "+v"(x)); return x; }
DI int opaque_s(int x) { asm volatile("" : "+s"(x)); return x; }
DI float bf2f(bf16_t v) { return __uint_as_float(((unsigned)v) << 16); }
DI float bflo(unsigned w) { return __uint_as_float(w << 16); }
DI float bfhi(unsigned w) { return __uint_as_float(w & 0xffff0000u); }
DI unsigned pk(float lo, float hi) { f32x2 v = {lo, hi}; bf16x2_t b = __builtin_convertvector(v, bf16x2_t); return __builtin_bit_cast(unsigned, b); }
DI bf16_t f2bf(float x) { return (bf16_t)(pk(x, 0.f) & 0xffffu); }
DI float dppf(float x, const int ctrl) { return x; }
#define DPPF(x, ctrl) __int_as_float(__builtin_amdgcn_update_dpp(0, __float_as_int(x), (ctrl), 0xF, 0xF, true))
DI float wave_sum(float v) {
  v += DPPF(v, 0xB1);
  v += DPPF(v, 0x4E);
  v += DPPF(v, 0x141);
  v += DPPF(v, 0x140);
  const int vi = __float_as_int(v);
  return (__int_as_float(__builtin_amdgcn_readlane(vi, 0)) + __int_as_float(__builtin_amdgcn_readlane(vi, 16))) +
         (__int_as_float(__builtin_amdgcn_readlane(vi, 32)) + __int_as_float(__builtin_amdgcn_readlane(vi, 48)));
}
DI float dpp_xor1(float x) { return __int_as_float(__builtin_amdgcn_update_dpp(0, __float_as_int(x), 0xB1, 0xF, 0xF, true)); }
DI float dpp_xor2(float x) { return __int_as_float(__builtin_amdgcn_update_dpp(0, __float_as_int(x), 0x4E, 0xF, 0xF, true)); }
DI float dpp_hmir(float x) { return __int_as_float(__builtin_amdgcn_update_dpp(0, __float_as_int(x), 0x141, 0xF, 0xF, true)); }
DI float red8(float x) { x += dpp_xor1(x); x += dpp_xor2(x); x += dpp_hmir(x); return x; }
DI float fexp2(float x) { return __builtin_amdgcn_exp2f(x); }
DI void seq_info(int s, int& row0, int& T) { if (s < 8) { row0 = s * 4096; T = 4096; } else { row0 = M0 + (s - 8) * 2048; T = 2048; } }
DI void row_info(int r, int& t, int& T) { if (r < M0) { t = r & 4095; T = 4096; } else { t = (r - M0) & 2047; T = 2048; } }
#define MFMA32(a, b, c) __builtin_amdgcn_mfma_f32_32x32x16_bf16((a), (b), (c), 0, 0, 0)

DI void conv_T(char* lds, const float* __restrict__ W, int K, int N, bf16_t* __restrict__ Wt, int mode, int tile) {
  float* t = (float*)lds;
  const int tid0 = opaque(threadIdx.x);
  const int ntn = N >> 6, kt = tile / ntn, nt = tile - kt * ntn, k0 = kt << 6, n0 = nt << 6;
  float wv[16];
#pragma unroll
  for (int i = 0; i < 16; ++i) { const int idx = tid0 + 256 * i, k = idx >> 6, n = idx & 63; wv[i] = W[(size_t)(k0 + k) * N + n0 + n]; }
#pragma unroll
  for (int i = 0; i < 16; ++i) { const int idx = tid0 + 256 * i, k = idx >> 6, n = idx & 63; t[k * 65 + n] = wv[i]; }
  __syncthreads();
#pragma unroll 4
  for (int i = 0; i < 8; ++i) {
    const int idx = tid0 + 256 * i, n = idx >> 5, k = (idx & 31) * 2, j = n0 + n;
    const int rho = (mode == 0) ? j : ((j >> 6) * 128 + ((j >> 5) & 1) * 64 + (mode - 1) * 32 + (j & 31));
    *(unsigned*)(Wt + (size_t)rho * K + k0 + k) = pk(t[k * 65 + n], t[(k + 1) * 65 + n]);
  }
  __syncthreads();
}

DI void row_phase(const float* __restrict__ xin, float* __restrict__ xout, const bf16_t* addsrc, const float* __restrict__ gpost,
                  const float* __restrict__ gpre, bf16_t* hout, int lane_in) {
  const int lane = opaque(lane_in);
  f32x4 x[4];
#pragma unroll
  for (int i = 0; i < 4; ++i) x[i] = *(const f32x4*)(xin + i * 256 + lane * 4);
  if (addsrc) {
    f32x4 m[4]; float ss = 0.f;
#pragma unroll
    for (int i = 0; i < 4; ++i) { const u32x2 w = *(const u32x2*)(addsrc + i * 256 + lane * 4); m[i] = (f32x4){bflo(w.x), bfhi(w.x), bflo(w.y), bfhi(w.y)};
      ss += m[i][0] * m[i][0] + m[i][1] * m[i][1] + m[i][2] * m[i][2] + m[i][3] * m[i][3]; }
    ss = wave_sum(ss); const float rs = rsqrtf(ss * (1.0f / 1024.0f) + EPS);
#pragma unroll
    for (int i = 0; i < 4; ++i) { const f32x4 g = *(const f32x4*)(gpost + i * 256 + lane * 4); x[i] += m[i] * rs * g; }
  }
#pragma unroll
  for (int i = 0; i < 4; ++i) *(f32x4*)(xout + i * 256 + lane * 4) = x[i];
  if (gpre) {
    float ss = 0.f;
#pragma unroll
    for (int i = 0; i < 4; ++i) ss += x[i][0] * x[i][0] + x[i][1] * x[i][1] + x[i][2] * x[i][2] + x[i][3] * x[i][3];
    ss = wave_sum(ss); const float rs = rsqrtf(ss * (1.0f / 1024.0f) + EPS);
#pragma unroll
    for (int i = 0; i < 4; ++i) { const f32x4 g = *(const f32x4*)(gpre + i * 256 + lane * 4); const f32x4 hv = x[i] * rs * g;
      u32x2 w; w.x = pk(hv[0], hv[1]); w.y = pk(hv[2], hv[3]); *(u32x2*)(hout + i * 256 + lane * 4) = w; }
  }
}

DI void row_phase2(const float* __restrict__ xinA, const float* __restrict__ xinB, float* __restrict__ xoutA, float* __restrict__ xoutB, const bf16_t* addA, const bf16_t* addB,
                   const float* __restrict__ gpost, const float* __restrict__ gpre, bf16_t* houtA, bf16_t* houtB, int lane_in) {
  const int lane = opaque(lane_in);
  f32x4 x[2][4]; u32x2 aw[2][4];
#pragma unroll
  for (int i = 0; i < 4; ++i) { x[0][i] = *(const f32x4*)(xinA + i * 256 + lane * 4); x[1][i] = *(const f32x4*)(xinB + i * 256 + lane * 4); }
  if (addA) {
#pragma unroll
    for (int i = 0; i < 4; ++i) { aw[0][i] = *(const u32x2*)(addA + i * 256 + lane * 4); aw[1][i] = *(const u32x2*)(addB + i * 256 + lane * 4); }
#pragma unroll
    for (int r = 0; r < 2; ++r) {
      f32x4 m[4]; float ss = 0.f;
#pragma unroll
      for (int i = 0; i < 4; ++i) { const u32x2 w = aw[r][i]; m[i] = (f32x4){bflo(w.x), bfhi(w.x), bflo(w.y), bfhi(w.y)};
        ss += m[i][0] * m[i][0] + m[i][1] * m[i][1] + m[i][2] * m[i][2] + m[i][3] * m[i][3]; }
      ss = wave_sum(ss); const float rs = rsqrtf(ss * (1.0f / 1024.0f) + EPS);
#pragma unroll
      for (int i = 0; i < 4; ++i) { const f32x4 g = *(const f32x4*)(gpost + i * 256 + lane * 4); x[r][i] += m[i] * rs * g; }
    }
  }
#pragma unroll
  for (int i = 0; i < 4; ++i) { *(f32x4*)(xoutA + i * 256 + lane * 4) = x[0][i]; *(f32x4*)(xoutB + i * 256 + lane * 4) = x[1][i]; }
  if (gpre) {
#pragma unroll
    for (int r = 0; r < 2; ++r) {
      float ss = 0.f;
#pragma unroll
      for (int i = 0; i < 4; ++i) ss += x[r][i][0] * x[r][i][0] + x[r][i][1] * x[r][i][1] + x[r][i][2] * x[r][i][2] + x[r][i][3] * x[r][i][3];
      ss = wave_sum(ss); const float rs = rsqrtf(ss * (1.0f / 1024.0f) + EPS);
      bf16_t* ho = r == 0 ? houtA : houtB;
#pragma unroll
      for (int i = 0; i < 4; ++i) { const f32x4 g = *(const f32x4*)(gpre + i * 256 + lane * 4); const f32x4 hv = x[r][i] * rs * g;
        u32x2 w; w.x = pk(hv[0], hv[1]); w.y = pk(hv[2], hv[3]); *(u32x2*)(ho + i * 256 + lane * 4) = w; }
    }
  }
}

struct ASrc { const bf16_t* b0; const bf16_t* b1; const bf16_t* b2; const bf16_t* b3; int s0, s1, s2, s3; int shift; };

struct EpiStore { bf16_t* out; int ldc; int nmax;
  DI void operator()(const f32x16 (&acc)[2][2], int mb, int nb, int n0, int wc, int l31, int h) const {
#pragma unroll
    for (int mf = 0; mf < 2; ++mf) { bf16_t* rp = out + (size_t)(mb + mf * 32 + l31) * ldc;
#pragma unroll
      for (int nf = 0; nf < 2; ++nf) { if (nb + nf * 32 < nmax) {
#pragma unroll
        for (int g = 0; g < 4; ++g) { u32x2 v; v.x = pk(acc[mf][nf][4 * g], acc[mf][nf][4 * g + 1]); v.y = pk(acc[mf][nf][4 * g + 2], acc[mf][nf][4 * g + 3]);
          *(u32x2*)(rp + nb + nf * 32 + 8 * g + 4 * h) = v; } } } }
  } };
struct EpiSwiGLU { bf16_t* out;
  DI void operator()(const f32x16 (&acc)[2][2], int mb, int nb, int n0, int wc, int l31, int h) const {
    const int hc = (nb >> 6) * 32;
#pragma unroll
    for (int mf = 0; mf < 2; ++mf) { bf16_t* rp = out + (size_t)(mb + mf * 32 + l31) * DFF + hc;
#pragma unroll
      for (int g = 0; g < 4; ++g) { float r[4];
#pragma unroll
        for (int e = 0; e < 4; ++e) { const float gt = acc[mf][0][4 * g + e], up = acc[mf][1][4 * g + e]; r[e] = gt / (1.0f + __expf(-gt)) * up; }
        u32x2 v; v.x = pk(r[0], r[1]); v.y = pk(r[2], r[3]); *(u32x2*)(rp + 8 * g + 4 * h) = v; } }
  } };

struct EpiIn { bf16_t* z; char* lds; const float* qg; const float* kg; const f32x2* tabA; const f32x2* tabB; const f32x2* tabC;
  DI void operator()(f32x16 (&acc)[2][2], int mb, int nb, int n0, int wc, int l31, int h) const {
    if (nb >= NIN) return;
    const bool isv = (nb >= A_V && nb < B_Q) || (nb >= B_V && nb < C_Q) || (nb >= C_V && nb < C_G);
    if (isv) {
      const int wv = (threadIdx.x >> 6);
      bf16_t* img = (bf16_t*)(lds + 32768 + wv * 9216);
#pragma unroll
      for (int mf = 0; mf < 2; ++mf)
#pragma unroll
        for (int nf = 0; nf < 2; ++nf)
#pragma unroll
          for (int i = 0; i < 16; ++i) { const int d = nf * 32 + (i & 3) + 8 * (i >> 2) + 4 * h; img[d * 72 + mf * 32 + l31] = f2bf(acc[mf][nf][i]); }
      __builtin_amdgcn_s_waitcnt(0xc07f);
      const int ln = l31 + 32 * h;
#pragma unroll
      for (int i = 0; i < 8; ++i) { const int q = ln + 64 * i, d = q >> 3, c8 = q & 7;
        const u32x4 v = *(const u32x4*)(img + d * 72 + c8 * 8); *(u32x4*)(z + (size_t)(mb + d) * NIN + nb + c8 * 8) = v; }
      return;
    }
#pragma unroll
    for (int mf = 0; mf < 2; ++mf) {
      const int row = mb + mf * 32 + l31; int t, T; row_info(row, t, T);
      if (nb < A_V) {
        const bool isq = nb < A_K; const float* gn = isq ? qg : kg;
        float ss = 0.f;
#pragma unroll
        for (int nf = 0; nf < 2; ++nf)
#pragma unroll
          for (int i = 0; i < 16; ++i) ss += acc[mf][nf][i] * acc[mf][nf][i];
        ss += __shfl_xor(ss, 32);
        const float rs = rsqrtf(ss * (1.0f / 64.0f) + EPS) * (isq ? 0.125f * LOG2E : 1.0f);
#pragma unroll
        for (int nf = 0; nf < 2; ++nf) {
          const int pos = nf == 0 ? (t >> 6) : (t & 63);
#pragma unroll
          for (int g = 0; g < 4; ++g)
#pragma unroll
            for (int e = 0; e < 4; ++e) acc[mf][nf][4 * g + e] *= rs * gn[nf * 32 + 8 * g + 4 * h + e];
#pragma unroll
          for (int g = 0; g < 2; ++g)
#pragma unroll
            for (int e = 0; e < 4; ++e) { const f32x2 cs = tabA[pos * 16 + 8 * g + 4 * h + e];
              const float x1 = acc[mf][nf][4 * g + e], x2 = acc[mf][nf][4 * (g + 2) + e];
              acc[mf][nf][4 * g + e] = x1 * cs.x - x2 * cs.y; acc[mf][nf][4 * (g + 2) + e] = x2 * cs.x + x1 * cs.y; }
        }
      } else if (nb >= B_Q && nb < B_V) {
        const bool isq = nb < B_K;
#pragma unroll
        for (int nf = 0; nf < 2; ++nf) {
#pragma unroll
          for (int e = 0; e < 4; ++e) { const f32x2 cs = tabB[t * 4 + e]; const float v = acc[mf][nf][e]; const float o = __shfl_xor(v, 32);
            acc[mf][nf][e] = (h == 0) ? (v * cs.x - o * cs.y) : (v * cs.x + o * cs.y); }
          if (isq) {
#pragma unroll
            for (int i = 0; i < 16; ++i) acc[mf][nf][i] *= 0.17677669529663687f * LOG2E; }
        }
      } else if (nb >= C_Q && nb < C_V) {
        const float sc = nb < C_K ? 1.0f : 0.125f;
#pragma unroll
        for (int g = 0; g < 4; ++g)
#pragma unroll
          for (int e = 0; e < 4; ++e) { const f32x2 cs = tabC[t * 32 + 8 * g + 4 * h + e]; const float x1 = acc[mf][0][4 * g + e], x2 = acc[mf][1][4 * g + e];
            acc[mf][0][4 * g + e] = (x1 * cs.x - x2 * cs.y) * sc; acc[mf][1][4 * g + e] = (x2 * cs.x + x1 * cs.y) * sc; }
      }
      bf16_t* rp = z + (size_t)row * NIN + nb;
#pragma unroll
      for (int nf = 0; nf < 2; ++nf)
#pragma unroll
        for (int g = 0; g < 4; ++g) { u32x2 v; v.x = pk(acc[mf][nf][4 * g], acc[mf][nf][4 * g + 1]); v.y = pk(acc[mf][nf][4 * g + 2], acc[mf][nf][4 * g + 3]);
          *(u32x2*)(rp + nf * 32 + 8 * g + 4 * h) = v; }
    }
  } };

#define LASP __attribute__((address_space(3)))
template <class Epi>
DI void gemm_tile(char* lds, const ASrc& A, const bf16_t* __restrict__ Bt, int K, int m0, int n0, const Epi& epi, bool first, bool has_next, int m0n, int n0n) {
  const int tid = opaque(threadIdx.x), lane = tid & 63, w = __builtin_amdgcn_readfirstlane(tid >> 6), wr = w >> 1, wc = w & 1, l31 = lane & 31, h = lane >> 5;
  const int nk = K >> 6, smask = (1 << A.shift) - 1;
  LASP char* ldsl = (LASP char*)lds;
  f32x16 acc[2][2];
#pragma unroll
  for (int a = 0; a < 2; ++a)
#pragma unroll
    for (int b = 0; b < 2; ++b)
#pragma unroll
      for (int i = 0; i < 16; ++i) acc[a][b][i] = 0.f;
  const int lrow = lane >> 3, lslot = lane & 7;
  int goffA[4], goffB[4];
#pragma unroll
  for (int i = 0; i < 4; ++i) { const int r = w * 32 + i * 8 + lrow, c = lslot ^ ((r >> 1) & 7); goffA[i] = r; goffB[i] = r * K + c * 8; goffA[i] = (goffA[i] << 3) | c; }
#define GEMM_ISSUE(kt, st, M0_, N0_) do { const int k0_ = (kt) << 6, seg_ = k0_ >> A.shift, kk_ = k0_ & smask; \
    const bf16_t* bp_ = seg_ == 0 ? A.b0 : seg_ == 1 ? A.b1 : seg_ == 2 ? A.b2 : A.b3; const int st_ = seg_ == 0 ? A.s0 : seg_ == 1 ? A.s1 : seg_ == 2 ? A.s2 : A.s3; \
    _Pragma("unroll") for (int i_ = 0; i_ < 4; ++i_) { \
      const bf16_t* ga_ = bp_ + (size_t)((M0_) + (goffA[i_] >> 3)) * st_ + kk_ + (goffA[i_] & 7) * 8; \
      __builtin_amdgcn_global_load_lds((const unsigned*)ga_, (LASP unsigned*)(ldsl + (st) * 32768 + (w * 4 + i_) * 1024), 16, 0, 0); \
      const bf16_t* gb_ = Bt + (size_t)(N0_) * K + goffB[i_] + k0_; \
      __builtin_amdgcn_global_load_lds((const unsigned*)gb_, (LASP unsigned*)(ldsl + (st) * 32768 + 16384 + (w * 4 + i_) * 1024), 16, 0, 0); } } while (0)
  const int xr = (l31 >> 1) & 7;
  int coff[4];
#pragma unroll
  for (int s = 0; s < 4; ++s) coff[s] = ((2 * s + h) ^ xr) * 16;
#define GEMM_COMPUTE(st) do { const char* as = lds + (st) * 32768; const char* bs = as + 16384; \
    bf16x8 af[4][2], wf[4][2]; \
    _Pragma("unroll") for (int s = 0; s < 4; ++s) { \
      _Pragma("unroll") for (int mf = 0; mf < 2; ++mf) af[s][mf] = *(const bf16x8*)(as + (wr * 64 + mf * 32 + l31) * 128 + coff[s]); \
      _Pragma("unroll") for (int nf = 0; nf < 2; ++nf) wf[s][nf] = *(const bf16x8*)(bs + (wc * 64 + nf * 32 + l31) * 128 + coff[s]); } \
    __builtin_amdgcn_sched_barrier(0); __builtin_amdgcn_s_setprio(1); \
    _Pragma("unroll") for (int s = 0; s < 4; ++s) \
      _Pragma("unroll") for (int mf = 0; mf < 2; ++mf) _Pragma("unroll") for (int nf = 0; nf < 2; ++nf) acc[mf][nf] = MFMA32(wf[s][nf], af[s][mf], acc[mf][nf]); \
    __builtin_amdgcn_s_setprio(0); __builtin_amdgcn_sched_barrier(0); } while (0)
  if (first) GEMM_ISSUE(0, 0, m0, n0);
  for (int kt = 0; kt < nk; kt += 2) {
    asm volatile("s_waitcnt vmcnt(0)" ::: "memory"); __syncthreads();
    GEMM_ISSUE(kt + 1, 1, m0, n0);
    GEMM_COMPUTE(0);
    asm volatile("s_waitcnt vmcnt(0)" ::: "memory"); __syncthreads();
    if (kt + 2 < nk) GEMM_ISSUE(kt + 2, 0, m0, n0);
    GEMM_COMPUTE(1);
  }
  __syncthreads();
  if (has_next) GEMM_ISSUE(0, 0, m0n, n0n);
  epi(acc, m0 + wr * 64, n0 + wc * 64, n0, wc, l31, h);
  __syncthreads();
#undef GEMM_ISSUE
#undef GEMM_COMPUTE
}

template <class Epi>
DI void gemm_phase(char* lds, const ASrc& A, const bf16_t* Bt, int K, int ntn, const Epi& epi) {
  const int xcd = blockIdx.x & 7, j = blockIdx.x >> 3, nloc = gridDim.x >> 3, per = 48 * ntn, grp = 8 * ntn;
  bool first = true;
  for (int li = j; li < per; li += nloc) {
    const int sg = li / grp, wi = li - sg * grp, nt = wi >> 3, mt = xcd * 48 + sg * 8 + (wi & 7);
    const int ln = li + nloc; const bool has_next = ln < per;
    const int sgn = ln / grp, win = ln - sgn * grp, ntn2 = win >> 3, mtn = xcd * 48 + sgn * 8 + (win & 7);
    gemm_tile(lds, A, Bt, K, mt * 128, nt * 128, epi, first, has_next, mtn * 128, ntn2 * 128);
    first = false;
  }
}

DI void prep_item(char* lds, const Params& p, int layer, int item) {
  const int tid = opaque(threadIdx.x), lane = tid & 63, w = tid >> 6;
  const int rowb = item * 64; int tb, T; row_info(rowb, tb, T);
  const float* qg = p.in[I_AQG] + layer * 64; const float* kg = p.in[I_AKG] + layer * 64;
  const float qgl = qg[lane], kgl = kg[lane];
  for (int tt = 0; tt < 16; ++tt) {
    const int row = rowb + w * 16 + tt, t = tb + w * 16 + tt;
    bf16_t* zr = p.z + (size_t)row * NIN;
    {
      const int j = lane & 31, i = j & 15; const bool first = j < 16; const int pos = (lane < 32) ? (t >> 6) : (t & 63);
      const f32x2 cs = p.tabA[pos * 16 + i];
#pragma unroll
      for (int hd = 0; hd < 6; ++hd) {
        bf16_t* ptr = zr + (hd < 4 ? A_Q + hd * 64 : A_K + (hd - 4) * 64) + lane;
        float v = bf2f(*ptr);
        const float ss = wave_sum(v * v);
        v = v * rsqrtf(ss * (1.0f / 64.0f) + EPS) * (hd < 4 ? qgl : kgl);
        const float o = __shfl_xor(v, 16);
        float r = first ? (v * cs.x - o * cs.y) : (v * cs.x + o * cs.y);
        if (hd < 4) r *= 0.125f * LOG2E;
        *ptr = f2bf(r);
      }
    }
    {
      const int d = lane & 31; const f32x2 cs = p.tabB[t * 4 + (d & 3)];
#pragma unroll
      for (int c = 0; c < 8; ++c) {
        bf16_t* ptr = zr + (c < 4 ? B_Q + c * 64 : B_K + (c - 4) * 64) + lane;
        float v = bf2f(*ptr);
        const float o = __shfl_xor(v, 4);
        float r = v;
        if (d < 8) r = (d < 4) ? (v * cs.x - o * cs.y) : (v * cs.x + o * cs.y);
        if (c < 4) r *= 0.17677669529663687f * LOG2E;
        *ptr = f2bf(r);
      }
    }
    {
      const f32x2 cs = p.tabC[t * 32 + (lane & 31)];
#pragma unroll
      for (int c = 0; c < 8; ++c) {
        bf16_t* ptr = zr + (c < 4 ? C_Q + c * 64 : C_K + (c - 4) * 64) + lane;
        const float v = bf2f(*ptr);
        const float o = __shfl_xor(v, 32);
        float r = (lane < 32) ? (v * cs.x - o * cs.y) : (v * cs.x + o * cs.y);
        if (c >= 4) r *= 0.125f;
        *ptr = f2bf(r);
      }
    }
  }
  bf16_t* tl = (bf16_t*)lds;
  const int r = tid >> 2, c0 = (tid & 3) * 16;
  for (int sl = 0; sl < 10; ++sl) {
    const int col = sl < 2 ? A_V + sl * 64 : sl < 6 ? B_V + (sl - 2) * 64 : C_V + (sl - 6) * 64;
    bf16_t* gp = p.z + (size_t)(rowb + r) * NIN + col + c0;
    const u32x4 v0 = *(const u32x4*)gp, v1 = *(const u32x4*)(gp + 8);
    __syncthreads();
#pragma unroll
    for (int e = 0; e < 4; ++e) {
      tl[(c0 + 2 * e) * 72 + r] = (bf16_t)(v0[e] & 0xffffu); tl[(c0 + 2 * e + 1) * 72 + r] = (bf16_t)(v0[e] >> 16);
      tl[(c0 + 8 + 2 * e) * 72 + r] = (bf16_t)(v1[e] & 0xffffu); tl[(c0 + 8 + 2 * e + 1) * 72 + r] = (bf16_t)(v1[e] >> 16);
    }
    __syncthreads();
    const u32x4 o0 = *(const u32x4*)(tl + r * 72 + c0), o1 = *(const u32x4*)(tl + r * 72 + c0 + 8);
    *(u32x4*)gp = o0; *(u32x4*)(gp + 8) = o1;
  }
  __syncthreads();
}

DI float dshift(const Params& p, const float* mup, const float* mun, int row, int t, int T, int dc) {
  const bf16_t* zp = p.z + (size_t)row * NIN + D_0 + dc;
  const float z = bf2f(*zp);
  const float zprev = (t > 0) ? bf2f(*(zp - NIN)) : 0.f;
  const float znext = (t < T - 1) ? bf2f(*(zp + NIN)) : 0.f;
  return z + mup[dc] * (zprev - z) + mun[dc] * (znext - z);
}
DI float sigmoidf_(float x) { return 1.0f / (1.0f + __expf(-x)); }
DI float omdecay(float ww) {
  const float e = 0.6065306597126334f / (1.0f + __expf(-ww));
  return 1.0f - __expf(-e);
}
DI float fast_tanh(float x) { const float xc = fminf(fmaxf(x, -15.f), 15.f); return 1.0f - 2.0f / (1.0f + __expf(2.0f * xc)); }
constexpr int DTOK = 16;
DI void dprep_item(char* lds, const Params& p, int layer, int item) {
  const int tid = opaque(threadIdx.x);
  const int rowb = item * DTOK; int tb, T; row_info(rowb, tb, T);
  const float* mup = p.in[I_DMUP] + layer * 1088; const float* mun = p.in[I_DMUN] + layer * 1088;
  float* su = (float*)lds;
  bf16_t* stg = (bf16_t*)(lds + 12288);
#pragma unroll
  for (int i = 0; i < 12; ++i) {
    const int idx = tid + 256 * i, tok = idx / 192, c = idx - tok * 192;
    float u = dshift(p, mup, mun, rowb + tok, tb + tok, T, 768 + c);
    if (c < 128) u = fast_tanh(u);
    su[c * DTOK + tok] = u;
  }
  __syncthreads();
  const int c = tid;
  const float w0f = p.in[I_DW0][(layer * 2 + 0) * 256 + c], w0b = p.in[I_DW0][(layer * 2 + 1) * 256 + c];
  const float a0 = p.in[I_DA0][layer * 256 + c], kkw = p.in[I_DKK][layer * 256 + c], kaw = p.in[I_DKA][layer * 256 + c];
  float zr[DTOK + 2], zk[DTOK + 2], zv[DTOK + 2];
  { const bf16_t* zp = p.z + (size_t)rowb * NIN + D_0 + c;
#pragma unroll
    for (int i = 0; i < DTOK + 2; ++i) { const int t = tb - 1 + i; const bool ok = (t >= 0) && (t < T); const bf16_t* q = zp + (ptrdiff_t)(i - 1) * NIN;
      zr[i] = ok ? bf2f(q[0]) : 0.f; zk[i] = ok ? bf2f(q[256]) : 0.f; zv[i] = ok ? bf2f(q[512]) : 0.f; } }
  const float mpr = mup[c], mnr = mun[c], mpk = mup[256 + c], mnk = mun[256 + c], mpv = mup[512 + c], mnv = mun[512 + c];
  float accf[DTOK], accb[DTOK], acca[DTOK];
#pragma unroll
  for (int k = 0; k < DTOK; ++k) { accf[k] = 0.f; accb[k] = 0.f; acca[k] = 0.f; }
  const float* wupf = p.in[I_DWUP] + (size_t)(layer * 2 + 0) * 64 * 256 + c;
  const float* wupb = p.in[I_DWUP] + (size_t)(layer * 2 + 1) * 64 * 256 + c;
  const float* aup = p.in[I_DAUP] + (size_t)layer * 64 * 256 + c;
#pragma unroll 2
  for (int j = 0; j < 64; ++j) {
    const float wf = wupf[j * 256], wb = wupb[j * 256], wa = aup[j * 256];
#pragma unroll
    for (int q = 0; q < 4; ++q) {
      const f32x4 f0 = *(const f32x4*)(su + j * DTOK + 4 * q), b0 = *(const f32x4*)(su + (64 + j) * DTOK + 4 * q), a0v = *(const f32x4*)(su + (128 + j) * DTOK + 4 * q);
#pragma unroll
      for (int k = 0; k < 4; ++k) { accf[4 * q + k] += f0[k] * wf; accb[4 * q + k] += b0[k] * wb; acca[4 * q + k] += a0v[k] * wa; }
    }
  }
#pragma unroll
  for (int k = 0; k < DTOK; ++k) {
    const float r = zr[k + 1] + mpr * (zr[k] - zr[k + 1]) + mnr * (zr[k + 2] - zr[k + 1]);
    const float kx = zk[k + 1] + mpk * (zk[k] - zk[k + 1]) + mnk * (zk[k + 2] - zk[k + 1]);
    const float v = zv[k + 1] + mpv * (zv[k] - zv[k + 1]) + mnv * (zv[k + 2] - zv[k + 1]);
    const float omf = omdecay(w0f + accf[k]), omb = omdecay(w0b + accb[k]);
    const float a = sigmoidf_(a0 + acca[k]);
    float kk = kx * kkw; const float n2 = wave_sum(kk * kk);
    kk = kk * rsqrtf(fmaxf(n2, 1e-24f));
    const float kmod = kx * (1.0f + (a - 1.0f) * kaw), b = kk * a;
    bf16_t* so = stg + k * 256 + c;
    so[0] = f2bf(r); so[DTOK * 256] = f2bf(kmod); so[2 * DTOK * 256] = f2bf(v); so[3 * DTOK * 256] = f2bf(-kk);
    so[4 * DTOK * 256] = f2bf(b); so[5 * DTOK * 256] = f2bf(omf); so[6 * DTOK * 256] = f2bf(omb);
  }
  __syncthreads();
#pragma unroll
  for (int i = 0; i < 14; ++i) {
    const int q = tid + 256 * i, pln = q >> 9, rem = q & 511, tok = rem >> 5, c16 = rem & 31;
    const u32x4 v = *(const u32x4*)(stg + pln * (DTOK * 256) + tok * 256 + c16 * 8);
    *(u32x4*)(p.pl + (size_t)pln * PLANE + (size_t)(rowb + tok) * 256 + c16 * 8) = v;
  }
  __syncthreads();
}

DI void dpost_item(char* lds, const Params& p, int layer, int item) {
  const int tid = opaque(threadIdx.x);
  const int rowb = item * DTOK; int tb, T; row_info(rowb, tb, T);
  const float* mup = p.in[I_DMUP] + layer * 1088; const float* mun = p.in[I_DMUN] + layer * 1088;
  float* sg = (float*)lds;
  bf16_t* stg = (bf16_t*)(lds + 8192);
#pragma unroll
  for (int i = 0; i < 8; ++i) { const int idx = tid + 256 * i, tok = idx >> 7, c = idx & 127; sg[c * DTOK + tok] = sigmoidf_(dshift(p, mup, mun, rowb + tok, tb + tok, T, 960 + c)); }
  __syncthreads();
  const int c = tid;
  float acc[DTOK];
#pragma unroll
  for (int k = 0; k < DTOK; ++k) acc[k] = 0.f;
  float yv[DTOK], rv_[DTOK], kmv[DTOK], vv_[DTOK];
#pragma unroll
  for (int k = 0; k < DTOK; ++k) { const int row = rowb + k; const bf16_t* zd = p.z + (size_t)row * NIN + D_0; const size_t o = (size_t)row * 256 + c;
    yv[k] = bf2f(zd[c]) + bf2f(zd[256 + c]); rv_[k] = bf2f(p.pl[o]); kmv[k] = bf2f(p.pl[PLANE + o]); vv_[k] = bf2f(p.pl[2 * PLANE + o]); }
  const float* gup = p.in[I_DGUP] + (size_t)layer * 128 * 256 + c;
#pragma unroll 4
  for (int j = 0; j < 128; ++j) { const float gw = gup[j * 256];
#pragma unroll
    for (int q = 0; q < 4; ++q) { const f32x4 s0 = *(const f32x4*)(sg + j * DTOK + 4 * q);
#pragma unroll
      for (int k = 0; k < 4; ++k) acc[4 * q + k] += s0[k] * gw; } }
  const float gnw = p.in[I_DGNW][layer * 256 + c], gnb = p.in[I_DGNB][layer * 256 + c], rk = p.in[I_DRK][layer * 256 + c];
#pragma unroll
  for (int k = 0; k < DTOK; ++k) {
    const float y = yv[k];
    const float mean = wave_sum(y) * (1.0f / 64.0f); const float d = y - mean; const float var = wave_sum(d * d) * (1.0f / 64.0f);
    const float yn = d * rsqrtf(var + 64e-5f) * gnw + gnb;
    const float r = rv_[k], km = kmv[k], v = vv_[k];
    const float bonus = wave_sum(r * km * rk);
    stg[k * 256 + c] = f2bf((yn + bonus * v) * acc[k]);
  }
  __syncthreads();
#pragma unroll
  for (int i = 0; i < 2; ++i) { const int q = tid + 256 * i, tok = q >> 5, c16 = q & 31;
    const u32x4 v = *(const u32x4*)(stg + tok * 256 + c16 * 8);
    *(u32x4*)(p.pl + 4 * PLANE + (size_t)(rowb + tok) * 256 + c16 * 8) = v; }
  __syncthreads();
}

DI void rwkv_item(char* lds, const Params& p, int seq, int head, int dir, int half) {
  int row0, T; seq_info(seq, row0, T);
  const int tid = opaque(threadIdx.x), kc = tid & 7, vrow = half * 32 + (tid >> 3);
  float* st = (float*)lds;
  f32x2 S[4];
#pragma unroll
  for (int j = 0; j < 4; ++j) S[j] = (f32x2){0.f, 0.f};
  const int nchunk = T >> 4;
  u32x4 rg[3];
  const int tsel = tid >> 7, srem = tid & 127, sstep = srem >> 3, sc8 = srem & 7;
#define RW_GLOAD(c) do { _Pragma("unroll") for (int i_ = 0; i_ < 3; ++i_) { const int tens_ = tsel + 2 * i_; \
      const int plane_ = tens_ == 0 ? (dir ? 6 : 5) : tens_ == 1 ? 3 : tens_ == 2 ? 4 : tens_ == 3 ? 1 : tens_ == 4 ? 0 : 2; \
      const int t_ = dir ? (T - 1 - ((c) * 16 + sstep)) : ((c) * 16 + sstep); \
      rg[i_] = *(const u32x4*)(p.pl + (size_t)plane_ * PLANE + (size_t)(row0 + t_) * 256 + head * 64 + sc8 * 8); } } while (0)
#define RW_LSTORE(buf) do { _Pragma("unroll") for (int i_ = 0; i_ < 3; ++i_) { const int tens_ = tsel + 2 * i_; \
      f32x4 a_ = {bflo(rg[i_].x), bfhi(rg[i_].x), bflo(rg[i_].y), bfhi(rg[i_].y)}, b_ = {bflo(rg[i_].z), bfhi(rg[i_].z), bflo(rg[i_].w), bfhi(rg[i_].w)}; \
      if (tens_ == 0) { a_ = 1.0f - a_; b_ = 1.0f - b_; } \
      float* d_ = st + (((buf) * 16 + sstep) * 6 + tens_) * 64 + sc8 * 8; *(f32x4*)d_ = a_; *(f32x4*)(d_ + 4) = b_; } } while (0)
  __builtin_amdgcn_s_setprio(3);
  RW_GLOAD(0); RW_LSTORE(0); __syncthreads();
  bf16_t* ybase = p.z + (size_t)row0 * NIN + D_0 + dir * 256 + head * 64 + vrow;
  for (int c = 0; c < nchunk; ++c) {
    if (c + 1 < nchunk) RW_GLOAD(c + 1);
    const float* sb = st + (c & 1) * (16 * 384);
#define RW_FETCH(S_, s_) do { const float* q_ = sb + (s_) * 384 + kc * 8; \
      S_##w0 = *(const f32x4*)(q_); S_##w1 = *(const f32x4*)(q_ + 4); S_##n0 = *(const f32x4*)(q_ + 64); S_##n1 = *(const f32x4*)(q_ + 68); \
      S_##b0 = *(const f32x4*)(q_ + 128); S_##b1 = *(const f32x4*)(q_ + 132); S_##k0 = *(const f32x4*)(q_ + 192); S_##k1 = *(const f32x4*)(q_ + 196); \
      S_##r0 = *(const f32x4*)(q_ + 256); S_##r1 = *(const f32x4*)(q_ + 260); S_##vv = sb[(s_) * 384 + 320 + vrow]; } while (0)
#define LO2(x) ((f32x2){(x)[0], (x)[1]})
#define HI2(x) ((f32x2){(x)[2], (x)[3]})
#define RW_STEP(S_, s_) do { \
      f32x2 a2 = S[0] * LO2(S_##n0); a2 += S[1] * HI2(S_##n0); a2 += S[2] * LO2(S_##n1); a2 += S[3] * HI2(S_##n1); \
      const float sa = red8(a2.x + a2.y); const float vx = S_##vv; \
      S[0] = S[0] * LO2(S_##w0) + (LO2(S_##b0) * sa + LO2(S_##k0) * vx); S[1] = S[1] * HI2(S_##w0) + (HI2(S_##b0) * sa + HI2(S_##k0) * vx); \
      S[2] = S[2] * LO2(S_##w1) + (LO2(S_##b1) * sa + LO2(S_##k1) * vx); S[3] = S[3] * HI2(S_##w1) + (HI2(S_##b1) * sa + HI2(S_##k1) * vx); \
      f32x2 y2 = S[0] * LO2(S_##r0); y2 += S[1] * HI2(S_##r0); y2 += S[2] * LO2(S_##r1); y2 += S[3] * HI2(S_##r1); \
      const float y = red8(y2.x + y2.y); const float yn = DPPF(y, 0x128);     \
      if ((tid & 15) == 0) { const int t_ = dir ? (T - 1 - (c * 16 + (s_))) : (c * 16 + (s_)); *(unsigned*)(ybase + (size_t)t_ * NIN) = pk(y, yn); } } while (0)
    f32x4 Aw0, Aw1, An0, An1, Ab0, Ab1, Ak0, Ak1, Ar0, Ar1; float Avv;
    f32x4 Bw0, Bw1, Bn0, Bn1, Bb0, Bb1, Bk0, Bk1, Br0, Br1; float Bvv;
    RW_FETCH(A, 0);
#pragma unroll 2
    for (int s = 0; s < 16; s += 2) {
      RW_FETCH(B, s + 1);
      RW_STEP(A, s);
      if (s + 2 < 16) RW_FETCH(A, s + 2);
      RW_STEP(B, s + 1);
    }
#undef RW_FETCH
#undef RW_STEP
    if (c + 1 < nchunk) RW_LSTORE((c + 1) & 1);
    __syncthreads();
  }
#undef RW_GLOAD
#undef RW_LSTORE
  __builtin_amdgcn_s_setprio(0);
}

template <int MODE>
DI void attn_item(char* lds, const Params& p, int layer, int seq, int head, int qt) {
  const int tid = opaque(threadIdx.x), lane = tid & 63, w = tid >> 6, l31 = lane & 31, h = lane >> 5;
  layer = opaque_s(layer); seq = opaque_s(seq); head = opaque_s(head); qt = opaque_s(qt);
  int row0, T; seq_info(seq, row0, T);
  const int QC = (MODE == 0 ? A_Q : MODE == 1 ? B_Q : C_Q) + head * 64;
  const int KC = MODE == 0 ? A_K + (head >> 1) * 64 : MODE == 1 ? B_K + head * 64 : C_K + head * 64;
  const int VC = MODE == 0 ? A_V + (head >> 1) * 64 : MODE == 1 ? B_V + head * 64 : C_V + head * 64;
  const int qw0 = qt * 128 + w * 32, qi = qw0 + l31;
  bf16_t* zq = p.z + (size_t)(row0 + qi) * NIN + QC;
  bf16x8 qf[4];
#pragma unroll
  for (int s = 0; s < 4; ++s) qf[s] = *(const bf16x8*)(zq + s * 16 + h * 8);
  const int srow = tid >> 3, sc8 = tid & 7;
  const bf16_t* kbase = p.z + (size_t)(row0 + srow) * NIN + KC + sc8 * 8;
  const bf16_t* vbase = p.z + (size_t)(row0 + srow) * NIN + VC + sc8 * 8;
  u32x4 rk[2][2], rv[2][2];
  const int nt = T >> 6;
  const int prow = (l31 & 19) | ((l31 & 4) << 1) | ((l31 & 8) >> 1);
#define AT_GLOAD(t, S) do { _Pragma("unroll") for (int i_ = 0; i_ < 2; ++i_) { const size_t off_ = (size_t)((t) * 64 + 32 * i_) * NIN; rk[S][i_] = *(const u32x4*)(kbase + off_); rv[S][i_] = *(const u32x4*)(vbase + off_); } } while (0)
#define AT_LSTORE(buf, S) do { char* ks_ = lds + (buf) * 18432; char* vs_ = ks_ + 9216; \
    _Pragma("unroll") for (int i_ = 0; i_ < 2; ++i_) { *(u32x4*)(ks_ + (srow + 32 * i_) * PITCH + sc8 * 16) = rk[S][i_]; *(u32x4*)(vs_ + (srow + 32 * i_) * PITCH + sc8 * 16) = rv[S][i_]; } } while (0)
  constexpr int NMAP = (MODE == 1) ? 2 : 1;
  f32x16 o[NMAP][2];
  float m_run[NMAP], l_run[NMAP];
#pragma unroll
  for (int a = 0; a < NMAP; ++a) { m_run[a] = -INFINITY; l_run[a] = 0.f;
#pragma unroll
    for (int b = 0; b < 2; ++b)
#pragma unroll
      for (int i = 0; i < 16; ++i) o[a][b][i] = 0.f; }
  float lf = 0.f, lb = 0.f;
  if (MODE == 2) { lf = log2f(1.0f - exp2f(-5.0f - (float)head)); lb = log2f(1.0f - exp2f(-5.0f - (float)(3 - head))); }
  auto body = [&](const char* ks, const char* vs, const int t) __attribute__((always_inline)) {
#pragma unroll
    for (int mp = 0; mp < NMAP; ++mp) {
      f32x16 st[2];
#pragma unroll
      for (int kf = 0; kf < 2; ++kf) {
#pragma unroll
        for (int i = 0; i < 16; ++i) st[kf][i] = 0.f;
        if (MODE == 1) {
#pragma unroll
          for (int s = 0; s < 2; ++s) { const bf16x8 kfr = *(const bf16x8*)(ks + (kf * 32 + prow) * PITCH + (mp * 2 + s) * 32 + h * 16); st[kf] = MFMA32(kfr, qf[mp * 2 + s], st[kf]); }
        } else {
#pragma unroll
          for (int s = 0; s < 4; ++s) { const bf16x8 kfr = *(const bf16x8*)(ks + (kf * 32 + prow) * PITCH + s * 32 + h * 16); st[kf] = MFMA32(kfr, qf[s], st[kf]); }
        }
      }
      if (MODE == 2) {
        const int k0 = t * 64;
        const float dbase = (float)(qi - k0 - 8 * h);
        if (k0 + 63 < qw0) {
#pragma unroll
          for (int kf = 0; kf < 2; ++kf)
#pragma unroll
            for (int i = 0; i < 16; ++i) { const float cc = (float)(32 * kf + (i & 3) + 4 * ((i >> 2) & 1) + 16 * ((i >> 3) & 1)); st[kf][i] *= fexp2(lf * (dbase - cc)); }
        } else if (k0 > qw0 + 31) {
#pragma unroll
          for (int kf = 0; kf < 2; ++kf)
#pragma unroll
            for (int i = 0; i < 16; ++i) { const float cc = (float)(32 * kf + (i & 3) + 4 * ((i >> 2) & 1) + 16 * ((i >> 3) & 1)); st[kf][i] *= fexp2(lb * (cc - dbase)); }
        } else {
#pragma unroll
          for (int kf = 0; kf < 2; ++kf)
#pragma unroll
            for (int i = 0; i < 16; ++i) { const float cc = (float)(32 * kf + (i & 3) + 4 * ((i >> 2) & 1) + 16 * ((i >> 3) & 1)); const float d = dbase - cc;
              float dd = fexp2(fminf(lf * d, -lb * d)); if (d == 0.f) dd = 2.0f; st[kf][i] *= dd; }
        }
      } else {
        float mx = st[0][0];
#pragma unroll
        for (int kf = 0; kf < 2; ++kf)
#pragma unroll
          for (int i = 0; i < 16; ++i) mx = fmaxf(mx, st[kf][i]);
        mx = fmaxf(mx, __shfl_xor(mx, 32));
        const float mn = fmaxf(m_run[mp], mx); const float alpha = fexp2(m_run[mp] - mn); m_run[mp] = mn;
        float ps = 0.f;
#pragma unroll
        for (int kf = 0; kf < 2; ++kf)
#pragma unroll
          for (int i = 0; i < 16; ++i) { st[kf][i] = fexp2(st[kf][i] - mn); ps += st[kf][i]; }
        l_run[mp] = l_run[mp] * alpha + ps;
#pragma unroll
        for (int df = 0; df < 2; ++df) o[mp][df] *= alpha;
      }
      bf16x8 pf[4];
#pragma unroll
      for (int kf = 0; kf < 2; ++kf)
#pragma unroll
        for (int s2 = 0; s2 < 2; ++s2) { u32x4 u; u.x = pk(st[kf][8 * s2], st[kf][8 * s2 + 1]); u.y = pk(st[kf][8 * s2 + 2], st[kf][8 * s2 + 3]);
          u.z = pk(st[kf][8 * s2 + 4], st[kf][8 * s2 + 5]); u.w = pk(st[kf][8 * s2 + 6], st[kf][8 * s2 + 7]); pf[kf * 2 + s2] = __builtin_bit_cast(bf16x8, u); }
#pragma unroll
      for (int df = 0; df < 2; ++df)
#pragma unroll
        for (int ksx = 0; ksx < 4; ++ksx) { const bf16x8 vfr = *(const bf16x8*)(vs + (df * 32 + l31) * PITCH + ksx * 32 + h * 16); o[mp][df] = MFMA32(vfr, pf[ksx], o[mp][df]); }
    }
  };
  if constexpr (MODE == 1) {
    AT_GLOAD(0, 0); AT_LSTORE(0, 0); __syncthreads();
#pragma unroll 1
    for (int t = 0; t < nt; ++t) {
      if (t + 1 < nt) AT_GLOAD(t + 1, 0);
      const char* ks = lds + (t & 1) * 18432;
      body(ks, ks + 9216, t);
      if (t + 1 < nt) AT_LSTORE((t + 1) & 1, 0);
      __syncthreads();
    }
  } else {
    AT_GLOAD(0, 0); AT_GLOAD(1, 1); AT_LSTORE(0, 0); __syncthreads();
#pragma unroll 1
    for (int t2 = 0; t2 < nt; t2 += 2) {
      if (t2 + 2 < nt) AT_GLOAD(t2 + 2, 0);
      body(lds, lds + 9216, t2);
      AT_LSTORE(1, 1);
      __syncthreads();
      if (t2 + 3 < nt) AT_GLOAD(t2 + 3, 1);
      body(lds + 18432, lds + 18432 + 9216, t2 + 1);
      if (t2 + 2 < nt) AT_LSTORE(0, 0);
      __syncthreads();
    }
  }
#undef AT_GLOAD
#undef AT_LSTORE
  f32x16 r[2];
  if (MODE == 0) {
    const float l = l_run[0] + __shfl_xor(l_run[0], 32); const float inv = 1.0f / l;
#pragma unroll
    for (int df = 0; df < 2; ++df) r[df] = o[0][df] * inv;
  } else if (MODE == 1) {
    const float* lp = p.in[I_BLAM] + layer * 128;
    float s01 = 0.f, s23 = 0.f;
    for (int i = 0; i < 32; ++i) { s01 += lp[i] * lp[32 + i]; s23 += lp[64 + i] * lp[96 + i]; }
    const float lam_init = 0.8f - 0.6f * expf(-0.3f * (float)layer);
    const float lam = expf(s01) - expf(s23) + lam_init;
    const float l0 = l_run[0] + __shfl_xor(l_run[0], 32), l1 = l_run[NMAP - 1] + __shfl_xor(l_run[NMAP - 1], 32);
    const float i0 = 1.0f / l0, i1 = lam / l1;
    float ss = 0.f;
#pragma unroll
    for (int df = 0; df < 2; ++df) { r[df] = o[0][df] * i0 - o[NMAP - 1][df] * i1;
#pragma unroll
      for (int i = 0; i < 16; ++i) ss += r[df][i] * r[df][i]; }
    ss += __shfl_xor(ss, 32);
    const float rs = rsqrtf(ss * (1.0f / 64.0f) + EPS) * (1.0f - lam_init);
    const float* sg = p.in[I_BSUB] + layer * 64;
#pragma unroll
    for (int df = 0; df < 2; ++df)
#pragma unroll
      for (int i = 0; i < 16; ++i) r[df][i] *= rs * sg[df * 32 + (i & 3) + 8 * (i >> 2) + 4 * h];
  } else {
    float ss = 0.f;
#pragma unroll
    for (int df = 0; df < 2; ++df)
#pragma unroll
      for (int i = 0; i < 16; ++i) ss += o[0][df][i] * o[0][df][i];
    ss += __shfl_xor(ss, 32);
    const float rs = rsqrtf(ss * (1.0f / 64.0f) + EPS);
    const float* gg = p.in[I_CGN] + layer * 256 + head * 64;
    const bf16_t* zg = p.z + (size_t)(row0 + qi) * NIN + C_G + head * 64;
#pragma unroll
    for (int df = 0; df < 2; ++df)
#pragma unroll
      for (int g = 0; g < 4; ++g) { const u32x2 gw = *(const u32x2*)(zg + df * 32 + 8 * g + 4 * h);
        const float gv[4] = {bflo(gw.x), bfhi(gw.x), bflo(gw.y), bfhi(gw.y)};
#pragma unroll
        for (int e = 0; e < 4; ++e) { const float x = gv[e]; r[df][4 * g + e] = o[0][df][4 * g + e] * rs * gg[df * 32 + 8 * g + 4 * h + e] * (x / (1.0f + __expf(-x))); } }
  }
#pragma unroll
  for (int df = 0; df < 2; ++df)
#pragma unroll
    for (int g = 0; g < 4; ++g) { u32x2 v; v.x = pk(r[df][4 * g], r[df][4 * g + 1]); v.y = pk(r[df][4 * g + 2], r[df][4 * g + 3]); *(u32x2*)(zq + df * 32 + 8 * g + 4 * h) = v; }
}

template <class Epi>
DI void gemm_tile2(char* lds, const ASrc& A, const bf16_t* __restrict__ Bt, int K, int m0, int n0, const Epi& epi) {
  const int tid = opaque(threadIdx.x), lane = tid & 63, w = __builtin_amdgcn_readfirstlane(tid >> 6), wr = w >> 1, wc = w & 1, l31 = lane & 31, h = lane >> 5;
  const int nk = K >> 5, smask = (1 << A.shift) - 1;
  LASP char* ldsl = (LASP char*)lds;
  f32x16 acc[2][4];
#pragma unroll
  for (int a = 0; a < 2; ++a)
#pragma unroll
    for (int b = 0; b < 4; ++b)
#pragma unroll
      for (int i = 0; i < 16; ++i) acc[a][b][i] = 0.f;
  const int lrow = lane >> 2, lslot = lane & 3;
  int goffA[2], goffB[4];
#pragma unroll
  for (int i = 0; i < 2; ++i) { const int r = (2 * w + i) * 16 + lrow, c = lslot ^ ((r >> 2) & 3); goffA[i] = (r << 2) | c; }
#pragma unroll
  for (int i = 0; i < 4; ++i) { const int r = (4 * w + i) * 16 + lrow, c = lslot ^ ((r >> 2) & 3); goffB[i] = r * K + c * 8; }
#define G2_ISSUE(kt, st) do { const int k0_ = (kt) << 5, seg_ = k0_ >> A.shift, kk_ = k0_ & smask; \
    const bf16_t* bp_ = seg_ == 0 ? A.b0 : seg_ == 1 ? A.b1 : seg_ == 2 ? A.b2 : A.b3; const int st_ = seg_ == 0 ? A.s0 : seg_ == 1 ? A.s1 : seg_ == 2 ? A.s2 : A.s3; \
    _Pragma("unroll") for (int i_ = 0; i_ < 2; ++i_) { \
      const bf16_t* ga_ = bp_ + (size_t)(m0 + (goffA[i_] >> 2)) * st_ + kk_ + (goffA[i_] & 3) * 8; \
      __builtin_amdgcn_global_load_lds((const unsigned*)ga_, (LASP unsigned*)(ldsl + (st) * 24576 + (2 * w + i_) * 1024), 16, 0, 0); } \
    _Pragma("unroll") for (int i_ = 0; i_ < 4; ++i_) { \
      const bf16_t* gb_ = Bt + (size_t)n0 * K + goffB[i_] + k0_; \
      __builtin_amdgcn_global_load_lds((const unsigned*)gb_, (LASP unsigned*)(ldsl + (st) * 24576 + 8192 + (4 * w + i_) * 1024), 16, 0, 0); } } while (0)
  const int xr = (l31 >> 2) & 3;
  int coff[2];
#pragma unroll
  for (int s = 0; s < 2; ++s) coff[s] = ((2 * s + h) ^ xr) * 16;
#define G2_COMPUTE(st) do { const char* as = lds + (st) * 24576; const char* bs = as + 8192; \
    bf16x8 af[2][2], wf[2][4]; \
    _Pragma("unroll") for (int s = 0; s < 2; ++s) { \
      _Pragma("unroll") for (int mf = 0; mf < 2; ++mf) af[s][mf] = *(const bf16x8*)(as + (wr * 64 + mf * 32 + l31) * 64 + coff[s]); \
      _Pragma("unroll") for (int nf = 0; nf < 4; ++nf) wf[s][nf] = *(const bf16x8*)(bs + (wc * 128 + nf * 32 + l31) * 64 + coff[s]); } \
    __builtin_amdgcn_sched_barrier(0); __builtin_amdgcn_s_setprio(1); \
    _Pragma("unroll") for (int s = 0; s < 2; ++s) \
      _Pragma("unroll") for (int mf = 0; mf < 2; ++mf) _Pragma("unroll") for (int nf = 0; nf < 4; ++nf) acc[mf][nf] = MFMA32(wf[s][nf], af[s][mf], acc[mf][nf]); \
    __builtin_amdgcn_s_setprio(0); __builtin_amdgcn_sched_barrier(0); } while (0)
  G2_ISSUE(0, 0);
  for (int kt = 0; kt < nk; kt += 2) {
    asm volatile("s_waitcnt vmcnt(0)" ::: "memory"); __syncthreads();
    G2_ISSUE(kt + 1, 1);
    G2_COMPUTE(0);
    asm volatile("s_waitcnt vmcnt(0)" ::: "memory"); __syncthreads();
    if (kt + 2 < nk) G2_ISSUE(kt + 2, 0);
    G2_COMPUTE(1);
  }
  __syncthreads();
#pragma unroll
  for (int hf = 0; hf < 2; ++hf) {
    f32x16 t[2][2];
#pragma unroll
    for (int mf = 0; mf < 2; ++mf) { t[mf][0] = acc[mf][2 * hf]; t[mf][1] = acc[mf][2 * hf + 1]; }
    epi(t, m0 + wr * 64, n0 + wc * 128 + hf * 64, n0, wc, l31, h);
  }
  __syncthreads();
#undef G2_ISSUE
#undef G2_COMPUTE
}

template <class Epi>
DI void gemm_phase2(char* lds, const ASrc& A, const bf16_t* Bt, int K, int ntn, const Epi& epi) {
  const int xcd = blockIdx.x & 7, j = blockIdx.x >> 3, nloc = gridDim.x >> 3, per = 48 * ntn, grp = 8 * ntn;
  for (int li = j; li < per; li += nloc) {
    const int sg = li / grp, wi = li - sg * grp, nt = wi >> 3, mt = xcd * 48 + sg * 8 + (wi & 7);
    gemm_tile2(lds, A, Bt, K, mt * 128, nt * 256, epi);
  }
}

template <int MODE>
DI void attn3_item(char* lds, const Params& p, int layer, int seq, int head, int qt) {
  const int tid = opaque(threadIdx.x), lane = tid & 63, w = tid >> 6, l31 = lane & 31, h = lane >> 5;
  layer = opaque_s(layer); seq = opaque_s(seq); head = opaque_s(head); qt = opaque_s(qt);
  int row0, T; seq_info(seq, row0, T);
  const int QC = (MODE == 0 ? A_Q : C_Q) + head * 64;
  const int KC = MODE == 0 ? A_K + (head >> 1) * 64 : C_K + head * 64;
  const int VC = MODE == 0 ? A_V + (head >> 1) * 64 : C_V + head * 64;
  const int qw0 = qt * 256 + w * 64;
  bf16x8 qf[2][4];
#pragma unroll
  for (int qi = 0; qi < 2; ++qi)
#pragma unroll
    for (int s = 0; s < 4; ++s) qf[qi][s] = *(const bf16x8*)(p.z + (size_t)(row0 + qw0 + qi * 32 + l31) * NIN + QC + s * 16 + h * 8);
  const int srow = tid >> 3, sc8 = tid & 7;
  const bf16_t* kbase = p.z + (size_t)(row0 + srow) * NIN + KC + sc8 * 8;
  const bf16_t* vbase = p.z + (size_t)(row0 + srow) * NIN + VC + sc8 * 8;
  u32x4 rk[2], rv[2];
  const int nt = T >> 6;
  const int prow = (l31 & 19) | ((l31 & 4) << 1) | ((l31 & 8) >> 1);
#define A3_GLOAD(t) do { _Pragma("unroll") for (int i_ = 0; i_ < 2; ++i_) { const size_t off_ = (size_t)((t) * 64 + 32 * i_) * NIN; rk[i_] = *(const u32x4*)(kbase + off_); rv[i_] = *(const u32x4*)(vbase + off_); } } while (0)
#define A3_LSTORE(buf) do { char* ks_ = lds + (buf) * 18432; char* vs_ = ks_ + 9216; \
    _Pragma("unroll") for (int i_ = 0; i_ < 2; ++i_) { *(u32x4*)(ks_ + (srow + 32 * i_) * PITCH + sc8 * 16) = rk[i_]; *(u32x4*)(vs_ + (srow + 32 * i_) * PITCH + sc8 * 16) = rv[i_]; } } while (0)
  f32x16 o[2][2];
  float m_run[2], l_run[2];
#pragma unroll
  for (int a = 0; a < 2; ++a) { m_run[a] = -INFINITY; l_run[a] = 0.f;
#pragma unroll
    for (int b = 0; b < 2; ++b)
#pragma unroll
      for (int i = 0; i < 16; ++i) o[a][b][i] = 0.f; }
  float lf = 0.f, lb = 0.f;
  if (MODE == 2) { lf = log2f(1.0f - exp2f(-5.0f - (float)head)); lb = log2f(1.0f - exp2f(-5.0f - (float)(3 - head))); }
  A3_GLOAD(0); A3_LSTORE(0); __syncthreads();
#pragma unroll 1
  for (int t = 0; t < nt; ++t) {
    if (t + 1 < nt) A3_GLOAD(t + 1);
    const char* ks = lds + (t & 1) * 18432; const char* vs = ks + 9216;
    f32x16 st[2][2];
#pragma unroll
    for (int kf = 0; kf < 2; ++kf) {
#pragma unroll
      for (int qi = 0; qi < 2; ++qi)
#pragma unroll
        for (int i = 0; i < 16; ++i) st[qi][kf][i] = 0.f;
#pragma unroll
      for (int s = 0; s < 4; ++s) { const bf16x8 kfr = *(const bf16x8*)(ks + (kf * 32 + prow) * PITCH + s * 32 + h * 16);
#pragma unroll
        for (int qi = 0; qi < 2; ++qi) st[qi][kf] = MFMA32(kfr, qf[qi][s], st[qi][kf]); }
    }
    __builtin_amdgcn_sched_barrier(0);
#pragma unroll
    for (int qi = 0; qi < 2; ++qi) {
      bf16x8 pf[4];
      if (MODE == 2) {
        const int k0 = t * 64, qb = qw0 + qi * 32;
        const float dbase = (float)(qb + l31 - k0 - 8 * h);
        if (k0 + 63 < qb) {
#pragma unroll
          for (int kf = 0; kf < 2; ++kf)
#pragma unroll
            for (int i = 0; i < 16; ++i) { const float cc = (float)(32 * kf + (i & 3) + 4 * ((i >> 2) & 1) + 16 * ((i >> 3) & 1)); st[qi][kf][i] *= fexp2(lf * (dbase - cc)); }
        } else if (k0 > qb + 31) {
#pragma unroll
          for (int kf = 0; kf < 2; ++kf)
#pragma unroll
            for (int i = 0; i < 16; ++i) { const float cc = (float)(32 * kf + (i & 3) + 4 * ((i >> 2) & 1) + 16 * ((i >> 3) & 1)); st[qi][kf][i] *= fexp2(lb * (cc - dbase)); }
        } else {
#pragma unroll
          for (int kf = 0; kf < 2; ++kf)
#pragma unroll
            for (int i = 0; i < 16; ++i) { const float cc = (float)(32 * kf + (i & 3) + 4 * ((i >> 2) & 1) + 16 * ((i >> 3) & 1)); const float d = dbase - cc;
              float dd = fexp2(fminf(lf * d, -lb * d)); if (d == 0.f) dd = 2.0f; st[qi][kf][i] *= dd; }
        }
      } else {
        float mx = st[qi][0][0];
#pragma unroll
        for (int kf = 0; kf < 2; ++kf)
#pragma unroll
          for (int i = 0; i < 16; ++i) mx = fmaxf(mx, st[qi][kf][i]);
        mx = fmaxf(mx, __shfl_xor(mx, 32));
        const float mn = fmaxf(m_run[qi], mx); const float alpha = fexp2(m_run[qi] - mn); m_run[qi] = mn;
        float ps = 0.f;
#pragma unroll
        for (int kf = 0; kf < 2; ++kf)
#pragma unroll
          for (int i = 0; i < 16; ++i) { st[qi][kf][i] = fexp2(st[qi][kf][i] - mn); ps += st[qi][kf][i]; }
        l_run[qi] = l_run[qi] * alpha + ps;
#pragma unroll
        for (int df = 0; df < 2; ++df) o[qi][df] *= alpha;
      }
#pragma unroll
      for (int kf = 0; kf < 2; ++kf)
#pragma unroll
        for (int s2 = 0; s2 < 2; ++s2) { u32x4 u; u.x = pk(st[qi][kf][8 * s2], st[qi][kf][8 * s2 + 1]); u.y = pk(st[qi][kf][8 * s2 + 2], st[qi][kf][8 * s2 + 3]);
          u.z = pk(st[qi][kf][8 * s2 + 4], st[qi][kf][8 * s2 + 5]); u.w = pk(st[qi][kf][8 * s2 + 6], st[qi][kf][8 * s2 + 7]); pf[kf * 2 + s2] = __builtin_bit_cast(bf16x8, u); }
#pragma unroll
      for (int df = 0; df < 2; ++df)
#pragma unroll
        for (int ksx = 0; ksx < 4; ++ksx) { const bf16x8 vfr = *(const bf16x8*)(vs + (df * 32 + l31) * PITCH + ksx * 32 + h * 16); o[qi][df] = MFMA32(vfr, pf[ksx], o[qi][df]); }
      __builtin_amdgcn_sched_barrier(0);
    }
    __builtin_amdgcn_sched_barrier(0);
    if (t + 1 < nt) A3_LSTORE((t + 1) & 1);
    __syncthreads();
  }
#undef A3_GLOAD
#undef A3_LSTORE
#pragma unroll
  for (int qi = 0; qi < 2; ++qi) {
    const int qrow = row0 + qw0 + qi * 32 + l31;
    bf16_t* zq = p.z + (size_t)qrow * NIN + QC;
    f32x16 r[2];
    if (MODE == 0) {
      const float l = l_run[qi] + __shfl_xor(l_run[qi], 32); const float inv = 1.0f / l;
#pragma unroll
      for (int df = 0; df < 2; ++df) r[df] = o[qi][df] * inv;
    } else {
      float ss = 0.f;
#pragma unroll
      for (int df = 0; df < 2; ++df)
#pragma unroll
        for (int i = 0; i < 16; ++i) ss += o[qi][df][i] * o[qi][df][i];
      ss += __shfl_xor(ss, 32);
      const float rs = rsqrtf(ss * (1.0f / 64.0f) + EPS);
      const float* gg = p.in[I_CGN] + layer * 256 + head * 64;
      const bf16_t* zg = p.z + (size_t)qrow * NIN + C_G + head * 64;
#pragma unroll
      for (int df = 0; df < 2; ++df)
#pragma unroll
        for (int g = 0; g < 4; ++g) { const u32x2 gw = *(const u32x2*)(zg + df * 32 + 8 * g + 4 * h);
          const float gv[4] = {bflo(gw.x), bfhi(gw.x), bflo(gw.y), bfhi(gw.y)};
#pragma unroll
          for (int e = 0; e < 4; ++e) { const float x = gv[e]; r[df][4 * g + e] = o[qi][df][4 * g + e] * rs * gg[df * 32 + 8 * g + 4 * h + e] * (x / (1.0f + __expf(-x))); } }
    }
#pragma unroll
    for (int df = 0; df < 2; ++df)
#pragma unroll
      for (int g = 0; g < 4; ++g) { u32x2 v; v.x = pk(r[df][4 * g], r[df][4 * g + 1]); v.y = pk(r[df][4 * g + 2], r[df][4 * g + 3]); *(u32x2*)(zq + df * 32 + 8 * g + 4 * h) = v; }
  }
}

DI void ctr_barrier(unsigned* cnt) {
  asm volatile("s_waitcnt vmcnt(0) lgkmcnt(0)" ::: "memory");
  __syncthreads();
  if (threadIdx.x == 0) {
    __builtin_amdgcn_fence(__ATOMIC_RELEASE, "agent");
    asm volatile("s_waitcnt vmcnt(0)" ::: "memory");
    const unsigned G = gridDim.x;
    const unsigned old = __hip_atomic_fetch_add(cnt, 1u, __ATOMIC_RELAXED, __HIP_MEMORY_SCOPE_AGENT);
    const unsigned gen = old / G + 1u;
    if (old + 1u == gen * G) __hip_atomic_store(cnt + 64, gen, __ATOMIC_RELAXED, __HIP_MEMORY_SCOPE_AGENT);
    else while (__hip_atomic_load(cnt + 64, __ATOMIC_RELAXED, __HIP_MEMORY_SCOPE_AGENT) < gen) __builtin_amdgcn_s_sleep(1);
    __builtin_amdgcn_fence(__ATOMIC_ACQUIRE, "agent");
    asm volatile("s_waitcnt vmcnt(0)" ::: "memory");
  }
  __syncthreads();
}

DI int next_item(int* ctr, int* sh) {
  __syncthreads();
  if (threadIdx.x == 0) *sh = atomicAdd(ctr, 1);
  __syncthreads();
  return *sh;
}
constexpr int XQ_N = 416;
DI int next_item_x(int* ctr8, int* sh) {
  __syncthreads();
  if (threadIdx.x == 0) {
    int r = -1;
    const int x0 = blockIdx.x & 7;
    for (int k = 0; k < 8; ++k) { const int x = (x0 + k) & 7; const int i = atomicAdd(ctr8 + x, 1); if (i < XQ_N) { r = (x << 16) | i; break; } }
    *sh = r;
  }
  __syncthreads();
  return *sh;
}

__global__ void __launch_bounds__(256, 2) fwd(Params p) {
  extern __shared__ __attribute__((aligned(16))) char lds[];
  __shared__ int s_item;
  cg::grid_group grid = cg::this_grid();
  const int bid = blockIdx.x, nb = gridDim.x, tid = threadIdx.x, lane = tid & 63, w = tid >> 6;
  if (bid == 0) p.ctr[tid] = 0;
  for (int i = bid * 256 + tid; i < 4096 * 32; i += nb * 256) { const int t = i >> 5, j = i & 31; const float inv = powf(10000.0f, -(float)(2 * j) / 64.0f); float sn, cs; sincosf((float)t * inv, &sn, &cs); p.tabC[i] = (f32x2){cs, sn}; }
  for (int i = bid * 256 + tid; i < 4096 * 4; i += nb * 256) { const int t = i >> 2, j = i & 3; const float inv = powf(500000.0f, -(float)(2 * j) / 8.0f); float sn, cs; sincosf((float)t * inv, &sn, &cs); p.tabB[i] = (f32x2){cs, sn}; }
  for (int i = bid * 256 + tid; i < 64 * 16; i += nb * 256) { const int t = i >> 4, j = i & 15; const float inv = powf(10000.0f, -(float)(2 * j) / 32.0f); float sn, cs; sincosf((float)t * inv, &sn, &cs); p.tabA[i] = (f32x2){cs, sn}; }
  for (int l = 0; l < 2; ++l) {
    for (int i = bid * 256 + tid; i < (NINP - NIN) * 1024; i += nb * 256) p.wtin[(size_t)l * NINP * 1024 + (size_t)NIN * 1024 + i] = 0;
    for (int tl = bid; tl < 16 * 53; tl += nb) conv_T(lds, p.in[I_WIN] + (size_t)l * 1024 * NIN, 1024, NIN, p.wtin + (size_t)l * NINP * 1024, 0, tl);
    for (int tl = bid; tl < 16 * 16; tl += nb) conv_T(lds, p.in[I_WOUT] + (size_t)l * 1024 * 1024, 1024, 1024, p.wtout + (size_t)l * 1024 * 1024, 0, tl);
  }
  bf16_t* hb = p.pl;
  for (int row = bid * 4 + opaque(w); row < MT; row += nb * 8) {
    const int rb = row + nb * 4;
    const float* xin = row < M0 ? p.in[I_XP] + (size_t)row * 1024 : p.in[I_XS] + (size_t)(row - M0) * 1024;
    if (rb < MT) { const float* xinb = rb < M0 ? p.in[I_XP] + (size_t)rb * 1024 : p.in[I_XS] + (size_t)(rb - M0) * 1024;
      row_phase2(xin, xinb, p.out + (size_t)row * 1024, p.out + (size_t)rb * 1024, nullptr, nullptr, nullptr, p.in[I_NMPRE], hb + (size_t)row * 1024, hb + (size_t)rb * 1024, lane); }
    else row_phase(xin, p.out + (size_t)row * 1024, nullptr, nullptr, p.in[I_NMPRE], hb + (size_t)row * 1024, lane);
  }
  grid.sync();
  for (int l = 0; l < 2; ++l) {
    { ASrc A; A.b0 = hb; A.b1 = hb; A.b2 = hb; A.b3 = hb; A.s0 = A.s1 = A.s2 = A.s3 = 1024; A.shift = 12;
      EpiIn e; e.z = p.z; e.lds = lds; e.qg = p.in[I_AQG] + l * 64; e.kg = p.in[I_AKG] + l * 64; e.tabA = p.tabA; e.tabB = p.tabB; e.tabC = p.tabC;
      gemm_phase2(lds, A, p.wtin + (size_t)l * NINP * 1024, 1024, 14, e); }
    ctr_barrier((unsigned*)p.ctr + 96);
    for (int it = bid; it < MT / DTOK; it += nb) dprep_item(lds, p, l, it);
    ctr_barrier((unsigned*)p.ctr + 96);
    for (;;) {
      const int it = next_item_x(p.ctr + l * 16, &s_item);
      if (it < 0) break;
      const int x = it >> 16; int i = it & 0xffff;
      if (i < 32) { const int j = i & 15; rwkv_item(lds, p, i < 16 ? x : 8 + x, (j >> 2) & 3, (j >> 1) & 1, j & 1); }
      else { i -= 32;
        if (i < 128) attn_item<1>(lds, p, l, x, i >> 5, i & 31);
        else if (i < 192) { i -= 128; attn3_item<2>(lds, p, l, x, i >> 4, i & 15); }
        else if (i < 256) { i -= 192; attn3_item<0>(lds, p, l, x, i >> 4, i & 15); }
        else if (i < 320) { i -= 256; attn_item<1>(lds, p, l, 8 + x, i >> 4, i & 15); }
        else if (i < 352) { i -= 320; attn3_item<2>(lds, p, l, 8 + x, i >> 3, i & 7); }
        else { i -= 352; attn3_item<0>(lds, p, l, 8 + x, i >> 3, i & 7); }
      }
    }
    ctr_barrier((unsigned*)p.ctr + 96);
    bf16_t* wtgu = p.pl + 5 * PLANE; bf16_t* wtd = wtgu + (size_t)2 * DFF * 1024;
    for (int it = bid; it < MT / DTOK + 3 * 704; it += nb) {
      if (it < MT / DTOK) dpost_item(lds, p, l, it);
      else { const int j = it - MT / DTOK;
        if (j < 704) conv_T(lds, p.in[I_FG] + (size_t)l * 1024 * DFF, 1024, DFF, wtgu, 1, j);
        else if (j < 1408) conv_T(lds, p.in[I_FU] + (size_t)l * 1024 * DFF, 1024, DFF, wtgu, 2, j - 704);
        else conv_T(lds, p.in[I_FD] + (size_t)l * DFF * 1024, DFF, 1024, wtd, 0, j - 1408); }
    }
    ctr_barrier((unsigned*)p.ctr + 96);
    { ASrc A; A.b0 = p.z + A_Q; A.b1 = p.z + B_Q; A.b2 = p.z + C_Q; A.b3 = p.pl + 4 * PLANE; A.s0 = A.s1 = A.s2 = NIN; A.s3 = 256; A.shift = 8;
      EpiStore e; e.out = hb; e.ldc = 1024; e.nmax = 1024;
      gemm_phase2(lds, A, p.wtout + (size_t)l * 1024 * 1024, 1024, 4, e); }
    ctr_barrier((unsigned*)p.ctr + 96);
    for (int row = bid * 4 + opaque(w); row < MT; row += nb * 8) { const int rb = row + nb * 4;
      if (rb < MT) row_phase2(p.out + (size_t)row * 1024, p.out + (size_t)rb * 1024, p.out + (size_t)row * 1024, p.out + (size_t)rb * 1024, hb + (size_t)row * 1024, hb + (size_t)rb * 1024,
                              p.in[I_NMPOST] + l * 1024, p.in[I_NFPRE] + l * 1024, hb + (size_t)row * 1024, hb + (size_t)rb * 1024, lane);
      else row_phase(p.out + (size_t)row * 1024, p.out + (size_t)row * 1024, hb + (size_t)row * 1024, p.in[I_NMPOST] + l * 1024, p.in[I_NFPRE] + l * 1024, hb + (size_t)row * 1024, lane); }
    ctr_barrier((unsigned*)p.ctr + 96);
    { ASrc A; A.b0 = hb; A.b1 = hb; A.b2 = hb; A.b3 = hb; A.s0 = A.s1 = A.s2 = A.s3 = 1024; A.shift = 12;
      EpiSwiGLU e; e.out = p.z;
      gemm_phase2(lds, A, wtgu, 1024, 22, e); }
    ctr_barrier((unsigned*)p.ctr + 96);
    { ASrc A; A.b0 = p.z; A.b1 = p.z; A.b2 = p.z; A.b3 = p.z; A.s0 = A.s1 = A.s2 = A.s3 = DFF; A.shift = 12;
      EpiStore e; e.out = hb; e.ldc = 1024; e.nmax = 1024;
      gemm_phase2(lds, A, wtd, DFF, 4, e); }
    ctr_barrier((unsigned*)p.ctr + 96);
    for (int row = bid * 4 + opaque(w); row < MT; row += nb * 8) { const int rb = row + nb * 4; const float* gp2 = l == 0 ? p.in[I_NMPRE] + 1024 : nullptr;
      if (rb < MT) row_phase2(p.out + (size_t)row * 1024, p.out + (size_t)rb * 1024, p.out + (size_t)row * 1024, p.out + (size_t)rb * 1024, hb + (size_t)row * 1024, hb + (size_t)rb * 1024,
                              p.in[I_NFPOST] + l * 1024, gp2, hb + (size_t)row * 1024, hb + (size_t)rb * 1024, lane);
      else row_phase(p.out + (size_t)row * 1024, p.out + (size_t)row * 1024, hb + (size_t)row * 1024, p.in[I_NFPOST] + l * 1024, gp2, hb + (size_t)row * 1024, lane); }
    if (l == 0) ctr_barrier((unsigned*)p.ctr + 96);
  }
}

extern "C" void kernel_launch(void* const* d_in, const int* in_sizes, int n_in, void* d_out, int out_size,
                              void* d_ws, size_t ws_size, hipStream_t stream) {
  static int grid_blocks = 0;
  if (!grid_blocks) {
    int dev = 0, cus = 0, per_cu = 0;
    hipGetDevice(&dev);
    hipDeviceGetAttribute(&cus, hipDeviceAttributeMultiprocessorCount, dev);
    hipFuncSetAttribute((const void*)fwd, hipFuncAttributeMaxDynamicSharedMemorySize, LDS_BYTES);
    hipOccupancyMaxActiveBlocksPerMultiprocessor(&per_cu, fwd, 256, LDS_BYTES);
    if (per_cu > 2) per_cu = 2;
    if (per_cu < 1) per_cu = 1;
    grid_blocks = cus * per_cu;
  }
  Params p{};
  for (int i = 0; i < 28; ++i) p.in[i] = (const float*)d_in[i];
  p.out = (float*)d_out;
  char* ws = (char*)d_ws;
  size_t off = 0;
  p.z = (bf16_t*)(ws + off); off += (size_t)MT * NIN * 2;
  p.pl = (bf16_t*)(ws + off); off += 7 * PLANE * 2;
  p.wtin = (bf16_t*)(ws + off); off += (size_t)2 * NINP * 1024 * 2;
  p.wtout = (bf16_t*)(ws + off); off += (size_t)2 * 1024 * 1024 * 2;
  p.tabC = (f32x2*)(ws + off); off += (size_t)4096 * 32 * 8;
  p.tabB = (f32x2*)(ws + off); off += (size_t)4096 * 4 * 8;
  p.tabA = (f32x2*)(ws + off); off += (size_t)64 * 16 * 8;
  p.ctr = (int*)(ws + off); off += 1024;
  if (off > ws_size) fprintf(stderr, "workspace too small: need %zu have %zu\n", off, ws_size);
  void* args[] = {&p};
  hipError_t e = hipLaunchCooperativeKernel((void*)fwd, dim3(grid_blocks), dim3(256), args, LDS_BYTES, stream);
  if (e != hipSuccess) fprintf(stderr, "coop launch failed: %s (grid %d)\n", hipGetErrorString(e), grid_blocks);
}
```

```cpp
#include <hip/hip_runtime.h>
#include <hip/hip_cooperative_groups.h>
#include <cstdio>
#include <cstdint>
namespace cg = cooperative_groups;

#define DI __device__ __forceinline__
typedef unsigned short bf16_t;
typedef short bf16x8 __attribute__((ext_vector_type(8)));
typedef float f32x2 __attribute__((ext_vector_type(2)));
typedef float f32x4 __attribute__((ext_vector_type(4)));
typedef float f32x16 __attribute__((ext_vector_type(16)));
typedef unsigned u32x2 __attribute__((ext_vector_type(2)));
typedef unsigned u32x4 __attribute__((ext_vector_type(4)));
typedef __bf16 bf16x2_t __attribute__((ext_vector_type(2)));

constexpr int M0 = 32768, MT = 49152, DM = 1024, NIN = 3392, NINP = 3584, DFF = 2816;
constexpr int A_Q = 0, A_K = 256, A_V = 384, B_Q = 512, B_K = 768, B_V = 1024, C_Q = 1280, C_K = 1536, C_V = 1792, C_G = 2048, D_0 = 2304;
constexpr int PITCH = 144;
constexpr size_t PLANE = (size_t)MT * 256;
constexpr int LDS_BYTES = 73728;
constexpr float LOG2E = 1.4426950408889634f;
constexpr float EPS = 1e-6f;

enum { I_XP = 0, I_XS, I_NMPRE, I_NMPOST, I_NFPRE, I_NFPOST, I_WIN, I_WOUT, I_AQG, I_AKG, I_BLAM, I_BSUB, I_CGN, I_DMUP, I_DMUN, I_DW0, I_DWUP,
       I_DA0, I_DAUP, I_DGUP, I_DKK, I_DKA, I_DRK, I_DGNW, I_DGNB, I_FG, I_FU, I_FD };

struct Params {
  const float* in[28];
  float* out;
  bf16_t* z;
  bf16_t* pl;
  bf16_t* wtin;
  bf16_t* wtout;
  f32x2* tabC;
  f32x2* tabB;
  f32x2* tabA;
  int* ctr;
};

DI int opaque(int x) { asm volatile("" : "+v"(x)); return x; }
DI int opaque_s(int x) { asm volatile("" : "+s"(x)); return x; }
DI float bf2f(bf16_t v) { return __uint_as_float(((unsigned)v) << 16); }
DI float bflo(unsigned w) { return __uint_as_float(w << 16); }
DI float bfhi(unsigned w) { return __uint_as_float(w & 0xffff0000u); }
DI unsigned pk(float lo, float hi) { f32x2 v = {lo, hi}; bf16x2_t b = __builtin_convertvector(v, bf16x2_t); return __builtin_bit_cast(unsigned, b); }
DI bf16_t f2bf(float x) { return (bf16_t)(pk(x, 0.f) & 0xffffu); }
DI float dppf(float x, const int ctrl) { return x; }
#define DPPF(x, ctrl) __int_as_float(__builtin_amdgcn_update_dpp(0, __float_as_int(x), (ctrl), 0xF, 0xF, true))
DI float wave_sum(float v) {
  v += DPPF(v, 0xB1);
  v += DPPF(v, 0x4E);
  v += DPPF(v, 0x141);
  v += DPPF(v, 0x140);
  const int vi = __float_as_int(v);
  return (__int_as_float(__builtin_amdgcn_readlane(vi, 0)) + __int_as_float(__builtin_amdgcn_readlane(vi, 16))) +
         (__int_as_float(__builtin_amdgcn_readlane(vi, 32)) + __int_as_float(__builtin_amdgcn_readlane(vi, 48)));
}
DI float dpp_xor1(float x) { return __int_as_float(__builtin_amdgcn_update_dpp(0, __float_as_int(x), 0xB1, 0xF, 0xF, true)); }
DI float dpp_xor2(float x) { return __int_as_float(__builtin_amdgcn_update_dpp(0, __float_as_int(x), 0x4E, 0xF, 0xF, true)); }
DI float dpp_hmir(float x) { return __int_as_float(__builtin_amdgcn_update_dpp(0, __float_as_int(x), 0x141, 0xF, 0xF, true)); }
DI float red8(float x) { x += dpp_xor1(x); x += dpp_xor2(x); x += dpp_hmir(x); return x; }
DI float fexp2(float x) { return __builtin_amdgcn_exp2f(x); }
DI void seq_info(int s, int& row0, int& T) { if (s < 8) { row0 = s * 4096; T = 4096; } else { row0 = M0 + (s - 8) * 2048; T = 2048; } }
DI void row_info(int r, int& t, int& T) { if (r < M0) { t = r & 4095; T = 4096; } else { t = (r - M0) & 2047; T = 2048; } }
#define MFMA32(a, b, c) __builtin_amdgcn_mfma_f32_32x32x16_bf16((a), (b), (c), 0, 0, 0)

DI void conv_T(char* lds, const float* __restrict__ W, int K, int N, bf16_t* __restrict__ Wt, int mode, int tile) {
  float* t = (float*)lds;
  const int tid0 = opaque(threadIdx.x);
  const int ntn = N >> 6, kt = tile / ntn, nt = tile - kt * ntn, k0 = kt << 6, n0 = nt << 6;
  float wv[16];
#pragma unroll
  for (int i = 0; i < 16; ++i) { const int idx = tid0 + 256 * i, k = idx >> 6, n = idx & 63; wv[i] = W[(size_t)(k0 + k) * N + n0 + n]; }
#pragma unroll
  for (int i = 0; i < 16; ++i) { const int idx = tid0 + 256 * i, k = idx >> 6, n = idx & 63; t[k * 65 + n] = wv[i]; }
  __syncthreads();
#pragma unroll 4
  for (int i = 0; i < 8; ++i) {
    const int idx = tid0 + 256 * i, n = idx >> 5, k = (idx & 31) * 2, j = n0 + n;
    const int rho = (mode == 0) ? j : ((j >> 6) * 128 + ((j >> 5) & 1) * 64 + (mode - 1) * 32 + (j & 31));
    *(unsigned*)(Wt + (size_t)rho * K + k0 + k) = pk(t[k * 65 + n], t[(k + 1) * 65 + n]);
  }
  __syncthreads();
}

DI void row_phase(const float* __restrict__ xin, float* __restrict__ xout, const bf16_t* addsrc, const float* __restrict__ gpost,
                  const float* __restrict__ gpre, bf16_t* hout, int lane_in) {
  const int lane = opaque(lane_in);
  f32x4 x[4];
#pragma unroll
  for (int i = 0; i < 4; ++i) x[i] = *(const f32x4*)(xin + i * 256 + lane * 4);
  if (addsrc) {
    f32x4 m[4]; float ss = 0.f;
#pragma unroll
    for (int i = 0; i < 4; ++i) { const u32x2 w = *(const u32x2*)(addsrc + i * 256 + lane * 4); m[i] = (f32x4){bflo(w.x), bfhi(w.x), bflo(w.y), bfhi(w.y)};
      ss += m[i][0] * m[i][0] + m[i][1] * m[i][1] + m[i][2] * m[i][2] + m[i][3] * m[i][3]; }
    ss = wave_sum(ss); const float rs = rsqrtf(ss * (1.0f / 1024.0f) + EPS);
#pragma unroll
    for (int i = 0; i < 4; ++i) { const f32x4 g = *(const f32x4*)(gpost + i * 256 + lane * 4); x[i] += m[i] * rs * g; }
  }
#pragma unroll
  for (int i = 0; i < 4; ++i) *(f32x4*)(xout + i * 256 + lane * 4) = x[i];
  if (gpre) {
    float ss = 0.f;
#pragma unroll
    for (int i = 0; i < 4; ++i) ss += x[i][0] * x[i][0] + x[i][1] * x[i][1] + x[i][2] * x[i][2] + x[i][3] * x[i][3];
    ss = wave_sum(ss); const float rs = rsqrtf(ss * (1.0f / 1024.0f) + EPS);
#pragma unroll
    for (int i = 0; i < 4; ++i) { const f32x4 g = *(const f32x4*)(gpre + i * 256 + lane * 4); const f32x4 hv = x[i] * rs * g;
      u32x2 w; w.x = pk(hv[0], hv[1]); w.y = pk(hv[2], hv[3]); *(u32x2*)(hout + i * 256 + lane * 4) = w; }
  }
}

DI void row_phase2(const float* __restrict__ xinA, const float* __restrict__ xinB, float* __restrict__ xoutA, float* __restrict__ xoutB, const bf16_t* addA, const bf16_t* addB,
                   const float* __restrict__ gpost, const float* __restrict__ gpre, bf16_t* houtA, bf16_t* houtB, int lane_in) {
  const int lane = opaque(lane_in);
  f32x4 x[2][4]; u32x2 aw[2][4];
#pragma unroll
  for (int i = 0; i < 4; ++i) { x[0][i] = *(const f32x4*)(xinA + i * 256 + lane * 4); x[1][i] = *(const f32x4*)(xinB + i * 256 + lane * 4); }
  if (addA) {
#pragma unroll
    for (int i = 0; i < 4; ++i) { aw[0][i] = *(const u32x2*)(addA + i * 256 + lane * 4); aw[1][i] = *(const u32x2*)(addB + i * 256 + lane * 4); }
#pragma unroll
    for (int r = 0; r < 2; ++r) {
      f32x4 m[4]; float ss = 0.f;
#pragma unroll
      for (int i = 0; i < 4; ++i) { const u32x2 w = aw[r][i]; m[i] = (f32x4){bflo(w.x), bfhi(w.x), bflo(w.y), bfhi(w.y)};
        ss += m[i][0] * m[i][0] + m[i][1] * m[i][1] + m[i][2] * m[i][2] + m[i][3] * m[i][3]; }
      ss = wave_sum(ss); const float rs = rsqrtf(ss * (1.0f / 1024.0f) + EPS);
#pragma unroll
      for (int i = 0; i < 4; ++i) { const f32x4 g = *(const f32x4*)(gpost + i * 256 + lane * 4); x[r][i] += m[i] * rs * g; }
    }
  }
#pragma unroll
  for (int i = 0; i < 4; ++i) { *(f32x4*)(xoutA + i * 256 + lane * 4) = x[0][i]; *(f32x4*)(xoutB + i * 256 + lane * 4) = x[1][i]; }
  if (gpre) {
#pragma unroll
    for (int r = 0; r < 2; ++r) {
      float ss = 0.f;
#pragma unroll
      for (int i = 0; i < 4; ++i) ss += x[r][i][0] * x[r][i][0] + x[r][i][1] * x[r][i][1] + x[r][i][2] * x[r][i][2] + x[r][i][3] * x[r][i][3];
      ss = wave_sum(ss); const float rs = rsqrtf(ss * (1.0f / 1024.0f) + EPS);
      bf16_t* ho = r == 0 ? houtA : houtB;
#pragma unroll
      for (int i = 0; i < 4; ++i) { const f32x4 g = *(const f32x4*)(gpre + i * 256 + lane * 4); const f32x4 hv = x[r][i] * rs * g;
        u32x2 w; w.x = pk(hv[0], hv[1]); w.y = pk(hv[2], hv[3]); *(u32x2*)(ho + i * 256 + lane * 4) = w; }
    }
  }
}

struct ASrc { const bf16_t* b0; const bf16_t* b1; const bf16_t* b2; const bf16_t* b3; int s0, s1, s2, s3; int shift; };

DI void store_piece64(char* img, const f32x16 (&acc)[2][2], bf16_t* out, size_t ld, int row0, int col0, int l31, int h) {
#pragma unroll
  for (int mf = 0; mf < 2; ++mf)
#pragma unroll
    for (int nf = 0; nf < 2; ++nf)
#pragma unroll
      for (int g = 0; g < 4; ++g) { u32x2 v; v.x = pk(acc[mf][nf][4 * g], acc[mf][nf][4 * g + 1]); v.y = pk(acc[mf][nf][4 * g + 2], acc[mf][nf][4 * g + 3]);
        *(u32x2*)(img + (mf * 32 + l31) * PITCH + (nf * 32 + 8 * g + 4 * h) * 2) = v; }
  const int ln = l31 + 32 * h;
#pragma unroll 2
  for (int i = 0; i < 8; ++i) { const int q = ln + 64 * i, r = q >> 3, c8 = q & 7;
    const u32x4 v = *(const u32x4*)(img + r * PITCH + c8 * 16); *(u32x4*)(out + (size_t)(row0 + r) * ld + col0 + c8 * 8) = v; }
}
struct EpiStore { bf16_t* out; int ldc; int nmax; char* lds;
  DI void operator()(const f32x16 (&acc)[2][2], int mb, int nb, int n0, int wc, int l31, int h) const {
    if (nb >= nmax) return;
    store_piece64(lds + (threadIdx.x >> 6) * 9216, acc, out, (size_t)ldc, mb, nb, l31, h);
  } };
struct EpiSwiGLU { bf16_t* out; char* lds;
  DI void operator()(const f32x16 (&acc)[2][2], int mb, int nb, int n0, int wc, int l31, int h) const {
    const int hc = (nb >> 6) * 32;
    char* img = lds + (threadIdx.x >> 6) * 9216;
#pragma unroll
    for (int mf = 0; mf < 2; ++mf)
#pragma unroll
      for (int g = 0; g < 4; ++g) { float r[4];
#pragma unroll
        for (int e = 0; e < 4; ++e) { const float gt = acc[mf][0][4 * g + e], up = acc[mf][1][4 * g + e]; r[e] = gt / (1.0f + __expf(-gt)) * up; }
        u32x2 v; v.x = pk(r[0], r[1]); v.y = pk(r[2], r[3]); *(u32x2*)(img + (mf * 32 + l31) * PITCH + (8 * g + 4 * h) * 2) = v; }
    const int ln = l31 + 32 * h;
#pragma unroll
    for (int i = 0; i < 4; ++i) { const int q = ln + 64 * i, r = q >> 2, c4 = q & 3;
      const u32x4 v = *(const u32x4*)(img + r * PITCH + c4 * 16); *(u32x4*)(out + (size_t)(mb + r) * DFF + hc + c4 * 8) = v; }
  } };

struct EpiIn { bf16_t* z; char* lds; const float* qg; const float* kg; const f32x2* tabA; const f32x2* tabB; const f32x2* tabC;
  DI void operator()(f32x16 (&acc)[2][2], int mb, int nb, int n0, int wc, int l31, int h) const {
    if (nb >= NIN) return;
    const bool isv = (nb >= A_V && nb < B_Q) || (nb >= B_V && nb < C_Q) || (nb >= C_V && nb < C_G);
    if (isv) {
      const int wv = (threadIdx.x >> 6);
      bf16_t* img = (bf16_t*)(lds + 32768 + wv * 9216);
#pragma unroll
      for (int mf = 0; mf < 2; ++mf)
#pragma unroll
        for (int nf = 0; nf < 2; ++nf)
#pragma unroll
          for (int i = 0; i < 16; ++i) { const int d = nf * 32 + (i & 3) + 8 * (i >> 2) + 4 * h; img[d * 72 + mf * 32 + l31] = f2bf(acc[mf][nf][i]); }
      __builtin_amdgcn_s_waitcnt(0xc07f);
      const int ln = l31 + 32 * h;
#pragma unroll
      for (int i = 0; i < 8; ++i) { const int q = ln + 64 * i, d = q >> 3, c8 = q & 7;
        const u32x4 v = *(const u32x4*)(img + d * 72 + c8 * 8); *(u32x4*)(z + (size_t)(mb + d) * NIN + nb + c8 * 8) = v; }
      return;
    }
#pragma unroll
    for (int mf = 0; mf < 2; ++mf) {
      const int row = mb + mf * 32 + l31; int t, T; row_info(row, t, T);
      if (nb < A_V) {
        const bool isq = nb < A_K; const float* gn = isq ? qg : kg;
        float ss = 0.f;
#pragma unroll
        for (int nf = 0; nf < 2; ++nf)
#pragma unroll
          for (int i = 0; i < 16; ++i) ss += acc[mf][nf][i] * acc[mf][nf][i];
        ss += __shfl_xor(ss, 32);
        const float rs = rsqrtf(ss * (1.0f / 64.0f) + EPS) * (isq ? 0.125f * LOG2E : 1.0f);
#pragma unroll
        for (int nf = 0; nf < 2; ++nf) {
          const int pos = nf == 0 ? (t >> 6) : (t & 63);
#pragma unroll
          for (int g = 0; g < 4; ++g)
#pragma unroll
            for (int e = 0; e < 4; ++e) acc[mf][nf][4 * g + e] *= rs * gn[nf * 32 + 8 * g + 4 * h + e];
#pragma unroll
          for (int g = 0; g < 2; ++g)
#pragma unroll
            for (int e = 0; e < 4; ++e) { const f32x2 cs = tabA[pos * 16 + 8 * g + 4 * h + e];
              const float x1 = acc[mf][nf][4 * g + e], x2 = acc[mf][nf][4 * (g + 2) + e];
              acc[mf][nf][4 * g + e] = x1 * cs.x - x2 * cs.y; acc[mf][nf][4 * (g + 2) + e] = x2 * cs.x + x1 * cs.y; }
        }
      } else if (nb >= B_Q && nb < B_V) {
        const bool isq = nb < B_K;
#pragma unroll
        for (int nf = 0; nf < 2; ++nf) {
#pragma unroll
          for (int e = 0; e < 4; ++e) { const f32x2 cs = tabB[t * 4 + e]; const float v = acc[mf][nf][e]; const float o = __shfl_xor(v, 32);
            acc[mf][nf][e] = (h == 0) ? (v * cs.x - o * cs.y) : (v * cs.x + o * cs.y); }
          if (isq) {
#pragma unroll
            for (int i = 0; i < 16; ++i) acc[mf][nf][i] *= 0.17677669529663687f * LOG2E; }
        }
      } else if (nb >= C_Q && nb < C_V) {
        const float sc = nb < C_K ? 1.0f : 0.125f;
#pragma unroll
        for (int g = 0; g < 4; ++g)
#pragma unroll
          for (int e = 0; e < 4; ++e) { const f32x2 cs = tabC[t * 32 + 8 * g + 4 * h + e]; const float x1 = acc[mf][0][4 * g + e], x2 = acc[mf][1][4 * g + e];
            acc[mf][0][4 * g + e] = (x1 * cs.x - x2 * cs.y) * sc; acc[mf][1][4 * g + e] = (x2 * cs.x + x1 * cs.y) * sc; }
      }
      bf16_t* rp = z + (size_t)row * NIN + nb;
#pragma unroll
      for (int nf = 0; nf < 2; ++nf)
#pragma unroll
        for (int g = 0; g < 4; ++g) { u32x2 v; v.x = pk(acc[mf][nf][4 * g], acc[mf][nf][4 * g + 1]); v.y = pk(acc[mf][nf][4 * g + 2], acc[mf][nf][4 * g + 3]);
          *(u32x2*)(rp + nf * 32 + 8 * g + 4 * h) = v; }
    }
  } };

#define LASP __attribute__((address_space(3)))
template <class Epi>
DI void gemm_tile(char* lds, const ASrc& A, const bf16_t* __restrict__ Bt, int K, int m0, int n0, const Epi& epi, bool first, bool has_next, int m0n, int n0n) {
  const int tid = opaque(threadIdx.x), lane = tid & 63, w = __builtin_amdgcn_readfirstlane(tid >> 6), wr = w >> 1, wc = w & 1, l31 = lane & 31, h = lane >> 5;
  const int nk = K >> 6, smask = (1 << A.shift) - 1;
  LASP char* ldsl = (LASP char*)lds;
  f32x16 acc[2][2];
#pragma unroll
  for (int a = 0; a < 2; ++a)
#pragma unroll
    for (int b = 0; b < 2; ++b)
#pragma unroll
      for (int i = 0; i < 16; ++i) acc[a][b][i] = 0.f;
  const int lrow = lane >> 3, lslot = lane & 7;
  int goffA[4], goffB[4];
#pragma unroll
  for (int i = 0; i < 4; ++i) { const int r = w * 32 + i * 8 + lrow, c = lslot ^ ((r >> 1) & 7); goffA[i] = r; goffB[i] = r * K + c * 8; goffA[i] = (goffA[i] << 3) | c; }
#define GEMM_ISSUE(kt, st, M0_, N0_) do { const int k0_ = (kt) << 6, seg_ = k0_ >> A.shift, kk_ = k0_ & smask; \
    const bf16_t* bp_ = seg_ == 0 ? A.b0 : seg_ == 1 ? A.b1 : seg_ == 2 ? A.b2 : A.b3; const int st_ = seg_ == 0 ? A.s0 : seg_ == 1 ? A.s1 : seg_ == 2 ? A.s2 : A.s3; \
    _Pragma("unroll") for (int i_ = 0; i_ < 4; ++i_) { \
      const bf16_t* ga_ = bp_ + (size_t)((M0_) + (goffA[i_] >> 3)) * st_ + kk_ + (goffA[i_] & 7) * 8; \
      __builtin_amdgcn_global_load_lds((const unsigned*)ga_, (LASP unsigned*)(ldsl + (st) * 32768 + (w * 4 + i_) * 1024), 16, 0, 0); \
      const bf16_t* gb_ = Bt + (size_t)(N0_) * K + goffB[i_] + k0_; \
      __builtin_amdgcn_global_load_lds((const unsigned*)gb_, (LASP unsigned*)(ldsl + (st) * 32768 + 16384 + (w * 4 + i_) * 1024), 16, 0, 0); } } while (0)
  const int xr = (l31 >> 1) & 7;
  int coff[4];
#pragma unroll
  for (int s = 0; s < 4; ++s) coff[s] = ((2 * s + h) ^ xr) * 16;
#define GEMM_COMPUTE(st) do { const char* as = lds + (st) * 32768; const char* bs = as + 16384; \
    bf16x8 af[4][2], wf[4][2]; \
    _Pragma("unroll") for (int s = 0; s < 4; ++s) { \
      _Pragma("unroll") for (int mf = 0; mf < 2; ++mf) af[s][mf] = *(const bf16x8*)(as + (wr * 64 + mf * 32 + l31) * 128 + coff[s]); \
      _Pragma("unroll") for (int nf = 0; nf < 2; ++nf) wf[s][nf] = *(const bf16x8*)(bs + (wc * 64 + nf * 32 + l31) * 128 + coff[s]); } \
    __builtin_amdgcn_sched_barrier(0); __builtin_amdgcn_s_setprio(1); \
    _Pragma("unroll") for (int s = 0; s < 4; ++s) \
      _Pragma("unroll") for (int mf = 0; mf < 2; ++mf) _Pragma("unroll") for (int nf = 0; nf < 2; ++nf) acc[mf][nf] = MFMA32(wf[s][nf], af[s][mf], acc[mf][nf]); \
    __builtin_amdgcn_s_setprio(0); __builtin_amdgcn_sched_barrier(0); } while (0)
  if (first) GEMM_ISSUE(0, 0, m0, n0);
  for (int kt = 0; kt < nk; kt += 2) {
    asm volatile("s_waitcnt vmcnt(0)" ::: "memory"); __syncthreads();
    GEMM_ISSUE(kt + 1, 1, m0, n0);
    GEMM_COMPUTE(0);
    asm volatile("s_waitcnt vmcnt(0)" ::: "memory"); __syncthreads();
    if (kt + 2 < nk) GEMM_ISSUE(kt + 2, 0, m0, n0);
    GEMM_COMPUTE(1);
  }
  __syncthreads();
  if (has_next) GEMM_ISSUE(0, 0, m0n, n0n);
  epi(acc, m0 + wr * 64, n0 + wc * 64, n0, wc, l31, h);
  __syncthreads();
#undef GEMM_ISSUE
#undef GEMM_COMPUTE
}

template <class Epi>
DI void gemm_phase(char* lds, const ASrc& A, const bf16_t* Bt, int K, int ntn, const Epi& epi) {
  const int xcd = blockIdx.x & 7, j = blockIdx.x >> 3, nloc = gridDim.x >> 3, per = 48 * ntn, grp = 8 * ntn;
  bool first = true;
  for (int li = j; li < per; li += nloc) {
    const int sg = li / grp, wi = li - sg * grp, nt = wi >> 3, mt = xcd * 48 + sg * 8 + (wi & 7);
    const int ln = li + nloc; const bool has_next = ln < per;
    const int sgn = ln / grp, win = ln - sgn * grp, ntn2 = win >> 3, mtn = xcd * 48 + sgn * 8 + (win & 7);
    gemm_tile(lds, A, Bt, K, mt * 128, nt * 128, epi, first, has_next, mtn * 128, ntn2 * 128);
    first = false;
  }
}

DI void prep_item(char* lds, const Params& p, int layer, int item) {
  const int tid = opaque(threadIdx.x), lane = tid & 63, w = tid >> 6;
  const int rowb = item * 64; int tb, T; row_info(rowb, tb, T);
  const float* qg = p.in[I_AQG] + layer * 64; const float* kg = p.in[I_AKG] + layer * 64;
  const float qgl = qg[lane], kgl = kg[lane];
  for (int tt = 0; tt < 16; ++tt) {
    const int row = rowb + w * 16 + tt, t = tb + w * 16 + tt;
    bf16_t* zr = p.z + (size_t)row * NIN;
    {
      const int j = lane & 31, i = j & 15; const bool first = j < 16; const int pos = (lane < 32) ? (t >> 6) : (t & 63);
      const f32x2 cs = p.tabA[pos * 16 + i];
#pragma unroll
      for (int hd = 0; hd < 6; ++hd) {
        bf16_t* ptr = zr + (hd < 4 ? A_Q + hd * 64 : A_K + (hd - 4) * 64) + lane;
        float v = bf2f(*ptr);
        const float ss = wave_sum(v * v);
        v = v * rsqrtf(ss * (1.0f / 64.0f) + EPS) * (hd < 4 ? qgl : kgl);
        const float o = __shfl_xor(v, 16);
        float r = first ? (v * cs.x - o * cs.y) : (v * cs.x + o * cs.y);
        if (hd < 4) r *= 0.125f * LOG2E;
        *ptr = f2bf(r);
      }
    }
    {
      const int d = lane & 31; const f32x2 cs = p.tabB[t * 4 + (d & 3)];
#pragma unroll
      for (int c = 0; c < 8; ++c) {
        bf16_t* ptr = zr + (c < 4 ? B_Q + c * 64 : B_K + (c - 4) * 64) + lane;
        float v = bf2f(*ptr);
        const float o = __shfl_xor(v, 4);
        float r = v;
        if (d < 8) r = (d < 4) ? (v * cs.x - o * cs.y) : (v * cs.x + o * cs.y);
        if (c < 4) r *= 0.17677669529663687f * LOG2E;
        *ptr = f2bf(r);
      }
    }
    {
      const f32x2 cs = p.tabC[t * 32 + (lane & 31)];
#pragma unroll
      for (int c = 0; c < 8; ++c) {
        bf16_t* ptr = zr + (c < 4 ? C_Q + c * 64 : C_K + (c - 4) * 64) + lane;
        const float v = bf2f(*ptr);
        const float o = __shfl_xor(v, 32);
        float r = (lane < 32) ? (v * cs.x - o * cs.y) : (v * cs.x + o * cs.y);
        if (c >= 4) r *= 0.125f;
        *ptr = f2bf(r);
      }
    }
  }
  bf16_t* tl = (bf16_t*)lds;
  const int r = tid >> 2, c0 = (tid & 3) * 16;
  for (int sl = 0; sl < 10; ++sl) {
    const int col = sl < 2 ? A_V + sl * 64 : sl < 6 ? B_V + (sl - 2) * 64 : C_V + (sl - 6) * 64;
    bf16_t* gp = p.z + (size_t)(rowb + r) * NIN + col + c0;
    const u32x4 v0 = *(const u32x4*)gp, v1 = *(const u32x4*)(gp + 8);
    __syncthreads();
#pragma unroll
    for (int e = 0; e < 4; ++e) {
      tl[(c0 + 2 * e) * 72 + r] = (bf16_t)(v0[e] & 0xffffu); tl[(c0 + 2 * e + 1) * 72 + r] = (bf16_t)(v0[e] >> 16);
      tl[(c0 + 8 + 2 * e) * 72 + r] = (bf16_t)(v1[e] & 0xffffu); tl[(c0 + 8 + 2 * e + 1) * 72 + r] = (bf16_t)(v1[e] >> 16);
    }
    __syncthreads();
    const u32x4 o0 = *(const u32x4*)(tl + r * 72 + c0), o1 = *(const u32x4*)(tl + r * 72 + c0 + 8);
    *(u32x4*)gp = o0; *(u32x4*)(gp + 8) = o1;
  }
  __syncthreads();
}

DI float dshift(const Params& p, const float* mup, const float* mun, int row, int t, int T, int dc) {
  const bf16_t* zp = p.z + (size_t)row * NIN + D_0 + dc;
  const float z = bf2f(*zp);
  const float zprev = (t > 0) ? bf2f(*(zp - NIN)) : 0.f;
  const float znext = (t < T - 1) ? bf2f(*(zp + NIN)) : 0.f;
  return z + mup[dc] * (zprev - z) + mun[dc] * (znext - z);
}
DI float sigmoidf_(float x) { return 1.0f / (1.0f + __expf(-x)); }
DI float omdecay(float ww) {
  const float e = 0.6065306597126334f / (1.0f + __expf(-ww));
  return 1.0f - __expf(-e);
}
DI float fast_tanh(float x) { const float xc = fminf(fmaxf(x, -15.f), 15.f); return 1.0f - 2.0f / (1.0f + __expf(2.0f * xc)); }
constexpr int DTOK = 16;
DI void dprep_item(char* lds, const Params& p, int layer, int item) {
  const int tid = opaque(threadIdx.x);
  const int rowb = item * DTOK; int tb, T; row_info(rowb, tb, T);
  const float* mup = p.in[I_DMUP] + layer * 1088; const float* mun = p.in[I_DMUN] + layer * 1088;
  float* su = (float*)lds;
  bf16_t* stg = (bf16_t*)(lds + 12288);
#pragma unroll
  for (int i = 0; i < 12; ++i) {
    const int idx = tid + 256 * i, tok = idx / 192, c = idx - tok * 192;
    float u = dshift(p, mup, mun, rowb + tok, tb + tok, T, 768 + c);
    if (c < 128) u = fast_tanh(u);
    su[c * DTOK + tok] = u;
  }
  __syncthreads();
  const int c = tid;
  const float w0f = p.in[I_DW0][(layer * 2 + 0) * 256 + c], w0b = p.in[I_DW0][(layer * 2 + 1) * 256 + c];
  const float a0 = p.in[I_DA0][layer * 256 + c], kkw = p.in[I_DKK][layer * 256 + c], kaw = p.in[I_DKA][layer * 256 + c];
  float zr[DTOK + 2], zk[DTOK + 2], zv[DTOK + 2];
  { const bf16_t* zp = p.z + (size_t)rowb * NIN + D_0 + c;
#pragma unroll
    for (int i = 0; i < DTOK + 2; ++i) { const int t = tb - 1 + i; const bool ok = (t >= 0) && (t < T); const bf16_t* q = zp + (ptrdiff_t)(i - 1) * NIN;
      zr[i] = ok ? bf2f(q[0]) : 0.f; zk[i] = ok ? bf2f(q[256]) : 0.f; zv[i] = ok ? bf2f(q[512]) : 0.f; } }
  const float mpr = mup[c], mnr = mun[c], mpk = mup[256 + c], mnk = mun[256 + c], mpv = mup[512 + c], mnv = mun[512 + c];
  float accf[DTOK], accb[DTOK], acca[DTOK];
#pragma unroll
  for (int k = 0; k < DTOK; ++k) { accf[k] = 0.f; accb[k] = 0.f; acca[k] = 0.f; }
  const float* wupf = p.in[I_DWUP] + (size_t)(layer * 2 + 0) * 64 * 256 + c;
  const float* wupb = p.in[I_DWUP] + (size_t)(layer * 2 + 1) * 64 * 256 + c;
  const float* aup = p.in[I_DAUP] + (size_t)layer * 64 * 256 + c;
#pragma unroll 2
  for (int j = 0; j < 64; ++j) {
    const float wf = wupf[j * 256], wb = wupb[j * 256], wa = aup[j * 256];
#pragma unroll
    for (int q = 0; q < 4; ++q) {
      const f32x4 f0 = *(const f32x4*)(su + j * DTOK + 4 * q), b0 = *(const f32x4*)(su + (64 + j) * DTOK + 4 * q), a0v = *(const f32x4*)(su + (128 + j) * DTOK + 4 * q);
#pragma unroll
      for (int k = 0; k < 4; ++k) { accf[4 * q + k] += f0[k] * wf; accb[4 * q + k] += b0[k] * wb; acca[4 * q + k] += a0v[k] * wa; }
    }
  }
#pragma unroll
  for (int k = 0; k < DTOK; ++k) {
    const float r = zr[k + 1] + mpr * (zr[k] - zr[k + 1]) + mnr * (zr[k + 2] - zr[k + 1]);
    const float kx = zk[k + 1] + mpk * (zk[k] - zk[k + 1]) + mnk * (zk[k + 2] - zk[k + 1]);
    const float v = zv[k + 1] + mpv * (zv[k] - zv[k + 1]) + mnv * (zv[k + 2] - zv[k + 1]);
    const float omf = omdecay(w0f + accf[k]), omb = omdecay(w0b + accb[k]);
    const float a = sigmoidf_(a0 + acca[k]);
    float kk = kx * kkw; const float n2 = wave_sum(kk * kk);
    kk = kk * rsqrtf(fmaxf(n2, 1e-24f));
    const float kmod = kx * (1.0f + (a - 1.0f) * kaw), b = kk * a;
    bf16_t* so = stg + k * 256 + c;
    so[0] = f2bf(r); so[DTOK * 256] = f2bf(kmod); so[2 * DTOK * 256] = f2bf(v); so[3 * DTOK * 256] = f2bf(-kk);
    so[4 * DTOK * 256] = f2bf(b); so[5 * DTOK * 256] = f2bf(omf); so[6 * DTOK * 256] = f2bf(omb);
  }
  __syncthreads();
#pragma unroll
  for (int i = 0; i < 14; ++i) {
    const int q = tid + 256 * i, pln = q >> 9, rem = q & 511, tok = rem >> 5, c16 = rem & 31;
    const u32x4 v = *(const u32x4*)(stg + pln * (DTOK * 256) + tok * 256 + c16 * 8);
    *(u32x4*)(p.pl + (size_t)pln * PLANE + (size_t)(rowb + tok) * 256 + c16 * 8) = v;
  }
  __syncthreads();
}

DI void dpost_item(char* lds, const Params& p, int layer, int item) {
  const int tid = opaque(threadIdx.x);
  const int rowb = item * DTOK; int tb, T; row_info(rowb, tb, T);
  const float* mup = p.in[I_DMUP] + layer * 1088; const float* mun = p.in[I_DMUN] + layer * 1088;
  float* sg = (float*)lds;
  bf16_t* stg = (bf16_t*)(lds + 8192);
#pragma unroll
  for (int i = 0; i < 8; ++i) { const int idx = tid + 256 * i, tok = idx >> 7, c = idx & 127; sg[c * DTOK + tok] = sigmoidf_(dshift(p, mup, mun, rowb + tok, tb + tok, T, 960 + c)); }
  __syncthreads();
  const int c = tid;
  float acc[DTOK];
#pragma unroll
  for (int k = 0; k < DTOK; ++k) acc[k] = 0.f;
  float yv[DTOK], rv_[DTOK], kmv[DTOK], vv_[DTOK];
#pragma unroll
  for (int k = 0; k < DTOK; ++k) { const int row = rowb + k; const bf16_t* zd = p.z + (size_t)row * NIN + D_0; const size_t o = (size_t)row * 256 + c;
    yv[k] = bf2f(zd[c]) + bf2f(zd[256 + c]); rv_[k] = bf2f(p.pl[o]); kmv[k] = bf2f(p.pl[PLANE + o]); vv_[k] = bf2f(p.pl[2 * PLANE + o]); }
  const float* gup = p.in[I_DGUP] + (size_t)layer * 128 * 256 + c;
#pragma unroll 4
  for (int j = 0; j < 128; ++j) { const float gw = gup[j * 256];
#pragma unroll
    for (int q = 0; q < 4; ++q) { const f32x4 s0 = *(const f32x4*)(sg + j * DTOK + 4 * q);
#pragma unroll
      for (int k = 0; k < 4; ++k) acc[4 * q + k] += s0[k] * gw; } }
  const float gnw = p.in[I_DGNW][layer * 256 + c], gnb = p.in[I_DGNB][layer * 256 + c], rk = p.in[I_DRK][layer * 256 + c];
#pragma unroll
  for (int k = 0; k < DTOK; ++k) {
    const float y = yv[k];
    const float mean = wave_sum(y) * (1.0f / 64.0f); const float d = y - mean; const float var = wave_sum(d * d) * (1.0f / 64.0f);
    const float yn = d * rsqrtf(var + 64e-5f) * gnw + gnb;
    const float r = rv_[k], km = kmv[k], v = vv_[k];
    const float bonus = wave_sum(r * km * rk);
    stg[k * 256 + c] = f2bf((yn + bonus * v) * acc[k]);
  }
  __syncthreads();
#pragma unroll
  for (int i = 0; i < 2; ++i) { const int q = tid + 256 * i, tok = q >> 5, c16 = q & 31;
    const u32x4 v = *(const u32x4*)(stg + tok * 256 + c16 * 8);
    *(u32x4*)(p.pl + 4 * PLANE + (size_t)(rowb + tok) * 256 + c16 * 8) = v; }
  __syncthreads();
}

DI void rwkv_item(char* lds, const Params& p, int seq, int head, int dir, int half) {
  int row0, T; seq_info(seq, row0, T);
  const int tid = opaque(threadIdx.x), kc = tid & 7, vrow = half * 32 + (tid >> 3);
  float* st = (float*)lds;
  f32x2 S[4];
#pragma unroll
  for (int j = 0; j < 4; ++j) S[j] = (f32x2){0.f, 0.f};
  const int nchunk = T >> 4;
  u32x4 rg[3];
  const int tsel = tid >> 7, srem = tid & 127, sstep = srem >> 3, sc8 = srem & 7;
#define RW_GLOAD(c) do { _Pragma("unroll") for (int i_ = 0; i_ < 3; ++i_) { const int tens_ = tsel + 2 * i_; \
      const int plane_ = tens_ == 0 ? (dir ? 6 : 5) : tens_ == 1 ? 3 : tens_ == 2 ? 4 : tens_ == 3 ? 1 : tens_ == 4 ? 0 : 2; \
      const int t_ = dir ? (T - 1 - ((c) * 16 + sstep)) : ((c) * 16 + sstep); \
      rg[i_] = *(const u32x4*)(p.pl + (size_t)plane_ * PLANE + (size_t)(row0 + t_) * 256 + head * 64 + sc8 * 8); } } while (0)
#define RW_LSTORE(buf) do { _Pragma("unroll") for (int i_ = 0; i_ < 3; ++i_) { const int tens_ = tsel + 2 * i_; \
      f32x4 a_ = {bflo(rg[i_].x), bfhi(rg[i_].x), bflo(rg[i_].y), bfhi(rg[i_].y)}, b_ = {bflo(rg[i_].z), bfhi(rg[i_].z), bflo(rg[i_].w), bfhi(rg[i_].w)}; \
      if (tens_ == 0) { a_ = 1.0f - a_; b_ = 1.0f - b_; } \
      float* d_ = st + (((buf) * 16 + sstep) * 6 + tens_) * 64 + sc8 * 8; *(f32x4*)d_ = a_; *(f32x4*)(d_ + 4) = b_; } } while (0)
  __builtin_amdgcn_s_setprio(3);
  RW_GLOAD(0); RW_LSTORE(0); __syncthreads();
  bf16_t* ybase = p.z + (size_t)row0 * NIN + D_0 + dir * 256 + head * 64 + vrow;
  for (int c = 0; c < nchunk; ++c) {
    if (c + 1 < nchunk) RW_GLOAD(c + 1);
    const float* sb = st + (c & 1) * (16 * 384);
#define RW_FETCH(S_, s_) do { const float* q_ = sb + (s_) * 384 + kc * 8; \
      S_##w0 = *(const f32x4*)(q_); S_##w1 = *(const f32x4*)(q_ + 4); S_##n0 = *(const f32x4*)(q_ + 64); S_##n1 = *(const f32x4*)(q_ + 68); \
      S_##b0 = *(const f32x4*)(q_ + 128); S_##b1 = *(const f32x4*)(q_ + 132); S_##k0 = *(const f32x4*)(q_ + 192); S_##k1 = *(const f32x4*)(q_ + 196); \
      S_##r0 = *(const f32x4*)(q_ + 256); S_##r1 = *(const f32x4*)(q_ + 260); S_##vv = sb[(s_) * 384 + 320 + vrow]; } while (0)
#define LO2(x) ((f32x2){(x)[0], (x)[1]})
#define HI2(x) ((f32x2){(x)[2], (x)[3]})
#define RW_STEP(S_, s_) do { \
      f32x2 a2 = S[0] * LO2(S_##n0); a2 += S[1] * HI2(S_##n0); a2 += S[2] * LO2(S_##n1); a2 += S[3] * HI2(S_##n1); \
      const float sa = red8(a2.x + a2.y); const float vx = S_##vv; \
      S[0] = S[0] * LO2(S_##w0) + (LO2(S_##b0) * sa + LO2(S_##k0) * vx); S[1] = S[1] * HI2(S_##w0) + (HI2(S_##b0) * sa + HI2(S_##k0) * vx); \
      S[2] = S[2] * LO2(S_##w1) + (LO2(S_##b1) * sa + LO2(S_##k1) * vx); S[3] = S[3] * HI2(S_##w1) + (HI2(S_##b1) * sa + HI2(S_##k1) * vx); \
      f32x2 y2 = S[0] * LO2(S_##r0); y2 += S[1] * HI2(S_##r0); y2 += S[2] * LO2(S_##r1); y2 += S[3] * HI2(S_##r1); \
      const float y = red8(y2.x + y2.y); const float yn = DPPF(y, 0x128);     \
      if ((tid & 15) == 0) { const int t_ = dir ? (T - 1 - (c * 16 + (s_))) : (c * 16 + (s_)); *(unsigned*)(ybase + (size_t)t_ * NIN) = pk(y, yn); } } while (0)
    f32x4 Aw0, Aw1, An0, An1, Ab0, Ab1, Ak0, Ak1, Ar0, Ar1; float Avv;
    f32x4 Bw0, Bw1, Bn0, Bn1, Bb0, Bb1, Bk0, Bk1, Br0, Br1; float Bvv;
    RW_FETCH(A, 0);
#pragma unroll 2
    for (int s = 0; s < 16; s += 2) {
      RW_FETCH(B, s + 1);
      RW_STEP(A, s);
      if (s + 2 < 16) RW_FETCH(A, s + 2);
      RW_STEP(B, s + 1);
    }
#undef RW_FETCH
#undef RW_STEP
    if (c + 1 < nchunk) RW_LSTORE((c + 1) & 1);
    __syncthreads();
  }
#undef RW_GLOAD
#undef RW_LSTORE
  __builtin_amdgcn_s_setprio(0);
}

template <int MODE>
DI void attn_item(char* lds, const Params& p, int layer, int seq, int head, int qt) {
  const int tid = opaque(threadIdx.x), lane = tid & 63, w = tid >> 6, l31 = lane & 31, h = lane >> 5;
  layer = opaque_s(layer); seq = opaque_s(seq); head = opaque_s(head); qt = opaque_s(qt);
  int row0, T; seq_info(seq, row0, T);
  const int QC = (MODE == 0 ? A_Q : MODE == 1 ? B_Q : C_Q) + head * 64;
  const int KC = MODE == 0 ? A_K + (head >> 1) * 64 : MODE == 1 ? B_K + head * 64 : C_K + head * 64;
  const int VC = MODE == 0 ? A_V + (head >> 1) * 64 : MODE == 1 ? B_V + head * 64 : C_V + head * 64;
  const int qw0 = qt * 128 + w * 32, qi = qw0 + l31;
  bf16_t* zq = p.z + (size_t)(row0 + qi) * NIN + QC;
  bf16x8 qf[4];
#pragma unroll
  for (int s = 0; s < 4; ++s) qf[s] = *(const bf16x8*)(zq + s * 16 + h * 8);
  const int srow = tid >> 3, sc8 = tid & 7;
  const bf16_t* kbase = p.z + (size_t)(row0 + srow) * NIN + KC + sc8 * 8;
  const bf16_t* vbase = p.z + (size_t)(row0 + srow) * NIN + VC + sc8 * 8;
  u32x4 rk[2][2], rv[2][2];
  const int nt = T >> 6;
  const int prow = (l31 & 19) | ((l31 & 4) << 1) | ((l31 & 8) >> 1);
#define AT_GLOAD(t, S) do { _Pragma("unroll") for (int i_ = 0; i_ < 2; ++i_) { const size_t off_ = (size_t)((t) * 64 + 32 * i_) * NIN; rk[S][i_] = *(const u32x4*)(kbase + off_); rv[S][i_] = *(const u32x4*)(vbase + off_); } } while (0)
#define AT_LSTORE(buf, S) do { char* ks_ = lds + (buf) * 18432; char* vs_ = ks_ + 9216; \
    _Pragma("unroll") for (int i_ = 0; i_ < 2; ++i_) { *(u32x4*)(ks_ + (srow + 32 * i_) * PITCH + sc8 * 16) = rk[S][i_]; *(u32x4*)(vs_ + (srow + 32 * i_) * PITCH + sc8 * 16) = rv[S][i_]; } } while (0)
  constexpr int NMAP = (MODE == 1) ? 2 : 1;
  f32x16 o[NMAP][2];
  float m_run[NMAP], l_run[NMAP];
#pragma unroll
  for (int a = 0; a < NMAP; ++a) { m_run[a] = -INFINITY; l_run[a] = 0.f;
#pragma unroll
    for (int b = 0; b < 2; ++b)
#pragma unroll
      for (int i = 0; i < 16; ++i) o[a][b][i] = 0.f; }
  float lf = 0.f, lb = 0.f;
  if (MODE == 2) { lf = log2f(1.0f - exp2f(-5.0f - (float)head)); lb = log2f(1.0f - exp2f(-5.0f - (float)(3 - head))); }
  auto body = [&](const char* ks, const char* vs, const int t) __attribute__((always_inline)) {
#pragma unroll
    for (int mp = 0; mp < NMAP; ++mp) {
      f32x16 st[2];
#pragma unroll
      for (int kf = 0; kf < 2; ++kf) {
#pragma unroll
        for (int i = 0; i < 16; ++i) st[kf][i] = 0.f;
        if (MODE == 1) {
#pragma unroll
          for (int s = 0; s < 2; ++s) { const bf16x8 kfr = *(const bf16x8*)(ks + (kf * 32 + prow) * PITCH + (mp * 2 + s) * 32 + h * 16); st[kf] = MFMA32(kfr, qf[mp * 2 + s], st[kf]); }
        } else {
#pragma unroll
          for (int s = 0; s < 4; ++s) { const bf16x8 kfr = *(const bf16x8*)(ks + (kf * 32 + prow) * PITCH + s * 32 + h * 16); st[kf] = MFMA32(kfr, qf[s], st[kf]); }
        }
      }
      if (MODE == 2) {
        const int k0 = t * 64;
        const float dbase = (float)(qi - k0 - 8 * h);
        if (k0 + 63 < qw0) {
#pragma unroll
          for (int kf = 0; kf < 2; ++kf)
#pragma unroll
            for (int i = 0; i < 16; ++i) { const float cc = (float)(32 * kf + (i & 3) + 4 * ((i >> 2) & 1) + 16 * ((i >> 3) & 1)); st[kf][i] *= fexp2(lf * (dbase - cc)); }
        } else if (k0 > qw0 + 31) {
#pragma unroll
          for (int kf = 0; kf < 2; ++kf)
#pragma unroll
            for (int i = 0; i < 16; ++i) { const float cc = (float)(32 * kf + (i & 3) + 4 * ((i >> 2) & 1) + 16 * ((i >> 3) & 1)); st[kf][i] *= fexp2(lb * (cc - dbase)); }
        } else {
#pragma unroll
          for (int kf = 0; kf < 2; ++kf)
#pragma unroll
            for (int i = 0; i < 16; ++i) { const float cc = (float)(32 * kf + (i & 3) + 4 * ((i >> 2) & 1) + 16 * ((i >> 3) & 1)); const float d = dbase - cc;
              float dd = fexp2(fminf(lf * d, -lb * d)); if (d == 0.f) dd = 2.0f; st[kf][i] *= dd; }
        }
      } else {
        float mx = st[0][0];
#pragma unroll
        for (int kf = 0; kf < 2; ++kf)
#pragma unroll
          for (int i = 0; i < 16; ++i) mx = fmaxf(mx, st[kf][i]);
        mx = fmaxf(mx, __shfl_xor(mx, 32));
        const float mn = fmaxf(m_run[mp], mx); const float alpha = fexp2(m_run[mp] - mn); m_run[mp] = mn;
        float ps = 0.f;
#pragma unroll
        for (int kf = 0; kf < 2; ++kf)
#pragma unroll
          for (int i = 0; i < 16; ++i) { st[kf][i] = fexp2(st[kf][i] - mn); ps += st[kf][i]; }
        l_run[mp] = l_run[mp] * alpha + ps;
#pragma unroll
        for (int df = 0; df < 2; ++df) o[mp][df] *= alpha;
      }
      bf16x8 pf[4];
#pragma unroll
      for (int kf = 0; kf < 2; ++kf)
#pragma unroll
        for (int s2 = 0; s2 < 2; ++s2) { u32x4 u; u.x = pk(st[kf][8 * s2], st[kf][8 * s2 + 1]); u.y = pk(st[kf][8 * s2 + 2], st[kf][8 * s2 + 3]);
          u.z = pk(st[kf][8 * s2 + 4], st[kf][8 * s2 + 5]); u.w = pk(st[kf][8 * s2 + 6], st[kf][8 * s2 + 7]); pf[kf * 2 + s2] = __builtin_bit_cast(bf16x8, u); }
#pragma unroll
      for (int df = 0; df < 2; ++df)
#pragma unroll
        for (int ksx = 0; ksx < 4; ++ksx) { const bf16x8 vfr = *(const bf16x8*)(vs + (df * 32 + l31) * PITCH + ksx * 32 + h * 16); o[mp][df] = MFMA32(vfr, pf[ksx], o[mp][df]); }
    }
  };
  if constexpr (MODE == 1) {
    AT_GLOAD(0, 0); AT_LSTORE(0, 0); __syncthreads();
#pragma unroll 1
    for (int t = 0; t < nt; ++t) {
      if (t + 1 < nt) AT_GLOAD(t + 1, 0);
      const char* ks = lds + (t & 1) * 18432;
      body(ks, ks + 9216, t);
      if (t + 1 < nt) AT_LSTORE((t + 1) & 1, 0);
      __syncthreads();
    }
  } else {
    AT_GLOAD(0, 0); AT_GLOAD(1, 1); AT_LSTORE(0, 0); __syncthreads();
#pragma unroll 1
    for (int t2 = 0; t2 < nt; t2 += 2) {
      if (t2 + 2 < nt) AT_GLOAD(t2 + 2, 0);
      body(lds, lds + 9216, t2);
      AT_LSTORE(1, 1);
      __syncthreads();
      if (t2 + 3 < nt) AT_GLOAD(t2 + 3, 1);
      body(lds + 18432, lds + 18432 + 9216, t2 + 1);
      if (t2 + 2 < nt) AT_LSTORE(0, 0);
      __syncthreads();
    }
  }
#undef AT_GLOAD
#undef AT_LSTORE
  f32x16 r[2];
  if (MODE == 0) {
    const float l = l_run[0] + __shfl_xor(l_run[0], 32); const float inv = 1.0f / l;
#pragma unroll
    for (int df = 0; df < 2; ++df) r[df] = o[0][df] * inv;
  } else if (MODE == 1) {
    const float* lp = p.in[I_BLAM] + layer * 128;
    float s01 = 0.f, s23 = 0.f;
    for (int i = 0; i < 32; ++i) { s01 += lp[i] * lp[32 + i]; s23 += lp[64 + i] * lp[96 + i]; }
    const float lam_init = 0.8f - 0.6f * expf(-0.3f * (float)layer);
    const float lam = expf(s01) - expf(s23) + lam_init;
    const float l0 = l_run[0] + __shfl_xor(l_run[0], 32), l1 = l_run[NMAP - 1] + __shfl_xor(l_run[NMAP - 1], 32);
    const float i0 = 1.0f / l0, i1 = lam / l1;
    float ss = 0.f;
#pragma unroll
    for (int df = 0; df < 2; ++df) { r[df] = o[0][df] * i0 - o[NMAP - 1][df] * i1;
#pragma unroll
      for (int i = 0; i < 16; ++i) ss += r[df][i] * r[df][i]; }
    ss += __shfl_xor(ss, 32);
    const float rs = rsqrtf(ss * (1.0f / 64.0f) + EPS) * (1.0f - lam_init);
    const float* sg = p.in[I_BSUB] + layer * 64;
#pragma unroll
    for (int df = 0; df < 2; ++df)
#pragma unroll
      for (int i = 0; i < 16; ++i) r[df][i] *= rs * sg[df * 32 + (i & 3) + 8 * (i >> 2) + 4 * h];
  } else {
    float ss = 0.f;
#pragma unroll
    for (int df = 0; df < 2; ++df)
#pragma unroll
      for (int i = 0; i < 16; ++i) ss += o[0][df][i] * o[0][df][i];
    ss += __shfl_xor(ss, 32);
    const float rs = rsqrtf(ss * (1.0f / 64.0f) + EPS);
    const float* gg = p.in[I_CGN] + layer * 256 + head * 64;
    const bf16_t* zg = p.z + (size_t)(row0 + qi) * NIN + C_G + head * 64;
#pragma unroll
    for (int df = 0; df < 2; ++df)
#pragma unroll
      for (int g = 0; g < 4; ++g) { const u32x2 gw = *(const u32x2*)(zg + df * 32 + 8 * g + 4 * h);
        const float gv[4] = {bflo(gw.x), bfhi(gw.x), bflo(gw.y), bfhi(gw.y)};
#pragma unroll
        for (int e = 0; e < 4; ++e) { const float x = gv[e]; r[df][4 * g + e] = o[0][df][4 * g + e] * rs * gg[df * 32 + 8 * g + 4 * h + e] * (x / (1.0f + __expf(-x))); } }
  }
#pragma unroll
  for (int df = 0; df < 2; ++df)
#pragma unroll
    for (int g = 0; g < 4; ++g) { u32x2 v; v.x = pk(r[df][4 * g], r[df][4 * g + 1]); v.y = pk(r[df][4 * g + 2], r[df][4 * g + 3]); *(u32x2*)(zq + df * 32 + 8 * g + 4 * h) = v; }
}

template <class Epi>
DI void gemm_tile2(char* lds, const ASrc& A, const bf16_t* __restrict__ Bt, int K, int m0, int n0, const Epi& epi) {
  const int tid = opaque(threadIdx.x), lane = tid & 63, w = __builtin_amdgcn_readfirstlane(tid >> 6), wr = w >> 1, wc = w & 1, l31 = lane & 31, h = lane >> 5;
  const int nk = K >> 5, smask = (1 << A.shift) - 1;
  LASP char* ldsl = (LASP char*)lds;
  f32x16 acc[2][4];
#pragma unroll
  for (int a = 0; a < 2; ++a)
#pragma unroll
    for (int b = 0; b < 4; ++b)
#pragma unroll
      for (int i = 0; i < 16; ++i) acc[a][b][i] = 0.f;
  const int lrow = lane >> 2, lslot = lane & 3;
  int goffA[2], goffB[4];
#pragma unroll
  for (int i = 0; i < 2; ++i) { const int r = (2 * w + i) * 16 + lrow, c = lslot ^ ((r >> 2) & 3); goffA[i] = (r << 2) | c; }
#pragma unroll
  for (int i = 0; i < 4; ++i) { const int r = (4 * w + i) * 16 + lrow, c = lslot ^ ((r >> 2) & 3); goffB[i] = r * K + c * 8; }
#define G2_ISSUE(kt, st) do { const int k0_ = (kt) << 5, seg_ = k0_ >> A.shift, kk_ = k0_ & smask; \
    const bf16_t* bp_ = seg_ == 0 ? A.b0 : seg_ == 1 ? A.b1 : seg_ == 2 ? A.b2 : A.b3; const int st_ = seg_ == 0 ? A.s0 : seg_ == 1 ? A.s1 : seg_ == 2 ? A.s2 : A.s3; \
    _Pragma("unroll") for (int i_ = 0; i_ < 2; ++i_) { \
      const bf16_t* ga_ = bp_ + (size_t)(m0 + (goffA[i_] >> 2)) * st_ + kk_ + (goffA[i_] & 3) * 8; \
      __builtin_amdgcn_global_load_lds((const unsigned*)ga_, (LASP unsigned*)(ldsl + (st) * 24576 + (2 * w + i_) * 1024), 16, 0, 0); } \
    _Pragma("unroll") for (int i_ = 0; i_ < 4; ++i_) { \
      const bf16_t* gb_ = Bt + (size_t)n0 * K + goffB[i_] + k0_; \
      __builtin_amdgcn_global_load_lds((const unsigned*)gb_, (LASP unsigned*)(ldsl + (st) * 24576 + 8192 + (4 * w + i_) * 1024), 16, 0, 0); } } while (0)
  const int xr = (l31 >> 2) & 3;
  int coff[2];
#pragma unroll
  for (int s = 0; s < 2; ++s) coff[s] = ((2 * s + h) ^ xr) * 16;
#define G2_COMPUTE(st) do { const char* as = lds + (st) * 24576; const char* bs = as + 8192; \
    bf16x8 af[2][2], wf[2][4]; \
    _Pragma("unroll") for (int s = 0; s < 2; ++s) { \
      _Pragma("unroll") for (int mf = 0; mf < 2; ++mf) af[s][mf] = *(const bf16x8*)(as + (wr * 64 + mf * 32 + l31) * 64 + coff[s]); \
      _Pragma("unroll") for (int nf = 0; nf < 4; ++nf) wf[s][nf] = *(const bf16x8*)(bs + (wc * 128 + nf * 32 + l31) * 64 + coff[s]); } \
    __builtin_amdgcn_sched_barrier(0); __builtin_amdgcn_s_setprio(1); \
    _Pragma("unroll") for (int s = 0; s < 2; ++s) \
      _Pragma("unroll") for (int mf = 0; mf < 2; ++mf) _Pragma("unroll") for (int nf = 0; nf < 4; ++nf) acc[mf][nf] = MFMA32(wf[s][nf], af[s][mf], acc[mf][nf]); \
    __builtin_amdgcn_s_setprio(0); __builtin_amdgcn_sched_barrier(0); } while (0)
  G2_ISSUE(0, 0);
  for (int kt = 0; kt < nk; kt += 2) {
    asm volatile("s_waitcnt vmcnt(0)" ::: "memory"); __syncthreads();
    G2_ISSUE(kt + 1, 1);
    G2_COMPUTE(0);
    asm volatile("s_waitcnt vmcnt(0)" ::: "memory"); __syncthreads();
    if (kt + 2 < nk) G2_ISSUE(kt + 2, 0);
    G2_COMPUTE(1);
  }
  __syncthreads();
#pragma unroll
  for (int hf = 0; hf < 2; ++hf) {
    f32x16 t[2][2];
#pragma unroll
    for (int mf = 0; mf < 2; ++mf) { t[mf][0] = acc[mf][2 * hf]; t[mf][1] = acc[mf][2 * hf + 1]; }
    epi(t, m0 + wr * 64, n0 + wc * 128 + hf * 64, n0, wc, l31, h);
  }
  __syncthreads();
#undef G2_ISSUE
#undef G2_COMPUTE
}

template <class Epi>
DI void gemm_phase2(char* lds, const ASrc& A, const bf16_t* Bt, int K, int ntn, const Epi& epi) {
  const int xcd = blockIdx.x & 7, j = blockIdx.x >> 3, nloc = gridDim.x >> 3, per = 48 * ntn, grp = 8 * ntn;
  for (int li = j; li < per; li += nloc) {
    const int sg = li / grp, wi = li - sg * grp, nt = wi >> 3, mt = xcd * 48 + sg * 8 + (wi & 7);
    gemm_tile2(lds, A, Bt, K, mt * 128, nt * 256, epi);
  }
}

template <int MODE>
DI void attn3_item(char* lds, const Params& p, int layer, int seq, int head, int qt) {
  const int tid = opaque(threadIdx.x), lane = tid & 63, w = tid >> 6, l31 = lane & 31, h = lane >> 5;
  layer = opaque_s(layer); seq = opaque_s(seq); head = opaque_s(head); qt = opaque_s(qt);
  int row0, T; seq_info(seq, row0, T);
  const int QC = (MODE == 0 ? A_Q : C_Q) + head * 64;
  const int KC = MODE == 0 ? A_K + (head >> 1) * 64 : C_K + head * 64;
  const int VC = MODE == 0 ? A_V + (head >> 1) * 64 : C_V + head * 64;
  const int qw0 = qt * 256 + w * 64;
  bf16x8 qf[2][4];
#pragma unroll
  for (int qi = 0; qi < 2; ++qi)
#pragma unroll
    for (int s = 0; s < 4; ++s) qf[qi][s] = *(const bf16x8*)(p.z + (size_t)(row0 + qw0 + qi * 32 + l31) * NIN + QC + s * 16 + h * 8);
  const int srow = tid >> 3, sc8 = tid & 7;
  const bf16_t* kbase = p.z + (size_t)(row0 + srow) * NIN + KC + sc8 * 8;
  const bf16_t* vbase = p.z + (size_t)(row0 + srow) * NIN + VC + sc8 * 8;
  u32x4 rk[2], rv[2];
  const int nt = T >> 6;
  const int prow = (l31 & 19) | ((l31 & 4) << 1) | ((l31 & 8) >> 1);
#define A3_GLOAD(t) do { _Pragma("unroll") for (int i_ = 0; i_ < 2; ++i_) { const size_t off_ = (size_t)((t) * 64 + 32 * i_) * NIN; rk[i_] = *(const u32x4*)(kbase + off_); rv[i_] = *(const u32x4*)(vbase + off_); } } while (0)
#define A3_LSTORE(buf) do { char* ks_ = lds + (buf) * 18432; char* vs_ = ks_ + 9216; \
    _Pragma("unroll") for (int i_ = 0; i_ < 2; ++i_) { *(u32x4*)(ks_ + (srow + 32 * i_) * PITCH + sc8 * 16) = rk[i_]; *(u32x4*)(vs_ + (srow + 32 * i_) * PITCH + sc8 * 16) = rv[i_]; } } while (0)
  f32x16 o[2][2];
  float m_run[2], l_run[2];
#pragma unroll
  for (int a = 0; a < 2; ++a) { m_run[a] = -INFINITY; l_run[a] = 0.f;
#pragma unroll
    for (int b = 0; b < 2; ++b)
#pragma unroll
      for (int i = 0; i < 16; ++i) o[a][b][i] = 0.f; }
  float lf = 0.f, lb = 0.f;
  if (MODE == 2) { lf = log2f(1.0f - exp2f(-5.0f - (float)head)); lb = log2f(1.0f - exp2f(-5.0f - (float)(3 - head))); }
  A3_GLOAD(0); A3_LSTORE(0); __syncthreads();
#pragma unroll 1
  for (int t = 0; t < nt; ++t) {
    if (t + 1 < nt) A3_GLOAD(t + 1);
    const char* ks = lds + (t & 1) * 18432; const char* vs = ks + 9216;
    f32x16 st[2][2];
#pragma unroll
    for (int kf = 0; kf < 2; ++kf) {
#pragma unroll
      for (int qi = 0; qi < 2; ++qi)
#pragma unroll
        for (int i = 0; i < 16; ++i) st[qi][kf][i] = 0.f;
#pragma unroll
      for (int s = 0; s < 4; ++s) { const bf16x8 kfr = *(const bf16x8*)(ks + (kf * 32 + prow) * PITCH + s * 32 + h * 16);
#pragma unroll
        for (int qi = 0; qi < 2; ++qi) st[qi][kf] = MFMA32(kfr, qf[qi][s], st[qi][kf]); }
    }
    __builtin_amdgcn_sched_barrier(0);
#pragma unroll
    for (int qi = 0; qi < 2; ++qi) {
      bf16x8 pf[4];
      if (MODE == 2) {
        const int k0 = t * 64, qb = qw0 + qi * 32;
        const float dbase = (float)(qb + l31 - k0 - 8 * h);
        if (k0 + 63 < qb) {
#pragma unroll
          for (int kf = 0; kf < 2; ++kf)
#pragma unroll
            for (int i = 0; i < 16; ++i) { const float cc = (float)(32 * kf + (i & 3) + 4 * ((i >> 2) & 1) + 16 * ((i >> 3) & 1)); st[qi][kf][i] *= fexp2(lf * (dbase - cc)); }
        } else if (k0 > qb + 31) {
#pragma unroll
          for (int kf = 0; kf < 2; ++kf)
#pragma unroll
            for (int i = 0; i < 16; ++i) { const float cc = (float)(32 * kf + (i & 3) + 4 * ((i >> 2) & 1) + 16 * ((i >> 3) & 1)); st[qi][kf][i] *= fexp2(lb * (cc - dbase)); }
        } else {
#pragma unroll
          for (int kf = 0; kf < 2; ++kf)
#pragma unroll
            for (int i = 0; i < 16; ++i) { const float cc = (float)(32 * kf + (i & 3) + 4 * ((i >> 2) & 1) + 16 * ((i >> 3) & 1)); const float d = dbase - cc;
              float dd = fexp2(fminf(lf * d, -lb * d)); if (d == 0.f) dd = 2.0f; st[qi][kf][i] *= dd; }
        }
      } else {
        float mx = st[qi][0][0];
#pragma unroll
        for (int kf = 0; kf < 2; ++kf)
#pragma unroll
          for (int i = 0; i < 16; ++i) mx = fmaxf(mx, st[qi][kf][i]);
        mx = fmaxf(mx, __shfl_xor(mx, 32));
        const float mn = fmaxf(m_run[qi], mx); const float alpha = fexp2(m_run[qi] - mn); m_run[qi] = mn;
        float ps = 0.f;
#pragma unroll
        for (int kf = 0; kf < 2; ++kf)
#pragma unroll
          for (int i = 0; i < 16; ++i) { st[qi][kf][i] = fexp2(st[qi][kf][i] - mn); ps += st[qi][kf][i]; }
        l_run[qi] = l_run[qi] * alpha + ps;
#pragma unroll
        for (int df = 0; df < 2; ++df) o[qi][df] *= alpha;
      }
#pragma unroll
      for (int kf = 0; kf < 2; ++kf)
#pragma unroll
        for (int s2 = 0; s2 < 2; ++s2) { u32x4 u; u.x = pk(st[qi][kf][8 * s2], st[qi][kf][8 * s2 + 1]); u.y = pk(st[qi][kf][8 * s2 + 2], st[qi][kf][8 * s2 + 3]);
          u.z = pk(st[qi][kf][8 * s2 + 4], st[qi][kf][8 * s2 + 5]); u.w = pk(st[qi][kf][8 * s2 + 6], st[qi][kf][8 * s2 + 7]); pf[kf * 2 + s2] = __builtin_bit_cast(bf16x8, u); }
#pragma unroll
      for (int df = 0; df < 2; ++df)
#pragma unroll
        for (int ksx = 0; ksx < 4; ++ksx) { const bf16x8 vfr = *(const bf16x8*)(vs + (df * 32 + l31) * PITCH + ksx * 32 + h * 16); o[qi][df] = MFMA32(vfr, pf[ksx], o[qi][df]); }
      __builtin_amdgcn_sched_barrier(0);
    }
    __builtin_amdgcn_sched_barrier(0);
    if (t + 1 < nt) A3_LSTORE((t + 1) & 1);
    __syncthreads();
  }
#undef A3_GLOAD
#undef A3_LSTORE
#pragma unroll
  for (int qi = 0; qi < 2; ++qi) {
    const int qrow = row0 + qw0 + qi * 32 + l31;
    bf16_t* zq = p.z + (size_t)qrow * NIN + QC;
    f32x16 r[2];
    if (MODE == 0) {
      const float l = l_run[qi] + __shfl_xor(l_run[qi], 32); const float inv = 1.0f / l;
#pragma unroll
      for (int df = 0; df < 2; ++df) r[df] = o[qi][df] * inv;
    } else {
      float ss = 0.f;
#pragma unroll
      for (int df = 0; df < 2; ++df)
#pragma unroll
        for (int i = 0; i < 16; ++i) ss += o[qi][df][i] * o[qi][df][i];
      ss += __shfl_xor(ss, 32);
      const float rs = rsqrtf(ss * (1.0f / 64.0f) + EPS);
      const float* gg = p.in[I_CGN] + layer * 256 + head * 64;
      const bf16_t* zg = p.z + (size_t)qrow * NIN + C_G + head * 64;
#pragma unroll
      for (int df = 0; df < 2; ++df)
#pragma unroll
        for (int g = 0; g < 4; ++g) { const u32x2 gw = *(const u32x2*)(zg + df * 32 + 8 * g + 4 * h);
          const float gv[4] = {bflo(gw.x), bfhi(gw.x), bflo(gw.y), bfhi(gw.y)};
#pragma unroll
          for (int e = 0; e < 4; ++e) { const float x = gv[e]; r[df][4 * g + e] = o[qi][df][4 * g + e] * rs * gg[df * 32 + 8 * g + 4 * h + e] * (x / (1.0f + __expf(-x))); } }
    }
#pragma unroll
    for (int df = 0; df < 2; ++df)
#pragma unroll
      for (int g = 0; g < 4; ++g) { u32x2 v; v.x = pk(r[df][4 * g], r[df][4 * g + 1]); v.y = pk(r[df][4 * g + 2], r[df][4 * g + 3]); *(u32x2*)(zq + df * 32 + 8 * g + 4 * h) = v; }
  }
}

DI void ctr_barrier(unsigned* cnt) {
  asm volatile("s_waitcnt vmcnt(0) lgkmcnt(0)" ::: "memory");
  __syncthreads();
  if (threadIdx.x == 0) {
    __builtin_amdgcn_fence(__ATOMIC_RELEASE, "agent");
    asm volatile("s_waitcnt vmcnt(0)" ::: "memory");
    const unsigned G = gridDim.x;
    const unsigned old = __hip_atomic_fetch_add(cnt, 1u, __ATOMIC_RELAXED, __HIP_MEMORY_SCOPE_AGENT);
    const unsigned gen = old / G + 1u;
    if (old + 1u == gen * G) __hip_atomic_store(cnt + 64, gen, __ATOMIC_RELAXED, __HIP_MEMORY_SCOPE_AGENT);
    else while (__hip_atomic_load(cnt + 64, __ATOMIC_RELAXED, __HIP_MEMORY_SCOPE_AGENT) < gen) __builtin_amdgcn_s_sleep(1);
    __builtin_amdgcn_fence(__ATOMIC_ACQUIRE, "agent");
    asm volatile("s_waitcnt vmcnt(0)" ::: "memory");
  }
  __syncthreads();
}

DI int next_item(int* ctr, int* sh) {
  __syncthreads();
  if (threadIdx.x == 0) *sh = atomicAdd(ctr, 1);
  __syncthreads();
  return *sh;
}
constexpr int XQ_N = 416;
DI int next_item_x(int* ctr8, int* sh) {
  __syncthreads();
  if (threadIdx.x == 0) {
    int r = -1;
    const int x0 = blockIdx.x & 7;
    for (int k = 0; k < 8; ++k) { const int x = (x0 + k) & 7; const int i = atomicAdd(ctr8 + x, 1); if (i < XQ_N) { r = (x << 16) | i; break; } }
    *sh = r;
  }
  __syncthreads();
  return *sh;
}

__global__ void __launch_bounds__(256, 2) fwd(Params p) {
  extern __shared__ __attribute__((aligned(16))) char lds[];
  __shared__ int s_item;
  cg::grid_group grid = cg::this_grid();
  const int bid = blockIdx.x, nb = gridDim.x, tid = threadIdx.x, lane = tid & 63, w = tid >> 6;
  if (bid == 0) p.ctr[tid] = 0;
  for (int i = bid * 256 + tid; i < 4096 * 32; i += nb * 256) { const int t = i >> 5, j = i & 31; const float inv = powf(10000.0f, -(float)(2 * j) / 64.0f); float sn, cs; sincosf((float)t * inv, &sn, &cs); p.tabC[i] = (f32x2){cs, sn}; }
  for (int i = bid * 256 + tid; i < 4096 * 4; i += nb * 256) { const int t = i >> 2, j = i & 3; const float inv = powf(500000.0f, -(float)(2 * j) / 8.0f); float sn, cs; sincosf((float)t * inv, &sn, &cs); p.tabB[i] = (f32x2){cs, sn}; }
  for (int i = bid * 256 + tid; i < 64 * 16; i += nb * 256) { const int t = i >> 4, j = i & 15; const float inv = powf(10000.0f, -(float)(2 * j) / 32.0f); float sn, cs; sincosf((float)t * inv, &sn, &cs); p.tabA[i] = (f32x2){cs, sn}; }
  for (int l = 0; l < 2; ++l) {
    for (int i = bid * 256 + tid; i < (NINP - NIN) * 1024; i += nb * 256) p.wtin[(size_t)l * NINP * 1024 + (size_t)NIN * 1024 + i] = 0;
    for (int tl = bid; tl < 16 * 53; tl += nb) conv_T(lds, p.in[I_WIN] + (size_t)l * 1024 * NIN, 1024, NIN, p.wtin + (size_t)l * NINP * 1024, 0, tl);
    for (int tl = bid; tl < 16 * 16; tl += nb) conv_T(lds, p.in[I_WOUT] + (size_t)l * 1024 * 1024, 1024, 1024, p.wtout + (size_t)l * 1024 * 1024, 0, tl);
  }
  bf16_t* hb = p.pl;
  for (int row = bid * 4 + opaque(w); row < MT; row += nb * 8) {
    const int rb = row + nb * 4;
    const float* xin = row < M0 ? p.in[I_XP] + (size_t)row * 1024 : p.in[I_XS] + (size_t)(row - M0) * 1024;
    if (rb < MT) { const float* xinb = rb < M0 ? p.in[I_XP] + (size_t)rb * 1024 : p.in[I_XS] + (size_t)(rb - M0) * 1024;
      row_phase2(xin, xinb, p.out + (size_t)row * 1024, p.out + (size_t)rb * 1024, nullptr, nullptr, nullptr, p.in[I_NMPRE], hb + (size_t)row * 1024, hb + (size_t)rb * 1024, lane); }
    else row_phase(xin, p.out + (size_t)row * 1024, nullptr, nullptr, p.in[I_NMPRE], hb + (size_t)row * 1024, lane);
  }
  grid.sync();
  for (int l = 0; l < 2; ++l) {
    { ASrc A; A.b0 = hb; A.b1 = hb; A.b2 = hb; A.b3 = hb; A.s0 = A.s1 = A.s2 = A.s3 = 1024; A.shift = 12;
      EpiIn e; e.z = p.z; e.lds = lds; e.qg = p.in[I_AQG] + l * 64; e.kg = p.in[I_AKG] + l * 64; e.tabA = p.tabA; e.tabB = p.tabB; e.tabC = p.tabC;
      gemm_phase2(lds, A, p.wtin + (size_t)l * NINP * 1024, 1024, 14, e); }
    ctr_barrier((unsigned*)p.ctr + 96);
    for (int it = bid; it < MT / DTOK; it += nb) dprep_item(lds, p, l, it);
    ctr_barrier((unsigned*)p.ctr + 96);
    for (;;) {
      const int it = next_item_x(p.ctr + l * 16, &s_item);
      if (it < 0) break;
      const int x = it >> 16; int i = it & 0xffff;
      if (i < 32) { const int j = i & 15; rwkv_item(lds, p, i < 16 ? x : 8 + x, (j >> 2) & 3, (j >> 1) & 1, j & 1); }
      else { i -= 32;
        if (i < 128) attn_item<1>(lds, p, l, x, i >> 5, i & 31);
        else if (i < 192) { i -= 128; attn3_item<2>(lds, p, l, x, i >> 4, i & 15); }
        else if (i < 256) { i -= 192; attn3_item<0>(lds, p, l, x, i >> 4, i & 15); }
        else if (i < 320) { i -= 256; attn_item<1>(lds, p, l, 8 + x, i >> 4, i & 15); }
        else if (i < 352) { i -= 320; attn3_item<2>(lds, p, l, 8 + x, i >> 3, i & 7); }
        else { i -= 352; attn3_item<0>(lds, p, l, 8 + x, i >> 3, i & 7); }
      }
    }
    ctr_barrier((unsigned*)p.ctr + 96);
    bf16_t* wtgu = p.pl + 5 * PLANE; bf16_t* wtd = wtgu + (size_t)2 * DFF * 1024;
    for (int it = bid; it < MT / DTOK + 3 * 704; it += nb) {
      if (it < MT / DTOK) dpost_item(lds, p, l, it);
      else { const int j = it - MT / DTOK;
        if (j < 704) conv_T(lds, p.in[I_FG] + (size_t)l * 1024 * DFF, 1024, DFF, wtgu, 1, j);
        else if (j < 1408) conv_T(lds, p.in[I_FU] + (size_t)l * 1024 * DFF, 1024, DFF, wtgu, 2, j - 704);
        else conv_T(lds, p.in[I_FD] + (size_t)l * DFF * 1024, DFF, 1024, wtd, 0, j - 1408); }
    }
    ctr_barrier((unsigned*)p.ctr + 96);
    { ASrc A; A.b0 = p.z + A_Q; A.b1 = p.z + B_Q; A.b2 = p.z + C_Q; A.b3 = p.pl + 4 * PLANE; A.s0 = A.s1 = A.s2 = NIN; A.s3 = 256; A.shift = 8;
      EpiStore e; e.out = hb; e.ldc = 1024; e.nmax = 1024; e.lds = lds;
      gemm_phase2(lds, A, p.wtout + (size_t)l * 1024 * 1024, 1024, 4, e); }
    ctr_barrier((unsigned*)p.ctr + 96);
    for (int row = bid * 4 + opaque(w); row < MT; row += nb * 8) { const int rb = row + nb * 4;
      if (rb < MT) row_phase2(p.out + (size_t)row * 1024, p.out + (size_t)rb * 1024, p.out + (size_t)row * 1024, p.out + (size_t)rb * 1024, hb + (size_t)row * 1024, hb + (size_t)rb * 1024,
                              p.in[I_NMPOST] + l * 1024, p.in[I_NFPRE] + l * 1024, hb + (size_t)row * 1024, hb + (size_t)rb * 1024, lane);
      else row_phase(p.out + (size_t)row * 1024, p.out + (size_t)row * 1024, hb + (size_t)row * 1024, p.in[I_NMPOST] + l * 1024, p.in[I_NFPRE] + l * 1024, hb + (size_t)row * 1024, lane); }
    ctr_barrier((unsigned*)p.ctr + 96);
    { ASrc A; A.b0 = hb; A.b1 = hb; A.b2 = hb; A.b3 = hb; A.s0 = A.s1 = A.s2 = A.s3 = 1024; A.shift = 12;
      EpiSwiGLU e; e.out = p.z; e.lds = lds;
      gemm_phase2(lds, A, wtgu, 1024, 22, e); }
    ctr_barrier((unsigned*)p.ctr + 96);
    { ASrc A; A.b0 = p.z; A.b1 = p.z; A.b2 = p.z; A.b3 = p.z; A.s0 = A.s1 = A.s2 = A.s3 = DFF; A.shift = 12;
      EpiStore e; e.out = hb; e.ldc = 1024; e.nmax = 1024; e.lds = lds;
      gemm_phase2(lds, A, wtd, DFF, 4, e); }
    ctr_barrier((unsigned*)p.ctr + 96);
    for (int row = bid * 4 + opaque(w); row < MT; row += nb * 8) { const int rb = row + nb * 4; const float* gp2 = l == 0 ? p.in[I_NMPRE] + 1024 : nullptr;
      if (rb < MT) row_phase2(p.out + (size_t)row * 1024, p.out + (size_t)rb * 1024, p.out + (size_t)row * 1024, p.out + (size_t)rb * 1024, hb + (size_t)row * 1024, hb + (size_t)rb * 1024,
                              p.in[I_NFPOST] + l * 1024, gp2, hb + (size_t)row * 1024, hb + (size_t)rb * 1024, lane);
      else row_phase(p.out + (size_t)row * 1024, p.out + (size_t)row * 1024, hb + (size_t)row * 1024, p.in[I_NFPOST] + l * 1024, gp2, hb + (size_t)row * 1024, lane); }
    if (l == 0) ctr_barrier((unsigned*)p.ctr + 96);
  }
}

extern "C" void kernel_launch(void* const* d_in, const int* in_sizes, int n_in, void* d_out, int out_size,
                              void* d_ws, size_t ws_size, hipStream_t stream) {
  static int grid_blocks = 0;
  if (!grid_blocks) {
    int dev = 0, cus = 0, per_cu = 0;
    hipGetDevice(&dev);
    hipDeviceGetAttribute(&cus, hipDeviceAttributeMultiprocessorCount, dev);
    hipFuncSetAttribute((const void*)fwd, hipFuncAttributeMaxDynamicSharedMemorySize, LDS_BYTES);
    hipOccupancyMaxActiveBlocksPerMultiprocessor(&per_cu, fwd, 256, LDS_BYTES);
    if (per_cu > 2) per_cu = 2;
    if (per_cu < 1) per_cu = 1;
    grid_blocks = cus * per_cu;
  }
  Params p{};
  for (int i = 0; i < 28; ++i) p.in[i] = (const float*)d_in[i];
  p.out = (float*)d_out;
  char* ws = (char*)d_ws;
  size_t off = 0;
  p.z = (bf16_t*)(ws + off); off += (size_t)MT * NIN * 2;
  p.pl = (bf16_t*)(ws + off); off += 7 * PLANE * 2;
  p.wtin = (bf16_t*)(ws + off); off += (size_t)2 * NINP * 1024 * 2;
  p.wtout = (bf16_t*)(ws + off); off += (size_t)2 * 1024 * 1024 * 2;
  p.tabC = (f32x2*)(ws + off); off += (size_t)4096 * 32 * 8;
  p.tabB = (f32x2*)(ws + off); off += (size_t)4096 * 4 * 8;
  p.tabA = (f32x2*)(ws + off); off += (size_t)64 * 16 * 8;
  p.ctr = (int*)(ws + off); off += 1024;
  if (off > ws_size) fprintf(stderr, "workspace too small: need %zu have %zu\n", off, ws_size);
  void* args[] = {&p};
  hipError_t e = hipLaunchCooperativeKernel((void*)fwd, dim3(grid_blocks), dim3(256), args, LDS_BYTES, stream);
  if (e != hipSuccess) fprintf(stderr, "coop launch failed: %s (grid %d)\n", hipGetErrorString(e), grid_blocks);
}
```

```cpp
#include <hip/hip_runtime.h>
#include <hip/hip_cooperative_groups.h>
#include <cstdio>
#include <cstdint>
namespace cg = cooperative_groups;

#define DI __device__ __forceinline__
typedef unsigned short bf16_t;
typedef short bf16x8 __attribute__((ext_vector_type(8)));
typedef float f32x2 __attribute__((ext_vector_type(2)));
typedef float f32x4 __attribute__((ext_vector_type(4)));
typedef float f32x16 __attribute__((ext_vector_type(16)));
typedef unsigned u32x2 __attribute__((ext_vector_type(2)));
typedef unsigned u32x4 __attribute__((ext_vector_type(4)));
typedef __bf16 bf16x2_t __attribute__((ext_vector_type(2)));

constexpr int M0 = 32768, MT = 49152, DM = 1024, NIN = 3392, NINP = 3584, DFF = 2816;
constexpr int A_Q = 0, A_K = 256, A_V = 384, B_Q = 512, B_K = 768, B_V = 1024, C_Q = 1280, C_K = 1536, C_V = 1792, C_G = 2048, D_0 = 2304;
constexpr int PITCH = 144;
constexpr size_t PLANE = (size_t)MT * 256;
constexpr int LDS_BYTES = 73728;
constexpr float LOG2E = 1.4426950408889634f;
constexpr float EPS = 1e-6f;

enum { I_XP = 0, I_XS, I_NMPRE, I_NMPOST, I_NFPRE, I_NFPOST, I_WIN, I_WOUT, I_AQG, I_AKG, I_BLAM, I_BSUB, I_CGN, I_DMUP, I_DMUN, I_DW0, I_DWUP,
       I_DA0, I_DAUP, I_DGUP, I_DKK, I_DKA, I_DRK, I_DGNW, I_DGNB, I_FG, I_FU, I_FD };

struct Params {
  const float* in[28];
  float* out;
  bf16_t* z;
  bf16_t* pl;
  bf16_t* wtin;
  bf16_t* wtout;
  f32x2* tabC;
  f32x2* tabB;
  f32x2* tabA;
  int* ctr;
};

DI int opaque(int x) { asm volatile("" : "+v"(x)); return x; }
DI int opaque_s(int x) { asm volatile("" : "+s"(x)); return x; }
DI float bf2f(bf16_t v) { return __uint_as_float(((unsigned)v) << 16); }
DI float bflo(unsigned w) { return __uint_as_float(w << 16); }
DI float bfhi(unsigned w) { return __uint_as_float(w & 0xffff0000u); }
DI unsigned pk(float lo, float hi) { f32x2 v = {lo, hi}; bf16x2_t b = __builtin_convertvector(v, bf16x2_t); return __builtin_bit_cast(unsigned, b); }
DI bf16_t f2bf(float x) { return (bf16_t)(pk(x, 0.f) & 0xffffu); }
DI float dppf(float x, const int ctrl) { return x; }
#define DPPF(x, ctrl) __int_as_float(__builtin_amdgcn_update_dpp(0, __float_as_int(x), (ctrl), 0xF, 0xF, true))
DI float wave_sum(float v) {
  v += DPPF(v, 0xB1);
  v += DPPF(v, 0x4E);
  v += DPPF(v, 0x141);
  v += DPPF(v, 0x140);
  const int vi = __float_as_int(v);
  return (__int_as_float(__builtin_amdgcn_readlane(vi, 0)) + __int_as_float(__builtin_amdgcn_readlane(vi, 16))) +
         (__int_as_float(__builtin_amdgcn_readlane(vi, 32)) + __int_as_float(__builtin_amdgcn_readlane(vi, 48)));
}
DI float dpp_xor1(float x) { return __int_as_float(__builtin_amdgcn_update_dpp(0, __float_as_int(x), 0xB1, 0xF, 0xF, true)); }
DI float dpp_xor2(float x) { return __int_as_float(__builtin_amdgcn_update_dpp(0, __float_as_int(x), 0x4E, 0xF, 0xF, true)); }
DI float dpp_hmir(float x) { return __int_as_float(__builtin_amdgcn_update_dpp(0, __float_as_int(x), 0x141, 0xF, 0xF, true)); }
DI float red8(float x) { x += dpp_xor1(x); x += dpp_xor2(x); x += dpp_hmir(x); return x; }
DI float fexp2(float x) { return __builtin_amdgcn_exp2f(x); }
DI void seq_info(int s, int& row0, int& T) { if (s < 8) { row0 = s * 4096; T = 4096; } else { row0 = M0 + (s - 8) * 2048; T = 2048; } }
DI void row_info(int r, int& t, int& T) { if (r < M0) { t = r & 4095; T = 4096; } else { t = (r - M0) & 2047; T = 2048; } }
#define MFMA32(a, b, c) __builtin_amdgcn_mfma_f32_32x32x16_bf16((a), (b), (c), 0, 0, 0)

DI void conv_T(char* lds, const float* __restrict__ W, int K, int N, bf16_t* __restrict__ Wt, int mode, int tile) {
  float* t = (float*)lds;
  const int tid0 = opaque(threadIdx.x);
  const int ntn = N >> 6, kt = tile / ntn, nt = tile - kt * ntn, k0 = kt << 6, n0 = nt << 6;
  float wv[16];
#pragma unroll
  for (int i = 0; i < 16; ++i) { const int idx = tid0 + 256 * i, k = idx >> 6, n = idx & 63; wv[i] = W[(size_t)(k0 + k) * N + n0 + n]; }
#pragma unroll
  for (int i = 0; i < 16; ++i) { const int idx = tid0 + 256 * i, k = idx >> 6, n = idx & 63; t[k * 65 + n] = wv[i]; }
  __syncthreads();
#pragma unroll 4
  for (int i = 0; i < 8; ++i) {
    const int idx = tid0 + 256 * i, n = idx >> 5, k = (idx & 31) * 2, j = n0 + n;
    const int rho = (mode == 0) ? j : ((j >> 6) * 128 + ((j >> 5) & 1) * 64 + (mode - 1) * 32 + (j & 31));
    *(unsigned*)(Wt + (size_t)rho * K + k0 + k) = pk(t[k * 65 + n], t[(k + 1) * 65 + n]);
  }
  __syncthreads();
}

DI void row_phase(const float* __restrict__ xin, float* __restrict__ xout, const bf16_t* addsrc, const float* __restrict__ gpost,
                  const float* __restrict__ gpre, bf16_t* hout, int lane_in) {
  const int lane = opaque(lane_in);
  f32x4 x[4];
#pragma unroll
  for (int i = 0; i < 4; ++i) x[i] = *(const f32x4*)(xin + i * 256 + lane * 4);
  if (addsrc) {
    f32x4 m[4]; float ss = 0.f;
#pragma unroll
    for (int i = 0; i < 4; ++i) { const u32x2 w = *(const u32x2*)(addsrc + i * 256 + lane * 4); m[i] = (f32x4){bflo(w.x), bfhi(w.x), bflo(w.y), bfhi(w.y)};
      ss += m[i][0] * m[i][0] + m[i][1] * m[i][1] + m[i][2] * m[i][2] + m[i][3] * m[i][3]; }
    ss = wave_sum(ss); const float rs = rsqrtf(ss * (1.0f / 1024.0f) + EPS);
#pragma unroll
    for (int i = 0; i < 4; ++i) { const f32x4 g = *(const f32x4*)(gpost + i * 256 + lane * 4); x[i] += m[i] * rs * g; }
  }
#pragma unroll
  for (int i = 0; i < 4; ++i) *(f32x4*)(xout + i * 256 + lane * 4) = x[i];
  if (gpre) {
    float ss = 0.f;
#pragma unroll
    for (int i = 0; i < 4; ++i) ss += x[i][0] * x[i][0] + x[i][1] * x[i][1] + x[i][2] * x[i][2] + x[i][3] * x[i][3];
    ss = wave_sum(ss); const float rs = rsqrtf(ss * (1.0f / 1024.0f) + EPS);
#pragma unroll
    for (int i = 0; i < 4; ++i) { const f32x4 g = *(const f32x4*)(gpre + i * 256 + lane * 4); const f32x4 hv = x[i] * rs * g;
      u32x2 w; w.x = pk(hv[0], hv[1]); w.y = pk(hv[2], hv[3]); *(u32x2*)(hout + i * 256 + lane * 4) = w; }
  }
}

DI void row_phase2(const float* __restrict__ xinA, const float* __restrict__ xinB, float* __restrict__ xoutA, float* __restrict__ xoutB, const bf16_t* addA, const bf16_t* addB,
                   const float* __restrict__ gpost, const float* __restrict__ gpre, bf16_t* houtA, bf16_t* houtB, int lane_in) {
  const int lane = opaque(lane_in);
  f32x4 x[2][4]; u32x2 aw[2][4];
#pragma unroll
  for (int i = 0; i < 4; ++i) { x[0][i] = *(const f32x4*)(xinA + i * 256 + lane * 4); x[1][i] = *(const f32x4*)(xinB + i * 256 + lane * 4); }
  if (addA) {
#pragma unroll
    for (int i = 0; i < 4; ++i) { aw[0][i] = *(const u32x2*)(addA + i * 256 + lane * 4); aw[1][i] = *(const u32x2*)(addB + i * 256 + lane * 4); }
#pragma unroll
    for (int r = 0; r < 2; ++r) {
      f32x4 m[4]; float ss = 0.f;
#pragma unroll
      for (int i = 0; i < 4; ++i) { const u32x2 w = aw[r][i]; m[i] = (f32x4){bflo(w.x), bfhi(w.x), bflo(w.y), bfhi(w.y)};
        ss += m[i][0] * m[i][0] + m[i][1] * m[i][1] + m[i][2] * m[i][2] + m[i][3] * m[i][3]; }
      ss = wave_sum(ss); const float rs = rsqrtf(ss * (1.0f / 1024.0f) + EPS);
#pragma unroll
      for (int i = 0; i < 4; ++i) { const f32x4 g = *(const f32x4*)(gpost + i * 256 + lane * 4); x[r][i] += m[i] * rs * g; }
    }
  }
#pragma unroll
  for (int i = 0; i < 4; ++i) { *(f32x4*)(xoutA + i * 256 + lane * 4) = x[0][i]; *(f32x4*)(xoutB + i * 256 + lane * 4) = x[1][i]; }
  if (gpre) {
#pragma unroll
    for (int r = 0; r < 2; ++r) {
      float ss = 0.f;
#pragma unroll
      for (int i = 0; i < 4; ++i) ss += x[r][i][0] * x[r][i][0] + x[r][i][1] * x[r][i][1] + x[r][i][2] * x[r][i][2] + x[r][i][3] * x[r][i][3];
      ss = wave_sum(ss); const float rs = rsqrtf(ss * (1.0f / 1024.0f) + EPS);
      bf16_t* ho = r == 0 ? houtA : houtB;
#pragma unroll
      for (int i = 0; i < 4; ++i) { const f32x4 g = *(const f32x4*)(gpre + i * 256 + lane * 4); const f32x4 hv = x[r][i] * rs * g;
        u32x2 w; w.x = pk(hv[0], hv[1]); w.y = pk(hv[2], hv[3]); *(u32x2*)(ho + i * 256 + lane * 4) = w; }
    }
  }
}

struct ASrc { const bf16_t* b0; const bf16_t* b1; const bf16_t* b2; const bf16_t* b3; int s0, s1, s2, s3; int shift; };

DI void store_piece64(char* img, const f32x16 (&acc)[2][2], bf16_t* out, size_t ld, int row0, int col0, int l31, int h) {
#pragma unroll
  for (int mf = 0; mf < 2; ++mf)
#pragma unroll
    for (int nf = 0; nf < 2; ++nf)
#pragma unroll
      for (int g = 0; g < 4; ++g) { u32x2 v; v.x = pk(acc[mf][nf][4 * g], acc[mf][nf][4 * g + 1]); v.y = pk(acc[mf][nf][4 * g + 2], acc[mf][nf][4 * g + 3]);
        *(u32x2*)(img + (mf * 32 + l31) * PITCH + (nf * 32 + 8 * g + 4 * h) * 2) = v; }
  const int ln = l31 + 32 * h;
#pragma unroll 2
  for (int i = 0; i < 8; ++i) { const int q = ln + 64 * i, r = q >> 3, c8 = q & 7;
    const u32x4 v = *(const u32x4*)(img + r * PITCH + c8 * 16); *(u32x4*)(out + (size_t)(row0 + r) * ld + col0 + c8 * 8) = v; }
}
DI void store_piece32(char* img, const f32x16 (&a0), const f32x16 (&a1), bf16_t* out, size_t ld, int row0, int col0, int l31, int h) {
#pragma unroll
  for (int g = 0; g < 4; ++g) { u32x2 v; v.x = pk(a0[4 * g], a0[4 * g + 1]); v.y = pk(a0[4 * g + 2], a0[4 * g + 3]); *(u32x2*)(img + l31 * PITCH + (8 * g + 4 * h) * 2) = v;
    u32x2 u; u.x = pk(a1[4 * g], a1[4 * g + 1]); u.y = pk(a1[4 * g + 2], a1[4 * g + 3]); *(u32x2*)(img + l31 * PITCH + (32 + 8 * g + 4 * h) * 2) = u; }
  const int ln = l31 + 32 * h;
#pragma unroll
  for (int i = 0; i < 4; ++i) { const int q = ln + 64 * i, r = q >> 3, c8 = q & 7;
    const u32x4 v = *(const u32x4*)(img + r * PITCH + c8 * 16); *(u32x4*)(out + (size_t)(row0 + r) * ld + col0 + c8 * 8) = v; }
}
struct EpiStore { bf16_t* out; int ldc; int nmax; char* lds;
  DI void operator()(const f32x16 (&acc)[2][2], int mb, int nb, int n0, int wc, int l31, int h) const {
    if (nb >= nmax) return;
    store_piece64(lds + (threadIdx.x >> 6) * 9216, acc, out, (size_t)ldc, mb, nb, l31, h);
  } };
struct EpiSwiGLU { bf16_t* out; char* lds;
  DI void operator()(const f32x16 (&acc)[2][2], int mb, int nb, int n0, int wc, int l31, int h) const {
    const int hc = (nb >> 6) * 32;
    char* img = lds + (threadIdx.x >> 6) * 9216;
#pragma unroll
    for (int mf = 0; mf < 2; ++mf)
#pragma unroll
      for (int g = 0; g < 4; ++g) { float r[4];
#pragma unroll
        for (int e = 0; e < 4; ++e) { const float gt = acc[mf][0][4 * g + e], up = acc[mf][1][4 * g + e]; r[e] = gt / (1.0f + __expf(-gt)) * up; }
        u32x2 v; v.x = pk(r[0], r[1]); v.y = pk(r[2], r[3]); *(u32x2*)(img + (mf * 32 + l31) * PITCH + (8 * g + 4 * h) * 2) = v; }
    const int ln = l31 + 32 * h;
#pragma unroll
    for (int i = 0; i < 4; ++i) { const int q = ln + 64 * i, r = q >> 2, c4 = q & 3;
      const u32x4 v = *(const u32x4*)(img + r * PITCH + c4 * 16); *(u32x4*)(out + (size_t)(mb + r) * DFF + hc + c4 * 8) = v; }
  } };

struct EpiIn { bf16_t* z; char* lds; const float* qg; const float* kg; const f32x2* tabA; const f32x2* tabB; const f32x2* tabC;
  DI void operator()(f32x16 (&acc)[2][2], int mb, int nb, int n0, int wc, int l31, int h) const {
    if (nb >= NIN) return;
    const bool isv = (nb >= A_V && nb < B_Q) || (nb >= B_V && nb < C_Q) || (nb >= C_V && nb < C_G);
    if (isv) {
      const int wv = (threadIdx.x >> 6);
      bf16_t* img = (bf16_t*)(lds + 32768 + wv * 9216);
#pragma unroll
      for (int mf = 0; mf < 2; ++mf)
#pragma unroll
        for (int nf = 0; nf < 2; ++nf)
#pragma unroll
          for (int i = 0; i < 16; ++i) { const int d = nf * 32 + (i & 3) + 8 * (i >> 2) + 4 * h; img[d * 72 + mf * 32 + l31] = f2bf(acc[mf][nf][i]); }
      __builtin_amdgcn_s_waitcnt(0xc07f);
      const int ln = l31 + 32 * h;
#pragma unroll
      for (int i = 0; i < 8; ++i) { const int q = ln + 64 * i, d = q >> 3, c8 = q & 7;
        const u32x4 v = *(const u32x4*)(img + d * 72 + c8 * 8); *(u32x4*)(z + (size_t)(mb + d) * NIN + nb + c8 * 8) = v; }
      return;
    }
#pragma unroll
    for (int mf = 0; mf < 2; ++mf) {
      const int row = mb + mf * 32 + l31; int t, T; row_info(row, t, T);
      if (nb < A_V) {
        const bool isq = nb < A_K; const float* gn = isq ? qg : kg;
        float ss = 0.f;
#pragma unroll
        for (int nf = 0; nf < 2; ++nf)
#pragma unroll
          for (int i = 0; i < 16; ++i) ss += acc[mf][nf][i] * acc[mf][nf][i];
        ss += __shfl_xor(ss, 32);
        const float rs = rsqrtf(ss * (1.0f / 64.0f) + EPS) * (isq ? 0.125f * LOG2E : 1.0f);
#pragma unroll
        for (int nf = 0; nf < 2; ++nf) {
          const int pos = nf == 0 ? (t >> 6) : (t & 63);
#pragma unroll
          for (int g = 0; g < 4; ++g)
#pragma unroll
            for (int e = 0; e < 4; ++e) acc[mf][nf][4 * g + e] *= rs * gn[nf * 32 + 8 * g + 4 * h + e];
#pragma unroll
          for (int g = 0; g < 2; ++g)
#pragma unroll
            for (int e = 0; e < 4; ++e) { const f32x2 cs = tabA[pos * 16 + 8 * g + 4 * h + e];
              const float x1 = acc[mf][nf][4 * g + e], x2 = acc[mf][nf][4 * (g + 2) + e];
              acc[mf][nf][4 * g + e] = x1 * cs.x - x2 * cs.y; acc[mf][nf][4 * (g + 2) + e] = x2 * cs.x + x1 * cs.y; }
        }
      } else if (nb >= B_Q && nb < B_V) {
        const bool isq = nb < B_K;
#pragma unroll
        for (int nf = 0; nf < 2; ++nf) {
#pragma unroll
          for (int e = 0; e < 4; ++e) { const f32x2 cs = tabB[t * 4 + e]; const float v = acc[mf][nf][e]; const float o = __shfl_xor(v, 32);
            acc[mf][nf][e] = (h == 0) ? (v * cs.x - o * cs.y) : (v * cs.x + o * cs.y); }
          if (isq) {
#pragma unroll
            for (int i = 0; i < 16; ++i) acc[mf][nf][i] *= 0.17677669529663687f * LOG2E; }
        }
      } else if (nb >= C_Q && nb < C_V) {
        const float sc = nb < C_K ? 1.0f : 0.125f;
#pragma unroll
        for (int g = 0; g < 4; ++g) {
#pragma unroll
          for (int e = 0; e < 4; ++e) { const f32x2 cs = tabC[t * 32 + 8 * g + 4 * h + e]; const float x1 = acc[mf][0][4 * g + e], x2 = acc[mf][1][4 * g + e];
            acc[mf][0][4 * g + e] = (x1 * cs.x - x2 * cs.y) * sc; acc[mf][1][4 * g + e] = (x2 * cs.x + x1 * cs.y) * sc; }
          if (g & 1) __builtin_amdgcn_sched_barrier(0); }
      }
      store_piece32(lds + (threadIdx.x >> 6) * 9216, acc[mf][0], acc[mf][1], z, (size_t)NIN, mb + mf * 32, nb, l31, h);
    }
  } };

#define LASP __attribute__((address_space(3)))
template <class Epi>
DI void gemm_tile(char* lds, const ASrc& A, const bf16_t* __restrict__ Bt, int K, int m0, int n0, const Epi& epi, bool first, bool has_next, int m0n, int n0n) {
  const int tid = opaque(threadIdx.x), lane = tid & 63, w = __builtin_amdgcn_readfirstlane(tid >> 6), wr = w >> 1, wc = w & 1, l31 = lane & 31, h = lane >> 5;
  const int nk = K >> 6, smask = (1 << A.shift) - 1;
  LASP char* ldsl = (LASP char*)lds;
  f32x16 acc[2][2];
#pragma unroll
  for (int a = 0; a < 2; ++a)
#pragma unroll
    for (int b = 0; b < 2; ++b)
#pragma unroll
      for (int i = 0; i < 16; ++i) acc[a][b][i] = 0.f;
  const int lrow = lane >> 3, lslot = lane & 7;
  int goffA[4], goffB[4];
#pragma unroll
  for (int i = 0; i < 4; ++i) { const int r = w * 32 + i * 8 + lrow, c = lslot ^ ((r >> 1) & 7); goffA[i] = r; goffB[i] = r * K + c * 8; goffA[i] = (goffA[i] << 3) | c; }
#define GEMM_ISSUE(kt, st, M0_, N0_) do { const int k0_ = (kt) << 6, seg_ = k0_ >> A.shift, kk_ = k0_ & smask; \
    const bf16_t* bp_ = seg_ == 0 ? A.b0 : seg_ == 1 ? A.b1 : seg_ == 2 ? A.b2 : A.b3; const int st_ = seg_ == 0 ? A.s0 : seg_ == 1 ? A.s1 : seg_ == 2 ? A.s2 : A.s3; \
    _Pragma("unroll") for (int i_ = 0; i_ < 4; ++i_) { \
      const bf16_t* ga_ = bp_ + (size_t)((M0_) + (goffA[i_] >> 3)) * st_ + kk_ + (goffA[i_] & 7) * 8; \
      __builtin_amdgcn_global_load_lds((const unsigned*)ga_, (LASP unsigned*)(ldsl + (st) * 32768 + (w * 4 + i_) * 1024), 16, 0, 0); \
      const bf16_t* gb_ = Bt + (size_t)(N0_) * K + goffB[i_] + k0_; \
      __builtin_amdgcn_global_load_lds((const unsigned*)gb_, (LASP unsigned*)(ldsl + (st) * 32768 + 16384 + (w * 4 + i_) * 1024), 16, 0, 0); } } while (0)
  const int xr = (l31 >> 1) & 7;
  int coff[4];
#pragma unroll
  for (int s = 0; s < 4; ++s) coff[s] = ((2 * s + h) ^ xr) * 16;
#define GEMM_COMPUTE(st) do { const char* as = lds + (st) * 32768; const char* bs = as + 16384; \
    bf16x8 af[4][2], wf[4][2]; \
    _Pragma("unroll") for (int s = 0; s < 4; ++s) { \
      _Pragma("unroll") for (int mf = 0; mf < 2; ++mf) af[s][mf] = *(const bf16x8*)(as + (wr * 64 + mf * 32 + l31) * 128 + coff[s]); \
      _Pragma("unroll") for (int nf = 0; nf < 2; ++nf) wf[s][nf] = *(const bf16x8*)(bs + (wc * 64 + nf * 32 + l31) * 128 + coff[s]); } \
    __builtin_amdgcn_sched_barrier(0); __builtin_amdgcn_s_setprio(1); \
    _Pragma("unroll") for (int s = 0; s < 4; ++s) \
      _Pragma("unroll") for (int mf = 0; mf < 2; ++mf) _Pragma("unroll") for (int nf = 0; nf < 2; ++nf) acc[mf][nf] = MFMA32(wf[s][nf], af[s][mf], acc[mf][nf]); \
    __builtin_amdgcn_s_setprio(0); __builtin_amdgcn_sched_barrier(0); } while (0)
  if (first) GEMM_ISSUE(0, 0, m0, n0);
  for (int kt = 0; kt < nk; kt += 2) {
    asm volatile("s_waitcnt vmcnt(0)" ::: "memory"); __syncthreads();
    GEMM_ISSUE(kt + 1, 1, m0, n0);
    GEMM_COMPUTE(0);
    asm volatile("s_waitcnt vmcnt(0)" ::: "memory"); __syncthreads();
    if (kt + 2 < nk) GEMM_ISSUE(kt + 2, 0, m0, n0);
    GEMM_COMPUTE(1);
  }
  __syncthreads();
  if (has_next) GEMM_ISSUE(0, 0, m0n, n0n);
  epi(acc, m0 + wr * 64, n0 + wc * 64, n0, wc, l31, h);
  __syncthreads();
#undef GEMM_ISSUE
#undef GEMM_COMPUTE
}

template <class Epi>
DI void gemm_phase(char* lds, const ASrc& A, const bf16_t* Bt, int K, int ntn, const Epi& epi) {
  const int xcd = blockIdx.x & 7, j = blockIdx.x >> 3, nloc = gridDim.x >> 3, per = 48 * ntn, grp = 8 * ntn;
  bool first = true;
  for (int li = j; li < per; li += nloc) {
    const int sg = li / grp, wi = li - sg * grp, nt = wi >> 3, mt = xcd * 48 + sg * 8 + (wi & 7);
    const int ln = li + nloc; const bool has_next = ln < per;
    const int sgn = ln / grp, win = ln - sgn * grp, ntn2 = win >> 3, mtn = xcd * 48 + sgn * 8 + (win & 7);
    gemm_tile(lds, A, Bt, K, mt * 128, nt * 128, epi, first, has_next, mtn * 128, ntn2 * 128);
    first = false;
  }
}

DI void prep_item(char* lds, const Params& p, int layer, int item) {
  const int tid = opaque(threadIdx.x), lane = tid & 63, w = tid >> 6;
  const int rowb = item * 64; int tb, T; row_info(rowb, tb, T);
  const float* qg = p.in[I_AQG] + layer * 64; const float* kg = p.in[I_AKG] + layer * 64;
  const float qgl = qg[lane], kgl = kg[lane];
  for (int tt = 0; tt < 16; ++tt) {
    const int row = rowb + w * 16 + tt, t = tb + w * 16 + tt;
    bf16_t* zr = p.z + (size_t)row * NIN;
    {
      const int j = lane & 31, i = j & 15; const bool first = j < 16; const int pos = (lane < 32) ? (t >> 6) : (t & 63);
      const f32x2 cs = p.tabA[pos * 16 + i];
#pragma unroll
      for (int hd = 0; hd < 6; ++hd) {
        bf16_t* ptr = zr + (hd < 4 ? A_Q + hd * 64 : A_K + (hd - 4) * 64) + lane;
        float v = bf2f(*ptr);
        const float ss = wave_sum(v * v);
        v = v * rsqrtf(ss * (1.0f / 64.0f) + EPS) * (hd < 4 ? qgl : kgl);
        const float o = __shfl_xor(v, 16);
        float r = first ? (v * cs.x - o * cs.y) : (v * cs.x + o * cs.y);
        if (hd < 4) r *= 0.125f * LOG2E;
        *ptr = f2bf(r);
      }
    }
    {
      const int d = lane & 31; const f32x2 cs = p.tabB[t * 4 + (d & 3)];
#pragma unroll
      for (int c = 0; c < 8; ++c) {
        bf16_t* ptr = zr + (c < 4 ? B_Q + c * 64 : B_K + (c - 4) * 64) + lane;
        float v = bf2f(*ptr);
        const float o = __shfl_xor(v, 4);
        float r = v;
        if (d < 8) r = (d < 4) ? (v * cs.x - o * cs.y) : (v * cs.x + o * cs.y);
        if (c < 4) r *= 0.17677669529663687f * LOG2E;
        *ptr = f2bf(r);
      }
    }
    {
      const f32x2 cs = p.tabC[t * 32 + (lane & 31)];
#pragma unroll
      for (int c = 0; c < 8; ++c) {
        bf16_t* ptr = zr + (c < 4 ? C_Q + c * 64 : C_K + (c - 4) * 64) + lane;
        const float v = bf2f(*ptr);
        const float o = __shfl_xor(v, 32);
        float r = (lane < 32) ? (v * cs.x - o * cs.y) : (v * cs.x + o * cs.y);
        if (c >= 4) r *= 0.125f;
        *ptr = f2bf(r);
      }
    }
  }
  bf16_t* tl = (bf16_t*)lds;
  const int r = tid >> 2, c0 = (tid & 3) * 16;
  for (int sl = 0; sl < 10; ++sl) {
    const int col = sl < 2 ? A_V + sl * 64 : sl < 6 ? B_V + (sl - 2) * 64 : C_V + (sl - 6) * 64;
    bf16_t* gp = p.z + (size_t)(rowb + r) * NIN + col + c0;
    const u32x4 v0 = *(const u32x4*)gp, v1 = *(const u32x4*)(gp + 8);
    __syncthreads();
#pragma unroll
    for (int e = 0; e < 4; ++e) {
      tl[(c0 + 2 * e) * 72 + r] = (bf16_t)(v0[e] & 0xffffu); tl[(c0 + 2 * e + 1) * 72 + r] = (bf16_t)(v0[e] >> 16);
      tl[(c0 + 8 + 2 * e) * 72 + r] = (bf16_t)(v1[e] & 0xffffu); tl[(c0 + 8 + 2 * e + 1) * 72 + r] = (bf16_t)(v1[e] >> 16);
    }
    __syncthreads();
    const u32x4 o0 = *(const u32x4*)(tl + r * 72 + c0), o1 = *(const u32x4*)(tl + r * 72 + c0 + 8);
    *(u32x4*)gp = o0; *(u32x4*)(gp + 8) = o1;
  }
  __syncthreads();
}

DI float dshift(const Params& p, const float* mup, const float* mun, int row, int t, int T, int dc) {
  const bf16_t* zp = p.z + (size_t)row * NIN + D_0 + dc;
  const float z = bf2f(*zp);
  const float zprev = (t > 0) ? bf2f(*(zp - NIN)) : 0.f;
  const float znext = (t < T - 1) ? bf2f(*(zp + NIN)) : 0.f;
  return z + mup[dc] * (zprev - z) + mun[dc] * (znext - z);
}
DI float sigmoidf_(float x) { return 1.0f / (1.0f + __expf(-x)); }
DI float omdecay(float ww) {
  const float e = 0.6065306597126334f / (1.0f + __expf(-ww));
  return 1.0f - __expf(-e);
}
DI float fast_tanh(float x) { const float xc = fminf(fmaxf(x, -15.f), 15.f); return 1.0f - 2.0f / (1.0f + __expf(2.0f * xc)); }
constexpr int DTOK = 16;
DI void dprep_item(char* lds, const Params& p, int layer, int item) {
  const int tid = opaque(threadIdx.x);
  const int rowb = item * DTOK; int tb, T; row_info(rowb, tb, T);
  const float* mup = p.in[I_DMUP] + layer * 1088; const float* mun = p.in[I_DMUN] + layer * 1088;
  float* su = (float*)lds;
  bf16_t* stg = (bf16_t*)(lds + 12288);
#pragma unroll
  for (int i = 0; i < 12; ++i) {
    const int idx = tid + 256 * i, tok = idx / 192, c = idx - tok * 192;
    float u = dshift(p, mup, mun, rowb + tok, tb + tok, T, 768 + c);
    if (c < 128) u = fast_tanh(u);
    su[c * DTOK + tok] = u;
  }
  __syncthreads();
  const int c = tid;
  const float w0f = p.in[I_DW0][(layer * 2 + 0) * 256 + c], w0b = p.in[I_DW0][(layer * 2 + 1) * 256 + c];
  const float a0 = p.in[I_DA0][layer * 256 + c], kkw = p.in[I_DKK][layer * 256 + c], kaw = p.in[I_DKA][layer * 256 + c];
  float zr[DTOK + 2], zk[DTOK + 2], zv[DTOK + 2];
  { const bf16_t* zp = p.z + (size_t)rowb * NIN + D_0 + c;
#pragma unroll
    for (int i = 0; i < DTOK + 2; ++i) { const int t = tb - 1 + i; const bool ok = (t >= 0) && (t < T); const bf16_t* q = zp + (ptrdiff_t)(i - 1) * NIN;
      zr[i] = ok ? bf2f(q[0]) : 0.f; zk[i] = ok ? bf2f(q[256]) : 0.f; zv[i] = ok ? bf2f(q[512]) : 0.f; } }
  const float mpr = mup[c], mnr = mun[c], mpk = mup[256 + c], mnk = mun[256 + c], mpv = mup[512 + c], mnv = mun[512 + c];
  float accf[DTOK], accb[DTOK], acca[DTOK];
#pragma unroll
  for (int k = 0; k < DTOK; ++k) { accf[k] = 0.f; accb[k] = 0.f; acca[k] = 0.f; }
  const float* wupf = p.in[I_DWUP] + (size_t)(layer * 2 + 0) * 64 * 256 + c;
  const float* wupb = p.in[I_DWUP] + (size_t)(layer * 2 + 1) * 64 * 256 + c;
  const float* aup = p.in[I_DAUP] + (size_t)layer * 64 * 256 + c;
#pragma unroll 2
  for (int j = 0; j < 64; ++j) {
    const float wf = wupf[j * 256], wb = wupb[j * 256], wa = aup[j * 256];
#pragma unroll
    for (int q = 0; q < 4; ++q) {
      const f32x4 f0 = *(const f32x4*)(su + j * DTOK + 4 * q), b0 = *(const f32x4*)(su + (64 + j) * DTOK + 4 * q), a0v = *(const f32x4*)(su + (128 + j) * DTOK + 4 * q);
#pragma unroll
      for (int k = 0; k < 4; ++k) { accf[4 * q + k] += f0[k] * wf; accb[4 * q + k] += b0[k] * wb; acca[4 * q + k] += a0v[k] * wa; }
    }
  }
#pragma unroll
  for (int k = 0; k < DTOK; ++k) {
    const float r = zr[k + 1] + mpr * (zr[k] - zr[k + 1]) + mnr * (zr[k + 2] - zr[k + 1]);
    const float kx = zk[k + 1] + mpk * (zk[k] - zk[k + 1]) + mnk * (zk[k + 2] - zk[k + 1]);
    const float v = zv[k + 1] + mpv * (zv[k] - zv[k + 1]) + mnv * (zv[k + 2] - zv[k + 1]);
    const float omf = omdecay(w0f + accf[k]), omb = omdecay(w0b + accb[k]);
    const float a = sigmoidf_(a0 + acca[k]);
    float kk = kx * kkw; const float n2 = wave_sum(kk * kk);
    kk = kk * rsqrtf(fmaxf(n2, 1e-24f));
    const float kmod = kx * (1.0f + (a - 1.0f) * kaw), b = kk * a;
    bf16_t* so = stg + k * 256 + c;
    so[0] = f2bf(r); so[DTOK * 256] = f2bf(kmod); so[2 * DTOK * 256] = f2bf(v); so[3 * DTOK * 256] = f2bf(-kk);
    so[4 * DTOK * 256] = f2bf(b); so[5 * DTOK * 256] = f2bf(omf); so[6 * DTOK * 256] = f2bf(omb);
  }
  __syncthreads();
#pragma unroll
  for (int i = 0; i < 14; ++i) {
    const int q = tid + 256 * i, pln = q >> 9, rem = q & 511, tok = rem >> 5, c16 = rem & 31;
    const u32x4 v = *(const u32x4*)(stg + pln * (DTOK * 256) + tok * 256 + c16 * 8);
    *(u32x4*)(p.pl + (size_t)pln * PLANE + (size_t)(rowb + tok) * 256 + c16 * 8) = v;
  }
  __syncthreads();
}

DI void dpost_item(char* lds, const Params& p, int layer, int item) {
  const int tid = opaque(threadIdx.x);
  const int rowb = item * DTOK; int tb, T; row_info(rowb, tb, T);
  const float* mup = p.in[I_DMUP] + layer * 1088; const float* mun = p.in[I_DMUN] + layer * 1088;
  float* sg = (float*)lds;
  bf16_t* stg = (bf16_t*)(lds + 8192);
#pragma unroll
  for (int i = 0; i < 8; ++i) { const int idx = tid + 256 * i, tok = idx >> 7, c = idx & 127; sg[c * DTOK + tok] = sigmoidf_(dshift(p, mup, mun, rowb + tok, tb + tok, T, 960 + c)); }
  __syncthreads();
  const int c = tid;
  float acc[DTOK];
#pragma unroll
  for (int k = 0; k < DTOK; ++k) acc[k] = 0.f;
  float yv[DTOK], rv_[DTOK], kmv[DTOK], vv_[DTOK];
#pragma unroll
  for (int k = 0; k < DTOK; ++k) { const int row = rowb + k; const bf16_t* zd = p.z + (size_t)row * NIN + D_0; const size_t o = (size_t)row * 256 + c;
    yv[k] = bf2f(zd[c]) + bf2f(zd[256 + c]); rv_[k] = bf2f(p.pl[o]); kmv[k] = bf2f(p.pl[PLANE + o]); vv_[k] = bf2f(p.pl[2 * PLANE + o]); }
  const float* gup = p.in[I_DGUP] + (size_t)layer * 128 * 256 + c;
#pragma unroll 4
  for (int j = 0; j < 128; ++j) { const float gw = gup[j * 256];
#pragma unroll
    for (int q = 0; q < 4; ++q) { const f32x4 s0 = *(const f32x4*)(sg + j * DTOK + 4 * q);
#pragma unroll
      for (int k = 0; k < 4; ++k) acc[4 * q + k] += s0[k] * gw; } }
  const float gnw = p.in[I_DGNW][layer * 256 + c], gnb = p.in[I_DGNB][layer * 256 + c], rk = p.in[I_DRK][layer * 256 + c];
#pragma unroll
  for (int k = 0; k < DTOK; ++k) {
    const float y = yv[k];
    const float mean = wave_sum(y) * (1.0f / 64.0f); const float d = y - mean; const float var = wave_sum(d * d) * (1.0f / 64.0f);
    const float yn = d * rsqrtf(var + 64e-5f) * gnw + gnb;
    const float r = rv_[k], km = kmv[k], v = vv_[k];
    const float bonus = wave_sum(r * km * rk);
    stg[k * 256 + c] = f2bf((yn + bonus * v) * acc[k]);
  }
  __syncthreads();
#pragma unroll
  for (int i = 0; i < 2; ++i) { const int q = tid + 256 * i, tok = q >> 5, c16 = q & 31;
    const u32x4 v = *(const u32x4*)(stg + tok * 256 + c16 * 8);
    *(u32x4*)(p.pl + 4 * PLANE + (size_t)(rowb + tok) * 256 + c16 * 8) = v; }
  __syncthreads();
}

DI void rwkv_item(char* lds, const Params& p, int seq, int head, int dir, int half) {
  int row0, T; seq_info(seq, row0, T);
  const int tid = opaque(threadIdx.x), kc = tid & 7, vrow = half * 32 + (tid >> 3);
  float* st = (float*)lds;
  f32x2 S[4];
#pragma unroll
  for (int j = 0; j < 4; ++j) S[j] = (f32x2){0.f, 0.f};
  const int nchunk = T >> 4;
  u32x4 rg[3];
  const int tsel = tid >> 7, srem = tid & 127, sstep = srem >> 3, sc8 = srem & 7;
#define RW_GLOAD(c) do { _Pragma("unroll") for (int i_ = 0; i_ < 3; ++i_) { const int tens_ = tsel + 2 * i_; \
      const int plane_ = tens_ == 0 ? (dir ? 6 : 5) : tens_ == 1 ? 3 : tens_ == 2 ? 4 : tens_ == 3 ? 1 : tens_ == 4 ? 0 : 2; \
      const int t_ = dir ? (T - 1 - ((c) * 16 + sstep)) : ((c) * 16 + sstep); \
      rg[i_] = *(const u32x4*)(p.pl + (size_t)plane_ * PLANE + (size_t)(row0 + t_) * 256 + head * 64 + sc8 * 8); } } while (0)
#define RW_LSTORE(buf) do { _Pragma("unroll") for (int i_ = 0; i_ < 3; ++i_) { const int tens_ = tsel + 2 * i_; \
      f32x4 a_ = {bflo(rg[i_].x), bfhi(rg[i_].x), bflo(rg[i_].y), bfhi(rg[i_].y)}, b_ = {bflo(rg[i_].z), bfhi(rg[i_].z), bflo(rg[i_].w), bfhi(rg[i_].w)}; \
      if (tens_ == 0) { a_ = 1.0f - a_; b_ = 1.0f - b_; } \
      float* d_ = st + (((buf) * 16 + sstep) * 6 + tens_) * 64 + sc8 * 8; *(f32x4*)d_ = a_; *(f32x4*)(d_ + 4) = b_; } } while (0)
  __builtin_amdgcn_s_setprio(3);
  RW_GLOAD(0); RW_LSTORE(0); __syncthreads();
  bf16_t* ybase = p.z + (size_t)row0 * NIN + D_0 + dir * 256 + head * 64 + vrow;
  for (int c = 0; c < nchunk; ++c) {
    if (c + 1 < nchunk) RW_GLOAD(c + 1);
    const float* sb = st + (c & 1) * (16 * 384);
#define RW_FETCH(S_, s_) do { const float* q_ = sb + (s_) * 384 + kc * 8; \
      S_##w0 = *(const f32x4*)(q_); S_##w1 = *(const f32x4*)(q_ + 4); S_##n0 = *(const f32x4*)(q_ + 64); S_##n1 = *(const f32x4*)(q_ + 68); \
      S_##b0 = *(const f32x4*)(q_ + 128); S_##b1 = *(const f32x4*)(q_ + 132); S_##k0 = *(const f32x4*)(q_ + 192); S_##k1 = *(const f32x4*)(q_ + 196); \
      S_##r0 = *(const f32x4*)(q_ + 256); S_##r1 = *(const f32x4*)(q_ + 260); S_##vv = sb[(s_) * 384 + 320 + vrow]; } while (0)
#define LO2(x) ((f32x2){(x)[0], (x)[1]})
#define HI2(x) ((f32x2){(x)[2], (x)[3]})
#define RW_STEP(S_, s_) do { \
      f32x2 a2 = S[0] * LO2(S_##n0); a2 += S[1] * HI2(S_##n0); a2 += S[2] * LO2(S_##n1); a2 += S[3] * HI2(S_##n1); \
      const float sa = red8(a2.x + a2.y); const float vx = S_##vv; \
      S[0] = S[0] * LO2(S_##w0) + (LO2(S_##b0) * sa + LO2(S_##k0) * vx); S[1] = S[1] * HI2(S_##w0) + (HI2(S_##b0) * sa + HI2(S_##k0) * vx); \
      S[2] = S[2] * LO2(S_##w1) + (LO2(S_##b1) * sa + LO2(S_##k1) * vx); S[3] = S[3] * HI2(S_##w1) + (HI2(S_##b1) * sa + HI2(S_##k1) * vx); \
      f32x2 y2 = S[0] * LO2(S_##r0); y2 += S[1] * HI2(S_##r0); y2 += S[2] * LO2(S_##r1); y2 += S[3] * HI2(S_##r1); \
      const float y = red8(y2.x + y2.y); const float yn = DPPF(y, 0x128);     \
      if ((tid & 15) == 0) { const int t_ = dir ? (T - 1 - (c * 16 + (s_))) : (c * 16 + (s_)); *(unsigned*)(ybase + (size_t)t_ * NIN) = pk(y, yn); } } while (0)
    f32x4 Aw0, Aw1, An0, An1, Ab0, Ab1, Ak0, Ak1, Ar0, Ar1; float Avv;
    f32x4 Bw0, Bw1, Bn0, Bn1, Bb0, Bb1, Bk0, Bk1, Br0, Br1; float Bvv;
    RW_FETCH(A, 0);
#pragma unroll 2
    for (int s = 0; s < 16; s += 2) {
      RW_FETCH(B, s + 1);
      RW_STEP(A, s);
      if (s + 2 < 16) RW_FETCH(A, s + 2);
      RW_STEP(B, s + 1);
    }
#undef RW_FETCH
#undef RW_STEP
    if (c + 1 < nchunk) RW_LSTORE((c + 1) & 1);
    __syncthreads();
  }
#undef RW_GLOAD
#undef RW_LSTORE
  __builtin_amdgcn_s_setprio(0);
}

template <int MODE>
DI void attn_item(char* lds, const Params& p, int layer, int seq, int head, int qt) {
  const int tid = opaque(threadIdx.x), lane = tid & 63, w = tid >> 6, l31 = lane & 31, h = lane >> 5;
  layer = opaque_s(layer); seq = opaque_s(seq); head = opaque_s(head); qt = opaque_s(qt);
  int row0, T; seq_info(seq, row0, T);
  const int QC = (MODE == 0 ? A_Q : MODE == 1 ? B_Q : C_Q) + head * 64;
  const int KC = MODE == 0 ? A_K + (head >> 1) * 64 : MODE == 1 ? B_K + head * 64 : C_K + head * 64;
  const int VC = MODE == 0 ? A_V + (head >> 1) * 64 : MODE == 1 ? B_V + head * 64 : C_V + head * 64;
  const int qw0 = qt * 128 + w * 32, qi = qw0 + l31;
  bf16_t* zq = p.z + (size_t)(row0 + qi) * NIN + QC;
  bf16x8 qf[4];
#pragma unroll
  for (int s = 0; s < 4; ++s) qf[s] = *(const bf16x8*)(zq + s * 16 + h * 8);
  const int srow = tid >> 3, sc8 = tid & 7;
  const bf16_t* kbase = p.z + (size_t)(row0 + srow) * NIN + KC + sc8 * 8;
  const bf16_t* vbase = p.z + (size_t)(row0 + srow) * NIN + VC + sc8 * 8;
  u32x4 rk[2][2], rv[2][2];
  const int nt = T >> 6;
  const int prow = (l31 & 19) | ((l31 & 4) << 1) | ((l31 & 8) >> 1);
#define AT_GLOAD(t, S) do { _Pragma("unroll") for (int i_ = 0; i_ < 2; ++i_) { const size_t off_ = (size_t)((t) * 64 + 32 * i_) * NIN; rk[S][i_] = *(const u32x4*)(kbase + off_); rv[S][i_] = *(const u32x4*)(vbase + off_); } } while (0)
#define AT_LSTORE(buf, S) do { char* ks_ = lds + (buf) * 18432; char* vs_ = ks_ + 9216; \
    _Pragma("unroll") for (int i_ = 0; i_ < 2; ++i_) { *(u32x4*)(ks_ + (srow + 32 * i_) * PITCH + sc8 * 16) = rk[S][i_]; *(u32x4*)(vs_ + (srow + 32 * i_) * PITCH + sc8 * 16) = rv[S][i_]; } } while (0)
  constexpr int NMAP = (MODE == 1) ? 2 : 1;
  f32x16 o[NMAP][2];
  float m_run[NMAP], l_run[NMAP];
#pragma unroll
  for (int a = 0; a < NMAP; ++a) { m_run[a] = -INFINITY; l_run[a] = 0.f;
#pragma unroll
    for (int b = 0; b < 2; ++b)
#pragma unroll
      for (int i = 0; i < 16; ++i) o[a][b][i] = 0.f; }
  float lf = 0.f, lb = 0.f;
  if (MODE == 2) { lf = log2f(1.0f - exp2f(-5.0f - (float)head)); lb = log2f(1.0f - exp2f(-5.0f - (float)(3 - head))); }
  auto body = [&](const char* ks, const char* vs, const int t) __attribute__((always_inline)) {
#pragma unroll
    for (int mp = 0; mp < NMAP; ++mp) {
      f32x16 st[2];
#pragma unroll
      for (int kf = 0; kf < 2; ++kf) {
#pragma unroll
        for (int i = 0; i < 16; ++i) st[kf][i] = 0.f;
        if (MODE == 1) {
#pragma unroll
          for (int s = 0; s < 2; ++s) { const bf16x8 kfr = *(const bf16x8*)(ks + (kf * 32 + prow) * PITCH + (mp * 2 + s) * 32 + h * 16); st[kf] = MFMA32(kfr, qf[mp * 2 + s], st[kf]); }
        } else {
#pragma unroll
          for (int s = 0; s < 4; ++s) { const bf16x8 kfr = *(const bf16x8*)(ks + (kf * 32 + prow) * PITCH + s * 32 + h * 16); st[kf] = MFMA32(kfr, qf[s], st[kf]); }
        }
      }
      if (MODE == 2) {
        const int k0 = t * 64;
        const float dbase = (float)(qi - k0 - 8 * h);
        if (k0 + 63 < qw0) {
#pragma unroll
          for (int kf = 0; kf < 2; ++kf)
#pragma unroll
            for (int i = 0; i < 16; ++i) { const float cc = (float)(32 * kf + (i & 3) + 4 * ((i >> 2) & 1) + 16 * ((i >> 3) & 1)); st[kf][i] *= fexp2(lf * (dbase - cc)); }
        } else if (k0 > qw0 + 31) {
#pragma unroll
          for (int kf = 0; kf < 2; ++kf)
#pragma unroll
            for (int i = 0; i < 16; ++i) { const float cc = (float)(32 * kf + (i & 3) + 4 * ((i >> 2) & 1) + 16 * ((i >> 3) & 1)); st[kf][i] *= fexp2(lb * (cc - dbase)); }
        } else {
#pragma unroll
          for (int kf = 0; kf < 2; ++kf)
#pragma unroll
            for (int i = 0; i < 16; ++i) { const float cc = (float)(32 * kf + (i & 3) + 4 * ((i >> 2) & 1) + 16 * ((i >> 3) & 1)); const float d = dbase - cc;
              float dd = fexp2(fminf(lf * d, -lb * d)); if (d == 0.f) dd = 2.0f; st[kf][i] *= dd; }
        }
      } else {
        float mx = st[0][0];
#pragma unroll
        for (int kf = 0; kf < 2; ++kf)
#pragma unroll
          for (int i = 0; i < 16; ++i) mx = fmaxf(mx, st[kf][i]);
        mx = fmaxf(mx, __shfl_xor(mx, 32));
        const float mn = fmaxf(m_run[mp], mx); const float alpha = fexp2(m_run[mp] - mn); m_run[mp] = mn;
        float ps = 0.f;
#pragma unroll
        for (int kf = 0; kf < 2; ++kf)
#pragma unroll
          for (int i = 0; i < 16; ++i) { st[kf][i] = fexp2(st[kf][i] - mn); ps += st[kf][i]; }
        l_run[mp] = l_run[mp] * alpha + ps;
#pragma unroll
        for (int df = 0; df < 2; ++df) o[mp][df] *= alpha;
      }
      bf16x8 pf[4];
#pragma unroll
      for (int kf = 0; kf < 2; ++kf)
#pragma unroll
        for (int s2 = 0; s2 < 2; ++s2) { u32x4 u; u.x = pk(st[kf][8 * s2], st[kf][8 * s2 + 1]); u.y = pk(st[kf][8 * s2 + 2], st[kf][8 * s2 + 3]);
          u.z = pk(st[kf][8 * s2 + 4], st[kf][8 * s2 + 5]); u.w = pk(st[kf][8 * s2 + 6], st[kf][8 * s2 + 7]); pf[kf * 2 + s2] = __builtin_bit_cast(bf16x8, u); }
#pragma unroll
      for (int df = 0; df < 2; ++df)
#pragma unroll
        for (int ksx = 0; ksx < 4; ++ksx) { const bf16x8 vfr = *(const bf16x8*)(vs + (df * 32 + l31) * PITCH + ksx * 32 + h * 16); o[mp][df] = MFMA32(vfr, pf[ksx], o[mp][df]); }
    }
  };
  if constexpr (MODE == 1) {
    AT_GLOAD(0, 0); AT_LSTORE(0, 0); __syncthreads();
#pragma unroll 1
    for (int t = 0; t < nt; ++t) {
      if (t + 1 < nt) AT_GLOAD(t + 1, 0);
      const char* ks = lds + (t & 1) * 18432;
      body(ks, ks + 9216, t);
      if (t + 1 < nt) AT_LSTORE((t + 1) & 1, 0);
      __syncthreads();
    }
  } else {
    AT_GLOAD(0, 0); AT_GLOAD(1, 1); AT_LSTORE(0, 0); __syncthreads();
#pragma unroll 1
    for (int t2 = 0; t2 < nt; t2 += 2) {
      if (t2 + 2 < nt) AT_GLOAD(t2 + 2, 0);
      body(lds, lds + 9216, t2);
      AT_LSTORE(1, 1);
      __syncthreads();
      if (t2 + 3 < nt) AT_GLOAD(t2 + 3, 1);
      body(lds + 18432, lds + 18432 + 9216, t2 + 1);
      if (t2 + 2 < nt) AT_LSTORE(0, 0);
      __syncthreads();
    }
  }
#undef AT_GLOAD
#undef AT_LSTORE
  f32x16 r[2];
  if (MODE == 0) {
    const float l = l_run[0] + __shfl_xor(l_run[0], 32); const float inv = 1.0f / l;
#pragma unroll
    for (int df = 0; df < 2; ++df) r[df] = o[0][df] * inv;
  } else if (MODE == 1) {
    const float* lp = p.in[I_BLAM] + layer * 128;
    float s01 = 0.f, s23 = 0.f;
    for (int i = 0; i < 32; ++i) { s01 += lp[i] * lp[32 + i]; s23 += lp[64 + i] * lp[96 + i]; }
    const float lam_init = 0.8f - 0.6f * expf(-0.3f * (float)layer);
    const float lam = expf(s01) - expf(s23) + lam_init;
    const float l0 = l_run[0] + __shfl_xor(l_run[0], 32), l1 = l_run[NMAP - 1] + __shfl_xor(l_run[NMAP - 1], 32);
    const float i0 = 1.0f / l0, i1 = lam / l1;
    float ss = 0.f;
#pragma unroll
    for (int df = 0; df < 2; ++df) { r[df] = o[0][df] * i0 - o[NMAP - 1][df] * i1;
#pragma unroll
      for (int i = 0; i < 16; ++i) ss += r[df][i] * r[df][i]; }
    ss += __shfl_xor(ss, 32);
    const float rs = rsqrtf(ss * (1.0f / 64.0f) + EPS) * (1.0f - lam_init);
    const float* sg = p.in[I_BSUB] + layer * 64;
#pragma unroll
    for (int df = 0; df < 2; ++df)
#pragma unroll
      for (int i = 0; i < 16; ++i) r[df][i] *= rs * sg[df * 32 + (i & 3) + 8 * (i >> 2) + 4 * h];
  } else {
    float ss = 0.f;
#pragma unroll
    for (int df = 0; df < 2; ++df)
#pragma unroll
      for (int i = 0; i < 16; ++i) ss += o[0][df][i] * o[0][df][i];
    ss += __shfl_xor(ss, 32);
    const float rs = rsqrtf(ss * (1.0f / 64.0f) + EPS);
    const float* gg = p.in[I_CGN] + layer * 256 + head * 64;
    const bf16_t* zg = p.z + (size_t)(row0 + qi) * NIN + C_G + head * 64;
#pragma unroll
    for (int df = 0; df < 2; ++df)
#pragma unroll
      for (int g = 0; g < 4; ++g) { const u32x2 gw = *(const u32x2*)(zg + df * 32 + 8 * g + 4 * h);
        const float gv[4] = {bflo(gw.x), bfhi(gw.x), bflo(gw.y), bfhi(gw.y)};
#pragma unroll
        for (int e = 0; e < 4; ++e) { const float x = gv[e]; r[df][4 * g + e] = o[0][df][4 * g + e] * rs * gg[df * 32 + 8 * g + 4 * h + e] * (x / (1.0f + __expf(-x))); } }
  }
#pragma unroll
  for (int df = 0; df < 2; ++df)
#pragma unroll
    for (int g = 0; g < 4; ++g) { u32x2 v; v.x = pk(r[df][4 * g], r[df][4 * g + 1]); v.y = pk(r[df][4 * g + 2], r[df][4 * g + 3]); *(u32x2*)(zq + df * 32 + 8 * g + 4 * h) = v; }
}

template <class Epi>
DI void gemm_tile2(char* lds, const ASrc& A, const bf16_t* __restrict__ Bt, int K, int m0, int n0, const Epi& epi) {
  const int tid = opaque(threadIdx.x), lane = tid & 63, w = __builtin_amdgcn_readfirstlane(tid >> 6), wr = w >> 1, wc = w & 1, l31 = lane & 31, h = lane >> 5;
  const int nk = K >> 5, smask = (1 << A.shift) - 1;
  LASP char* ldsl = (LASP char*)lds;
  f32x16 acc[2][4];
#pragma unroll
  for (int a = 0; a < 2; ++a)
#pragma unroll
    for (int b = 0; b < 4; ++b)
#pragma unroll
      for (int i = 0; i < 16; ++i) acc[a][b][i] = 0.f;
  const int lrow = lane >> 2, lslot = lane & 3;
  int goffA[2], goffB[4];
#pragma unroll
  for (int i = 0; i < 2; ++i) { const int r = (2 * w + i) * 16 + lrow, c = lslot ^ ((r >> 2) & 3); goffA[i] = (r << 2) | c; }
#pragma unroll
  for (int i = 0; i < 4; ++i) { const int r = (4 * w + i) * 16 + lrow, c = lslot ^ ((r >> 2) & 3); goffB[i] = r * K + c * 8; }
#define G2_ISSUE(kt, st) do { const int k0_ = (kt) << 5, seg_ = k0_ >> A.shift, kk_ = k0_ & smask; \
    const bf16_t* bp_ = seg_ == 0 ? A.b0 : seg_ == 1 ? A.b1 : seg_ == 2 ? A.b2 : A.b3; const int st_ = seg_ == 0 ? A.s0 : seg_ == 1 ? A.s1 : seg_ == 2 ? A.s2 : A.s3; \
    _Pragma("unroll") for (int i_ = 0; i_ < 2; ++i_) { \
      const bf16_t* ga_ = bp_ + (size_t)(m0 + (goffA[i_] >> 2)) * st_ + kk_ + (goffA[i_] & 3) * 8; \
      __builtin_amdgcn_global_load_lds((const unsigned*)ga_, (LASP unsigned*)(ldsl + (st) * 24576 + (2 * w + i_) * 1024), 16, 0, 0); } \
    _Pragma("unroll") for (int i_ = 0; i_ < 4; ++i_) { \
      const bf16_t* gb_ = Bt + (size_t)n0 * K + goffB[i_] + k0_; \
      __builtin_amdgcn_global_load_lds((const unsigned*)gb_, (LASP unsigned*)(ldsl + (st) * 24576 + 8192 + (4 * w + i_) * 1024), 16, 0, 0); } } while (0)
  const int xr = (l31 >> 2) & 3;
  int coff[2];
#pragma unroll
  for (int s = 0; s < 2; ++s) coff[s] = ((2 * s + h) ^ xr) * 16;
#define G2_COMPUTE(st) do { const char* as = lds + (st) * 24576; const char* bs = as + 8192; \
    bf16x8 af[2][2], wf[2][4]; \
    _Pragma("unroll") for (int s = 0; s < 2; ++s) { \
      _Pragma("unroll") for (int mf = 0; mf < 2; ++mf) af[s][mf] = *(const bf16x8*)(as + (wr * 64 + mf * 32 + l31) * 64 + coff[s]); \
      _Pragma("unroll") for (int nf = 0; nf < 4; ++nf) wf[s][nf] = *(const bf16x8*)(bs + (wc * 128 + nf * 32 + l31) * 64 + coff[s]); } \
    __builtin_amdgcn_sched_barrier(0); __builtin_amdgcn_s_setprio(1); \
    _Pragma("unroll") for (int s = 0; s < 2; ++s) \
      _Pragma("unroll") for (int mf = 0; mf < 2; ++mf) _Pragma("unroll") for (int nf = 0; nf < 4; ++nf) acc[mf][nf] = MFMA32(wf[s][nf], af[s][mf], acc[mf][nf]); \
    __builtin_amdgcn_s_setprio(0); __builtin_amdgcn_sched_barrier(0); } while (0)
  G2_ISSUE(0, 0);
  for (int kt = 0; kt < nk; kt += 2) {
    asm volatile("s_waitcnt vmcnt(0)" ::: "memory"); __syncthreads();
    G2_ISSUE(kt + 1, 1);
    G2_COMPUTE(0);
    asm volatile("s_waitcnt vmcnt(0)" ::: "memory"); __syncthreads();
    if (kt + 2 < nk) G2_ISSUE(kt + 2, 0);
    G2_COMPUTE(1);
  }
  __syncthreads();
#pragma unroll
  for (int hf = 0; hf < 2; ++hf) {
    f32x16 t[2][2];
#pragma unroll
    for (int mf = 0; mf < 2; ++mf) { t[mf][0] = acc[mf][2 * hf]; t[mf][1] = acc[mf][2 * hf + 1]; }
    epi(t, m0 + wr * 64, n0 + wc * 128 + hf * 64, n0, wc, l31, h);
  }
  __syncthreads();
#undef G2_ISSUE
#undef G2_COMPUTE
}

template <class Epi>
DI void gemm_phase2(char* lds, const ASrc& A, const bf16_t* Bt, int K, int ntn, const Epi& epi) {
  const int xcd = blockIdx.x & 7, j = blockIdx.x >> 3, nloc = gridDim.x >> 3, per = 48 * ntn, grp = 8 * ntn;
  for (int li = j; li < per; li += nloc) {
    const int sg = li / grp, wi = li - sg * grp, nt = wi >> 3, mt = xcd * 48 + sg * 8 + (wi & 7);
    gemm_tile2(lds, A, Bt, K, mt * 128, nt * 256, epi);
  }
}

template <int MODE>
DI void attn3_item(char* lds, const Params& p, int layer, int seq, int head, int qt) {
  const int tid = opaque(threadIdx.x), lane = tid & 63, w = tid >> 6, l31 = lane & 31, h = lane >> 5;
  layer = opaque_s(layer); seq = opaque_s(seq); head = opaque_s(head); qt = opaque_s(qt);
  int row0, T; seq_info(seq, row0, T);
  const int QC = (MODE == 0 ? A_Q : C_Q) + head * 64;
  const int KC = MODE == 0 ? A_K + (head >> 1) * 64 : C_K + head * 64;
  const int VC = MODE == 0 ? A_V + (head >> 1) * 64 : C_V + head * 64;
  const int qw0 = qt * 256 + w * 64;
  bf16x8 qf[2][4];
#pragma unroll
  for (int qi = 0; qi < 2; ++qi)
#pragma unroll
    for (int s = 0; s < 4; ++s) qf[qi][s] = *(const bf16x8*)(p.z + (size_t)(row0 + qw0 + qi * 32 + l31) * NIN + QC + s * 16 + h * 8);
  const int srow = tid >> 3, sc8 = tid & 7;
  const bf16_t* kbase = p.z + (size_t)(row0 + srow) * NIN + KC + sc8 * 8;
  const bf16_t* vbase = p.z + (size_t)(row0 + srow) * NIN + VC + sc8 * 8;
  u32x4 rk[2], rv[2];
  const int nt = T >> 6;
  const int prow = (l31 & 19) | ((l31 & 4) << 1) | ((l31 & 8) >> 1);
#define A3_GLOAD(t) do { _Pragma("unroll") for (int i_ = 0; i_ < 2; ++i_) { const size_t off_ = (size_t)((t) * 64 + 32 * i_) * NIN; rk[i_] = *(const u32x4*)(kbase + off_); rv[i_] = *(const u32x4*)(vbase + off_); } } while (0)
#define A3_LSTORE(buf) do { char* ks_ = lds + (buf) * 18432; char* vs_ = ks_ + 9216; \
    _Pragma("unroll") for (int i_ = 0; i_ < 2; ++i_) { *(u32x4*)(ks_ + (srow + 32 * i_) * PITCH + sc8 * 16) = rk[i_]; *(u32x4*)(vs_ + (srow + 32 * i_) * PITCH + sc8 * 16) = rv[i_]; } } while (0)
  f32x16 o[2][2];
  float m_run[2], l_run[2];
#pragma unroll
  for (int a = 0; a < 2; ++a) { m_run[a] = -INFINITY; l_run[a] = 0.f;
#pragma unroll
    for (int b = 0; b < 2; ++b)
#pragma unroll
      for (int i = 0; i < 16; ++i) o[a][b][i] = 0.f; }
  float lf = 0.f, lb = 0.f;
  if (MODE == 2) { lf = log2f(1.0f - exp2f(-5.0f - (float)head)); lb = log2f(1.0f - exp2f(-5.0f - (float)(3 - head))); }
  A3_GLOAD(0); A3_LSTORE(0); __syncthreads();
#pragma unroll 1
  for (int t = 0; t < nt; ++t) {
    if (t + 1 < nt) A3_GLOAD(t + 1);
    const char* ks = lds + (t & 1) * 18432; const char* vs = ks + 9216;
    f32x16 st[2][2];
#pragma unroll
    for (int kf = 0; kf < 2; ++kf) {
#pragma unroll
      for (int qi = 0; qi < 2; ++qi)
#pragma unroll
        for (int i = 0; i < 16; ++i) st[qi][kf][i] = 0.f;
#pragma unroll
      for (int s = 0; s < 4; ++s) { const bf16x8 kfr = *(const bf16x8*)(ks + (kf * 32 + prow) * PITCH + s * 32 + h * 16);
#pragma unroll
        for (int qi = 0; qi < 2; ++qi) st[qi][kf] = MFMA32(kfr, qf[qi][s], st[qi][kf]); }
    }
    __builtin_amdgcn_sched_barrier(0);
#pragma unroll
    for (int qi = 0; qi < 2; ++qi) {
      bf16x8 pf[4];
      if (MODE == 2) {
        const int k0 = t * 64, qb = qw0 + qi * 32;
        const float dbase = (float)(qb + l31 - k0 - 8 * h);
        if (k0 + 63 < qb) {
#pragma unroll
          for (int kf = 0; kf < 2; ++kf)
#pragma unroll
            for (int i = 0; i < 16; ++i) { const float cc = (float)(32 * kf + (i & 3) + 4 * ((i >> 2) & 1) + 16 * ((i >> 3) & 1)); st[qi][kf][i] *= fexp2(lf * (dbase - cc)); }
        } else if (k0 > qb + 31) {
#pragma unroll
          for (int kf = 0; kf < 2; ++kf)
#pragma unroll
            for (int i = 0; i < 16; ++i) { const float cc = (float)(32 * kf + (i & 3) + 4 * ((i >> 2) & 1) + 16 * ((i >> 3) & 1)); st[qi][kf][i] *= fexp2(lb * (cc - dbase)); }
        } else {
#pragma unroll
          for (int kf = 0; kf < 2; ++kf)
#pragma unroll
            for (int i = 0; i < 16; ++i) { const float cc = (float)(32 * kf + (i & 3) + 4 * ((i >> 2) & 1) + 16 * ((i >> 3) & 1)); const float d = dbase - cc;
              float dd = fexp2(fminf(lf * d, -lb * d)); if (d == 0.f) dd = 2.0f; st[qi][kf][i] *= dd; }
        }
      } else {
        float mx = st[qi][0][0];
#pragma unroll
        for (int kf = 0; kf < 2; ++kf)
#pragma unroll
          for (int i = 0; i < 16; ++i) mx = fmaxf(mx, st[qi][kf][i]);
        mx = fmaxf(mx, __shfl_xor(mx, 32));
        const float mn = fmaxf(m_run[qi], mx); const float alpha = fexp2(m_run[qi] - mn); m_run[qi] = mn;
        float ps = 0.f;
#pragma unroll
        for (int kf = 0; kf < 2; ++kf)
#pragma unroll
          for (int i = 0; i < 16; ++i) { st[qi][kf][i] = fexp2(st[qi][kf][i] - mn); ps += st[qi][kf][i]; }
        l_run[qi] = l_run[qi] * alpha + ps;
#pragma unroll
        for (int df = 0; df < 2; ++df) o[qi][df] *= alpha;
      }
#pragma unroll
      for (int kf = 0; kf < 2; ++kf)
#pragma unroll
        for (int s2 = 0; s2 < 2; ++s2) { u32x4 u; u.x = pk(st[qi][kf][8 * s2], st[qi][kf][8 * s2 + 1]); u.y = pk(st[qi][kf][8 * s2 + 2], st[qi][kf][8 * s2 + 3]);
          u.z = pk(st[qi][kf][8 * s2 + 4], st[qi][kf][8 * s2 + 5]); u.w = pk(st[qi][kf][8 * s2 + 6], st[qi][kf][8 * s2 + 7]); pf[kf * 2 + s2] = __builtin_bit_cast(bf16x8, u); }
#pragma unroll
      for (int df = 0; df < 2; ++df)
#pragma unroll
        for (int ksx = 0; ksx < 4; ++ksx) { const bf16x8 vfr = *(const bf16x8*)(vs + (df * 32 + l31) * PITCH + ksx * 32 + h * 16); o[qi][df] = MFMA32(vfr, pf[ksx], o[qi][df]); }
      __builtin_amdgcn_sched_barrier(0);
    }
    __builtin_amdgcn_sched_barrier(0);
    if (t + 1 < nt) A3_LSTORE((t + 1) & 1);
    __syncthreads();
  }
#undef A3_GLOAD
#undef A3_LSTORE
#pragma unroll
  for (int qi = 0; qi < 2; ++qi) {
    const int qrow = row0 + qw0 + qi * 32 + l31;
    bf16_t* zq = p.z + (size_t)qrow * NIN + QC;
    f32x16 r[2];
    if (MODE == 0) {
      const float l = l_run[qi] + __shfl_xor(l_run[qi], 32); const float inv = 1.0f / l;
#pragma unroll
      for (int df = 0; df < 2; ++df) r[df] = o[qi][df] * inv;
    } else {
      float ss = 0.f;
#pragma unroll
      for (int df = 0; df < 2; ++df)
#pragma unroll
        for (int i = 0; i < 16; ++i) ss += o[qi][df][i] * o[qi][df][i];
      ss += __shfl_xor(ss, 32);
      const float rs = rsqrtf(ss * (1.0f / 64.0f) + EPS);
      const float* gg = p.in[I_CGN] + layer * 256 + head * 64;
      const bf16_t* zg = p.z + (size_t)qrow * NIN + C_G + head * 64;
#pragma unroll
      for (int df = 0; df < 2; ++df)
#pragma unroll
        for (int g = 0; g < 4; ++g) { const u32x2 gw = *(const u32x2*)(zg + df * 32 + 8 * g + 4 * h);
          const float gv[4] = {bflo(gw.x), bfhi(gw.x), bflo(gw.y), bfhi(gw.y)};
#pragma unroll
          for (int e = 0; e < 4; ++e) { const float x = gv[e]; r[df][4 * g + e] = o[qi][df][4 * g + e] * rs * gg[df * 32 + 8 * g + 4 * h + e] * (x / (1.0f + __expf(-x))); } }
    }
#pragma unroll
    for (int df = 0; df < 2; ++df)
#pragma unroll
      for (int g = 0; g < 4; ++g) { u32x2 v; v.x = pk(r[df][4 * g], r[df][4 * g + 1]); v.y = pk(r[df][4 * g + 2], r[df][4 * g + 3]); *(u32x2*)(zq + df * 32 + 8 * g + 4 * h) = v; }
  }
}

DI void ctr_barrier(unsigned* cnt) {
  asm volatile("s_waitcnt vmcnt(0) lgkmcnt(0)" ::: "memory");
  __syncthreads();
  if (threadIdx.x == 0) {
    __builtin_amdgcn_fence(__ATOMIC_RELEASE, "agent");
    asm volatile("s_waitcnt vmcnt(0)" ::: "memory");
    const unsigned G = gridDim.x;
    const unsigned old = __hip_atomic_fetch_add(cnt, 1u, __ATOMIC_RELAXED, __HIP_MEMORY_SCOPE_AGENT);
    const unsigned gen = old / G + 1u;
    if (old + 1u == gen * G) __hip_atomic_store(cnt + 64, gen, __ATOMIC_RELAXED, __HIP_MEMORY_SCOPE_AGENT);
    else while (__hip_atomic_load(cnt + 64, __ATOMIC_RELAXED, __HIP_MEMORY_SCOPE_AGENT) < gen) __builtin_amdgcn_s_sleep(1);
    __builtin_amdgcn_fence(__ATOMIC_ACQUIRE, "agent");
    asm volatile("s_waitcnt vmcnt(0)" ::: "memory");
  }
  __syncthreads();
}

DI int next_item(int* ctr, int* sh) {
  __syncthreads();
  if (threadIdx.x == 0) *sh = atomicAdd(ctr, 1);
  __syncthreads();
  return *sh;
}
constexpr int XQ_N = 416;
DI int next_item_x(int* ctr8, int* sh) {
  __syncthreads();
  if (threadIdx.x == 0) {
    int r = -1;
    const int x0 = blockIdx.x & 7;
    for (int k = 0; k < 8; ++k) { const int x = (x0 + k) & 7; const int i = atomicAdd(ctr8 + x, 1); if (i < XQ_N) { r = (x << 16) | i; break; } }
    *sh = r;
  }
  __syncthreads();
  return *sh;
}

__global__ void __launch_bounds__(256, 2) fwd(Params p) {
  extern __shared__ __attribute__((aligned(16))) char lds[];
  __shared__ int s_item;
  cg::grid_group grid = cg::this_grid();
  const int bid = blockIdx.x, nb = gridDim.x, tid = threadIdx.x, lane = tid & 63, w = tid >> 6;
  if (bid == 0) p.ctr[tid] = 0;
  for (int i = bid * 256 + tid; i < 4096 * 32; i += nb * 256) { const int t = i >> 5, j = i & 31; const float inv = powf(10000.0f, -(float)(2 * j) / 64.0f); float sn, cs; sincosf((float)t * inv, &sn, &cs); p.tabC[i] = (f32x2){cs, sn}; }
  for (int i = bid * 256 + tid; i < 4096 * 4; i += nb * 256) { const int t = i >> 2, j = i & 3; const float inv = powf(500000.0f, -(float)(2 * j) / 8.0f); float sn, cs; sincosf((float)t * inv, &sn, &cs); p.tabB[i] = (f32x2){cs, sn}; }
  for (int i = bid * 256 + tid; i < 64 * 16; i += nb * 256) { const int t = i >> 4, j = i & 15; const float inv = powf(10000.0f, -(float)(2 * j) / 32.0f); float sn, cs; sincosf((float)t * inv, &sn, &cs); p.tabA[i] = (f32x2){cs, sn}; }
  for (int l = 0; l < 2; ++l) {
    for (int i = bid * 256 + tid; i < (NINP - NIN) * 1024; i += nb * 256) p.wtin[(size_t)l * NINP * 1024 + (size_t)NIN * 1024 + i] = 0;
    for (int tl = bid; tl < 16 * 53; tl += nb) conv_T(lds, p.in[I_WIN] + (size_t)l * 1024 * NIN, 1024, NIN, p.wtin + (size_t)l * NINP * 1024, 0, tl);
    for (int tl = bid; tl < 16 * 16; tl += nb) conv_T(lds, p.in[I_WOUT] + (size_t)l * 1024 * 1024, 1024, 1024, p.wtout + (size_t)l * 1024 * 1024, 0, tl);
  }
  bf16_t* hb = p.pl;
  for (int row = bid * 4 + opaque(w); row < MT; row += nb * 8) {
    const int rb = row + nb * 4;
    const float* xin = row < M0 ? p.in[I_XP] + (size_t)row * 1024 : p.in[I_XS] + (size_t)(row - M0) * 1024;
    if (rb < MT) { const float* xinb = rb < M0 ? p.in[I_XP] + (size_t)rb * 1024 : p.in[I_XS] + (size_t)(rb - M0) * 1024;
      row_phase2(xin, xinb, p.out + (size_t)row * 1024, p.out + (size_t)rb * 1024, nullptr, nullptr, nullptr, p.in[I_NMPRE], hb + (size_t)row * 1024, hb + (size_t)rb * 1024, lane); }
    else row_phase(xin, p.out + (size_t)row * 1024, nullptr, nullptr, p.in[I_NMPRE], hb + (size_t)row * 1024, lane);
  }
  grid.sync();
  for (int l = 0; l < 2; ++l) {
    { ASrc A; A.b0 = hb; A.b1 = hb; A.b2 = hb; A.b3 = hb; A.s0 = A.s1 = A.s2 = A.s3 = 1024; A.shift = 12;
      EpiIn e; e.z = p.z; e.lds = lds; e.qg = p.in[I_AQG] + l * 64; e.kg = p.in[I_AKG] + l * 64; e.tabA = p.tabA; e.tabB = p.tabB; e.tabC = p.tabC;
      gemm_phase2(lds, A, p.wtin + (size_t)l * NINP * 1024, 1024, 14, e); }
    ctr_barrier((unsigned*)p.ctr + 96);
    for (int it = bid; it < MT / DTOK; it += nb) dprep_item(lds, p, l, it);
    ctr_barrier((unsigned*)p.ctr + 96);
    for (;;) {
      const int it = next_item_x(p.ctr + l * 16, &s_item);
      if (it < 0) break;
      const int x = it >> 16; int i = it & 0xffff;
      if (i < 32) { const int j = i & 15; rwkv_item(lds, p, i < 16 ? x : 8 + x, (j >> 2) & 3, (j >> 1) & 1, j & 1); }
      else { i -= 32;
        if (i < 128) attn_item<1>(lds, p, l, x, i >> 5, i & 31);
        else if (i < 192) { i -= 128; attn3_item<2>(lds, p, l, x, i >> 4, i & 15); }
        else if (i < 256) { i -= 192; attn3_item<0>(lds, p, l, x, i >> 4, i & 15); }
        else if (i < 320) { i -= 256; attn_item<1>(lds, p, l, 8 + x, i >> 4, i & 15); }
        else if (i < 352) { i -= 320; attn3_item<2>(lds, p, l, 8 + x, i >> 3, i & 7); }
        else { i -= 352; attn3_item<0>(lds, p, l, 8 + x, i >> 3, i & 7); }
      }
    }
    ctr_barrier((unsigned*)p.ctr + 96);
    bf16_t* wtgu = p.pl + 5 * PLANE; bf16_t* wtd = wtgu + (size_t)2 * DFF * 1024;
    for (int it = bid; it < MT / DTOK + 3 * 704; it += nb) {
      if (it < MT / DTOK) dpost_item(lds, p, l, it);
      else { const int j = it - MT / DTOK;
        if (j < 704) conv_T(lds, p.in[I_FG] + (size_t)l * 1024 * DFF, 1024, DFF, wtgu, 1, j);
        else if (j < 1408) conv_T(lds, p.in[I_FU] + (size_t)l * 1024 * DFF, 1024, DFF, wtgu, 2, j - 704);
        else conv_T(lds, p.in[I_FD] + (size_t)l * DFF * 1024, DFF, 1024, wtd, 0, j - 1408); }
    }
    ctr_barrier((unsigned*)p.ctr + 96);
    { ASrc A; A.b0 = p.z + A_Q; A.b1 = p.z + B_Q; A.b2 = p.z + C_Q; A.b3 = p.pl + 4 * PLANE; A.s0 = A.s1 = A.s2 = NIN; A.s3 = 256; A.shift = 8;
      EpiStore e; e.out = hb; e.ldc = 1024; e.nmax = 1024; e.lds = lds;
      gemm_phase2(lds, A, p.wtout + (size_t)l * 1024 * 1024, 1024, 4, e); }
    ctr_barrier((unsigned*)p.ctr + 96);
    for (int row = bid * 4 + opaque(w); row < MT; row += nb * 8) { const int rb = row + nb * 4;
      if (rb < MT) row_phase2(p.out + (size_t)row * 1024, p.out + (size_t)rb * 1024, p.out + (size_t)row * 1024, p.out + (size_t)rb * 1024, hb + (size_t)row * 1024, hb + (size_t)rb * 1024,
                              p.in[I_NMPOST] + l * 1024, p.in[I_NFPRE] + l * 1024, hb + (size_t)row * 1024, hb + (size_t)rb * 1024, lane);
      else row_phase(p.out + (size_t)row * 1024, p.out + (size_t)row * 1024, hb + (size_t)row * 1024, p.in[I_NMPOST] + l * 1024, p.in[I_NFPRE] + l * 1024, hb + (size_t)row * 1024, lane); }
    ctr_barrier((unsigned*)p.ctr + 96);
    { ASrc A; A.b0 = hb; A.b1 = hb; A.b2 = hb; A.b3 = hb; A.s0 = A.s1 = A.s2 = A.s3 = 1024; A.shift = 12;
      EpiSwiGLU e; e.out = p.z; e.lds = lds;
      gemm_phase2(lds, A, wtgu, 1024, 22, e); }
    ctr_barrier((unsigned*)p.ctr + 96);
    { ASrc A; A.b0 = p.z; A.b1 = p.z; A.b2 = p.z; A.b3 = p.z; A.s0 = A.s1 = A.s2 = A.s3 = DFF; A.shift = 12;
      EpiStore e; e.out = hb; e.ldc = 1024; e.nmax = 1024; e.lds = lds;
      gemm_phase2(lds, A, wtd, DFF, 4, e); }
    ctr_barrier((unsigned*)p.ctr + 96);
    for (int row = bid * 4 + opaque(w); row < MT; row += nb * 8) { const int rb = row + nb * 4; const float* gp2 = l == 0 ? p.in[I_NMPRE] + 1024 : nullptr;
      if (rb < MT) row_phase2(p.out + (size_t)row * 1024, p.out + (size_t)rb * 1024, p.out + (size_t)row * 1024, p.out + (size_t)rb * 1024, hb + (size_t)row * 1024, hb + (size_t)rb * 1024,
                              p.in[I_NFPOST] + l * 1024, gp2, hb + (size_t)row * 1024, hb + (size_t)rb * 1024, lane);
      else row_phase(p.out + (size_t)row * 1024, p.out + (size_t)row * 1024, hb + (size_t)row * 1024, p.in[I_NFPOST] + l * 1024, gp2, hb + (size_t)row * 1024, lane); }
    if (l == 0) ctr_barrier((unsigned*)p.ctr + 96);
  }
}

extern "C" void kernel_launch(void* const* d_in, const int* in_sizes, int n_in, void* d_out, int out_size,
                              void* d_ws, size_t ws_size, hipStream_t stream) {
  static int grid_blocks = 0;
  if (!grid_blocks) {
    int dev = 0, cus = 0, per_cu = 0;
    hipGetDevice(&dev);
    hipDeviceGetAttribute(&cus, hipDeviceAttributeMultiprocessorCount, dev);
    hipFuncSetAttribute((const void*)fwd, hipFuncAttributeMaxDynamicSharedMemorySize, LDS_BYTES);
    hipOccupancyMaxActiveBlocksPerMultiprocessor(&per_cu, fwd, 256, LDS_BYTES);
    if (per_cu > 2) per_cu = 2;
    if (per_cu < 1) per_cu = 1;
    grid_blocks = cus * per_cu;
  }
  Params p{};
  for (int i = 0; i < 28; ++i) p.in[i] = (const float*)d_in[i];
  p.out = (float*)d_out;
  char* ws = (char*)d_ws;
  size_t off = 0;
  p.z = (bf16_t*)(ws + off); off += (size_t)MT * NIN * 2;
  p.pl = (bf16_t*)(ws + off); off += 7 * PLANE * 2;
  p.wtin = (bf16_t*)(ws + off); off += (size_t)2 * NINP * 1024 * 2;
  p.wtout = (bf16_t*)(ws + off); off += (size_t)2 * 1024 * 1024 * 2;
  p.tabC = (f32x2*)(ws + off); off += (size_t)4096 * 32 * 8;
  p.tabB = (f32x2*)(ws + off); off += (size_t)4096 * 4 * 8;
  p.tabA = (f32x2*)(ws + off); off += (size_t)64 * 16 * 8;
  p.ctr = (int*)(ws + off); off += 1024;
  if (off > ws_size) fprintf(stderr, "workspace too small: need %zu have %zu\n", off, ws_size);
  void* args[] = {&p};
  hipError_t e = hipLaunchCooperativeKernel((void*)fwd, dim3(grid_blocks), dim3(256), args, LDS_BYTES, stream);
  if (e != hipSuccess) fprintf(stderr, "coop launch failed: %s (grid %d)\n", hipGetErrorString(e), grid_blocks);
}
```

```cpp
#include <hip/hip_runtime.h>
#include <hip/hip_cooperative_groups.h>
#include <cstdio>
#include <cstdint>
namespace cg = cooperative_groups;

#define DI __device__ __forceinline__
typedef unsigned short bf16_t;
typedef short bf16x8 __attribute__((ext_vector_type(8)));
typedef float f32x2 __attribute__((ext_vector_type(2)));
typedef float f32x4 __attribute__((ext_vector_type(4)));
typedef float f32x16 __attribute__((ext_vector_type(16)));
typedef unsigned u32x2 __attribute__((ext_vector_type(2)));
typedef unsigned u32x4 __attribute__((ext_vector_type(4)));
typedef __bf16 bf16x2_t __attribute__((ext_vector_type(2)));

constexpr int M0 = 32768, MT = 49152, DM = 1024, NIN = 3392, NINP = 3584, DFF = 2816;
constexpr int A_Q = 0, A_K = 256, A_V = 384, B_Q = 512, B_K = 768, B_V = 1024, C_Q = 1280, C_K = 1536, C_V = 1792, C_G = 2048, D_0 = 2304;
constexpr int PITCH = 144;
constexpr size_t PLANE = (size_t)MT * 256;
constexpr int LDS_BYTES = 73728;
constexpr float LOG2E = 1.4426950408889634f;
constexpr float EPS = 1e-6f;

enum { I_XP = 0, I_XS, I_NMPRE, I_NMPOST, I_NFPRE, I_NFPOST, I_WIN, I_WOUT, I_AQG, I_AKG, I_BLAM, I_BSUB, I_CGN, I_DMUP, I_DMUN, I_DW0, I_DWUP,
       I_DA0, I_DAUP, I_DGUP, I_DKK, I_DKA, I_DRK, I_DGNW, I_DGNB, I_FG, I_FU, I_FD };

struct Params {
  const float* in[28];
  float* out;
  bf16_t* z;
  bf16_t* pl;
  bf16_t* wtin;
  bf16_t* wtout;
  f32x2* tabC;
  f32x2* tabB;
  f32x2* tabA;
  int* ctr;
};

DI int opaque(int x) { asm volatile("" : "+v"(x)); return x; }
DI int opaque_s(int x) { asm volatile("" : "+s"(x)); return x; }
DI float bf2f(bf16_t v) { return __uint_as_float(((unsigned)v) << 16); }
DI float bflo(unsigned w) { return __uint_as_float(w << 16); }
DI float bfhi(unsigned w) { return __uint_as_float(w & 0xffff0000u); }
DI unsigned pk(float lo, float hi) { f32x2 v = {lo, hi}; bf16x2_t b = __builtin_convertvector(v, bf16x2_t); return __builtin_bit_cast(unsigned, b); }
DI bf16_t f2bf(float x) { return (bf16_t)(pk(x, 0.f) & 0xffffu); }
DI float dppf(float x, const int ctrl) { return x; }
#define DPPF(x, ctrl) __int_as_float(__builtin_amdgcn_update_dpp(0, __float_as_int(x), (ctrl), 0xF, 0xF, true))
DI float wave_sum(float v) {
  v += DPPF(v, 0xB1);
  v += DPPF(v, 0x4E);
  v += DPPF(v, 0x141);
  v += DPPF(v, 0x140);
  const int vi = __float_as_int(v);
  return (__int_as_float(__builtin_amdgcn_readlane(vi, 0)) + __int_as_float(__builtin_amdgcn_readlane(vi, 16))) +
         (__int_as_float(__builtin_amdgcn_readlane(vi, 32)) + __int_as_float(__builtin_amdgcn_readlane(vi, 48)));
}
DI float dpp_xor1(float x) { return __int_as_float(__builtin_amdgcn_update_dpp(0, __float_as_int(x), 0xB1, 0xF, 0xF, true)); }
DI float dpp_xor2(float x) { return __int_as_float(__builtin_amdgcn_update_dpp(0, __float_as_int(x), 0x4E, 0xF, 0xF, true)); }
DI float dpp_hmir(float x) { return __int_as_float(__builtin_amdgcn_update_dpp(0, __float_as_int(x), 0x141, 0xF, 0xF, true)); }
DI float red8(float x) { x += dpp_xor1(x); x += dpp_xor2(x); x += dpp_hmir(x); return x; }
DI float fexp2(float x) { return __builtin_amdgcn_exp2f(x); }
DI void seq_info(int s, int& row0, int& T) { if (s < 8) { row0 = s * 4096; T = 4096; } else { row0 = M0 + (s - 8) * 2048; T = 2048; } }
DI void row_info(int r, int& t, int& T) { if (r < M0) { t = r & 4095; T = 4096; } else { t = (r - M0) & 2047; T = 2048; } }
#define MFMA32(a, b, c) __builtin_amdgcn_mfma_f32_32x32x16_bf16((a), (b), (c), 0, 0, 0)

DI void conv_T(char* lds, const float* __restrict__ W, int K, int N, bf16_t* __restrict__ Wt, int mode, int tile) {
  float* t = (float*)lds;
  const int tid0 = opaque(threadIdx.x);
  const int ntn = N >> 6, kt = tile / ntn, nt = tile - kt * ntn, k0 = kt << 6, n0 = nt << 6;
  float wv[16];
#pragma unroll
  for (int i = 0; i < 16; ++i) { const int idx = tid0 + 256 * i, k = idx >> 6, n = idx & 63; wv[i] = W[(size_t)(k0 + k) * N + n0 + n]; }
#pragma unroll
  for (int i = 0; i < 16; ++i) { const int idx = tid0 + 256 * i, k = idx >> 6, n = idx & 63; t[k * 65 + n] = wv[i]; }
  __syncthreads();
#pragma unroll 4
  for (int i = 0; i < 8; ++i) {
    const int idx = tid0 + 256 * i, n = idx >> 5, k = (idx & 31) * 2, j = n0 + n;
    const int rho = (mode == 0) ? j : ((j >> 6) * 128 + ((j >> 5) & 1) * 64 + (mode - 1) * 32 + (j & 31));
    *(unsigned*)(Wt + (size_t)rho * K + k0 + k) = pk(t[k * 65 + n], t[(k + 1) * 65 + n]);
  }
  __syncthreads();
}

DI void row_phase(const float* __restrict__ xin, float* __restrict__ xout, const bf16_t* addsrc, const float* __restrict__ gpost,
                  const float* __restrict__ gpre, bf16_t* hout, int lane_in) {
  const int lane = opaque(lane_in);
  f32x4 x[4];
#pragma unroll
  for (int i = 0; i < 4; ++i) x[i] = *(const f32x4*)(xin + i * 256 + lane * 4);
  if (addsrc) {
    f32x4 m[4]; float ss = 0.f;
#pragma unroll
    for (int i = 0; i < 4; ++i) { const u32x2 w = *(const u32x2*)(addsrc + i * 256 + lane * 4); m[i] = (f32x4){bflo(w.x), bfhi(w.x), bflo(w.y), bfhi(w.y)};
      ss += m[i][0] * m[i][0] + m[i][1] * m[i][1] + m[i][2] * m[i][2] + m[i][3] * m[i][3]; }
    ss = wave_sum(ss); const float rs = rsqrtf(ss * (1.0f / 1024.0f) + EPS);
#pragma unroll
    for (int i = 0; i < 4; ++i) { const f32x4 g = *(const f32x4*)(gpost + i * 256 + lane * 4); x[i] += m[i] * rs * g; }
  }
#pragma unroll
  for (int i = 0; i < 4; ++i) *(f32x4*)(xout + i * 256 + lane * 4) = x[i];
  if (gpre) {
    float ss = 0.f;
#pragma unroll
    for (int i = 0; i < 4; ++i) ss += x[i][0] * x[i][0] + x[i][1] * x[i][1] + x[i][2] * x[i][2] + x[i][3] * x[i][3];
    ss = wave_sum(ss); const float rs = rsqrtf(ss * (1.0f / 1024.0f) + EPS);
#pragma unroll
    for (int i = 0; i < 4; ++i) { const f32x4 g = *(const f32x4*)(gpre + i * 256 + lane * 4); const f32x4 hv = x[i] * rs * g;
      u32x2 w; w.x = pk(hv[0], hv[1]); w.y = pk(hv[2], hv[3]); *(u32x2*)(hout + i * 256 + lane * 4) = w; }
  }
}

DI void row_phase2(const float* __restrict__ xinA, const float* __restrict__ xinB, float* __restrict__ xoutA, float* __restrict__ xoutB, const bf16_t* addA, const bf16_t* addB,
                   const float* __restrict__ gpost, const float* __restrict__ gpre, bf16_t* houtA, bf16_t* houtB, int lane_in) {
  const int lane = opaque(lane_in);
  f32x4 x[2][4]; u32x2 aw[2][4];
#pragma unroll
  for (int i = 0; i < 4; ++i) { x[0][i] = *(const f32x4*)(xinA + i * 256 + lane * 4); x[1][i] = *(const f32x4*)(xinB + i * 256 + lane * 4); }
  if (addA) {
#pragma unroll
    for (int i = 0; i < 4; ++i) { aw[0][i] = *(const u32x2*)(addA + i * 256 + lane * 4); aw[1][i] = *(const u32x2*)(addB + i * 256 + lane * 4); }
#pragma unroll
    for (int r = 0; r < 2; ++r) {
      f32x4 m[4]; float ss = 0.f;
#pragma unroll
      for (int i = 0; i < 4; ++i) { const u32x2 w = aw[r][i]; m[i] = (f32x4){bflo(w.x), bfhi(w.x), bflo(w.y), bfhi(w.y)};
        ss += m[i][0] * m[i][0] + m[i][1] * m[i][1] + m[i][2] * m[i][2] + m[i][3] * m[i][3]; }
      ss = wave_sum(ss); const float rs = rsqrtf(ss * (1.0f / 1024.0f) + EPS);
#pragma unroll
      for (int i = 0; i < 4; ++i) { const f32x4 g = *(const f32x4*)(gpost + i * 256 + lane * 4); x[r][i] += m[i] * rs * g; }
    }
  }
#pragma unroll
  for (int i = 0; i < 4; ++i) { *(f32x4*)(xoutA + i * 256 + lane * 4) = x[0][i]; *(f32x4*)(xoutB + i * 256 + lane * 4) = x[1][i]; }
  if (gpre) {
#pragma unroll
    for (int r = 0; r < 2; ++r) {
      float ss = 0.f;
#pragma unroll
      for (int i = 0; i < 4; ++i) ss += x[r][i][0] * x[r][i][0] + x[r][i][1] * x[r][i][1] + x[r][i][2] * x[r][i][2] + x[r][i][3] * x[r][i][3];
      ss = wave_sum(ss); const float rs = rsqrtf(ss * (1.0f / 1024.0f) + EPS);
      bf16_t* ho = r == 0 ? houtA : houtB;
#pragma unroll
      for (int i = 0; i < 4; ++i) { const f32x4 g = *(const f32x4*)(gpre + i * 256 + lane * 4); const f32x4 hv = x[r][i] * rs * g;
        u32x2 w; w.x = pk(hv[0], hv[1]); w.y = pk(hv[2], hv[3]); *(u32x2*)(ho + i * 256 + lane * 4) = w; }
    }
  }
}

struct ASrc { const bf16_t* b0; const bf16_t* b1; const bf16_t* b2; const bf16_t* b3; int s0, s1, s2, s3; int shift; };

DI void store_piece64(char* img, const f32x16 (&acc)[2][2], bf16_t* out, size_t ld, int row0, int col0, int l31, int h) {
#pragma unroll
  for (int mf = 0; mf < 2; ++mf)
#pragma unroll
    for (int nf = 0; nf < 2; ++nf)
#pragma unroll
      for (int g = 0; g < 4; ++g) { u32x2 v; v.x = pk(acc[mf][nf][4 * g], acc[mf][nf][4 * g + 1]); v.y = pk(acc[mf][nf][4 * g + 2], acc[mf][nf][4 * g + 3]);
        *(u32x2*)(img + (mf * 32 + l31) * PITCH + (nf * 32 + 8 * g + 4 * h) * 2) = v; }
  const int ln = l31 + 32 * h;
#pragma unroll 2
  for (int i = 0; i < 8; ++i) { const int q = ln + 64 * i, r = q >> 3, c8 = q & 7;
    const u32x4 v = *(const u32x4*)(img + r * PITCH + c8 * 16); *(u32x4*)(out + (size_t)(row0 + r) * ld + col0 + c8 * 8) = v; }
}
DI void store_piece32(char* img, const f32x16 (&a0), const f32x16 (&a1), bf16_t* out, size_t ld, int row0, int col0, int l31, int h) {
#pragma unroll
  for (int g = 0; g < 4; ++g) { u32x2 v; v.x = pk(a0[4 * g], a0[4 * g + 1]); v.y = pk(a0[4 * g + 2], a0[4 * g + 3]); *(u32x2*)(img + l31 * PITCH + (8 * g + 4 * h) * 2) = v;
    u32x2 u; u.x = pk(a1[4 * g], a1[4 * g + 1]); u.y = pk(a1[4 * g + 2], a1[4 * g + 3]); *(u32x2*)(img + l31 * PITCH + (32 + 8 * g + 4 * h) * 2) = u; }
  const int ln = l31 + 32 * h;
#pragma unroll
  for (int i = 0; i < 4; ++i) { const int q = ln + 64 * i, r = q >> 3, c8 = q & 7;
    const u32x4 v = *(const u32x4*)(img + r * PITCH + c8 * 16); *(u32x4*)(out + (size_t)(row0 + r) * ld + col0 + c8 * 8) = v; }
}
struct EpiStore { bf16_t* out; int ldc; int nmax; char* lds;
  DI void operator()(const f32x16 (&acc)[2][2], int mb, int nb, int n0, int wc, int l31, int h) const {
    if (nb >= nmax) return;
    store_piece64(lds + (threadIdx.x >> 6) * 9216, acc, out, (size_t)ldc, mb, nb, l31, h);
  } };
struct EpiSwiGLU { bf16_t* out; char* lds;
  DI void operator()(const f32x16 (&acc)[2][2], int mb, int nb, int n0, int wc, int l31, int h) const {
    const int hc = (nb >> 6) * 32;
    char* img = lds + (threadIdx.x >> 6) * 9216;
#pragma unroll
    for (int mf = 0; mf < 2; ++mf)
#pragma unroll
      for (int g = 0; g < 4; ++g) { float r[4];
#pragma unroll
        for (int e = 0; e < 4; ++e) { const float gt = acc[mf][0][4 * g + e], up = acc[mf][1][4 * g + e]; r[e] = gt / (1.0f + __expf(-gt)) * up; }
        u32x2 v; v.x = pk(r[0], r[1]); v.y = pk(r[2], r[3]); *(u32x2*)(img + (mf * 32 + l31) * PITCH + (8 * g + 4 * h) * 2) = v; }
    const int ln = l31 + 32 * h;
#pragma unroll
    for (int i = 0; i < 4; ++i) { const int q = ln + 64 * i, r = q >> 2, c4 = q & 3;
      const u32x4 v = *(const u32x4*)(img + r * PITCH + c4 * 16); *(u32x4*)(out + (size_t)(mb + r) * DFF + hc + c4 * 8) = v; }
  } };

struct EpiIn { bf16_t* z; char* lds; const float* qg; const float* kg; const f32x2* tabA; const f32x2* tabB; const f32x2* tabC;
  DI void operator()(f32x16 (&acc)[2][2], int mb, int nb, int n0, int wc, int l31, int h) const {
    if (nb >= NIN) return;
    const bool isv = (nb >= A_V && nb < B_Q) || (nb >= B_V && nb < C_Q) || (nb >= C_V && nb < C_G);
    if (isv) {
      const int wv = (threadIdx.x >> 6);
      bf16_t* img = (bf16_t*)(lds + 32768 + wv * 9216);
#pragma unroll
      for (int mf = 0; mf < 2; ++mf)
#pragma unroll
        for (int nf = 0; nf < 2; ++nf)
#pragma unroll
          for (int i = 0; i < 16; ++i) { const int d = nf * 32 + (i & 3) + 8 * (i >> 2) + 4 * h; img[d * 72 + mf * 32 + l31] = f2bf(acc[mf][nf][i]); }
      __builtin_amdgcn_s_waitcnt(0xc07f);
      const int ln = l31 + 32 * h;
#pragma unroll
      for (int i = 0; i < 8; ++i) { const int q = ln + 64 * i, d = q >> 3, c8 = q & 7;
        const u32x4 v = *(const u32x4*)(img + d * 72 + c8 * 8); *(u32x4*)(z + (size_t)(mb + d) * NIN + nb + c8 * 8) = v; }
      return;
    }
#pragma unroll
    for (int mf = 0; mf < 2; ++mf) {
      const int row = mb + mf * 32 + l31; int t, T; row_info(row, t, T);
      if (nb < A_V) {
        const bool isq = nb < A_K; const float* gn = isq ? qg : kg;
        float ss = 0.f;
#pragma unroll
        for (int nf = 0; nf < 2; ++nf)
#pragma unroll
          for (int i = 0; i < 16; ++i) ss += acc[mf][nf][i] * acc[mf][nf][i];
        ss += __shfl_xor(ss, 32);
        const float rs = rsqrtf(ss * (1.0f / 64.0f) + EPS) * (isq ? 0.125f * LOG2E : 1.0f);
#pragma unroll
        for (int nf = 0; nf < 2; ++nf) {
          const int pos = nf == 0 ? (t >> 6) : (t & 63);
#pragma unroll
          for (int g = 0; g < 4; ++g)
#pragma unroll
            for (int e = 0; e < 4; ++e) acc[mf][nf][4 * g + e] *= rs * gn[nf * 32 + 8 * g + 4 * h + e];
#pragma unroll
          for (int g = 0; g < 2; ++g)
#pragma unroll
            for (int e = 0; e < 4; ++e) { const f32x2 cs = tabA[pos * 16 + 8 * g + 4 * h + e];
              const float x1 = acc[mf][nf][4 * g + e], x2 = acc[mf][nf][4 * (g + 2) + e];
              acc[mf][nf][4 * g + e] = x1 * cs.x - x2 * cs.y; acc[mf][nf][4 * (g + 2) + e] = x2 * cs.x + x1 * cs.y; }
        }
      } else if (nb >= B_Q && nb < B_V) {
        const bool isq = nb < B_K;
#pragma unroll
        for (int nf = 0; nf < 2; ++nf) {
#pragma unroll
          for (int e = 0; e < 4; ++e) { const f32x2 cs = tabB[t * 4 + e]; const float v = acc[mf][nf][e]; const float o = __shfl_xor(v, 32);
            acc[mf][nf][e] = (h == 0) ? (v * cs.x - o * cs.y) : (v * cs.x + o * cs.y); }
          if (isq) {
#pragma unroll
            for (int i = 0; i < 16; ++i) acc[mf][nf][i] *= 0.17677669529663687f * LOG2E; }
        }
      } else if (nb >= C_Q && nb < C_V) {
        const float sc = nb < C_K ? 1.0f : 0.125f;
#pragma unroll
        for (int g = 0; g < 4; ++g) {
#pragma unroll
          for (int e = 0; e < 4; ++e) { const f32x2 cs = tabC[t * 32 + 8 * g + 4 * h + e]; const float x1 = acc[mf][0][4 * g + e], x2 = acc[mf][1][4 * g + e];
            acc[mf][0][4 * g + e] = (x1 * cs.x - x2 * cs.y) * sc; acc[mf][1][4 * g + e] = (x2 * cs.x + x1 * cs.y) * sc; }
          if (g & 1) __builtin_amdgcn_sched_barrier(0); }
      }
      store_piece32(lds + (threadIdx.x >> 6) * 9216, acc[mf][0], acc[mf][1], z, (size_t)NIN, mb + mf * 32, nb, l31, h);
    }
  } };

#define LASP __attribute__((address_space(3)))
template <class Epi>
DI void gemm_tile(char* lds, const ASrc& A, const bf16_t* __restrict__ Bt, int K, int m0, int n0, const Epi& epi, bool first, bool has_next, int m0n, int n0n) {
  const int tid = opaque(threadIdx.x), lane = tid & 63, w = __builtin_amdgcn_readfirstlane(tid >> 6), wr = w >> 1, wc = w & 1, l31 = lane & 31, h = lane >> 5;
  const int nk = K >> 6, smask = (1 << A.shift) - 1;
  LASP char* ldsl = (LASP char*)lds;
  f32x16 acc[2][2];
#pragma unroll
  for (int a = 0; a < 2; ++a)
#pragma unroll
    for (int b = 0; b < 2; ++b)
#pragma unroll
      for (int i = 0; i < 16; ++i) acc[a][b][i] = 0.f;
  const int lrow = lane >> 3, lslot = lane & 7;
  int goffA[4], goffB[4];
#pragma unroll
  for (int i = 0; i < 4; ++i) { const int r = w * 32 + i * 8 + lrow, c = lslot ^ ((r >> 1) & 7); goffA[i] = r; goffB[i] = r * K + c * 8; goffA[i] = (goffA[i] << 3) | c; }
#define GEMM_ISSUE(kt, st, M0_, N0_) do { const int k0_ = (kt) << 6, seg_ = k0_ >> A.shift, kk_ = k0_ & smask; \
    const bf16_t* bp_ = seg_ == 0 ? A.b0 : seg_ == 1 ? A.b1 : seg_ == 2 ? A.b2 : A.b3; const int st_ = seg_ == 0 ? A.s0 : seg_ == 1 ? A.s1 : seg_ == 2 ? A.s2 : A.s3; \
    _Pragma("unroll") for (int i_ = 0; i_ < 4; ++i_) { \
      const bf16_t* ga_ = bp_ + (size_t)((M0_) + (goffA[i_] >> 3)) * st_ + kk_ + (goffA[i_] & 7) * 8; \
      __builtin_amdgcn_global_load_lds((const unsigned*)ga_, (LASP unsigned*)(ldsl + (st) * 32768 + (w * 4 + i_) * 1024), 16, 0, 0); \
      const bf16_t* gb_ = Bt + (size_t)(N0_) * K + goffB[i_] + k0_; \
      __builtin_amdgcn_global_load_lds((const unsigned*)gb_, (LASP unsigned*)(ldsl + (st) * 32768 + 16384 + (w * 4 + i_) * 1024), 16, 0, 0); } } while (0)
  const int xr = (l31 >> 1) & 7;
  int coff[4];
#pragma unroll
  for (int s = 0; s < 4; ++s) coff[s] = ((2 * s + h) ^ xr) * 16;
#define GEMM_COMPUTE(st) do { const char* as = lds + (st) * 32768; const char* bs = as + 16384; \
    bf16x8 af[4][2], wf[4][2]; \
    _Pragma("unroll") for (int s = 0; s < 4; ++s) { \
      _Pragma("unroll") for (int mf = 0; mf < 2; ++mf) af[s][mf] = *(const bf16x8*)(as + (wr * 64 + mf * 32 + l31) * 128 + coff[s]); \
      _Pragma("unroll") for (int nf = 0; nf < 2; ++nf) wf[s][nf] = *(const bf16x8*)(bs + (wc * 64 + nf * 32 + l31) * 128 + coff[s]); } \
    __builtin_amdgcn_sched_barrier(0); __builtin_amdgcn_s_setprio(1); \
    _Pragma("unroll") for (int s = 0; s < 4; ++s) \
      _Pragma("unroll") for (int mf = 0; mf < 2; ++mf) _Pragma("unroll") for (int nf = 0; nf < 2; ++nf) acc[mf][nf] = MFMA32(wf[s][nf], af[s][mf], acc[mf][nf]); \
    __builtin_amdgcn_s_setprio(0); __builtin_amdgcn_sched_barrier(0); } while (0)
  if (first) GEMM_ISSUE(0, 0, m0, n0);
  for (int kt = 0; kt < nk; kt += 2) {
    asm volatile("s_waitcnt vmcnt(0)" ::: "memory"); __syncthreads();
    GEMM_ISSUE(kt + 1, 1, m0, n0);
    GEMM_COMPUTE(0);
    asm volatile("s_waitcnt vmcnt(0)" ::: "memory"); __syncthreads();
    if (kt + 2 < nk) GEMM_ISSUE(kt + 2, 0, m0, n0);
    GEMM_COMPUTE(1);
  }
  __syncthreads();
  if (has_next) GEMM_ISSUE(0, 0, m0n, n0n);
  epi(acc, m0 + wr * 64, n0 + wc * 64, n0, wc, l31, h);
  __syncthreads();
#undef GEMM_ISSUE
#undef GEMM_COMPUTE
}

template <class Epi>
DI void gemm_phase(char* lds, const ASrc& A, const bf16_t* Bt, int K, int ntn, const Epi& epi) {
  const int xcd = blockIdx.x & 7, j = blockIdx.x >> 3, nloc = gridDim.x >> 3, per = 48 * ntn, grp = 8 * ntn;
  bool first = true;
  for (int li = j; li < per; li += nloc) {
    const int sg = li / grp, wi = li - sg * grp, nt = wi >> 3, mt = xcd * 48 + sg * 8 + (wi & 7);
    const int ln = li + nloc; const bool has_next = ln < per;
    const int sgn = ln / grp, win = ln - sgn * grp, ntn2 = win >> 3, mtn = xcd * 48 + sgn * 8 + (win & 7);
    gemm_tile(lds, A, Bt, K, mt * 128, nt * 128, epi, first, has_next, mtn * 128, ntn2 * 128);
    first = false;
  }
}

DI void prep_item(char* lds, const Params& p, int layer, int item) {
  const int tid = opaque(threadIdx.x), lane = tid & 63, w = tid >> 6;
  const int rowb = item * 64; int tb, T; row_info(rowb, tb, T);
  const float* qg = p.in[I_AQG] + layer * 64; const float* kg = p.in[I_AKG] + layer * 64;
  const float qgl = qg[lane], kgl = kg[lane];
  for (int tt = 0; tt < 16; ++tt) {
    const int row = rowb + w * 16 + tt, t = tb + w * 16 + tt;
    bf16_t* zr = p.z + (size_t)row * NIN;
    {
      const int j = lane & 31, i = j & 15; const bool first = j < 16; const int pos = (lane < 32) ? (t >> 6) : (t & 63);
      const f32x2 cs = p.tabA[pos * 16 + i];
#pragma unroll
      for (int hd = 0; hd < 6; ++hd) {
        bf16_t* ptr = zr + (hd < 4 ? A_Q + hd * 64 : A_K + (hd - 4) * 64) + lane;
        float v = bf2f(*ptr);
        const float ss = wave_sum(v * v);
        v = v * rsqrtf(ss * (1.0f / 64.0f) + EPS) * (hd < 4 ? qgl : kgl);
        const float o = __shfl_xor(v, 16);
        float r = first ? (v * cs.x - o * cs.y) : (v * cs.x + o * cs.y);
        if (hd < 4) r *= 0.125f * LOG2E;
        *ptr = f2bf(r);
      }
    }
    {
      const int d = lane & 31; const f32x2 cs = p.tabB[t * 4 + (d & 3)];
#pragma unroll
      for (int c = 0; c < 8; ++c) {
        bf16_t* ptr = zr + (c < 4 ? B_Q + c * 64 : B_K + (c - 4) * 64) + lane;
        float v = bf2f(*ptr);
        const float o = __shfl_xor(v, 4);
        float r = v;
        if (d < 8) r = (d < 4) ? (v * cs.x - o * cs.y) : (v * cs.x + o * cs.y);
        if (c < 4) r *= 0.17677669529663687f * LOG2E;
        *ptr = f2bf(r);
      }
    }
    {
      const f32x2 cs = p.tabC[t * 32 + (lane & 31)];
#pragma unroll
      for (int c = 0; c < 8; ++c) {
        bf16_t* ptr = zr + (c < 4 ? C_Q + c * 64 : C_K + (c - 4) * 64) + lane;
        const float v = bf2f(*ptr);
        const float o = __shfl_xor(v, 32);
        float r = (lane < 32) ? (v * cs.x - o * cs.y) : (v * cs.x + o * cs.y);
        if (c >= 4) r *= 0.125f;
        *ptr = f2bf(r);
      }
    }
  }
  bf16_t* tl = (bf16_t*)lds;
  const int r = tid >> 2, c0 = (tid & 3) * 16;
  for (int sl = 0; sl < 10; ++sl) {
    const int col = sl < 2 ? A_V + sl * 64 : sl < 6 ? B_V + (sl - 2) * 64 : C_V + (sl - 6) * 64;
    bf16_t* gp = p.z + (size_t)(rowb + r) * NIN + col + c0;
    const u32x4 v0 = *(const u32x4*)gp, v1 = *(const u32x4*)(gp + 8);
    __syncthreads();
#pragma unroll
    for (int e = 0; e < 4; ++e) {
      tl[(c0 + 2 * e) * 72 + r] = (bf16_t)(v0[e] & 0xffffu); tl[(c0 + 2 * e + 1) * 72 + r] = (bf16_t)(v0[e] >> 16);
      tl[(c0 + 8 + 2 * e) * 72 + r] = (bf16_t)(v1[e] & 0xffffu); tl[(c0 + 8 + 2 * e + 1) * 72 + r] = (bf16_t)(v1[e] >> 16);
    }
    __syncthreads();
    const u32x4 o0 = *(const u32x4*)(tl + r * 72 + c0), o1 = *(const u32x4*)(tl + r * 72 + c0 + 8);
    *(u32x4*)gp = o0; *(u32x4*)(gp + 8) = o1;
  }
  __syncthreads();
}

DI float dshift(const Params& p, const float* mup, const float* mun, int row, int t, int T, int dc) {
  const bf16_t* zp = p.z + (size_t)row * NIN + D_0 + dc;
  const float z = bf2f(*zp);
  const float zprev = (t > 0) ? bf2f(*(zp - NIN)) : 0.f;
  const float znext = (t < T - 1) ? bf2f(*(zp + NIN)) : 0.f;
  return z + mup[dc] * (zprev - z) + mun[dc] * (znext - z);
}
DI float sigmoidf_(float x) { return 1.0f / (1.0f + __expf(-x)); }
DI float omdecay(float ww) {
  const float e = 0.6065306597126334f / (1.0f + __expf(-ww));
  return 1.0f - __expf(-e);
}
DI float fast_tanh(float x) { const float xc = fminf(fmaxf(x, -15.f), 15.f); return 1.0f - 2.0f / (1.0f + __expf(2.0f * xc)); }
constexpr int DTOK = 16;
DI void dprep_item(char* lds, const Params& p, int layer, int item) {
  const int tid = opaque(threadIdx.x);
  const int rowb = item * DTOK; int tb, T; row_info(rowb, tb, T);
  const float* mup = p.in[I_DMUP] + layer * 1088; const float* mun = p.in[I_DMUN] + layer * 1088;
  float* su = (float*)lds;
  bf16_t* stg = (bf16_t*)(lds + 12288);
#pragma unroll
  for (int i = 0; i < 12; ++i) {
    const int idx = tid + 256 * i, tok = idx / 192, c = idx - tok * 192;
    float u = dshift(p, mup, mun, rowb + tok, tb + tok, T, 768 + c);
    if (c < 128) u = fast_tanh(u);
    su[c * DTOK + tok] = u;
  }
  __syncthreads();
  const int c = tid;
  const float w0f = p.in[I_DW0][(layer * 2 + 0) * 256 + c], w0b = p.in[I_DW0][(layer * 2 + 1) * 256 + c];
  const float a0 = p.in[I_DA0][layer * 256 + c], kkw = p.in[I_DKK][layer * 256 + c], kaw = p.in[I_DKA][layer * 256 + c];
  float zr[DTOK + 2], zk[DTOK + 2], zv[DTOK + 2];
  { const bf16_t* zp = p.z + (size_t)rowb * NIN + D_0 + c;
#pragma unroll
    for (int i = 0; i < DTOK + 2; ++i) { const int t = tb - 1 + i; const bool ok = (t >= 0) && (t < T); const bf16_t* q = zp + (ptrdiff_t)(i - 1) * NIN;
      zr[i] = ok ? bf2f(q[0]) : 0.f; zk[i] = ok ? bf2f(q[256]) : 0.f; zv[i] = ok ? bf2f(q[512]) : 0.f; } }
  const float mpr = mup[c], mnr = mun[c], mpk = mup[256 + c], mnk = mun[256 + c], mpv = mup[512 + c], mnv = mun[512 + c];
  float accf[DTOK], accb[DTOK], acca[DTOK];
#pragma unroll
  for (int k = 0; k < DTOK; ++k) { accf[k] = 0.f; accb[k] = 0.f; acca[k] = 0.f; }
  const float* wupf = p.in[I_DWUP] + (size_t)(layer * 2 + 0) * 64 * 256 + c;
  const float* wupb = p.in[I_DWUP] + (size_t)(layer * 2 + 1) * 64 * 256 + c;
  const float* aup = p.in[I_DAUP] + (size_t)layer * 64 * 256 + c;
#pragma unroll 2
  for (int j = 0; j < 64; ++j) {
    const float wf = wupf[j * 256], wb = wupb[j * 256], wa = aup[j * 256];
#pragma unroll
    for (int q = 0; q < 4; ++q) {
      const f32x4 f0 = *(const f32x4*)(su + j * DTOK + 4 * q), b0 = *(const f32x4*)(su + (64 + j) * DTOK + 4 * q), a0v = *(const f32x4*)(su + (128 + j) * DTOK + 4 * q);
#pragma unroll
      for (int k = 0; k < 4; ++k) { accf[4 * q + k] += f0[k] * wf; accb[4 * q + k] += b0[k] * wb; acca[4 * q + k] += a0v[k] * wa; }
    }
  }
#pragma unroll
  for (int k = 0; k < DTOK; ++k) {
    const float r = zr[k + 1] + mpr * (zr[k] - zr[k + 1]) + mnr * (zr[k + 2] - zr[k + 1]);
    const float kx = zk[k + 1] + mpk * (zk[k] - zk[k + 1]) + mnk * (zk[k + 2] - zk[k + 1]);
    const float v = zv[k + 1] + mpv * (zv[k] - zv[k + 1]) + mnv * (zv[k + 2] - zv[k + 1]);
    const float omf = omdecay(w0f + accf[k]), omb = omdecay(w0b + accb[k]);
    const float a = sigmoidf_(a0 + acca[k]);
    float kk = kx * kkw; const float n2 = wave_sum(kk * kk);
    kk = kk * rsqrtf(fmaxf(n2, 1e-24f));
    const float kmod = kx * (1.0f + (a - 1.0f) * kaw), b = kk * a;
    bf16_t* so = stg + k * 256 + c;
    so[0] = f2bf(r); so[DTOK * 256] = f2bf(kmod); so[2 * DTOK * 256] = f2bf(v); so[3 * DTOK * 256] = f2bf(-kk);
    so[4 * DTOK * 256] = f2bf(b); so[5 * DTOK * 256] = f2bf(omf); so[6 * DTOK * 256] = f2bf(omb);
  }
  __syncthreads();
#pragma unroll
  for (int i = 0; i < 14; ++i) {
    const int q = tid + 256 * i, pln = q >> 9, rem = q & 511, tok = rem >> 5, c16 = rem & 31;
    const u32x4 v = *(const u32x4*)(stg + pln * (DTOK * 256) + tok * 256 + c16 * 8);
    *(u32x4*)(p.pl + (size_t)pln * PLANE + (size_t)(rowb + tok) * 256 + c16 * 8) = v;
  }
  __syncthreads();
}

DI void dpost_item(char* lds, const Params& p, int layer, int item) {
  const int tid = opaque(threadIdx.x);
  const int rowb = item * DTOK; int tb, T; row_info(rowb, tb, T);
  const float* mup = p.in[I_DMUP] + layer * 1088; const float* mun = p.in[I_DMUN] + layer * 1088;
  float* sg = (float*)lds;
  bf16_t* stg = (bf16_t*)(lds + 8192);
#pragma unroll
  for (int i = 0; i < 8; ++i) { const int idx = tid + 256 * i, tok = idx >> 7, c = idx & 127; sg[c * DTOK + tok] = sigmoidf_(dshift(p, mup, mun, rowb + tok, tb + tok, T, 960 + c)); }
  __syncthreads();
  const int c = tid;
  float acc[DTOK];
#pragma unroll
  for (int k = 0; k < DTOK; ++k) acc[k] = 0.f;
  float yv[DTOK], rv_[DTOK], kmv[DTOK], vv_[DTOK];
#pragma unroll
  for (int k = 0; k < DTOK; ++k) { const int row = rowb + k; const bf16_t* zd = p.z + (size_t)row * NIN + D_0; const size_t o = (size_t)row * 256 + c;
    yv[k] = bf2f(zd[c]) + bf2f(zd[256 + c]); rv_[k] = bf2f(p.pl[o]); kmv[k] = bf2f(p.pl[PLANE + o]); vv_[k] = bf2f(p.pl[2 * PLANE + o]); }
  const float* gup = p.in[I_DGUP] + (size_t)layer * 128 * 256 + c;
#pragma unroll 4
  for (int j = 0; j < 128; ++j) { const float gw = gup[j * 256];
#pragma unroll
    for (int q = 0; q < 4; ++q) { const f32x4 s0 = *(const f32x4*)(sg + j * DTOK + 4 * q);
#pragma unroll
      for (int k = 0; k < 4; ++k) acc[4 * q + k] += s0[k] * gw; } }
  const float gnw = p.in[I_DGNW][layer * 256 + c], gnb = p.in[I_DGNB][layer * 256 + c], rk = p.in[I_DRK][layer * 256 + c];
#pragma unroll
  for (int k = 0; k < DTOK; ++k) {
    const float y = yv[k];
    const float mean = wave_sum(y) * (1.0f / 64.0f); const float d = y - mean; const float var = wave_sum(d * d) * (1.0f / 64.0f);
    const float yn = d * rsqrtf(var + 64e-5f) * gnw + gnb;
    const float r = rv_[k], km = kmv[k], v = vv_[k];
    const float bonus = wave_sum(r * km * rk);
    stg[k * 256 + c] = f2bf((yn + bonus * v) * acc[k]);
  }
  __syncthreads();
#pragma unroll
  for (int i = 0; i < 2; ++i) { const int q = tid + 256 * i, tok = q >> 5, c16 = q & 31;
    const u32x4 v = *(const u32x4*)(stg + tok * 256 + c16 * 8);
    *(u32x4*)(p.pl + 4 * PLANE + (size_t)(rowb + tok) * 256 + c16 * 8) = v; }
  __syncthreads();
}

DI void rwkv_item(char* lds, const Params& p, int seq, int head, int dir, int half) {
  int row0, T; seq_info(seq, row0, T);
  const int tid = opaque(threadIdx.x), kc = tid & 7, vrow = half * 32 + (tid >> 3);
  float* st = (float*)lds;
  f32x2 S[4];
#pragma unroll
  for (int j = 0; j < 4; ++j) S[j] = (f32x2){0.f, 0.f};
  const int nchunk = T >> 4;
  u32x4 rg[3];
  const int tsel = tid >> 7, srem = tid & 127, sstep = srem >> 3, sc8 = srem & 7;
#define RW_GLOAD(c) do { _Pragma("unroll") for (int i_ = 0; i_ < 3; ++i_) { const int tens_ = tsel + 2 * i_; \
      const int plane_ = tens_ == 0 ? (dir ? 6 : 5) : tens_ == 1 ? 3 : tens_ == 2 ? 4 : tens_ == 3 ? 1 : tens_ == 4 ? 0 : 2; \
      const int t_ = dir ? (T - 1 - ((c) * 16 + sstep)) : ((c) * 16 + sstep); \
      rg[i_] = *(const u32x4*)(p.pl + (size_t)plane_ * PLANE + (size_t)(row0 + t_) * 256 + head * 64 + sc8 * 8); } } while (0)
#define RW_LSTORE(buf) do { _Pragma("unroll") for (int i_ = 0; i_ < 3; ++i_) { const int tens_ = tsel + 2 * i_; \
      f32x4 a_ = {bflo(rg[i_].x), bfhi(rg[i_].x), bflo(rg[i_].y), bfhi(rg[i_].y)}, b_ = {bflo(rg[i_].z), bfhi(rg[i_].z), bflo(rg[i_].w), bfhi(rg[i_].w)}; \
      if (tens_ == 0) { a_ = 1.0f - a_; b_ = 1.0f - b_; } \
      float* d_ = st + (((buf) * 16 + sstep) * 6 + tens_) * 64 + sc8 * 8; *(f32x4*)d_ = a_; *(f32x4*)(d_ + 4) = b_; } } while (0)
  __builtin_amdgcn_s_setprio(3);
  RW_GLOAD(0); RW_LSTORE(0); __syncthreads();
  bf16_t* ybase = p.z + (size_t)row0 * NIN + D_0 + dir * 256 + head * 64 + half * 32;
  for (int c = 0; c < nchunk; ++c) {
    if (c + 1 < nchunk) RW_GLOAD(c + 1);
    const float* sb = st + (c & 1) * (16 * 384);
    unsigned* yb = (unsigned*)(lds + 49152) + (c & 1) * 256;
    if (c > 0 && tid < 64) {
      const int sp = tid >> 2, part = tid & 3, tt = (c - 1) * 16 + sp; const int t_ = dir ? (T - 1 - tt) : tt;
      const u32x4 v = *(const u32x4*)((unsigned*)(lds + 49152) + ((c - 1) & 1) * 256 + sp * 16 + part * 4);
      *(u32x4*)(ybase + (size_t)t_ * NIN + part * 8) = v; }
#define RW_FETCH(S_, s_) do { const float* q_ = sb + (s_) * 384 + kc * 8; \
      S_##w0 = *(const f32x4*)(q_); S_##w1 = *(const f32x4*)(q_ + 4); S_##n0 = *(const f32x4*)(q_ + 64); S_##n1 = *(const f32x4*)(q_ + 68); \
      S_##b0 = *(const f32x4*)(q_ + 128); S_##b1 = *(const f32x4*)(q_ + 132); S_##k0 = *(const f32x4*)(q_ + 192); S_##k1 = *(const f32x4*)(q_ + 196); \
      S_##r0 = *(const f32x4*)(q_ + 256); S_##r1 = *(const f32x4*)(q_ + 260); S_##vv = sb[(s_) * 384 + 320 + vrow]; } while (0)
#define LO2(x) ((f32x2){(x)[0], (x)[1]})
#define HI2(x) ((f32x2){(x)[2], (x)[3]})
#define RW_STEP(S_, s_) do { \
      f32x2 a2 = S[0] * LO2(S_##n0); a2 += S[1] * HI2(S_##n0); a2 += S[2] * LO2(S_##n1); a2 += S[3] * HI2(S_##n1); \
      const float sa = red8(a2.x + a2.y); const float vx = S_##vv; \
      S[0] = S[0] * LO2(S_##w0) + (LO2(S_##b0) * sa + LO2(S_##k0) * vx); S[1] = S[1] * HI2(S_##w0) + (HI2(S_##b0) * sa + HI2(S_##k0) * vx); \
      S[2] = S[2] * LO2(S_##w1) + (LO2(S_##b1) * sa + LO2(S_##k1) * vx); S[3] = S[3] * HI2(S_##w1) + (HI2(S_##b1) * sa + HI2(S_##k1) * vx); \
      f32x2 y2 = S[0] * LO2(S_##r0); y2 += S[1] * HI2(S_##r0); y2 += S[2] * LO2(S_##r1); y2 += S[3] * HI2(S_##r1); \
      const float y = red8(y2.x + y2.y); const float yn = DPPF(y, 0x128);     \
      if ((tid & 15) == 0) yb[(s_) * 16 + (tid >> 4)] = pk(y, yn); } while (0)
    f32x4 Aw0, Aw1, An0, An1, Ab0, Ab1, Ak0, Ak1, Ar0, Ar1; float Avv;
    f32x4 Bw0, Bw1, Bn0, Bn1, Bb0, Bb1, Bk0, Bk1, Br0, Br1; float Bvv;
    RW_FETCH(A, 0);
#pragma unroll 2
    for (int s = 0; s < 16; s += 2) {
      RW_FETCH(B, s + 1);
      RW_STEP(A, s);
      if (s + 2 < 16) RW_FETCH(A, s + 2);
      RW_STEP(B, s + 1);
    }
#undef RW_FETCH
#undef RW_STEP
    if (c + 1 < nchunk) RW_LSTORE((c + 1) & 1);
    __syncthreads();
  }
#undef RW_GLOAD
#undef RW_LSTORE
  if (tid < 64) { const int c = nchunk; const int sp = tid >> 2, part = tid & 3, tt = (c - 1) * 16 + sp; const int t_ = dir ? (T - 1 - tt) : tt;
    const u32x4 v = *(const u32x4*)((unsigned*)(lds + 49152) + ((c - 1) & 1) * 256 + sp * 16 + part * 4);
    *(u32x4*)(ybase + (size_t)t_ * NIN + part * 8) = v; }
  __syncthreads();
  __builtin_amdgcn_s_setprio(0);
}

template <int MODE>
DI void attn_item(char* lds, const Params& p, int layer, int seq, int head, int qt) {
  const int tid = opaque(threadIdx.x), lane = tid & 63, w = tid >> 6, l31 = lane & 31, h = lane >> 5;
  layer = opaque_s(layer); seq = opaque_s(seq); head = opaque_s(head); qt = opaque_s(qt);
  int row0, T; seq_info(seq, row0, T);
  const int QC = (MODE == 0 ? A_Q : MODE == 1 ? B_Q : C_Q) + head * 64;
  const int KC = MODE == 0 ? A_K + (head >> 1) * 64 : MODE == 1 ? B_K + head * 64 : C_K + head * 64;
  const int VC = MODE == 0 ? A_V + (head >> 1) * 64 : MODE == 1 ? B_V + head * 64 : C_V + head * 64;
  const int qw0 = qt * 128 + w * 32, qi = qw0 + l31;
  bf16_t* zq = p.z + (size_t)(row0 + qi) * NIN + QC;
  bf16x8 qf[4];
#pragma unroll
  for (int s = 0; s < 4; ++s) qf[s] = *(const bf16x8*)(zq + s * 16 + h * 8);
  const int srow = tid >> 3, sc8 = tid & 7;
  const bf16_t* kbase = p.z + (size_t)(row0 + srow) * NIN + KC + sc8 * 8;
  const bf16_t* vbase = p.z + (size_t)(row0 + srow) * NIN + VC + sc8 * 8;
  u32x4 rk[2][2], rv[2][2];
  const int nt = T >> 6;
  const int prow = (l31 & 19) | ((l31 & 4) << 1) | ((l31 & 8) >> 1);
#define AT_GLOAD(t, S) do { _Pragma("unroll") for (int i_ = 0; i_ < 2; ++i_) { const size_t off_ = (size_t)((t) * 64 + 32 * i_) * NIN; rk[S][i_] = *(const u32x4*)(kbase + off_); rv[S][i_] = *(const u32x4*)(vbase + off_); } } while (0)
#define AT_LSTORE(buf, S) do { char* ks_ = lds + (buf) * 18432; char* vs_ = ks_ + 9216; \
    _Pragma("unroll") for (int i_ = 0; i_ < 2; ++i_) { *(u32x4*)(ks_ + (srow + 32 * i_) * PITCH + sc8 * 16) = rk[S][i_]; *(u32x4*)(vs_ + (srow + 32 * i_) * PITCH + sc8 * 16) = rv[S][i_]; } } while (0)
  constexpr int NMAP = (MODE == 1) ? 2 : 1;
  f32x16 o[NMAP][2];
  float m_run[NMAP], l_run[NMAP];
#pragma unroll
  for (int a = 0; a < NMAP; ++a) { m_run[a] = -INFINITY; l_run[a] = 0.f;
#pragma unroll
    for (int b = 0; b < 2; ++b)
#pragma unroll
      for (int i = 0; i < 16; ++i) o[a][b][i] = 0.f; }
  float lf = 0.f, lb = 0.f;
  if (MODE == 2) { lf = log2f(1.0f - exp2f(-5.0f - (float)head)); lb = log2f(1.0f - exp2f(-5.0f - (float)(3 - head))); }
  auto body = [&](const char* ks, const char* vs, const int t) __attribute__((always_inline)) {
#pragma unroll
    for (int mp = 0; mp < NMAP; ++mp) {
      f32x16 st[2];
#pragma unroll
      for (int kf = 0; kf < 2; ++kf) {
#pragma unroll
        for (int i = 0; i < 16; ++i) st[kf][i] = 0.f;
        if (MODE == 1) {
#pragma unroll
          for (int s = 0; s < 2; ++s) { const bf16x8 kfr = *(const bf16x8*)(ks + (kf * 32 + prow) * PITCH + (mp * 2 + s) * 32 + h * 16); st[kf] = MFMA32(kfr, qf[mp * 2 + s], st[kf]); }
        } else {
#pragma unroll
          for (int s = 0; s < 4; ++s) { const bf16x8 kfr = *(const bf16x8*)(ks + (kf * 32 + prow) * PITCH + s * 32 + h * 16); st[kf] = MFMA32(kfr, qf[s], st[kf]); }
        }
      }
      if (MODE == 2) {
        const int k0 = t * 64;
        const float dbase = (float)(qi - k0 - 8 * h);
        if (k0 + 63 < qw0) {
#pragma unroll
          for (int kf = 0; kf < 2; ++kf)
#pragma unroll
            for (int i = 0; i < 16; ++i) { const float cc = (float)(32 * kf + (i & 3) + 4 * ((i >> 2) & 1) + 16 * ((i >> 3) & 1)); st[kf][i] *= fexp2(lf * (dbase - cc)); }
        } else if (k0 > qw0 + 31) {
#pragma unroll
          for (int kf = 0; kf < 2; ++kf)
#pragma unroll
            for (int i = 0; i < 16; ++i) { const float cc = (float)(32 * kf + (i & 3) + 4 * ((i >> 2) & 1) + 16 * ((i >> 3) & 1)); st[kf][i] *= fexp2(lb * (cc - dbase)); }
        } else {
#pragma unroll
          for (int kf = 0; kf < 2; ++kf)
#pragma unroll
            for (int i = 0; i < 16; ++i) { const float cc = (float)(32 * kf + (i & 3) + 4 * ((i >> 2) & 1) + 16 * ((i >> 3) & 1)); const float d = dbase - cc;
              float dd = fexp2(fminf(lf * d, -lb * d)); if (d == 0.f) dd = 2.0f; st[kf][i] *= dd; }
        }
      } else {
        float mx = st[0][0];
#pragma unroll
        for (int kf = 0; kf < 2; ++kf)
#pragma unroll
          for (int i = 0; i < 16; ++i) mx = fmaxf(mx, st[kf][i]);
        mx = fmaxf(mx, __shfl_xor(mx, 32));
        const float mn = fmaxf(m_run[mp], mx); const float alpha = fexp2(m_run[mp] - mn); m_run[mp] = mn;
        float ps = 0.f;
#pragma unroll
        for (int kf = 0; kf < 2; ++kf)
#pragma unroll
          for (int i = 0; i < 16; ++i) { st[kf][i] = fexp2(st[kf][i] - mn); ps += st[kf][i]; }
        l_run[mp] = l_run[mp] * alpha + ps;
#pragma unroll
        for (int df = 0; df < 2; ++df) o[mp][df] *= alpha;
      }
      bf16x8 pf[4];
#pragma unroll
      for (int kf = 0; kf < 2; ++kf)
#pragma unroll
        for (int s2 = 0; s2 < 2; ++s2) { u32x4 u; u.x = pk(st[kf][8 * s2], st[kf][8 * s2 + 1]); u.y = pk(st[kf][8 * s2 + 2], st[kf][8 * s2 + 3]);
          u.z = pk(st[kf][8 * s2 + 4], st[kf][8 * s2 + 5]); u.w = pk(st[kf][8 * s2 + 6], st[kf][8 * s2 + 7]); pf[kf * 2 + s2] = __builtin_bit_cast(bf16x8, u); }
#pragma unroll
      for (int df = 0; df < 2; ++df)
#pragma unroll
        for (int ksx = 0; ksx < 4; ++ksx) { const bf16x8 vfr = *(const bf16x8*)(vs + (df * 32 + l31) * PITCH + ksx * 32 + h * 16); o[mp][df] = MFMA32(vfr, pf[ksx], o[mp][df]); }
    }
  };
  if constexpr (MODE == 1) {
    AT_GLOAD(0, 0); AT_LSTORE(0, 0); __syncthreads();
#pragma unroll 1
    for (int t = 0; t < nt; ++t) {
      if (t + 1 < nt) AT_GLOAD(t + 1, 0);
      const char* ks = lds + (t & 1) * 18432;
      body(ks, ks + 9216, t);
      if (t + 1 < nt) AT_LSTORE((t + 1) & 1, 0);
      __syncthreads();
    }
  } else {
    AT_GLOAD(0, 0); AT_GLOAD(1, 1); AT_LSTORE(0, 0); __syncthreads();
#pragma unroll 1
    for (int t2 = 0; t2 < nt; t2 += 2) {
      if (t2 + 2 < nt) AT_GLOAD(t2 + 2, 0);
      body(lds, lds + 9216, t2);
      AT_LSTORE(1, 1);
      __syncthreads();
      if (t2 + 3 < nt) AT_GLOAD(t2 + 3, 1);
      body(lds + 18432, lds + 18432 + 9216, t2 + 1);
      if (t2 + 2 < nt) AT_LSTORE(0, 0);
      __syncthreads();
    }
  }
#undef AT_GLOAD
#undef AT_LSTORE
  f32x16 r[2];
  if (MODE == 0) {
    const float l = l_run[0] + __shfl_xor(l_run[0], 32); const float inv = 1.0f / l;
#pragma unroll
    for (int df = 0; df < 2; ++df) r[df] = o[0][df] * inv;
  } else if (MODE == 1) {
    const float* lp = p.in[I_BLAM] + layer * 128;
    float s01 = 0.f, s23 = 0.f;
    for (int i = 0; i < 32; ++i) { s01 += lp[i] * lp[32 + i]; s23 += lp[64 + i] * lp[96 + i]; }
    const float lam_init = 0.8f - 0.6f * expf(-0.3f * (float)layer);
    const float lam = expf(s01) - expf(s23) + lam_init;
    const float l0 = l_run[0] + __shfl_xor(l_run[0], 32), l1 = l_run[NMAP - 1] + __shfl_xor(l_run[NMAP - 1], 32);
    const float i0 = 1.0f / l0, i1 = lam / l1;
    float ss = 0.f;
#pragma unroll
    for (int df = 0; df < 2; ++df) { r[df] = o[0][df] * i0 - o[NMAP - 1][df] * i1;
#pragma unroll
      for (int i = 0; i < 16; ++i) ss += r[df][i] * r[df][i]; }
    ss += __shfl_xor(ss, 32);
    const float rs = rsqrtf(ss * (1.0f / 64.0f) + EPS) * (1.0f - lam_init);
    const float* sg = p.in[I_BSUB] + layer * 64;
#pragma unroll
    for (int df = 0; df < 2; ++df)
#pragma unroll
      for (int i = 0; i < 16; ++i) r[df][i] *= rs * sg[df * 32 + (i & 3) + 8 * (i >> 2) + 4 * h];
  } else {
    float ss = 0.f;
#pragma unroll
    for (int df = 0; df < 2; ++df)
#pragma unroll
      for (int i = 0; i < 16; ++i) ss += o[0][df][i] * o[0][df][i];
    ss += __shfl_xor(ss, 32);
    const float rs = rsqrtf(ss * (1.0f / 64.0f) + EPS);
    const float* gg = p.in[I_CGN] + layer * 256 + head * 64;
    const bf16_t* zg = p.z + (size_t)(row0 + qi) * NIN + C_G + head * 64;
#pragma unroll
    for (int df = 0; df < 2; ++df)
#pragma unroll
      for (int g = 0; g < 4; ++g) { const u32x2 gw = *(const u32x2*)(zg + df * 32 + 8 * g + 4 * h);
        const float gv[4] = {bflo(gw.x), bfhi(gw.x), bflo(gw.y), bfhi(gw.y)};
#pragma unroll
        for (int e = 0; e < 4; ++e) { const float x = gv[e]; r[df][4 * g + e] = o[0][df][4 * g + e] * rs * gg[df * 32 + 8 * g + 4 * h + e] * (x / (1.0f + __expf(-x))); } }
  }
#pragma unroll
  for (int df = 0; df < 2; ++df)
#pragma unroll
    for (int g = 0; g < 4; ++g) { u32x2 v; v.x = pk(r[df][4 * g], r[df][4 * g + 1]); v.y = pk(r[df][4 * g + 2], r[df][4 * g + 3]); *(u32x2*)(zq + df * 32 + 8 * g + 4 * h) = v; }
}

template <class Epi>
DI void gemm_tile2(char* lds, const ASrc& A, const bf16_t* __restrict__ Bt, int K, int m0, int n0, const Epi& epi) {
  const int tid = opaque(threadIdx.x), lane = tid & 63, w = __builtin_amdgcn_readfirstlane(tid >> 6), wr = w >> 1, wc = w & 1, l31 = lane & 31, h = lane >> 5;
  const int nk = K >> 5, smask = (1 << A.shift) - 1;
  LASP char* ldsl = (LASP char*)lds;
  f32x16 acc[2][4];
#pragma unroll
  for (int a = 0; a < 2; ++a)
#pragma unroll
    for (int b = 0; b < 4; ++b)
#pragma unroll
      for (int i = 0; i < 16; ++i) acc[a][b][i] = 0.f;
  const int lrow = lane >> 2, lslot = lane & 3;
  int goffA[2], goffB[4];
#pragma unroll
  for (int i = 0; i < 2; ++i) { const int r = (2 * w + i) * 16 + lrow, c = lslot ^ ((r >> 2) & 3); goffA[i] = (r << 2) | c; }
#pragma unroll
  for (int i = 0; i < 4; ++i) { const int r = (4 * w + i) * 16 + lrow, c = lslot ^ ((r >> 2) & 3); goffB[i] = r * K + c * 8; }
#define G2_ISSUE(kt, st) do { const int k0_ = (kt) << 5, seg_ = k0_ >> A.shift, kk_ = k0_ & smask; \
    const bf16_t* bp_ = seg_ == 0 ? A.b0 : seg_ == 1 ? A.b1 : seg_ == 2 ? A.b2 : A.b3; const int st_ = seg_ == 0 ? A.s0 : seg_ == 1 ? A.s1 : seg_ == 2 ? A.s2 : A.s3; \
    _Pragma("unroll") for (int i_ = 0; i_ < 2; ++i_) { \
      const bf16_t* ga_ = bp_ + (size_t)(m0 + (goffA[i_] >> 2)) * st_ + kk_ + (goffA[i_] & 3) * 8; \
      __builtin_amdgcn_global_load_lds((const unsigned*)ga_, (LASP unsigned*)(ldsl + (st) * 24576 + (2 * w + i_) * 1024), 16, 0, 0); } \
    _Pragma("unroll") for (int i_ = 0; i_ < 4; ++i_) { \
      const bf16_t* gb_ = Bt + (size_t)n0 * K + goffB[i_] + k0_; \
      __builtin_amdgcn_global_load_lds((const unsigned*)gb_, (LASP unsigned*)(ldsl + (st) * 24576 + 8192 + (4 * w + i_) * 1024), 16, 0, 0); } } while (0)
  const int xr = (l31 >> 2) & 3;
  int coff[2];
#pragma unroll
  for (int s = 0; s < 2; ++s) coff[s] = ((2 * s + h) ^ xr) * 16;
#define G2_COMPUTE(st) do { const char* as = lds + (st) * 24576; const char* bs = as + 8192; \
    bf16x8 af[2][2], wf[2][4]; \
    _Pragma("unroll") for (int s = 0; s < 2; ++s) { \
      _Pragma("unroll") for (int mf = 0; mf < 2; ++mf) af[s][mf] = *(const bf16x8*)(as + (wr * 64 + mf * 32 + l31) * 64 + coff[s]); \
      _Pragma("unroll") for (int nf = 0; nf < 4; ++nf) wf[s][nf] = *(const bf16x8*)(bs + (wc * 128 + nf * 32 + l31) * 64 + coff[s]); } \
    __builtin_amdgcn_sched_barrier(0); __builtin_amdgcn_s_setprio(1); \
    _Pragma("unroll") for (int s = 0; s < 2; ++s) \
      _Pragma("unroll") for (int mf = 0; mf < 2; ++mf) _Pragma("unroll") for (int nf = 0; nf < 4; ++nf) acc[mf][nf] = MFMA32(wf[s][nf], af[s][mf], acc[mf][nf]); \
    __builtin_amdgcn_s_setprio(0); __builtin_amdgcn_sched_barrier(0); } while (0)
  G2_ISSUE(0, 0);
  for (int kt = 0; kt < nk; kt += 2) {
    asm volatile("s_waitcnt vmcnt(0)" ::: "memory"); __syncthreads();
    G2_ISSUE(kt + 1, 1);
    G2_COMPUTE(0);
    asm volatile("s_waitcnt vmcnt(0)" ::: "memory"); __syncthreads();
    if (kt + 2 < nk) G2_ISSUE(kt + 2, 0);
    G2_COMPUTE(1);
  }
  __syncthreads();
#pragma unroll
  for (int hf = 0; hf < 2; ++hf) {
    f32x16 t[2][2];
#pragma unroll
    for (int mf = 0; mf < 2; ++mf) { t[mf][0] = acc[mf][2 * hf]; t[mf][1] = acc[mf][2 * hf + 1]; }
    epi(t, m0 + wr * 64, n0 + wc * 128 + hf * 64, n0, wc, l31, h);
  }
  __syncthreads();
#undef G2_ISSUE
#undef G2_COMPUTE
}

template <class Epi>
DI void gemm_phase2(char* lds, const ASrc& A, const bf16_t* Bt, int K, int ntn, const Epi& epi) {
  const int xcd = blockIdx.x & 7, j = blockIdx.x >> 3, nloc = gridDim.x >> 3, per = 48 * ntn, grp = 8 * ntn;
  for (int li = j; li < per; li += nloc) {
    const int sg = li / grp, wi = li - sg * grp, nt = wi >> 3, mt = xcd * 48 + sg * 8 + (wi & 7);
    gemm_tile2(lds, A, Bt, K, mt * 128, nt * 256, epi);
  }
}

template <int MODE>
DI void attn3_item(char* lds, const Params& p, int layer, int seq, int head, int qt) {
  const int tid = opaque(threadIdx.x), lane = tid & 63, w = tid >> 6, l31 = lane & 31, h = lane >> 5;
  layer = opaque_s(layer); seq = opaque_s(seq); head = opaque_s(head); qt = opaque_s(qt);
  int row0, T; seq_info(seq, row0, T);
  const int QC = (MODE == 0 ? A_Q : C_Q) + head * 64;
  const int KC = MODE == 0 ? A_K + (head >> 1) * 64 : C_K + head * 64;
  const int VC = MODE == 0 ? A_V + (head >> 1) * 64 : C_V + head * 64;
  const int qw0 = qt * 256 + w * 64;
  bf16x8 qf[2][4];
#pragma unroll
  for (int qi = 0; qi < 2; ++qi)
#pragma unroll
    for (int s = 0; s < 4; ++s) qf[qi][s] = *(const bf16x8*)(p.z + (size_t)(row0 + qw0 + qi * 32 + l31) * NIN + QC + s * 16 + h * 8);
  const int srow = tid >> 3, sc8 = tid & 7;
  const bf16_t* kbase = p.z + (size_t)(row0 + srow) * NIN + KC + sc8 * 8;
  const bf16_t* vbase = p.z + (size_t)(row0 + srow) * NIN + VC + sc8 * 8;
  u32x4 rk[2], rv[2];
  const int nt = T >> 6;
  const int prow = (l31 & 19) | ((l31 & 4) << 1) | ((l31 & 8) >> 1);
#define A3_GLOAD(t) do { _Pragma("unroll") for (int i_ = 0; i_ < 2; ++i_) { const size_t off_ = (size_t)((t) * 64 + 32 * i_) * NIN; rk[i_] = *(const u32x4*)(kbase + off_); rv[i_] = *(const u32x4*)(vbase + off_); } } while (0)
#define A3_LSTORE(buf) do { char* ks_ = lds + (buf) * 18432; char* vs_ = ks_ + 9216; \
    _Pragma("unroll") for (int i_ = 0; i_ < 2; ++i_) { *(u32x4*)(ks_ + (srow + 32 * i_) * PITCH + sc8 * 16) = rk[i_]; *(u32x4*)(vs_ + (srow + 32 * i_) * PITCH + sc8 * 16) = rv[i_]; } } while (0)
  f32x16 o[2][2];
  float m_run[2], l_run[2];
#pragma unroll
  for (int a = 0; a < 2; ++a) { m_run[a] = -INFINITY; l_run[a] = 0.f;
#pragma unroll
    for (int b = 0; b < 2; ++b)
#pragma unroll
      for (int i = 0; i < 16; ++i) o[a][b][i] = 0.f; }
  float lf = 0.f, lb = 0.f;
  if (MODE == 2) { lf = log2f(1.0f - exp2f(-5.0f - (float)head)); lb = log2f(1.0f - exp2f(-5.0f - (float)(3 - head))); }
  A3_GLOAD(0); A3_LSTORE(0); __syncthreads();
#pragma unroll 1
  for (int t = 0; t < nt; ++t) {
    if (t + 1 < nt) A3_GLOAD(t + 1);
    const char* ks = lds + (t & 1) * 18432; const char* vs = ks + 9216;
    f32x16 st[2][2];
#pragma unroll
    for (int kf = 0; kf < 2; ++kf) {
#pragma unroll
      for (int qi = 0; qi < 2; ++qi)
#pragma unroll
        for (int i = 0; i < 16; ++i) st[qi][kf][i] = 0.f;
#pragma unroll
      for (int s = 0; s < 4; ++s) { const bf16x8 kfr = *(const bf16x8*)(ks + (kf * 32 + prow) * PITCH + s * 32 + h * 16);
#pragma unroll
        for (int qi = 0; qi < 2; ++qi) st[qi][kf] = MFMA32(kfr, qf[qi][s], st[qi][kf]); }
    }
    __builtin_amdgcn_sched_barrier(0);
#pragma unroll
    for (int qi = 0; qi < 2; ++qi) {
      bf16x8 pf[4];
      if (MODE == 2) {
        const int k0 = t * 64, qb = qw0 + qi * 32;
        const float dbase = (float)(qb + l31 - k0 - 8 * h);
        if (k0 + 63 < qb) {
#pragma unroll
          for (int kf = 0; kf < 2; ++kf)
#pragma unroll
            for (int i = 0; i < 16; ++i) { const float cc = (float)(32 * kf + (i & 3) + 4 * ((i >> 2) & 1) + 16 * ((i >> 3) & 1)); st[qi][kf][i] *= fexp2(lf * (dbase - cc)); }
        } else if (k0 > qb + 31) {
#pragma unroll
          for (int kf = 0; kf < 2; ++kf)
#pragma unroll
            for (int i = 0; i < 16; ++i) { const float cc = (float)(32 * kf + (i & 3) + 4 * ((i >> 2) & 1) + 16 * ((i >> 3) & 1)); st[qi][kf][i] *= fexp2(lb * (cc - dbase)); }
        } else {
#pragma unroll
          for (int kf = 0; kf < 2; ++kf)
#pragma unroll
            for (int i = 0; i < 16; ++i) { const float cc = (float)(32 * kf + (i & 3) + 4 * ((i >> 2) & 1) + 16 * ((i >> 3) & 1)); const float d = dbase - cc;
              float dd = fexp2(fminf(lf * d, -lb * d)); if (d == 0.f) dd = 2.0f; st[qi][kf][i] *= dd; }
        }
      } else {
        float mx = st[qi][0][0];
#pragma unroll
        for (int kf = 0; kf < 2; ++kf)
#pragma unroll
          for (int i = 0; i < 16; ++i) mx = fmaxf(mx, st[qi][kf][i]);
        mx = fmaxf(mx, __shfl_xor(mx, 32));
        const float mn = fmaxf(m_run[qi], mx); const float alpha = fexp2(m_run[qi] - mn); m_run[qi] = mn;
        float ps = 0.f;
#pragma unroll
        for (int kf = 0; kf < 2; ++kf)
#pragma unroll
          for (int i = 0; i < 16; ++i) { st[qi][kf][i] = fexp2(st[qi][kf][i] - mn); ps += st[qi][kf][i]; }
        l_run[qi] = l_run[qi] * alpha + ps;
#pragma unroll
        for (int df = 0; df < 2; ++df) o[qi][df] *= alpha;
      }
#pragma unroll
      for (int kf = 0; kf < 2; ++kf)
#pragma unroll
        for (int s2 = 0; s2 < 2; ++s2) { u32x4 u; u.x = pk(st[qi][kf][8 * s2], st[qi][kf][8 * s2 + 1]); u.y = pk(st[qi][kf][8 * s2 + 2], st[qi][kf][8 * s2 + 3]);
          u.z = pk(st[qi][kf][8 * s2 + 4], st[qi][kf][8 * s2 + 5]); u.w = pk(st[qi][kf][8 * s2 + 6], st[qi][kf][8 * s2 + 7]); pf[kf * 2 + s2] = __builtin_bit_cast(bf16x8, u); }
#pragma unroll
      for (int df = 0; df < 2; ++df)
#pragma unroll
        for (int ksx = 0; ksx < 4; ++ksx) { const bf16x8 vfr = *(const bf16x8*)(vs + (df * 32 + l31) * PITCH + ksx * 32 + h * 16); o[qi][df] = MFMA32(vfr, pf[ksx], o[qi][df]); }
      __builtin_amdgcn_sched_barrier(0);
    }
    __builtin_amdgcn_sched_barrier(0);
    if (t + 1 < nt) A3_LSTORE((t + 1) & 1);
    __syncthreads();
  }
#undef A3_GLOAD
#undef A3_LSTORE
#pragma unroll
  for (int qi = 0; qi < 2; ++qi) {
    const int qrow = row0 + qw0 + qi * 32 + l31;
    bf16_t* zq = p.z + (size_t)qrow * NIN + QC;
    f32x16 r[2];
    if (MODE == 0) {
      const float l = l_run[qi] + __shfl_xor(l_run[qi], 32); const float inv = 1.0f / l;
#pragma unroll
      for (int df = 0; df < 2; ++df) r[df] = o[qi][df] * inv;
    } else {
      float ss = 0.f;
#pragma unroll
      for (int df = 0; df < 2; ++df)
#pragma unroll
        for (int i = 0; i < 16; ++i) ss += o[qi][df][i] * o[qi][df][i];
      ss += __shfl_xor(ss, 32);
      const float rs = rsqrtf(ss * (1.0f / 64.0f) + EPS);
      const float* gg = p.in[I_CGN] + layer * 256 + head * 64;
      const bf16_t* zg = p.z + (size_t)qrow * NIN + C_G + head * 64;
#pragma unroll
      for (int df = 0; df < 2; ++df)
#pragma unroll
        for (int g = 0; g < 4; ++g) { const u32x2 gw = *(const u32x2*)(zg + df * 32 + 8 * g + 4 * h);
          const float gv[4] = {bflo(gw.x), bfhi(gw.x), bflo(gw.y), bfhi(gw.y)};
#pragma unroll
          for (int e = 0; e < 4; ++e) { const float x = gv[e]; r[df][4 * g + e] = o[qi][df][4 * g + e] * rs * gg[df * 32 + 8 * g + 4 * h + e] * (x / (1.0f + __expf(-x))); } }
    }
#pragma unroll
    for (int df = 0; df < 2; ++df)
#pragma unroll
      for (int g = 0; g < 4; ++g) { u32x2 v; v.x = pk(r[df][4 * g], r[df][4 * g + 1]); v.y = pk(r[df][4 * g + 2], r[df][4 * g + 3]); *(u32x2*)(zq + df * 32 + 8 * g + 4 * h) = v; }
  }
}

DI void ctr_barrier(unsigned* cnt) {
  asm volatile("s_waitcnt vmcnt(0) lgkmcnt(0)" ::: "memory");
  __syncthreads();
  if (threadIdx.x == 0) {
    __builtin_amdgcn_fence(__ATOMIC_RELEASE, "agent");
    asm volatile("s_waitcnt vmcnt(0)" ::: "memory");
    const unsigned G = gridDim.x;
    const unsigned old = __hip_atomic_fetch_add(cnt, 1u, __ATOMIC_RELAXED, __HIP_MEMORY_SCOPE_AGENT);
    const unsigned gen = old / G + 1u;
    if (old + 1u == gen * G) __hip_atomic_store(cnt + 64, gen, __ATOMIC_RELAXED, __HIP_MEMORY_SCOPE_AGENT);
    else while (__hip_atomic_load(cnt + 64, __ATOMIC_RELAXED, __HIP_MEMORY_SCOPE_AGENT) < gen) __builtin_amdgcn_s_sleep(1);
    __builtin_amdgcn_fence(__ATOMIC_ACQUIRE, "agent");
    asm volatile("s_waitcnt vmcnt(0)" ::: "memory");
  }
  __syncthreads();
}

DI int next_item(int* ctr, int* sh) {
  __syncthreads();
  if (threadIdx.x == 0) *sh = atomicAdd(ctr, 1);
  __syncthreads();
  return *sh;
}
constexpr int XQ_N = 416;
DI int next_item_x(int* ctr8, int* sh) {
  __syncthreads();
  if (threadIdx.x == 0) {
    int r = -1;
    const int x0 = blockIdx.x & 7;
    for (int k = 0; k < 8; ++k) { const int x = (x0 + k) & 7; const int i = atomicAdd(ctr8 + x, 1); if (i < XQ_N) { r = (x << 16) | i; break; } }
    *sh = r;
  }
  __syncthreads();
  return *sh;
}

__global__ void __launch_bounds__(256, 2) fwd(Params p) {
  extern __shared__ __attribute__((aligned(16))) char lds[];
  __shared__ int s_item;
  cg::grid_group grid = cg::this_grid();
  const int bid = blockIdx.x, nb = gridDim.x, tid = threadIdx.x, lane = tid & 63, w = tid >> 6;
  if (bid == 0) p.ctr[tid] = 0;
  for (int i = bid * 256 + tid; i < 4096 * 32; i += nb * 256) { const int t = i >> 5, j = i & 31; const float inv = powf(10000.0f, -(float)(2 * j) / 64.0f); float sn, cs; sincosf((float)t * inv, &sn, &cs); p.tabC[i] = (f32x2){cs, sn}; }
  for (int i = bid * 256 + tid; i < 4096 * 4; i += nb * 256) { const int t = i >> 2, j = i & 3; const float inv = powf(500000.0f, -(float)(2 * j) / 8.0f); float sn, cs; sincosf((float)t * inv, &sn, &cs); p.tabB[i] = (f32x2){cs, sn}; }
  for (int i = bid * 256 + tid; i < 64 * 16; i += nb * 256) { const int t = i >> 4, j = i & 15; const float inv = powf(10000.0f, -(float)(2 * j) / 32.0f); float sn, cs; sincosf((float)t * inv, &sn, &cs); p.tabA[i] = (f32x2){cs, sn}; }
  for (int l = 0; l < 2; ++l) {
    for (int i = bid * 256 + tid; i < (NINP - NIN) * 1024; i += nb * 256) p.wtin[(size_t)l * NINP * 1024 + (size_t)NIN * 1024 + i] = 0;
    for (int tl = bid; tl < 16 * 53; tl += nb) conv_T(lds, p.in[I_WIN] + (size_t)l * 1024 * NIN, 1024, NIN, p.wtin + (size_t)l * NINP * 1024, 0, tl);
    for (int tl = bid; tl < 16 * 16; tl += nb) conv_T(lds, p.in[I_WOUT] + (size_t)l * 1024 * 1024, 1024, 1024, p.wtout + (size_t)l * 1024 * 1024, 0, tl);
  }
  bf16_t* hb = p.pl;
  for (int row = bid * 4 + opaque(w); row < MT; row += nb * 8) {
    const int rb = row + nb * 4;
    const float* xin = row < M0 ? p.in[I_XP] + (size_t)row * 1024 : p.in[I_XS] + (size_t)(row - M0) * 1024;
    if (rb < MT) { const float* xinb = rb < M0 ? p.in[I_XP] + (size_t)rb * 1024 : p.in[I_XS] + (size_t)(rb - M0) * 1024;
      row_phase2(xin, xinb, p.out + (size_t)row * 1024, p.out + (size_t)rb * 1024, nullptr, nullptr, nullptr, p.in[I_NMPRE], hb + (size_t)row * 1024, hb + (size_t)rb * 1024, lane); }
    else row_phase(xin, p.out + (size_t)row * 1024, nullptr, nullptr, p.in[I_NMPRE], hb + (size_t)row * 1024, lane);
  }
  grid.sync();
  for (int l = 0; l < 2; ++l) {
    { ASrc A; A.b0 = hb; A.b1 = hb; A.b2 = hb; A.b3 = hb; A.s0 = A.s1 = A.s2 = A.s3 = 1024; A.shift = 12;
      EpiIn e; e.z = p.z; e.lds = lds; e.qg = p.in[I_AQG] + l * 64; e.kg = p.in[I_AKG] + l * 64; e.tabA = p.tabA; e.tabB = p.tabB; e.tabC = p.tabC;
      gemm_phase2(lds, A, p.wtin + (size_t)l * NINP * 1024, 1024, 14, e); }
    ctr_barrier((unsigned*)p.ctr + 96);
    for (int it = bid; it < MT / DTOK; it += nb) dprep_item(lds, p, l, it);
    ctr_barrier((unsigned*)p.ctr + 96);
    for (;;) {
      const int it = next_item_x(p.ctr + l * 16, &s_item);
      if (it < 0) break;
      const int x = it >> 16; int i = it & 0xffff;
      if (i < 32) { const int j = i & 15; rwkv_item(lds, p, i < 16 ? x : 8 + x, (j >> 2) & 3, (j >> 1) & 1, j & 1); }
      else { i -= 32;
        if (i < 128) attn_item<1>(lds, p, l, x, i >> 5, i & 31);
        else if (i < 192) { i -= 128; attn3_item<2>(lds, p, l, x, i >> 4, i & 15); }
        else if (i < 256) { i -= 192; attn3_item<0>(lds, p, l, x, i >> 4, i & 15); }
        else if (i < 320) { i -= 256; attn_item<1>(lds, p, l, 8 + x, i >> 4, i & 15); }
        else if (i < 352) { i -= 320; attn3_item<2>(lds, p, l, 8 + x, i >> 3, i & 7); }
        else { i -= 352; attn3_item<0>(lds, p, l, 8 + x, i >> 3, i & 7); }
      }
    }
    ctr_barrier((unsigned*)p.ctr + 96);
    bf16_t* wtgu = p.pl + 5 * PLANE; bf16_t* wtd = wtgu + (size_t)2 * DFF * 1024;
    for (int it = bid; it < MT / DTOK + 3 * 704; it += nb) {
      if (it < MT / DTOK) dpost_item(lds, p, l, it);
      else { const int j = it - MT / DTOK;
        if (j < 704) conv_T(lds, p.in[I_FG] + (size_t)l * 1024 * DFF, 1024, DFF, wtgu, 1, j);
        else if (j < 1408) conv_T(lds, p.in[I_FU] + (size_t)l * 1024 * DFF, 1024, DFF, wtgu, 2, j - 704);
        else conv_T(lds, p.in[I_FD] + (size_t)l * DFF * 1024, DFF, 1024, wtd, 0, j - 1408); }
    }
    ctr_barrier((unsigned*)p.ctr + 96);
    { ASrc A; A.b0 = p.z + A_Q; A.b1 = p.z + B_Q; A.b2 = p.z + C_Q; A.b3 = p.pl + 4 * PLANE; A.s0 = A.s1 = A.s2 = NIN; A.s3 = 256; A.shift = 8;
      EpiStore e; e.out = hb; e.ldc = 1024; e.nmax = 1024; e.lds = lds;
      gemm_phase2(lds, A, p.wtout + (size_t)l * 1024 * 1024, 1024, 4, e); }
    ctr_barrier((unsigned*)p.ctr + 96);
    for (int row = bid * 4 + opaque(w); row < MT; row += nb * 8) { const int rb = row + nb * 4;
      if (rb < MT) row_phase2(p.out + (size_t)row * 1024, p.out + (size_t)rb * 1024, p.out + (size_t)row * 1024, p.out + (size_t)rb * 1024, hb + (size_t)row * 1024, hb + (size_t)rb * 1024,
                              p.in[I_NMPOST] + l * 1024, p.in[I_NFPRE] + l * 1024, hb + (size_t)row * 1024, hb + (size_t)rb * 1024, lane);
      else row_phase(p.out + (size_t)row * 1024, p.out + (size_t)row * 1024, hb + (size_t)row * 1024, p.in[I_NMPOST] + l * 1024, p.in[I_NFPRE] + l * 1024, hb + (size_t)row * 1024, lane); }
    ctr_barrier((unsigned*)p.ctr + 96);
    { ASrc A; A.b0 = hb; A.b1 = hb; A.b2 = hb; A.b3 = hb; A.s0 = A.s1 = A.s2 = A.s3 = 1024; A.shift = 12;
      EpiSwiGLU e; e.out = p.z; e.lds = lds;
      gemm_phase2(lds, A, wtgu, 1024, 22, e); }
    ctr_barrier((unsigned*)p.ctr + 96);
    { ASrc A; A.b0 = p.z; A.b1 = p.z; A.b2 = p.z; A.b3 = p.z; A.s0 = A.s1 = A.s2 = A.s3 = DFF; A.shift = 12;
      EpiStore e; e.out = hb; e.ldc = 1024; e.nmax = 1024; e.lds = lds;
      gemm_phase2(lds, A, wtd, DFF, 4, e); }
    ctr_barrier((unsigned*)p.ctr + 96);
    for (int row = bid * 4 + opaque(w); row < MT; row += nb * 8) { const int rb = row + nb * 4; const float* gp2 = l == 0 ? p.in[I_NMPRE] + 1024 : nullptr;
      if (rb < MT) row_phase2(p.out + (size_t)row * 1024, p.out + (size_t)rb * 1024, p.out + (size_t)row * 1024, p.out + (size_t)rb * 1024, hb + (size_t)row * 1024, hb + (size_t)rb * 1024,
                              p.in[I_NFPOST] + l * 1024, gp2, hb + (size_t)row * 1024, hb + (size_t)rb * 1024, lane);
      else row_phase(p.out + (size_t)row * 1024, p.out + (size_t)row * 1024, hb + (size_t)row * 1024, p.in[I_NFPOST] + l * 1024, gp2, hb + (size_t)row * 1024, lane); }
    if (l == 0) ctr_barrier((unsigned*)p.ctr + 96);
  }
}

extern "C" void kernel_launch(void* const* d_in, const int* in_sizes, int n_in, void* d_out, int out_size,
                              void* d_ws, size_t ws_size, hipStream_t stream) {
  static int grid_blocks = 0;
  if (!grid_blocks) {
    int dev = 0, cus = 0, per_cu = 0;
    hipGetDevice(&dev);
    hipDeviceGetAttribute(&cus, hipDeviceAttributeMultiprocessorCount, dev);
    hipFuncSetAttribute((const void*)fwd, hipFuncAttributeMaxDynamicSharedMemorySize, LDS_BYTES);
    hipOccupancyMaxActiveBlocksPerMultiprocessor(&per_cu, fwd, 256, LDS_BYTES);
    if (per_cu > 2) per_cu = 2;
    if (per_cu < 1) per_cu = 1;
    grid_blocks = cus * per_cu;
  }
  Params p{};
  for (int i = 0; i < 28; ++i) p.in[i] = (const float*)d_in[i];
  p.out = (float*)d_out;
  char* ws = (char*)d_ws;
  size_t off = 0;
  p.z = (bf16_t*)(ws + off); off += (size_t)MT * NIN * 2;
  p.pl = (bf16_t*)(ws + off); off += 7 * PLANE * 2;
  p.wtin = (bf16_t*)(ws + off); off += (size_t)2 * NINP * 1024 * 2;
  p.wtout = (bf16_t*)(ws + off); off += (size_t)2 * 1024 * 1024 * 2;
  p.tabC = (f32x2*)(ws + off); off += (size_t)4096 * 32 * 8;
  p.tabB = (f32x2*)(ws + off); off += (size_t)4096 * 4 * 8;
  p.tabA = (f32x2*)(ws + off); off += (size_t)64 * 16 * 8;
  p.ctr = (int*)(ws + off); off += 1024;
  if (off > ws_size) fprintf(stderr, "workspace too small: need %zu have %zu\n", off, ws_size);
  void* args[] = {&p};
  hipError_t e = hipLaunchCooperativeKernel((void*)fwd, dim3(grid_blocks), dim3(256), args, LDS_BYTES, stream);
  if (e != hipSuccess) fprintf(stderr, "coop launch failed: %s (grid %d)\n", hipGetErrorString(e), grid_blocks);
}
```

```cpp
#include <hip/hip_runtime.h>
#include <hip/hip_cooperative_groups.h>
#include <cstdio>
#include <cstdint>
namespace cg = cooperative_groups;

#define DI __device__ __forceinline__
typedef unsigned short bf16_t;
typedef short bf16x8 __attribute__((ext_vector_type(8)));
typedef float f32x2 __attribute__((ext_vector_type(2)));
typedef float f32x4 __attribute__((ext_vector_type(4)));
typedef float f32x16 __attribute__((ext_vector_type(16)));
typedef unsigned u32x2 __attribute__((ext_vector_type(2)));
typedef unsigned u32x4 __attribute__((ext_vector_type(4)));
typedef __bf16 bf16x2_t __attribute__((ext_vector_type(2)));

constexpr int M0 = 32768, MT = 49152, DM = 1024, NIN = 3392, NINP = 3584, DFF = 2816;
constexpr int A_Q = 0, A_K = 256, A_V = 384, B_Q = 512, B_K = 768, B_V = 1024, C_Q = 1280, C_K = 1536, C_V = 1792, C_G = 2048, D_0 = 2304;
constexpr int PITCH = 144;
constexpr size_t PLANE = (size_t)MT * 256;
constexpr int LDS_BYTES = 73728;
constexpr float LOG2E = 1.4426950408889634f;
constexpr float EPS = 1e-6f;

enum { I_XP = 0, I_XS, I_NMPRE, I_NMPOST, I_NFPRE, I_NFPOST, I_WIN, I_WOUT, I_AQG, I_AKG, I_BLAM, I_BSUB, I_CGN, I_DMUP, I_DMUN, I_DW0, I_DWUP,
       I_DA0, I_DAUP, I_DGUP, I_DKK, I_DKA, I_DRK, I_DGNW, I_DGNB, I_FG, I_FU, I_FD };

struct Params {
  const float* in[28];
  float* out;
  bf16_t* z;
  bf16_t* pl;
  bf16_t* wtin;
  bf16_t* wtout;
  f32x2* tabC;
  f32x2* tabB;
  f32x2* tabA;
  int* ctr;
};

DI int opaque(int x) { asm volatile("" : "+v"(x)); return x; }
DI int opaque_s(int x) { asm volatile("" : "+s"(x)); return x; }
DI float bf2f(bf16_t v) { return __uint_as_float(((unsigned)v) << 16); }
DI float bflo(unsigned w) { return __uint_as_float(w << 16); }
DI float bfhi(unsigned w) { return __uint_as_float(w & 0xffff0000u); }
DI unsigned pk(float lo, float hi) { f32x2 v = {lo, hi}; bf16x2_t b = __builtin_convertvector(v, bf16x2_t); return __builtin_bit_cast(unsigned, b); }
DI bf16_t f2bf(float x) { return (bf16_t)(pk(x, 0.f) & 0xffffu); }
DI float dppf(float x, const int ctrl) { return x; }
#define DPPF(x, ctrl) __int_as_float(__builtin_amdgcn_update_dpp(0, __float_as_int(x), (ctrl), 0xF, 0xF, true))
DI float wave_sum(float v) {
  v += DPPF(v, 0xB1);
  v += DPPF(v, 0x4E);
  v += DPPF(v, 0x141);
  v += DPPF(v, 0x140);
  const int vi = __float_as_int(v);
  return (__int_as_float(__builtin_amdgcn_readlane(vi, 0)) + __int_as_float(__builtin_amdgcn_readlane(vi, 16))) +
         (__int_as_float(__builtin_amdgcn_readlane(vi, 32)) + __int_as_float(__builtin_amdgcn_readlane(vi, 48)));
}
DI float dpp_xor1(float x) { return __int_as_float(__builtin_amdgcn_update_dpp(0, __float_as_int(x), 0xB1, 0xF, 0xF, true)); }
DI float dpp_xor2(float x) { return __int_as_float(__builtin_amdgcn_update_dpp(0, __float_as_int(x), 0x4E, 0xF, 0xF, true)); }
DI float dpp_hmir(float x) { return __int_as_float(__builtin_amdgcn_update_dpp(0, __float_as_int(x), 0x141, 0xF, 0xF, true)); }
DI float red8(float x) { x += dpp_xor1(x); x += dpp_xor2(x); x += dpp_hmir(x); return x; }
DI float fexp2(float x) { return __builtin_amdgcn_exp2f(x); }
DI void seq_info(int s, int& row0, int& T) { if (s < 8) { row0 = s * 4096; T = 4096; } else { row0 = M0 + (s - 8) * 2048; T = 2048; } }
DI void row_info(int r, int& t, int& T) { if (r < M0) { t = r & 4095; T = 4096; } else { t = (r - M0) & 2047; T = 2048; } }
#define MFMA32(a, b, c) __builtin_amdgcn_mfma_f32_32x32x16_bf16((a), (b), (c), 0, 0, 0)

DI void conv_T(char* lds, const float* __restrict__ W, int K, int N, bf16_t* __restrict__ Wt, int mode, int tile) {
  float* t = (float*)lds;
  const int tid0 = opaque(threadIdx.x);
  const int ntn = N >> 6, kt = tile / ntn, nt = tile - kt * ntn, k0 = kt << 6, n0 = nt << 6;
  float wv[16];
#pragma unroll
  for (int i = 0; i < 16; ++i) { const int idx = tid0 + 256 * i, k = idx >> 6, n = idx & 63; wv[i] = W[(size_t)(k0 + k) * N + n0 + n]; }
#pragma unroll
  for (int i = 0; i < 16; ++i) { const int idx = tid0 + 256 * i, k = idx >> 6, n = idx & 63; t[k * 65 + n] = wv[i]; }
  __syncthreads();
#pragma unroll 4
  for (int i = 0; i < 8; ++i) {
    const int idx = tid0 + 256 * i, n = idx >> 5, k = (idx & 31) * 2, j = n0 + n;
    const int rho = (mode == 0) ? j : ((j >> 6) * 128 + ((j >> 5) & 1) * 64 + (mode - 1) * 32 + (j & 31));
    *(unsigned*)(Wt + (size_t)rho * K + k0 + k) = pk(t[k * 65 + n], t[(k + 1) * 65 + n]);
  }
  __syncthreads();
}

DI void row_phase(const float* __restrict__ xin, float* __restrict__ xout, const bf16_t* addsrc, const float* __restrict__ gpost,
                  const float* __restrict__ gpre, bf16_t* hout, int lane_in) {
  const int lane = opaque(lane_in);
  f32x4 x[4];
#pragma unroll
  for (int i = 0; i < 4; ++i) x[i] = *(const f32x4*)(xin + i * 256 + lane * 4);
  if (addsrc) {
    f32x4 m[4]; float ss = 0.f;
#pragma unroll
    for (int i = 0; i < 4; ++i) { const u32x2 w = *(const u32x2*)(addsrc + i * 256 + lane * 4); m[i] = (f32x4){bflo(w.x), bfhi(w.x), bflo(w.y), bfhi(w.y)};
      ss += m[i][0] * m[i][0] + m[i][1] * m[i][1] + m[i][2] * m[i][2] + m[i][3] * m[i][3]; }
    ss = wave_sum(ss); const float rs = rsqrtf(ss * (1.0f / 1024.0f) + EPS);
#pragma unroll
    for (int i = 0; i < 4; ++i) { const f32x4 g = *(const f32x4*)(gpost + i * 256 + lane * 4); x[i] += m[i] * rs * g; }
  }
#pragma unroll
  for (int i = 0; i < 4; ++i) *(f32x4*)(xout + i * 256 + lane * 4) = x[i];
  if (gpre) {
    float ss = 0.f;
#pragma unroll
    for (int i = 0; i < 4; ++i) ss += x[i][0] * x[i][0] + x[i][1] * x[i][1] + x[i][2] * x[i][2] + x[i][3] * x[i][3];
    ss = wave_sum(ss); const float rs = rsqrtf(ss * (1.0f / 1024.0f) + EPS);
#pragma unroll
    for (int i = 0; i < 4; ++i) { const f32x4 g = *(const f32x4*)(gpre + i * 256 + lane * 4); const f32x4 hv = x[i] * rs * g;
      u32x2 w; w.x = pk(hv[0], hv[1]); w.y = pk(hv[2], hv[3]); *(u32x2*)(hout + i * 256 + lane * 4) = w; }
  }
}

DI void row_phase2(const float* __restrict__ xinA, const float* __restrict__ xinB, float* __restrict__ xoutA, float* __restrict__ xoutB, const bf16_t* addA, const bf16_t* addB,
                   const float* __restrict__ gpost, const float* __restrict__ gpre, bf16_t* houtA, bf16_t* houtB, int lane_in) {
  const int lane = opaque(lane_in);
  f32x4 x[2][4]; u32x2 aw[2][4];
#pragma unroll
  for (int i = 0; i < 4; ++i) { x[0][i] = *(const f32x4*)(xinA + i * 256 + lane * 4); x[1][i] = *(const f32x4*)(xinB + i * 256 + lane * 4); }
  if (addA) {
#pragma unroll
    for (int i = 0; i < 4; ++i) { aw[0][i] = *(const u32x2*)(addA + i * 256 + lane * 4); aw[1][i] = *(const u32x2*)(addB + i * 256 + lane * 4); }
#pragma unroll
    for (int r = 0; r < 2; ++r) {
      f32x4 m[4]; float ss = 0.f;
#pragma unroll
      for (int i = 0; i < 4; ++i) { const u32x2 w = aw[r][i]; m[i] = (f32x4){bflo(w.x), bfhi(w.x), bflo(w.y), bfhi(w.y)};
        ss += m[i][0] * m[i][0] + m[i][1] * m[i][1] + m[i][2] * m[i][2] + m[i][3] * m[i][3]; }
      ss = wave_sum(ss); const float rs = rsqrtf(ss * (1.0f / 1024.0f) + EPS);
#pragma unroll
      for (int i = 0; i < 4; ++i) { const f32x4 g = *(const f32x4*)(gpost + i * 256 + lane * 4); x[r][i] += m[i] * rs * g; }
    }
  }
#pragma unroll
  for (int i = 0; i < 4; ++i) { *(f32x4*)(xoutA + i * 256 + lane * 4) = x[0][i]; *(f32x4*)(xoutB + i * 256 + lane * 4) = x[1][i]; }
  if (gpre) {
#pragma unroll
    for (int r = 0; r < 2; ++r) {
      float ss = 0.f;
#pragma unroll
      for (int i = 0; i < 4; ++i) ss += x[r][i][0] * x[r][i][0] + x[r][i][1] * x[r][i][1] + x[r][i][2] * x[r][i][2] + x[r][i][3] * x[r][i][3];
      ss = wave_sum(ss); const float rs = rsqrtf(ss * (1.0f / 1024.0f) + EPS);
      bf16_t* ho = r == 0 ? houtA : houtB;
#pragma unroll
      for (int i = 0; i < 4; ++i) { const f32x4 g = *(const f32x4*)(gpre + i * 256 + lane * 4); const f32x4 hv = x[r][i] * rs * g;
        u32x2 w; w.x = pk(hv[0], hv[1]); w.y = pk(hv[2], hv[3]); *(u32x2*)(ho + i * 256 + lane * 4) = w; }
    }
  }
}

struct ASrc { const bf16_t* b0; const bf16_t* b1; const bf16_t* b2; const bf16_t* b3; int s0, s1, s2, s3; int shift; };

DI void store_piece64(char* img, const f32x16 (&acc)[2][2], bf16_t* out, size_t ld, int row0, int col0, int l31, int h) {
#pragma unroll
  for (int mf = 0; mf < 2; ++mf)
#pragma unroll
    for (int nf = 0; nf < 2; ++nf)
#pragma unroll
      for (int g = 0; g < 4; ++g) { u32x2 v; v.x = pk(acc[mf][nf][4 * g], acc[mf][nf][4 * g + 1]); v.y = pk(acc[mf][nf][4 * g + 2], acc[mf][nf][4 * g + 3]);
        *(u32x2*)(img + (mf * 32 + l31) * PITCH + (nf * 32 + 8 * g + 4 * h) * 2) = v; }
  const int ln = l31 + 32 * h;
#pragma unroll 2
  for (int i = 0; i < 8; ++i) { const int q = ln + 64 * i, r = q >> 3, c8 = q & 7;
    const u32x4 v = *(const u32x4*)(img + r * PITCH + c8 * 16); *(u32x4*)(out + (size_t)(row0 + r) * ld + col0 + c8 * 8) = v; }
}
DI void store_piece32(char* img, const f32x16 (&a0), const f32x16 (&a1), bf16_t* out, size_t ld, int row0, int col0, int l31, int h) {
#pragma unroll
  for (int g = 0; g < 4; ++g) { u32x2 v; v.x = pk(a0[4 * g], a0[4 * g + 1]); v.y = pk(a0[4 * g + 2], a0[4 * g + 3]); *(u32x2*)(img + l31 * PITCH + (8 * g + 4 * h) * 2) = v;
    u32x2 u; u.x = pk(a1[4 * g], a1[4 * g + 1]); u.y = pk(a1[4 * g + 2], a1[4 * g + 3]); *(u32x2*)(img + l31 * PITCH + (32 + 8 * g + 4 * h) * 2) = u; }
  const int ln = l31 + 32 * h;
#pragma unroll
  for (int i = 0; i < 4; ++i) { const int q = ln + 64 * i, r = q >> 3, c8 = q & 7;
    const u32x4 v = *(const u32x4*)(img + r * PITCH + c8 * 16); *(u32x4*)(out + (size_t)(row0 + r) * ld + col0 + c8 * 8) = v; }
}
struct EpiStore { bf16_t* out; int ldc; int nmax; char* lds;
  DI void operator()(const f32x16 (&acc)[2][2], int mb, int nb, int n0, int wc, int l31, int h) const {
    if (nb >= nmax) return;
    store_piece64(lds + (threadIdx.x >> 6) * 9216, acc, out, (size_t)ldc, mb, nb, l31, h);
  } };
struct EpiSwiGLU { bf16_t* out; char* lds;
  DI void operator()(const f32x16 (&acc)[2][2], int mb, int nb, int n0, int wc, int l31, int h) const {
    const int hc = (nb >> 6) * 32;
    char* img = lds + (threadIdx.x >> 6) * 9216;
#pragma unroll
    for (int mf = 0; mf < 2; ++mf)
#pragma unroll
      for (int g = 0; g < 4; ++g) { float r[4];
#pragma unroll
        for (int e = 0; e < 4; ++e) { const float gt = acc[mf][0][4 * g + e], up = acc[mf][1][4 * g + e]; r[e] = gt / (1.0f + __expf(-gt)) * up; }
        u32x2 v; v.x = pk(r[0], r[1]); v.y = pk(r[2], r[3]); *(u32x2*)(img + (mf * 32 + l31) * PITCH + (8 * g + 4 * h) * 2) = v; }
    const int ln = l31 + 32 * h;
#pragma unroll
    for (int i = 0; i < 4; ++i) { const int q = ln + 64 * i, r = q >> 2, c4 = q & 3;
      const u32x4 v = *(const u32x4*)(img + r * PITCH + c4 * 16); *(u32x4*)(out + (size_t)(mb + r) * DFF + hc + c4 * 8) = v; }
  } };

struct EpiIn { bf16_t* z; char* lds; const float* qg; const float* kg; const f32x2* tabA; const f32x2* tabB; const f32x2* tabC;
  DI void operator()(f32x16 (&acc)[2][2], int mb, int nb, int n0, int wc, int l31, int h) const {
    if (nb >= NIN) return;
    const bool isv = (nb >= A_V && nb < B_Q) || (nb >= B_V && nb < C_Q) || (nb >= C_V && nb < C_G);
    if (isv) {
      const int wv = (threadIdx.x >> 6);
      bf16_t* img = (bf16_t*)(lds + 32768 + wv * 9216);
#pragma unroll
      for (int mf = 0; mf < 2; ++mf)
#pragma unroll
        for (int nf = 0; nf < 2; ++nf)
#pragma unroll
          for (int i = 0; i < 16; ++i) { const int d = nf * 32 + (i & 3) + 8 * (i >> 2) + 4 * h; img[d * 72 + mf * 32 + l31] = f2bf(acc[mf][nf][i]); }
      __builtin_amdgcn_s_waitcnt(0xc07f);
      const int ln = l31 + 32 * h;
#pragma unroll
      for (int i = 0; i < 8; ++i) { const int q = ln + 64 * i, d = q >> 3, c8 = q & 7;
        const u32x4 v = *(const u32x4*)(img + d * 72 + c8 * 8); *(u32x4*)(z + (size_t)(mb + d) * NIN + nb + c8 * 8) = v; }
      return;
    }
#pragma unroll
    for (int mf = 0; mf < 2; ++mf) {
      const int row = mb + mf * 32 + l31; int t, T; row_info(row, t, T);
      if (nb < A_V) {
        const bool isq = nb < A_K; const float* gn = isq ? qg : kg;
        float ss = 0.f;
#pragma unroll
        for (int nf = 0; nf < 2; ++nf)
#pragma unroll
          for (int i = 0; i < 16; ++i) ss += acc[mf][nf][i] * acc[mf][nf][i];
        ss += __shfl_xor(ss, 32);
        const float rs = rsqrtf(ss * (1.0f / 64.0f) + EPS) * (isq ? 0.125f * LOG2E : 1.0f);
#pragma unroll
        for (int nf = 0; nf < 2; ++nf) {
          const int pos = nf == 0 ? (t >> 6) : (t & 63);
#pragma unroll
          for (int g = 0; g < 4; ++g)
#pragma unroll
            for (int e = 0; e < 4; ++e) acc[mf][nf][4 * g + e] *= rs * gn[nf * 32 + 8 * g + 4 * h + e];
#pragma unroll
          for (int g = 0; g < 2; ++g)
#pragma unroll
            for (int e = 0; e < 4; ++e) { const f32x2 cs = tabA[pos * 16 + 8 * g + 4 * h + e];
              const float x1 = acc[mf][nf][4 * g + e], x2 = acc[mf][nf][4 * (g + 2) + e];
              acc[mf][nf][4 * g + e] = x1 * cs.x - x2 * cs.y; acc[mf][nf][4 * (g + 2) + e] = x2 * cs.x + x1 * cs.y; }
        }
      } else if (nb >= B_Q && nb < B_V) {
        const bool isq = nb < B_K;
#pragma unroll
        for (int nf = 0; nf < 2; ++nf) {
#pragma unroll
          for (int e = 0; e < 4; ++e) { const f32x2 cs = tabB[t * 4 + e]; const float v = acc[mf][nf][e]; const float o = __shfl_xor(v, 32);
            acc[mf][nf][e] = (h == 0) ? (v * cs.x - o * cs.y) : (v * cs.x + o * cs.y); }
          if (isq) {
#pragma unroll
            for (int i = 0; i < 16; ++i) acc[mf][nf][i] *= 0.17677669529663687f * LOG2E; }
        }
      } else if (nb >= C_Q && nb < C_V) {
        const float sc = nb < C_K ? 1.0f : 0.125f;
#pragma unroll
        for (int g = 0; g < 4; ++g) {
#pragma unroll
          for (int e = 0; e < 4; ++e) { const f32x2 cs = tabC[t * 32 + 8 * g + 4 * h + e]; const float x1 = acc[mf][0][4 * g + e], x2 = acc[mf][1][4 * g + e];
            acc[mf][0][4 * g + e] = (x1 * cs.x - x2 * cs.y) * sc; acc[mf][1][4 * g + e] = (x2 * cs.x + x1 * cs.y) * sc; }
          if (g & 1) __builtin_amdgcn_sched_barrier(0); }
      }
      store_piece32(lds + (threadIdx.x >> 6) * 9216, acc[mf][0], acc[mf][1], z, (size_t)NIN, mb + mf * 32, nb, l31, h);
    }
  } };

#define LASP __attribute__((address_space(3)))
template <class Epi>
DI void gemm_tile(char* lds, const ASrc& A, const bf16_t* __restrict__ Bt, int K, int m0, int n0, const Epi& epi, bool first, bool has_next, int m0n, int n0n) {
  const int tid = opaque(threadIdx.x), lane = tid & 63, w = __builtin_amdgcn_readfirstlane(tid >> 6), wr = w >> 1, wc = w & 1, l31 = lane & 31, h = lane >> 5;
  const int nk = K >> 6, smask = (1 << A.shift) - 1;
  LASP char* ldsl = (LASP char*)lds;
  f32x16 acc[2][2];
#pragma unroll
  for (int a = 0; a < 2; ++a)
#pragma unroll
    for (int b = 0; b < 2; ++b)
#pragma unroll
      for (int i = 0; i < 16; ++i) acc[a][b][i] = 0.f;
  const int lrow = lane >> 3, lslot = lane & 7;
  int goffA[4], goffB[4];
#pragma unroll
  for (int i = 0; i < 4; ++i) { const int r = w * 32 + i * 8 + lrow, c = lslot ^ ((r >> 1) & 7); goffA[i] = r; goffB[i] = r * K + c * 8; goffA[i] = (goffA[i] << 3) | c; }
#define GEMM_ISSUE(kt, st, M0_, N0_) do { const int k0_ = (kt) << 6, seg_ = k0_ >> A.shift, kk_ = k0_ & smask; \
    const bf16_t* bp_ = seg_ == 0 ? A.b0 : seg_ == 1 ? A.b1 : seg_ == 2 ? A.b2 : A.b3; const int st_ = seg_ == 0 ? A.s0 : seg_ == 1 ? A.s1 : seg_ == 2 ? A.s2 : A.s3; \
    _Pragma("unroll") for (int i_ = 0; i_ < 4; ++i_) { \
      const bf16_t* ga_ = bp_ + (size_t)((M0_) + (goffA[i_] >> 3)) * st_ + kk_ + (goffA[i_] & 7) * 8; \
      __builtin_amdgcn_global_load_lds((const unsigned*)ga_, (LASP unsigned*)(ldsl + (st) * 32768 + (w * 4 + i_) * 1024), 16, 0, 0); \
      const bf16_t* gb_ = Bt + (size_t)(N0_) * K + goffB[i_] + k0_; \
      __builtin_amdgcn_global_load_lds((const unsigned*)gb_, (LASP unsigned*)(ldsl + (st) * 32768 + 16384 + (w * 4 + i_) * 1024), 16, 0, 0); } } while (0)
  const int xr = (l31 >> 1) & 7;
  int coff[4];
#pragma unroll
  for (int s = 0; s < 4; ++s) coff[s] = ((2 * s + h) ^ xr) * 16;
#define GEMM_COMPUTE(st) do { const char* as = lds + (st) * 32768; const char* bs = as + 16384; \
    bf16x8 af[4][2], wf[4][2]; \
    _Pragma("unroll") for (int s = 0; s < 4; ++s) { \
      _Pragma("unroll") for (int mf = 0; mf < 2; ++mf) af[s][mf] = *(const bf16x8*)(as + (wr * 64 + mf * 32 + l31) * 128 + coff[s]); \
      _Pragma("unroll") for (int nf = 0; nf < 2; ++nf) wf[s][nf] = *(const bf16x8*)(bs + (wc * 64 + nf * 32 + l31) * 128 + coff[s]); } \
    __builtin_amdgcn_sched_barrier(0); __builtin_amdgcn_s_setprio(1); \
    _Pragma("unroll") for (int s = 0; s < 4; ++s) \
      _Pragma("unroll") for (int mf = 0; mf < 2; ++mf) _Pragma("unroll") for (int nf = 0; nf < 2; ++nf) acc[mf][nf] = MFMA32(wf[s][nf], af[s][mf], acc[mf][nf]); \
    __builtin_amdgcn_s_setprio(0); __builtin_amdgcn_sched_barrier(0); } while (0)
  if (first) GEMM_ISSUE(0, 0, m0, n0);
  for (int kt = 0; kt < nk; kt += 2) {
    asm volatile("s_waitcnt vmcnt(0)" ::: "memory"); __syncthreads();
    GEMM_ISSUE(kt + 1, 1, m0, n0);
    GEMM_COMPUTE(0);
    asm volatile("s_waitcnt vmcnt(0)" ::: "memory"); __syncthreads();
    if (kt + 2 < nk) GEMM_ISSUE(kt + 2, 0, m0, n0);
    GEMM_COMPUTE(1);
  }
  __syncthreads();
  if (has_next) GEMM_ISSUE(0, 0, m0n, n0n);
  epi(acc, m0 + wr * 64, n0 + wc * 64, n0, wc, l31, h);
  __syncthreads();
#undef GEMM_ISSUE
#undef GEMM_COMPUTE
}

template <class Epi>
DI void gemm_phase(char* lds, const ASrc& A, const bf16_t* Bt, int K, int ntn, const Epi& epi) {
  const int xcd = blockIdx.x & 7, j = blockIdx.x >> 3, nloc = gridDim.x >> 3, per = 48 * ntn, grp = 8 * ntn;
  bool first = true;
  for (int li = j; li < per; li += nloc) {
    const int sg = li / grp, wi = li - sg * grp, nt = wi >> 3, mt = xcd * 48 + sg * 8 + (wi & 7);
    const int ln = li + nloc; const bool has_next = ln < per;
    const int sgn = ln / grp, win = ln - sgn * grp, ntn2 = win >> 3, mtn = xcd * 48 + sgn * 8 + (win & 7);
    gemm_tile(lds, A, Bt, K, mt * 128, nt * 128, epi, first, has_next, mtn * 128, ntn2 * 128);
    first = false;
  }
}

DI void prep_item(char* lds, const Params& p, int layer, int item) {
  const int tid = opaque(threadIdx.x), lane = tid & 63, w = tid >> 6;
  const int rowb = item * 64; int tb, T; row_info(rowb, tb, T);
  const float* qg = p.in[I_AQG] + layer * 64; const float* kg = p.in[I_AKG] + layer * 64;
  const float qgl = qg[lane], kgl = kg[lane];
  for (int tt = 0; tt < 16; ++tt) {
    const int row = rowb + w * 16 + tt, t = tb + w * 16 + tt;
    bf16_t* zr = p.z + (size_t)row * NIN;
    {
      const int j = lane & 31, i = j & 15; const bool first = j < 16; const int pos = (lane < 32) ? (t >> 6) : (t & 63);
      const f32x2 cs = p.tabA[pos * 16 + i];
#pragma unroll
      for (int hd = 0; hd < 6; ++hd) {
        bf16_t* ptr = zr + (hd < 4 ? A_Q + hd * 64 : A_K + (hd - 4) * 64) + lane;
        float v = bf2f(*ptr);
        const float ss = wave_sum(v * v);
        v = v * rsqrtf(ss * (1.0f / 64.0f) + EPS) * (hd < 4 ? qgl : kgl);
        const float o = __shfl_xor(v, 16);
        float r = first ? (v * cs.x - o * cs.y) : (v * cs.x + o * cs.y);
        if (hd < 4) r *= 0.125f * LOG2E;
        *ptr = f2bf(r);
      }
    }
    {
      const int d = lane & 31; const f32x2 cs = p.tabB[t * 4 + (d & 3)];
#pragma unroll
      for (int c = 0; c < 8; ++c) {
        bf16_t* ptr = zr + (c < 4 ? B_Q + c * 64 : B_K + (c - 4) * 64) + lane;
        float v = bf2f(*ptr);
        const float o = __shfl_xor(v, 4);
        float r = v;
        if (d < 8) r = (d < 4) ? (v * cs.x - o * cs.y) : (v * cs.x + o * cs.y);
        if (c < 4) r *= 0.17677669529663687f * LOG2E;
        *ptr = f2bf(r);
      }
    }
    {
      const f32x2 cs = p.tabC[t * 32 + (lane & 31)];
#pragma unroll
      for (int c = 0; c < 8; ++c) {
        bf16_t* ptr = zr + (c < 4 ? C_Q + c * 64 : C_K + (c - 4) * 64) + lane;
        const float v = bf2f(*ptr);
        const float o = __shfl_xor(v, 32);
        float r = (lane < 32) ? (v * cs.x - o * cs.y) : (v * cs.x + o * cs.y);
        if (c >= 4) r *= 0.125f;
        *ptr = f2bf(r);
      }
    }
  }
  bf16_t* tl = (bf16_t*)lds;
  const int r = tid >> 2, c0 = (tid & 3) * 16;
  for (int sl = 0; sl < 10; ++sl) {
    const int col = sl < 2 ? A_V + sl * 64 : sl < 6 ? B_V + (sl - 2) * 64 : C_V + (sl - 6) * 64;
    bf16_t* gp = p.z + (size_t)(rowb + r) * NIN + col + c0;
    const u32x4 v0 = *(const u32x4*)gp, v1 = *(const u32x4*)(gp + 8);
    __syncthreads();
#pragma unroll
    for (int e = 0; e < 4; ++e) {
      tl[(c0 + 2 * e) * 72 + r] = (bf16_t)(v0[e] & 0xffffu); tl[(c0 + 2 * e + 1) * 72 + r] = (bf16_t)(v0[e] >> 16);
      tl[(c0 + 8 + 2 * e) * 72 + r] = (bf16_t)(v1[e] & 0xffffu); tl[(c0 + 8 + 2 * e + 1) * 72 + r] = (bf16_t)(v1[e] >> 16);
    }
    __syncthreads();
    const u32x4 o0 = *(const u32x4*)(tl + r * 72 + c0), o1 = *(const u32x4*)(tl + r * 72 + c0 + 8);
    *(u32x4*)gp = o0; *(u32x4*)(gp + 8) = o1;
  }
  __syncthreads();
}

DI float dshift(const Params& p, const float* mup, const float* mun, int row, int t, int T, int dc) {
  const bf16_t* zp = p.z + (size_t)row * NIN + D_0 + dc;
  const float z = bf2f(*zp);
  const float zprev = (t > 0) ? bf2f(*(zp - NIN)) : 0.f;
  const float znext = (t < T - 1) ? bf2f(*(zp + NIN)) : 0.f;
  return z + mup[dc] * (zprev - z) + mun[dc] * (znext - z);
}
DI float sigmoidf_(float x) { return 1.0f / (1.0f + __expf(-x)); }
DI float omdecay(float ww) {
  const float e = 0.6065306597126334f / (1.0f + __expf(-ww));
  return 1.0f - __expf(-e);
}
DI float fast_tanh(float x) { const float xc = fminf(fmaxf(x, -15.f), 15.f); return 1.0f - 2.0f / (1.0f + __expf(2.0f * xc)); }
constexpr int DTOK = 16;
DI void dprep_item(char* lds, const Params& p, int layer, int item) {
  const int tid = opaque(threadIdx.x);
  const int rowb = item * DTOK; int tb, T; row_info(rowb, tb, T);
  const float* mup = p.in[I_DMUP] + layer * 1088; const float* mun = p.in[I_DMUN] + layer * 1088;
  float* su = (float*)lds;
  bf16_t* stg = (bf16_t*)(lds + 12288);
#pragma unroll
  for (int i = 0; i < 12; ++i) {
    const int idx = tid + 256 * i, tok = idx / 192, c = idx - tok * 192;
    float u = dshift(p, mup, mun, rowb + tok, tb + tok, T, 768 + c);
    if (c < 128) u = fast_tanh(u);
    su[c * DTOK + tok] = u;
  }
  __syncthreads();
  const int c = tid;
  const float w0f = p.in[I_DW0][(layer * 2 + 0) * 256 + c], w0b = p.in[I_DW0][(layer * 2 + 1) * 256 + c];
  const float a0 = p.in[I_DA0][layer * 256 + c], kkw = p.in[I_DKK][layer * 256 + c], kaw = p.in[I_DKA][layer * 256 + c];
  float zr[DTOK + 2], zk[DTOK + 2], zv[DTOK + 2];
  { const bf16_t* zp = p.z + (size_t)rowb * NIN + D_0 + c;
#pragma unroll
    for (int i = 0; i < DTOK + 2; ++i) { const int t = tb - 1 + i; const bool ok = (t >= 0) && (t < T); const bf16_t* q = zp + (ptrdiff_t)(i - 1) * NIN;
      zr[i] = ok ? bf2f(q[0]) : 0.f; zk[i] = ok ? bf2f(q[256]) : 0.f; zv[i] = ok ? bf2f(q[512]) : 0.f; } }
  const float mpr = mup[c], mnr = mun[c], mpk = mup[256 + c], mnk = mun[256 + c], mpv = mup[512 + c], mnv = mun[512 + c];
  float accf[DTOK], accb[DTOK], acca[DTOK];
#pragma unroll
  for (int k = 0; k < DTOK; ++k) { accf[k] = 0.f; accb[k] = 0.f; acca[k] = 0.f; }
  const float* wupf = p.in[I_DWUP] + (size_t)(layer * 2 + 0) * 64 * 256 + c;
  const float* wupb = p.in[I_DWUP] + (size_t)(layer * 2 + 1) * 64 * 256 + c;
  const float* aup = p.in[I_DAUP] + (size_t)layer * 64 * 256 + c;
#pragma unroll 2
  for (int j = 0; j < 64; ++j) {
    const float wf = wupf[j * 256], wb = wupb[j * 256], wa = aup[j * 256];
#pragma unroll
    for (int q = 0; q < 4; ++q) {
      const f32x4 f0 = *(const f32x4*)(su + j * DTOK + 4 * q), b0 = *(const f32x4*)(su + (64 + j) * DTOK + 4 * q), a0v = *(const f32x4*)(su + (128 + j) * DTOK + 4 * q);
#pragma unroll
      for (int k = 0; k < 4; ++k) { accf[4 * q + k] += f0[k] * wf; accb[4 * q + k] += b0[k] * wb; acca[4 * q + k] += a0v[k] * wa; }
    }
  }
#pragma unroll
  for (int k = 0; k < DTOK; ++k) {
    const float r = zr[k + 1] + mpr * (zr[k] - zr[k + 1]) + mnr * (zr[k + 2] - zr[k + 1]);
    const float kx = zk[k + 1] + mpk * (zk[k] - zk[k + 1]) + mnk * (zk[k + 2] - zk[k + 1]);
    const float v = zv[k + 1] + mpv * (zv[k] - zv[k + 1]) + mnv * (zv[k + 2] - zv[k + 1]);
    const float omf = omdecay(w0f + accf[k]), omb = omdecay(w0b + accb[k]);
    const float a = sigmoidf_(a0 + acca[k]);
    float kk = kx * kkw; const float n2 = wave_sum(kk * kk);
    kk = kk * rsqrtf(fmaxf(n2, 1e-24f));
    const float kmod = kx * (1.0f + (a - 1.0f) * kaw), b = kk * a;
    bf16_t* so = stg + k * 256 + c;
    so[0] = f2bf(r); so[DTOK * 256] = f2bf(kmod); so[2 * DTOK * 256] = f2bf(v); so[3 * DTOK * 256] = f2bf(-kk);
    so[4 * DTOK * 256] = f2bf(b); so[5 * DTOK * 256] = f2bf(omf); so[6 * DTOK * 256] = f2bf(omb);
  }
  __syncthreads();
#pragma unroll
  for (int i = 0; i < 14; ++i) {
    const int q = tid + 256 * i, pln = q >> 9, rem = q & 511, tok = rem >> 5, c16 = rem & 31;
    const u32x4 v = *(const u32x4*)(stg + pln * (DTOK * 256) + tok * 256 + c16 * 8);
    *(u32x4*)(p.pl + (size_t)pln * PLANE + (size_t)(rowb + tok) * 256 + c16 * 8) = v;
  }
  __syncthreads();
}

DI void dpost_item(char* lds, const Params& p, int layer, int item) {
  const int tid = opaque(threadIdx.x);
  const int rowb = item * DTOK; int tb, T; row_info(rowb, tb, T);
  const float* mup = p.in[I_DMUP] + layer * 1088; const float* mun = p.in[I_DMUN] + layer * 1088;
  float* sg = (float*)lds;
  bf16_t* stg = (bf16_t*)(lds + 8192);
#pragma unroll
  for (int i = 0; i < 8; ++i) { const int idx = tid + 256 * i, tok = idx >> 7, c = idx & 127; sg[c * DTOK + tok] = sigmoidf_(dshift(p, mup, mun, rowb + tok, tb + tok, T, 960 + c)); }
  __syncthreads();
  const int c = tid;
  float acc[DTOK];
#pragma unroll
  for (int k = 0; k < DTOK; ++k) acc[k] = 0.f;
  float yv[DTOK], rv_[DTOK], kmv[DTOK], vv_[DTOK];
#pragma unroll
  for (int k = 0; k < DTOK; ++k) { const int row = rowb + k; const bf16_t* zd = p.z + (size_t)row * NIN + D_0; const size_t o = (size_t)row * 256 + c;
    yv[k] = bf2f(zd[c]) + bf2f(zd[256 + c]); rv_[k] = bf2f(p.pl[o]); kmv[k] = bf2f(p.pl[PLANE + o]); vv_[k] = bf2f(p.pl[2 * PLANE + o]); }
  const float* gup = p.in[I_DGUP] + (size_t)layer * 128 * 256 + c;
#pragma unroll 4
  for (int j = 0; j < 128; ++j) { const float gw = gup[j * 256];
#pragma unroll
    for (int q = 0; q < 4; ++q) { const f32x4 s0 = *(const f32x4*)(sg + j * DTOK + 4 * q);
#pragma unroll
      for (int k = 0; k < 4; ++k) acc[4 * q + k] += s0[k] * gw; } }
  const float gnw = p.in[I_DGNW][layer * 256 + c], gnb = p.in[I_DGNB][layer * 256 + c], rk = p.in[I_DRK][layer * 256 + c];
#pragma unroll
  for (int k = 0; k < DTOK; ++k) {
    const float y = yv[k];
    const float mean = wave_sum(y) * (1.0f / 64.0f); const float d = y - mean; const float var = wave_sum(d * d) * (1.0f / 64.0f);
    const float yn = d * rsqrtf(var + 64e-5f) * gnw + gnb;
    const float r = rv_[k], km = kmv[k], v = vv_[k];
    const float bonus = wave_sum(r * km * rk);
    stg[k * 256 + c] = f2bf((yn + bonus * v) * acc[k]);
  }
  __syncthreads();
#pragma unroll
  for (int i = 0; i < 2; ++i) { const int q = tid + 256 * i, tok = q >> 5, c16 = q & 31;
    const u32x4 v = *(const u32x4*)(stg + tok * 256 + c16 * 8);
    *(u32x4*)(p.pl + 4 * PLANE + (size_t)(rowb + tok) * 256 + c16 * 8) = v; }
  __syncthreads();
}

DI void rwkv_item(char* lds, const Params& p, int seq, int head, int dir, int half) {
  int row0, T; seq_info(seq, row0, T);
  const int tid = opaque(threadIdx.x), kc = tid & 7, vrow = half * 32 + (tid >> 3);
  float* st = (float*)lds;
  f32x2 S[4];
#pragma unroll
  for (int j = 0; j < 4; ++j) S[j] = (f32x2){0.f, 0.f};
  const int nchunk = T >> 4;
  u32x4 rg[3];
  const int tsel = tid >> 7, srem = tid & 127, sstep = srem >> 3, sc8 = srem & 7;
#define RW_GLOAD(c) do { _Pragma("unroll") for (int i_ = 0; i_ < 3; ++i_) { const int tens_ = tsel + 2 * i_; \
      const int plane_ = tens_ == 0 ? (dir ? 6 : 5) : tens_ == 1 ? 3 : tens_ == 2 ? 4 : tens_ == 3 ? 1 : tens_ == 4 ? 0 : 2; \
      const int t_ = dir ? (T - 1 - ((c) * 16 + sstep)) : ((c) * 16 + sstep); \
      rg[i_] = *(const u32x4*)(p.pl + (size_t)plane_ * PLANE + (size_t)(row0 + t_) * 256 + head * 64 + sc8 * 8); } } while (0)
#define RW_LSTORE(buf) do { _Pragma("unroll") for (int i_ = 0; i_ < 3; ++i_) { const int tens_ = tsel + 2 * i_; \
      f32x4 a_ = {bflo(rg[i_].x), bfhi(rg[i_].x), bflo(rg[i_].y), bfhi(rg[i_].y)}, b_ = {bflo(rg[i_].z), bfhi(rg[i_].z), bflo(rg[i_].w), bfhi(rg[i_].w)}; \
      if (tens_ == 0) { a_ = 1.0f - a_; b_ = 1.0f - b_; } \
      float* d_ = st + (((buf) * 16 + sstep) * 6 + tens_) * 64 + sc8 * 8; *(f32x4*)d_ = a_; *(f32x4*)(d_ + 4) = b_; } } while (0)
  __builtin_amdgcn_s_setprio(3);
  RW_GLOAD(0); RW_LSTORE(0); __syncthreads();
  bf16_t* ybase = p.z + (size_t)row0 * NIN + D_0 + dir * 256 + head * 64 + half * 32;
  for (int c = 0; c < nchunk; ++c) {
    if (c + 1 < nchunk) RW_GLOAD(c + 1);
    const float* sb = st + (c & 1) * (16 * 384);
    unsigned* yb = (unsigned*)(lds + 49152) + (c & 1) * 256;
    if (c > 0 && tid < 64) {
      const int sp = tid >> 2, part = tid & 3, tt = (c - 1) * 16 + sp; const int t_ = dir ? (T - 1 - tt) : tt;
      const u32x4 v = *(const u32x4*)((unsigned*)(lds + 49152) + ((c - 1) & 1) * 256 + sp * 16 + part * 4);
      *(u32x4*)(ybase + (size_t)t_ * NIN + part * 8) = v; }
#define RW_FETCH(S_, s_) do { const float* q_ = sb + (s_) * 384 + kc * 8; \
      S_##w0 = *(const f32x4*)(q_); S_##w1 = *(const f32x4*)(q_ + 4); S_##n0 = *(const f32x4*)(q_ + 64); S_##n1 = *(const f32x4*)(q_ + 68); \
      S_##b0 = *(const f32x4*)(q_ + 128); S_##b1 = *(const f32x4*)(q_ + 132); S_##k0 = *(const f32x4*)(q_ + 192); S_##k1 = *(const f32x4*)(q_ + 196); \
      S_##r0 = *(const f32x4*)(q_ + 256); S_##r1 = *(const f32x4*)(q_ + 260); S_##vv = sb[(s_) * 384 + 320 + vrow]; } while (0)
#define LO2(x) ((f32x2){(x)[0], (x)[1]})
#define HI2(x) ((f32x2){(x)[2], (x)[3]})
#define RW_STEP(S_, s_) do { \
      f32x2 a2 = S[0] * LO2(S_##n0); a2 += S[1] * HI2(S_##n0); a2 += S[2] * LO2(S_##n1); a2 += S[3] * HI2(S_##n1); \
      const float sa = red8(a2.x + a2.y); const float vx = S_##vv; \
      S[0] = S[0] * LO2(S_##w0) + (LO2(S_##b0) * sa + LO2(S_##k0) * vx); S[1] = S[1] * HI2(S_##w0) + (HI2(S_##b0) * sa + HI2(S_##k0) * vx); \
      S[2] = S[2] * LO2(S_##w1) + (LO2(S_##b1) * sa + LO2(S_##k1) * vx); S[3] = S[3] * HI2(S_##w1) + (HI2(S_##b1) * sa + HI2(S_##k1) * vx); \
      f32x2 y2 = S[0] * LO2(S_##r0); y2 += S[1] * HI2(S_##r0); y2 += S[2] * LO2(S_##r1); y2 += S[3] * HI2(S_##r1); \
      const float y = red8(y2.x + y2.y); const float yn = DPPF(y, 0x128);     \
      if ((tid & 15) == 0) yb[(s_) * 16 + (tid >> 4)] = pk(y, yn); } while (0)
    f32x4 Aw0, Aw1, An0, An1, Ab0, Ab1, Ak0, Ak1, Ar0, Ar1; float Avv;
    f32x4 Bw0, Bw1, Bn0, Bn1, Bb0, Bb1, Bk0, Bk1, Br0, Br1; float Bvv;
    RW_FETCH(A, 0);
#pragma unroll
    for (int s = 0; s < 16; s += 2) {
      RW_FETCH(B, s + 1);
      RW_STEP(A, s);
      if (s + 2 < 16) RW_FETCH(A, s + 2);
      RW_STEP(B, s + 1);
    }
#undef RW_FETCH
#undef RW_STEP
    if (c + 1 < nchunk) RW_LSTORE((c + 1) & 1);
    __syncthreads();
  }
#undef RW_GLOAD
#undef RW_LSTORE
  if (tid < 64) { const int c = nchunk; const int sp = tid >> 2, part = tid & 3, tt = (c - 1) * 16 + sp; const int t_ = dir ? (T - 1 - tt) : tt;
    const u32x4 v = *(const u32x4*)((unsigned*)(lds + 49152) + ((c - 1) & 1) * 256 + sp * 16 + part * 4);
    *(u32x4*)(ybase + (size_t)t_ * NIN + part * 8) = v; }
  __syncthreads();
  __builtin_amdgcn_s_setprio(0);
}

template <int MODE>
DI void attn_item(char* lds, const Params& p, int layer, int seq, int head, int qt) {
  const int tid = opaque(threadIdx.x), lane = tid & 63, w = tid >> 6, l31 = lane & 31, h = lane >> 5;
  layer = opaque_s(layer); seq = opaque_s(seq); head = opaque_s(head); qt = opaque_s(qt);
  int row0, T; seq_info(seq, row0, T);
  const int QC = (MODE == 0 ? A_Q : MODE == 1 ? B_Q : C_Q) + head * 64;
  const int KC = MODE == 0 ? A_K + (head >> 1) * 64 : MODE == 1 ? B_K + head * 64 : C_K + head * 64;
  const int VC = MODE == 0 ? A_V + (head >> 1) * 64 : MODE == 1 ? B_V + head * 64 : C_V + head * 64;
  const int qw0 = qt * 128 + w * 32, qi = qw0 + l31;
  bf16_t* zq = p.z + (size_t)(row0 + qi) * NIN + QC;
  bf16x8 qf[4];
#pragma unroll
  for (int s = 0; s < 4; ++s) qf[s] = *(const bf16x8*)(zq + s * 16 + h * 8);
  const int srow = tid >> 3, sc8 = tid & 7;
  const bf16_t* kbase = p.z + (size_t)(row0 + srow) * NIN + KC + sc8 * 8;
  const bf16_t* vbase = p.z + (size_t)(row0 + srow) * NIN + VC + sc8 * 8;
  u32x4 rk[2][2], rv[2][2];
  const int nt = T >> 6;
  const int prow = (l31 & 19) | ((l31 & 4) << 1) | ((l31 & 8) >> 1);
#define AT_GLOAD(t, S) do { _Pragma("unroll") for (int i_ = 0; i_ < 2; ++i_) { const size_t off_ = (size_t)((t) * 64 + 32 * i_) * NIN; rk[S][i_] = *(const u32x4*)(kbase + off_); rv[S][i_] = *(const u32x4*)(vbase + off_); } } while (0)
#define AT_LSTORE(buf, S) do { char* ks_ = lds + (buf) * 18432; char* vs_ = ks_ + 9216; \
    _Pragma("unroll") for (int i_ = 0; i_ < 2; ++i_) { *(u32x4*)(ks_ + (srow + 32 * i_) * PITCH + sc8 * 16) = rk[S][i_]; *(u32x4*)(vs_ + (srow + 32 * i_) * PITCH + sc8 * 16) = rv[S][i_]; } } while (0)
  constexpr int NMAP = (MODE == 1) ? 2 : 1;
  f32x16 o[NMAP][2];
  float m_run[NMAP], l_run[NMAP];
#pragma unroll
  for (int a = 0; a < NMAP; ++a) { m_run[a] = -INFINITY; l_run[a] = 0.f;
#pragma unroll
    for (int b = 0; b < 2; ++b)
#pragma unroll
      for (int i = 0; i < 16; ++i) o[a][b][i] = 0.f; }
  float lf = 0.f, lb = 0.f;
  if (MODE == 2) { lf = log2f(1.0f - exp2f(-5.0f - (float)head)); lb = log2f(1.0f - exp2f(-5.0f - (float)(3 - head))); }
  auto body = [&](const char* ks, const char* vs, const int t) __attribute__((always_inline)) {
#pragma unroll
    for (int mp = 0; mp < NMAP; ++mp) {
      f32x16 st[2];
#pragma unroll
      for (int kf = 0; kf < 2; ++kf) {
#pragma unroll
        for (int i = 0; i < 16; ++i) st[kf][i] = 0.f;
        if (MODE == 1) {
#pragma unroll
          for (int s = 0; s < 2; ++s) { const bf16x8 kfr = *(const bf16x8*)(ks + (kf * 32 + prow) * PITCH + (mp * 2 + s) * 32 + h * 16); st[kf] = MFMA32(kfr, qf[mp * 2 + s], st[kf]); }
        } else {
#pragma unroll
          for (int s = 0; s < 4; ++s) { const bf16x8 kfr = *(const bf16x8*)(ks + (kf * 32 + prow) * PITCH + s * 32 + h * 16); st[kf] = MFMA32(kfr, qf[s], st[kf]); }
        }
      }
      if (MODE == 2) {
        const int k0 = t * 64;
        const float dbase = (float)(qi - k0 - 8 * h);
        if (k0 + 63 < qw0) {
#pragma unroll
          for (int kf = 0; kf < 2; ++kf)
#pragma unroll
            for (int i = 0; i < 16; ++i) { const float cc = (float)(32 * kf + (i & 3) + 4 * ((i >> 2) & 1) + 16 * ((i >> 3) & 1)); st[kf][i] *= fexp2(lf * (dbase - cc)); }
        } else if (k0 > qw0 + 31) {
#pragma unroll
          for (int kf = 0; kf < 2; ++kf)
#pragma unroll
            for (int i = 0; i < 16; ++i) { const float cc = (float)(32 * kf + (i & 3) + 4 * ((i >> 2) & 1) + 16 * ((i >> 3) & 1)); st[kf][i] *= fexp2(lb * (cc - dbase)); }
        } else {
#pragma unroll
          for (int kf = 0; kf < 2; ++kf)
#pragma unroll
            for (int i = 0; i < 16; ++i) { const float cc = (float)(32 * kf + (i & 3) + 4 * ((i >> 2) & 1) + 16 * ((i >> 3) & 1)); const float d = dbase - cc;
              float dd = fexp2(fminf(lf * d, -lb * d)); if (d == 0.f) dd = 2.0f; st[kf][i] *= dd; }
        }
      } else {
        float mx = st[0][0];
#pragma unroll
        for (int kf = 0; kf < 2; ++kf)
#pragma unroll
          for (int i = 0; i < 16; ++i) mx = fmaxf(mx, st[kf][i]);
        mx = fmaxf(mx, __shfl_xor(mx, 32));
        const float mn = fmaxf(m_run[mp], mx); const float alpha = fexp2(m_run[mp] - mn); m_run[mp] = mn;
        float ps = 0.f;
#pragma unroll
        for (int kf = 0; kf < 2; ++kf)
#pragma unroll
          for (int i = 0; i < 16; ++i) { st[kf][i] = fexp2(st[kf][i] - mn); ps += st[kf][i]; }
        l_run[mp] = l_run[mp] * alpha + ps;
#pragma unroll
        for (int df = 0; df < 2; ++df) o[mp][df] *= alpha;
      }
      bf16x8 pf[4];
#pragma unroll
      for (int kf = 0; kf < 2; ++kf)
#pragma unroll
        for (int s2 = 0; s2 < 2; ++s2) { u32x4 u; u.x = pk(st[kf][8 * s2], st[kf][8 * s2 + 1]); u.y = pk(st[kf][8 * s2 + 2], st[kf][8 * s2 + 3]);
          u.z = pk(st[kf][8 * s2 + 4], st[kf][8 * s2 + 5]); u.w = pk(st[kf][8 * s2 + 6], st[kf][8 * s2 + 7]); pf[kf * 2 + s2] = __builtin_bit_cast(bf16x8, u); }
#pragma unroll
      for (int df = 0; df < 2; ++df)
#pragma unroll
        for (int ksx = 0; ksx < 4; ++ksx) { const bf16x8 vfr = *(const bf16x8*)(vs + (df * 32 + l31) * PITCH + ksx * 32 + h * 16); o[mp][df] = MFMA32(vfr, pf[ksx], o[mp][df]); }
    }
  };
  if constexpr (MODE == 1) {
    AT_GLOAD(0, 0); AT_LSTORE(0, 0); __syncthreads();
#pragma unroll 1
    for (int t = 0; t < nt; ++t) {
      if (t + 1 < nt) AT_GLOAD(t + 1, 0);
      const char* ks = lds + (t & 1) * 18432;
      body(ks, ks + 9216, t);
      if (t + 1 < nt) AT_LSTORE((t + 1) & 1, 0);
      __syncthreads();
    }
  } else {
    AT_GLOAD(0, 0); AT_GLOAD(1, 1); AT_LSTORE(0, 0); __syncthreads();
#pragma unroll 1
    for (int t2 = 0; t2 < nt; t2 += 2) {
      if (t2 + 2 < nt) AT_GLOAD(t2 + 2, 0);
      body(lds, lds + 9216, t2);
      AT_LSTORE(1, 1);
      __syncthreads();
      if (t2 + 3 < nt) AT_GLOAD(t2 + 3, 1);
      body(lds + 18432, lds + 18432 + 9216, t2 + 1);
      if (t2 + 2 < nt) AT_LSTORE(0, 0);
      __syncthreads();
    }
  }
#undef AT_GLOAD
#undef AT_LSTORE
  f32x16 r[2];
  if (MODE == 0) {
    const float l = l_run[0] + __shfl_xor(l_run[0], 32); const float inv = 1.0f / l;
#pragma unroll
    for (int df = 0; df < 2; ++df) r[df] = o[0][df] * inv;
  } else if (MODE == 1) {
    const float* lp = p.in[I_BLAM] + layer * 128;
    float s01 = 0.f, s23 = 0.f;
    for (int i = 0; i < 32; ++i) { s01 += lp[i] * lp[32 + i]; s23 += lp[64 + i] * lp[96 + i]; }
    const float lam_init = 0.8f - 0.6f * expf(-0.3f * (float)layer);
    const float lam = expf(s01) - expf(s23) + lam_init;
    const float l0 = l_run[0] + __shfl_xor(l_run[0], 32), l1 = l_run[NMAP - 1] + __shfl_xor(l_run[NMAP - 1], 32);
    const float i0 = 1.0f / l0, i1 = lam / l1;
    float ss = 0.f;
#pragma unroll
    for (int df = 0; df < 2; ++df) { r[df] = o[0][df] * i0 - o[NMAP - 1][df] * i1;
#pragma unroll
      for (int i = 0; i < 16; ++i) ss += r[df][i] * r[df][i]; }
    ss += __shfl_xor(ss, 32);
    const float rs = rsqrtf(ss * (1.0f / 64.0f) + EPS) * (1.0f - lam_init);
    const float* sg = p.in[I_BSUB] + layer * 64;
#pragma unroll
    for (int df = 0; df < 2; ++df)
#pragma unroll
      for (int i = 0; i < 16; ++i) r[df][i] *= rs * sg[df * 32 + (i & 3) + 8 * (i >> 2) + 4 * h];
  } else {
    float ss = 0.f;
#pragma unroll
    for (int df = 0; df < 2; ++df)
#pragma unroll
      for (int i = 0; i < 16; ++i) ss += o[0][df][i] * o[0][df][i];
    ss += __shfl_xor(ss, 32);
    const float rs = rsqrtf(ss * (1.0f / 64.0f) + EPS);
    const float* gg = p.in[I_CGN] + layer * 256 + head * 64;
    const bf16_t* zg = p.z + (size_t)(row0 + qi) * NIN + C_G + head * 64;
#pragma unroll
    for (int df = 0; df < 2; ++df)
#pragma unroll
      for (int g = 0; g < 4; ++g) { const u32x2 gw = *(const u32x2*)(zg + df * 32 + 8 * g + 4 * h);
        const float gv[4] = {bflo(gw.x), bfhi(gw.x), bflo(gw.y), bfhi(gw.y)};
#pragma unroll
        for (int e = 0; e < 4; ++e) { const float x = gv[e]; r[df][4 * g + e] = o[0][df][4 * g + e] * rs * gg[df * 32 + 8 * g + 4 * h + e] * (x / (1.0f + __expf(-x))); } }
  }
#pragma unroll
  for (int df = 0; df < 2; ++df)
#pragma unroll
    for (int g = 0; g < 4; ++g) { u32x2 v; v.x = pk(r[df][4 * g], r[df][4 * g + 1]); v.y = pk(r[df][4 * g + 2], r[df][4 * g + 3]); *(u32x2*)(zq + df * 32 + 8 * g + 4 * h) = v; }
}

template <class Epi>
DI void gemm_tile2(char* lds, const ASrc& A, const bf16_t* __restrict__ Bt, int K, int m0, int n0, const Epi& epi) {
  const int tid = opaque(threadIdx.x), lane = tid & 63, w = __builtin_amdgcn_readfirstlane(tid >> 6), wr = w >> 1, wc = w & 1, l31 = lane & 31, h = lane >> 5;
  const int nk = K >> 5, smask = (1 << A.shift) - 1;
  LASP char* ldsl = (LASP char*)lds;
  f32x16 acc[2][4];
#pragma unroll
  for (int a = 0; a < 2; ++a)
#pragma unroll
    for (int b = 0; b < 4; ++b)
#pragma unroll
      for (int i = 0; i < 16; ++i) acc[a][b][i] = 0.f;
  const int lrow = lane >> 2, lslot = lane & 3;
  int goffA[2], goffB[4];
#pragma unroll
  for (int i = 0; i < 2; ++i) { const int r = (2 * w + i) * 16 + lrow, c = lslot ^ ((r >> 2) & 3); goffA[i] = (r << 2) | c; }
#pragma unroll
  for (int i = 0; i < 4; ++i) { const int r = (4 * w + i) * 16 + lrow, c = lslot ^ ((r >> 2) & 3); goffB[i] = r * K + c * 8; }
#define G2_ISSUE(kt, st) do { const int k0_ = (kt) << 5, seg_ = k0_ >> A.shift, kk_ = k0_ & smask; \
    const bf16_t* bp_ = seg_ == 0 ? A.b0 : seg_ == 1 ? A.b1 : seg_ == 2 ? A.b2 : A.b3; const int st_ = seg_ == 0 ? A.s0 : seg_ == 1 ? A.s1 : seg_ == 2 ? A.s2 : A.s3; \
    _Pragma("unroll") for (int i_ = 0; i_ < 2; ++i_) { \
      const bf16_t* ga_ = bp_ + (size_t)(m0 + (goffA[i_] >> 2)) * st_ + kk_ + (goffA[i_] & 3) * 8; \
      __builtin_amdgcn_global_load_lds((const unsigned*)ga_, (LASP unsigned*)(ldsl + (st) * 24576 + (2 * w + i_) * 1024), 16, 0, 0); } \
    _Pragma("unroll") for (int i_ = 0; i_ < 4; ++i_) { \
      const bf16_t* gb_ = Bt + (size_t)n0 * K + goffB[i_] + k0_; \
      __builtin_amdgcn_global_load_lds((const unsigned*)gb_, (LASP unsigned*)(ldsl + (st) * 24576 + 8192 + (4 * w + i_) * 1024), 16, 0, 0); } } while (0)
  const int xr = (l31 >> 2) & 3;
  int coff[2];
#pragma unroll
  for (int s = 0; s < 2; ++s) coff[s] = ((2 * s + h) ^ xr) * 16;
#define G2_COMPUTE(st) do { const char* as = lds + (st) * 24576; const char* bs = as + 8192; \
    bf16x8 af[2][2], wf[2][4]; \
    _Pragma("unroll") for (int s = 0; s < 2; ++s) { \
      _Pragma("unroll") for (int mf = 0; mf < 2; ++mf) af[s][mf] = *(const bf16x8*)(as + (wr * 64 + mf * 32 + l31) * 64 + coff[s]); \
      _Pragma("unroll") for (int nf = 0; nf < 4; ++nf) wf[s][nf] = *(const bf16x8*)(bs + (wc * 128 + nf * 32 + l31) * 64 + coff[s]); } \
    __builtin_amdgcn_sched_barrier(0); __builtin_amdgcn_s_setprio(1); \
    _Pragma("unroll") for (int s = 0; s < 2; ++s) \
      _Pragma("unroll") for (int mf = 0; mf < 2; ++mf) _Pragma("unroll") for (int nf = 0; nf < 4; ++nf) acc[mf][nf] = MFMA32(wf[s][nf], af[s][mf], acc[mf][nf]); \
    __builtin_amdgcn_s_setprio(0); __builtin_amdgcn_sched_barrier(0); } while (0)
  G2_ISSUE(0, 0);
  for (int kt = 0; kt < nk; kt += 2) {
    asm volatile("s_waitcnt vmcnt(0)" ::: "memory"); __syncthreads();
    G2_ISSUE(kt + 1, 1);
    G2_COMPUTE(0);
    asm volatile("s_waitcnt vmcnt(0)" ::: "memory"); __syncthreads();
    if (kt + 2 < nk) G2_ISSUE(kt + 2, 0);
    G2_COMPUTE(1);
  }
  __syncthreads();
#pragma unroll
  for (int hf = 0; hf < 2; ++hf) {
    f32x16 t[2][2];
#pragma unroll
    for (int mf = 0; mf < 2; ++mf) { t[mf][0] = acc[mf][2 * hf]; t[mf][1] = acc[mf][2 * hf + 1]; }
    epi(t, m0 + wr * 64, n0 + wc * 128 + hf * 64, n0, wc, l31, h);
  }
  __syncthreads();
#undef G2_ISSUE
#undef G2_COMPUTE
}

template <class Epi>
DI void gemm_phase2(char* lds, const ASrc& A, const bf16_t* Bt, int K, int ntn, const Epi& epi) {
  const int xcd = blockIdx.x & 7, j = blockIdx.x >> 3, nloc = gridDim.x >> 3, per = 48 * ntn, grp = 8 * ntn;
  for (int li = j; li < per; li += nloc) {
    const int sg = li / grp, wi = li - sg * grp, nt = wi >> 3, mt = xcd * 48 + sg * 8 + (wi & 7);
    gemm_tile2(lds, A, Bt, K, mt * 128, nt * 256, epi);
  }
}

template <int MODE>
DI void attn3_item(char* lds, const Params& p, int layer, int seq, int head, int qt) {
  const int tid = opaque(threadIdx.x), lane = tid & 63, w = tid >> 6, l31 = lane & 31, h = lane >> 5;
  layer = opaque_s(layer); seq = opaque_s(seq); head = opaque_s(head); qt = opaque_s(qt);
  int row0, T; seq_info(seq, row0, T);
  const int QC = (MODE == 0 ? A_Q : C_Q) + head * 64;
  const int KC = MODE == 0 ? A_K + (head >> 1) * 64 : C_K + head * 64;
  const int VC = MODE == 0 ? A_V + (head >> 1) * 64 : C_V + head * 64;
  const int qw0 = qt * 256 + w * 64;
  bf16x8 qf[2][4];
#pragma unroll
  for (int qi = 0; qi < 2; ++qi)
#pragma unroll
    for (int s = 0; s < 4; ++s) qf[qi][s] = *(const bf16x8*)(p.z + (size_t)(row0 + qw0 + qi * 32 + l31) * NIN + QC + s * 16 + h * 8);
  const int srow = tid >> 3, sc8 = tid & 7;
  const bf16_t* kbase = p.z + (size_t)(row0 + srow) * NIN + KC + sc8 * 8;
  const bf16_t* vbase = p.z + (size_t)(row0 + srow) * NIN + VC + sc8 * 8;
  u32x4 rk[2], rv[2];
  const int nt = T >> 6;
  const int prow = (l31 & 19) | ((l31 & 4) << 1) | ((l31 & 8) >> 1);
#define A3_GLOAD(t) do { _Pragma("unroll") for (int i_ = 0; i_ < 2; ++i_) { const size_t off_ = (size_t)((t) * 64 + 32 * i_) * NIN; rk[i_] = *(const u32x4*)(kbase + off_); rv[i_] = *(const u32x4*)(vbase + off_); } } while (0)
#define A3_LSTORE(buf) do { char* ks_ = lds + (buf) * 18432; char* vs_ = ks_ + 9216; \
    _Pragma("unroll") for (int i_ = 0; i_ < 2; ++i_) { *(u32x4*)(ks_ + (srow + 32 * i_) * PITCH + sc8 * 16) = rk[i_]; *(u32x4*)(vs_ + (srow + 32 * i_) * PITCH + sc8 * 16) = rv[i_]; } } while (0)
  f32x16 o[2][2];
  float m_run[2], l_run[2];
#pragma unroll
  for (int a = 0; a < 2; ++a) { m_run[a] = -INFINITY; l_run[a] = 0.f;
#pragma unroll
    for (int b = 0; b < 2; ++b)
#pragma unroll
      for (int i = 0; i < 16; ++i) o[a][b][i] = 0.f; }
  float lf = 0.f, lb = 0.f;
  if (MODE == 2) { lf = log2f(1.0f - exp2f(-5.0f - (float)head)); lb = log2f(1.0f - exp2f(-5.0f - (float)(3 - head))); }
  A3_GLOAD(0); A3_LSTORE(0); __syncthreads();
#pragma unroll 1
  for (int t = 0; t < nt; ++t) {
    if (t + 1 < nt) A3_GLOAD(t + 1);
    const char* ks = lds + (t & 1) * 18432; const char* vs = ks + 9216;
    f32x16 st[2][2];
#pragma unroll
    for (int kf = 0; kf < 2; ++kf) {
#pragma unroll
      for (int qi = 0; qi < 2; ++qi)
#pragma unroll
        for (int i = 0; i < 16; ++i) st[qi][kf][i] = 0.f;
#pragma unroll
      for (int s = 0; s < 4; ++s) { const bf16x8 kfr = *(const bf16x8*)(ks + (kf * 32 + prow) * PITCH + s * 32 + h * 16);
#pragma unroll
        for (int qi = 0; qi < 2; ++qi) st[qi][kf] = MFMA32(kfr, qf[qi][s], st[qi][kf]); }
    }
    __builtin_amdgcn_sched_barrier(0);
#pragma unroll
    for (int qi = 0; qi < 2; ++qi) {
      bf16x8 pf[4];
      if (MODE == 2) {
        const int k0 = t * 64, qb = qw0 + qi * 32;
        const float dbase = (float)(qb + l31 - k0 - 8 * h);
        if (k0 + 63 < qb) {
#pragma unroll
          for (int kf = 0; kf < 2; ++kf)
#pragma unroll
            for (int i = 0; i < 16; ++i) { const float cc = (float)(32 * kf + (i & 3) + 4 * ((i >> 2) & 1) + 16 * ((i >> 3) & 1)); st[qi][kf][i] *= fexp2(lf * (dbase - cc)); }
        } else if (k0 > qb + 31) {
#pragma unroll
          for (int kf = 0; kf < 2; ++kf)
#pragma unroll
            for (int i = 0; i < 16; ++i) { const float cc = (float)(32 * kf + (i & 3) + 4 * ((i >> 2) & 1) + 16 * ((i >> 3) & 1)); st[qi][kf][i] *= fexp2(lb * (cc - dbase)); }
        } else {
#pragma unroll
          for (int kf = 0; kf < 2; ++kf)
#pragma unroll
            for (int i = 0; i < 16; ++i) { const float cc = (float)(32 * kf + (i & 3) + 4 * ((i >> 2) & 1) + 16 * ((i >> 3) & 1)); const float d = dbase - cc;
              float dd = fexp2(fminf(lf * d, -lb * d)); if (d == 0.f) dd = 2.0f; st[qi][kf][i] *= dd; }
        }
      } else {
        float mx = st[qi][0][0];
#pragma unroll
        for (int kf = 0; kf < 2; ++kf)
#pragma unroll
          for (int i = 0; i < 16; ++i) mx = fmaxf(mx, st[qi][kf][i]);
        mx = fmaxf(mx, __shfl_xor(mx, 32));
        const float mn = fmaxf(m_run[qi], mx); const float alpha = fexp2(m_run[qi] - mn); m_run[qi] = mn;
        float ps = 0.f;
#pragma unroll
        for (int kf = 0; kf < 2; ++kf)
#pragma unroll
          for (int i = 0; i < 16; ++i) { st[qi][kf][i] = fexp2(st[qi][kf][i] - mn); ps += st[qi][kf][i]; }
        l_run[qi] = l_run[qi] * alpha + ps;
#pragma unroll
        for (int df = 0; df < 2; ++df) o[qi][df] *= alpha;
      }
#pragma unroll
      for (int kf = 0; kf < 2; ++kf)
#pragma unroll
        for (int s2 = 0; s2 < 2; ++s2) { u32x4 u; u.x = pk(st[qi][kf][8 * s2], st[qi][kf][8 * s2 + 1]); u.y = pk(st[qi][kf][8 * s2 + 2], st[qi][kf][8 * s2 + 3]);
          u.z = pk(st[qi][kf][8 * s2 + 4], st[qi][kf][8 * s2 + 5]); u.w = pk(st[qi][kf][8 * s2 + 6], st[qi][kf][8 * s2 + 7]); pf[kf * 2 + s2] = __builtin_bit_cast(bf16x8, u); }
#pragma unroll
      for (int df = 0; df < 2; ++df)
#pragma unroll
        for (int ksx = 0; ksx < 4; ++ksx) { const bf16x8 vfr = *(const bf16x8*)(vs + (df * 32 + l31) * PITCH + ksx * 32 + h * 16); o[qi][df] = MFMA32(vfr, pf[ksx], o[qi][df]); }
      __builtin_amdgcn_sched_barrier(0);
    }
    __builtin_amdgcn_sched_barrier(0);
    if (t + 1 < nt) A3_LSTORE((t + 1) & 1);
    __syncthreads();
  }
#undef A3_GLOAD
#undef A3_LSTORE
#pragma unroll
  for (int qi = 0; qi < 2; ++qi) {
    const int qrow = row0 + qw0 + qi * 32 + l31;
    bf16_t* zq = p.z + (size_t)qrow * NIN + QC;
    f32x16 r[2];
    if (MODE == 0) {
      const float l = l_run[qi] + __shfl_xor(l_run[qi], 32); const float inv = 1.0f / l;
#pragma unroll
      for (int df = 0; df < 2; ++df) r[df] = o[qi][df] * inv;
    } else {
      float ss = 0.f;
#pragma unroll
      for (int df = 0; df < 2; ++df)
#pragma unroll
        for (int i = 0; i < 16; ++i) ss += o[qi][df][i] * o[qi][df][i];
      ss += __shfl_xor(ss, 32);
      const float rs = rsqrtf(ss * (1.0f / 64.0f) + EPS);
      const float* gg = p.in[I_CGN] + layer * 256 + head * 64;
      const bf16_t* zg = p.z + (size_t)qrow * NIN + C_G + head * 64;
#pragma unroll
      for (int df = 0; df < 2; ++df)
#pragma unroll
        for (int g = 0; g < 4; ++g) { const u32x2 gw = *(const u32x2*)(zg + df * 32 + 8 * g + 4 * h);
          const float gv[4] = {bflo(gw.x), bfhi(gw.x), bflo(gw.y), bfhi(gw.y)};
#pragma unroll
          for (int e = 0; e < 4; ++e) { const float x = gv[e]; r[df][4 * g + e] = o[qi][df][4 * g + e] * rs * gg[df * 32 + 8 * g + 4 * h + e] * (x / (1.0f + __expf(-x))); } }
    }
#pragma unroll
    for (int df = 0; df < 2; ++df)
#pragma unroll
      for (int g = 0; g < 4; ++g) { u32x2 v; v.x = pk(r[df][4 * g], r[df][4 * g + 1]); v.y = pk(r[df][4 * g + 2], r[df][4 * g + 3]); *(u32x2*)(zq + df * 32 + 8 * g + 4 * h) = v; }
  }
}

DI void ctr_barrier(unsigned* cnt) {
  asm volatile("s_waitcnt vmcnt(0) lgkmcnt(0)" ::: "memory");
  __syncthreads();
  if (threadIdx.x == 0) {
    __builtin_amdgcn_fence(__ATOMIC_RELEASE, "agent");
    asm volatile("s_waitcnt vmcnt(0)" ::: "memory");
    const unsigned G = gridDim.x;
    const unsigned old = __hip_atomic_fetch_add(cnt, 1u, __ATOMIC_RELAXED, __HIP_MEMORY_SCOPE_AGENT);
    const unsigned gen = old / G + 1u;
    if (old + 1u == gen * G) __hip_atomic_store(cnt + 64, gen, __ATOMIC_RELAXED, __HIP_MEMORY_SCOPE_AGENT);
    else while (__hip_atomic_load(cnt + 64, __ATOMIC_RELAXED, __HIP_MEMORY_SCOPE_AGENT) < gen) __builtin_amdgcn_s_sleep(1);
    __builtin_amdgcn_fence(__ATOMIC_ACQUIRE, "agent");
    asm volatile("s_waitcnt vmcnt(0)" ::: "memory");
  }
  __syncthreads();
}

DI int next_item(int* ctr, int* sh) {
  __syncthreads();
  if (threadIdx.x == 0) *sh = atomicAdd(ctr, 1);
  __syncthreads();
  return *sh;
}
constexpr int XQ_N = 416;
DI int next_item_x(int* ctr8, int* sh) {
  __syncthreads();
  if (threadIdx.x == 0) {
    int r = -1;
    const int x0 = blockIdx.x & 7;
    for (int k = 0; k < 8; ++k) { const int x = (x0 + k) & 7; const int i = atomicAdd(ctr8 + x, 1); if (i < XQ_N) { r = (x << 16) | i; break; } }
    *sh = r;
  }
  __syncthreads();
  return *sh;
}

__global__ void __launch_bounds__(256, 2) fwd(Params p) {
  extern __shared__ __attribute__((aligned(16))) char lds[];
  __shared__ int s_item;
  cg::grid_group grid = cg::this_grid();
  const int bid = blockIdx.x, nb = gridDim.x, tid = threadIdx.x, lane = tid & 63, w = tid >> 6;
  if (bid == 0) p.ctr[tid] = 0;
  for (int i = bid * 256 + tid; i < 4096 * 32; i += nb * 256) { const int t = i >> 5, j = i & 31; const float inv = powf(10000.0f, -(float)(2 * j) / 64.0f); float sn, cs; sincosf((float)t * inv, &sn, &cs); p.tabC[i] = (f32x2){cs, sn}; }
  for (int i = bid * 256 + tid; i < 4096 * 4; i += nb * 256) { const int t = i >> 2, j = i & 3; const float inv = powf(500000.0f, -(float)(2 * j) / 8.0f); float sn, cs; sincosf((float)t * inv, &sn, &cs); p.tabB[i] = (f32x2){cs, sn}; }
  for (int i = bid * 256 + tid; i < 64 * 16; i += nb * 256) { const int t = i >> 4, j = i & 15; const float inv = powf(10000.0f, -(float)(2 * j) / 32.0f); float sn, cs; sincosf((float)t * inv, &sn, &cs); p.tabA[i] = (f32x2){cs, sn}; }
  for (int l = 0; l < 2; ++l) {
    for (int i = bid * 256 + tid; i < (NINP - NIN) * 1024; i += nb * 256) p.wtin[(size_t)l * NINP * 1024 + (size_t)NIN * 1024 + i] = 0;
    for (int tl = bid; tl < 16 * 53; tl += nb) conv_T(lds, p.in[I_WIN] + (size_t)l * 1024 * NIN, 1024, NIN, p.wtin + (size_t)l * NINP * 1024, 0, tl);
    for (int tl = bid; tl < 16 * 16; tl += nb) conv_T(lds, p.in[I_WOUT] + (size_t)l * 1024 * 1024, 1024, 1024, p.wtout + (size_t)l * 1024 * 1024, 0, tl);
  }
  bf16_t* hb = p.pl;
  for (int row = bid * 4 + opaque(w); row < MT; row += nb * 8) {
    const int rb = row + nb * 4;
    const float* xin = row < M0 ? p.in[I_XP] + (size_t)row * 1024 : p.in[I_XS] + (size_t)(row - M0) * 1024;
    if (rb < MT) { const float* xinb = rb < M0 ? p.in[I_XP] + (size_t)rb * 1024 : p.in[I_XS] + (size_t)(rb - M0) * 1024;
      row_phase2(xin, xinb, p.out + (size_t)row * 1024, p.out + (size_t)rb * 1024, nullptr, nullptr, nullptr, p.in[I_NMPRE], hb + (size_t)row * 1024, hb + (size_t)rb * 1024, lane); }
    else row_phase(xin, p.out + (size_t)row * 1024, nullptr, nullptr, p.in[I_NMPRE], hb + (size_t)row * 1024, lane);
  }
  grid.sync();
  for (int l = 0; l < 2; ++l) {
    { ASrc A; A.b0 = hb; A.b1 = hb; A.b2 = hb; A.b3 = hb; A.s0 = A.s1 = A.s2 = A.s3 = 1024; A.shift = 12;
      EpiIn e; e.z = p.z; e.lds = lds; e.qg = p.in[I_AQG] + l * 64; e.kg = p.in[I_AKG] + l * 64; e.tabA = p.tabA; e.tabB = p.tabB; e.tabC = p.tabC;
      gemm_phase2(lds, A, p.wtin + (size_t)l * NINP * 1024, 1024, 14, e); }
    ctr_barrier((unsigned*)p.ctr + 96);
    for (int it = bid; it < MT / DTOK; it += nb) dprep_item(lds, p, l, it);
    ctr_barrier((unsigned*)p.ctr + 96);
    for (;;) {
      const int it = next_item_x(p.ctr + l * 16, &s_item);
      if (it < 0) break;
      const int x = it >> 16; int i = it & 0xffff;
      if (i < 32) { const int j = i & 15; rwkv_item(lds, p, i < 16 ? x : 8 + x, (j >> 2) & 3, (j >> 1) & 1, j & 1); }
      else { i -= 32;
        if (i < 128) attn_item<1>(lds, p, l, x, i >> 5, i & 31);
        else if (i < 192) { i -= 128; attn3_item<2>(lds, p, l, x, i >> 4, i & 15); }
        else if (i < 256) { i -= 192; attn3_item<0>(lds, p, l, x, i >> 4, i & 15); }
        else if (i < 320) { i -= 256; attn_item<1>(lds, p, l, 8 + x, i >> 4, i & 15); }
        else if (i < 352) { i -= 320; attn3_item<2>(lds, p, l, 8 + x, i >> 3, i & 7); }
        else { i -= 352; attn3_item<0>(lds, p, l, 8 + x, i >> 3, i & 7); }
      }
    }
    ctr_barrier((unsigned*)p.ctr + 96);
    bf16_t* wtgu = p.pl + 5 * PLANE; bf16_t* wtd = wtgu + (size_t)2 * DFF * 1024;
    for (int it = bid; it < MT / DTOK + 3 * 704; it += nb) {
      if (it < MT / DTOK) dpost_item(lds, p, l, it);
      else { const int j = it - MT / DTOK;
        if (j < 704) conv_T(lds, p.in[I_FG] + (size_t)l * 1024 * DFF, 1024, DFF, wtgu, 1, j);
        else if (j < 1408) conv_T(lds, p.in[I_FU] + (size_t)l * 1024 * DFF, 1024, DFF, wtgu, 2, j - 704);
        else conv_T(lds, p.in[I_FD] + (size_t)l * DFF * 1024, DFF, 1024, wtd, 0, j - 1408); }
    }
    ctr_barrier((unsigned*)p.ctr + 96);
    { ASrc A; A.b0 = p.z + A_Q; A.b1 = p.z + B_Q; A.b2 = p.z + C_Q; A.b3 = p.pl + 4 * PLANE; A.s0 = A.s1 = A.s2 = NIN; A.s3 = 256; A.shift = 8;
      EpiStore e; e.out = hb; e.ldc = 1024; e.nmax = 1024; e.lds = lds;
      gemm_phase2(lds, A, p.wtout + (size_t)l * 1024 * 1024, 1024, 4, e); }
    ctr_barrier((unsigned*)p.ctr + 96);
    for (int row = bid * 4 + opaque(w); row < MT; row += nb * 8) { const int rb = row + nb * 4;
      if (rb < MT) row_phase2(p.out + (size_t)row * 1024, p.out + (size_t)rb * 1024, p.out + (size_t)row * 1024, p.out + (size_t)rb * 1024, hb + (size_t)row * 1024, hb + (size_t)rb * 1024,
                              p.in[I_NMPOST] + l * 1024, p.in[I_NFPRE] + l * 1024, hb + (size_t)row * 1024, hb + (size_t)rb * 1024, lane);
      else row_phase(p.out + (size_t)row * 1024, p.out + (size_t)row * 1024, hb + (size_t)row * 1024, p.in[I_NMPOST] + l * 1024, p.in[I_NFPRE] + l * 1024, hb + (size_t)row * 1024, lane); }
    ctr_barrier((unsigned*)p.ctr + 96);
    { ASrc A; A.b0 = hb; A.b1 = hb; A.b2 = hb; A.b3 = hb; A.s0 = A.s1 = A.s2 = A.s3 = 1024; A.shift = 12;
      EpiSwiGLU e; e.out = p.z; e.lds = lds;
      gemm_phase2(lds, A, wtgu, 1024, 22, e); }
    ctr_barrier((unsigned*)p.ctr + 96);
    { ASrc A; A.b0 = p.z; A.b1 = p.z; A.b2 = p.z; A.b3 = p.z; A.s0 = A.s1 = A.s2 = A.s3 = DFF; A.shift = 12;
      EpiStore e; e.out = hb; e.ldc = 1024; e.nmax = 1024; e.lds = lds;
      gemm_phase2(lds, A, wtd, DFF, 4, e); }
    ctr_barrier((unsigned*)p.ctr + 96);
    for (int row = bid * 4 + opaque(w); row < MT; row += nb * 8) { const int rb = row + nb * 4; const float* gp2 = l == 0 ? p.in[I_NMPRE] + 1024 : nullptr;
      if (rb < MT) row_phase2(p.out + (size_t)row * 1024, p.out + (size_t)rb * 1024, p.out + (size_t)row * 1024, p.out + (size_t)rb * 1024, hb + (size_t)row * 1024, hb + (size_t)rb * 1024,
                              p.in[I_NFPOST] + l * 1024, gp2, hb + (size_t)row * 1024, hb + (size_t)rb * 1024, lane);
      else row_phase(p.out + (size_t)row * 1024, p.out + (size_t)row * 1024, hb + (size_t)row * 1024, p.in[I_NFPOST] + l * 1024, gp2, hb + (size_t)row * 1024, lane); }
    if (l == 0) ctr_barrier((unsigned*)p.ctr + 96);
  }
}

extern "C" void kernel_launch(void* const* d_in, const int* in_sizes, int n_in, void* d_out, int out_size,
                              void* d_ws, size_t ws_size, hipStream_t stream) {
  static int grid_blocks = 0;
  if (!grid_blocks) {
    int dev = 0, cus = 0, per_cu = 0;
    hipGetDevice(&dev);
    hipDeviceGetAttribute(&cus, hipDeviceAttributeMultiprocessorCount, dev);
    hipFuncSetAttribute((const void*)fwd, hipFuncAttributeMaxDynamicSharedMemorySize, LDS_BYTES);
    hipOccupancyMaxActiveBlocksPerMultiprocessor(&per_cu, fwd, 256, LDS_BYTES);
    if (per_cu > 2) per_cu = 2;
    if (per_cu < 1) per_cu = 1;
    grid_blocks = cus * per_cu;
  }
  Params p{};
  for (int i = 0; i < 28; ++i) p.in[i] = (const float*)d_in[i];
  p.out = (float*)d_out;
  char* ws = (char*)d_ws;
  size_t off = 0;
  p.z = (bf16_t*)(ws + off); off += (size_t)MT * NIN * 2;
  p.pl = (bf16_t*)(ws + off); off += 7 * PLANE * 2;
  p.wtin = (bf16_t*)(ws + off); off += (size_t)2 * NINP * 1024 * 2;
  p.wtout = (bf16_t*)(ws + off); off += (size_t)2 * 1024 * 1024 * 2;
  p.tabC = (f32x2*)(ws + off); off += (size_t)4096 * 32 * 8;
  p.tabB = (f32x2*)(ws + off); off += (size_t)4096 * 4 * 8;
  p.tabA = (f32x2*)(ws + off); off += (size_t)64 * 16 * 8;
  p.ctr = (int*)(ws + off); off += 1024;
  if (off > ws_size) fprintf(stderr, "workspace too small: need %zu have %zu\n", off, ws_size);
  void* args[] = {&p};
  hipError_t e = hipLaunchCooperativeKernel((void*)fwd, dim3(grid_blocks), dim3(256), args, LDS_BYTES, stream);
  if (e != hipSuccess) fprintf(stderr, "coop launch failed: %s (grid %d)\n", hipGetErrorString(e), grid_blocks);
}
```

```cpp
#include <hip/hip_runtime.h>
#include <hip/hip_cooperative_groups.h>
#include <cstdio>
#include <cstdint>
namespace cg = cooperative_groups;

#define DI __device__ __forceinline__
typedef unsigned short bf16_t;
typedef short bf16x8 __attribute__((ext_vector_type(8)));
typedef float f32x2 __attribute__((ext_vector_type(2)));
typedef float f32x4 __attribute__((ext_vector_type(4)));
typedef float f32x16 __attribute__((ext_vector_type(16)));
typedef unsigned u32x2 __attribute__((ext_vector_type(2)));
typedef unsigned u32x4 __attribute__((ext_vector_type(4)));
typedef __bf16 bf16x2_t __attribute__((ext_vector_type(2)));

constexpr int M0 = 32768, MT = 49152, DM = 1024, NIN = 3392, NINP = 3584, DFF = 2816;
constexpr int A_Q = 0, A_K = 256, A_V = 384, B_Q = 512, B_K = 768, B_V = 1024, C_Q = 1280, C_K = 1536, C_V = 1792, C_G = 2048, D_0 = 2304;
constexpr int PITCH = 144;
constexpr size_t PLANE = (size_t)MT * 256;
constexpr int LDS_BYTES = 73728;
constexpr float LOG2E = 1.4426950408889634f;
constexpr float EPS = 1e-6f;

enum { I_XP = 0, I_XS, I_NMPRE, I_NMPOST, I_NFPRE, I_NFPOST, I_WIN, I_WOUT, I_AQG, I_AKG, I_BLAM, I_BSUB, I_CGN, I_DMUP, I_DMUN, I_DW0, I_DWUP,
       I_DA0, I_DAUP, I_DGUP, I_DKK, I_DKA, I_DRK, I_DGNW, I_DGNB, I_FG, I_FU, I_FD };

struct Params {
  const float* in[28];
  float* out;
  bf16_t* z;
  bf16_t* pl;
  bf16_t* wtin;
  bf16_t* wtout;
  f32x2* tabC;
  f32x2* tabB;
  f32x2* tabA;
  int* ctr;
};

DI int opaque(int x) { asm volatile("" : "+v"(x)); return x; }
DI int opaque_s(int x) { asm volatile("" : "+s"(x)); return x; }
DI float bf2f(bf16_t v) { return __uint_as_float(((unsigned)v) << 16); }
DI float bflo(unsigned w) { return __uint_as_float(w << 16); }
DI float bfhi(unsigned w) { return __uint_as_float(w & 0xffff0000u); }
DI unsigned pk(float lo, float hi) { f32x2 v = {lo, hi}; bf16x2_t b = __builtin_convertvector(v, bf16x2_t); return __builtin_bit_cast(unsigned, b); }
DI bf16_t f2bf(float x) { return (bf16_t)(pk(x, 0.f) & 0xffffu); }
DI float dppf(float x, const int ctrl) { return x; }
#define DPPF(x, ctrl) __int_as_float(__builtin_amdgcn_update_dpp(0, __float_as_int(x), (ctrl), 0xF, 0xF, true))
DI float wave_sum(float v) {
  v += DPPF(v, 0xB1);
  v += DPPF(v, 0x4E);
  v += DPPF(v, 0x141);
  v += DPPF(v, 0x140);
  const int vi = __float_as_int(v);
  return (__int_as_float(__builtin_amdgcn_readlane(vi, 0)) + __int_as_float(__builtin_amdgcn_readlane(vi, 16))) +
         (__int_as_float(__builtin_amdgcn_readlane(vi, 32)) + __int_as_float(__builtin_amdgcn_readlane(vi, 48)));
}
DI float dpp_xor1(float x) { return __int_as_float(__builtin_amdgcn_update_dpp(0, __float_as_int(x), 0xB1, 0xF, 0xF, true)); }
DI float dpp_xor2(float x) { return __int_as_float(__builtin_amdgcn_update_dpp(0, __float_as_int(x), 0x4E, 0xF, 0xF, true)); }
DI float dpp_hmir(float x) { return __int_as_float(__builtin_amdgcn_update_dpp(0, __float_as_int(x), 0x141, 0xF, 0xF, true)); }
DI float red8(float x) { x += dpp_xor1(x); x += dpp_xor2(x); x += dpp_hmir(x); return x; }
DI float fexp2(float x) { return __builtin_amdgcn_exp2f(x); }
DI void seq_info(int s, int& row0, int& T) { if (s < 8) { row0 = s * 4096; T = 4096; } else { row0 = M0 + (s - 8) * 2048; T = 2048; } }
DI void row_info(int r, int& t, int& T) { if (r < M0) { t = r & 4095; T = 4096; } else { t = (r - M0) & 2047; T = 2048; } }
#define MFMA32(a, b, c) __builtin_amdgcn_mfma_f32_32x32x16_bf16((a), (b), (c), 0, 0, 0)

DI void conv_T(char* lds, const float* __restrict__ W, int K, int N, bf16_t* __restrict__ Wt, int mode, int tile) {
  float* t = (float*)lds;
  const int tid0 = opaque(threadIdx.x);
  const int ntn = N >> 6, kt = tile / ntn, nt = tile - kt * ntn, k0 = kt << 6, n0 = nt << 6;
  float wv[16];
#pragma unroll
  for (int i = 0; i < 16; ++i) { const int idx = tid0 + 256 * i, k = idx >> 6, n = idx & 63; wv[i] = W[(size_t)(k0 + k) * N + n0 + n]; }
#pragma unroll
  for (int i = 0; i < 16; ++i) { const int idx = tid0 + 256 * i, k = idx >> 6, n = idx & 63; t[k * 65 + n] = wv[i]; }
  __syncthreads();
#pragma unroll 4
  for (int i = 0; i < 8; ++i) {
    const int idx = tid0 + 256 * i, n = idx >> 5, k = (idx & 31) * 2, j = n0 + n;
    const int rho = (mode == 0) ? j : ((j >> 6) * 128 + ((j >> 5) & 1) * 64 + (mode - 1) * 32 + (j & 31));
    *(unsigned*)(Wt + (size_t)rho * K + k0 + k) = pk(t[k * 65 + n], t[(k + 1) * 65 + n]);
  }
  __syncthreads();
}

DI void row_phase(const float* __restrict__ xin, float* __restrict__ xout, const bf16_t* addsrc, const float* __restrict__ gpost,
                  const float* __restrict__ gpre, bf16_t* hout, int lane_in) {
  const int lane = opaque(lane_in);
  f32x4 x[4];
#pragma unroll
  for (int i = 0; i < 4; ++i) x[i] = *(const f32x4*)(xin + i * 256 + lane * 4);
  if (addsrc) {
    f32x4 m[4]; float ss = 0.f;
#pragma unroll
    for (int i = 0; i < 4; ++i) { const u32x2 w = *(const u32x2*)(addsrc + i * 256 + lane * 4); m[i] = (f32x4){bflo(w.x), bfhi(w.x), bflo(w.y), bfhi(w.y)};
      ss += m[i][0] * m[i][0] + m[i][1] * m[i][1] + m[i][2] * m[i][2] + m[i][3] * m[i][3]; }
    ss = wave_sum(ss); const float rs = rsqrtf(ss * (1.0f / 1024.0f) + EPS);
#pragma unroll
    for (int i = 0; i < 4; ++i) { const f32x4 g = *(const f32x4*)(gpost + i * 256 + lane * 4); x[i] += m[i] * rs * g; }
  }
#pragma unroll
  for (int i = 0; i < 4; ++i) *(f32x4*)(xout + i * 256 + lane * 4) = x[i];
  if (gpre) {
    float ss = 0.f;
#pragma unroll
    for (int i = 0; i < 4; ++i) ss += x[i][0] * x[i][0] + x[i][1] * x[i][1] + x[i][2] * x[i][2] + x[i][3] * x[i][3];
    ss = wave_sum(ss); const float rs = rsqrtf(ss * (1.0f / 1024.0f) + EPS);
#pragma unroll
    for (int i = 0; i < 4; ++i) { const f32x4 g = *(const f32x4*)(gpre + i * 256 + lane * 4); const f32x4 hv = x[i] * rs * g;
      u32x2 w; w.x = pk(hv[0], hv[1]); w.y = pk(hv[2], hv[3]); *(u32x2*)(hout + i * 256 + lane * 4) = w; }
  }
}

DI void row_phase2(const float* __restrict__ xinA, const float* __restrict__ xinB, float* __restrict__ xoutA, float* __restrict__ xoutB, const bf16_t* addA, const bf16_t* addB,
                   const float* __restrict__ gpost, const float* __restrict__ gpre, bf16_t* houtA, bf16_t* houtB, int lane_in) {
  const int lane = opaque(lane_in);
  f32x4 x[2][4]; u32x2 aw[2][4];
#pragma unroll
  for (int i = 0; i < 4; ++i) { x[0][i] = *(const f32x4*)(xinA + i * 256 + lane * 4); x[1][i] = *(const f32x4*)(xinB + i * 256 + lane * 4); }
  if (addA) {
#pragma unroll
    for (int i = 0; i < 4; ++i) { aw[0][i] = *(const u32x2*)(addA + i * 256 + lane * 4); aw[1][i] = *(const u32x2*)(addB + i * 256 + lane * 4); }
#pragma unroll
    for (int r = 0; r < 2; ++r) {
      f32x4 m[4]; float ss = 0.f;
#pragma unroll
      for (int i = 0; i < 4; ++i) { const u32x2 w = aw[r][i]; m[i] = (f32x4){bflo(w.x), bfhi(w.x), bflo(w.y), bfhi(w.y)};
        ss += m[i][0] * m[i][0] + m[i][1] * m[i][1] + m[i][2] * m[i][2] + m[i][3] * m[i][3]; }
      ss = wave_sum(ss); const float rs = rsqrtf(ss * (1.0f / 1024.0f) + EPS);
#pragma unroll
      for (int i = 0; i < 4; ++i) { const f32x4 g = *(const f32x4*)(gpost + i * 256 + lane * 4); x[r][i] += m[i] * rs * g; }
    }
  }
#pragma unroll
  for (int i = 0; i < 4; ++i) { *(f32x4*)(xoutA + i * 256 + lane * 4) = x[0][i]; *(f32x4*)(xoutB + i * 256 + lane * 4) = x[1][i]; }
  if (gpre) {
#pragma unroll
    for (int r = 0; r < 2; ++r) {
      float ss = 0.f;
#pragma unroll
      for (int i = 0; i < 4; ++i) ss += x[r][i][0] * x[r][i][0] + x[r][i][1] * x[r][i][1] + x[r][i][2] * x[r][i][2] + x[r][i][3] * x[r][i][3];
      ss = wave_sum(ss); const float rs = rsqrtf(ss * (1.0f / 1024.0f) + EPS);
      bf16_t* ho = r == 0 ? houtA : houtB;
#pragma unroll
      for (int i = 0; i < 4; ++i) { const f32x4 g = *(const f32x4*)(gpre + i * 256 + lane * 4); const f32x4 hv = x[r][i] * rs * g;
        u32x2 w; w.x = pk(hv[0], hv[1]); w.y = pk(hv[2], hv[3]); *(u32x2*)(ho + i * 256 + lane * 4) = w; }
    }
  }
}

struct ASrc { const bf16_t* b0; const bf16_t* b1; const bf16_t* b2; const bf16_t* b3; int s0, s1, s2, s3; int shift; };

DI void store_piece64(char* img, const f32x16 (&acc)[2][2], bf16_t* out, size_t ld, int row0, int col0, int l31, int h) {
#pragma unroll
  for (int mf = 0; mf < 2; ++mf)
#pragma unroll
    for (int nf = 0; nf < 2; ++nf)
#pragma unroll
      for (int g = 0; g < 4; ++g) { u32x2 v; v.x = pk(acc[mf][nf][4 * g], acc[mf][nf][4 * g + 1]); v.y = pk(acc[mf][nf][4 * g + 2], acc[mf][nf][4 * g + 3]);
        *(u32x2*)(img + (mf * 32 + l31) * PITCH + (nf * 32 + 8 * g + 4 * h) * 2) = v; }
  const int ln = l31 + 32 * h;
#pragma unroll 2
  for (int i = 0; i < 8; ++i) { const int q = ln + 64 * i, r = q >> 3, c8 = q & 7;
    const u32x4 v = *(const u32x4*)(img + r * PITCH + c8 * 16); *(u32x4*)(out + (size_t)(row0 + r) * ld + col0 + c8 * 8) = v; }
}
DI void store_piece32(char* img, const f32x16 (&a0), const f32x16 (&a1), bf16_t* out, size_t ld, int row0, int col0, int l31, int h) {
#pragma unroll
  for (int g = 0; g < 4; ++g) { u32x2 v; v.x = pk(a0[4 * g], a0[4 * g + 1]); v.y = pk(a0[4 * g + 2], a0[4 * g + 3]); *(u32x2*)(img + l31 * PITCH + (8 * g + 4 * h) * 2) = v;
    u32x2 u; u.x = pk(a1[4 * g], a1[4 * g + 1]); u.y = pk(a1[4 * g + 2], a1[4 * g + 3]); *(u32x2*)(img + l31 * PITCH + (32 + 8 * g + 4 * h) * 2) = u; }
  const int ln = l31 + 32 * h;
#pragma unroll
  for (int i = 0; i < 4; ++i) { const int q = ln + 64 * i, r = q >> 3, c8 = q & 7;
    const u32x4 v = *(const u32x4*)(img + r * PITCH + c8 * 16); *(u32x4*)(out + (size_t)(row0 + r) * ld + col0 + c8 * 8) = v; }
}
struct EpiStore { bf16_t* out; int ldc; int nmax; char* lds;
  DI void operator()(const f32x16 (&acc)[2][2], int mb, int nb, int n0, int wc, int l31, int h) const {
    if (nb >= nmax) return;
    store_piece64(lds + (threadIdx.x >> 6) * 9216, acc, out, (size_t)ldc, mb, nb, l31, h);
  } };
struct EpiSwiGLU { bf16_t* out; char* lds;
  DI void operator()(const f32x16 (&acc)[2][2], int mb, int nb, int n0, int wc, int l31, int h) const {
    const int hc = (nb >> 6) * 32;
    char* img = lds + (threadIdx.x >> 6) * 9216;
#pragma unroll
    for (int mf = 0; mf < 2; ++mf)
#pragma unroll
      for (int g = 0; g < 4; ++g) { float r[4];
#pragma unroll
        for (int e = 0; e < 4; ++e) { const float gt = acc[mf][0][4 * g + e], up = acc[mf][1][4 * g + e]; r[e] = gt / (1.0f + __expf(-gt)) * up; }
        u32x2 v; v.x = pk(r[0], r[1]); v.y = pk(r[2], r[3]); *(u32x2*)(img + (mf * 32 + l31) * PITCH + (8 * g + 4 * h) * 2) = v; }
    const int ln = l31 + 32 * h;
#pragma unroll
    for (int i = 0; i < 4; ++i) { const int q = ln + 64 * i, r = q >> 2, c4 = q & 3;
      const u32x4 v = *(const u32x4*)(img + r * PITCH + c4 * 16); *(u32x4*)(out + (size_t)(mb + r) * DFF + hc + c4 * 8) = v; }
  } };

struct EpiIn { bf16_t* z; char* lds; const float* qg; const float* kg; const f32x2* tabA; const f32x2* tabB; const f32x2* tabC;
  DI void operator()(f32x16 (&acc)[2][2], int mb, int nb, int n0, int wc, int l31, int h) const {
    if (nb >= NIN) return;
    const bool isv = (nb >= A_V && nb < B_Q) || (nb >= B_V && nb < C_Q) || (nb >= C_V && nb < C_G);
    if (isv) {
      const int wv = (threadIdx.x >> 6);
      bf16_t* img = (bf16_t*)(lds + 32768 + wv * 9216);
#pragma unroll
      for (int mf = 0; mf < 2; ++mf)
#pragma unroll
        for (int nf = 0; nf < 2; ++nf)
#pragma unroll
          for (int i = 0; i < 16; ++i) { const int d = nf * 32 + (i & 3) + 8 * (i >> 2) + 4 * h; img[d * 72 + mf * 32 + l31] = f2bf(acc[mf][nf][i]); }
      __builtin_amdgcn_s_waitcnt(0xc07f);
      const int ln = l31 + 32 * h;
#pragma unroll
      for (int i = 0; i < 8; ++i) { const int q = ln + 64 * i, d = q >> 3, c8 = q & 7;
        const u32x4 v = *(const u32x4*)(img + d * 72 + c8 * 8); *(u32x4*)(z + (size_t)(mb + d) * NIN + nb + c8 * 8) = v; }
      return;
    }
#pragma unroll
    for (int mf = 0; mf < 2; ++mf) {
      const int row = mb + mf * 32 + l31; int t, T; row_info(row, t, T);
      if (nb < A_V) {
        const bool isq = nb < A_K; const float* gn = isq ? qg : kg;
        float ss = 0.f;
#pragma unroll
        for (int nf = 0; nf < 2; ++nf)
#pragma unroll
          for (int i = 0; i < 16; ++i) ss += acc[mf][nf][i] * acc[mf][nf][i];
        ss += __shfl_xor(ss, 32);
        const float rs = rsqrtf(ss * (1.0f / 64.0f) + EPS) * (isq ? 0.125f * LOG2E : 1.0f);
#pragma unroll
        for (int nf = 0; nf < 2; ++nf) {
          const int pos = nf == 0 ? (t >> 6) : (t & 63);
#pragma unroll
          for (int g = 0; g < 4; ++g)
#pragma unroll
            for (int e = 0; e < 4; ++e) acc[mf][nf][4 * g + e] *= rs * gn[nf * 32 + 8 * g + 4 * h + e];
#pragma unroll
          for (int g = 0; g < 2; ++g)
#pragma unroll
            for (int e = 0; e < 4; ++e) { const f32x2 cs = tabA[pos * 16 + 8 * g + 4 * h + e];
              const float x1 = acc[mf][nf][4 * g + e], x2 = acc[mf][nf][4 * (g + 2) + e];
              acc[mf][nf][4 * g + e] = x1 * cs.x - x2 * cs.y; acc[mf][nf][4 * (g + 2) + e] = x2 * cs.x + x1 * cs.y; }
        }
      } else if (nb >= B_Q && nb < B_V) {
        const bool isq = nb < B_K;
#pragma unroll
        for (int nf = 0; nf < 2; ++nf) {
#pragma unroll
          for (int e = 0; e < 4; ++e) { const f32x2 cs = tabB[t * 4 + e]; const float v = acc[mf][nf][e]; const float o = __shfl_xor(v, 32);
            acc[mf][nf][e] = (h == 0) ? (v * cs.x - o * cs.y) : (v * cs.x + o * cs.y); }
          if (isq) {
#pragma unroll
            for (int i = 0; i < 16; ++i) acc[mf][nf][i] *= 0.17677669529663687f * LOG2E; }
        }
      } else if (nb >= C_Q && nb < C_V) {
        const float sc = nb < C_K ? 1.0f : 0.125f;
#pragma unroll
        for (int g = 0; g < 4; ++g) {
#pragma unroll
          for (int e = 0; e < 4; ++e) { const f32x2 cs = tabC[t * 32 + 8 * g + 4 * h + e]; const float x1 = acc[mf][0][4 * g + e], x2 = acc[mf][1][4 * g + e];
            acc[mf][0][4 * g + e] = (x1 * cs.x - x2 * cs.y) * sc; acc[mf][1][4 * g + e] = (x2 * cs.x + x1 * cs.y) * sc; }
          if (g & 1) __builtin_amdgcn_sched_barrier(0); }
      }
      store_piece32(lds + (threadIdx.x >> 6) * 9216, acc[mf][0], acc[mf][1], z, (size_t)NIN, mb + mf * 32, nb, l31, h);
    }
  } };

#define LASP __attribute__((address_space(3)))
template <class Epi>
DI void gemm_tile(char* lds, const ASrc& A, const bf16_t* __restrict__ Bt, int K, int m0, int n0, const Epi& epi, bool first, bool has_next, int m0n, int n0n) {
  const int tid = opaque(threadIdx.x), lane = tid & 63, w = __builtin_amdgcn_readfirstlane(tid >> 6), wr = w >> 1, wc = w & 1, l31 = lane & 31, h = lane >> 5;
  const int nk = K >> 6, smask = (1 << A.shift) - 1;
  LASP char* ldsl = (LASP char*)lds;
  f32x16 acc[2][2];
#pragma unroll
  for (int a = 0; a < 2; ++a)
#pragma unroll
    for (int b = 0; b < 2; ++b)
#pragma unroll
      for (int i = 0; i < 16; ++i) acc[a][b][i] = 0.f;
  const int lrow = lane >> 3, lslot = lane & 7;
  int goffA[4], goffB[4];
#pragma unroll
  for (int i = 0; i < 4; ++i) { const int r = w * 32 + i * 8 + lrow, c = lslot ^ ((r >> 1) & 7); goffA[i] = r; goffB[i] = r * K + c * 8; goffA[i] = (goffA[i] << 3) | c; }
#define GEMM_ISSUE(kt, st, M0_, N0_) do { const int k0_ = (kt) << 6, seg_ = k0_ >> A.shift, kk_ = k0_ & smask; \
    const bf16_t* bp_ = seg_ == 0 ? A.b0 : seg_ == 1 ? A.b1 : seg_ == 2 ? A.b2 : A.b3; const int st_ = seg_ == 0 ? A.s0 : seg_ == 1 ? A.s1 : seg_ == 2 ? A.s2 : A.s3; \
    _Pragma("unroll") for (int i_ = 0; i_ < 4; ++i_) { \
      const bf16_t* ga_ = bp_ + (size_t)((M0_) + (goffA[i_] >> 3)) * st_ + kk_ + (goffA[i_] & 7) * 8; \
      __builtin_amdgcn_global_load_lds((const unsigned*)ga_, (LASP unsigned*)(ldsl + (st) * 32768 + (w * 4 + i_) * 1024), 16, 0, 0); \
      const bf16_t* gb_ = Bt + (size_t)(N0_) * K + goffB[i_] + k0_; \
      __builtin_amdgcn_global_load_lds((const unsigned*)gb_, (LASP unsigned*)(ldsl + (st) * 32768 + 16384 + (w * 4 + i_) * 1024), 16, 0, 0); } } while (0)
  const int xr = (l31 >> 1) & 7;
  int coff[4];
#pragma unroll
  for (int s = 0; s < 4; ++s) coff[s] = ((2 * s + h) ^ xr) * 16;
#define GEMM_COMPUTE(st) do { const char* as = lds + (st) * 32768; const char* bs = as + 16384; \
    bf16x8 af[4][2], wf[4][2]; \
    _Pragma("unroll") for (int s = 0; s < 4; ++s) { \
      _Pragma("unroll") for (int mf = 0; mf < 2; ++mf) af[s][mf] = *(const bf16x8*)(as + (wr * 64 + mf * 32 + l31) * 128 + coff[s]); \
      _Pragma("unroll") for (int nf = 0; nf < 2; ++nf) wf[s][nf] = *(const bf16x8*)(bs + (wc * 64 + nf * 32 + l31) * 128 + coff[s]); } \
    __builtin_amdgcn_sched_barrier(0); __builtin_amdgcn_s_setprio(1); \
    _Pragma("unroll") for (int s = 0; s < 4; ++s) \
      _Pragma("unroll") for (int mf = 0; mf < 2; ++mf) _Pragma("unroll") for (int nf = 0; nf < 2; ++nf) acc[mf][nf] = MFMA32(wf[s][nf], af[s][mf], acc[mf][nf]); \
    __builtin_amdgcn_s_setprio(0); __builtin_amdgcn_sched_barrier(0); } while (0)
  if (first) GEMM_ISSUE(0, 0, m0, n0);
  for (int kt = 0; kt < nk; kt += 2) {
    asm volatile("s_waitcnt vmcnt(0)" ::: "memory"); __syncthreads();
    GEMM_ISSUE(kt + 1, 1, m0, n0);
    GEMM_COMPUTE(0);
    asm volatile("s_waitcnt vmcnt(0)" ::: "memory"); __syncthreads();
    if (kt + 2 < nk) GEMM_ISSUE(kt + 2, 0, m0, n0);
    GEMM_COMPUTE(1);
  }
  __syncthreads();
  if (has_next) GEMM_ISSUE(0, 0, m0n, n0n);
  epi(acc, m0 + wr * 64, n0 + wc * 64, n0, wc, l31, h);
  __syncthreads();
#undef GEMM_ISSUE
#undef GEMM_COMPUTE
}

template <class Epi>
DI void gemm_phase(char* lds, const ASrc& A, const bf16_t* Bt, int K, int ntn, const Epi& epi) {
  const int xcd = blockIdx.x & 7, j = blockIdx.x >> 3, nloc = gridDim.x >> 3, per = 48 * ntn, grp = 8 * ntn;
  bool first = true;
  for (int li = j; li < per; li += nloc) {
    const int sg = li / grp, wi = li - sg * grp, nt = wi >> 3, mt = xcd * 48 + sg * 8 + (wi & 7);
    const int ln = li + nloc; const bool has_next = ln < per;
    const int sgn = ln / grp, win = ln - sgn * grp, ntn2 = win >> 3, mtn = xcd * 48 + sgn * 8 + (win & 7);
    gemm_tile(lds, A, Bt, K, mt * 128, nt * 128, epi, first, has_next, mtn * 128, ntn2 * 128);
    first = false;
  }
}

DI void prep_item(char* lds, const Params& p, int layer, int item) {
  const int tid = opaque(threadIdx.x), lane = tid & 63, w = tid >> 6;
  const int rowb = item * 64; int tb, T; row_info(rowb, tb, T);
  const float* qg = p.in[I_AQG] + layer * 64; const float* kg = p.in[I_AKG] + layer * 64;
  const float qgl = qg[lane], kgl = kg[lane];
  for (int tt = 0; tt < 16; ++tt) {
    const int row = rowb + w * 16 + tt, t = tb + w * 16 + tt;
    bf16_t* zr = p.z + (size_t)row * NIN;
    {
      const int j = lane & 31, i = j & 15; const bool first = j < 16; const int pos = (lane < 32) ? (t >> 6) : (t & 63);
      const f32x2 cs = p.tabA[pos * 16 + i];
#pragma unroll
      for (int hd = 0; hd < 6; ++hd) {
        bf16_t* ptr = zr + (hd < 4 ? A_Q + hd * 64 : A_K + (hd - 4) * 64) + lane;
        float v = bf2f(*ptr);
        const float ss = wave_sum(v * v);
        v = v * rsqrtf(ss * (1.0f / 64.0f) + EPS) * (hd < 4 ? qgl : kgl);
        const float o = __shfl_xor(v, 16);
        float r = first ? (v * cs.x - o * cs.y) : (v * cs.x + o * cs.y);
        if (hd < 4) r *= 0.125f * LOG2E;
        *ptr = f2bf(r);
      }
    }
    {
      const int d = lane & 31; const f32x2 cs = p.tabB[t * 4 + (d & 3)];
#pragma unroll
      for (int c = 0; c < 8; ++c) {
        bf16_t* ptr = zr + (c < 4 ? B_Q + c * 64 : B_K + (c - 4) * 64) + lane;
        float v = bf2f(*ptr);
        const float o = __shfl_xor(v, 4);
        float r = v;
        if (d < 8) r = (d < 4) ? (v * cs.x - o * cs.y) : (v * cs.x + o * cs.y);
        if (c < 4) r *= 0.17677669529663687f * LOG2E;
        *ptr = f2bf(r);
      }
    }
    {
      const f32x2 cs = p.tabC[t * 32 + (lane & 31)];
#pragma unroll
      for (int c = 0; c < 8; ++c) {
        bf16_t* ptr = zr + (c < 4 ? C_Q + c * 64 : C_K + (c - 4) * 64) + lane;
        const float v = bf2f(*ptr);
        const float o = __shfl_xor(v, 32);
        float r = (lane < 32) ? (v * cs.x - o * cs.y) : (v * cs.x + o * cs.y);
        if (c >= 4) r *= 0.125f;
        *ptr = f2bf(r);
      }
    }
  }
  bf16_t* tl = (bf16_t*)lds;
  const int r = tid >> 2, c0 = (tid & 3) * 16;
  for (int sl = 0; sl < 10; ++sl) {
    const int col = sl < 2 ? A_V + sl * 64 : sl < 6 ? B_V + (sl - 2) * 64 : C_V + (sl - 6) * 64;
    bf16_t* gp = p.z + (size_t)(rowb + r) * NIN + col + c0;
    const u32x4 v0 = *(const u32x4*)gp, v1 = *(const u32x4*)(gp + 8);
    __syncthreads();
#pragma unroll
    for (int e = 0; e < 4; ++e) {
      tl[(c0 + 2 * e) * 72 + r] = (bf16_t)(v0[e] & 0xffffu); tl[(c0 + 2 * e + 1) * 72 + r] = (bf16_t)(v0[e] >> 16);
      tl[(c0 + 8 + 2 * e) * 72 + r] = (bf16_t)(v1[e] & 0xffffu); tl[(c0 + 8 + 2 * e + 1) * 72 + r] = (bf16_t)(v1[e] >> 16);
    }
    __syncthreads();
    const u32x4 o0 = *(const u32x4*)(tl + r * 72 + c0), o1 = *(const u32x4*)(tl + r * 72 + c0 + 8);
    *(u32x4*)gp = o0; *(u32x4*)(gp + 8) = o1;
  }
  __syncthreads();
}

DI float dshift(const Params& p, const float* mup, const float* mun, int row, int t, int T, int dc) {
  const bf16_t* zp = p.z + (size_t)row * NIN + D_0 + dc;
  const float z = bf2f(*zp);
  const float zprev = (t > 0) ? bf2f(*(zp - NIN)) : 0.f;
  const float znext = (t < T - 1) ? bf2f(*(zp + NIN)) : 0.f;
  return z + mup[dc] * (zprev - z) + mun[dc] * (znext - z);
}
DI float sigmoidf_(float x) { return 1.0f / (1.0f + __expf(-x)); }
DI float omdecay(float ww) {
  const float e = 0.6065306597126334f / (1.0f + __expf(-ww));
  return 1.0f - __expf(-e);
}
DI float fast_tanh(float x) { const float xc = fminf(fmaxf(x, -15.f), 15.f); return 1.0f - 2.0f / (1.0f + __expf(2.0f * xc)); }
constexpr int DTOK = 16;
DI void dprep_item(char* lds, const Params& p, int layer, int item) {
  const int tid = opaque(threadIdx.x);
  const int rowb = item * DTOK; int tb, T; row_info(rowb, tb, T);
  const float* mup = p.in[I_DMUP] + layer * 1088; const float* mun = p.in[I_DMUN] + layer * 1088;
  float* su = (float*)lds;
  bf16_t* stg = (bf16_t*)(lds + 12288);
#pragma unroll
  for (int i = 0; i < 12; ++i) {
    const int idx = tid + 256 * i, tok = idx / 192, c = idx - tok * 192;
    float u = dshift(p, mup, mun, rowb + tok, tb + tok, T, 768 + c);
    if (c < 128) u = fast_tanh(u);
    su[c * DTOK + tok] = u;
  }
  __syncthreads();
  const int c = tid;
  const float w0f = p.in[I_DW0][(layer * 2 + 0) * 256 + c], w0b = p.in[I_DW0][(layer * 2 + 1) * 256 + c];
  const float a0 = p.in[I_DA0][layer * 256 + c], kkw = p.in[I_DKK][layer * 256 + c], kaw = p.in[I_DKA][layer * 256 + c];
  float zr[DTOK + 2], zk[DTOK + 2], zv[DTOK + 2];
  { const bf16_t* zp = p.z + (size_t)rowb * NIN + D_0 + c;
#pragma unroll
    for (int i = 0; i < DTOK + 2; ++i) { const int t = tb - 1 + i; const bool ok = (t >= 0) && (t < T); const bf16_t* q = zp + (ptrdiff_t)(i - 1) * NIN;
      zr[i] = ok ? bf2f(q[0]) : 0.f; zk[i] = ok ? bf2f(q[256]) : 0.f; zv[i] = ok ? bf2f(q[512]) : 0.f; } }
  const float mpr = mup[c], mnr = mun[c], mpk = mup[256 + c], mnk = mun[256 + c], mpv = mup[512 + c], mnv = mun[512 + c];
  float accf[DTOK], accb[DTOK], acca[DTOK];
#pragma unroll
  for (int k = 0; k < DTOK; ++k) { accf[k] = 0.f; accb[k] = 0.f; acca[k] = 0.f; }
  const float* wupf = p.in[I_DWUP] + (size_t)(layer * 2 + 0) * 64 * 256 + c;
  const float* wupb = p.in[I_DWUP] + (size_t)(layer * 2 + 1) * 64 * 256 + c;
  const float* aup = p.in[I_DAUP] + (size_t)layer * 64 * 256 + c;
#pragma unroll 2
  for (int j = 0; j < 64; ++j) {
    const float wf = wupf[j * 256], wb = wupb[j * 256], wa = aup[j * 256];
#pragma unroll
    for (int q = 0; q < 4; ++q) {
      const f32x4 f0 = *(const f32x4*)(su + j * DTOK + 4 * q), b0 = *(const f32x4*)(su + (64 + j) * DTOK + 4 * q), a0v = *(const f32x4*)(su + (128 + j) * DTOK + 4 * q);
#pragma unroll
      for (int k = 0; k < 4; ++k) { accf[4 * q + k] += f0[k] * wf; accb[4 * q + k] += b0[k] * wb; acca[4 * q + k] += a0v[k] * wa; }
    }
  }
#pragma unroll
  for (int k = 0; k < DTOK; ++k) {
    const float r = zr[k + 1] + mpr * (zr[k] - zr[k + 1]) + mnr * (zr[k + 2] - zr[k + 1]);
    const float kx = zk[k + 1] + mpk * (zk[k] - zk[k + 1]) + mnk * (zk[k + 2] - zk[k + 1]);
    const float v = zv[k + 1] + mpv * (zv[k] - zv[k + 1]) + mnv * (zv[k + 2] - zv[k + 1]);
    const float omf = omdecay(w0f + accf[k]), omb = omdecay(w0b + accb[k]);
    const float a = sigmoidf_(a0 + acca[k]);
    float kk = kx * kkw; const float n2 = wave_sum(kk * kk);
    kk = kk * rsqrtf(fmaxf(n2, 1e-24f));
    const float kmod = kx * (1.0f + (a - 1.0f) * kaw), b = kk * a;
    bf16_t* so = stg + k * 256 + c;
    so[0] = f2bf(r); so[DTOK * 256] = f2bf(kmod); so[2 * DTOK * 256] = f2bf(v); so[3 * DTOK * 256] = f2bf(-kk);
    so[4 * DTOK * 256] = f2bf(b); so[5 * DTOK * 256] = f2bf(omf); so[6 * DTOK * 256] = f2bf(omb);
  }
  __syncthreads();
#pragma unroll
  for (int i = 0; i < 14; ++i) {
    const int q = tid + 256 * i, pln = q >> 9, rem = q & 511, tok = rem >> 5, c16 = rem & 31;
    const u32x4 v = *(const u32x4*)(stg + pln * (DTOK * 256) + tok * 256 + c16 * 8);
    *(u32x4*)(p.pl + (size_t)pln * PLANE + (size_t)(rowb + tok) * 256 + c16 * 8) = v;
  }
  __syncthreads();
}

DI void dpost_item(char* lds, const Params& p, int layer, int item) {
  const int tid = opaque(threadIdx.x);
  const int rowb = item * DTOK; int tb, T; row_info(rowb, tb, T);
  const float* mup = p.in[I_DMUP] + layer * 1088; const float* mun = p.in[I_DMUN] + layer * 1088;
  float* sg = (float*)lds;
  bf16_t* stg = (bf16_t*)(lds + 8192);
#pragma unroll
  for (int i = 0; i < 8; ++i) { const int idx = tid + 256 * i, tok = idx >> 7, c = idx & 127; sg[c * DTOK + tok] = sigmoidf_(dshift(p, mup, mun, rowb + tok, tb + tok, T, 960 + c)); }
  __syncthreads();
  const int c = tid;
  float acc[DTOK];
#pragma unroll
  for (int k = 0; k < DTOK; ++k) acc[k] = 0.f;
  float yv[DTOK], rv_[DTOK], kmv[DTOK], vv_[DTOK];
#pragma unroll
  for (int k = 0; k < DTOK; ++k) { const int row = rowb + k; const bf16_t* zd = p.z + (size_t)row * NIN + D_0; const size_t o = (size_t)row * 256 + c;
    yv[k] = bf2f(zd[c]) + bf2f(zd[256 + c]); rv_[k] = bf2f(p.pl[o]); kmv[k] = bf2f(p.pl[PLANE + o]); vv_[k] = bf2f(p.pl[2 * PLANE + o]); }
  const float* gup = p.in[I_DGUP] + (size_t)layer * 128 * 256 + c;
#pragma unroll 4
  for (int j = 0; j < 128; ++j) { const float gw = gup[j * 256];
#pragma unroll
    for (int q = 0; q < 4; ++q) { const f32x4 s0 = *(const f32x4*)(sg + j * DTOK + 4 * q);
#pragma unroll
      for (int k = 0; k < 4; ++k) acc[4 * q + k] += s0[k] * gw; } }
  const float gnw = p.in[I_DGNW][layer * 256 + c], gnb = p.in[I_DGNB][layer * 256 + c], rk = p.in[I_DRK][layer * 256 + c];
#pragma unroll
  for (int k = 0; k < DTOK; ++k) {
    const float y = yv[k];
    const float mean = wave_sum(y) * (1.0f / 64.0f); const float d = y - mean; const float var = wave_sum(d * d) * (1.0f / 64.0f);
    const float yn = d * rsqrtf(var + 64e-5f) * gnw + gnb;
    const float r = rv_[k], km = kmv[k], v = vv_[k];
    const float bonus = wave_sum(r * km * rk);
    stg[k * 256 + c] = f2bf((yn + bonus * v) * acc[k]);
  }
  __syncthreads();
#pragma unroll
  for (int i = 0; i < 2; ++i) { const int q = tid + 256 * i, tok = q >> 5, c16 = q & 31;
    const u32x4 v = *(const u32x4*)(stg + tok * 256 + c16 * 8);
    *(u32x4*)(p.pl + 4 * PLANE + (size_t)(rowb + tok) * 256 + c16 * 8) = v; }
  __syncthreads();
}

DI void rwkv_item(char* lds, const Params& p, int seq, int head, int dir, int half) {
  int row0, T; seq_info(seq, row0, T);
  const int tid = opaque(threadIdx.x), kc = tid & 7, vrow = half * 32 + (tid >> 3);
  float* st = (float*)lds;
  f32x2 S[4];
#pragma unroll
  for (int j = 0; j < 4; ++j) S[j] = (f32x2){0.f, 0.f};
  const int nchunk = T >> 4;
  u32x4 rg[3];
  const int tsel = tid >> 7, srem = tid & 127, sstep = srem >> 3, sc8 = srem & 7;
#define RW_GLOAD(c) do { _Pragma("unroll") for (int i_ = 0; i_ < 3; ++i_) { const int tens_ = tsel + 2 * i_; \
      const int plane_ = tens_ == 0 ? (dir ? 6 : 5) : tens_ == 1 ? 3 : tens_ == 2 ? 4 : tens_ == 3 ? 1 : tens_ == 4 ? 0 : 2; \
      const int t_ = dir ? (T - 1 - ((c) * 16 + sstep)) : ((c) * 16 + sstep); \
      rg[i_] = *(const u32x4*)(p.pl + (size_t)plane_ * PLANE + (size_t)(row0 + t_) * 256 + head * 64 + sc8 * 8); } } while (0)
#define RW_LSTORE(buf) do { _Pragma("unroll") for (int i_ = 0; i_ < 3; ++i_) { const int tens_ = tsel + 2 * i_; \
      f32x4 a_ = {bflo(rg[i_].x), bfhi(rg[i_].x), bflo(rg[i_].y), bfhi(rg[i_].y)}, b_ = {bflo(rg[i_].z), bfhi(rg[i_].z), bflo(rg[i_].w), bfhi(rg[i_].w)}; \
      if (tens_ == 0) { a_ = 1.0f - a_; b_ = 1.0f - b_; } \
      float* d_ = st + (((buf) * 16 + sstep) * 6 + tens_) * 64 + sc8 * 8; *(f32x4*)d_ = a_; *(f32x4*)(d_ + 4) = b_; } } while (0)
  __builtin_amdgcn_s_setprio(3);
  RW_GLOAD(0); RW_LSTORE(0); __syncthreads();
  bf16_t* ybase = p.z + (size_t)row0 * NIN + D_0 + dir * 256 + head * 64 + half * 32;
  for (int c = 0; c < nchunk; ++c) {
    if (c + 1 < nchunk) RW_GLOAD(c + 1);
    const float* sb = st + (c & 1) * (16 * 384);
    unsigned* yb = (unsigned*)(lds + 49152) + (c & 1) * 256;
    if (c > 0 && tid < 64) {
      const int sp = tid >> 2, part = tid & 3, tt = (c - 1) * 16 + sp; const int t_ = dir ? (T - 1 - tt) : tt;
      const u32x4 v = *(const u32x4*)((unsigned*)(lds + 49152) + ((c - 1) & 1) * 256 + sp * 16 + part * 4);
      *(u32x4*)(ybase + (size_t)t_ * NIN + part * 8) = v; }
#define RW_FETCH(S_, s_) do { const float* q_ = sb + (s_) * 384 + kc * 8; \
      S_##w0 = *(const f32x4*)(q_); S_##w1 = *(const f32x4*)(q_ + 4); S_##n0 = *(const f32x4*)(q_ + 64); S_##n1 = *(const f32x4*)(q_ + 68); \
      S_##b0 = *(const f32x4*)(q_ + 128); S_##b1 = *(const f32x4*)(q_ + 132); S_##k0 = *(const f32x4*)(q_ + 192); S_##k1 = *(const f32x4*)(q_ + 196); \
      S_##r0 = *(const f32x4*)(q_ + 256); S_##r1 = *(const f32x4*)(q_ + 260); S_##vv = sb[(s_) * 384 + 320 + vrow]; } while (0)
#define LO2(x) ((f32x2){(x)[0], (x)[1]})
#define HI2(x) ((f32x2){(x)[2], (x)[3]})
#define RW_STEP(S_, s_) do { \
      f32x2 a2 = S[0] * LO2(S_##n0); a2 += S[1] * HI2(S_##n0); a2 += S[2] * LO2(S_##n1); a2 += S[3] * HI2(S_##n1); \
      const float sa = red8(a2.x + a2.y); const float vx = S_##vv; \
      S[0] = S[0] * LO2(S_##w0) + (LO2(S_##b0) * sa + LO2(S_##k0) * vx); S[1] = S[1] * HI2(S_##w0) + (HI2(S_##b0) * sa + HI2(S_##k0) * vx); \
      S[2] = S[2] * LO2(S_##w1) + (LO2(S_##b1) * sa + LO2(S_##k1) * vx); S[3] = S[3] * HI2(S_##w1) + (HI2(S_##b1) * sa + HI2(S_##k1) * vx); \
      f32x2 y2 = S[0] * LO2(S_##r0); y2 += S[1] * HI2(S_##r0); y2 += S[2] * LO2(S_##r1); y2 += S[3] * HI2(S_##r1); \
      const float y = red8(y2.x + y2.y); const float yn = DPPF(y, 0x128);     \
      if ((tid & 15) == 0) yb[(s_) * 16 + (tid >> 4)] = pk(y, yn); } while (0)
    f32x4 Aw0, Aw1, An0, An1, Ab0, Ab1, Ak0, Ak1, Ar0, Ar1; float Avv;
    f32x4 Bw0, Bw1, Bn0, Bn1, Bb0, Bb1, Bk0, Bk1, Br0, Br1; float Bvv;
    RW_FETCH(A, 0);
#pragma unroll
    for (int s = 0; s < 16; s += 2) {
      RW_FETCH(B, s + 1);
      RW_STEP(A, s);
      if (s + 2 < 16) RW_FETCH(A, s + 2);
      RW_STEP(B, s + 1);
    }
#undef RW_FETCH
#undef RW_STEP
    if (c + 1 < nchunk) RW_LSTORE((c + 1) & 1);
    __syncthreads();
  }
#undef RW_GLOAD
#undef RW_LSTORE
  if (tid < 64) { const int c = nchunk; const int sp = tid >> 2, part = tid & 3, tt = (c - 1) * 16 + sp; const int t_ = dir ? (T - 1 - tt) : tt;
    const u32x4 v = *(const u32x4*)((unsigned*)(lds + 49152) + ((c - 1) & 1) * 256 + sp * 16 + part * 4);
    *(u32x4*)(ybase + (size_t)t_ * NIN + part * 8) = v; }
  __syncthreads();
  __builtin_amdgcn_s_setprio(0);
}

template <int MODE>
DI void attn_item(char* lds, const Params& p, int layer, int seq, int head, int qt) {
  const int tid = opaque(threadIdx.x), lane = tid & 63, w = tid >> 6, l31 = lane & 31, h = lane >> 5;
  layer = opaque_s(layer); seq = opaque_s(seq); head = opaque_s(head); qt = opaque_s(qt);
  int row0, T; seq_info(seq, row0, T);
  const int QC = (MODE == 0 ? A_Q : MODE == 1 ? B_Q : C_Q) + head * 64;
  const int KC = MODE == 0 ? A_K + (head >> 1) * 64 : MODE == 1 ? B_K + head * 64 : C_K + head * 64;
  const int VC = MODE == 0 ? A_V + (head >> 1) * 64 : MODE == 1 ? B_V + head * 64 : C_V + head * 64;
  const int qw0 = qt * 128 + w * 32, qi = qw0 + l31;
  bf16_t* zq = p.z + (size_t)(row0 + qi) * NIN + QC;
  bf16x8 qf[4];
#pragma unroll
  for (int s = 0; s < 4; ++s) qf[s] = *(const bf16x8*)(zq + s * 16 + h * 8);
  const int srow = tid >> 3, sc8 = tid & 7;
  const bf16_t* kbase = p.z + (size_t)(row0 + srow) * NIN + KC + sc8 * 8;
  const bf16_t* vbase = p.z + (size_t)(row0 + srow) * NIN + VC + sc8 * 8;
  u32x4 rk[2][2], rv[2][2];
  const int nt = T >> 6;
  const int prow = (l31 & 19) | ((l31 & 4) << 1) | ((l31 & 8) >> 1);
#define AT_GLOAD(t, S) do { _Pragma("unroll") for (int i_ = 0; i_ < 2; ++i_) { const size_t off_ = (size_t)((t) * 64 + 32 * i_) * NIN; rk[S][i_] = *(const u32x4*)(kbase + off_); rv[S][i_] = *(const u32x4*)(vbase + off_); } } while (0)
#define AT_LSTORE(buf, S) do { char* ks_ = lds + (buf) * 18432; char* vs_ = ks_ + 9216; \
    _Pragma("unroll") for (int i_ = 0; i_ < 2; ++i_) { *(u32x4*)(ks_ + (srow + 32 * i_) * PITCH + sc8 * 16) = rk[S][i_]; *(u32x4*)(vs_ + (srow + 32 * i_) * PITCH + sc8 * 16) = rv[S][i_]; } } while (0)
  constexpr int NMAP = (MODE == 1) ? 2 : 1;
  f32x16 o[NMAP][2];
  float m_run[NMAP], l_run[NMAP];
#pragma unroll
  for (int a = 0; a < NMAP; ++a) { m_run[a] = -INFINITY; l_run[a] = 0.f;
#pragma unroll
    for (int b = 0; b < 2; ++b)
#pragma unroll
      for (int i = 0; i < 16; ++i) o[a][b][i] = 0.f; }
  float lf = 0.f, lb = 0.f;
  if (MODE == 2) { lf = log2f(1.0f - exp2f(-5.0f - (float)head)); lb = log2f(1.0f - exp2f(-5.0f - (float)(3 - head))); }
  auto body = [&](const char* ks, const char* vs, const int t) __attribute__((always_inline)) {
#pragma unroll
    for (int mp = 0; mp < NMAP; ++mp) {
      f32x16 st[2];
#pragma unroll
      for (int kf = 0; kf < 2; ++kf) {
#pragma unroll
        for (int i = 0; i < 16; ++i) st[kf][i] = 0.f;
        if (MODE == 1) {
#pragma unroll
          for (int s = 0; s < 2; ++s) { const bf16x8 kfr = *(const bf16x8*)(ks + (kf * 32 + prow) * PITCH + (mp * 2 + s) * 32 + h * 16); st[kf] = MFMA32(kfr, qf[mp * 2 + s], st[kf]); }
        } else {
#pragma unroll
          for (int s = 0; s < 4; ++s) { const bf16x8 kfr = *(const bf16x8*)(ks + (kf * 32 + prow) * PITCH + s * 32 + h * 16); st[kf] = MFMA32(kfr, qf[s], st[kf]); }
        }
      }
      if (MODE == 2) {
        const int k0 = t * 64;
        const float dbase = (float)(qi - k0 - 8 * h);
        if (k0 + 63 < qw0) {
#pragma unroll
          for (int kf = 0; kf < 2; ++kf)
#pragma unroll
            for (int i = 0; i < 16; ++i) { const float cc = (float)(32 * kf + (i & 3) + 4 * ((i >> 2) & 1) + 16 * ((i >> 3) & 1)); st[kf][i] *= fexp2(lf * (dbase - cc)); }
        } else if (k0 > qw0 + 31) {
#pragma unroll
          for (int kf = 0; kf < 2; ++kf)
#pragma unroll
            for (int i = 0; i < 16; ++i) { const float cc = (float)(32 * kf + (i & 3) + 4 * ((i >> 2) & 1) + 16 * ((i >> 3) & 1)); st[kf][i] *= fexp2(lb * (cc - dbase)); }
        } else {
#pragma unroll
          for (int kf = 0; kf < 2; ++kf)
#pragma unroll
            for (int i = 0; i < 16; ++i) { const float cc = (float)(32 * kf + (i & 3) + 4 * ((i >> 2) & 1) + 16 * ((i >> 3) & 1)); const float d = dbase - cc;
              float dd = fexp2(fminf(lf * d, -lb * d)); if (d == 0.f) dd = 2.0f; st[kf][i] *= dd; }
        }
      } else {
        float mx = st[0][0];
#pragma unroll
        for (int kf = 0; kf < 2; ++kf)
#pragma unroll
          for (int i = 0; i < 16; ++i) mx = fmaxf(mx, st[kf][i]);
        mx = fmaxf(mx, __shfl_xor(mx, 32));
        const float mn = fmaxf(m_run[mp], mx); const float alpha = fexp2(m_run[mp] - mn); m_run[mp] = mn;
        float ps = 0.f;
#pragma unroll
        for (int kf = 0; kf < 2; ++kf)
#pragma unroll
          for (int i = 0; i < 16; ++i) { st[kf][i] = fexp2(st[kf][i] - mn); ps += st[kf][i]; }
        l_run[mp] = l_run[mp] * alpha + ps;
#pragma unroll
        for (int df = 0; df < 2; ++df) o[mp][df] *= alpha;
      }
      bf16x8 pf[4];
#pragma unroll
      for (int kf = 0; kf < 2; ++kf)
#pragma unroll
        for (int s2 = 0; s2 < 2; ++s2) { u32x4 u; u.x = pk(st[kf][8 * s2], st[kf][8 * s2 + 1]); u.y = pk(st[kf][8 * s2 + 2], st[kf][8 * s2 + 3]);
          u.z = pk(st[kf][8 * s2 + 4], st[kf][8 * s2 + 5]); u.w = pk(st[kf][8 * s2 + 6], st[kf][8 * s2 + 7]); pf[kf * 2 + s2] = __builtin_bit_cast(bf16x8, u); }
#pragma unroll
      for (int df = 0; df < 2; ++df)
#pragma unroll
        for (int ksx = 0; ksx < 4; ++ksx) { const bf16x8 vfr = *(const bf16x8*)(vs + (df * 32 + l31) * PITCH + ksx * 32 + h * 16); o[mp][df] = MFMA32(vfr, pf[ksx], o[mp][df]); }
    }
  };
  if constexpr (MODE == 1) {
    AT_GLOAD(0, 0); AT_LSTORE(0, 0); __syncthreads();
#pragma unroll 1
    for (int t = 0; t < nt; ++t) {
      if (t + 1 < nt) AT_GLOAD(t + 1, 0);
      const char* ks = lds + (t & 1) * 18432;
      body(ks, ks + 9216, t);
      if (t + 1 < nt) AT_LSTORE((t + 1) & 1, 0);
      __syncthreads();
    }
  } else {
    AT_GLOAD(0, 0); AT_GLOAD(1, 1); AT_LSTORE(0, 0); __syncthreads();
#pragma unroll 1
    for (int t2 = 0; t2 < nt; t2 += 2) {
      if (t2 + 2 < nt) AT_GLOAD(t2 + 2, 0);
      body(lds, lds + 9216, t2);
      AT_LSTORE(1, 1);
      __syncthreads();
      if (t2 + 3 < nt) AT_GLOAD(t2 + 3, 1);
      body(lds + 18432, lds + 18432 + 9216, t2 + 1);
      if (t2 + 2 < nt) AT_LSTORE(0, 0);
      __syncthreads();
    }
  }
#undef AT_GLOAD
#undef AT_LSTORE
  f32x16 r[2];
  if (MODE == 0) {
    const float l = l_run[0] + __shfl_xor(l_run[0], 32); const float inv = 1.0f / l;
#pragma unroll
    for (int df = 0; df < 2; ++df) r[df] = o[0][df] * inv;
  } else if (MODE == 1) {
    const float* lp = p.in[I_BLAM] + layer * 128;
    float s01 = 0.f, s23 = 0.f;
    for (int i = 0; i < 32; ++i) { s01 += lp[i] * lp[32 + i]; s23 += lp[64 + i] * lp[96 + i]; }
    const float lam_init = 0.8f - 0.6f * expf(-0.3f * (float)layer);
    const float lam = expf(s01) - expf(s23) + lam_init;
    const float l0 = l_run[0] + __shfl_xor(l_run[0], 32), l1 = l_run[NMAP - 1] + __shfl_xor(l_run[NMAP - 1], 32);
    const float i0 = 1.0f / l0, i1 = lam / l1;
    float ss = 0.f;
#pragma unroll
    for (int df = 0; df < 2; ++df) { r[df] = o[0][df] * i0 - o[NMAP - 1][df] * i1;
#pragma unroll
      for (int i = 0; i < 16; ++i) ss += r[df][i] * r[df][i]; }
    ss += __shfl_xor(ss, 32);
    const float rs = rsqrtf(ss * (1.0f / 64.0f) + EPS) * (1.0f - lam_init);
    const float* sg = p.in[I_BSUB] + layer * 64;
#pragma unroll
    for (int df = 0; df < 2; ++df)
#pragma unroll
      for (int i = 0; i < 16; ++i) r[df][i] *= rs * sg[df * 32 + (i & 3) + 8 * (i >> 2) + 4 * h];
  } else {
    float ss = 0.f;
#pragma unroll
    for (int df = 0; df < 2; ++df)
#pragma unroll
      for (int i = 0; i < 16; ++i) ss += o[0][df][i] * o[0][df][i];
    ss += __shfl_xor(ss, 32);
    const float rs = rsqrtf(ss * (1.0f / 64.0f) + EPS);
    const float* gg = p.in[I_CGN] + layer * 256 + head * 64;
    const bf16_t* zg = p.z + (size_t)(row0 + qi) * NIN + C_G + head * 64;
#pragma unroll
    for (int df = 0; df < 2; ++df)
#pragma unroll
      for (int g = 0; g < 4; ++g) { const u32x2 gw = *(const u32x2*)(zg + df * 32 + 8 * g + 4 * h);
        const float gv[4] = {bflo(gw.x), bfhi(gw.x), bflo(gw.y), bfhi(gw.y)};
#pragma unroll
        for (int e = 0; e < 4; ++e) { const float x = gv[e]; r[df][4 * g + e] = o[0][df][4 * g + e] * rs * gg[df * 32 + 8 * g + 4 * h + e] * (x / (1.0f + __expf(-x))); } }
  }
#pragma unroll
  for (int df = 0; df < 2; ++df)
#pragma unroll
    for (int g = 0; g < 4; ++g) { u32x2 v; v.x = pk(r[df][4 * g], r[df][4 * g + 1]); v.y = pk(r[df][4 * g + 2], r[df][4 * g + 3]); *(u32x2*)(zq + df * 32 + 8 * g + 4 * h) = v; }
}

template <class Epi>
DI void gemm_tile2(char* lds, const ASrc& A, const bf16_t* __restrict__ Bt, int K, int m0, int n0, const Epi& epi) {
  const int tid = opaque(threadIdx.x), lane = tid & 63, w = __builtin_amdgcn_readfirstlane(tid >> 6), wr = w >> 1, wc = w & 1, l31 = lane & 31, h = lane >> 5;
  const int nk = K >> 5, smask = (1 << A.shift) - 1;
  LASP char* ldsl = (LASP char*)lds;
  f32x16 acc[2][4];
#pragma unroll
  for (int a = 0; a < 2; ++a)
#pragma unroll
    for (int b = 0; b < 4; ++b)
#pragma unroll
      for (int i = 0; i < 16; ++i) acc[a][b][i] = 0.f;
  const int lrow = lane >> 2, lslot = lane & 3;
  int goffA[2], goffB[4];
#pragma unroll
  for (int i = 0; i < 2; ++i) { const int r = (2 * w + i) * 16 + lrow, c = lslot ^ ((r >> 2) & 3); goffA[i] = (r << 2) | c; }
#pragma unroll
  for (int i = 0; i < 4; ++i) { const int r = (4 * w + i) * 16 + lrow, c = lslot ^ ((r >> 2) & 3); goffB[i] = r * K + c * 8; }
#define G2_ISSUE(kt, st) do { const int k0_ = (kt) << 5, seg_ = k0_ >> A.shift, kk_ = k0_ & smask; \
    const bf16_t* bp_ = seg_ == 0 ? A.b0 : seg_ == 1 ? A.b1 : seg_ == 2 ? A.b2 : A.b3; const int st_ = seg_ == 0 ? A.s0 : seg_ == 1 ? A.s1 : seg_ == 2 ? A.s2 : A.s3; \
    _Pragma("unroll") for (int i_ = 0; i_ < 2; ++i_) { \
      const bf16_t* ga_ = bp_ + (size_t)(m0 + (goffA[i_] >> 2)) * st_ + kk_ + (goffA[i_] & 3) * 8; \
      __builtin_amdgcn_global_load_lds((const unsigned*)ga_, (LASP unsigned*)(ldsl + (st) * 24576 + (2 * w + i_) * 1024), 16, 0, 0); } \
    _Pragma("unroll") for (int i_ = 0; i_ < 4; ++i_) { \
      const bf16_t* gb_ = Bt + (size_t)n0 * K + goffB[i_] + k0_; \
      __builtin_amdgcn_global_load_lds((const unsigned*)gb_, (LASP unsigned*)(ldsl + (st) * 24576 + 8192 + (4 * w + i_) * 1024), 16, 0, 0); } } while (0)
  const int xr = (l31 >> 2) & 3;
  int coff[2];
#pragma unroll
  for (int s = 0; s < 2; ++s) coff[s] = ((2 * s + h) ^ xr) * 16;
#define G2_COMPUTE(st) do { const char* as = lds + (st) * 24576; const char* bs = as + 8192; \
    bf16x8 af[2][2], wf[2][4]; \
    _Pragma("unroll") for (int s = 0; s < 2; ++s) { \
      _Pragma("unroll") for (int mf = 0; mf < 2; ++mf) af[s][mf] = *(const bf16x8*)(as + (wr * 64 + mf * 32 + l31) * 64 + coff[s]); \
      _Pragma("unroll") for (int nf = 0; nf < 4; ++nf) wf[s][nf] = *(const bf16x8*)(bs + (wc * 128 + nf * 32 + l31) * 64 + coff[s]); } \
    __builtin_amdgcn_sched_barrier(0); __builtin_amdgcn_s_setprio(1); \
    _Pragma("unroll") for (int s = 0; s < 2; ++s) \
      _Pragma("unroll") for (int mf = 0; mf < 2; ++mf) _Pragma("unroll") for (int nf = 0; nf < 4; ++nf) acc[mf][nf] = MFMA32(wf[s][nf], af[s][mf], acc[mf][nf]); \
    __builtin_amdgcn_s_setprio(0); __builtin_amdgcn_sched_barrier(0); } while (0)
  G2_ISSUE(0, 0);
  for (int kt = 0; kt < nk; kt += 2) {
    asm volatile("s_waitcnt vmcnt(0)" ::: "memory"); __syncthreads();
    G2_ISSUE(kt + 1, 1);
    G2_COMPUTE(0);
    asm volatile("s_waitcnt vmcnt(0)" ::: "memory"); __syncthreads();
    if (kt + 2 < nk) G2_ISSUE(kt + 2, 0);
    G2_COMPUTE(1);
  }
  __syncthreads();
#pragma unroll
  for (int hf = 0; hf < 2; ++hf) {
    f32x16 t[2][2];
#pragma unroll
    for (int mf = 0; mf < 2; ++mf) { t[mf][0] = acc[mf][2 * hf]; t[mf][1] = acc[mf][2 * hf + 1]; }
    epi(t, m0 + wr * 64, n0 + wc * 128 + hf * 64, n0, wc, l31, h);
  }
  __syncthreads();
#undef G2_ISSUE
#undef G2_COMPUTE
}

template <class Epi>
DI void gemm_phase2(char* lds, const ASrc& A, const bf16_t* Bt, int K, int ntn, const Epi& epi) {
  const int xcd = blockIdx.x & 7, j = blockIdx.x >> 3, nloc = gridDim.x >> 3, per = 48 * ntn, grp = 8 * ntn;
  for (int li = j; li < per; li += nloc) {
    const int sg = li / grp, wi = li - sg * grp, nt = wi >> 3, mt = xcd * 48 + sg * 8 + (wi & 7);
    gemm_tile2(lds, A, Bt, K, mt * 128, nt * 256, epi);
  }
}

template <int MODE>
DI void attn3_item(char* lds, const Params& p, int layer, int seq, int head, int qt) {
  const int tid = opaque(threadIdx.x), lane = tid & 63, w = tid >> 6, l31 = lane & 31, h = lane >> 5;
  layer = opaque_s(layer); seq = opaque_s(seq); head = opaque_s(head); qt = opaque_s(qt);
  int row0, T; seq_info(seq, row0, T);
  const int QC = (MODE == 0 ? A_Q : C_Q) + head * 64;
  const int KC = MODE == 0 ? A_K + (head >> 1) * 64 : C_K + head * 64;
  const int VC = MODE == 0 ? A_V + (head >> 1) * 64 : C_V + head * 64;
  const int qw0 = qt * 256 + w * 64;
  bf16x8 qf[2][4];
#pragma unroll
  for (int qi = 0; qi < 2; ++qi)
#pragma unroll
    for (int s = 0; s < 4; ++s) qf[qi][s] = *(const bf16x8*)(p.z + (size_t)(row0 + qw0 + qi * 32 + l31) * NIN + QC + s * 16 + h * 8);
  const int srow = tid >> 3, sc8 = tid & 7;
  const bf16_t* kbase = p.z + (size_t)(row0 + srow) * NIN + KC + sc8 * 8;
  const bf16_t* vbase = p.z + (size_t)(row0 + srow) * NIN + VC + sc8 * 8;
  u32x4 rk[2], rv[2];
  const int nt = T >> 6;
  const int prow = (l31 & 19) | ((l31 & 4) << 1) | ((l31 & 8) >> 1);
#define A3_GLOAD(t) do { _Pragma("unroll") for (int i_ = 0; i_ < 2; ++i_) { const size_t off_ = (size_t)((t) * 64 + 32 * i_) * NIN; rk[i_] = *(const u32x4*)(kbase + off_); rv[i_] = *(const u32x4*)(vbase + off_); } } while (0)
#define A3_LSTORE(buf) do { char* ks_ = lds + (buf) * 18432; char* vs_ = ks_ + 9216; \
    _Pragma("unroll") for (int i_ = 0; i_ < 2; ++i_) { *(u32x4*)(ks_ + (srow + 32 * i_) * PITCH + sc8 * 16) = rk[i_]; *(u32x4*)(vs_ + (srow + 32 * i_) * PITCH + sc8 * 16) = rv[i_]; } } while (0)
  f32x16 o[2][2];
  float m_run[2], l_run[2];
#pragma unroll
  for (int a = 0; a < 2; ++a) { m_run[a] = -INFINITY; l_run[a] = 0.f;
#pragma unroll
    for (int b = 0; b < 2; ++b)
#pragma unroll
      for (int i = 0; i < 16; ++i) o[a][b][i] = 0.f; }
  float lf = 0.f, lb = 0.f;
  if (MODE == 2) { lf = log2f(1.0f - exp2f(-5.0f - (float)head)); lb = log2f(1.0f - exp2f(-5.0f - (float)(3 - head))); }
  float* dtab = (float*)(lds + 40960);
  if (MODE == 2 && tid < 64) { const int d_ = tid >> 5, kf_ = (tid >> 4) & 1, i_ = tid & 15;
    const float cc_ = (float)(32 * kf_ + (i_ & 3) + 4 * ((i_ >> 2) & 1) + 16 * ((i_ >> 3) & 1));
    dtab[tid] = d_ == 0 ? exp2f(-lf * cc_) : exp2f(lb * cc_); }
  A3_GLOAD(0); A3_LSTORE(0); __syncthreads();
#pragma unroll 1
  for (int t = 0; t < nt; ++t) {
    if (t + 1 < nt) A3_GLOAD(t + 1);
    const char* ks = lds + (t & 1) * 18432; const char* vs = ks + 9216;
    f32x16 st[2][2];
#pragma unroll
    for (int kf = 0; kf < 2; ++kf) {
#pragma unroll
      for (int qi = 0; qi < 2; ++qi)
#pragma unroll
        for (int i = 0; i < 16; ++i) st[qi][kf][i] = 0.f;
#pragma unroll
      for (int s = 0; s < 4; ++s) { const bf16x8 kfr = *(const bf16x8*)(ks + (kf * 32 + prow) * PITCH + s * 32 + h * 16);
#pragma unroll
        for (int qi = 0; qi < 2; ++qi) st[qi][kf] = MFMA32(kfr, qf[qi][s], st[qi][kf]); }
    }
    __builtin_amdgcn_sched_barrier(0);
#pragma unroll
    for (int qi = 0; qi < 2; ++qi) {
      bf16x8 pf[4];
      if (MODE == 2) {
        const int k0 = t * 64, qb = qw0 + qi * 32;
        const float dbase = (float)(qb + l31 - k0 - 8 * h);
        if (k0 + 63 < qb) {
          const float qfac = fexp2(lf * dbase);
#pragma unroll
          for (int kf = 0; kf < 2; ++kf)
#pragma unroll
            for (int g = 0; g < 4; ++g) { const f32x4 kv = *(const f32x4*)(dtab + kf * 16 + 4 * g);
#pragma unroll
              for (int e = 0; e < 4; ++e) st[qi][kf][4 * g + e] *= kv[e] * qfac; }
        } else if (k0 > qb + 31) {
          const float qfac = fexp2(-lb * dbase);
#pragma unroll
          for (int kf = 0; kf < 2; ++kf)
#pragma unroll
            for (int g = 0; g < 4; ++g) { const f32x4 kv = *(const f32x4*)(dtab + 32 + kf * 16 + 4 * g);
#pragma unroll
              for (int e = 0; e < 4; ++e) st[qi][kf][4 * g + e] *= kv[e] * qfac; }
        } else {
#pragma unroll
          for (int kf = 0; kf < 2; ++kf)
#pragma unroll
            for (int i = 0; i < 16; ++i) { const float cc = (float)(32 * kf + (i & 3) + 4 * ((i >> 2) & 1) + 16 * ((i >> 3) & 1)); const float d = dbase - cc;
              float dd = fexp2(fminf(lf * d, -lb * d)); if (d == 0.f) dd = 2.0f; st[qi][kf][i] *= dd; }
        }
      } else {
        float mx = st[qi][0][0];
#pragma unroll
        for (int kf = 0; kf < 2; ++kf)
#pragma unroll
          for (int i = 0; i < 16; ++i) mx = fmaxf(mx, st[qi][kf][i]);
        mx = fmaxf(mx, __shfl_xor(mx, 32));
        const float mn = fmaxf(m_run[qi], mx); const float alpha = fexp2(m_run[qi] - mn); m_run[qi] = mn;
        float ps = 0.f;
#pragma unroll
        for (int kf = 0; kf < 2; ++kf)
#pragma unroll
          for (int i = 0; i < 16; ++i) { st[qi][kf][i] = fexp2(st[qi][kf][i] - mn); ps += st[qi][kf][i]; }
        l_run[qi] = l_run[qi] * alpha + ps;
#pragma unroll
        for (int df = 0; df < 2; ++df) o[qi][df] *= alpha;
      }
#pragma unroll
      for (int kf = 0; kf < 2; ++kf)
#pragma unroll
        for (int s2 = 0; s2 < 2; ++s2) { u32x4 u; u.x = pk(st[qi][kf][8 * s2], st[qi][kf][8 * s2 + 1]); u.y = pk(st[qi][kf][8 * s2 + 2], st[qi][kf][8 * s2 + 3]);
          u.z = pk(st[qi][kf][8 * s2 + 4], st[qi][kf][8 * s2 + 5]); u.w = pk(st[qi][kf][8 * s2 + 6], st[qi][kf][8 * s2 + 7]); pf[kf * 2 + s2] = __builtin_bit_cast(bf16x8, u); }
#pragma unroll
      for (int df = 0; df < 2; ++df)
#pragma unroll
        for (int ksx = 0; ksx < 4; ++ksx) { const bf16x8 vfr = *(const bf16x8*)(vs + (df * 32 + l31) * PITCH + ksx * 32 + h * 16); o[qi][df] = MFMA32(vfr, pf[ksx], o[qi][df]); }
      __builtin_amdgcn_sched_barrier(0);
    }
    __builtin_amdgcn_sched_barrier(0);
    if (t + 1 < nt) A3_LSTORE((t + 1) & 1);
    __syncthreads();
  }
#undef A3_GLOAD
#undef A3_LSTORE
#pragma unroll
  for (int qi = 0; qi < 2; ++qi) {
    const int qrow = row0 + qw0 + qi * 32 + l31;
    bf16_t* zq = p.z + (size_t)qrow * NIN + QC;
    f32x16 r[2];
    if (MODE == 0) {
      const float l = l_run[qi] + __shfl_xor(l_run[qi], 32); const float inv = 1.0f / l;
#pragma unroll
      for (int df = 0; df < 2; ++df) r[df] = o[qi][df] * inv;
    } else {
      float ss = 0.f;
#pragma unroll
      for (int df = 0; df < 2; ++df)
#pragma unroll
        for (int i = 0; i < 16; ++i) ss += o[qi][df][i] * o[qi][df][i];
      ss += __shfl_xor(ss, 32);
      const float rs = rsqrtf(ss * (1.0f / 64.0f) + EPS);
      const float* gg = p.in[I_CGN] + layer * 256 + head * 64;
      const bf16_t* zg = p.z + (size_t)qrow * NIN + C_G + head * 64;
#pragma unroll
      for (int df = 0; df < 2; ++df)
#pragma unroll
        for (int g = 0; g < 4; ++g) { const u32x2 gw = *(const u32x2*)(zg + df * 32 + 8 * g + 4 * h);
          const float gv[4] = {bflo(gw.x), bfhi(gw.x), bflo(gw.y), bfhi(gw.y)};
#pragma unroll
          for (int e = 0; e < 4; ++e) { const float x = gv[e]; r[df][4 * g + e] = o[qi][df][4 * g + e] * rs * gg[df * 32 + 8 * g + 4 * h + e] * (x / (1.0f + __expf(-x))); } }
    }
#pragma unroll
    for (int df = 0; df < 2; ++df)
#pragma unroll
      for (int g = 0; g < 4; ++g) { u32x2 v; v.x = pk(r[df][4 * g], r[df][4 * g + 1]); v.y = pk(r[df][4 * g + 2], r[df][4 * g + 3]); *(u32x2*)(zq + df * 32 + 8 * g + 4 * h) = v; }
  }
}

DI void ctr_barrier(unsigned* cnt) {
  asm volatile("s_waitcnt vmcnt(0) lgkmcnt(0)" ::: "memory");
  __syncthreads();
  if (threadIdx.x == 0) {
    __builtin_amdgcn_fence(__ATOMIC_RELEASE, "agent");
    asm volatile("s_waitcnt vmcnt(0)" ::: "memory");
    const unsigned G = gridDim.x;
    const unsigned old = __hip_atomic_fetch_add(cnt, 1u, __ATOMIC_RELAXED, __HIP_MEMORY_SCOPE_AGENT);
    const unsigned gen = old / G + 1u;
    if (old + 1u == gen * G) __hip_atomic_store(cnt + 64, gen, __ATOMIC_RELAXED, __HIP_MEMORY_SCOPE_AGENT);
    else while (__hip_atomic_load(cnt + 64, __ATOMIC_RELAXED, __HIP_MEMORY_SCOPE_AGENT) < gen) __builtin_amdgcn_s_sleep(1);
    __builtin_amdgcn_fence(__ATOMIC_ACQUIRE, "agent");
    asm volatile("s_waitcnt vmcnt(0)" ::: "memory");
  }
  __syncthreads();
}

DI int next_item(int* ctr, int* sh) {
  __syncthreads();
  if (threadIdx.x == 0) *sh = atomicAdd(ctr, 1);
  __syncthreads();
  return *sh;
}
constexpr int XQ_N = 416;
DI int next_item_x(int* ctr8, int* sh) {
  __syncthreads();
  if (threadIdx.x == 0) {
    int r = -1;
    const int x0 = blockIdx.x & 7;
    for (int k = 0; k < 8; ++k) { const int x = (x0 + k) & 7; const int i = atomicAdd(ctr8 + x, 1); if (i < XQ_N) { r = (x << 16) | i; break; } }
    *sh = r;
  }
  __syncthreads();
  return *sh;
}

__global__ void __launch_bounds__(256, 2) fwd(Params p) {
  extern __shared__ __attribute__((aligned(16))) char lds[];
  __shared__ int s_item;
  cg::grid_group grid = cg::this_grid();
  const int bid = blockIdx.x, nb = gridDim.x, tid = threadIdx.x, lane = tid & 63, w = tid >> 6;
  if (bid == 0) p.ctr[tid] = 0;
  for (int i = bid * 256 + tid; i < 4096 * 32; i += nb * 256) { const int t = i >> 5, j = i & 31; const float inv = powf(10000.0f, -(float)(2 * j) / 64.0f); float sn, cs; sincosf((float)t * inv, &sn, &cs); p.tabC[i] = (f32x2){cs, sn}; }
  for (int i = bid * 256 + tid; i < 4096 * 4; i += nb * 256) { const int t = i >> 2, j = i & 3; const float inv = powf(500000.0f, -(float)(2 * j) / 8.0f); float sn, cs; sincosf((float)t * inv, &sn, &cs); p.tabB[i] = (f32x2){cs, sn}; }
  for (int i = bid * 256 + tid; i < 64 * 16; i += nb * 256) { const int t = i >> 4, j = i & 15; const float inv = powf(10000.0f, -(float)(2 * j) / 32.0f); float sn, cs; sincosf((float)t * inv, &sn, &cs); p.tabA[i] = (f32x2){cs, sn}; }
  for (int l = 0; l < 2; ++l) {
    for (int i = bid * 256 + tid; i < (NINP - NIN) * 1024; i += nb * 256) p.wtin[(size_t)l * NINP * 1024 + (size_t)NIN * 1024 + i] = 0;
    for (int tl = bid; tl < 16 * 53; tl += nb) conv_T(lds, p.in[I_WIN] + (size_t)l * 1024 * NIN, 1024, NIN, p.wtin + (size_t)l * NINP * 1024, 0, tl);
    for (int tl = bid; tl < 16 * 16; tl += nb) conv_T(lds, p.in[I_WOUT] + (size_t)l * 1024 * 1024, 1024, 1024, p.wtout + (size_t)l * 1024 * 1024, 0, tl);
  }
  bf16_t* hb = p.pl;
  for (int row = bid * 4 + opaque(w); row < MT; row += nb * 8) {
    const int rb = row + nb * 4;
    const float* xin = row < M0 ? p.in[I_XP] + (size_t)row * 1024 : p.in[I_XS] + (size_t)(row - M0) * 1024;
    if (rb < MT) { const float* xinb = rb < M0 ? p.in[I_XP] + (size_t)rb * 1024 : p.in[I_XS] + (size_t)(rb - M0) * 1024;
      row_phase2(xin, xinb, p.out + (size_t)row * 1024, p.out + (size_t)rb * 1024, nullptr, nullptr, nullptr, p.in[I_NMPRE], hb + (size_t)row * 1024, hb + (size_t)rb * 1024, lane); }
    else row_phase(xin, p.out + (size_t)row * 1024, nullptr, nullptr, p.in[I_NMPRE], hb + (size_t)row * 1024, lane);
  }
  grid.sync();
  for (int l = 0; l < 2; ++l) {
    { ASrc A; A.b0 = hb; A.b1 = hb; A.b2 = hb; A.b3 = hb; A.s0 = A.s1 = A.s2 = A.s3 = 1024; A.shift = 12;
      EpiIn e; e.z = p.z; e.lds = lds; e.qg = p.in[I_AQG] + l * 64; e.kg = p.in[I_AKG] + l * 64; e.tabA = p.tabA; e.tabB = p.tabB; e.tabC = p.tabC;
      gemm_phase2(lds, A, p.wtin + (size_t)l * NINP * 1024, 1024, 14, e); }
    ctr_barrier((unsigned*)p.ctr + 96);
    for (int it = bid; it < MT / DTOK; it += nb) dprep_item(lds, p, l, it);
    ctr_barrier((unsigned*)p.ctr + 96);
    for (;;) {
      const int it = next_item_x(p.ctr + l * 16, &s_item);
      if (it < 0) break;
      const int x = it >> 16; int i = it & 0xffff;
      if (i < 32) { const int j = i & 15; rwkv_item(lds, p, i < 16 ? x : 8 + x, (j >> 2) & 3, (j >> 1) & 1, j & 1); }
      else { i -= 32;
        if (i < 128) attn_item<1>(lds, p, l, x, i >> 5, i & 31);
        else if (i < 192) { i -= 128; attn3_item<2>(lds, p, l, x, i >> 4, i & 15); }
        else if (i < 256) { i -= 192; attn3_item<0>(lds, p, l, x, i >> 4, i & 15); }
        else if (i < 320) { i -= 256; attn_item<1>(lds, p, l, 8 + x, i >> 4, i & 15); }
        else if (i < 352) { i -= 320; attn3_item<2>(lds, p, l, 8 + x, i >> 3, i & 7); }
        else { i -= 352; attn3_item<0>(lds, p, l, 8 + x, i >> 3, i & 7); }
      }
    }
    ctr_barrier((unsigned*)p.ctr + 96);
    bf16_t* wtgu = p.pl + 5 * PLANE; bf16_t* wtd = wtgu + (size_t)2 * DFF * 1024;
    for (int it = bid; it < MT / DTOK + 3 * 704; it += nb) {
      if (it < MT / DTOK) dpost_item(lds, p, l, it);
      else { const int j = it - MT / DTOK;
        if (j < 704) conv_T(lds, p.in[I_FG] + (size_t)l * 1024 * DFF, 1024, DFF, wtgu, 1, j);
        else if (j < 1408) conv_T(lds, p.in[I_FU] + (size_t)l * 1024 * DFF, 1024, DFF, wtgu, 2, j - 704);
        else conv_T(lds, p.in[I_FD] + (size_t)l * DFF * 1024, DFF, 1024, wtd, 0, j - 1408); }
    }
    ctr_barrier((unsigned*)p.ctr + 96);
    { ASrc A; A.b0 = p.z + A_Q; A.b1 = p.z + B_Q; A.b2 = p.z + C_Q; A.b3 = p.pl + 4 * PLANE; A.s0 = A.s1 = A.s2 = NIN; A.s3 = 256; A.shift = 8;
      EpiStore e; e.out = hb; e.ldc = 1024; e.nmax = 1024; e.lds = lds;
      gemm_phase2(lds, A, p.wtout + (size_t)l * 1024 * 1024, 1024, 4, e); }
    ctr_barrier((unsigned*)p.ctr + 96);
    for (int row = bid * 4 + opaque(w); row < MT; row += nb * 8) { const int rb = row + nb * 4;
      if (rb < MT) row_phase2(p.out + (size_t)row * 1024, p.out + (size_t)rb * 1024, p.out + (size_t)row * 1024, p.out + (size_t)rb * 1024, hb + (size_t)row * 1024, hb + (size_t)rb * 1024,
                              p.in[I_NMPOST] + l * 1024, p.in[I_NFPRE] + l * 1024, hb + (size_t)row * 1024, hb + (size_t)rb * 1024, lane);
      else row_phase(p.out + (size_t)row * 1024, p.out + (size_t)row * 1024, hb + (size_t)row * 1024, p.in[I_NMPOST] + l * 1024, p.in[I_NFPRE] + l * 1024, hb + (size_t)row * 1024, lane); }
    ctr_barrier((unsigned*)p.ctr + 96);
    { ASrc A; A.b0 = hb; A.b1 = hb; A.b2 = hb; A.b3 = hb; A.s0 = A.s1 = A.s2 = A.s3 = 1024; A.shift = 12;
      EpiSwiGLU e; e.out = p.z; e.lds = lds;
      gemm_phase2(lds, A, wtgu, 1024, 22, e); }
    ctr_barrier((unsigned*)p.ctr + 96);
    { ASrc A; A.b0 = p.z; A.b1 = p.z; A.b2 = p.z; A.b3 = p.z; A.s0 = A.s1 = A.s2 = A.s3 = DFF; A.shift = 12;
      EpiStore e; e.out = hb; e.ldc = 1024; e.nmax = 1024; e.lds = lds;
      gemm_phase2(lds, A, wtd, DFF, 4, e); }
    ctr_barrier((unsigned*)p.ctr + 96);
    for (int row = bid * 4 + opaque(w); row < MT; row += nb * 8) { const int rb = row + nb * 4; const float* gp2 = l == 0 ? p.in[I_NMPRE] + 1024 : nullptr;
      if (rb < MT) row_phase2(p.out + (size_t)row * 1024, p.out + (size_t)rb * 1024, p.out + (size_t)row * 1024, p.out + (size_t)rb * 1024, hb + (size_t)row * 1024, hb + (size_t)rb * 1024,
                              p.in[I_NFPOST] + l * 1024, gp2, hb + (size_t)row * 1024, hb + (size_t)rb * 1024, lane);
      else row_phase(p.out + (size_t)row * 1024, p.out + (size_t)row * 1024, hb + (size_t)row * 1024, p.in[I_NFPOST] + l * 1024, gp2, hb + (size_t)row * 1024, lane); }
    if (l == 0) ctr_barrier((unsigned*)p.ctr + 96);
  }
}

extern "C" void kernel_launch(void* const* d_in, const int* in_sizes, int n_in, void* d_out, int out_size,
                              void* d_ws, size_t ws_size, hipStream_t stream) {
  static int grid_blocks = 0;
  if (!grid_blocks) {
    int dev = 0, cus = 0, per_cu = 0;
    hipGetDevice(&dev);
    hipDeviceGetAttribute(&cus, hipDeviceAttributeMultiprocessorCount, dev);
    hipFuncSetAttribute((const void*)fwd, hipFuncAttributeMaxDynamicSharedMemorySize, LDS_BYTES);
    hipOccupancyMaxActiveBlocksPerMultiprocessor(&per_cu, fwd, 256, LDS_BYTES);
    if (per_cu > 2) per_cu = 2;
    if (per_cu < 1) per_cu = 1;
    grid_blocks = cus * per_cu;
  }
  Params p{};
  for (int i = 0; i < 28; ++i) p.in[i] = (const float*)d_in[i];
  p.out = (float*)d_out;
  char* ws = (char*)d_ws;
  size_t off = 0;
  p.z = (bf16_t*)(ws + off); off += (size_t)MT * NIN * 2;
  p.pl = (bf16_t*)(ws + off); off += 7 * PLANE * 2;
  p.wtin = (bf16_t*)(ws + off); off += (size_t)2 * NINP * 1024 * 2;
  p.wtout = (bf16_t*)(ws + off); off += (size_t)2 * 1024 * 1024 * 2;
  p.tabC = (f32x2*)(ws + off); off += (size_t)4096 * 32 * 8;
  p.tabB = (f32x2*)(ws + off); off += (size_t)4096 * 4 * 8;
  p.tabA = (f32x2*)(ws + off); off += (size_t)64 * 16 * 8;
  p.ctr = (int*)(ws + off); off += 1024;
  if (off > ws_size) fprintf(stderr, "workspace too small: need %zu have %zu\n", off, ws_size);
  void* args[] = {&p};
  hipError_t e = hipLaunchCooperativeKernel((void*)fwd, dim3(grid_blocks), dim3(256), args, LDS_BYTES, stream);
  if (e != hipSuccess) fprintf(stderr, "coop launch failed: %s (grid %d)\n", hipGetErrorString(e), grid_blocks);
}
```

```cpp
#include <hip/hip_runtime.h>
#include <hip/hip_cooperative_groups.h>
#include <cstdio>
#include <cstdint>
namespace cg = cooperative_groups;

#define DI __device__ __forceinline__
typedef unsigned short bf16_t;
typedef short bf16x8 __attribute__((ext_vector_type(8)));
typedef float f32x2 __attribute__((ext_vector_type(2)));
typedef float f32x4 __attribute__((ext_vector_type(4)));
typedef float f32x16 __attribute__((ext_vector_type(16)));
typedef unsigned u32x2 __attribute__((ext_vector_type(2)));
typedef unsigned u32x4 __attribute__((ext_vector_type(4)));
typedef __bf16 bf16x2_t __attribute__((ext_vector_type(2)));

constexpr int M0 = 32768, MT = 49152, DM = 1024, NIN = 3392, NINP = 3584, DFF = 2816;
constexpr int A_Q = 0, A_K = 256, A_V = 384, B_Q = 512, B_K = 768, B_V = 1024, C_Q = 1280, C_K = 1536, C_V = 1792, C_G = 2048, D_0 = 2304;
constexpr int PITCH = 144;
constexpr size_t PLANE = (size_t)MT * 256;
constexpr int LDS_BYTES = 73728;
constexpr float LOG2E = 1.4426950408889634f;
constexpr float EPS = 1e-6f;

enum { I_XP = 0, I_XS, I_NMPRE, I_NMPOST, I_NFPRE, I_NFPOST, I_WIN, I_WOUT, I_AQG, I_AKG, I_BLAM, I_BSUB, I_CGN, I_DMUP, I_DMUN, I_DW0, I_DWUP,
       I_DA0, I_DAUP, I_DGUP, I_DKK, I_DKA, I_DRK, I_DGNW, I_DGNB, I_FG, I_FU, I_FD };

struct Params {
  const float* in[28];
  float* out;
  bf16_t* z;
  bf16_t* pl;
  bf16_t* wtin;
  bf16_t* wtout;
  f32x2* tabC;
  f32x2* tabB;
  f32x2* tabA;
  int* ctr;
};

DI int opaque(int x) { asm volatile("" : "+v"(x)); return x; }
DI int opaque_s(int x) { asm volatile("" : "+s"(x)); return x; }
DI float bf2f(bf16_t v) { return __uint_as_float(((unsigned)v) << 16); }
DI float bflo(unsigned w) { return __uint_as_float(w << 16); }
DI float bfhi(unsigned w) { return __uint_as_float(w & 0xffff0000u); }
DI unsigned pk(float lo, float hi) { f32x2 v = {lo, hi}; bf16x2_t b = __builtin_convertvector(v, bf16x2_t); return __builtin_bit_cast(unsigned, b); }
DI bf16_t f2bf(float x) { return (bf16_t)(pk(x, 0.f) & 0xffffu); }
DI float dppf(float x, const int ctrl) { return x; }
#define DPPF(x, ctrl) __int_as_float(__builtin_amdgcn_update_dpp(0, __float_as_int(x), (ctrl), 0xF, 0xF, true))
DI float wave_sum(float v) {
  v += DPPF(v, 0xB1);
  v += DPPF(v, 0x4E);
  v += DPPF(v, 0x141);
  v += DPPF(v, 0x140);
  const int vi = __float_as_int(v);
  return (__int_as_float(__builtin_amdgcn_readlane(vi, 0)) + __int_as_float(__builtin_amdgcn_readlane(vi, 16))) +
         (__int_as_float(__builtin_amdgcn_readlane(vi, 32)) + __int_as_float(__builtin_amdgcn_readlane(vi, 48)));
}
DI float dpp_xor1(float x) { return __int_as_float(__builtin_amdgcn_update_dpp(0, __float_as_int(x), 0xB1, 0xF, 0xF, true)); }
DI float dpp_xor2(float x) { return __int_as_float(__builtin_amdgcn_update_dpp(0, __float_as_int(x), 0x4E, 0xF, 0xF, true)); }
DI float dpp_hmir(float x) { return __int_as_float(__builtin_amdgcn_update_dpp(0, __float_as_int(x), 0x141, 0xF, 0xF, true)); }
DI float red8(float x) { x += dpp_xor1(x); x += dpp_xor2(x); x += dpp_hmir(x); return x; }
DI float fexp2(float x) { return __builtin_amdgcn_exp2f(x); }
DI void seq_info(int s, int& row0, int& T) { if (s < 8) { row0 = s * 4096; T = 4096; } else { row0 = M0 + (s - 8) * 2048; T = 2048; } }
DI void row_info(int r, int& t, int& T) { if (r < M0) { t = r & 4095; T = 4096; } else { t = (r - M0) & 2047; T = 2048; } }
#define MFMA32(a, b, c) __builtin_amdgcn_mfma_f32_32x32x16_bf16((a), (b), (c), 0, 0, 0)

DI void conv_T(char* lds, const float* __restrict__ W, int K, int N, bf16_t* __restrict__ Wt, int mode, int tile) {
  float* t = (float*)lds;
  const int tid0 = opaque(threadIdx.x);
  const int ntn = N >> 6, kt = tile / ntn, nt = tile - kt * ntn, k0 = kt << 6, n0 = nt << 6;
  float wv[16];
#pragma unroll
  for (int i = 0; i < 16; ++i) { const int idx = tid0 + 256 * i, k = idx >> 6, n = idx & 63; wv[i] = W[(size_t)(k0 + k) * N + n0 + n]; }
#pragma unroll
  for (int i = 0; i < 16; ++i) { const int idx = tid0 + 256 * i, k = idx >> 6, n = idx & 63; t[k * 65 + n] = wv[i]; }
  __syncthreads();
#pragma unroll 4
  for (int i = 0; i < 8; ++i) {
    const int idx = tid0 + 256 * i, n = idx >> 5, k = (idx & 31) * 2, j = n0 + n;
    const int rho = (mode == 0) ? j : ((j >> 6) * 128 + ((j >> 5) & 1) * 64 + (mode - 1) * 32 + (j & 31));
    *(unsigned*)(Wt + (size_t)rho * K + k0 + k) = pk(t[k * 65 + n], t[(k + 1) * 65 + n]);
  }
  __syncthreads();
}

DI void row_phase(const float* __restrict__ xin, float* __restrict__ xout, const bf16_t* addsrc, const float* __restrict__ gpost,
                  const float* __restrict__ gpre, bf16_t* hout, int lane_in) {
  const int lane = opaque(lane_in);
  f32x4 x[4];
#pragma unroll
  for (int i = 0; i < 4; ++i) x[i] = *(const f32x4*)(xin + i * 256 + lane * 4);
  if (addsrc) {
    f32x4 m[4]; float ss = 0.f;
#pragma unroll
    for (int i = 0; i < 4; ++i) { const u32x2 w = *(const u32x2*)(addsrc + i * 256 + lane * 4); m[i] = (f32x4){bflo(w.x), bfhi(w.x), bflo(w.y), bfhi(w.y)};
      ss += m[i][0] * m[i][0] + m[i][1] * m[i][1] + m[i][2] * m[i][2] + m[i][3] * m[i][3]; }
    ss = wave_sum(ss); const float rs = rsqrtf(ss * (1.0f / 1024.0f) + EPS);
#pragma unroll
    for (int i = 0; i < 4; ++i) { const f32x4 g = *(const f32x4*)(gpost + i * 256 + lane * 4); x[i] += m[i] * rs * g; }
  }
#pragma unroll
  for (int i = 0; i < 4; ++i) if (xout) *(f32x4*)(xout + i * 256 + lane * 4) = x[i];
  if (gpre) {
    float ss = 0.f;
#pragma unroll
    for (int i = 0; i < 4; ++i) ss += x[i][0] * x[i][0] + x[i][1] * x[i][1] + x[i][2] * x[i][2] + x[i][3] * x[i][3];
    ss = wave_sum(ss); const float rs = rsqrtf(ss * (1.0f / 1024.0f) + EPS);
#pragma unroll
    for (int i = 0; i < 4; ++i) { const f32x4 g = *(const f32x4*)(gpre + i * 256 + lane * 4); const f32x4 hv = x[i] * rs * g;
      u32x2 w; w.x = pk(hv[0], hv[1]); w.y = pk(hv[2], hv[3]); *(u32x2*)(hout + i * 256 + lane * 4) = w; }
  }
}

DI void row_phase2(const float* __restrict__ xinA, const float* __restrict__ xinB, float* __restrict__ xoutA, float* __restrict__ xoutB, const bf16_t* addA, const bf16_t* addB,
                   const float* __restrict__ gpost, const float* __restrict__ gpre, bf16_t* houtA, bf16_t* houtB, int lane_in) {
  const int lane = opaque(lane_in);
  f32x4 x[2][4]; u32x2 aw[2][4];
#pragma unroll
  for (int i = 0; i < 4; ++i) { x[0][i] = *(const f32x4*)(xinA + i * 256 + lane * 4); x[1][i] = *(const f32x4*)(xinB + i * 256 + lane * 4); }
  if (addA) {
#pragma unroll
    for (int i = 0; i < 4; ++i) { aw[0][i] = *(const u32x2*)(addA + i * 256 + lane * 4); aw[1][i] = *(const u32x2*)(addB + i * 256 + lane * 4); }
#pragma unroll
    for (int r = 0; r < 2; ++r) {
      f32x4 m[4]; float ss = 0.f;
#pragma unroll
      for (int i = 0; i < 4; ++i) { const u32x2 w = aw[r][i]; m[i] = (f32x4){bflo(w.x), bfhi(w.x), bflo(w.y), bfhi(w.y)};
        ss += m[i][0] * m[i][0] + m[i][1] * m[i][1] + m[i][2] * m[i][2] + m[i][3] * m[i][3]; }
      ss = wave_sum(ss); const float rs = rsqrtf(ss * (1.0f / 1024.0f) + EPS);
#pragma unroll
      for (int i = 0; i < 4; ++i) { const f32x4 g = *(const f32x4*)(gpost + i * 256 + lane * 4); x[r][i] += m[i] * rs * g; }
    }
  }
#pragma unroll
  for (int i = 0; i < 4; ++i) if (xoutA) { *(f32x4*)(xoutA + i * 256 + lane * 4) = x[0][i]; *(f32x4*)(xoutB + i * 256 + lane * 4) = x[1][i]; }
  if (gpre) {
#pragma unroll
    for (int r = 0; r < 2; ++r) {
      float ss = 0.f;
#pragma unroll
      for (int i = 0; i < 4; ++i) ss += x[r][i][0] * x[r][i][0] + x[r][i][1] * x[r][i][1] + x[r][i][2] * x[r][i][2] + x[r][i][3] * x[r][i][3];
      ss = wave_sum(ss); const float rs = rsqrtf(ss * (1.0f / 1024.0f) + EPS);
      bf16_t* ho = r == 0 ? houtA : houtB;
#pragma unroll
      for (int i = 0; i < 4; ++i) { const f32x4 g = *(const f32x4*)(gpre + i * 256 + lane * 4); const f32x4 hv = x[r][i] * rs * g;
        u32x2 w; w.x = pk(hv[0], hv[1]); w.y = pk(hv[2], hv[3]); *(u32x2*)(ho + i * 256 + lane * 4) = w; }
    }
  }
}

struct ASrc { const bf16_t* b0; const bf16_t* b1; const bf16_t* b2; const bf16_t* b3; int s0, s1, s2, s3; int shift; };

DI void store_piece64(char* img, const f32x16 (&acc)[2][2], bf16_t* out, size_t ld, int row0, int col0, int l31, int h) {
#pragma unroll
  for (int mf = 0; mf < 2; ++mf)
#pragma unroll
    for (int nf = 0; nf < 2; ++nf)
#pragma unroll
      for (int g = 0; g < 4; ++g) { u32x2 v; v.x = pk(acc[mf][nf][4 * g], acc[mf][nf][4 * g + 1]); v.y = pk(acc[mf][nf][4 * g + 2], acc[mf][nf][4 * g + 3]);
        *(u32x2*)(img + (mf * 32 + l31) * PITCH + (nf * 32 + 8 * g + 4 * h) * 2) = v; }
  const int ln = l31 + 32 * h;
#pragma unroll 2
  for (int i = 0; i < 8; ++i) { const int q = ln + 64 * i, r = q >> 3, c8 = q & 7;
    const u32x4 v = *(const u32x4*)(img + r * PITCH + c8 * 16); *(u32x4*)(out + (size_t)(row0 + r) * ld + col0 + c8 * 8) = v; }
}
DI void store_piece32(char* img, const f32x16 (&a0), const f32x16 (&a1), bf16_t* out, size_t ld, int row0, int col0, int l31, int h) {
#pragma unroll
  for (int g = 0; g < 4; ++g) { u32x2 v; v.x = pk(a0[4 * g], a0[4 * g + 1]); v.y = pk(a0[4 * g + 2], a0[4 * g + 3]); *(u32x2*)(img + l31 * PITCH + (8 * g + 4 * h) * 2) = v;
    u32x2 u; u.x = pk(a1[4 * g], a1[4 * g + 1]); u.y = pk(a1[4 * g + 2], a1[4 * g + 3]); *(u32x2*)(img + l31 * PITCH + (32 + 8 * g + 4 * h) * 2) = u; }
  const int ln = l31 + 32 * h;
#pragma unroll
  for (int i = 0; i < 4; ++i) { const int q = ln + 64 * i, r = q >> 3, c8 = q & 7;
    const u32x4 v = *(const u32x4*)(img + r * PITCH + c8 * 16); *(u32x4*)(out + (size_t)(row0 + r) * ld + col0 + c8 * 8) = v; }
}
struct EpiStore { bf16_t* out; int ldc; int nmax; char* lds;
  DI void operator()(const f32x16 (&acc)[2][2], int mb, int nb, int n0, int wc, int l31, int h) const {
    if (nb >= nmax) return;
    store_piece64(lds + (threadIdx.x >> 6) * 9216, acc, out, (size_t)ldc, mb, nb, l31, h);
  } };
struct EpiSwiGLU { bf16_t* out; char* lds;
  DI void operator()(const f32x16 (&acc)[2][2], int mb, int nb, int n0, int wc, int l31, int h) const {
    const int hc = (nb >> 6) * 32;
    char* img = lds + (threadIdx.x >> 6) * 9216;
#pragma unroll
    for (int mf = 0; mf < 2; ++mf)
#pragma unroll
      for (int g = 0; g < 4; ++g) { float r[4];
#pragma unroll
        for (int e = 0; e < 4; ++e) { const float gt = acc[mf][0][4 * g + e], up = acc[mf][1][4 * g + e]; r[e] = gt / (1.0f + __expf(-gt)) * up; }
        u32x2 v; v.x = pk(r[0], r[1]); v.y = pk(r[2], r[3]); *(u32x2*)(img + (mf * 32 + l31) * PITCH + (8 * g + 4 * h) * 2) = v; }
    const int ln = l31 + 32 * h;
#pragma unroll
    for (int i = 0; i < 4; ++i) { const int q = ln + 64 * i, r = q >> 2, c4 = q & 3;
      const u32x4 v = *(const u32x4*)(img + r * PITCH + c4 * 16); *(u32x4*)(out + (size_t)(mb + r) * DFF + hc + c4 * 8) = v; }
  } };

struct EpiIn { bf16_t* z; char* lds; const float* qg; const float* kg; const f32x2* tabA; const f32x2* tabB; const f32x2* tabC;
  DI void operator()(f32x16 (&acc)[2][2], int mb, int nb, int n0, int wc, int l31, int h) const {
    if (nb >= NIN) return;
    const bool isv = (nb >= A_V && nb < B_Q) || (nb >= B_V && nb < C_Q) || (nb >= C_V && nb < C_G);
    if (isv) {
      const int wv = (threadIdx.x >> 6);
      bf16_t* img = (bf16_t*)(lds + 32768 + wv * 9216);
#pragma unroll
      for (int mf = 0; mf < 2; ++mf)
#pragma unroll
        for (int nf = 0; nf < 2; ++nf)
#pragma unroll
          for (int i = 0; i < 16; ++i) { const int d = nf * 32 + (i & 3) + 8 * (i >> 2) + 4 * h; img[d * 72 + mf * 32 + l31] = f2bf(acc[mf][nf][i]); }
      __builtin_amdgcn_s_waitcnt(0xc07f);
      const int ln = l31 + 32 * h;
#pragma unroll
      for (int i = 0; i < 8; ++i) { const int q = ln + 64 * i, d = q >> 3, c8 = q & 7;
        const u32x4 v = *(const u32x4*)(img + d * 72 + c8 * 8); *(u32x4*)(z + (size_t)(mb + d) * NIN + nb + c8 * 8) = v; }
      return;
    }
#pragma unroll
    for (int mf = 0; mf < 2; ++mf) {
      const int row = mb + mf * 32 + l31; int t, T; row_info(row, t, T);
      if (nb < A_V) {
        const bool isq = nb < A_K; const float* gn = isq ? qg : kg;
        float ss = 0.f;
#pragma unroll
        for (int nf = 0; nf < 2; ++nf)
#pragma unroll
          for (int i = 0; i < 16; ++i) ss += acc[mf][nf][i] * acc[mf][nf][i];
        ss += __shfl_xor(ss, 32);
        const float rs = rsqrtf(ss * (1.0f / 64.0f) + EPS) * (isq ? 0.125f * LOG2E : 1.0f);
#pragma unroll
        for (int nf = 0; nf < 2; ++nf) {
          const int pos = nf == 0 ? (t >> 6) : (t & 63);
#pragma unroll
          for (int g = 0; g < 4; ++g)
#pragma unroll
            for (int e = 0; e < 4; ++e) acc[mf][nf][4 * g + e] *= rs * gn[nf * 32 + 8 * g + 4 * h + e];
#pragma unroll
          for (int g = 0; g < 2; ++g)
#pragma unroll
            for (int e = 0; e < 4; ++e) { const f32x2 cs = tabA[pos * 16 + 8 * g + 4 * h + e];
              const float x1 = acc[mf][nf][4 * g + e], x2 = acc[mf][nf][4 * (g + 2) + e];
              acc[mf][nf][4 * g + e] = x1 * cs.x - x2 * cs.y; acc[mf][nf][4 * (g + 2) + e] = x2 * cs.x + x1 * cs.y; }
        }
      } else if (nb >= B_Q && nb < B_V) {
        const bool isq = nb < B_K;
#pragma unroll
        for (int nf = 0; nf < 2; ++nf) {
#pragma unroll
          for (int e = 0; e < 4; ++e) { const f32x2 cs = tabB[t * 4 + e]; const float v = acc[mf][nf][e]; const float o = __shfl_xor(v, 32);
            acc[mf][nf][e] = (h == 0) ? (v * cs.x - o * cs.y) : (v * cs.x + o * cs.y); }
          if (isq) {
#pragma unroll
            for (int i = 0; i < 16; ++i) acc[mf][nf][i] *= 0.17677669529663687f * LOG2E; }
        }
      } else if (nb >= C_Q && nb < C_V) {
        const float sc = nb < C_K ? 1.0f : 0.125f;
#pragma unroll
        for (int g = 0; g < 4; ++g) {
#pragma unroll
          for (int e = 0; e < 4; ++e) { const f32x2 cs = tabC[t * 32 + 8 * g + 4 * h + e]; const float x1 = acc[mf][0][4 * g + e], x2 = acc[mf][1][4 * g + e];
            acc[mf][0][4 * g + e] = (x1 * cs.x - x2 * cs.y) * sc; acc[mf][1][4 * g + e] = (x2 * cs.x + x1 * cs.y) * sc; }
          if (g & 1) __builtin_amdgcn_sched_barrier(0); }
      }
      store_piece32(lds + (threadIdx.x >> 6) * 9216, acc[mf][0], acc[mf][1], z, (size_t)NIN, mb + mf * 32, nb, l31, h);
    }
  } };

#define LASP __attribute__((address_space(3)))
template <class Epi>
DI void gemm_tile(char* lds, const ASrc& A, const bf16_t* __restrict__ Bt, int K, int m0, int n0, const Epi& epi, bool first, bool has_next, int m0n, int n0n) {
  const int tid = opaque(threadIdx.x), lane = tid & 63, w = __builtin_amdgcn_readfirstlane(tid >> 6), wr = w >> 1, wc = w & 1, l31 = lane & 31, h = lane >> 5;
  const int nk = K >> 6, smask = (1 << A.shift) - 1;
  LASP char* ldsl = (LASP char*)lds;
  f32x16 acc[2][2];
#pragma unroll
  for (int a = 0; a < 2; ++a)
#pragma unroll
    for (int b = 0; b < 2; ++b)
#pragma unroll
      for (int i = 0; i < 16; ++i) acc[a][b][i] = 0.f;
  const int lrow = lane >> 3, lslot = lane & 7;
  int goffA[4], goffB[4];
#pragma unroll
  for (int i = 0; i < 4; ++i) { const int r = w * 32 + i * 8 + lrow, c = lslot ^ ((r >> 1) & 7); goffA[i] = r; goffB[i] = r * K + c * 8; goffA[i] = (goffA[i] << 3) | c; }
#define GEMM_ISSUE(kt, st, M0_, N0_) do { const int k0_ = (kt) << 6, seg_ = k0_ >> A.shift, kk_ = k0_ & smask; \
    const bf16_t* bp_ = seg_ == 0 ? A.b0 : seg_ == 1 ? A.b1 : seg_ == 2 ? A.b2 : A.b3; const int st_ = seg_ == 0 ? A.s0 : seg_ == 1 ? A.s1 : seg_ == 2 ? A.s2 : A.s3; \
    _Pragma("unroll") for (int i_ = 0; i_ < 4; ++i_) { \
      const bf16_t* ga_ = bp_ + (size_t)((M0_) + (goffA[i_] >> 3)) * st_ + kk_ + (goffA[i_] & 7) * 8; \
      __builtin_amdgcn_global_load_lds((const unsigned*)ga_, (LASP unsigned*)(ldsl + (st) * 32768 + (w * 4 + i_) * 1024), 16, 0, 0); \
      const bf16_t* gb_ = Bt + (size_t)(N0_) * K + goffB[i_] + k0_; \
      __builtin_amdgcn_global_load_lds((const unsigned*)gb_, (LASP unsigned*)(ldsl + (st) * 32768 + 16384 + (w * 4 + i_) * 1024), 16, 0, 0); } } while (0)
  const int xr = (l31 >> 1) & 7;
  int coff[4];
#pragma unroll
  for (int s = 0; s < 4; ++s) coff[s] = ((2 * s + h) ^ xr) * 16;
#define GEMM_COMPUTE(st) do { const char* as = lds + (st) * 32768; const char* bs = as + 16384; \
    bf16x8 af[4][2], wf[4][2]; \
    _Pragma("unroll") for (int s = 0; s < 4; ++s) { \
      _Pragma("unroll") for (int mf = 0; mf < 2; ++mf) af[s][mf] = *(const bf16x8*)(as + (wr * 64 + mf * 32 + l31) * 128 + coff[s]); \
      _Pragma("unroll") for (int nf = 0; nf < 2; ++nf) wf[s][nf] = *(const bf16x8*)(bs + (wc * 64 + nf * 32 + l31) * 128 + coff[s]); } \
    __builtin_amdgcn_sched_barrier(0); __builtin_amdgcn_s_setprio(1); \
    _Pragma("unroll") for (int s = 0; s < 4; ++s) \
      _Pragma("unroll") for (int mf = 0; mf < 2; ++mf) _Pragma("unroll") for (int nf = 0; nf < 2; ++nf) acc[mf][nf] = MFMA32(wf[s][nf], af[s][mf], acc[mf][nf]); \
    __builtin_amdgcn_s_setprio(0); __builtin_amdgcn_sched_barrier(0); } while (0)
  if (first) GEMM_ISSUE(0, 0, m0, n0);
  for (int kt = 0; kt < nk; kt += 2) {
    asm volatile("s_waitcnt vmcnt(0)" ::: "memory"); __syncthreads();
    GEMM_ISSUE(kt + 1, 1, m0, n0);
    GEMM_COMPUTE(0);
    asm volatile("s_waitcnt vmcnt(0)" ::: "memory"); __syncthreads();
    if (kt + 2 < nk) GEMM_ISSUE(kt + 2, 0, m0, n0);
    GEMM_COMPUTE(1);
  }
  __syncthreads();
  if (has_next) GEMM_ISSUE(0, 0, m0n, n0n);
  epi(acc, m0 + wr * 64, n0 + wc * 64, n0, wc, l31, h);
  __syncthreads();
#undef GEMM_ISSUE
#undef GEMM_COMPUTE
}

template <class Epi>
DI void gemm_phase(char* lds, const ASrc& A, const bf16_t* Bt, int K, int ntn, const Epi& epi) {
  const int xcd = blockIdx.x & 7, j = blockIdx.x >> 3, nloc = gridDim.x >> 3, per = 48 * ntn, grp = 8 * ntn;
  bool first = true;
  for (int li = j; li < per; li += nloc) {
    const int sg = li / grp, wi = li - sg * grp, nt = wi >> 3, mt = xcd * 48 + sg * 8 + (wi & 7);
    const int ln = li + nloc; const bool has_next = ln < per;
    const int sgn = ln / grp, win = ln - sgn * grp, ntn2 = win >> 3, mtn = xcd * 48 + sgn * 8 + (win & 7);
    gemm_tile(lds, A, Bt, K, mt * 128, nt * 128, epi, first, has_next, mtn * 128, ntn2 * 128);
    first = false;
  }
}

DI void prep_item(char* lds, const Params& p, int layer, int item) {
  const int tid = opaque(threadIdx.x), lane = tid & 63, w = tid >> 6;
  const int rowb = item * 64; int tb, T; row_info(rowb, tb, T);
  const float* qg = p.in[I_AQG] + layer * 64; const float* kg = p.in[I_AKG] + layer * 64;
  const float qgl = qg[lane], kgl = kg[lane];
  for (int tt = 0; tt < 16; ++tt) {
    const int row = rowb + w * 16 + tt, t = tb + w * 16 + tt;
    bf16_t* zr = p.z + (size_t)row * NIN;
    {
      const int j = lane & 31, i = j & 15; const bool first = j < 16; const int pos = (lane < 32) ? (t >> 6) : (t & 63);
      const f32x2 cs = p.tabA[pos * 16 + i];
#pragma unroll
      for (int hd = 0; hd < 6; ++hd) {
        bf16_t* ptr = zr + (hd < 4 ? A_Q + hd * 64 : A_K + (hd - 4) * 64) + lane;
        float v = bf2f(*ptr);
        const float ss = wave_sum(v * v);
        v = v * rsqrtf(ss * (1.0f / 64.0f) + EPS) * (hd < 4 ? qgl : kgl);
        const float o = __shfl_xor(v, 16);
        float r = first ? (v * cs.x - o * cs.y) : (v * cs.x + o * cs.y);
        if (hd < 4) r *= 0.125f * LOG2E;
        *ptr = f2bf(r);
      }
    }
    {
      const int d = lane & 31; const f32x2 cs = p.tabB[t * 4 + (d & 3)];
#pragma unroll
      for (int c = 0; c < 8; ++c) {
        bf16_t* ptr = zr + (c < 4 ? B_Q + c * 64 : B_K + (c - 4) * 64) + lane;
        float v = bf2f(*ptr);
        const float o = __shfl_xor(v, 4);
        float r = v;
        if (d < 8) r = (d < 4) ? (v * cs.x - o * cs.y) : (v * cs.x + o * cs.y);
        if (c < 4) r *= 0.17677669529663687f * LOG2E;
        *ptr = f2bf(r);
      }
    }
    {
      const f32x2 cs = p.tabC[t * 32 + (lane & 31)];
#pragma unroll
      for (int c = 0; c < 8; ++c) {
        bf16_t* ptr = zr + (c < 4 ? C_Q + c * 64 : C_K + (c - 4) * 64) + lane;
        const float v = bf2f(*ptr);
        const float o = __shfl_xor(v, 32);
        float r = (lane < 32) ? (v * cs.x - o * cs.y) : (v * cs.x + o * cs.y);
        if (c >= 4) r *= 0.125f;
        *ptr = f2bf(r);
      }
    }
  }
  bf16_t* tl = (bf16_t*)lds;
  const int r = tid >> 2, c0 = (tid & 3) * 16;
  for (int sl = 0; sl < 10; ++sl) {
    const int col = sl < 2 ? A_V + sl * 64 : sl < 6 ? B_V + (sl - 2) * 64 : C_V + (sl - 6) * 64;
    bf16_t* gp = p.z + (size_t)(rowb + r) * NIN + col + c0;
    const u32x4 v0 = *(const u32x4*)gp, v1 = *(const u32x4*)(gp + 8);
    __syncthreads();
#pragma unroll
    for (int e = 0; e < 4; ++e) {
      tl[(c0 + 2 * e) * 72 + r] = (bf16_t)(v0[e] & 0xffffu); tl[(c0 + 2 * e + 1) * 72 + r] = (bf16_t)(v0[e] >> 16);
      tl[(c0 + 8 + 2 * e) * 72 + r] = (bf16_t)(v1[e] & 0xffffu); tl[(c0 + 8 + 2 * e + 1) * 72 + r] = (bf16_t)(v1[e] >> 16);
    }
    __syncthreads();
    const u32x4 o0 = *(const u32x4*)(tl + r * 72 + c0), o1 = *(const u32x4*)(tl + r * 72 + c0 + 8);
    *(u32x4*)gp = o0; *(u32x4*)(gp + 8) = o1;
  }
  __syncthreads();
}

DI float dshift(const Params& p, const float* mup, const float* mun, int row, int t, int T, int dc) {
  const bf16_t* zp = p.z + (size_t)row * NIN + D_0 + dc;
  const float z = bf2f(*zp);
  const float zprev = (t > 0) ? bf2f(*(zp - NIN)) : 0.f;
  const float znext = (t < T - 1) ? bf2f(*(zp + NIN)) : 0.f;
  return z + mup[dc] * (zprev - z) + mun[dc] * (znext - z);
}
DI float sigmoidf_(float x) { return 1.0f / (1.0f + __expf(-x)); }
DI float omdecay(float ww) {
  const float e = 0.6065306597126334f / (1.0f + __expf(-ww));
  return 1.0f - __expf(-e);
}
DI float fast_tanh(float x) { const float xc = fminf(fmaxf(x, -15.f), 15.f); return 1.0f - 2.0f / (1.0f + __expf(2.0f * xc)); }
constexpr int DTOK = 16;
DI void dprep_item(char* lds, const Params& p, int layer, int item) {
  const int tid = opaque(threadIdx.x);
  const int rowb = item * DTOK; int tb, T; row_info(rowb, tb, T);
  const float* mup = p.in[I_DMUP] + layer * 1088; const float* mun = p.in[I_DMUN] + layer * 1088;
  float* su = (float*)lds;
  bf16_t* stg = (bf16_t*)(lds + 12288);
#pragma unroll
  for (int i = 0; i < 12; ++i) {
    const int idx = tid + 256 * i, tok = idx / 192, c = idx - tok * 192;
    float u = dshift(p, mup, mun, rowb + tok, tb + tok, T, 768 + c);
    if (c < 128) u = fast_tanh(u);
    su[c * DTOK + tok] = u;
  }
  __syncthreads();
  const int c = tid;
  const float w0f = p.in[I_DW0][(layer * 2 + 0) * 256 + c], w0b = p.in[I_DW0][(layer * 2 + 1) * 256 + c];
  const float a0 = p.in[I_DA0][layer * 256 + c], kkw = p.in[I_DKK][layer * 256 + c], kaw = p.in[I_DKA][layer * 256 + c];
  float zr[DTOK + 2], zk[DTOK + 2], zv[DTOK + 2];
  { const bf16_t* zp = p.z + (size_t)rowb * NIN + D_0 + c;
#pragma unroll
    for (int i = 0; i < DTOK + 2; ++i) { const int t = tb - 1 + i; const bool ok = (t >= 0) && (t < T); const bf16_t* q = zp + (ptrdiff_t)(i - 1) * NIN;
      zr[i] = ok ? bf2f(q[0]) : 0.f; zk[i] = ok ? bf2f(q[256]) : 0.f; zv[i] = ok ? bf2f(q[512]) : 0.f; } }
  const float mpr = mup[c], mnr = mun[c], mpk = mup[256 + c], mnk = mun[256 + c], mpv = mup[512 + c], mnv = mun[512 + c];
  float accf[DTOK], accb[DTOK], acca[DTOK];
#pragma unroll
  for (int k = 0; k < DTOK; ++k) { accf[k] = 0.f; accb[k] = 0.f; acca[k] = 0.f; }
  const float* wupf = p.in[I_DWUP] + (size_t)(layer * 2 + 0) * 64 * 256 + c;
  const float* wupb = p.in[I_DWUP] + (size_t)(layer * 2 + 1) * 64 * 256 + c;
  const float* aup = p.in[I_DAUP] + (size_t)layer * 64 * 256 + c;
#pragma unroll 2
  for (int j = 0; j < 64; ++j) {
    const float wf = wupf[j * 256], wb = wupb[j * 256], wa = aup[j * 256];
#pragma unroll
    for (int q = 0; q < 4; ++q) {
      const f32x4 f0 = *(const f32x4*)(su + j * DTOK + 4 * q), b0 = *(const f32x4*)(su + (64 + j) * DTOK + 4 * q), a0v = *(const f32x4*)(su + (128 + j) * DTOK + 4 * q);
#pragma unroll
      for (int k = 0; k < 4; ++k) { accf[4 * q + k] += f0[k] * wf; accb[4 * q + k] += b0[k] * wb; acca[4 * q + k] += a0v[k] * wa; }
    }
  }
#pragma unroll
  for (int k = 0; k < DTOK; ++k) {
    const float r = zr[k + 1] + mpr * (zr[k] - zr[k + 1]) + mnr * (zr[k + 2] - zr[k + 1]);
    const float kx = zk[k + 1] + mpk * (zk[k] - zk[k + 1]) + mnk * (zk[k + 2] - zk[k + 1]);
    const float v = zv[k + 1] + mpv * (zv[k] - zv[k + 1]) + mnv * (zv[k + 2] - zv[k + 1]);
    const float omf = omdecay(w0f + accf[k]), omb = omdecay(w0b + accb[k]);
    const float a = sigmoidf_(a0 + acca[k]);
    float kk = kx * kkw; const float n2 = wave_sum(kk * kk);
    kk = kk * rsqrtf(fmaxf(n2, 1e-24f));
    const float kmod = kx * (1.0f + (a - 1.0f) * kaw), b = kk * a;
    bf16_t* so = stg + k * 256 + c;
    so[0] = f2bf(r); so[DTOK * 256] = f2bf(kmod); so[2 * DTOK * 256] = f2bf(v); so[3 * DTOK * 256] = f2bf(-kk);
    so[4 * DTOK * 256] = f2bf(b); so[5 * DTOK * 256] = f2bf(omf); so[6 * DTOK * 256] = f2bf(omb);
  }
  __syncthreads();
#pragma unroll
  for (int i = 0; i < 14; ++i) {
    const int q = tid + 256 * i, pln = q >> 9, rem = q & 511, tok = rem >> 5, c16 = rem & 31;
    const u32x4 v = *(const u32x4*)(stg + pln * (DTOK * 256) + tok * 256 + c16 * 8);
    *(u32x4*)(p.pl + (size_t)pln * PLANE + (size_t)(rowb + tok) * 256 + c16 * 8) = v;
  }
  __syncthreads();
}

DI void dpost_item(char* lds, const Params& p, int layer, int item) {
  const int tid = opaque(threadIdx.x);
  const int rowb = item * DTOK; int tb, T; row_info(rowb, tb, T);
  const float* mup = p.in[I_DMUP] + layer * 1088; const float* mun = p.in[I_DMUN] + layer * 1088;
  float* sg = (float*)lds;
  bf16_t* stg = (bf16_t*)(lds + 8192);
#pragma unroll
  for (int i = 0; i < 8; ++i) { const int idx = tid + 256 * i, tok = idx >> 7, c = idx & 127; sg[c * DTOK + tok] = sigmoidf_(dshift(p, mup, mun, rowb + tok, tb + tok, T, 960 + c)); }
  __syncthreads();
  const int c = tid;
  float acc[DTOK];
#pragma unroll
  for (int k = 0; k < DTOK; ++k) acc[k] = 0.f;
  float yv[DTOK], rv_[DTOK], kmv[DTOK], vv_[DTOK];
#pragma unroll
  for (int k = 0; k < DTOK; ++k) { const int row = rowb + k; const bf16_t* zd = p.z + (size_t)row * NIN + D_0; const size_t o = (size_t)row * 256 + c;
    yv[k] = bf2f(zd[c]) + bf2f(zd[256 + c]); rv_[k] = bf2f(p.pl[o]); kmv[k] = bf2f(p.pl[PLANE + o]); vv_[k] = bf2f(p.pl[2 * PLANE + o]); }
  const float* gup = p.in[I_DGUP] + (size_t)layer * 128 * 256 + c;
#pragma unroll 4
  for (int j = 0; j < 128; ++j) { const float gw = gup[j * 256];
#pragma unroll
    for (int q = 0; q < 4; ++q) { const f32x4 s0 = *(const f32x4*)(sg + j * DTOK + 4 * q);
#pragma unroll
      for (int k = 0; k < 4; ++k) acc[4 * q + k] += s0[k] * gw; } }
  const float gnw = p.in[I_DGNW][layer * 256 + c], gnb = p.in[I_DGNB][layer * 256 + c], rk = p.in[I_DRK][layer * 256 + c];
#pragma unroll
  for (int k = 0; k < DTOK; ++k) {
    const float y = yv[k];
    const float mean = wave_sum(y) * (1.0f / 64.0f); const float d = y - mean; const float var = wave_sum(d * d) * (1.0f / 64.0f);
    const float yn = d * rsqrtf(var + 64e-5f) * gnw + gnb;
    const float r = rv_[k], km = kmv[k], v = vv_[k];
    const float bonus = wave_sum(r * km * rk);
    stg[k * 256 + c] = f2bf((yn + bonus * v) * acc[k]);
  }
  __syncthreads();
#pragma unroll
  for (int i = 0; i < 2; ++i) { const int q = tid + 256 * i, tok = q >> 5, c16 = q & 31;
    const u32x4 v = *(const u32x4*)(stg + tok * 256 + c16 * 8);
    *(u32x4*)(p.pl + 4 * PLANE + (size_t)(rowb + tok) * 256 + c16 * 8) = v; }
  __syncthreads();
}

DI void rwkv_item(char* lds, const Params& p, int seq, int head, int dir, int half) {
  int row0, T; seq_info(seq, row0, T);
  const int tid = opaque(threadIdx.x), kc = tid & 7, vrow = half * 32 + (tid >> 3);
  float* st = (float*)lds;
  f32x2 S[4];
#pragma unroll
  for (int j = 0; j < 4; ++j) S[j] = (f32x2){0.f, 0.f};
  const int nchunk = T >> 4;
  u32x4 rg[3];
  const int tsel = tid >> 7, srem = tid & 127, sstep = srem >> 3, sc8 = srem & 7;
#define RW_GLOAD(c) do { _Pragma("unroll") for (int i_ = 0; i_ < 3; ++i_) { const int tens_ = tsel + 2 * i_; \
      const int plane_ = tens_ == 0 ? (dir ? 6 : 5) : tens_ == 1 ? 3 : tens_ == 2 ? 4 : tens_ == 3 ? 1 : tens_ == 4 ? 0 : 2; \
      const int t_ = dir ? (T - 1 - ((c) * 16 + sstep)) : ((c) * 16 + sstep); \
      rg[i_] = *(const u32x4*)(p.pl + (size_t)plane_ * PLANE + (size_t)(row0 + t_) * 256 + head * 64 + sc8 * 8); } } while (0)
#define RW_LSTORE(buf) do { _Pragma("unroll") for (int i_ = 0; i_ < 3; ++i_) { const int tens_ = tsel + 2 * i_; \
      f32x4 a_ = {bflo(rg[i_].x), bfhi(rg[i_].x), bflo(rg[i_].y), bfhi(rg[i_].y)}, b_ = {bflo(rg[i_].z), bfhi(rg[i_].z), bflo(rg[i_].w), bfhi(rg[i_].w)}; \
      if (tens_ == 0) { a_ = 1.0f - a_; b_ = 1.0f - b_; } \
      float* d_ = st + (((buf) * 16 + sstep) * 6 + tens_) * 64 + sc8 * 8; *(f32x4*)d_ = a_; *(f32x4*)(d_ + 4) = b_; } } while (0)
  __builtin_amdgcn_s_setprio(3);
  RW_GLOAD(0); RW_LSTORE(0); __syncthreads();
  bf16_t* ybase = p.z + (size_t)row0 * NIN + D_0 + dir * 256 + head * 64 + half * 32;
  for (int c = 0; c < nchunk; ++c) {
    if (c + 1 < nchunk) RW_GLOAD(c + 1);
    const float* sb = st + (c & 1) * (16 * 384);
    unsigned* yb = (unsigned*)(lds + 49152) + (c & 1) * 256;
    if (c > 0 && tid < 64) {
      const int sp = tid >> 2, part = tid & 3, tt = (c - 1) * 16 + sp; const int t_ = dir ? (T - 1 - tt) : tt;
      const u32x4 v = *(const u32x4*)((unsigned*)(lds + 49152) + ((c - 1) & 1) * 256 + sp * 16 + part * 4);
      *(u32x4*)(ybase + (size_t)t_ * NIN + part * 8) = v; }
#define RW_FETCH(S_, s_) do { const float* q_ = sb + (s_) * 384 + kc * 8; \
      S_##w0 = *(const f32x4*)(q_); S_##w1 = *(const f32x4*)(q_ + 4); S_##n0 = *(const f32x4*)(q_ + 64); S_##n1 = *(const f32x4*)(q_ + 68); \
      S_##b0 = *(const f32x4*)(q_ + 128); S_##b1 = *(const f32x4*)(q_ + 132); S_##k0 = *(const f32x4*)(q_ + 192); S_##k1 = *(const f32x4*)(q_ + 196); \
      S_##r0 = *(const f32x4*)(q_ + 256); S_##r1 = *(const f32x4*)(q_ + 260); S_##vv = sb[(s_) * 384 + 320 + vrow]; } while (0)
#define LO2(x) ((f32x2){(x)[0], (x)[1]})
#define HI2(x) ((f32x2){(x)[2], (x)[3]})
#define RW_STEP(S_, s_) do { \
      f32x2 a2 = S[0] * LO2(S_##n0); a2 += S[1] * HI2(S_##n0); a2 += S[2] * LO2(S_##n1); a2 += S[3] * HI2(S_##n1); \
      const float sa = red8(a2.x + a2.y); const float vx = S_##vv; \
      S[0] = S[0] * LO2(S_##w0) + (LO2(S_##b0) * sa + LO2(S_##k0) * vx); S[1] = S[1] * HI2(S_##w0) + (HI2(S_##b0) * sa + HI2(S_##k0) * vx); \
      S[2] = S[2] * LO2(S_##w1) + (LO2(S_##b1) * sa + LO2(S_##k1) * vx); S[3] = S[3] * HI2(S_##w1) + (HI2(S_##b1) * sa + HI2(S_##k1) * vx); \
      f32x2 y2 = S[0] * LO2(S_##r0); y2 += S[1] * HI2(S_##r0); y2 += S[2] * LO2(S_##r1); y2 += S[3] * HI2(S_##r1); \
      const float y = red8(y2.x + y2.y); const float yn = DPPF(y, 0x128);     \
      if ((tid & 15) == 0) yb[(s_) * 16 + (tid >> 4)] = pk(y, yn); } while (0)
    f32x4 Aw0, Aw1, An0, An1, Ab0, Ab1, Ak0, Ak1, Ar0, Ar1; float Avv;
    f32x4 Bw0, Bw1, Bn0, Bn1, Bb0, Bb1, Bk0, Bk1, Br0, Br1; float Bvv;
    RW_FETCH(A, 0);
#pragma unroll
    for (int s = 0; s < 16; s += 2) {
      RW_FETCH(B, s + 1);
      RW_STEP(A, s);
      if (s + 2 < 16) RW_FETCH(A, s + 2);
      RW_STEP(B, s + 1);
    }
#undef RW_FETCH
#undef RW_STEP
    if (c + 1 < nchunk) RW_LSTORE((c + 1) & 1);
    __syncthreads();
  }
#undef RW_GLOAD
#undef RW_LSTORE
  if (tid < 64) { const int c = nchunk; const int sp = tid >> 2, part = tid & 3, tt = (c - 1) * 16 + sp; const int t_ = dir ? (T - 1 - tt) : tt;
    const u32x4 v = *(const u32x4*)((unsigned*)(lds + 49152) + ((c - 1) & 1) * 256 + sp * 16 + part * 4);
    *(u32x4*)(ybase + (size_t)t_ * NIN + part * 8) = v; }
  __syncthreads();
  __builtin_amdgcn_s_setprio(0);
}

template <int MODE>
DI void attn_item(char* lds, const Params& p, int layer, int seq, int head, int qt) {
  const int tid = opaque(threadIdx.x), lane = tid & 63, w = tid >> 6, l31 = lane & 31, h = lane >> 5;
  layer = opaque_s(layer); seq = opaque_s(seq); head = opaque_s(head); qt = opaque_s(qt);
  int row0, T; seq_info(seq, row0, T);
  const int QC = (MODE == 0 ? A_Q : MODE == 1 ? B_Q : C_Q) + head * 64;
  const int KC = MODE == 0 ? A_K + (head >> 1) * 64 : MODE == 1 ? B_K + head * 64 : C_K + head * 64;
  const int VC = MODE == 0 ? A_V + (head >> 1) * 64 : MODE == 1 ? B_V + head * 64 : C_V + head * 64;
  const int qw0 = qt * 128 + w * 32, qi = qw0 + l31;
  bf16_t* zq = p.z + (size_t)(row0 + qi) * NIN + QC;
  bf16x8 qf[4];
#pragma unroll
  for (int s = 0; s < 4; ++s) qf[s] = *(const bf16x8*)(zq + s * 16 + h * 8);
  const int srow = tid >> 3, sc8 = tid & 7;
  const bf16_t* kbase = p.z + (size_t)(row0 + srow) * NIN + KC + sc8 * 8;
  const bf16_t* vbase = p.z + (size_t)(row0 + srow) * NIN + VC + sc8 * 8;
  u32x4 rk[2][2], rv[2][2];
  const int nt = T >> 6;
  const int prow = (l31 & 19) | ((l31 & 4) << 1) | ((l31 & 8) >> 1);
#define AT_GLOAD(t, S) do { _Pragma("unroll") for (int i_ = 0; i_ < 2; ++i_) { const size_t off_ = (size_t)((t) * 64 + 32 * i_) * NIN; rk[S][i_] = *(const u32x4*)(kbase + off_); rv[S][i_] = *(const u32x4*)(vbase + off_); } } while (0)
#define AT_LSTORE(buf, S) do { char* ks_ = lds + (buf) * 18432; char* vs_ = ks_ + 9216; \
    _Pragma("unroll") for (int i_ = 0; i_ < 2; ++i_) { *(u32x4*)(ks_ + (srow + 32 * i_) * PITCH + sc8 * 16) = rk[S][i_]; *(u32x4*)(vs_ + (srow + 32 * i_) * PITCH + sc8 * 16) = rv[S][i_]; } } while (0)
  constexpr int NMAP = (MODE == 1) ? 2 : 1;
  f32x16 o[NMAP][2];
  float m_run[NMAP], l_run[NMAP];
#pragma unroll
  for (int a = 0; a < NMAP; ++a) { m_run[a] = -INFINITY; l_run[a] = 0.f;
#pragma unroll
    for (int b = 0; b < 2; ++b)
#pragma unroll
      for (int i = 0; i < 16; ++i) o[a][b][i] = 0.f; }
  float lf = 0.f, lb = 0.f;
  if (MODE == 2) { lf = log2f(1.0f - exp2f(-5.0f - (float)head)); lb = log2f(1.0f - exp2f(-5.0f - (float)(3 - head))); }
  auto body = [&](const char* ks, const char* vs, const int t) __attribute__((always_inline)) {
#pragma unroll
    for (int mp = 0; mp < NMAP; ++mp) {
      f32x16 st[2];
#pragma unroll
      for (int kf = 0; kf < 2; ++kf) {
#pragma unroll
        for (int i = 0; i < 16; ++i) st[kf][i] = 0.f;
        if (MODE == 1) {
#pragma unroll
          for (int s = 0; s < 2; ++s) { const bf16x8 kfr = *(const bf16x8*)(ks + (kf * 32 + prow) * PITCH + (mp * 2 + s) * 32 + h * 16); st[kf] = MFMA32(kfr, qf[mp * 2 + s], st[kf]); }
        } else {
#pragma unroll
          for (int s = 0; s < 4; ++s) { const bf16x8 kfr = *(const bf16x8*)(ks + (kf * 32 + prow) * PITCH + s * 32 + h * 16); st[kf] = MFMA32(kfr, qf[s], st[kf]); }
        }
      }
      if (MODE == 2) {
        const int k0 = t * 64;
        const float dbase = (float)(qi - k0 - 8 * h);
        if (k0 + 63 < qw0) {
#pragma unroll
          for (int kf = 0; kf < 2; ++kf)
#pragma unroll
            for (int i = 0; i < 16; ++i) { const float cc = (float)(32 * kf + (i & 3) + 4 * ((i >> 2) & 1) + 16 * ((i >> 3) & 1)); st[kf][i] *= fexp2(lf * (dbase - cc)); }
        } else if (k0 > qw0 + 31) {
#pragma unroll
          for (int kf = 0; kf < 2; ++kf)
#pragma unroll
            for (int i = 0; i < 16; ++i) { const float cc = (float)(32 * kf + (i & 3) + 4 * ((i >> 2) & 1) + 16 * ((i >> 3) & 1)); st[kf][i] *= fexp2(lb * (cc - dbase)); }
        } else {
#pragma unroll
          for (int kf = 0; kf < 2; ++kf)
#pragma unroll
            for (int i = 0; i < 16; ++i) { const float cc = (float)(32 * kf + (i & 3) + 4 * ((i >> 2) & 1) + 16 * ((i >> 3) & 1)); const float d = dbase - cc;
              float dd = fexp2(fminf(lf * d, -lb * d)); if (d == 0.f) dd = 2.0f; st[kf][i] *= dd; }
        }
      } else {
        float mx = st[0][0];
#pragma unroll
        for (int kf = 0; kf < 2; ++kf)
#pragma unroll
          for (int i = 0; i < 16; ++i) mx = fmaxf(mx, st[kf][i]);
        mx = fmaxf(mx, __shfl_xor(mx, 32));
        const float mn = fmaxf(m_run[mp], mx); const float alpha = fexp2(m_run[mp] - mn); m_run[mp] = mn;
        float ps = 0.f;
#pragma unroll
        for (int kf = 0; kf < 2; ++kf)
#pragma unroll
          for (int i = 0; i < 16; ++i) { st[kf][i] = fexp2(st[kf][i] - mn); ps += st[kf][i]; }
        l_run[mp] = l_run[mp] * alpha + ps;
#pragma unroll
        for (int df = 0; df < 2; ++df) o[mp][df] *= alpha;
      }
      bf16x8 pf[4];
#pragma unroll
      for (int kf = 0; kf < 2; ++kf)
#pragma unroll
        for (int s2 = 0; s2 < 2; ++s2) { u32x4 u; u.x = pk(st[kf][8 * s2], st[kf][8 * s2 + 1]); u.y = pk(st[kf][8 * s2 + 2], st[kf][8 * s2 + 3]);
          u.z = pk(st[kf][8 * s2 + 4], st[kf][8 * s2 + 5]); u.w = pk(st[kf][8 * s2 + 6], st[kf][8 * s2 + 7]); pf[kf * 2 + s2] = __builtin_bit_cast(bf16x8, u); }
#pragma unroll
      for (int df = 0; df < 2; ++df)
#pragma unroll
        for (int ksx = 0; ksx < 4; ++ksx) { const bf16x8 vfr = *(const bf16x8*)(vs + (df * 32 + l31) * PITCH + ksx * 32 + h * 16); o[mp][df] = MFMA32(vfr, pf[ksx], o[mp][df]); }
    }
  };
  if constexpr (MODE == 1) {
    AT_GLOAD(0, 0); AT_LSTORE(0, 0); __syncthreads();
#pragma unroll 1
    for (int t = 0; t < nt; ++t) {
      if (t + 1 < nt) AT_GLOAD(t + 1, 0);
      const char* ks = lds + (t & 1) * 18432;
      body(ks, ks + 9216, t);
      if (t + 1 < nt) AT_LSTORE((t + 1) & 1, 0);
      __syncthreads();
    }
  } else {
    AT_GLOAD(0, 0); AT_GLOAD(1, 1); AT_LSTORE(0, 0); __syncthreads();
#pragma unroll 1
    for (int t2 = 0; t2 < nt; t2 += 2) {
      if (t2 + 2 < nt) AT_GLOAD(t2 + 2, 0);
      body(lds, lds + 9216, t2);
      AT_LSTORE(1, 1);
      __syncthreads();
      if (t2 + 3 < nt) AT_GLOAD(t2 + 3, 1);
      body(lds + 18432, lds + 18432 + 9216, t2 + 1);
      if (t2 + 2 < nt) AT_LSTORE(0, 0);
      __syncthreads();
    }
  }
#undef AT_GLOAD
#undef AT_LSTORE
  f32x16 r[2];
  if (MODE == 0) {
    const float l = l_run[0] + __shfl_xor(l_run[0], 32); const float inv = 1.0f / l;
#pragma unroll
    for (int df = 0; df < 2; ++df) r[df] = o[0][df] * inv;
  } else if (MODE == 1) {
    const float* lp = p.in[I_BLAM] + layer * 128;
    float s01 = 0.f, s23 = 0.f;
    for (int i = 0; i < 32; ++i) { s01 += lp[i] * lp[32 + i]; s23 += lp[64 + i] * lp[96 + i]; }
    const float lam_init = 0.8f - 0.6f * expf(-0.3f * (float)layer);
    const float lam = expf(s01) - expf(s23) + lam_init;
    const float l0 = l_run[0] + __shfl_xor(l_run[0], 32), l1 = l_run[NMAP - 1] + __shfl_xor(l_run[NMAP - 1], 32);
    const float i0 = 1.0f / l0, i1 = lam / l1;
    float ss = 0.f;
#pragma unroll
    for (int df = 0; df < 2; ++df) { r[df] = o[0][df] * i0 - o[NMAP - 1][df] * i1;
#pragma unroll
      for (int i = 0; i < 16; ++i) ss += r[df][i] * r[df][i]; }
    ss += __shfl_xor(ss, 32);
    const float rs = rsqrtf(ss * (1.0f / 64.0f) + EPS) * (1.0f - lam_init);
    const float* sg = p.in[I_BSUB] + layer * 64;
#pragma unroll
    for (int df = 0; df < 2; ++df)
#pragma unroll
      for (int i = 0; i < 16; ++i) r[df][i] *= rs * sg[df * 32 + (i & 3) + 8 * (i >> 2) + 4 * h];
  } else {
    float ss = 0.f;
#pragma unroll
    for (int df = 0; df < 2; ++df)
#pragma unroll
      for (int i = 0; i < 16; ++i) ss += o[0][df][i] * o[0][df][i];
    ss += __shfl_xor(ss, 32);
    const float rs = rsqrtf(ss * (1.0f / 64.0f) + EPS);
    const float* gg = p.in[I_CGN] + layer * 256 + head * 64;
    const bf16_t* zg = p.z + (size_t)(row0 + qi) * NIN + C_G + head * 64;
#pragma unroll
    for (int df = 0; df < 2; ++df)
#pragma unroll
      for (int g = 0; g < 4; ++g) { const u32x2 gw = *(const u32x2*)(zg + df * 32 + 8 * g + 4 * h);
        const float gv[4] = {bflo(gw.x), bfhi(gw.x), bflo(gw.y), bfhi(gw.y)};
#pragma unroll
        for (int e = 0; e < 4; ++e) { const float x = gv[e]; r[df][4 * g + e] = o[0][df][4 * g + e] * rs * gg[df * 32 + 8 * g + 4 * h + e] * (x / (1.0f + __expf(-x))); } }
  }
#pragma unroll
  for (int df = 0; df < 2; ++df)
#pragma unroll
    for (int g = 0; g < 4; ++g) { u32x2 v; v.x = pk(r[df][4 * g], r[df][4 * g + 1]); v.y = pk(r[df][4 * g + 2], r[df][4 * g + 3]); *(u32x2*)(zq + df * 32 + 8 * g + 4 * h) = v; }
}

template <class Epi>
DI void gemm_tile2(char* lds, const ASrc& A, const bf16_t* __restrict__ Bt, int K, int m0, int n0, const Epi& epi) {
  const int tid = opaque(threadIdx.x), lane = tid & 63, w = __builtin_amdgcn_readfirstlane(tid >> 6), wr = w >> 1, wc = w & 1, l31 = lane & 31, h = lane >> 5;
  const int nk = K >> 5, smask = (1 << A.shift) - 1;
  LASP char* ldsl = (LASP char*)lds;
  f32x16 acc[2][4];
#pragma unroll
  for (int a = 0; a < 2; ++a)
#pragma unroll
    for (int b = 0; b < 4; ++b)
#pragma unroll
      for (int i = 0; i < 16; ++i) acc[a][b][i] = 0.f;
  const int lrow = lane >> 2, lslot = lane & 3;
  int goffA[2], goffB[4];
#pragma unroll
  for (int i = 0; i < 2; ++i) { const int r = (2 * w + i) * 16 + lrow, c = lslot ^ ((r >> 2) & 3); goffA[i] = (r << 2) | c; }
#pragma unroll
  for (int i = 0; i < 4; ++i) { const int r = (4 * w + i) * 16 + lrow, c = lslot ^ ((r >> 2) & 3); goffB[i] = r * K + c * 8; }
#define G2_ISSUE(kt, st) do { const int k0_ = (kt) << 5, seg_ = k0_ >> A.shift, kk_ = k0_ & smask; \
    const bf16_t* bp_ = seg_ == 0 ? A.b0 : seg_ == 1 ? A.b1 : seg_ == 2 ? A.b2 : A.b3; const int st_ = seg_ == 0 ? A.s0 : seg_ == 1 ? A.s1 : seg_ == 2 ? A.s2 : A.s3; \
    _Pragma("unroll") for (int i_ = 0; i_ < 2; ++i_) { \
      const bf16_t* ga_ = bp_ + (size_t)(m0 + (goffA[i_] >> 2)) * st_ + kk_ + (goffA[i_] & 3) * 8; \
      __builtin_amdgcn_global_load_lds((const unsigned*)ga_, (LASP unsigned*)(ldsl + (st) * 24576 + (2 * w + i_) * 1024), 16, 0, 0); } \
    _Pragma("unroll") for (int i_ = 0; i_ < 4; ++i_) { \
      const bf16_t* gb_ = Bt + (size_t)n0 * K + goffB[i_] + k0_; \
      __builtin_amdgcn_global_load_lds((const unsigned*)gb_, (LASP unsigned*)(ldsl + (st) * 24576 + 8192 + (4 * w + i_) * 1024), 16, 0, 0); } } while (0)
  const int xr = (l31 >> 2) & 3;
  int coff[2];
#pragma unroll
  for (int s = 0; s < 2; ++s) coff[s] = ((2 * s + h) ^ xr) * 16;
#define G2_COMPUTE(st) do { const char* as = lds + (st) * 24576; const char* bs = as + 8192; \
    bf16x8 af[2][2], wf[2][4]; \
    _Pragma("unroll") for (int s = 0; s < 2; ++s) { \
      _Pragma("unroll") for (int mf = 0; mf < 2; ++mf) af[s][mf] = *(const bf16x8*)(as + (wr * 64 + mf * 32 + l31) * 64 + coff[s]); \
      _Pragma("unroll") for (int nf = 0; nf < 4; ++nf) wf[s][nf] = *(const bf16x8*)(bs + (wc * 128 + nf * 32 + l31) * 64 + coff[s]); } \
    __builtin_amdgcn_sched_barrier(0); __builtin_amdgcn_s_setprio(1); \
    _Pragma("unroll") for (int s = 0; s < 2; ++s) \
      _Pragma("unroll") for (int mf = 0; mf < 2; ++mf) _Pragma("unroll") for (int nf = 0; nf < 4; ++nf) acc[mf][nf] = MFMA32(wf[s][nf], af[s][mf], acc[mf][nf]); \
    __builtin_amdgcn_s_setprio(0); __builtin_amdgcn_sched_barrier(0); } while (0)
  G2_ISSUE(0, 0);
  for (int kt = 0; kt < nk; kt += 2) {
    asm volatile("s_waitcnt vmcnt(0)" ::: "memory"); __syncthreads();
    G2_ISSUE(kt + 1, 1);
    G2_COMPUTE(0);
    asm volatile("s_waitcnt vmcnt(0)" ::: "memory"); __syncthreads();
    if (kt + 2 < nk) G2_ISSUE(kt + 2, 0);
    G2_COMPUTE(1);
  }
  __syncthreads();
#pragma unroll
  for (int hf = 0; hf < 2; ++hf) {
    f32x16 t[2][2];
#pragma unroll
    for (int mf = 0; mf < 2; ++mf) { t[mf][0] = acc[mf][2 * hf]; t[mf][1] = acc[mf][2 * hf + 1]; }
    epi(t, m0 + wr * 64, n0 + wc * 128 + hf * 64, n0, wc, l31, h);
  }
  __syncthreads();
#undef G2_ISSUE
#undef G2_COMPUTE
}

template <class Epi>
DI void gemm_phase2(char* lds, const ASrc& A, const bf16_t* Bt, int K, int ntn, const Epi& epi) {
  const int xcd = blockIdx.x & 7, j = blockIdx.x >> 3, nloc = gridDim.x >> 3, per = 48 * ntn, grp = 8 * ntn;
  for (int li = j; li < per; li += nloc) {
    const int sg = li / grp, wi = li - sg * grp, nt = wi >> 3, mt = xcd * 48 + sg * 8 + (wi & 7);
    gemm_tile2(lds, A, Bt, K, mt * 128, nt * 256, epi);
  }
}

template <int MODE>
DI void attn3_item(char* lds, const Params& p, int layer, int seq, int head, int qt) {
  const int tid = opaque(threadIdx.x), lane = tid & 63, w = tid >> 6, l31 = lane & 31, h = lane >> 5;
  layer = opaque_s(layer); seq = opaque_s(seq); head = opaque_s(head); qt = opaque_s(qt);
  int row0, T; seq_info(seq, row0, T);
  const int QC = (MODE == 0 ? A_Q : C_Q) + head * 64;
  const int KC = MODE == 0 ? A_K + (head >> 1) * 64 : C_K + head * 64;
  const int VC = MODE == 0 ? A_V + (head >> 1) * 64 : C_V + head * 64;
  const int qw0 = qt * 256 + w * 64;
  bf16x8 qf[2][4];
#pragma unroll
  for (int qi = 0; qi < 2; ++qi)
#pragma unroll
    for (int s = 0; s < 4; ++s) qf[qi][s] = *(const bf16x8*)(p.z + (size_t)(row0 + qw0 + qi * 32 + l31) * NIN + QC + s * 16 + h * 8);
  const int srow = tid >> 3, sc8 = tid & 7;
  const bf16_t* kbase = p.z + (size_t)(row0 + srow) * NIN + KC + sc8 * 8;
  const bf16_t* vbase = p.z + (size_t)(row0 + srow) * NIN + VC + sc8 * 8;
  u32x4 rk[2], rv[2];
  const int nt = T >> 6;
  const int prow = (l31 & 19) | ((l31 & 4) << 1) | ((l31 & 8) >> 1);
#define A3_GLOAD(t) do { _Pragma("unroll") for (int i_ = 0; i_ < 2; ++i_) { const size_t off_ = (size_t)((t) * 64 + 32 * i_) * NIN; rk[i_] = *(const u32x4*)(kbase + off_); rv[i_] = *(const u32x4*)(vbase + off_); } } while (0)
#define A3_LSTORE(buf) do { char* ks_ = lds + (buf) * 18432; char* vs_ = ks_ + 9216; \
    _Pragma("unroll") for (int i_ = 0; i_ < 2; ++i_) { *(u32x4*)(ks_ + (srow + 32 * i_) * PITCH + sc8 * 16) = rk[i_]; *(u32x4*)(vs_ + (srow + 32 * i_) * PITCH + sc8 * 16) = rv[i_]; } } while (0)
  f32x16 o[2][2];
  float m_run[2], l_run[2];
#pragma unroll
  for (int a = 0; a < 2; ++a) { m_run[a] = -INFINITY; l_run[a] = 0.f;
#pragma unroll
    for (int b = 0; b < 2; ++b)
#pragma unroll
      for (int i = 0; i < 16; ++i) o[a][b][i] = 0.f; }
  float lf = 0.f, lb = 0.f;
  if (MODE == 2) { lf = log2f(1.0f - exp2f(-5.0f - (float)head)); lb = log2f(1.0f - exp2f(-5.0f - (float)(3 - head))); }
  float* dtab = (float*)(lds + 40960);
  if (MODE == 2 && tid < 64) { const int d_ = tid >> 5, kf_ = (tid >> 4) & 1, i_ = tid & 15;
    const float cc_ = (float)(32 * kf_ + (i_ & 3) + 4 * ((i_ >> 2) & 1) + 16 * ((i_ >> 3) & 1));
    dtab[tid] = d_ == 0 ? exp2f(-lf * cc_) : exp2f(lb * cc_); }
  A3_GLOAD(0); A3_LSTORE(0); __syncthreads();
#pragma unroll 1
  for (int t = 0; t < nt; ++t) {
    if (t + 1 < nt) A3_GLOAD(t + 1);
    const char* ks = lds + (t & 1) * 18432; const char* vs = ks + 9216;
    f32x16 st[2][2];
#pragma unroll
    for (int kf = 0; kf < 2; ++kf) {
#pragma unroll
      for (int qi = 0; qi < 2; ++qi)
#pragma unroll
        for (int i = 0; i < 16; ++i) st[qi][kf][i] = 0.f;
#pragma unroll
      for (int s = 0; s < 4; ++s) { const bf16x8 kfr = *(const bf16x8*)(ks + (kf * 32 + prow) * PITCH + s * 32 + h * 16);
#pragma unroll
        for (int qi = 0; qi < 2; ++qi) st[qi][kf] = MFMA32(kfr, qf[qi][s], st[qi][kf]); }
    }
    __builtin_amdgcn_sched_barrier(0);
#pragma unroll
    for (int qi = 0; qi < 2; ++qi) {
      bf16x8 pf[4];
      if (MODE == 2) {
        const int k0 = t * 64, qb = qw0 + qi * 32;
        const float dbase = (float)(qb + l31 - k0 - 8 * h);
        if (k0 + 63 < qb) {
          const float qfac = fexp2(lf * dbase);
#pragma unroll
          for (int kf = 0; kf < 2; ++kf)
#pragma unroll
            for (int g = 0; g < 4; ++g) { const f32x4 kv = *(const f32x4*)(dtab + kf * 16 + 4 * g);
#pragma unroll
              for (int e = 0; e < 4; ++e) st[qi][kf][4 * g + e] *= kv[e] * qfac; }
        } else if (k0 > qb + 31) {
          const float qfac = fexp2(-lb * dbase);
#pragma unroll
          for (int kf = 0; kf < 2; ++kf)
#pragma unroll
            for (int g = 0; g < 4; ++g) { const f32x4 kv = *(const f32x4*)(dtab + 32 + kf * 16 + 4 * g);
#pragma unroll
              for (int e = 0; e < 4; ++e) st[qi][kf][4 * g + e] *= kv[e] * qfac; }
        } else {
#pragma unroll
          for (int kf = 0; kf < 2; ++kf)
#pragma unroll
            for (int i = 0; i < 16; ++i) { const float cc = (float)(32 * kf + (i & 3) + 4 * ((i >> 2) & 1) + 16 * ((i >> 3) & 1)); const float d = dbase - cc;
              float dd = fexp2(fminf(lf * d, -lb * d)); if (d == 0.f) dd = 2.0f; st[qi][kf][i] *= dd; }
        }
      } else {
        float mx = st[qi][0][0];
#pragma unroll
        for (int kf = 0; kf < 2; ++kf)
#pragma unroll
          for (int i = 0; i < 16; ++i) mx = fmaxf(mx, st[qi][kf][i]);
        mx = fmaxf(mx, __shfl_xor(mx, 32));
        const float mn = fmaxf(m_run[qi], mx); const float alpha = fexp2(m_run[qi] - mn); m_run[qi] = mn;
        float ps = 0.f;
#pragma unroll
        for (int kf = 0; kf < 2; ++kf)
#pragma unroll
          for (int i = 0; i < 16; ++i) { st[qi][kf][i] = fexp2(st[qi][kf][i] - mn); ps += st[qi][kf][i]; }
        l_run[qi] = l_run[qi] * alpha + ps;
#pragma unroll
        for (int df = 0; df < 2; ++df) o[qi][df] *= alpha;
      }
#pragma unroll
      for (int kf = 0; kf < 2; ++kf)
#pragma unroll
        for (int s2 = 0; s2 < 2; ++s2) { u32x4 u; u.x = pk(st[qi][kf][8 * s2], st[qi][kf][8 * s2 + 1]); u.y = pk(st[qi][kf][8 * s2 + 2], st[qi][kf][8 * s2 + 3]);
          u.z = pk(st[qi][kf][8 * s2 + 4], st[qi][kf][8 * s2 + 5]); u.w = pk(st[qi][kf][8 * s2 + 6], st[qi][kf][8 * s2 + 7]); pf[kf * 2 + s2] = __builtin_bit_cast(bf16x8, u); }
#pragma unroll
      for (int df = 0; df < 2; ++df)
#pragma unroll
        for (int ksx = 0; ksx < 4; ++ksx) { const bf16x8 vfr = *(const bf16x8*)(vs + (df * 32 + l31) * PITCH + ksx * 32 + h * 16); o[qi][df] = MFMA32(vfr, pf[ksx], o[qi][df]); }
      __builtin_amdgcn_sched_barrier(0);
    }
    __builtin_amdgcn_sched_barrier(0);
    if (t + 1 < nt) A3_LSTORE((t + 1) & 1);
    __syncthreads();
  }
#undef A3_GLOAD
#undef A3_LSTORE
#pragma unroll
  for (int qi = 0; qi < 2; ++qi) {
    const int qrow = row0 + qw0 + qi * 32 + l31;
    bf16_t* zq = p.z + (size_t)qrow * NIN + QC;
    f32x16 r[2];
    if (MODE == 0) {
      const float l = l_run[qi] + __shfl_xor(l_run[qi], 32); const float inv = 1.0f / l;
#pragma unroll
      for (int df = 0; df < 2; ++df) r[df] = o[qi][df] * inv;
    } else {
      float ss = 0.f;
#pragma unroll
      for (int df = 0; df < 2; ++df)
#pragma unroll
        for (int i = 0; i < 16; ++i) ss += o[qi][df][i] * o[qi][df][i];
      ss += __shfl_xor(ss, 32);
      const float rs = rsqrtf(ss * (1.0f / 64.0f) + EPS);
      const float* gg = p.in[I_CGN] + layer * 256 + head * 64;
      const bf16_t* zg = p.z + (size_t)qrow * NIN + C_G + head * 64;
#pragma unroll
      for (int df = 0; df < 2; ++df)
#pragma unroll
        for (int g = 0; g < 4; ++g) { const u32x2 gw = *(const u32x2*)(zg + df * 32 + 8 * g + 4 * h);
          const float gv[4] = {bflo(gw.x), bfhi(gw.x), bflo(gw.y), bfhi(gw.y)};
#pragma unroll
          for (int e = 0; e < 4; ++e) { const float x = gv[e]; r[df][4 * g + e] = o[qi][df][4 * g + e] * rs * gg[df * 32 + 8 * g + 4 * h + e] * (x / (1.0f + __expf(-x))); } }
    }
#pragma unroll
    for (int df = 0; df < 2; ++df)
#pragma unroll
      for (int g = 0; g < 4; ++g) { u32x2 v; v.x = pk(r[df][4 * g], r[df][4 * g + 1]); v.y = pk(r[df][4 * g + 2], r[df][4 * g + 3]); *(u32x2*)(zq + df * 32 + 8 * g + 4 * h) = v; }
  }
}

DI void ctr_barrier(unsigned* cnt) {
  asm volatile("s_waitcnt vmcnt(0) lgkmcnt(0)" ::: "memory");
  __syncthreads();
  if (threadIdx.x == 0) {
    __builtin_amdgcn_fence(__ATOMIC_RELEASE, "agent");
    asm volatile("s_waitcnt vmcnt(0)" ::: "memory");
    const unsigned G = gridDim.x;
    const unsigned old = __hip_atomic_fetch_add(cnt, 1u, __ATOMIC_RELAXED, __HIP_MEMORY_SCOPE_AGENT);
    const unsigned gen = old / G + 1u;
    if (old + 1u == gen * G) __hip_atomic_store(cnt + 64, gen, __ATOMIC_RELAXED, __HIP_MEMORY_SCOPE_AGENT);
    else while (__hip_atomic_load(cnt + 64, __ATOMIC_RELAXED, __HIP_MEMORY_SCOPE_AGENT) < gen) __builtin_amdgcn_s_sleep(1);
    __builtin_amdgcn_fence(__ATOMIC_ACQUIRE, "agent");
    asm volatile("s_waitcnt vmcnt(0)" ::: "memory");
  }
  __syncthreads();
}

DI int next_item(int* ctr, int* sh) {
  __syncthreads();
  if (threadIdx.x == 0) *sh = atomicAdd(ctr, 1);
  __syncthreads();
  return *sh;
}
constexpr int XQ_N = 416;
DI int next_item_x(int* ctr8, int* sh) {
  __syncthreads();
  if (threadIdx.x == 0) {
    int r = -1;
    const int x0 = blockIdx.x & 7;
    for (int k = 0; k < 8; ++k) { const int x = (x0 + k) & 7; const int i = atomicAdd(ctr8 + x, 1); if (i < XQ_N) { r = (x << 16) | i; break; } }
    *sh = r;
  }
  __syncthreads();
  return *sh;
}

__global__ void __launch_bounds__(256, 2) fwd(Params p) {
  extern __shared__ __attribute__((aligned(16))) char lds[];
  __shared__ int s_item;
  cg::grid_group grid = cg::this_grid();
  const int bid = blockIdx.x, nb = gridDim.x, tid = threadIdx.x, lane = tid & 63, w = tid >> 6;
  if (bid == 0) p.ctr[tid] = 0;
  for (int i = bid * 256 + tid; i < 4096 * 32; i += nb * 256) { const int t = i >> 5, j = i & 31; const float inv = powf(10000.0f, -(float)(2 * j) / 64.0f); float sn, cs; sincosf((float)t * inv, &sn, &cs); p.tabC[i] = (f32x2){cs, sn}; }
  for (int i = bid * 256 + tid; i < 4096 * 4; i += nb * 256) { const int t = i >> 2, j = i & 3; const float inv = powf(500000.0f, -(float)(2 * j) / 8.0f); float sn, cs; sincosf((float)t * inv, &sn, &cs); p.tabB[i] = (f32x2){cs, sn}; }
  for (int i = bid * 256 + tid; i < 64 * 16; i += nb * 256) { const int t = i >> 4, j = i & 15; const float inv = powf(10000.0f, -(float)(2 * j) / 32.0f); float sn, cs; sincosf((float)t * inv, &sn, &cs); p.tabA[i] = (f32x2){cs, sn}; }
  for (int l = 0; l < 2; ++l) {
    for (int i = bid * 256 + tid; i < (NINP - NIN) * 1024; i += nb * 256) p.wtin[(size_t)l * NINP * 1024 + (size_t)NIN * 1024 + i] = 0;
    for (int tl = bid; tl < 16 * 53; tl += nb) conv_T(lds, p.in[I_WIN] + (size_t)l * 1024 * NIN, 1024, NIN, p.wtin + (size_t)l * NINP * 1024, 0, tl);
    for (int tl = bid; tl < 16 * 16; tl += nb) conv_T(lds, p.in[I_WOUT] + (size_t)l * 1024 * 1024, 1024, 1024, p.wtout + (size_t)l * 1024 * 1024, 0, tl);
  }
  bf16_t* hb = p.pl;
  for (int row = bid * 4 + opaque(w); row < MT; row += nb * 8) {
    const int rb = row + nb * 4;
    const float* xin = row < M0 ? p.in[I_XP] + (size_t)row * 1024 : p.in[I_XS] + (size_t)(row - M0) * 1024;
    if (rb < MT) { const float* xinb = rb < M0 ? p.in[I_XP] + (size_t)rb * 1024 : p.in[I_XS] + (size_t)(rb - M0) * 1024;
      row_phase2(xin, xinb, nullptr, nullptr, nullptr, nullptr, nullptr, p.in[I_NMPRE], hb + (size_t)row * 1024, hb + (size_t)rb * 1024, lane); }
    else row_phase(xin, nullptr, nullptr, nullptr, p.in[I_NMPRE], hb + (size_t)row * 1024, lane);
  }
  grid.sync();
  for (int l = 0; l < 2; ++l) {
    { ASrc A; A.b0 = hb; A.b1 = hb; A.b2 = hb; A.b3 = hb; A.s0 = A.s1 = A.s2 = A.s3 = 1024; A.shift = 12;
      EpiIn e; e.z = p.z; e.lds = lds; e.qg = p.in[I_AQG] + l * 64; e.kg = p.in[I_AKG] + l * 64; e.tabA = p.tabA; e.tabB = p.tabB; e.tabC = p.tabC;
      gemm_phase2(lds, A, p.wtin + (size_t)l * NINP * 1024, 1024, 14, e); }
    ctr_barrier((unsigned*)p.ctr + 96);
    for (int it = bid; it < MT / DTOK; it += nb) dprep_item(lds, p, l, it);
    ctr_barrier((unsigned*)p.ctr + 96);
    for (;;) {
      const int it = next_item_x(p.ctr + l * 16, &s_item);
      if (it < 0) break;
      const int x = it >> 16; int i = it & 0xffff;
      if (i < 32) { const int j = i & 15; rwkv_item(lds, p, i < 16 ? x : 8 + x, (j >> 2) & 3, (j >> 1) & 1, j & 1); }
      else { i -= 32;
        if (i < 128) attn_item<1>(lds, p, l, x, i >> 5, i & 31);
        else if (i < 192) { i -= 128; attn3_item<2>(lds, p, l, x, i >> 4, i & 15); }
        else if (i < 256) { i -= 192; attn3_item<0>(lds, p, l, x, i >> 4, i & 15); }
        else if (i < 320) { i -= 256; attn_item<1>(lds, p, l, 8 + x, i >> 4, i & 15); }
        else if (i < 352) { i -= 320; attn3_item<2>(lds, p, l, 8 + x, i >> 3, i & 7); }
        else { i -= 352; attn3_item<0>(lds, p, l, 8 + x, i >> 3, i & 7); }
      }
    }
    ctr_barrier((unsigned*)p.ctr + 96);
    bf16_t* wtgu = p.pl + 5 * PLANE; bf16_t* wtd = wtgu + (size_t)2 * DFF * 1024;
    for (int it = bid; it < MT / DTOK + 3 * 704; it += nb) {
      if (it < MT / DTOK) dpost_item(lds, p, l, it);
      else { const int j = it - MT / DTOK;
        if (j < 704) conv_T(lds, p.in[I_FG] + (size_t)l * 1024 * DFF, 1024, DFF, wtgu, 1, j);
        else if (j < 1408) conv_T(lds, p.in[I_FU] + (size_t)l * 1024 * DFF, 1024, DFF, wtgu, 2, j - 704);
        else conv_T(lds, p.in[I_FD] + (size_t)l * DFF * 1024, DFF, 1024, wtd, 0, j - 1408); }
    }
    ctr_barrier((unsigned*)p.ctr + 96);
    { ASrc A; A.b0 = p.z + A_Q; A.b1 = p.z + B_Q; A.b2 = p.z + C_Q; A.b3 = p.pl + 4 * PLANE; A.s0 = A.s1 = A.s2 = NIN; A.s3 = 256; A.shift = 8;
      EpiStore e; e.out = hb; e.ldc = 1024; e.nmax = 1024; e.lds = lds;
      gemm_phase2(lds, A, p.wtout + (size_t)l * 1024 * 1024, 1024, 4, e); }
    ctr_barrier((unsigned*)p.ctr + 96);
    for (int row = bid * 4 + opaque(w); row < MT; row += nb * 8) { const int rb = row + nb * 4;
      const float* xa = l == 0 ? (row < M0 ? p.in[I_XP] + (size_t)row * 1024 : p.in[I_XS] + (size_t)(row - M0) * 1024) : p.out + (size_t)row * 1024;
      if (rb < MT) { const float* xb = l == 0 ? (rb < M0 ? p.in[I_XP] + (size_t)rb * 1024 : p.in[I_XS] + (size_t)(rb - M0) * 1024) : p.out + (size_t)rb * 1024;
        row_phase2(xa, xb, p.out + (size_t)row * 1024, p.out + (size_t)rb * 1024, hb + (size_t)row * 1024, hb + (size_t)rb * 1024,
                   p.in[I_NMPOST] + l * 1024, p.in[I_NFPRE] + l * 1024, hb + (size_t)row * 1024, hb + (size_t)rb * 1024, lane); }
      else row_phase(xa, p.out + (size_t)row * 1024, hb + (size_t)row * 1024, p.in[I_NMPOST] + l * 1024, p.in[I_NFPRE] + l * 1024, hb + (size_t)row * 1024, lane); }
    ctr_barrier((unsigned*)p.ctr + 96);
    { ASrc A; A.b0 = hb; A.b1 = hb; A.b2 = hb; A.b3 = hb; A.s0 = A.s1 = A.s2 = A.s3 = 1024; A.shift = 12;
      EpiSwiGLU e; e.out = p.z; e.lds = lds;
      gemm_phase2(lds, A, wtgu, 1024, 22, e); }
    ctr_barrier((unsigned*)p.ctr + 96);
    { ASrc A; A.b0 = p.z; A.b1 = p.z; A.b2 = p.z; A.b3 = p.z; A.s0 = A.s1 = A.s2 = A.s3 = DFF; A.shift = 12;
      EpiStore e; e.out = hb; e.ldc = 1024; e.nmax = 1024; e.lds = lds;
      gemm_phase2(lds, A, wtd, DFF, 4, e); }
    ctr_barrier((unsigned*)p.ctr + 96);
    for (int row = bid * 4 + opaque(w); row < MT; row += nb * 8) { const int rb = row + nb * 4; const float* gp2 = l == 0 ? p.in[I_NMPRE] + 1024 : nullptr;
      if (rb < MT) row_phase2(p.out + (size_t)row * 1024, p.out + (size_t)rb * 1024, p.out + (size_t)row * 1024, p.out + (size_t)rb * 1024, hb + (size_t)row * 1024, hb + (size_t)rb * 1024,
                              p.in[I_NFPOST] + l * 1024, gp2, hb + (size_t)row * 1024, hb + (size_t)rb * 1024, lane);
      else row_phase(p.out + (size_t)row * 1024, p.out + (size_t)row * 1024, hb + (size_t)row * 1024, p.in[I_NFPOST] + l * 1024, gp2, hb + (size_t)row * 1024, lane); }
    if (l == 0) ctr_barrier((unsigned*)p.ctr + 96);
  }
}

extern "C" void kernel_launch(void* const* d_in, const int* in_sizes, int n_in, void* d_out, int out_size,
                              void* d_ws, size_t ws_size, hipStream_t stream) {
  static int grid_blocks = 0;
  if (!grid_blocks) {
    int dev = 0, cus = 0, per_cu = 0;
    hipGetDevice(&dev);
    hipDeviceGetAttribute(&cus, hipDeviceAttributeMultiprocessorCount, dev);
    hipFuncSetAttribute((const void*)fwd, hipFuncAttributeMaxDynamicSharedMemorySize, LDS_BYTES);
    hipOccupancyMaxActiveBlocksPerMultiprocessor(&per_cu, fwd, 256, LDS_BYTES);
    if (per_cu > 2) per_cu = 2;
    if (per_cu < 1) per_cu = 1;
    grid_blocks = cus * per_cu;
  }
  Params p{};
  for (int i = 0; i < 28; ++i) p.in[i] = (const float*)d_in[i];
  p.out = (float*)d_out;
  char* ws = (char*)d_ws;
  size_t off = 0;
  p.z = (bf16_t*)(ws + off); off += (size_t)MT * NIN * 2;
  p.pl = (bf16_t*)(ws + off); off += 7 * PLANE * 2;
  p.wtin = (bf16_t*)(ws + off); off += (size_t)2 * NINP * 1024 * 2;
  p.wtout = (bf16_t*)(ws + off); off += (size_t)2 * 1024 * 1024 * 2;
  p.tabC = (f32x2*)(ws + off); off += (size_t)4096 * 32 * 8;
  p.tabB = (f32x2*)(ws + off); off += (size_t)4096 * 4 * 8;
  p.tabA = (f32x2*)(ws + off); off += (size_t)64 * 16 * 8;
  p.ctr = (int*)(ws + off); off += 1024;
  if (off > ws_size) fprintf(stderr, "workspace too small: need %zu have %zu\n", off, ws_size);
  void* args[] = {&p};
  hipError_t e = hipLaunchCooperativeKernel((void*)fwd, dim3(grid_blocks), dim3(256), args, LDS_BYTES, stream);
  if (e != hipSuccess) fprintf(stderr, "coop launch failed: %s (grid %d)\n", hipGetErrorString(e), grid_blocks);
}
```

```cpp
#include <hip/hip_runtime.h>
#include <hip/hip_cooperative_groups.h>
#include <cstdio>
#include <cstdint>
namespace cg = cooperative_groups;

#define DI __device__ __forceinline__
typedef unsigned short bf16_t;
typedef short bf16x8 __attribute__((ext_vector_type(8)));
typedef float f32x2 __attribute__((ext_vector_type(2)));
typedef float f32x4 __attribute__((ext_vector_type(4)));
typedef float f32x16 __attribute__((ext_vector_type(16)));
typedef unsigned u32x2 __attribute__((ext_vector_type(2)));
typedef unsigned u32x4 __attribute__((ext_vector_type(4)));
typedef __bf16 bf16x2_t __attribute__((ext_vector_type(2)));

constexpr int M0 = 32768, MT = 49152, DM = 1024, NIN = 3392, NINP = 3584, DFF = 2816;
constexpr int A_Q = 0, A_K = 256, A_V = 384, B_Q = 512, B_K = 768, B_V = 1024, C_Q = 1280, C_K = 1536, C_V = 1792, C_G = 2048, D_0 = 2304;
constexpr int PITCH = 144;
constexpr size_t PLANE = (size_t)MT * 256;
constexpr int LDS_BYTES = 73728;
constexpr float LOG2E = 1.4426950408889634f;
constexpr float EPS = 1e-6f;

enum { I_XP = 0, I_XS, I_NMPRE, I_NMPOST, I_NFPRE, I_NFPOST, I_WIN, I_WOUT, I_AQG, I_AKG, I_BLAM, I_BSUB, I_CGN, I_DMUP, I_DMUN, I_DW0, I_DWUP,
       I_DA0, I_DAUP, I_DGUP, I_DKK, I_DKA, I_DRK, I_DGNW, I_DGNB, I_FG, I_FU, I_FD };

struct Params {
  const float* in[28];
  float* out;
  bf16_t* z;
  bf16_t* pl;
  bf16_t* wtin;
  bf16_t* wtout;
  f32x2* tabC;
  f32x2* tabB;
  f32x2* tabA;
  int* ctr;
};

DI int opaque(int x) { asm volatile("" : "+v"(x)); return x; }
DI int opaque_s(int x) { asm volatile("" : "+s"(x)); return x; }
DI float bf2f(bf16_t v) { return __uint_as_float(((unsigned)v) << 16); }
DI float bflo(unsigned w) { return __uint_as_float(w << 16); }
DI float bfhi(unsigned w) { return __uint_as_float(w & 0xffff0000u); }
DI unsigned pk(float lo, float hi) { f32x2 v = {lo, hi}; bf16x2_t b = __builtin_convertvector(v, bf16x2_t); return __builtin_bit_cast(unsigned, b); }
DI bf16_t f2bf(float x) { return (bf16_t)(pk(x, 0.f) & 0xffffu); }
DI float dppf(float x, const int ctrl) { return x; }
#define DPPF(x, ctrl) __int_as_float(__builtin_amdgcn_update_dpp(0, __float_as_int(x), (ctrl), 0xF, 0xF, true))
DI float wave_sum(float v) {
  v += DPPF(v, 0xB1);
  v += DPPF(v, 0x4E);
  v += DPPF(v, 0x141);
  v += DPPF(v, 0x140);
  const int vi = __float_as_int(v);
  return (__int_as_float(__builtin_amdgcn_readlane(vi, 0)) + __int_as_float(__builtin_amdgcn_readlane(vi, 16))) +
         (__int_as_float(__builtin_amdgcn_readlane(vi, 32)) + __int_as_float(__builtin_amdgcn_readlane(vi, 48)));
}
DI float dpp_xor1(float x) { return __int_as_float(__builtin_amdgcn_update_dpp(0, __float_as_int(x), 0xB1, 0xF, 0xF, true)); }
DI float dpp_xor2(float x) { return __int_as_float(__builtin_amdgcn_update_dpp(0, __float_as_int(x), 0x4E, 0xF, 0xF, true)); }
DI float dpp_hmir(float x) { return __int_as_float(__builtin_amdgcn_update_dpp(0, __float_as_int(x), 0x141, 0xF, 0xF, true)); }
DI float red8(float x) { x += dpp_xor1(x); x += dpp_xor2(x); x += dpp_hmir(x); return x; }
DI float fexp2(float x) { return __builtin_amdgcn_exp2f(x); }
DI void seq_info(int s, int& row0, int& T) { if (s < 8) { row0 = s * 4096; T = 4096; } else { row0 = M0 + (s - 8) * 2048; T = 2048; } }
DI void row_info(int r, int& t, int& T) { if (r < M0) { t = r & 4095; T = 4096; } else { t = (r - M0) & 2047; T = 2048; } }
#define MFMA32(a, b, c) __builtin_amdgcn_mfma_f32_32x32x16_bf16((a), (b), (c), 0, 0, 0)

DI void conv_T(char* lds, const float* __restrict__ W, int K, int N, bf16_t* __restrict__ Wt, int mode, int tile) {
  float* t = (float*)lds;
  const int tid0 = opaque(threadIdx.x);
  const int ntn = N >> 6, kt = tile / ntn, nt = tile - kt * ntn, k0 = kt << 6, n0 = nt << 6;
  float wv[16];
#pragma unroll
  for (int i = 0; i < 16; ++i) { const int idx = tid0 + 256 * i, k = idx >> 6, n = idx & 63; wv[i] = W[(size_t)(k0 + k) * N + n0 + n]; }
#pragma unroll
  for (int i = 0; i < 16; ++i) { const int idx = tid0 + 256 * i, k = idx >> 6, n = idx & 63; t[k * 65 + n] = wv[i]; }
  __syncthreads();
#pragma unroll 4
  for (int i = 0; i < 8; ++i) {
    const int idx = tid0 + 256 * i, n = idx >> 5, k = (idx & 31) * 2, j = n0 + n;
    const int rho = (mode == 0) ? j : ((j >> 6) * 128 + ((j >> 5) & 1) * 64 + (mode - 1) * 32 + (j & 31));
    *(unsigned*)(Wt + (size_t)rho * K + k0 + k) = pk(t[k * 65 + n], t[(k + 1) * 65 + n]);
  }
  __syncthreads();
}

DI void row_phase(const float* __restrict__ xin, float* __restrict__ xout, const bf16_t* addsrc, const float* __restrict__ gpost,
                  const float* __restrict__ gpre, bf16_t* hout, int lane_in) {
  const int lane = opaque(lane_in);
  f32x4 x[4];
#pragma unroll
  for (int i = 0; i < 4; ++i) x[i] = *(const f32x4*)(xin + i * 256 + lane * 4);
  if (addsrc) {
    f32x4 m[4]; float ss = 0.f;
#pragma unroll
    for (int i = 0; i < 4; ++i) { const u32x2 w = *(const u32x2*)(addsrc + i * 256 + lane * 4); m[i] = (f32x4){bflo(w.x), bfhi(w.x), bflo(w.y), bfhi(w.y)};
      ss += m[i][0] * m[i][0] + m[i][1] * m[i][1] + m[i][2] * m[i][2] + m[i][3] * m[i][3]; }
    ss = wave_sum(ss); const float rs = rsqrtf(ss * (1.0f / 1024.0f) + EPS);
#pragma unroll
    for (int i = 0; i < 4; ++i) { const f32x4 g = *(const f32x4*)(gpost + i * 256 + lane * 4); x[i] += m[i] * rs * g; }
  }
#pragma unroll
  for (int i = 0; i < 4; ++i) if (xout) *(f32x4*)(xout + i * 256 + lane * 4) = x[i];
  if (gpre) {
    float ss = 0.f;
#pragma unroll
    for (int i = 0; i < 4; ++i) ss += x[i][0] * x[i][0] + x[i][1] * x[i][1] + x[i][2] * x[i][2] + x[i][3] * x[i][3];
    ss = wave_sum(ss); const float rs = rsqrtf(ss * (1.0f / 1024.0f) + EPS);
#pragma unroll
    for (int i = 0; i < 4; ++i) { const f32x4 g = *(const f32x4*)(gpre + i * 256 + lane * 4); const f32x4 hv = x[i] * rs * g;
      u32x2 w; w.x = pk(hv[0], hv[1]); w.y = pk(hv[2], hv[3]); *(u32x2*)(hout + i * 256 + lane * 4) = w; }
  }
}

DI void row_phase2(const float* __restrict__ xinA, const float* __restrict__ xinB, float* __restrict__ xoutA, float* __restrict__ xoutB, const bf16_t* addA, const bf16_t* addB,
                   const float* __restrict__ gpost, const float* __restrict__ gpre, bf16_t* houtA, bf16_t* houtB, int lane_in) {
  const int lane = opaque(lane_in);
  f32x4 x[2][4]; u32x2 aw[2][4];
#pragma unroll
  for (int i = 0; i < 4; ++i) { x[0][i] = __builtin_nontemporal_load((const f32x4*)(xinA + i * 256 + lane * 4)); x[1][i] = __builtin_nontemporal_load((const f32x4*)(xinB + i * 256 + lane * 4)); }
  if (addA) {
#pragma unroll
    for (int i = 0; i < 4; ++i) { aw[0][i] = *(const u32x2*)(addA + i * 256 + lane * 4); aw[1][i] = *(const u32x2*)(addB + i * 256 + lane * 4); }
#pragma unroll
    for (int r = 0; r < 2; ++r) {
      f32x4 m[4]; float ss = 0.f;
#pragma unroll
      for (int i = 0; i < 4; ++i) { const u32x2 w = aw[r][i]; m[i] = (f32x4){bflo(w.x), bfhi(w.x), bflo(w.y), bfhi(w.y)};
        ss += m[i][0] * m[i][0] + m[i][1] * m[i][1] + m[i][2] * m[i][2] + m[i][3] * m[i][3]; }
      ss = wave_sum(ss); const float rs = rsqrtf(ss * (1.0f / 1024.0f) + EPS);
#pragma unroll
      for (int i = 0; i < 4; ++i) { const f32x4 g = *(const f32x4*)(gpost + i * 256 + lane * 4); x[r][i] += m[i] * rs * g; }
    }
  }
#pragma unroll
  for (int i = 0; i < 4; ++i) if (xoutA) { __builtin_nontemporal_store(x[0][i], (f32x4*)(xoutA + i * 256 + lane * 4)); __builtin_nontemporal_store(x[1][i], (f32x4*)(xoutB + i * 256 + lane * 4)); }
  if (gpre) {
#pragma unroll
    for (int r = 0; r < 2; ++r) {
      float ss = 0.f;
#pragma unroll
      for (int i = 0; i < 4; ++i) ss += x[r][i][0] * x[r][i][0] + x[r][i][1] * x[r][i][1] + x[r][i][2] * x[r][i][2] + x[r][i][3] * x[r][i][3];
      ss = wave_sum(ss); const float rs = rsqrtf(ss * (1.0f / 1024.0f) + EPS);
      bf16_t* ho = r == 0 ? houtA : houtB;
#pragma unroll
      for (int i = 0; i < 4; ++i) { const f32x4 g = *(const f32x4*)(gpre + i * 256 + lane * 4); const f32x4 hv = x[r][i] * rs * g;
        u32x2 w; w.x = pk(hv[0], hv[1]); w.y = pk(hv[2], hv[3]); *(u32x2*)(ho + i * 256 + lane * 4) = w; }
    }
  }
}

struct ASrc { const bf16_t* b0; const bf16_t* b1; const bf16_t* b2; const bf16_t* b3; int s0, s1, s2, s3; int shift; };

DI void store_piece64(char* img, const f32x16 (&acc)[2][2], bf16_t* out, size_t ld, int row0, int col0, int l31, int h) {
#pragma unroll
  for (int mf = 0; mf < 2; ++mf)
#pragma unroll
    for (int nf = 0; nf < 2; ++nf)
#pragma unroll
      for (int g = 0; g < 4; ++g) { u32x2 v; v.x = pk(acc[mf][nf][4 * g], acc[mf][nf][4 * g + 1]); v.y = pk(acc[mf][nf][4 * g + 2], acc[mf][nf][4 * g + 3]);
        *(u32x2*)(img + (mf * 32 + l31) * PITCH + (nf * 32 + 8 * g + 4 * h) * 2) = v; }
  const int ln = l31 + 32 * h;
#pragma unroll 2
  for (int i = 0; i < 8; ++i) { const int q = ln + 64 * i, r = q >> 3, c8 = q & 7;
    const u32x4 v = *(const u32x4*)(img + r * PITCH + c8 * 16); *(u32x4*)(out + (size_t)(row0 + r) * ld + col0 + c8 * 8) = v; }
}
DI void store_piece32(char* img, const f32x16 (&a0), const f32x16 (&a1), bf16_t* out, size_t ld, int row0, int col0, int l31, int h) {
#pragma unroll
  for (int g = 0; g < 4; ++g) { u32x2 v; v.x = pk(a0[4 * g], a0[4 * g + 1]); v.y = pk(a0[4 * g + 2], a0[4 * g + 3]); *(u32x2*)(img + l31 * PITCH + (8 * g + 4 * h) * 2) = v;
    u32x2 u; u.x = pk(a1[4 * g], a1[4 * g + 1]); u.y = pk(a1[4 * g + 2], a1[4 * g + 3]); *(u32x2*)(img + l31 * PITCH + (32 + 8 * g + 4 * h) * 2) = u; }
  const int ln = l31 + 32 * h;
#pragma unroll
  for (int i = 0; i < 4; ++i) { const int q = ln + 64 * i, r = q >> 3, c8 = q & 7;
    const u32x4 v = *(const u32x4*)(img + r * PITCH + c8 * 16); *(u32x4*)(out + (size_t)(row0 + r) * ld + col0 + c8 * 8) = v; }
}
struct EpiStore { bf16_t* out; int ldc; int nmax; char* lds;
  DI void operator()(const f32x16 (&acc)[2][2], int mb, int nb, int n0, int wc, int l31, int h) const {
    if (nb >= nmax) return;
    store_piece64(lds + (threadIdx.x >> 6) * 9216, acc, out, (size_t)ldc, mb, nb, l31, h);
  } };
struct EpiSwiGLU { bf16_t* out; char* lds;
  DI void operator()(const f32x16 (&acc)[2][2], int mb, int nb, int n0, int wc, int l31, int h) const {
    const int hc = (nb >> 6) * 32;
    char* img = lds + (threadIdx.x >> 6) * 9216;
#pragma unroll
    for (int mf = 0; mf < 2; ++mf)
#pragma unroll
      for (int g = 0; g < 4; ++g) { float r[4];
#pragma unroll
        for (int e = 0; e < 4; ++e) { const float gt = acc[mf][0][4 * g + e], up = acc[mf][1][4 * g + e]; r[e] = gt / (1.0f + __expf(-gt)) * up; }
        u32x2 v; v.x = pk(r[0], r[1]); v.y = pk(r[2], r[3]); *(u32x2*)(img + (mf * 32 + l31) * PITCH + (8 * g + 4 * h) * 2) = v; }
    const int ln = l31 + 32 * h;
#pragma unroll
    for (int i = 0; i < 4; ++i) { const int q = ln + 64 * i, r = q >> 2, c4 = q & 3;
      const u32x4 v = *(const u32x4*)(img + r * PITCH + c4 * 16); *(u32x4*)(out + (size_t)(mb + r) * DFF + hc + c4 * 8) = v; }
  } };

struct EpiIn { bf16_t* z; char* lds; const float* qg; const float* kg; const f32x2* tabA; const f32x2* tabB; const f32x2* tabC;
  DI void operator()(f32x16 (&acc)[2][2], int mb, int nb, int n0, int wc, int l31, int h) const {
    if (nb >= NIN) return;
    const bool isv = (nb >= A_V && nb < B_Q) || (nb >= B_V && nb < C_Q) || (nb >= C_V && nb < C_G);
    if (isv) {
      const int wv = (threadIdx.x >> 6);
      bf16_t* img = (bf16_t*)(lds + 32768 + wv * 9216);
#pragma unroll
      for (int mf = 0; mf < 2; ++mf)
#pragma unroll
        for (int nf = 0; nf < 2; ++nf)
#pragma unroll
          for (int i = 0; i < 16; ++i) { const int d = nf * 32 + (i & 3) + 8 * (i >> 2) + 4 * h; img[d * 72 + mf * 32 + l31] = f2bf(acc[mf][nf][i]); }
      __builtin_amdgcn_s_waitcnt(0xc07f);
      const int ln = l31 + 32 * h;
#pragma unroll
      for (int i = 0; i < 8; ++i) { const int q = ln + 64 * i, d = q >> 3, c8 = q & 7;
        const u32x4 v = *(const u32x4*)(img + d * 72 + c8 * 8); *(u32x4*)(z + (size_t)(mb + d) * NIN + nb + c8 * 8) = v; }
      return;
    }
#pragma unroll
    for (int mf = 0; mf < 2; ++mf) {
      const int row = mb + mf * 32 + l31; int t, T; row_info(row, t, T);
      if (nb < A_V) {
        const bool isq = nb < A_K; const float* gn = isq ? qg : kg;
        float ss = 0.f;
#pragma unroll
        for (int nf = 0; nf < 2; ++nf)
#pragma unroll
          for (int i = 0; i < 16; ++i) ss += acc[mf][nf][i] * acc[mf][nf][i];
        ss += __shfl_xor(ss, 32);
        const float rs = rsqrtf(ss * (1.0f / 64.0f) + EPS) * (isq ? 0.125f * LOG2E : 1.0f);
#pragma unroll
        for (int nf = 0; nf < 2; ++nf) {
          const int pos = nf == 0 ? (t >> 6) : (t & 63);
#pragma unroll
          for (int g = 0; g < 4; ++g)
#pragma unroll
            for (int e = 0; e < 4; ++e) acc[mf][nf][4 * g + e] *= rs * gn[nf * 32 + 8 * g + 4 * h + e];
#pragma unroll
          for (int g = 0; g < 2; ++g)
#pragma unroll
            for (int e = 0; e < 4; ++e) { const f32x2 cs = tabA[pos * 16 + 8 * g + 4 * h + e];
              const float x1 = acc[mf][nf][4 * g + e], x2 = acc[mf][nf][4 * (g + 2) + e];
              acc[mf][nf][4 * g + e] = x1 * cs.x - x2 * cs.y; acc[mf][nf][4 * (g + 2) + e] = x2 * cs.x + x1 * cs.y; }
        }
      } else if (nb >= B_Q && nb < B_V) {
        const bool isq = nb < B_K;
#pragma unroll
        for (int nf = 0; nf < 2; ++nf) {
#pragma unroll
          for (int e = 0; e < 4; ++e) { const f32x2 cs = tabB[t * 4 + e]; const float v = acc[mf][nf][e]; const float o = __shfl_xor(v, 32);
            acc[mf][nf][e] = (h == 0) ? (v * cs.x - o * cs.y) : (v * cs.x + o * cs.y); }
          if (isq) {
#pragma unroll
            for (int i = 0; i < 16; ++i) acc[mf][nf][i] *= 0.17677669529663687f * LOG2E; }
        }
      } else if (nb >= C_Q && nb < C_V) {
        const float sc = nb < C_K ? 1.0f : 0.125f;
#pragma unroll
        for (int g = 0; g < 4; ++g) {
#pragma unroll
          for (int e = 0; e < 4; ++e) { const f32x2 cs = tabC[t * 32 + 8 * g + 4 * h + e]; const float x1 = acc[mf][0][4 * g + e], x2 = acc[mf][1][4 * g + e];
            acc[mf][0][4 * g + e] = (x1 * cs.x - x2 * cs.y) * sc; acc[mf][1][4 * g + e] = (x2 * cs.x + x1 * cs.y) * sc; }
          if (g & 1) __builtin_amdgcn_sched_barrier(0); }
      }
      store_piece32(lds + (threadIdx.x >> 6) * 9216, acc[mf][0], acc[mf][1], z, (size_t)NIN, mb + mf * 32, nb, l31, h);
    }
  } };

#define LASP __attribute__((address_space(3)))
template <class Epi>
DI void gemm_tile(char* lds, const ASrc& A, const bf16_t* __restrict__ Bt, int K, int m0, int n0, const Epi& epi, bool first, bool has_next, int m0n, int n0n) {
  const int tid = opaque(threadIdx.x), lane = tid & 63, w = __builtin_amdgcn_readfirstlane(tid >> 6), wr = w >> 1, wc = w & 1, l31 = lane & 31, h = lane >> 5;
  const int nk = K >> 6, smask = (1 << A.shift) - 1;
  LASP char* ldsl = (LASP char*)lds;
  f32x16 acc[2][2];
#pragma unroll
  for (int a = 0; a < 2; ++a)
#pragma unroll
    for (int b = 0; b < 2; ++b)
#pragma unroll
      for (int i = 0; i < 16; ++i) acc[a][b][i] = 0.f;
  const int lrow = lane >> 3, lslot = lane & 7;
  int goffA[4], goffB[4];
#pragma unroll
  for (int i = 0; i < 4; ++i) { const int r = w * 32 + i * 8 + lrow, c = lslot ^ ((r >> 1) & 7); goffA[i] = r; goffB[i] = r * K + c * 8; goffA[i] = (goffA[i] << 3) | c; }
#define GEMM_ISSUE(kt, st, M0_, N0_) do { const int k0_ = (kt) << 6, seg_ = k0_ >> A.shift, kk_ = k0_ & smask; \
    const bf16_t* bp_ = seg_ == 0 ? A.b0 : seg_ == 1 ? A.b1 : seg_ == 2 ? A.b2 : A.b3; const int st_ = seg_ == 0 ? A.s0 : seg_ == 1 ? A.s1 : seg_ == 2 ? A.s2 : A.s3; \
    _Pragma("unroll") for (int i_ = 0; i_ < 4; ++i_) { \
      const bf16_t* ga_ = bp_ + (size_t)((M0_) + (goffA[i_] >> 3)) * st_ + kk_ + (goffA[i_] & 7) * 8; \
      __builtin_amdgcn_global_load_lds((const unsigned*)ga_, (LASP unsigned*)(ldsl + (st) * 32768 + (w * 4 + i_) * 1024), 16, 0, 0); \
      const bf16_t* gb_ = Bt + (size_t)(N0_) * K + goffB[i_] + k0_; \
      __builtin_amdgcn_global_load_lds((const unsigned*)gb_, (LASP unsigned*)(ldsl + (st) * 32768 + 16384 + (w * 4 + i_) * 1024), 16, 0, 0); } } while (0)
  const int xr = (l31 >> 1) & 7;
  int coff[4];
#pragma unroll
  for (int s = 0; s < 4; ++s) coff[s] = ((2 * s + h) ^ xr) * 16;
#define GEMM_COMPUTE(st) do { const char* as = lds + (st) * 32768; const char* bs = as + 16384; \
    bf16x8 af[4][2], wf[4][2]; \
    _Pragma("unroll") for (int s = 0; s < 4; ++s) { \
      _Pragma("unroll") for (int mf = 0; mf < 2; ++mf) af[s][mf] = *(const bf16x8*)(as + (wr * 64 + mf * 32 + l31) * 128 + coff[s]); \
      _Pragma("unroll") for (int nf = 0; nf < 2; ++nf) wf[s][nf] = *(const bf16x8*)(bs + (wc * 64 + nf * 32 + l31) * 128 + coff[s]); } \
    __builtin_amdgcn_sched_barrier(0); __builtin_amdgcn_s_setprio(1); \
    _Pragma("unroll") for (int s = 0; s < 4; ++s) \
      _Pragma("unroll") for (int mf = 0; mf < 2; ++mf) _Pragma("unroll") for (int nf = 0; nf < 2; ++nf) acc[mf][nf] = MFMA32(wf[s][nf], af[s][mf], acc[mf][nf]); \
    __builtin_amdgcn_s_setprio(0); __builtin_amdgcn_sched_barrier(0); } while (0)
  if (first) GEMM_ISSUE(0, 0, m0, n0);
  for (int kt = 0; kt < nk; kt += 2) {
    asm volatile("s_waitcnt vmcnt(0)" ::: "memory"); __syncthreads();
    GEMM_ISSUE(kt + 1, 1, m0, n0);
    GEMM_COMPUTE(0);
    asm volatile("s_waitcnt vmcnt(0)" ::: "memory"); __syncthreads();
    if (kt + 2 < nk) GEMM_ISSUE(kt + 2, 0, m0, n0);
    GEMM_COMPUTE(1);
  }
  __syncthreads();
  if (has_next) GEMM_ISSUE(0, 0, m0n, n0n);
  epi(acc, m0 + wr * 64, n0 + wc * 64, n0, wc, l31, h);
  __syncthreads();
#undef GEMM_ISSUE
#undef GEMM_COMPUTE
}

template <class Epi>
DI void gemm_phase(char* lds, const ASrc& A, const bf16_t* Bt, int K, int ntn, const Epi& epi) {
  const int xcd = blockIdx.x & 7, j = blockIdx.x >> 3, nloc = gridDim.x >> 3, per = 48 * ntn, grp = 8 * ntn;
  bool first = true;
  for (int li = j; li < per; li += nloc) {
    const int sg = li / grp, wi = li - sg * grp, nt = wi >> 3, mt = xcd * 48 + sg * 8 + (wi & 7);
    const int ln = li + nloc; const bool has_next = ln < per;
    const int sgn = ln / grp, win = ln - sgn * grp, ntn2 = win >> 3, mtn = xcd * 48 + sgn * 8 + (win & 7);
    gemm_tile(lds, A, Bt, K, mt * 128, nt * 128, epi, first, has_next, mtn * 128, ntn2 * 128);
    first = false;
  }
}

DI void prep_item(char* lds, const Params& p, int layer, int item) {
  const int tid = opaque(threadIdx.x), lane = tid & 63, w = tid >> 6;
  const int rowb = item * 64; int tb, T; row_info(rowb, tb, T);
  const float* qg = p.in[I_AQG] + layer * 64; const float* kg = p.in[I_AKG] + layer * 64;
  const float qgl = qg[lane], kgl = kg[lane];
  for (int tt = 0; tt < 16; ++tt) {
    const int row = rowb + w * 16 + tt, t = tb + w * 16 + tt;
    bf16_t* zr = p.z + (size_t)row * NIN;
    {
      const int j = lane & 31, i = j & 15; const bool first = j < 16; const int pos = (lane < 32) ? (t >> 6) : (t & 63);
      const f32x2 cs = p.tabA[pos * 16 + i];
#pragma unroll
      for (int hd = 0; hd < 6; ++hd) {
        bf16_t* ptr = zr + (hd < 4 ? A_Q + hd * 64 : A_K + (hd - 4) * 64) + lane;
        float v = bf2f(*ptr);
        const float ss = wave_sum(v * v);
        v = v * rsqrtf(ss * (1.0f / 64.0f) + EPS) * (hd < 4 ? qgl : kgl);
        const float o = __shfl_xor(v, 16);
        float r = first ? (v * cs.x - o * cs.y) : (v * cs.x + o * cs.y);
        if (hd < 4) r *= 0.125f * LOG2E;
        *ptr = f2bf(r);
      }
    }
    {
      const int d = lane & 31; const f32x2 cs = p.tabB[t * 4 + (d & 3)];
#pragma unroll
      for (int c = 0; c < 8; ++c) {
        bf16_t* ptr = zr + (c < 4 ? B_Q + c * 64 : B_K + (c - 4) * 64) + lane;
        float v = bf2f(*ptr);
        const float o = __shfl_xor(v, 4);
        float r = v;
        if (d < 8) r = (d < 4) ? (v * cs.x - o * cs.y) : (v * cs.x + o * cs.y);
        if (c < 4) r *= 0.17677669529663687f * LOG2E;
        *ptr = f2bf(r);
      }
    }
    {
      const f32x2 cs = p.tabC[t * 32 + (lane & 31)];
#pragma unroll
      for (int c = 0; c < 8; ++c) {
        bf16_t* ptr = zr + (c < 4 ? C_Q + c * 64 : C_K + (c - 4) * 64) + lane;
        const float v = bf2f(*ptr);
        const float o = __shfl_xor(v, 32);
        float r = (lane < 32) ? (v * cs.x - o * cs.y) : (v * cs.x + o * cs.y);
        if (c >= 4) r *= 0.125f;
        *ptr = f2bf(r);
      }
    }
  }
  bf16_t* tl = (bf16_t*)lds;
  const int r = tid >> 2, c0 = (tid & 3) * 16;
  for (int sl = 0; sl < 10; ++sl) {
    const int col = sl < 2 ? A_V + sl * 64 : sl < 6 ? B_V + (sl - 2) * 64 : C_V + (sl - 6) * 64;
    bf16_t* gp = p.z + (size_t)(rowb + r) * NIN + col + c0;
    const u32x4 v0 = *(const u32x4*)gp, v1 = *(const u32x4*)(gp + 8);
    __syncthreads();
#pragma unroll
    for (int e = 0; e < 4; ++e) {
      tl[(c0 + 2 * e) * 72 + r] = (bf16_t)(v0[e] & 0xffffu); tl[(c0 + 2 * e + 1) * 72 + r] = (bf16_t)(v0[e] >> 16);
      tl[(c0 + 8 + 2 * e) * 72 + r] = (bf16_t)(v1[e] & 0xffffu); tl[(c0 + 8 + 2 * e + 1) * 72 + r] = (bf16_t)(v1[e] >> 16);
    }
    __syncthreads();
    const u32x4 o0 = *(const u32x4*)(tl + r * 72 + c0), o1 = *(const u32x4*)(tl + r * 72 + c0 + 8);
    *(u32x4*)gp = o0; *(u32x4*)(gp + 8) = o1;
  }
  __syncthreads();
}

DI float dshift(const Params& p, const float* mup, const float* mun, int row, int t, int T, int dc) {
  const bf16_t* zp = p.z + (size_t)row * NIN + D_0 + dc;
  const float z = bf2f(*zp);
  const float zprev = (t > 0) ? bf2f(*(zp - NIN)) : 0.f;
  const float znext = (t < T - 1) ? bf2f(*(zp + NIN)) : 0.f;
  return z + mup[dc] * (zprev - z) + mun[dc] * (znext - z);
}
DI float sigmoidf_(float x) { return 1.0f / (1.0f + __expf(-x)); }
DI float omdecay(float ww) {
  const float e = 0.6065306597126334f / (1.0f + __expf(-ww));
  return 1.0f - __expf(-e);
}
DI float fast_tanh(float x) { const float xc = fminf(fmaxf(x, -15.f), 15.f); return 1.0f - 2.0f / (1.0f + __expf(2.0f * xc)); }
constexpr int DTOK = 16;
DI void dprep_item(char* lds, const Params& p, int layer, int item) {
  const int tid = opaque(threadIdx.x);
  const int rowb = item * DTOK; int tb, T; row_info(rowb, tb, T);
  const float* mup = p.in[I_DMUP] + layer * 1088; const float* mun = p.in[I_DMUN] + layer * 1088;
  float* su = (float*)lds;
  bf16_t* stg = (bf16_t*)(lds + 12288);
#pragma unroll
  for (int i = 0; i < 12; ++i) {
    const int idx = tid + 256 * i, tok = idx / 192, c = idx - tok * 192;
    float u = dshift(p, mup, mun, rowb + tok, tb + tok, T, 768 + c);
    if (c < 128) u = fast_tanh(u);
    su[c * DTOK + tok] = u;
  }
  __syncthreads();
  const int c = tid;
  const float w0f = p.in[I_DW0][(layer * 2 + 0) * 256 + c], w0b = p.in[I_DW0][(layer * 2 + 1) * 256 + c];
  const float a0 = p.in[I_DA0][layer * 256 + c], kkw = p.in[I_DKK][layer * 256 + c], kaw = p.in[I_DKA][layer * 256 + c];
  float zr[DTOK + 2], zk[DTOK + 2], zv[DTOK + 2];
  { const bf16_t* zp = p.z + (size_t)rowb * NIN + D_0 + c;
#pragma unroll
    for (int i = 0; i < DTOK + 2; ++i) { const int t = tb - 1 + i; const bool ok = (t >= 0) && (t < T); const bf16_t* q = zp + (ptrdiff_t)(i - 1) * NIN;
      zr[i] = ok ? bf2f(q[0]) : 0.f; zk[i] = ok ? bf2f(q[256]) : 0.f; zv[i] = ok ? bf2f(q[512]) : 0.f; } }
  const float mpr = mup[c], mnr = mun[c], mpk = mup[256 + c], mnk = mun[256 + c], mpv = mup[512 + c], mnv = mun[512 + c];
  float accf[DTOK], accb[DTOK], acca[DTOK];
#pragma unroll
  for (int k = 0; k < DTOK; ++k) { accf[k] = 0.f; accb[k] = 0.f; acca[k] = 0.f; }
  const float* wupf = p.in[I_DWUP] + (size_t)(layer * 2 + 0) * 64 * 256 + c;
  const float* wupb = p.in[I_DWUP] + (size_t)(layer * 2 + 1) * 64 * 256 + c;
  const float* aup = p.in[I_DAUP] + (size_t)layer * 64 * 256 + c;
#pragma unroll 2
  for (int j = 0; j < 64; ++j) {
    const float wf = wupf[j * 256], wb = wupb[j * 256], wa = aup[j * 256];
#pragma unroll
    for (int q = 0; q < 4; ++q) {
      const f32x4 f0 = *(const f32x4*)(su + j * DTOK + 4 * q), b0 = *(const f32x4*)(su + (64 + j) * DTOK + 4 * q), a0v = *(const f32x4*)(su + (128 + j) * DTOK + 4 * q);
#pragma unroll
      for (int k = 0; k < 4; ++k) { accf[4 * q + k] += f0[k] * wf; accb[4 * q + k] += b0[k] * wb; acca[4 * q + k] += a0v[k] * wa; }
    }
  }
#pragma unroll
  for (int k = 0; k < DTOK; ++k) {
    const float r = zr[k + 1] + mpr * (zr[k] - zr[k + 1]) + mnr * (zr[k + 2] - zr[k + 1]);
    const float kx = zk[k + 1] + mpk * (zk[k] - zk[k + 1]) + mnk * (zk[k + 2] - zk[k + 1]);
    const float v = zv[k + 1] + mpv * (zv[k] - zv[k + 1]) + mnv * (zv[k + 2] - zv[k + 1]);
    const float omf = omdecay(w0f + accf[k]), omb = omdecay(w0b + accb[k]);
    const float a = sigmoidf_(a0 + acca[k]);
    float kk = kx * kkw; const float n2 = wave_sum(kk * kk);
    kk = kk * rsqrtf(fmaxf(n2, 1e-24f));
    const float kmod = kx * (1.0f + (a - 1.0f) * kaw), b = kk * a;
    bf16_t* so = stg + k * 256 + c;
    so[0] = f2bf(r); so[DTOK * 256] = f2bf(kmod); so[2 * DTOK * 256] = f2bf(v); so[3 * DTOK * 256] = f2bf(-kk);
    so[4 * DTOK * 256] = f2bf(b); so[5 * DTOK * 256] = f2bf(omf); so[6 * DTOK * 256] = f2bf(omb);
  }
  __syncthreads();
#pragma unroll
  for (int i = 0; i < 14; ++i) {
    const int q = tid + 256 * i, pln = q >> 9, rem = q & 511, tok = rem >> 5, c16 = rem & 31;
    const u32x4 v = *(const u32x4*)(stg + pln * (DTOK * 256) + tok * 256 + c16 * 8);
    *(u32x4*)(p.pl + (size_t)pln * PLANE + (size_t)(rowb + tok) * 256 + c16 * 8) = v;
  }
  __syncthreads();
}

DI void dpost_item(char* lds, const Params& p, int layer, int item) {
  const int tid = opaque(threadIdx.x);
  const int rowb = item * DTOK; int tb, T; row_info(rowb, tb, T);
  const float* mup = p.in[I_DMUP] + layer * 1088; const float* mun = p.in[I_DMUN] + layer * 1088;
  float* sg = (float*)lds;
  bf16_t* stg = (bf16_t*)(lds + 8192);
#pragma unroll
  for (int i = 0; i < 8; ++i) { const int idx = tid + 256 * i, tok = idx >> 7, c = idx & 127; sg[c * DTOK + tok] = sigmoidf_(dshift(p, mup, mun, rowb + tok, tb + tok, T, 960 + c)); }
  __syncthreads();
  const int c = tid;
  float acc[DTOK];
#pragma unroll
  for (int k = 0; k < DTOK; ++k) acc[k] = 0.f;
  float yv[DTOK], rv_[DTOK], kmv[DTOK], vv_[DTOK];
#pragma unroll
  for (int k = 0; k < DTOK; ++k) { const int row = rowb + k; const bf16_t* zd = p.z + (size_t)row * NIN + D_0; const size_t o = (size_t)row * 256 + c;
    yv[k] = bf2f(zd[c]) + bf2f(zd[256 + c]); rv_[k] = bf2f(p.pl[o]); kmv[k] = bf2f(p.pl[PLANE + o]); vv_[k] = bf2f(p.pl[2 * PLANE + o]); }
  const float* gup = p.in[I_DGUP] + (size_t)layer * 128 * 256 + c;
#pragma unroll 4
  for (int j = 0; j < 128; ++j) { const float gw = gup[j * 256];
#pragma unroll
    for (int q = 0; q < 4; ++q) { const f32x4 s0 = *(const f32x4*)(sg + j * DTOK + 4 * q);
#pragma unroll
      for (int k = 0; k < 4; ++k) acc[4 * q + k] += s0[k] * gw; } }
  const float gnw = p.in[I_DGNW][layer * 256 + c], gnb = p.in[I_DGNB][layer * 256 + c], rk = p.in[I_DRK][layer * 256 + c];
#pragma unroll
  for (int k = 0; k < DTOK; ++k) {
    const float y = yv[k];
    const float mean = wave_sum(y) * (1.0f / 64.0f); const float d = y - mean; const float var = wave_sum(d * d) * (1.0f / 64.0f);
    const float yn = d * rsqrtf(var + 64e-5f) * gnw + gnb;
    const float r = rv_[k], km = kmv[k], v = vv_[k];
    const float bonus = wave_sum(r * km * rk);
    stg[k * 256 + c] = f2bf((yn + bonus * v) * acc[k]);
  }
  __syncthreads();
#pragma unroll
  for (int i = 0; i < 2; ++i) { const int q = tid + 256 * i, tok = q >> 5, c16 = q & 31;
    const u32x4 v = *(const u32x4*)(stg + tok * 256 + c16 * 8);
    *(u32x4*)(p.pl + 4 * PLANE + (size_t)(rowb + tok) * 256 + c16 * 8) = v; }
  __syncthreads();
}

DI void rwkv_item(char* lds, const Params& p, int seq, int head, int dir, int half) {
  int row0, T; seq_info(seq, row0, T);
  const int tid = opaque(threadIdx.x), kc = tid & 7, vrow = half * 32 + (tid >> 3);
  float* st = (float*)lds;
  f32x2 S[4];
#pragma unroll
  for (int j = 0; j < 4; ++j) S[j] = (f32x2){0.f, 0.f};
  const int nchunk = T >> 4;
  u32x4 rg[3];
  const int tsel = tid >> 7, srem = tid & 127, sstep = srem >> 3, sc8 = srem & 7;
#define RW_GLOAD(c) do { _Pragma("unroll") for (int i_ = 0; i_ < 3; ++i_) { const int tens_ = tsel + 2 * i_; \
      const int plane_ = tens_ == 0 ? (dir ? 6 : 5) : tens_ == 1 ? 3 : tens_ == 2 ? 4 : tens_ == 3 ? 1 : tens_ == 4 ? 0 : 2; \
      const int t_ = dir ? (T - 1 - ((c) * 16 + sstep)) : ((c) * 16 + sstep); \
      rg[i_] = *(const u32x4*)(p.pl + (size_t)plane_ * PLANE + (size_t)(row0 + t_) * 256 + head * 64 + sc8 * 8); } } while (0)
#define RW_LSTORE(buf) do { _Pragma("unroll") for (int i_ = 0; i_ < 3; ++i_) { const int tens_ = tsel + 2 * i_; \
      f32x4 a_ = {bflo(rg[i_].x), bfhi(rg[i_].x), bflo(rg[i_].y), bfhi(rg[i_].y)}, b_ = {bflo(rg[i_].z), bfhi(rg[i_].z), bflo(rg[i_].w), bfhi(rg[i_].w)}; \
      if (tens_ == 0) { a_ = 1.0f - a_; b_ = 1.0f - b_; } \
      float* d_ = st + (((buf) * 16 + sstep) * 6 + tens_) * 64 + sc8 * 8; *(f32x4*)d_ = a_; *(f32x4*)(d_ + 4) = b_; } } while (0)
  __builtin_amdgcn_s_setprio(3);
  RW_GLOAD(0); RW_LSTORE(0); __syncthreads();
  bf16_t* ybase = p.z + (size_t)row0 * NIN + D_0 + dir * 256 + head * 64 + half * 32;
  for (int c = 0; c < nchunk; ++c) {
    if (c + 1 < nchunk) RW_GLOAD(c + 1);
    const float* sb = st + (c & 1) * (16 * 384);
    unsigned* yb = (unsigned*)(lds + 49152) + (c & 1) * 256;
    if (c > 0 && tid < 64) {
      const int sp = tid >> 2, part = tid & 3, tt = (c - 1) * 16 + sp; const int t_ = dir ? (T - 1 - tt) : tt;
      const u32x4 v = *(const u32x4*)((unsigned*)(lds + 49152) + ((c - 1) & 1) * 256 + sp * 16 + part * 4);
      *(u32x4*)(ybase + (size_t)t_ * NIN + part * 8) = v; }
#define RW_FETCH(S_, s_) do { const float* q_ = sb + (s_) * 384 + kc * 8; \
      S_##w0 = *(const f32x4*)(q_); S_##w1 = *(const f32x4*)(q_ + 4); S_##n0 = *(const f32x4*)(q_ + 64); S_##n1 = *(const f32x4*)(q_ + 68); \
      S_##b0 = *(const f32x4*)(q_ + 128); S_##b1 = *(const f32x4*)(q_ + 132); S_##k0 = *(const f32x4*)(q_ + 192); S_##k1 = *(const f32x4*)(q_ + 196); \
      S_##r0 = *(const f32x4*)(q_ + 256); S_##r1 = *(const f32x4*)(q_ + 260); S_##vv = sb[(s_) * 384 + 320 + vrow]; } while (0)
#define LO2(x) ((f32x2){(x)[0], (x)[1]})
#define HI2(x) ((f32x2){(x)[2], (x)[3]})
#define RW_STEP(S_, s_) do { \
      f32x2 a2 = S[0] * LO2(S_##n0); a2 += S[1] * HI2(S_##n0); a2 += S[2] * LO2(S_##n1); a2 += S[3] * HI2(S_##n1); \
      const float sa = red8(a2.x + a2.y); const float vx = S_##vv; \
      S[0] = S[0] * LO2(S_##w0) + (LO2(S_##b0) * sa + LO2(S_##k0) * vx); S[1] = S[1] * HI2(S_##w0) + (HI2(S_##b0) * sa + HI2(S_##k0) * vx); \
      S[2] = S[2] * LO2(S_##w1) + (LO2(S_##b1) * sa + LO2(S_##k1) * vx); S[3] = S[3] * HI2(S_##w1) + (HI2(S_##b1) * sa + HI2(S_##k1) * vx); \
      f32x2 y2 = S[0] * LO2(S_##r0); y2 += S[1] * HI2(S_##r0); y2 += S[2] * LO2(S_##r1); y2 += S[3] * HI2(S_##r1); \
      const float y = red8(y2.x + y2.y); const float yn = DPPF(y, 0x128);     \
      if ((tid & 15) == 0) yb[(s_) * 16 + (tid >> 4)] = pk(y, yn); } while (0)
    f32x4 Aw0, Aw1, An0, An1, Ab0, Ab1, Ak0, Ak1, Ar0, Ar1; float Avv;
    f32x4 Bw0, Bw1, Bn0, Bn1, Bb0, Bb1, Bk0, Bk1, Br0, Br1; float Bvv;
    RW_FETCH(A, 0);
#pragma unroll
    for (int s = 0; s < 16; s += 2) {
      RW_FETCH(B, s + 1);
      RW_STEP(A, s);
      if (s + 2 < 16) RW_FETCH(A, s + 2);
      RW_STEP(B, s + 1);
    }
#undef RW_FETCH
#undef RW_STEP
    if (c + 1 < nchunk) RW_LSTORE((c + 1) & 1);
    __syncthreads();
  }
#undef RW_GLOAD
#undef RW_LSTORE
  if (tid < 64) { const int c = nchunk; const int sp = tid >> 2, part = tid & 3, tt = (c - 1) * 16 + sp; const int t_ = dir ? (T - 1 - tt) : tt;
    const u32x4 v = *(const u32x4*)((unsigned*)(lds + 49152) + ((c - 1) & 1) * 256 + sp * 16 + part * 4);
    *(u32x4*)(ybase + (size_t)t_ * NIN + part * 8) = v; }
  __syncthreads();
  __builtin_amdgcn_s_setprio(0);
}

template <int MODE>
DI void attn_item(char* lds, const Params& p, int layer, int seq, int head, int qt) {
  const int tid = opaque(threadIdx.x), lane = tid & 63, w = tid >> 6, l31 = lane & 31, h = lane >> 5;
  layer = opaque_s(layer); seq = opaque_s(seq); head = opaque_s(head); qt = opaque_s(qt);
  int row0, T; seq_info(seq, row0, T);
  const int QC = (MODE == 0 ? A_Q : MODE == 1 ? B_Q : C_Q) + head * 64;
  const int KC = MODE == 0 ? A_K + (head >> 1) * 64 : MODE == 1 ? B_K + head * 64 : C_K + head * 64;
  const int VC = MODE == 0 ? A_V + (head >> 1) * 64 : MODE == 1 ? B_V + head * 64 : C_V + head * 64;
  const int qw0 = qt * 128 + w * 32, qi = qw0 + l31;
  bf16_t* zq = p.z + (size_t)(row0 + qi) * NIN + QC;
  bf16x8 qf[4];
#pragma unroll
  for (int s = 0; s < 4; ++s) qf[s] = *(const bf16x8*)(zq + s * 16 + h * 8);
  const int srow = tid >> 3, sc8 = tid & 7;
  const bf16_t* kbase = p.z + (size_t)(row0 + srow) * NIN + KC + sc8 * 8;
  const bf16_t* vbase = p.z + (size_t)(row0 + srow) * NIN + VC + sc8 * 8;
  u32x4 rk[2][2], rv[2][2];
  const int nt = T >> 6;
  const int prow = (l31 & 19) | ((l31 & 4) << 1) | ((l31 & 8) >> 1);
#define AT_GLOAD(t, S) do { _Pragma("unroll") for (int i_ = 0; i_ < 2; ++i_) { const size_t off_ = (size_t)((t) * 64 + 32 * i_) * NIN; rk[S][i_] = *(const u32x4*)(kbase + off_); rv[S][i_] = *(const u32x4*)(vbase + off_); } } while (0)
#define AT_LSTORE(buf, S) do { char* ks_ = lds + (buf) * 18432; char* vs_ = ks_ + 9216; \
    _Pragma("unroll") for (int i_ = 0; i_ < 2; ++i_) { *(u32x4*)(ks_ + (srow + 32 * i_) * PITCH + sc8 * 16) = rk[S][i_]; *(u32x4*)(vs_ + (srow + 32 * i_) * PITCH + sc8 * 16) = rv[S][i_]; } } while (0)
  constexpr int NMAP = (MODE == 1) ? 2 : 1;
  f32x16 o[NMAP][2];
  float m_run[NMAP], l_run[NMAP];
#pragma unroll
  for (int a = 0; a < NMAP; ++a) { m_run[a] = -INFINITY; l_run[a] = 0.f;
#pragma unroll
    for (int b = 0; b < 2; ++b)
#pragma unroll
      for (int i = 0; i < 16; ++i) o[a][b][i] = 0.f; }
  float lf = 0.f, lb = 0.f;
  if (MODE == 2) { lf = log2f(1.0f - exp2f(-5.0f - (float)head)); lb = log2f(1.0f - exp2f(-5.0f - (float)(3 - head))); }
  auto body = [&](const char* ks, const char* vs, const int t) __attribute__((always_inline)) {
#pragma unroll
    for (int mp = 0; mp < NMAP; ++mp) {
      f32x16 st[2];
#pragma unroll
      for (int kf = 0; kf < 2; ++kf) {
#pragma unroll
        for (int i = 0; i < 16; ++i) st[kf][i] = 0.f;
        if (MODE == 1) {
#pragma unroll
          for (int s = 0; s < 2; ++s) { const bf16x8 kfr = *(const bf16x8*)(ks + (kf * 32 + prow) * PITCH + (mp * 2 + s) * 32 + h * 16); st[kf] = MFMA32(kfr, qf[mp * 2 + s], st[kf]); }
        } else {
#pragma unroll
          for (int s = 0; s < 4; ++s) { const bf16x8 kfr = *(const bf16x8*)(ks + (kf * 32 + prow) * PITCH + s * 32 + h * 16); st[kf] = MFMA32(kfr, qf[s], st[kf]); }
        }
      }
      if (MODE == 2) {
        const int k0 = t * 64;
        const float dbase = (float)(qi - k0 - 8 * h);
        if (k0 + 63 < qw0) {
#pragma unroll
          for (int kf = 0; kf < 2; ++kf)
#pragma unroll
            for (int i = 0; i < 16; ++i) { const float cc = (float)(32 * kf + (i & 3) + 4 * ((i >> 2) & 1) + 16 * ((i >> 3) & 1)); st[kf][i] *= fexp2(lf * (dbase - cc)); }
        } else if (k0 > qw0 + 31) {
#pragma unroll
          for (int kf = 0; kf < 2; ++kf)
#pragma unroll
            for (int i = 0; i < 16; ++i) { const float cc = (float)(32 * kf + (i & 3) + 4 * ((i >> 2) & 1) + 16 * ((i >> 3) & 1)); st[kf][i] *= fexp2(lb * (cc - dbase)); }
        } else {
#pragma unroll
          for (int kf = 0; kf < 2; ++kf)
#pragma unroll
            for (int i = 0; i < 16; ++i) { const float cc = (float)(32 * kf + (i & 3) + 4 * ((i >> 2) & 1) + 16 * ((i >> 3) & 1)); const float d = dbase - cc;
              float dd = fexp2(fminf(lf * d, -lb * d)); if (d == 0.f) dd = 2.0f; st[kf][i] *= dd; }
        }
      } else {
        float mx = st[0][0];
#pragma unroll
        for (int kf = 0; kf < 2; ++kf)
#pragma unroll
          for (int i = 0; i < 16; ++i) mx = fmaxf(mx, st[kf][i]);
        mx = fmaxf(mx, __shfl_xor(mx, 32));
        const float mn = fmaxf(m_run[mp], mx); const float alpha = fexp2(m_run[mp] - mn); m_run[mp] = mn;
        float ps = 0.f;
#pragma unroll
        for (int kf = 0; kf < 2; ++kf)
#pragma unroll
          for (int i = 0; i < 16; ++i) { st[kf][i] = fexp2(st[kf][i] - mn); ps += st[kf][i]; }
        l_run[mp] = l_run[mp] * alpha + ps;
#pragma unroll
        for (int df = 0; df < 2; ++df) o[mp][df] *= alpha;
      }
      bf16x8 pf[4];
#pragma unroll
      for (int kf = 0; kf < 2; ++kf)
#pragma unroll
        for (int s2 = 0; s2 < 2; ++s2) { u32x4 u; u.x = pk(st[kf][8 * s2], st[kf][8 * s2 + 1]); u.y = pk(st[kf][8 * s2 + 2], st[kf][8 * s2 + 3]);
          u.z = pk(st[kf][8 * s2 + 4], st[kf][8 * s2 + 5]); u.w = pk(st[kf][8 * s2 + 6], st[kf][8 * s2 + 7]); pf[kf * 2 + s2] = __builtin_bit_cast(bf16x8, u); }
#pragma unroll
      for (int df = 0; df < 2; ++df)
#pragma unroll
        for (int ksx = 0; ksx < 4; ++ksx) { const bf16x8 vfr = *(const bf16x8*)(vs + (df * 32 + l31) * PITCH + ksx * 32 + h * 16); o[mp][df] = MFMA32(vfr, pf[ksx], o[mp][df]); }
    }
  };
  if constexpr (MODE == 1) {
    AT_GLOAD(0, 0); AT_LSTORE(0, 0); __syncthreads();
#pragma unroll 1
    for (int t = 0; t < nt; ++t) {
      if (t + 1 < nt) AT_GLOAD(t + 1, 0);
      const char* ks = lds + (t & 1) * 18432;
      body(ks, ks + 9216, t);
      if (t + 1 < nt) AT_LSTORE((t + 1) & 1, 0);
      __syncthreads();
    }
  } else {
    AT_GLOAD(0, 0); AT_GLOAD(1, 1); AT_LSTORE(0, 0); __syncthreads();
#pragma unroll 1
    for (int t2 = 0; t2 < nt; t2 += 2) {
      if (t2 + 2 < nt) AT_GLOAD(t2 + 2, 0);
      body(lds, lds + 9216, t2);
      AT_LSTORE(1, 1);
      __syncthreads();
      if (t2 + 3 < nt) AT_GLOAD(t2 + 3, 1);
      body(lds + 18432, lds + 18432 + 9216, t2 + 1);
      if (t2 + 2 < nt) AT_LSTORE(0, 0);
      __syncthreads();
    }
  }
#undef AT_GLOAD
#undef AT_LSTORE
  f32x16 r[2];
  if (MODE == 0) {
    const float l = l_run[0] + __shfl_xor(l_run[0], 32); const float inv = 1.0f / l;
#pragma unroll
    for (int df = 0; df < 2; ++df) r[df] = o[0][df] * inv;
  } else if (MODE == 1) {
    const float* lp = p.in[I_BLAM] + layer * 128;
    float s01 = 0.f, s23 = 0.f;
    for (int i = 0; i < 32; ++i) { s01 += lp[i] * lp[32 + i]; s23 += lp[64 + i] * lp[96 + i]; }
    const float lam_init = 0.8f - 0.6f * expf(-0.3f * (float)layer);
    const float lam = expf(s01) - expf(s23) + lam_init;
    const float l0 = l_run[0] + __shfl_xor(l_run[0], 32), l1 = l_run[NMAP - 1] + __shfl_xor(l_run[NMAP - 1], 32);
    const float i0 = 1.0f / l0, i1 = lam / l1;
    float ss = 0.f;
#pragma unroll
    for (int df = 0; df < 2; ++df) { r[df] = o[0][df] * i0 - o[NMAP - 1][df] * i1;
#pragma unroll
      for (int i = 0; i < 16; ++i) ss += r[df][i] * r[df][i]; }
    ss += __shfl_xor(ss, 32);
    const float rs = rsqrtf(ss * (1.0f / 64.0f) + EPS) * (1.0f - lam_init);
    const float* sg = p.in[I_BSUB] + layer * 64;
#pragma unroll
    for (int df = 0; df < 2; ++df)
#pragma unroll
      for (int i = 0; i < 16; ++i) r[df][i] *= rs * sg[df * 32 + (i & 3) + 8 * (i >> 2) + 4 * h];
  } else {
    float ss = 0.f;
#pragma unroll
    for (int df = 0; df < 2; ++df)
#pragma unroll
      for (int i = 0; i < 16; ++i) ss += o[0][df][i] * o[0][df][i];
    ss += __shfl_xor(ss, 32);
    const float rs = rsqrtf(ss * (1.0f / 64.0f) + EPS);
    const float* gg = p.in[I_CGN] + layer * 256 + head * 64;
    const bf16_t* zg = p.z + (size_t)(row0 + qi) * NIN + C_G + head * 64;
#pragma unroll
    for (int df = 0; df < 2; ++df)
#pragma unroll
      for (int g = 0; g < 4; ++g) { const u32x2 gw = *(const u32x2*)(zg + df * 32 + 8 * g + 4 * h);
        const float gv[4] = {bflo(gw.x), bfhi(gw.x), bflo(gw.y), bfhi(gw.y)};
#pragma unroll
        for (int e = 0; e < 4; ++e) { const float x = gv[e]; r[df][4 * g + e] = o[0][df][4 * g + e] * rs * gg[df * 32 + 8 * g + 4 * h + e] * (x / (1.0f + __expf(-x))); } }
  }
#pragma unroll
  for (int df = 0; df < 2; ++df)
#pragma unroll
    for (int g = 0; g < 4; ++g) { u32x2 v; v.x = pk(r[df][4 * g], r[df][4 * g + 1]); v.y = pk(r[df][4 * g + 2], r[df][4 * g + 3]); *(u32x2*)(zq + df * 32 + 8 * g + 4 * h) = v; }
}

template <class Epi>
DI void gemm_tile2(char* lds, const ASrc& A, const bf16_t* __restrict__ Bt, int K, int m0, int n0, const Epi& epi) {
  const int tid = opaque(threadIdx.x), lane = tid & 63, w = __builtin_amdgcn_readfirstlane(tid >> 6), wr = w >> 1, wc = w & 1, l31 = lane & 31, h = lane >> 5;
  const int nk = K >> 5, smask = (1 << A.shift) - 1;
  LASP char* ldsl = (LASP char*)lds;
  f32x16 acc[2][4];
#pragma unroll
  for (int a = 0; a < 2; ++a)
#pragma unroll
    for (int b = 0; b < 4; ++b)
#pragma unroll
      for (int i = 0; i < 16; ++i) acc[a][b][i] = 0.f;
  const int lrow = lane >> 2, lslot = lane & 3;
  int goffA[2], goffB[4];
#pragma unroll
  for (int i = 0; i < 2; ++i) { const int r = (2 * w + i) * 16 + lrow, c = lslot ^ ((r >> 2) & 3); goffA[i] = (r << 2) | c; }
#pragma unroll
  for (int i = 0; i < 4; ++i) { const int r = (4 * w + i) * 16 + lrow, c = lslot ^ ((r >> 2) & 3); goffB[i] = r * K + c * 8; }
#define G2_ISSUE(kt, st) do { const int k0_ = (kt) << 5, seg_ = k0_ >> A.shift, kk_ = k0_ & smask; \
    const bf16_t* bp_ = seg_ == 0 ? A.b0 : seg_ == 1 ? A.b1 : seg_ == 2 ? A.b2 : A.b3; const int st_ = seg_ == 0 ? A.s0 : seg_ == 1 ? A.s1 : seg_ == 2 ? A.s2 : A.s3; \
    _Pragma("unroll") for (int i_ = 0; i_ < 2; ++i_) { \
      const bf16_t* ga_ = bp_ + (size_t)(m0 + (goffA[i_] >> 2)) * st_ + kk_ + (goffA[i_] & 3) * 8; \
      __builtin_amdgcn_global_load_lds((const unsigned*)ga_, (LASP unsigned*)(ldsl + (st) * 24576 + (2 * w + i_) * 1024), 16, 0, 0); } \
    _Pragma("unroll") for (int i_ = 0; i_ < 4; ++i_) { \
      const bf16_t* gb_ = Bt + (size_t)n0 * K + goffB[i_] + k0_; \
      __builtin_amdgcn_global_load_lds((const unsigned*)gb_, (LASP unsigned*)(ldsl + (st) * 24576 + 8192 + (4 * w + i_) * 1024), 16, 0, 0); } } while (0)
  const int xr = (l31 >> 2) & 3;
  int coff[2];
#pragma unroll
  for (int s = 0; s < 2; ++s) coff[s] = ((2 * s + h) ^ xr) * 16;
#define G2_COMPUTE(st) do { const char* as = lds + (st) * 24576; const char* bs = as + 8192; \
    bf16x8 af[2][2], wf[2][4]; \
    _Pragma("unroll") for (int s = 0; s < 2; ++s) { \
      _Pragma("unroll") for (int mf = 0; mf < 2; ++mf) af[s][mf] = *(const bf16x8*)(as + (wr * 64 + mf * 32 + l31) * 64 + coff[s]); \
      _Pragma("unroll") for (int nf = 0; nf < 4; ++nf) wf[s][nf] = *(const bf16x8*)(bs + (wc * 128 + nf * 32 + l31) * 64 + coff[s]); } \
    __builtin_amdgcn_sched_barrier(0); __builtin_amdgcn_s_setprio(1); \
    _Pragma("unroll") for (int s = 0; s < 2; ++s) \
      _Pragma("unroll") for (int mf = 0; mf < 2; ++mf) _Pragma("unroll") for (int nf = 0; nf < 4; ++nf) acc[mf][nf] = MFMA32(wf[s][nf], af[s][mf], acc[mf][nf]); \
    __builtin_amdgcn_s_setprio(0); __builtin_amdgcn_sched_barrier(0); } while (0)
  G2_ISSUE(0, 0);
  for (int kt = 0; kt < nk; kt += 2) {
    asm volatile("s_waitcnt vmcnt(0)" ::: "memory"); __syncthreads();
    G2_ISSUE(kt + 1, 1);
    G2_COMPUTE(0);
    asm volatile("s_waitcnt vmcnt(0)" ::: "memory"); __syncthreads();
    if (kt + 2 < nk) G2_ISSUE(kt + 2, 0);
    G2_COMPUTE(1);
  }
  __syncthreads();
#pragma unroll
  for (int hf = 0; hf < 2; ++hf) {
    f32x16 t[2][2];
#pragma unroll
    for (int mf = 0; mf < 2; ++mf) { t[mf][0] = acc[mf][2 * hf]; t[mf][1] = acc[mf][2 * hf + 1]; }
    epi(t, m0 + wr * 64, n0 + wc * 128 + hf * 64, n0, wc, l31, h);
  }
  __syncthreads();
#undef G2_ISSUE
#undef G2_COMPUTE
}

template <class Epi>
DI void gemm_phase2(char* lds, const ASrc& A, const bf16_t* Bt, int K, int ntn, const Epi& epi) {
  const int xcd = blockIdx.x & 7, j = blockIdx.x >> 3, nloc = gridDim.x >> 3, per = 48 * ntn, grp = 8 * ntn;
  for (int li = j; li < per; li += nloc) {
    const int sg = li / grp, wi = li - sg * grp, nt = wi >> 3, mt = xcd * 48 + sg * 8 + (wi & 7);
    gemm_tile2(lds, A, Bt, K, mt * 128, nt * 256, epi);
  }
}

template <int MODE>
DI void attn3_item(char* lds, const Params& p, int layer, int seq, int head, int qt) {
  const int tid = opaque(threadIdx.x), lane = tid & 63, w = tid >> 6, l31 = lane & 31, h = lane >> 5;
  layer = opaque_s(layer); seq = opaque_s(seq); head = opaque_s(head); qt = opaque_s(qt);
  int row0, T; seq_info(seq, row0, T);
  const int QC = (MODE == 0 ? A_Q : C_Q) + head * 64;
  const int KC = MODE == 0 ? A_K + (head >> 1) * 64 : C_K + head * 64;
  const int VC = MODE == 0 ? A_V + (head >> 1) * 64 : C_V + head * 64;
  const int qw0 = qt * 256 + w * 64;
  bf16x8 qf[2][4];
#pragma unroll
  for (int qi = 0; qi < 2; ++qi)
#pragma unroll
    for (int s = 0; s < 4; ++s) qf[qi][s] = *(const bf16x8*)(p.z + (size_t)(row0 + qw0 + qi * 32 + l31) * NIN + QC + s * 16 + h * 8);
  const int srow = tid >> 3, sc8 = tid & 7;
  const bf16_t* kbase = p.z + (size_t)(row0 + srow) * NIN + KC + sc8 * 8;
  const bf16_t* vbase = p.z + (size_t)(row0 + srow) * NIN + VC + sc8 * 8;
  u32x4 rk[2], rv[2];
  const int nt = T >> 6;
  const int prow = (l31 & 19) | ((l31 & 4) << 1) | ((l31 & 8) >> 1);
#define A3_GLOAD(t) do { _Pragma("unroll") for (int i_ = 0; i_ < 2; ++i_) { const size_t off_ = (size_t)((t) * 64 + 32 * i_) * NIN; rk[i_] = *(const u32x4*)(kbase + off_); rv[i_] = *(const u32x4*)(vbase + off_); } } while (0)
#define A3_LSTORE(buf) do { char* ks_ = lds + (buf) * 18432; char* vs_ = ks_ + 9216; \
    _Pragma("unroll") for (int i_ = 0; i_ < 2; ++i_) { *(u32x4*)(ks_ + (srow + 32 * i_) * PITCH + sc8 * 16) = rk[i_]; *(u32x4*)(vs_ + (srow + 32 * i_) * PITCH + sc8 * 16) = rv[i_]; } } while (0)
  f32x16 o[2][2];
  float m_run[2], l_run[2];
#pragma unroll
  for (int a = 0; a < 2; ++a) { m_run[a] = -INFINITY; l_run[a] = 0.f;
#pragma unroll
    for (int b = 0; b < 2; ++b)
#pragma unroll
      for (int i = 0; i < 16; ++i) o[a][b][i] = 0.f; }
  float lf = 0.f, lb = 0.f;
  if (MODE == 2) { lf = log2f(1.0f - exp2f(-5.0f - (float)head)); lb = log2f(1.0f - exp2f(-5.0f - (float)(3 - head))); }
  float* dtab = (float*)(lds + 40960);
  if (MODE == 2 && tid < 64) { const int d_ = tid >> 5, kf_ = (tid >> 4) & 1, i_ = tid & 15;
    const float cc_ = (float)(32 * kf_ + (i_ & 3) + 4 * ((i_ >> 2) & 1) + 16 * ((i_ >> 3) & 1));
    dtab[tid] = d_ == 0 ? exp2f(-lf * cc_) : exp2f(lb * cc_); }
  A3_GLOAD(0); A3_LSTORE(0); __syncthreads();
#pragma unroll 1
  for (int t = 0; t < nt; ++t) {
    if (t + 1 < nt) A3_GLOAD(t + 1);
    const char* ks = lds + (t & 1) * 18432; const char* vs = ks + 9216;
    f32x16 st[2][2];
#pragma unroll
    for (int kf = 0; kf < 2; ++kf) {
#pragma unroll
      for (int qi = 0; qi < 2; ++qi)
#pragma unroll
        for (int i = 0; i < 16; ++i) st[qi][kf][i] = 0.f;
#pragma unroll
      for (int s = 0; s < 4; ++s) { const bf16x8 kfr = *(const bf16x8*)(ks + (kf * 32 + prow) * PITCH + s * 32 + h * 16);
#pragma unroll
        for (int qi = 0; qi < 2; ++qi) st[qi][kf] = MFMA32(kfr, qf[qi][s], st[qi][kf]); }
    }
    __builtin_amdgcn_sched_barrier(0);
#pragma unroll
    for (int qi = 0; qi < 2; ++qi) {
      bf16x8 pf[4];
      if (MODE == 2) {
        const int k0 = t * 64, qb = qw0 + qi * 32;
        const float dbase = (float)(qb + l31 - k0 - 8 * h);
        if (k0 + 63 < qb) {
          const float qfac = fexp2(lf * dbase);
#pragma unroll
          for (int kf = 0; kf < 2; ++kf)
#pragma unroll
            for (int g = 0; g < 4; ++g) { const f32x4 kv = *(const f32x4*)(dtab + kf * 16 + 4 * g);
#pragma unroll
              for (int e = 0; e < 4; ++e) st[qi][kf][4 * g + e] *= kv[e] * qfac; }
        } else if (k0 > qb + 31) {
          const float qfac = fexp2(-lb * dbase);
#pragma unroll
          for (int kf = 0; kf < 2; ++kf)
#pragma unroll
            for (int g = 0; g < 4; ++g) { const f32x4 kv = *(const f32x4*)(dtab + 32 + kf * 16 + 4 * g);
#pragma unroll
              for (int e = 0; e < 4; ++e) st[qi][kf][4 * g + e] *= kv[e] * qfac; }
        } else {
#pragma unroll
          for (int kf = 0; kf < 2; ++kf)
#pragma unroll
            for (int i = 0; i < 16; ++i) { const float cc = (float)(32 * kf + (i & 3) + 4 * ((i >> 2) & 1) + 16 * ((i >> 3) & 1)); const float d = dbase - cc;
              float dd = fexp2(fminf(lf * d, -lb * d)); if (d == 0.f) dd = 2.0f; st[qi][kf][i] *= dd; }
        }
      } else {
        float mx = st[qi][0][0];
#pragma unroll
        for (int kf = 0; kf < 2; ++kf)
#pragma unroll
          for (int i = 0; i < 16; ++i) mx = fmaxf(mx, st[qi][kf][i]);
        mx = fmaxf(mx, __shfl_xor(mx, 32));
        const float mn = fmaxf(m_run[qi], mx); const float alpha = fexp2(m_run[qi] - mn); m_run[qi] = mn;
        float ps = 0.f;
#pragma unroll
        for (int kf = 0; kf < 2; ++kf)
#pragma unroll
          for (int i = 0; i < 16; ++i) { st[qi][kf][i] = fexp2(st[qi][kf][i] - mn); ps += st[qi][kf][i]; }
        l_run[qi] = l_run[qi] * alpha + ps;
#pragma unroll
        for (int df = 0; df < 2; ++df) o[qi][df] *= alpha;
      }
#pragma unroll
      for (int kf = 0; kf < 2; ++kf)
#pragma unroll
        for (int s2 = 0; s2 < 2; ++s2) { u32x4 u; u.x = pk(st[qi][kf][8 * s2], st[qi][kf][8 * s2 + 1]); u.y = pk(st[qi][kf][8 * s2 + 2], st[qi][kf][8 * s2 + 3]);
          u.z = pk(st[qi][kf][8 * s2 + 4], st[qi][kf][8 * s2 + 5]); u.w = pk(st[qi][kf][8 * s2 + 6], st[qi][kf][8 * s2 + 7]); pf[kf * 2 + s2] = __builtin_bit_cast(bf16x8, u); }
#pragma unroll
      for (int df = 0; df < 2; ++df)
#pragma unroll
        for (int ksx = 0; ksx < 4; ++ksx) { const bf16x8 vfr = *(const bf16x8*)(vs + (df * 32 + l31) * PITCH + ksx * 32 + h * 16); o[qi][df] = MFMA32(vfr, pf[ksx], o[qi][df]); }
      __builtin_amdgcn_sched_barrier(0);
    }
    __builtin_amdgcn_sched_barrier(0);
    if (t + 1 < nt) A3_LSTORE((t + 1) & 1);
    __syncthreads();
  }
#undef A3_GLOAD
#undef A3_LSTORE
#pragma unroll
  for (int qi = 0; qi < 2; ++qi) {
    const int qrow = row0 + qw0 + qi * 32 + l31;
    bf16_t* zq = p.z + (size_t)qrow * NIN + QC;
    f32x16 r[2];
    if (MODE == 0) {
      const float l = l_run[qi] + __shfl_xor(l_run[qi], 32); const float inv = 1.0f / l;
#pragma unroll
      for (int df = 0; df < 2; ++df) r[df] = o[qi][df] * inv;
    } else {
      float ss = 0.f;
#pragma unroll
      for (int df = 0; df < 2; ++df)
#pragma unroll
        for (int i = 0; i < 16; ++i) ss += o[qi][df][i] * o[qi][df][i];
      ss += __shfl_xor(ss, 32);
      const float rs = rsqrtf(ss * (1.0f / 64.0f) + EPS);
      const float* gg = p.in[I_CGN] + layer * 256 + head * 64;
      const bf16_t* zg = p.z + (size_t)qrow * NIN + C_G + head * 64;
#pragma unroll
      for (int df = 0; df < 2; ++df)
#pragma unroll
        for (int g = 0; g < 4; ++g) { const u32x2 gw = *(const u32x2*)(zg + df * 32 + 8 * g + 4 * h);
          const float gv[4] = {bflo(gw.x), bfhi(gw.x), bflo(gw.y), bfhi(gw.y)};
#pragma unroll
          for (int e = 0; e < 4; ++e) { const float x = gv[e]; r[df][4 * g + e] = o[qi][df][4 * g + e] * rs * gg[df * 32 + 8 * g + 4 * h + e] * (x / (1.0f + __expf(-x))); } }
    }
#pragma unroll
    for (int df = 0; df < 2; ++df)
#pragma unroll
      for (int g = 0; g < 4; ++g) { u32x2 v; v.x = pk(r[df][4 * g], r[df][4 * g + 1]); v.y = pk(r[df][4 * g + 2], r[df][4 * g + 3]); *(u32x2*)(zq + df * 32 + 8 * g + 4 * h) = v; }
  }
}

DI void ctr_barrier(unsigned* cnt) {
  asm volatile("s_waitcnt vmcnt(0) lgkmcnt(0)" ::: "memory");
  __syncthreads();
  if (threadIdx.x == 0) {
    __builtin_amdgcn_fence(__ATOMIC_RELEASE, "agent");
    asm volatile("s_waitcnt vmcnt(0)" ::: "memory");
    const unsigned G = gridDim.x;
    const unsigned old = __hip_atomic_fetch_add(cnt, 1u, __ATOMIC_RELAXED, __HIP_MEMORY_SCOPE_AGENT);
    const unsigned gen = old / G + 1u;
    if (old + 1u == gen * G) __hip_atomic_store(cnt + 64, gen, __ATOMIC_RELAXED, __HIP_MEMORY_SCOPE_AGENT);
    else while (__hip_atomic_load(cnt + 64, __ATOMIC_RELAXED, __HIP_MEMORY_SCOPE_AGENT) < gen) __builtin_amdgcn_s_sleep(1);
    __builtin_amdgcn_fence(__ATOMIC_ACQUIRE, "agent");
    asm volatile("s_waitcnt vmcnt(0)" ::: "memory");
  }
  __syncthreads();
}

DI int next_item(int* ctr, int* sh) {
  __syncthreads();
  if (threadIdx.x == 0) *sh = atomicAdd(ctr, 1);
  __syncthreads();
  return *sh;
}
constexpr int XQ_N = 416;
DI int next_item_x(int* ctr8, int* sh) {
  __syncthreads();
  if (threadIdx.x == 0) {
    int r = -1;
    const int x0 = blockIdx.x & 7;
    for (int k = 0; k < 8; ++k) { const int x = (x0 + k) & 7; const int i = atomicAdd(ctr8 + x, 1); if (i < XQ_N) { r = (x << 16) | i; break; } }
    *sh = r;
  }
  __syncthreads();
  return *sh;
}

__global__ void __launch_bounds__(256, 2) fwd(Params p) {
  extern __shared__ __attribute__((aligned(16))) char lds[];
  __shared__ int s_item;
  cg::grid_group grid = cg::this_grid();
  const int bid = blockIdx.x, nb = gridDim.x, tid = threadIdx.x, lane = tid & 63, w = tid >> 6;
  if (bid == 0) p.ctr[tid] = 0;
  for (int i = bid * 256 + tid; i < 4096 * 32; i += nb * 256) { const int t = i >> 5, j = i & 31; const float inv = powf(10000.0f, -(float)(2 * j) / 64.0f); float sn, cs; sincosf((float)t * inv, &sn, &cs); p.tabC[i] = (f32x2){cs, sn}; }
  for (int i = bid * 256 + tid; i < 4096 * 4; i += nb * 256) { const int t = i >> 2, j = i & 3; const float inv = powf(500000.0f, -(float)(2 * j) / 8.0f); float sn, cs; sincosf((float)t * inv, &sn, &cs); p.tabB[i] = (f32x2){cs, sn}; }
  for (int i = bid * 256 + tid; i < 64 * 16; i += nb * 256) { const int t = i >> 4, j = i & 15; const float inv = powf(10000.0f, -(float)(2 * j) / 32.0f); float sn, cs; sincosf((float)t * inv, &sn, &cs); p.tabA[i] = (f32x2){cs, sn}; }
  for (int l = 0; l < 2; ++l) {
    for (int i = bid * 256 + tid; i < (NINP - NIN) * 1024; i += nb * 256) p.wtin[(size_t)l * NINP * 1024 + (size_t)NIN * 1024 + i] = 0;
    for (int tl = bid; tl < 16 * 53; tl += nb) conv_T(lds, p.in[I_WIN] + (size_t)l * 1024 * NIN, 1024, NIN, p.wtin + (size_t)l * NINP * 1024, 0, tl);
    for (int tl = bid; tl < 16 * 16; tl += nb) conv_T(lds, p.in[I_WOUT] + (size_t)l * 1024 * 1024, 1024, 1024, p.wtout + (size_t)l * 1024 * 1024, 0, tl);
  }
  bf16_t* hb = p.pl;
  for (int row = bid * 4 + opaque(w); row < MT; row += nb * 8) {
    const int rb = row + nb * 4;
    const float* xin = row < M0 ? p.in[I_XP] + (size_t)row * 1024 : p.in[I_XS] + (size_t)(row - M0) * 1024;
    if (rb < MT) { const float* xinb = rb < M0 ? p.in[I_XP] + (size_t)rb * 1024 : p.in[I_XS] + (size_t)(rb - M0) * 1024;
      row_phase2(xin, xinb, nullptr, nullptr, nullptr, nullptr, nullptr, p.in[I_NMPRE], hb + (size_t)row * 1024, hb + (size_t)rb * 1024, lane); }
    else row_phase(xin, nullptr, nullptr, nullptr, p.in[I_NMPRE], hb + (size_t)row * 1024, lane);
  }
  grid.sync();
  for (int l = 0; l < 2; ++l) {
    { ASrc A; A.b0 = hb; A.b1 = hb; A.b2 = hb; A.b3 = hb; A.s0 = A.s1 = A.s2 = A.s3 = 1024; A.shift = 12;
      EpiIn e; e.z = p.z; e.lds = lds; e.qg = p.in[I_AQG] + l * 64; e.kg = p.in[I_AKG] + l * 64; e.tabA = p.tabA; e.tabB = p.tabB; e.tabC = p.tabC;
      gemm_phase2(lds, A, p.wtin + (size_t)l * NINP * 1024, 1024, 14, e); }
    ctr_barrier((unsigned*)p.ctr + 96);
    for (int it = bid; it < MT / DTOK; it += nb) dprep_item(lds, p, l, it);
    ctr_barrier((unsigned*)p.ctr + 96);
    for (;;) {
      const int it = next_item_x(p.ctr + l * 16, &s_item);
      if (it < 0) break;
      const int x = it >> 16; int i = it & 0xffff;
      if (i < 32) { const int j = i & 15; rwkv_item(lds, p, i < 16 ? x : 8 + x, (j >> 2) & 3, (j >> 1) & 1, j & 1); }
      else { i -= 32;
        if (i < 128) attn_item<1>(lds, p, l, x, i >> 5, i & 31);
        else if (i < 192) { i -= 128; attn3_item<2>(lds, p, l, x, i >> 4, i & 15); }
        else if (i < 256) { i -= 192; attn3_item<0>(lds, p, l, x, i >> 4, i & 15); }
        else if (i < 320) { i -= 256; attn_item<1>(lds, p, l, 8 + x, i >> 4, i & 15); }
        else if (i < 352) { i -= 320; attn3_item<2>(lds, p, l, 8 + x, i >> 3, i & 7); }
        else { i -= 352; attn3_item<0>(lds, p, l, 8 + x, i >> 3, i & 7); }
      }
    }
    ctr_barrier((unsigned*)p.ctr + 96);
    bf16_t* wtgu = p.pl + 5 * PLANE; bf16_t* wtd = wtgu + (size_t)2 * DFF * 1024;
    for (int it = bid; it < MT / DTOK + 3 * 704; it += nb) {
      if (it < MT / DTOK) dpost_item(lds, p, l, it);
      else { const int j = it - MT / DTOK;
        if (j < 704) conv_T(lds, p.in[I_FG] + (size_t)l * 1024 * DFF, 1024, DFF, wtgu, 1, j);
        else if (j < 1408) conv_T(lds, p.in[I_FU] + (size_t)l * 1024 * DFF, 1024, DFF, wtgu, 2, j - 704);
        else conv_T(lds, p.in[I_FD] + (size_t)l * DFF * 1024, DFF, 1024, wtd, 0, j - 1408); }
    }
    ctr_barrier((unsigned*)p.ctr + 96);
    { ASrc A; A.b0 = p.z + A_Q; A.b1 = p.z + B_Q; A.b2 = p.z + C_Q; A.b3 = p.pl + 4 * PLANE; A.s0 = A.s1 = A.s2 = NIN; A.s3 = 256; A.shift = 8;
      EpiStore e; e.out = hb; e.ldc = 1024; e.nmax = 1024; e.lds = lds;
      gemm_phase2(lds, A, p.wtout + (size_t)l * 1024 * 1024, 1024, 4, e); }
    ctr_barrier((unsigned*)p.ctr + 96);
    for (int row = bid * 4 + opaque(w); row < MT; row += nb * 8) { const int rb = row + nb * 4;
      const float* xa = l == 0 ? (row < M0 ? p.in[I_XP] + (size_t)row * 1024 : p.in[I_XS] + (size_t)(row - M0) * 1024) : p.out + (size_t)row * 1024;
      if (rb < MT) { const float* xb = l == 0 ? (rb < M0 ? p.in[I_XP] + (size_t)rb * 1024 : p.in[I_XS] + (size_t)(rb - M0) * 1024) : p.out + (size_t)rb * 1024;
        row_phase2(xa, xb, p.out + (size_t)row * 1024, p.out + (size_t)rb * 1024, hb + (size_t)row * 1024, hb + (size_t)rb * 1024,
                   p.in[I_NMPOST] + l * 1024, p.in[I_NFPRE] + l * 1024, hb + (size_t)row * 1024, hb + (size_t)rb * 1024, lane); }
      else row_phase(xa, p.out + (size_t)row * 1024, hb + (size_t)row * 1024, p.in[I_NMPOST] + l * 1024, p.in[I_NFPRE] + l * 1024, hb + (size_t)row * 1024, lane); }
    ctr_barrier((unsigned*)p.ctr + 96);
    { ASrc A; A.b0 = hb; A.b1 = hb; A.b2 = hb; A.b3 = hb; A.s0 = A.s1 = A.s2 = A.s3 = 1024; A.shift = 12;
      EpiSwiGLU e; e.out = p.z; e.lds = lds;
      gemm_phase2(lds, A, wtgu, 1024, 22, e); }
    ctr_barrier((unsigned*)p.ctr + 96);
    { ASrc A; A.b0 = p.z; A.b1 = p.z; A.b2 = p.z; A.b3 = p.z; A.s0 = A.s1 = A.s2 = A.s3 = DFF; A.shift = 12;
      EpiStore e; e.out = hb; e.ldc = 1024; e.nmax = 1024; e.lds = lds;
      gemm_phase2(lds, A, wtd, DFF, 4, e); }
    ctr_barrier((unsigned*)p.ctr + 96);
    for (int row = bid * 4 + opaque(w); row < MT; row += nb * 8) { const int rb = row + nb * 4; const float* gp2 = l == 0 ? p.in[I_NMPRE] + 1024 : nullptr;
      if (rb < MT) row_phase2(p.out + (size_t)row * 1024, p.out + (size_t)rb * 1024, p.out + (size_t)row * 1024, p.out + (size_t)rb * 1024, hb + (size_t)row * 1024, hb + (size_t)rb * 1024,
                              p.in[I_NFPOST] + l * 1024, gp2, hb + (size_t)row * 1024, hb + (size_t)rb * 1024, lane);
      else row_phase(p.out + (size_t)row * 1024, p.out + (size_t)row * 1024, hb + (size_t)row * 1024, p.in[I_NFPOST] + l * 1024, gp2, hb + (size_t)row * 1024, lane); }
    if (l == 0) ctr_barrier((unsigned*)p.ctr + 96);
  }
}

extern "C" void kernel_launch(void* const* d_in, const int* in_sizes, int n_in, void* d_out, int out_size,
                              void* d_ws, size_t ws_size, hipStream_t stream) {
  static int grid_blocks = 0;
  if (!grid_blocks) {
    int dev = 0, cus = 0, per_cu = 0;
    hipGetDevice(&dev);
    hipDeviceGetAttribute(&cus, hipDeviceAttributeMultiprocessorCount, dev);
    hipFuncSetAttribute((const void*)fwd, hipFuncAttributeMaxDynamicSharedMemorySize, LDS_BYTES);
    hipOccupancyMaxActiveBlocksPerMultiprocessor(&per_cu, fwd, 256, LDS_BYTES);
    if (per_cu > 2) per_cu = 2;
    if (per_cu < 1) per_cu = 1;
    grid_blocks = cus * per_cu;
  }
  Params p{};
  for (int i = 0; i < 28; ++i) p.in[i] = (const float*)d_in[i];
  p.out = (float*)d_out;
  char* ws = (char*)d_ws;
  size_t off = 0;
  p.z = (bf16_t*)(ws + off); off += (size_t)MT * NIN * 2;
  p.pl = (bf16_t*)(ws + off); off += 7 * PLANE * 2;
  p.wtin = (bf16_t*)(ws + off); off += (size_t)2 * NINP * 1024 * 2;
  p.wtout = (bf16_t*)(ws + off); off += (size_t)2 * 1024 * 1024 * 2;
  p.tabC = (f32x2*)(ws + off); off += (size_t)4096 * 32 * 8;
  p.tabB = (f32x2*)(ws + off); off += (size_t)4096 * 4 * 8;
  p.tabA = (f32x2*)(ws + off); off += (size_t)64 * 16 * 8;
  p.ctr = (int*)(ws + off); off += 1024;
  if (off > ws_size) fprintf(stderr, "workspace too small: need %zu have %zu\n", off, ws_size);
  void* args[] = {&p};
  hipError_t e = hipLaunchCooperativeKernel((void*)fwd, dim3(grid_blocks), dim3(256), args, LDS_BYTES, stream);
  if (e != hipSuccess) fprintf(stderr, "coop launch failed: %s (grid %d)\n", hipGetErrorString(e), grid_blocks);
}
```
